# Optimizing an MI355X kernel written in HIP

```python
import jax, jax.numpy as jnp
from jax import lax
import numpy as np

D_MODEL = 1024
BATCH = 4
SEQ = 4096
DEPTH = 2

GRID_W = 64
CTX_LEN = 256

HEAD_DIM = 64
ROPE_THETA = 10000.0

ATTN_HEADS = 8
ATTN_KV_HEADS = 2
ATTN_GROUP = ATTN_HEADS // ATTN_KV_HEADS
Q_BLOCK = 128

GLA_HEADS = 4
GLA_DK = 64
GLA_DV = 128
GLA_GATE_RANK = 16
GLA_TAU = 16.0
GLA_CHUNK = 64

NA_HEADS = 8
NA_KH = 8
NA_KW = 16

A_Q = ATTN_HEADS * HEAD_DIM
A_KV = ATTN_KV_HEADS * HEAD_DIM
B_QK = GLA_HEADS * GLA_DK
B_V = GLA_HEADS * GLA_DV
B_A = 2 * GLA_GATE_RANK
C_W = NA_HEADS * HEAD_DIM
N_BRANCH = 3
IN_SPLITS = (A_Q, A_KV, A_KV, B_QK, B_QK, B_V, B_V, B_A, C_W, C_W, C_W, N_BRANCH * D_MODEL)
N_IN = sum(IN_SPLITS)
N_MOD = 6 * D_MODEL

N_GROUPS = 4
EXPERTS_PER_GROUP = 8
N_EXPERTS = N_GROUPS * EXPERTS_PER_GROUP
TOP_K = 2
D_EXPERT = 512
MOE_BLOCK = 128

LN_EPS = 1e-6
RMS_EPS = 1e-6
DEEPNORM_ALPHA = (2 * DEPTH) ** 0.25
DEEPNORM_BETA = (8 * DEPTH) ** -0.25

kernel_name = "hybrid_gated_mixers_hmoe_dit"


def _f32(a):
    return a.astype(jnp.float32)


def layer_norm0(x):
    xf = _f32(x)
    mu = xf.mean(-1, keepdims=True)
    var = jnp.square(xf - mu).mean(-1, keepdims=True)
    return ((xf - mu) * lax.rsqrt(var + LN_EPS)).astype(x.dtype)


def layer_norm(x, g, b):
    return layer_norm0(x) * g + b


def rms_norm(x, g):
    xf = _f32(x)
    return (xf * lax.rsqrt(jnp.mean(xf * xf, -1, keepdims=True) + RMS_EPS)).astype(x.dtype) * g


def modulate(x, shift, scale):
    return layer_norm0(x) * (1.0 + scale) + shift


def split_cols(z):
    idx = [int(i) for i in np.cumsum(IN_SPLITS)[:-1]]
    return jnp.split(z, idx, axis=-1)


def axial_rope(L):
    t = jnp.arange(L)
    row = (t // GRID_W).astype(jnp.float32)
    col = (t % GRID_W).astype(jnp.float32)
    n_freq = HEAD_DIM // 4
    inv = ROPE_THETA ** (-jnp.arange(n_freq, dtype=jnp.float32) / n_freq)
    ar = row[:, None] * inv
    ac = col[:, None] * inv
    ang = jnp.concatenate([ar, ar, ac, ac], axis=-1)
    return jnp.cos(ang), jnp.sin(ang)


def apply_rope(x, cos, sin):
    xf = _f32(x)
    x1, x2, x3, x4 = jnp.split(xf, 4, axis=-1)
    rot = jnp.concatenate([-x2, x1, -x4, x3], axis=-1)
    return (xf * cos[:, None, :] + rot * sin[:, None, :]).astype(x.dtype)


def softmax_attend(q, k, v):
    s = _f32(jnp.einsum('bqkgd,bskd->bkgqs', q, k)) * (HEAD_DIM ** -0.5)
    p = jax.nn.softmax(s, axis=-1).astype(v.dtype)
    return jnp.einsum('bkgqs,bskd->bqkgd', p, v)


def gqa_axial(q_lat, k_lat, v_lat, q_ctx, k_ctx, v_ctx, q_norm, k_norm, with_ctx_out):
    B, L = q_lat.shape[:2]
    Lc = q_ctx.shape[1]
    cos, sin = axial_rope(L)
    q = apply_rope(rms_norm(q_lat.reshape(B, L, ATTN_HEADS, HEAD_DIM), q_norm), cos, sin)
    k = apply_rope(rms_norm(k_lat.reshape(B, L, ATTN_KV_HEADS, HEAD_DIM), k_norm), cos, sin)
    k_c = rms_norm(k_ctx.reshape(B, Lc, ATTN_KV_HEADS, HEAD_DIM), k_norm)
    v_c = v_ctx.reshape(B, Lc, ATTN_KV_HEADS, HEAD_DIM)
    k_all = jnp.concatenate([k_c, k], axis=1)
    v_all = jnp.concatenate([v_c, v_lat.reshape(B, L, ATTN_KV_HEADS, HEAD_DIM)], axis=1)
    n_blk = L // Q_BLOCK
    q_blocks = q.reshape(B, n_blk, Q_BLOCK, ATTN_KV_HEADS, ATTN_GROUP, HEAD_DIM).transpose(1, 0, 2, 3, 4, 5)
    o = lax.map(lambda qb: softmax_attend(qb, k_all, v_all), q_blocks)
    o_lat = o.transpose(1, 0, 2, 3, 4, 5).reshape(B, L, A_Q)
    if not with_ctx_out:
        return o_lat, None
    q_c = rms_norm(q_ctx.reshape(B, Lc, ATTN_KV_HEADS, ATTN_GROUP, HEAD_DIM), q_norm)
    return o_lat, softmax_attend(q_c, k_c, v_c).reshape(B, Lc, A_Q)


def gla_chunk_scan(q, k, v, log_g, s0):
    B, H, T, dk = q.shape
    dv = v.shape[-1]
    nc = T // GLA_CHUNK

    def to_chunks(a):
        return jnp.moveaxis(a.reshape(B, H, nc, GLA_CHUNK, a.shape[-1]), 2, 0)

    causal = jnp.tril(jnp.ones((GLA_CHUNK, GLA_CHUNK), dtype=bool))[:, :, None]

    def step(S, inp):
        qc, kc, vc, gc = (_f32(a) for a in inp)
        b = jnp.cumsum(gc, axis=2)
        o_inter = jnp.einsum('bhtd,bhde->bhte', qc * jnp.exp(b), S)
        diff = b[:, :, :, None, :] - b[:, :, None, :, :]
        decay = jnp.where(causal, jnp.exp(jnp.where(causal, diff, 0.0)), 0.0)
        scores = jnp.einsum('bhtsd,bhsd->bhts', qc[:, :, :, None, :] * decay, kc)
        o_intra = jnp.einsum('bhts,bhse->bhte', scores, vc)
        b_end = b[:, :, -1:, :]
        S_new = jnp.exp(b_end[:, :, 0, :])[..., None] * S + jnp.einsum('bhsd,bhse->bhde', kc * jnp.exp(b_end - b), vc)
        return S_new, o_inter + o_intra

    S, o = lax.scan(step, s0, (to_chunks(q), to_chunks(k), to_chunks(v), to_chunks(log_g)))
    o = jnp.moveaxis(o, 0, 2).reshape(B, H, T, dv).astype(v.dtype)
    return S, o


def gla_bidir(z_lat, z_ctx, w_gate, b_gate, norm_g, with_ctx_out):
    def prep(z):
        q, k, v, r, a = z
        B, T = q.shape[:2]

        def heads(t, d):
            return t.reshape(B, T, GLA_HEADS, d).transpose(0, 2, 1, 3)

        def log_gate(a_dir, d):
            return heads(jax.nn.log_sigmoid(_f32(a_dir @ w_gate[d] + b_gate[d])) / GLA_TAU, GLA_DK)

        a_f, a_b = jnp.split(a, 2, axis=-1)
        return (heads(q, GLA_DK) * (GLA_DK ** -0.5), heads(k, GLA_DK), heads(v, GLA_DV), r,
                log_gate(a_f, 0), log_gate(a_b, 1))

    q_l, k_l, v_l, r_l, gf_l, gb_l = prep(z_lat)
    q_c, k_c, v_c, r_c, gf_c, gb_c = prep(z_ctx)
    B = q_l.shape[0]
    s0 = jnp.zeros((B, GLA_HEADS, GLA_DK, GLA_DV), jnp.float32)

    def flip(t):
        return jnp.flip(t, axis=2)

    s_cf, o_cf = gla_chunk_scan(q_c, k_c, v_c, gf_c, s0)
    _, o_lf = gla_chunk_scan(q_l, k_l, v_l, gf_l, s_cf)
    s_cb, o_cb = gla_chunk_scan(flip(q_c), flip(k_c), flip(v_c), flip(gb_c), s0)
    _, o_lb = gla_chunk_scan(flip(q_l), flip(k_l), flip(v_l), flip(gb_l), s_cb)

    def readout(o, r):
        Bo, H, T, dv = o.shape
        o = rms_norm(o.transpose(0, 2, 1, 3), norm_g).reshape(Bo, T, H * dv)
        return o * jax.nn.silu(r)

    o_lat = readout(o_lf + flip(o_lb), r_l)
    o_ctx = readout(o_cf + flip(o_cb), r_c) if with_ctx_out else None
    return o_lat, o_ctx


def neighbourhood_attn(q_lat, k_lat, v_lat, q_ctx, k_ctx, v_ctx, rpb, with_ctx_out):
    B, L = q_lat.shape[:2]
    Lc = q_ctx.shape[1]
    rows = L // GRID_W
    kh = min(NA_KH, rows)
    scale = HEAD_DIM ** -0.5

    def grid(t):
        return t.reshape(B, rows, GRID_W, NA_HEADS, HEAD_DIM).transpose(0, 3, 1, 2, 4)

    q_rows = q_lat.reshape(B, rows, GRID_W, NA_HEADS, HEAD_DIM).transpose(1, 0, 3, 2, 4)
    k_grid, v_grid = grid(k_lat), grid(v_lat)
    k_c = k_ctx.reshape(B, Lc, NA_HEADS, HEAD_DIM)
    v_c = v_ctx.reshape(B, Lc, NA_HEADS, HEAD_DIM)

    r = np.arange(rows)
    row_start = np.clip(r - kh // 2, 0, rows - kh)
    cidx = np.arange(GRID_W)
    col_start = np.clip(cidx - NA_KW // 2, 0, GRID_W - NA_KW)
    col_idx = col_start[:, None] + np.arange(NA_KW)
    row_rel = row_start[:, None] + np.arange(kh) - r[:, None] + (NA_KH - 1)
    col_rel = col_idx - cidx[:, None] + (NA_KW - 1)
    bias = rpb[:, row_rel][:, :, :, col_rel].transpose(1, 0, 3, 2, 4)

    def row_fn(inp):
        qr, rs, br = inp
        kb = lax.dynamic_slice_in_dim(k_grid, rs, kh, axis=2)
        vb = lax.dynamic_slice_in_dim(v_grid, rs, kh, axis=2)
        kg = kb[:, :, :, col_idx]
        vg = vb[:, :, :, col_idx]
        s_nb = _f32(jnp.einsum('bhwd,bhiwjd->bhwij', qr, kg)) * scale + br
        s_cx = _f32(jnp.einsum('bhwd,bchd->bhwc', qr, k_c)) * scale
        s = jnp.concatenate([s_nb.reshape(B, NA_HEADS, GRID_W, kh * NA_KW), s_cx], axis=-1)
        p = jax.nn.softmax(s, axis=-1).astype(vg.dtype)
        p_nb = p[..., :kh * NA_KW].reshape(B, NA_HEADS, GRID_W, kh, NA_KW)
        p_cx = p[..., kh * NA_KW:]
        return jnp.einsum('bhwij,bhiwjd->bhwd', p_nb, vg) + jnp.einsum('bhwc,bchd->bhwd', p_cx, v_c)

    o = lax.map(row_fn, (q_rows, jnp.asarray(row_start, jnp.int32), bias))
    o_lat = o.transpose(1, 0, 3, 2, 4).reshape(B, L, C_W)
    if not with_ctx_out:
        return o_lat, None
    q_c = q_ctx.reshape(B, Lc, NA_HEADS, 1, HEAD_DIM)
    return o_lat, softmax_attend(q_c, k_c, v_c).reshape(B, Lc, C_W)


def token_mixers(h_lat, h_ctx, w_in, b_in, q_norm, k_norm, gla_w_gate, gla_b_gate, gla_norm, na_rpb,
                 w_br_attn, w_br_gla, w_br_na, w_out, with_ctx_out):
    z_lat = split_cols(h_lat @ w_in + b_in)
    z_ctx = split_cols(h_ctx @ w_in + b_in)
    oa_l, oa_c = gqa_axial(*z_lat[0:3], *z_ctx[0:3], q_norm, k_norm, with_ctx_out)
    ob_l, ob_c = gla_bidir(z_lat[3:8], z_ctx[3:8], gla_w_gate, gla_b_gate, gla_norm, with_ctx_out)
    oc_l, oc_c = neighbourhood_attn(*z_lat[8:11], *z_ctx[8:11], na_rpb, with_ctx_out)

    def merge(o_a, o_b, o_c, gate_cols):
        g = jax.nn.sigmoid(gate_cols.reshape(gate_cols.shape[:-1] + (N_BRANCH, D_MODEL)))
        y = g[..., 0, :] * (o_a @ w_br_attn) + g[..., 1, :] * (o_b @ w_br_gla) + g[..., 2, :] * (o_c @ w_br_na)
        return y @ w_out

    y_lat = merge(oa_l, ob_l, oc_l, z_lat[11])
    y_ctx = merge(oa_c, ob_c, oc_c, z_ctx[11]) if with_ctx_out else None
    return y_lat, y_ctx


def hier_moe(h, w_rg, b_rg, w_re, b_re, w1, w3, w2):
    T, D = h.shape
    hf = _f32(h)
    g_logits = hf @ _f32(w_rg) + _f32(b_rg)
    grp = jnp.argmax(g_logits, axis=-1)
    p_grp = jax.nn.softmax(g_logits, axis=-1).max(-1, keepdims=True)
    e_logits = (hf @ _f32(w_re) + _f32(b_re)).reshape(T, N_GROUPS, EXPERTS_PER_GROUP)
    sel = jnp.einsum('tge,tg->te', e_logits, jax.nn.one_hot(grp, N_GROUPS, dtype=jnp.float32))
    top_v, top_i = lax.top_k(sel, TOP_K)
    gate = p_grp * jax.nn.softmax(top_v, axis=-1)
    expert = grp[:, None] * EXPERTS_PER_GROUP + top_i

    n_assign = T * TOP_K
    n_blocks = -(-n_assign // MOE_BLOCK) + N_EXPERTS
    flat_e = expert.reshape(-1)
    flat_t = jnp.repeat(jnp.arange(T), TOP_K)
    order = jnp.argsort(flat_e)
    se, st, sw = flat_e[order], flat_t[order], gate.reshape(-1)[order]
    counts = jnp.bincount(flat_e, length=N_EXPERTS)
    padded = ((counts + MOE_BLOCK - 1) // MOE_BLOCK) * MOE_BLOCK
    pad_end = jnp.cumsum(padded)
    pad_start = pad_end - padded
    start = jnp.cumsum(counts) - counts
    pos = pad_start[se] + (jnp.arange(n_assign) - start[se])
    block_expert = jnp.minimum(
        jnp.searchsorted(pad_end, jnp.arange(n_blocks) * MOE_BLOCK, side='right'), N_EXPERTS - 1)
    x_slots = jnp.zeros((n_blocks * MOE_BLOCK, D), h.dtype).at[pos].set(h[st])

    def expert_block(inp):
        xb, e = inp
        return (jax.nn.silu(xb @ w1[e]) * (xb @ w3[e])) @ w2[e]

    y_slots = lax.map(expert_block, (x_slots.reshape(n_blocks, MOE_BLOCK, D), block_expert)).reshape(-1, D)
    y = y_slots[pos] * sw[:, None].astype(h.dtype)
    return jax.ops.segment_sum(y, st, num_segments=T)


def setup_inputs(seed: int = 0) -> dict:
    key = jax.random.key(seed)
    ks = jax.random.split(key, 29)
    D = D_MODEL

    def n(k, shape, s):
        return jax.random.normal(k, shape, jnp.float32) * s

    return {
        "x": n(ks[0], (BATCH, SEQ, D), 1.0),
        "c": n(ks[1], (BATCH, D), 1.0),
        "ctx": n(ks[2], (BATCH, CTX_LEN, D), 1.0),
        "c_ctx": n(ks[3], (D,), 1.0),
        "w_mod": n(ks[4], (DEPTH, D, N_MOD), 0.5 * D ** -0.5),
        "b_mod": n(ks[5], (DEPTH, N_MOD), 0.01),
        "w_in": n(ks[6], (DEPTH, D, N_IN), D ** -0.5),
        "b_in": n(ks[7], (DEPTH, N_IN), 0.01),
        "attn_q_norm": 1.0 + n(ks[8], (DEPTH, HEAD_DIM), 0.02),
        "attn_k_norm": 1.0 + n(ks[9], (DEPTH, HEAD_DIM), 0.02),
        "gla_w_gate": n(ks[10], (DEPTH, 2, GLA_GATE_RANK, B_QK), GLA_GATE_RANK ** -0.5),
        "gla_b_gate": n(ks[11], (DEPTH, 2, B_QK), 0.1),
        "gla_norm": 1.0 + n(ks[12], (DEPTH, GLA_DV), 0.02),
        "na_rpb": n(ks[13], (DEPTH, NA_HEADS, 2 * NA_KH - 1, 2 * NA_KW - 1), 0.02),
        "w_br_attn": n(ks[14], (DEPTH, A_Q, D), DEEPNORM_BETA * A_Q ** -0.5),
        "w_br_gla": n(ks[15], (DEPTH, B_V, D), DEEPNORM_BETA * B_V ** -0.5),
        "w_br_na": n(ks[16], (DEPTH, C_W, D), DEEPNORM_BETA * C_W ** -0.5),
        "w_out": n(ks[17], (DEPTH, D, D), DEEPNORM_BETA * D ** -0.5),
        "ln1_g": 1.0 + n(ks[18], (DEPTH, D), 0.02),
        "ln1_b": n(ks[19], (DEPTH, D), 0.01),
        "w_router_group": n(ks[20], (DEPTH, D, N_GROUPS), D ** -0.5),
        "b_router_group": n(ks[21], (DEPTH, N_GROUPS), 0.01),
        "w_router_expert": n(ks[22], (DEPTH, D, N_EXPERTS), D ** -0.5),
        "b_router_expert": n(ks[23], (DEPTH, N_EXPERTS), 0.01),
        "moe_w1": n(ks[24], (DEPTH, N_EXPERTS, D, D_EXPERT), D ** -0.5),
        "moe_w3": n(ks[25], (DEPTH, N_EXPERTS, D, D_EXPERT), D ** -0.5),
        "moe_w2": n(ks[26], (DEPTH, N_EXPERTS, D_EXPERT, D), DEEPNORM_BETA * D_EXPERT ** -0.5),
        "ln2_g": 1.0 + n(ks[27], (DEPTH, D), 0.02),
        "ln2_b": n(ks[28], (DEPTH, D), 0.01),
    }


def reference(x, c, ctx, c_ctx, w_mod, b_mod, w_in, b_in, attn_q_norm, attn_k_norm, gla_w_gate, gla_b_gate,
              gla_norm, na_rpb, w_br_attn, w_br_gla, w_br_na, w_out, ln1_g, ln1_b, w_router_group,
              b_router_group, w_router_expert, b_router_expert, moe_w1, moe_w3, moe_w2, ln2_g, ln2_b):
    B, L, D = x.shape
    Lc = ctx.shape[1]
    silu_c = jax.nn.silu(c)
    silu_cc = jax.nn.silu(c_ctx)
    x_ctx = ctx
    for l in range(DEPTH):
        last = l == DEPTH - 1
        sh1, sc1, g1, sh2, sc2, g2 = jnp.split((silu_c @ w_mod[l] + b_mod[l])[:, None, :], 6, axis=-1)
        csh1, csc1, cg1, csh2, csc2, cg2 = jnp.split(silu_cc @ w_mod[l] + b_mod[l], 6, axis=-1)

        y_lat, y_ctx = token_mixers(modulate(x, sh1, sc1), modulate(x_ctx, csh1, csc1), w_in[l], b_in[l],
                                    attn_q_norm[l], attn_k_norm[l], gla_w_gate[l], gla_b_gate[l], gla_norm[l],
                                    na_rpb[l], w_br_attn[l], w_br_gla[l], w_br_na[l], w_out[l], not last)
        x = layer_norm(DEEPNORM_ALPHA * x + g1 * y_lat, ln1_g[l], ln1_b[l])

        h_lat = modulate(x, sh2, sc2).reshape(B * L, D)
        if last:
            tokens = h_lat
        else:
            x_ctx = layer_norm(DEEPNORM_ALPHA * x_ctx + cg1 * y_ctx, ln1_g[l], ln1_b[l])
            tokens = jnp.concatenate([h_lat, modulate(x_ctx, csh2, csc2).reshape(B * Lc, D)], axis=0)
        y = hier_moe(tokens, w_router_group[l], b_router_group[l], w_router_expert[l], b_router_expert[l],
                     moe_w1[l], moe_w3[l], moe_w2[l])
        x = layer_norm(DEEPNORM_ALPHA * x + g2 * y[:B * L].reshape(B, L, D), ln2_g[l], ln2_b[l])
        if not last:
            x_ctx = layer_norm(DEEPNORM_ALPHA * x_ctx + cg2 * y[B * L:].reshape(B, Lc, D), ln2_g[l], ln2_b[l])
    return x
```

```cpp
#include <hip/hip_runtime.h>
#include <hip/hip_cooperative_groups.h>
#include <stdint.h>
#include <stdio.h>
namespace cg = cooperative_groups;

typedef unsigned short bf16_t;
typedef __attribute__((ext_vector_type(8))) short bf16x8;
typedef __attribute__((ext_vector_type(4))) short bf16x4;
typedef __attribute__((ext_vector_type(16))) float f32x16;

constexpr int D = 1024;
constexpr int TLAT = 16384, TCTX = 1024, TALL = 17408, PALL = 4352;
constexpr int NIN_SRC = 6944, NMOD = 6144;
constexpr int NT_IN = 31;
constexpr int SMEM_BYTES = 69632;
constexpr int LDC = 132;
constexpr float LOG2E = 1.4426950408889634f;
constexpr float QSCALE = 0.125f * LOG2E;
constexpr float ALPHA = 1.4142135623730951f;
constexpr int NCHUNK = 68;
constexpr int MOE_CAP = TALL;
constexpr int MAX_MBLK = 304;

struct Params {
  const float *x, *c, *ctx, *c_ctx, *w_mod, *b_mod, *w_in, *b_in, *q_norm, *k_norm, *gla_wg, *gla_bg, *gla_norm, *rpb,
      *w_br_attn, *w_br_gla, *w_br_na, *w_out, *ln1_g, *ln1_b, *w_rg, *b_rg, *w_re, *b_re, *w1, *w3, *w2, *ln2_g, *ln2_b;
  float* out;
  float *mod_part, *mod, *rope;
  bf16_t *wt_in, *wt_gate, *wt_br, *wt_out, *wt_13, *wt_2;
  float* xres;
  bf16_t *h, *h2;
  bf16_t *qA, *kA, *vAT, *qB, *kB, *vBT, *rB;
  float* aB;
  bf16_t *qC, *kC, *vCT;
  bf16_t *oA, *oB, *oC;
  float* KVt;
  bf16_t* SP;
  float* decay;
  bf16_t* m;
  bf16_t *act, *ysl;
  int *cnt, *list, *tok_e, *tok_pos, *estart;
  float* tok_gate;
};

__device__ __forceinline__ bf16_t f2bf(float f) {
  unsigned u = __float_as_uint(f);
  u += 0x7fffu + ((u >> 16) & 1u);
  return (bf16_t)(u >> 16);
}
__device__ __forceinline__ float bf2f(bf16_t b) { return __uint_as_float(((unsigned)b) << 16); }
__device__ __forceinline__ unsigned pack2(float a, float b) { return (unsigned)f2bf(a) | ((unsigned)f2bf(b) << 16); }
__device__ __forceinline__ float wave_sum(float v) {
#pragma unroll
  for (int o = 32; o > 0; o >>= 1) v += __shfl_xor(v, o);
  return v;
}
__device__ __forceinline__ float siluf(float x) { return x / (1.f + __expf(-x)); }
__device__ __forceinline__ float sigmoidf_(float x) { return 1.f / (1.f + __expf(-x)); }
__device__ __forceinline__ f32x16 zero16() {
  f32x16 z;
#pragma unroll
  for (int i = 0; i < 16; ++i) z[i] = 0.f;
  return z;
}
__device__ __forceinline__ f32x16 mfma32(bf16x8 a, bf16x8 b, f32x16 c) {
  return __builtin_amdgcn_mfma_f32_32x32x16_bf16(a, b, c, 0, 0, 0);
}
__device__ __forceinline__ int tok_modrow(int tok) { return tok < TLAT ? (tok >> 12) : 4; }

__device__ void phase_setup(const Params& p, char* smem) {
  float* sS = (float*)smem;
  const int tid = threadIdx.x;
  for (int item = blockIdx.x; item < 769; item += gridDim.x) {
    if (item == 768) {
      for (int i = tid; i < 1024; i += 256) {
        int pos = i >> 4, f = i & 15;
        float inv = powf(10000.f, -(float)f / 16.f);
        float ang = (float)pos * inv;
        p.rope[i] = cosf(ang);
        p.rope[1024 + i] = sinf(ang);
      }
      continue;
    }
    int nb = item % 24, ks = (item / 24) % 16, l = item / 384;
    __syncthreads();
    for (int i = tid; i < 320; i += 256) {
      int r = i >> 6, k = ks * 64 + (i & 63);
      float cv = (r < 4) ? p.c[r * 1024 + k] : p.c_ctx[k];
      sS[i] = siluf(cv);
    }
    __syncthreads();
    int n = nb * 256 + tid;
    const float* w = p.w_mod + ((size_t)l * 1024 + ks * 64) * NMOD + n;
    float acc[5] = {0.f, 0.f, 0.f, 0.f, 0.f};
#pragma unroll 8
    for (int k = 0; k < 64; ++k) {
      float wv = w[(size_t)k * NMOD];
#pragma unroll
      for (int r = 0; r < 5; ++r) acc[r] += sS[r * 64 + k] * wv;
    }
#pragma unroll
    for (int r = 0; r < 5; ++r) p.mod_part[(((size_t)ks * 2 + l) * 5 + r) * NMOD + n] = acc[r];
  }
}
__device__ void phase_modreduce(const Params& p) {
  for (int i = blockIdx.x * 256 + threadIdx.x; i < 2 * 5 * NMOD; i += gridDim.x * 256) {
    int n = i % NMOD, l = i / (5 * NMOD);
    float s = p.b_mod[l * NMOD + n];
#pragma unroll
    for (int ks = 0; ks < 16; ++ks) s += p.mod_part[(size_t)ks * 2 * 5 * NMOD + i];
    p.mod[i] = s;
  }
}

__device__ __forceinline__ void conv_tile(const float* src, int ldsrc, int srccol, bool zero, int k0, bf16_t* dst, int lddst,
                                          int n0, float* sT) {
  const int tid = threadIdx.x;
  __syncthreads();
#pragma unroll
  for (int i = 0; i < 4; ++i) {
    int kr = (tid >> 4) + 16 * i, c4 = (tid & 15) * 4;
    float4 v = make_float4(0.f, 0.f, 0.f, 0.f);
    if (!zero) v = *(const float4*)(src + (size_t)(k0 + kr) * ldsrc + srccol + c4);
    float* d = sT + kr * 65 + c4;
    d[0] = v.x; d[1] = v.y; d[2] = v.z; d[3] = v.w;
  }
  __syncthreads();
#pragma unroll
  for (int i = 0; i < 2; ++i) {
    int n = (tid >> 3) + 32 * i, kc = (tid & 7) * 8;
    unsigned o[4];
#pragma unroll
    for (int e = 0; e < 4; ++e) o[e] = pack2(sT[(kc + 2 * e) * 65 + n], sT[(kc + 2 * e + 1) * 65 + n]);
    *(uint4*)(dst + (size_t)(n0 + n) * lddst + k0 + kc) = make_uint4(o[0], o[1], o[2], o[3]);
  }
}
constexpr int CV_IN = 16 * 62, CV_GATE = 16 * 48, CV_BR = 8 * 16, CV_OUT = 16 * 16, CV_13 = 16 * 16, CV_2 = 8 * 16;
constexpr int CV_O1 = CV_IN, CV_O2 = CV_O1 + CV_GATE, CV_O3 = CV_O2 + 3 * CV_BR, CV_O4 = CV_O3 + CV_OUT, CV_O5 = CV_O4 + 32 * CV_13,
              CV_TOTAL = CV_O5 + 32 * CV_2;
__device__ void phase_convert(const Params& p, int layer, char* smem) {
  float* sT = (float*)smem;
  for (int item = blockIdx.x; item < CV_TOTAL; item += gridDim.x) {
    if (item < CV_O1) {
      int kt = item & 15, ntile = item >> 4;
      int n0 = ntile * 64;
      int srccol;
      bool zero = false;
      if (n0 < 2304) srccol = n0;
      else if (n0 < 3840) srccol = n0 + 32;
      else if (n0 == 3840) srccol = 2304;
      else { srccol = 0; zero = true; }
      const float* src = p.w_in + (size_t)layer * 1024 * NIN_SRC;
      if (n0 == 3840) {
        const int tid = threadIdx.x;
        __syncthreads();
#pragma unroll
        for (int i = 0; i < 4; ++i) {
          int kr = (tid >> 4) + 16 * i, c4 = (tid & 15) * 4;
          float4 v = make_float4(0.f, 0.f, 0.f, 0.f);
          if (c4 < 32) v = *(const float4*)(src + (size_t)(kt * 64 + kr) * NIN_SRC + 2304 + c4);
          float* d = sT + kr * 65 + c4;
          d[0] = v.x; d[1] = v.y; d[2] = v.z; d[3] = v.w;
        }
        __syncthreads();
#pragma unroll
        for (int i = 0; i < 2; ++i) {
          int n = (tid >> 3) + 32 * i, kc = (tid & 7) * 8;
          unsigned o[4];
#pragma unroll
          for (int e = 0; e < 4; ++e) o[e] = pack2(sT[(kc + 2 * e) * 65 + n], sT[(kc + 2 * e + 1) * 65 + n]);
          *(uint4*)(p.wt_in + (size_t)(n0 + n) * 1024 + kt * 64 + kc) = make_uint4(o[0], o[1], o[2], o[3]);
        }
      } else {
        conv_tile(src, NIN_SRC, srccol, zero, kt * 64, p.wt_in, 1024, n0, sT);
      }
    } else if (item < CV_O2) {
      int it = item - CV_O1;
      int kt = it & 15, ntile = it >> 4;
      conv_tile(p.w_in + (size_t)layer * 1024 * NIN_SRC, NIN_SRC, 3872 + ntile * 64, false, kt * 64, p.wt_gate, 1024, ntile * 64, sT);
    } else if (item < CV_O3) {
      int it = item - CV_O2;
      int br = it / CV_BR, t = it % CV_BR;
      int kt = t & 7, ntile = t >> 3;
      const float* src = (br == 0 ? p.w_br_attn : (br == 1 ? p.w_br_gla : p.w_br_na)) + (size_t)layer * 512 * 1024;
      conv_tile(src, 1024, ntile * 64, false, kt * 64, p.wt_br + (size_t)br * 1024 * 512, 512, ntile * 64, sT);
    } else if (item < CV_O4) {
      int it = item - CV_O3;
      int kt = it & 15, ntile = it >> 4;
      conv_tile(p.w_out + (size_t)layer * 1024 * 1024, 1024, ntile * 64, false, kt * 64, p.wt_out, 1024, ntile * 64, sT);
    } else if (item < CV_O5) {
      int it = item - CV_O4;
      int e = it >> 8, t = it & 255;
      int kt = t & 15, ntile = t >> 4;
      int j = ntile >> 1, isw3 = ntile & 1;
      const float* src = (isw3 ? p.w3 : p.w1) + ((size_t)layer * 32 + e) * 1024 * 512;
      conv_tile(src, 512, j * 64, false, kt * 64, p.wt_13 + (size_t)e * 1024 * 1024, 1024, ntile * 64, sT);
    } else {
      int it = item - CV_O5;
      int e = it >> 7, t = it & 127;
      int kt = t & 7, ntile = t >> 3;
      conv_tile(p.w2 + ((size_t)layer * 32 + e) * 512 * 1024, 1024, ntile * 64, false, kt * 64, p.wt_2 + (size_t)e * 1024 * 512, 512,
                ntile * 64, sT);
    }
  }
}

__device__ __forceinline__ void row_stats(const float (&v)[16], float& mean, float& rstd) {
  float s = 0.f;
#pragma unroll
  for (int i = 0; i < 16; ++i) s += v[i];
  mean = wave_sum(s) * (1.f / 1024.f);
  float q = 0.f;
#pragma unroll
  for (int i = 0; i < 16; ++i) { float d = v[i] - mean; q += d * d; }
  float var = wave_sum(q) * (1.f / 1024.f);
  rstd = rsqrtf(var + 1e-6f);
}
__device__ __forceinline__ void load_row(const float* src, int lane, float (&v)[16]) {
#pragma unroll
  for (int i = 0; i < 4; ++i) {
    float4 t = *(const float4*)(src + lane * 4 + 256 * i);
    v[4 * i] = t.x; v[4 * i + 1] = t.y; v[4 * i + 2] = t.z; v[4 * i + 3] = t.w;
  }
}
__device__ __forceinline__ void store_row(float* dst, int lane, const float (&v)[16]) {
#pragma unroll
  for (int i = 0; i < 4; ++i) *(float4*)(dst + lane * 4 + 256 * i) = make_float4(v[4 * i], v[4 * i + 1], v[4 * i + 2], v[4 * i + 3]);
}
__device__ __forceinline__ void store_row_bf(bf16_t* dst, int lane, const float (&v)[16]) {
#pragma unroll
  for (int i = 0; i < 4; ++i) {
    uint2 o = make_uint2(pack2(v[4 * i], v[4 * i + 1]), pack2(v[4 * i + 2], v[4 * i + 3]));
    *(uint2*)(dst + lane * 4 + 256 * i) = o;
  }
}
__device__ __forceinline__ void modulate_row(const float (&x)[16], const float* shift, const float* scale, int lane, float (&h)[16]) {
  float mean, rstd;
  row_stats(x, mean, rstd);
  float sh[16], sc[16];
  load_row(shift, lane, sh);
  load_row(scale, lane, sc);
#pragma unroll
  for (int i = 0; i < 16; ++i) h[i] = (x[i] - mean) * rstd * (1.f + sc[i]) + sh[i];
}

__device__ void phase_rowpass0(const Params& p) {
  const int lane = threadIdx.x & 63, w = threadIdx.x >> 6;
  for (int tok = blockIdx.x * 4 + w; tok < TALL; tok += gridDim.x * 4) {
    const float* src = tok < TLAT ? p.x + (size_t)tok * D : p.ctx + (size_t)(tok - TLAT) * D;
    const float* md = p.mod + (size_t)tok_modrow(tok) * NMOD;
    float x[16], h[16];
    load_row(src, lane, x);
    modulate_row(x, md, md + 1024, lane, h);
    store_row_bf(p.h + (size_t)tok * D, lane, h);
  }
}

__device__ void phase_rowpass1(const Params& p, int layer, char* smem) {
  float* sH = (float*)smem;
  float* sLe = sH + 8 * 1024;
  float* sLg = sLe + 8 * 32;
  const int tid = threadIdx.x, lane = tid & 63, w = tid >> 6;
  const int ntok = layer == 0 ? TALL : TLAT;
  const float* lg = p.ln1_g + layer * D;
  const float* lb = p.ln1_b + layer * D;
  const float* wre = p.w_re + (size_t)layer * 1024 * 32;
  const float* wrg = p.w_rg + (size_t)layer * 1024 * 4;
  for (int g0 = blockIdx.x * 8; g0 < ntok; g0 += gridDim.x * 8) {
    __syncthreads();
#pragma unroll 1
    for (int rr = 0; rr < 2; ++rr) {
      int tok = g0 + w * 2 + rr;
      float v[16], x1[16], h2[16], gg[16], bb[16];
      load_row(p.xres + (size_t)tok * D, lane, v);
      float mean, rstd;
      row_stats(v, mean, rstd);
      load_row(lg, lane, gg);
      load_row(lb, lane, bb);
#pragma unroll
      for (int i = 0; i < 16; ++i) x1[i] = (v[i] - mean) * rstd * gg[i] + bb[i];
      store_row(p.xres + (size_t)tok * D, lane, x1);
      const float* md = p.mod + ((size_t)layer * 5 + tok_modrow(tok)) * NMOD;
      modulate_row(x1, md + 3072, md + 4096, lane, h2);
      store_row_bf(p.h2 + (size_t)tok * D, lane, h2);
      store_row(sH + (w * 2 + rr) * 1024, lane, h2);
    }
    __syncthreads();
    {
      int row = tid >> 5, e = tid & 31;
      const float* hr = sH + row * 1024;
      float ae = 0.f, ag = 0.f;
#pragma unroll 8
      for (int k = 0; k < 1024; ++k) {
        float hv = hr[k];
        ae += hv * wre[k * 32 + e];
        ag += hv * wrg[k * 4 + (e & 3)];
      }
      sLe[row * 32 + e] = ae + p.b_re[layer * 32 + e];
      if (e < 4) sLg[row * 4 + e] = ag + p.b_rg[layer * 4 + e];
    }
    __syncthreads();
    if (tid < 8) {
      int tok = g0 + tid;
      float g[4];
#pragma unroll
      for (int i = 0; i < 4; ++i) g[i] = sLg[tid * 4 + i];
      int grp = 0;
      float gm = g[0];
#pragma unroll
      for (int i = 1; i < 4; ++i) if (g[i] > gm) { gm = g[i]; grp = i; }
      float gs = 0.f;
#pragma unroll
      for (int i = 0; i < 4; ++i) gs += __expf(g[i] - gm);
      float pg = 1.f / gs;
      float sv[8];
#pragma unroll
      for (int i = 0; i < 8; ++i) sv[i] = sLe[tid * 32 + grp * 8 + i];
      int i0 = 0;
      float v0 = sv[0];
#pragma unroll
      for (int i = 1; i < 8; ++i) if (sv[i] > v0) { v0 = sv[i]; i0 = i; }
      int i1 = -1;
      float v1 = -3.0e38f;
#pragma unroll
      for (int i = 0; i < 8; ++i) if (i != i0 && sv[i] > v1) { v1 = sv[i]; i1 = i; }
      float e1 = __expf(v1 - v0);
      float w0 = pg / (1.f + e1), w1 = pg * e1 / (1.f + e1);
      int ex0 = grp * 8 + i0, ex1 = grp * 8 + i1;
      int p0 = atomicAdd(&p.cnt[ex0], 1);
      int p1 = atomicAdd(&p.cnt[ex1], 1);
      p.list[ex0 * MOE_CAP + p0] = tok;
      p.list[ex1 * MOE_CAP + p1] = tok;
      p.tok_e[tok * 2] = ex0; p.tok_e[tok * 2 + 1] = ex1;
      p.tok_pos[tok * 2] = p0; p.tok_pos[tok * 2 + 1] = p1;
      p.tok_gate[tok * 2] = w0; p.tok_gate[tok * 2 + 1] = w1;
    }
  }
}

__device__ void phase_rowpass2(const Params& p, int layer) {
  const int lane = threadIdx.x & 63, w = threadIdx.x >> 6;
  const bool last = layer == 1;
  const int ntok = last ? TLAT : TALL;
  const float* lg = p.ln2_g + layer * D;
  const float* lb = p.ln2_b + layer * D;
  for (int tok = blockIdx.x * 4 + w; tok < ntok; tok += gridDim.x * 4) {
    float x1[16], g2[16], v[16], x2[16], gg[16], bb[16];
    load_row(p.xres + (size_t)tok * D, lane, x1);
    const float* md = p.mod + ((size_t)layer * 5 + tok_modrow(tok)) * NMOD;
    load_row(md + 5120, lane, g2);
    int e0 = p.tok_e[tok * 2], e1 = p.tok_e[tok * 2 + 1];
    int s0 = p.estart[e0] * 128 + p.tok_pos[tok * 2], s1 = p.estart[e1] * 128 + p.tok_pos[tok * 2 + 1];
    float w0 = p.tok_gate[tok * 2], w1 = p.tok_gate[tok * 2 + 1];
    const bf16_t* y0 = p.ysl + (size_t)s0 * D;
    const bf16_t* y1 = p.ysl + (size_t)s1 * D;
#pragma unroll
    for (int i = 0; i < 4; ++i) {
      uint2 a = *(const uint2*)(y0 + lane * 4 + 256 * i);
      uint2 b = *(const uint2*)(y1 + lane * 4 + 256 * i);
      float ya[4] = {bf2f(a.x & 0xffff), bf2f(a.x >> 16), bf2f(a.y & 0xffff), bf2f(a.y >> 16)};
      float yb[4] = {bf2f(b.x & 0xffff), bf2f(b.x >> 16), bf2f(b.y & 0xffff), bf2f(b.y >> 16)};
#pragma unroll
      for (int e = 0; e < 4; ++e) v[4 * i + e] = ALPHA * x1[4 * i + e] + g2[4 * i + e] * (w0 * ya[e] + w1 * yb[e]);
    }
    float mean, rstd;
    row_stats(v, mean, rstd);
    load_row(lg, lane, gg);
    load_row(lb, lane, bb);
#pragma unroll
    for (int i = 0; i < 16; ++i) x2[i] = (v[i] - mean) * rstd * gg[i] + bb[i];
    if (last) {
      store_row(p.out + (size_t)tok * D, lane, x2);
    } else {
      store_row(p.xres + (size_t)tok * D, lane, x2);
      const float* mdn = p.mod + ((size_t)(layer + 1) * 5 + tok_modrow(tok)) * NMOD;
      float h[16];
      modulate_row(x2, mdn, mdn + 1024, lane, h);
      store_row_bf(p.h + (size_t)tok * D, lane, h);
    }
  }
}

struct Ptr4 { const bf16_t* p[4]; };

template <int NJ>
__device__ __forceinline__ void gemm_mainloop(const Ptr4& ap, const Ptr4& bp, int nk, f32x16 (&acc)[2][NJ], char* smem) {
  const int tid = threadIdx.x, lane = tid & 63, w = tid >> 6, wr = w >> 1, wc = w & 1, r = lane & 31, hh = lane >> 5;
  const int lrow = tid >> 3, lch = tid & 7;
  const int wofs = lrow * 128 + ((lch ^ (lrow & 7)) << 4);
  char* sA = smem;
  char* sB = smem + 32768;
  uint4 ra[4], rb[2 * NJ];
#pragma unroll
  for (int i = 0; i < 4; ++i) ra[i] = *(const uint4*)(ap.p[i]);
#pragma unroll
  for (int i = 0; i < 2 * NJ; ++i) rb[i] = *(const uint4*)(bp.p[i]);
#pragma unroll
  for (int i = 0; i < 4; ++i) *(uint4*)(sA + wofs + i * 4096) = ra[i];
#pragma unroll
  for (int i = 0; i < 2 * NJ; ++i) *(uint4*)(sB + wofs + i * 4096) = rb[i];
  __syncthreads();
  for (int kt = 0; kt < nk; ++kt) {
    const int cur = kt & 1;
    if (kt + 1 < nk) {
#pragma unroll
      for (int i = 0; i < 4; ++i) ra[i] = *(const uint4*)(ap.p[i] + (kt + 1) * 64);
#pragma unroll
      for (int i = 0; i < 2 * NJ; ++i) rb[i] = *(const uint4*)(bp.p[i] + (kt + 1) * 64);
    }
    const char* cA = sA + cur * 16384 + (wr * 64 + r) * 128;
    const char* cB = sB + cur * 16384 + (wc * 32 * NJ + r) * 128;
#pragma unroll
    for (int s = 0; s < 4; ++s) {
      const int co = ((2 * s + hh) ^ (r & 7)) << 4;
      bf16x8 a0 = *(const bf16x8*)(cA + co);
      bf16x8 a1 = *(const bf16x8*)(cA + 4096 + co);
      bf16x8 b[NJ];
#pragma unroll
      for (int j = 0; j < NJ; ++j) b[j] = *(const bf16x8*)(cB + j * 4096 + co);
#pragma unroll
      for (int j = 0; j < NJ; ++j) {
        acc[0][j] = mfma32(a0, b[j], acc[0][j]);
        acc[1][j] = mfma32(a1, b[j], acc[1][j]);
      }
    }
    if (kt + 1 < nk) {
      char* dA = sA + (cur ^ 1) * 16384 + wofs;
      char* dB = sB + (cur ^ 1) * 16384 + wofs;
#pragma unroll
      for (int i = 0; i < 4; ++i) *(uint4*)(dA + i * 4096) = ra[i];
#pragma unroll
      for (int i = 0; i < 2 * NJ; ++i) *(uint4*)(dB + i * 4096) = rb[i];
    }
    __syncthreads();
  }
}
__device__ __forceinline__ Ptr4 rows_contig(const bf16_t* base, int ld) {
  Ptr4 q;
  const int lrow = threadIdx.x >> 3, lch = threadIdx.x & 7;
#pragma unroll
  for (int i = 0; i < 4; ++i) q.p[i] = base + (size_t)(lrow + 32 * i) * ld + lch * 8;
  return q;
}
__device__ __forceinline__ void acc_to_lds(const f32x16 (&acc)[2][2], float* sC) {
  const int lane = threadIdx.x & 63, w = threadIdx.x >> 6, wr = w >> 1, wc = w & 1, r = lane & 31, hh = lane >> 5;
#pragma unroll
  for (int i = 0; i < 2; ++i)
#pragma unroll
    for (int j = 0; j < 2; ++j)
#pragma unroll
      for (int g = 0; g < 16; ++g) {
        int row = wr * 64 + i * 32 + (g & 3) + 8 * (g >> 2) + 4 * hh, col = wc * 64 + j * 32 + r;
        sC[row * LDC + col] = acc[i][j][g];
      }
}
__device__ __forceinline__ void acc_to_lds_T(const f32x16 (&acc)[2][2], float* sC) {
  const int lane = threadIdx.x & 63, w = threadIdx.x >> 6, wr = w >> 1, wc = w & 1, r = lane & 31, hh = lane >> 5;
#pragma unroll
  for (int i = 0; i < 2; ++i)
#pragma unroll
    for (int j = 0; j < 2; ++j)
#pragma unroll
      for (int g4 = 0; g4 < 4; ++g4) {
        int row = wr * 64 + i * 32 + 8 * g4 + 4 * hh, col = wc * 64 + j * 32 + r;
        *(float4*)(sC + col * LDC + row) = make_float4(acc[i][j][4 * g4], acc[i][j][4 * g4 + 1], acc[i][j][4 * g4 + 2], acc[i][j][4 * g4 + 3]);
      }
}
__device__ __forceinline__ void lds_read8(const float* s, float (&v)[8]) {
  float4 a = *(const float4*)s, b = *(const float4*)(s + 4);
  v[0] = a.x; v[1] = a.y; v[2] = a.z; v[3] = a.w; v[4] = b.x; v[5] = b.y; v[6] = b.z; v[7] = b.w;
}
__device__ __forceinline__ uint4 pack8(const float (&v)[8]) {
  return make_uint4(pack2(v[0], v[1]), pack2(v[2], v[3]), pack2(v[4], v[5]), pack2(v[6], v[7]));
}

__device__ void phase_inproj(const Params& p, int layer, char* smem) {
  float* sC = (float*)smem;
  const int tid = threadIdx.x;
  const int nitems = 136 * NT_IN;
  const float* bias = p.b_in + layer * NIN_SRC;
  for (int item = blockIdx.x; item < nitems; item += gridDim.x) {
    const int mt = item / NT_IN, nt = item % NT_IN;
    f32x16 acc[2][2];
#pragma unroll
    for (int i = 0; i < 2; ++i)
#pragma unroll
      for (int j = 0; j < 2; ++j) acc[i][j] = zero16();
    Ptr4 ap = rows_contig(p.h + (size_t)mt * 128 * D, D);
    Ptr4 bp = rows_contig(p.wt_in + (size_t)nt * 128 * D, D);
    gemm_mainloop<2>(ap, bp, 16, acc, smem);
    const bool transposed = (nt == 5) || (nt >= 10 && nt <= 13) || (nt >= 26 && nt <= 29);
    if (transposed) acc_to_lds_T(acc, sC); else acc_to_lds(acc, sC);
    __syncthreads();
    const int tok0 = mt * 128;
    const bool lat = tok0 < TLAT;
    int b, pos0, pall0;
    if (lat) { b = tok0 >> 12; pos0 = tok0 & 4095; pall0 = 256 + pos0; }
    else { int ci = tok0 - TLAT; b = ci >> 8; pos0 = ci & 255; pall0 = pos0; }
    const int n0 = nt * 128;
    const int srcc0 = (nt < 18) ? n0 : (nt < 30 ? n0 + 32 : 2304);
    if (transposed) {
#pragma unroll 1
      for (int ps = 0; ps < 8; ++ps) {
        int col = ps * 16 + (tid >> 4), tc = tid & 15;
        float v[8];
        lds_read8(sC + col * LDC + tc * 8, v);
        float bv = bias[srcc0 + col];
#pragma unroll
        for (int e = 0; e < 8; ++e) v[e] += bv;
        bf16_t* dst;
        if (nt == 5) dst = p.vAT + ((size_t)(b * 2 + (col >> 6)) * 64 + (col & 63)) * PALL;
        else if (nt <= 13) dst = p.vBT + ((size_t)(b * 4 + (nt - 10)) * 128 + col) * PALL;
        else dst = p.vCT + ((size_t)(b * 8 + (nt - 26) * 2 + (col >> 6)) * 64 + (col & 63)) * PALL;
        *(uint4*)(dst + pall0 + tc * 8) = pack8(v);
      }
    } else if (nt <= 4) {
      const float* gn = (nt < 4 ? p.q_norm : p.k_norm) + layer * 64;
      const float osc = nt < 4 ? QSCALE : 1.f;
#pragma unroll 1
      for (int ps = 0; ps < 8; ++ps) {
        int row = ps * 16 + (tid >> 4), c8 = tid & 15;
        float v[8], pv[8];
        lds_read8(sC + row * LDC + c8 * 8, v);
        lds_read8(sC + row * LDC + ((c8 * 8) ^ 16), pv);
        float ss = 0.f;
#pragma unroll
        for (int e = 0; e < 8; ++e) {
          v[e] += bias[srcc0 + c8 * 8 + e];
          pv[e] += bias[srcc0 + ((c8 * 8) ^ 16) + e];
          ss += v[e] * v[e];
        }
        ss += __shfl_xor(ss, 1);
        ss += __shfl_xor(ss, 2);
        ss += __shfl_xor(ss, 4);
        float rstd = rsqrtf(ss * (1.f / 64.f) + 1e-6f);
        const int d0 = (c8 & 7) * 8;
        float o[8];
#pragma unroll
        for (int e = 0; e < 8; ++e) {
          float xn = v[e] * rstd * gn[d0 + e];
          float pn = pv[e] * rstd * gn[(d0 ^ 16) + e];
          if (lat) {
            int t = pos0 + row;
            int qd = d0 >> 4;
            int pp = (qd < 2) ? (t >> 6) : (t & 63);
            int f = (d0 & 15) + e;
            float cs = p.rope[pp * 16 + f], sn = p.rope[1024 + pp * 16 + f];
            o[e] = (xn * cs + ((qd & 1) ? pn : -pn) * sn) * osc;
          } else {
            o[e] = xn * osc;
          }
        }
        bf16_t* dst;
        if (nt < 4) dst = p.qA + (size_t)(tok0 + row) * 512 + nt * 128 + c8 * 8;
        else dst = p.kA + ((size_t)(b * 2 + (c8 >> 3)) * PALL + pall0 + row) * 64 + d0;
        *(uint4*)dst = pack8(o);
      }
    } else if (nt == 30) {
      for (int i = tid; i < 128 * 32; i += 256) {
        int row = i >> 5, col = i & 31;
        p.aB[(size_t)(tok0 + row) * 32 + col] = sC[row * LDC + col] + bias[2304 + col];
      }
    } else {
      bf16_t* base;
      int ld, cofs;
      float osc = 1.f;
      if (nt <= 7) { base = p.qB; ld = 256; cofs = (nt - 6) * 128; osc = 0.125f; }
      else if (nt <= 9) { base = p.kB; ld = 256; cofs = (nt - 8) * 128; }
      else if (nt <= 17) { base = p.rB; ld = 512; cofs = (nt - 14) * 128; }
      else if (nt <= 21) { base = p.qC; ld = 512; cofs = (nt - 18) * 128; osc = QSCALE; }
      else { base = p.kC; ld = 512; cofs = (nt - 22) * 128; }
#pragma unroll 1
      for (int ps = 0; ps < 8; ++ps) {
        int row = ps * 16 + (tid >> 4), c8 = tid & 15;
        float v[8];
        lds_read8(sC + row * LDC + c8 * 8, v);
#pragma unroll
        for (int e = 0; e < 8; ++e) v[e] = (v[e] + bias[srcc0 + c8 * 8 + e]) * osc;
        *(uint4*)(base + (size_t)(tok0 + row) * ld + cofs + c8 * 8) = pack8(v);
      }
    }
    __syncthreads();
  }
}

__device__ void phase_merge(const Params& p, int layer, char* smem) {
  float* sC = (float*)smem;
  const int tid = threadIdx.x, lane = tid & 63, w = tid >> 6, wr = w >> 1, wc = w & 1, r = lane & 31, hh = lane >> 5;
  const int nmt = layer == 0 ? 136 : 128;
  const float* bias = p.b_in + layer * NIN_SRC + 3872;
  if (blockIdx.x == 0 && tid < 32) p.cnt[tid] = 0;
  for (int item = blockIdx.x; item < nmt * 16; item += gridDim.x) {
    const int mt = item >> 4, nt = item & 15;
    f32x16 tot[2][1];
    tot[0][0] = zero16();
    tot[1][0] = zero16();
#pragma unroll 1
    for (int br = 0; br < 3; ++br) {
      f32x16 acc[2][1];
      acc[0][0] = zero16();
      acc[1][0] = zero16();
      gemm_mainloop<1>(rows_contig(p.h + (size_t)mt * 128 * D, D), rows_contig(p.wt_gate + (size_t)(br * 1024 + nt * 64) * D, D), 16, acc, smem);
      unsigned sg[2][8];
      {
        float bv = bias[br * 1024 + nt * 64 + wc * 32 + r];
#pragma unroll
        for (int i = 0; i < 2; ++i)
#pragma unroll
          for (int g = 0; g < 8; ++g)
            sg[i][g] = pack2(sigmoidf_(acc[i][0][2 * g] + bv), sigmoidf_(acc[i][0][2 * g + 1] + bv));
      }
      acc[0][0] = zero16();
      acc[1][0] = zero16();
      const bf16_t* ob = (br == 0 ? p.oA : (br == 1 ? p.oB : p.oC));
      gemm_mainloop<1>(rows_contig(ob + (size_t)mt * 128 * 512, 512), rows_contig(p.wt_br + ((size_t)br * 1024 + nt * 64) * 512, 512), 8, acc, smem);
#pragma unroll
      for (int i = 0; i < 2; ++i)
#pragma unroll
        for (int g = 0; g < 8; ++g) {
          tot[i][0][2 * g] += bf2f((bf16_t)(sg[i][g] & 0xffff)) * acc[i][0][2 * g];
          tot[i][0][2 * g + 1] += bf2f((bf16_t)(sg[i][g] >> 16)) * acc[i][0][2 * g + 1];
        }
    }
#pragma unroll
    for (int i = 0; i < 2; ++i)
#pragma unroll
      for (int g = 0; g < 16; ++g) {
        int row = wr * 64 + i * 32 + (g & 3) + 8 * (g >> 2) + 4 * hh, col = wc * 32 + r;
        sC[row * LDC + col] = tot[i][0][g];
      }
    __syncthreads();
#pragma unroll 1
    for (int ps = 0; ps < 4; ++ps) {
      int row = ps * 32 + (tid >> 3), c8 = tid & 7;
      float v[8];
      lds_read8(sC + row * LDC + c8 * 8, v);
      *(uint4*)(p.m + (size_t)(mt * 128 + row) * D + nt * 64 + c8 * 8) = pack8(v);
    }
    __syncthreads();
  }
}

__device__ void phase_outproj(const Params& p, int layer, char* smem) {
  const int tid = threadIdx.x, lane = tid & 63, w = tid >> 6, wr = w >> 1, wc = w & 1, r = lane & 31, hh = lane >> 5;
  const int nmt = layer == 0 ? 136 : 128;
  for (int item = blockIdx.x; item < nmt * 8; item += gridDim.x) {
    const int mt = item >> 3, nt = item & 7;
    f32x16 acc[2][2];
#pragma unroll
    for (int i = 0; i < 2; ++i)
#pragma unroll
      for (int j = 0; j < 2; ++j) acc[i][j] = zero16();
    gemm_mainloop<2>(rows_contig(p.m + (size_t)mt * 128 * D, D), rows_contig(p.wt_out + (size_t)nt * 128 * D, D), 16, acc, smem);
    const int tok0 = mt * 128;
    const float* g1 = p.mod + ((size_t)layer * 5 + tok_modrow(tok0)) * NMOD + 2048;
#pragma unroll
    for (int j = 0; j < 2; ++j) {
      int col = nt * 128 + wc * 64 + j * 32 + r;
      float gv = g1[col];
#pragma unroll
      for (int i = 0; i < 2; ++i)
#pragma unroll
        for (int g = 0; g < 16; ++g) {
          int tok = tok0 + wr * 64 + i * 32 + (g & 3) + 8 * (g >> 2) + 4 * hh;
          float xv;
          if (layer == 0) xv = tok < TLAT ? p.x[(size_t)tok * D + col] : p.ctx[(size_t)(tok - TLAT) * D + col];
          else xv = p.xres[(size_t)tok * D + col];
          p.xres[(size_t)tok * D + col] = ALPHA * xv + gv * acc[i][j][g];
        }
    }
  }
}

__device__ __forceinline__ bool moe_block_lookup(const Params& p, int mb, int& e, int& lb, int& cnt_e) {
  int start = 0;
  for (int i = 0; i < 32; ++i) {
    int c = p.cnt[i];
    int nb = (c + 127) >> 7;
    if (mb < start + nb) { e = i; lb = mb - start; cnt_e = c; return true; }
    start += nb;
  }
  return false;
}
__device__ void phase_moe1(const Params& p, int layer, char* smem) {
  float* sC = (float*)smem;
  const int tid = threadIdx.x;
  if (blockIdx.x == 0 && tid == 0) {
    int start = 0;
    for (int i = 0; i < 32; ++i) { p.estart[i] = start; start += (p.cnt[i] + 127) >> 7; }
  }
  for (int item = blockIdx.x; item < MAX_MBLK * 8; item += gridDim.x) {
    const int mb = item >> 3, nt = item & 7;
    int e, lb, ce;
    if (!moe_block_lookup(p, mb, e, lb, ce)) continue;
    Ptr4 ap;
    {
      const int lrow = tid >> 3, lch = tid & 7;
#pragma unroll
      for (int i = 0; i < 4; ++i) {
        int sl = lb * 128 + lrow + 32 * i;
        int tok = sl < ce ? p.list[e * MOE_CAP + sl] : 0;
        ap.p[i] = p.h2 + (size_t)tok * D + lch * 8;
      }
    }
    f32x16 acc[2][2];
#pragma unroll
    for (int i = 0; i < 2; ++i)
#pragma unroll
      for (int j = 0; j < 2; ++j) acc[i][j] = zero16();
    gemm_mainloop<2>(ap, rows_contig(p.wt_13 + ((size_t)e * 1024 + nt * 128) * D, D), 16, acc, smem);
    acc_to_lds(acc, sC);
    __syncthreads();
#pragma unroll 1
    for (int ps = 0; ps < 8; ++ps) {
      int row = ps * 16 + (tid >> 4), c4 = (tid & 15) * 4;
      float4 a = *(const float4*)(sC + row * LDC + c4);
      float4 b = *(const float4*)(sC + row * LDC + 64 + c4);
      uint2 o = make_uint2(pack2(siluf(a.x) * b.x, siluf(a.y) * b.y), pack2(siluf(a.z) * b.z, siluf(a.w) * b.w));
      *(uint2*)(p.act + (size_t)(mb * 128 + row) * 512 + nt * 64 + c4) = o;
    }
    __syncthreads();
  }
}
__device__ void phase_moe2(const Params& p, int layer, char* smem) {
  float* sC = (float*)smem;
  const int tid = threadIdx.x;
  for (int item = blockIdx.x; item < MAX_MBLK * 8; item += gridDim.x) {
    const int mb = item >> 3, nt = item & 7;
    int e, lb, ce;
    if (!moe_block_lookup(p, mb, e, lb, ce)) continue;
    f32x16 acc[2][2];
#pragma unroll
    for (int i = 0; i < 2; ++i)
#pragma unroll
      for (int j = 0; j < 2; ++j) acc[i][j] = zero16();
    gemm_mainloop<2>(rows_contig(p.act + (size_t)mb * 128 * 512, 512), rows_contig(p.wt_2 + ((size_t)e * 1024 + nt * 128) * 512, 512), 8, acc, smem);
    acc_to_lds(acc, sC);
    __syncthreads();
#pragma unroll 1
    for (int ps = 0; ps < 8; ++ps) {
      int row = ps * 16 + (tid >> 4), c8 = tid & 15;
      float v[8];
      lds_read8(sC + row * LDC + c8 * 8, v);
      *(uint4*)(p.ysl + (size_t)(mb * 128 + row) * D + nt * 128 + c8 * 8) = pack8(v);
    }
    __syncthreads();
  }
}

template <class MaskF>
__device__ __forceinline__ void attn_tile(const char* sK, const char* sV, const bf16x8 (&bq)[4], f32x16 (&O)[2], float& m, float& l,
                                          int r, int hh, MaskF maskf) {
  f32x16 S[2];
  S[0] = zero16();
  S[1] = zero16();
  const char* kp = sK + r * 128;
#pragma unroll
  for (int s = 0; s < 4; ++s) {
    const int co = ((2 * s + hh) ^ (r & 7)) << 4;
    bf16x8 a0 = *(const bf16x8*)(kp + co);
    bf16x8 a1 = *(const bf16x8*)(kp + 4096 + co);
    S[0] = mfma32(a0, bq[s], S[0]);
    S[1] = mfma32(a1, bq[s], S[1]);
  }
  maskf(S);
  float mx = S[0][0];
#pragma unroll
  for (int g = 1; g < 16; ++g) mx = fmaxf(mx, S[0][g]);
#pragma unroll
  for (int g = 0; g < 16; ++g) mx = fmaxf(mx, S[1][g]);
  mx = fmaxf(mx, __shfl_xor(mx, 32));
  const float mn = fmaxf(m, mx);
  const float alpha = __builtin_amdgcn_exp2f(m - mn);
  m = mn;
  float ls = 0.f;
#pragma unroll
  for (int kb = 0; kb < 2; ++kb)
#pragma unroll
    for (int g = 0; g < 16; ++g) {
      float pv = __builtin_amdgcn_exp2f(S[kb][g] - mn);
      S[kb][g] = pv;
      ls += pv;
    }
  l = l * alpha + ls;
#pragma unroll
  for (int g = 0; g < 16; ++g) { O[0][g] *= alpha; O[1][g] *= alpha; }
  const char* vp = sV + r * 136 + hh * 8;
#pragma unroll
  for (int sp = 0; sp < 4; ++sp) {
    bf16x8 bp;
#pragma unroll
    for (int j = 0; j < 8; ++j) bp[j] = (short)f2bf(S[sp >> 1][8 * (sp & 1) + j]);
#pragma unroll
    for (int db = 0; db < 2; ++db) {
      bf16x4 lo = *(const bf16x4*)(vp + db * 32 * 136 + sp * 32);
      bf16x4 hi = *(const bf16x4*)(vp + db * 32 * 136 + sp * 32 + 16);
      bf16x8 av = __builtin_shufflevector(lo, hi, 0, 1, 2, 3, 4, 5, 6, 7);
      O[db] = mfma32(av, bp, O[db]);
    }
  }
}
struct NoMask { __device__ __forceinline__ void operator()(f32x16 (&)[2]) const {} };

__device__ __forceinline__ void attn_write_out(bf16_t* dst  , const f32x16 (&O)[2], float l, int hh) {
  float lt = l + __shfl_xor(l, 32);
  float inv = 1.f / lt;
#pragma unroll
  for (int db = 0; db < 2; ++db)
#pragma unroll
    for (int g4 = 0; g4 < 4; ++g4) {
      uint2 o = make_uint2(pack2(O[db][4 * g4] * inv, O[db][4 * g4 + 1] * inv), pack2(O[db][4 * g4 + 2] * inv, O[db][4 * g4 + 3] * inv));
      *(uint2*)(dst + 32 * db + 8 * g4 + 4 * hh) = o;
    }
}

__device__ void phase_attnA(const Params& p, int layer, char* smem) {
  const int tid = threadIdx.x, lane = tid & 63, w = tid >> 6, r = lane & 31, hh = lane >> 5;
  char* sK = smem;
  char* sV = smem + 16384;
  const int nitems = layer == 0 ? 1088 : 1024;
  for (int item = blockIdx.x; item < nitems; item += gridDim.x) {
    int b, kvh, qtok0, nkt;
    if (item < 1024) { b = item >> 8; kvh = (item >> 7) & 1; qtok0 = b * 4096 + (item & 127) * 32; nkt = 68; }
    else { int it = item - 1024; b = it >> 4; kvh = (it >> 3) & 1; qtok0 = TLAT + b * 256 + (it & 7) * 32; nkt = 4; }
    const int head = kvh * 4 + w;
    bf16x8 bq[4];
    {
      const bf16_t* qp = p.qA + (size_t)(qtok0 + r) * 512 + head * 64 + 8 * hh;
#pragma unroll
      for (int s = 0; s < 4; ++s) bq[s] = *(const bf16x8*)(qp + 16 * s);
    }
    const bf16_t* kbase = p.kA + (size_t)(b * 2 + kvh) * PALL * 64;
    const bf16_t* vbase = p.vAT + (size_t)(b * 2 + kvh) * 64 * PALL;
    const int krow0 = tid >> 3, kch0 = tid & 7;
    const bf16_t* kg = kbase + (size_t)krow0 * 64 + kch0 * 8;
    const bf16_t* vg = vbase + (size_t)krow0 * PALL + kch0 * 8;
    const int ksto = krow0 * 128 + ((kch0 ^ (krow0 & 7)) << 4);
    const int vsto = krow0 * 136 + kch0 * 16;
    uint4 rk0, rk1, rv0, rv1;
#define ATTN_GLOAD(kt)                                                    \
  {                                                                       \
    rk0 = *(const uint4*)(kg + (size_t)(kt) * 4096);                      \
    rk1 = *(const uint4*)(kg + (size_t)(kt) * 4096 + 2048);               \
    rv0 = *(const uint4*)(vg + (kt) * 64);                                \
    rv1 = *(const uint4*)(vg + (size_t)32 * PALL + (kt) * 64);            \
  }
#define ATTN_LSTORE(buf)                                                  \
  {                                                                       \
    *(uint4*)(sK + (buf) * 8192 + ksto) = rk0;                            \
    *(uint4*)(sK + (buf) * 8192 + 4096 + ksto) = rk1;                     \
    char* d0 = sV + (buf) * 8704 + vsto;                                  \
    *(uint2*)d0 = make_uint2(rv0.x, rv0.y);                               \
    *(uint2*)(d0 + 8) = make_uint2(rv0.z, rv0.w);                         \
    *(uint2*)(d0 + 32 * 136) = make_uint2(rv1.x, rv1.y);                  \
    *(uint2*)(d0 + 32 * 136 + 8) = make_uint2(rv1.z, rv1.w);              \
  }
    f32x16 O[2];
    O[0] = zero16();
    O[1] = zero16();
    float m = -1e30f, l = 0.f;
    __syncthreads();
    ATTN_GLOAD(0);
    ATTN_LSTORE(0);
    __syncthreads();
    for (int kt = 0; kt < nkt; ++kt) {
      const int cur = kt & 1;
      if (kt + 1 < nkt) ATTN_GLOAD(kt + 1);
      attn_tile(sK + cur * 8192, sV + cur * 8704, bq, O, m, l, r, hh, NoMask());
      if (kt + 1 < nkt) ATTN_LSTORE(cur ^ 1);
      __syncthreads();
    }
    attn_write_out(p.oA + (size_t)(qtok0 + r) * 512 + head * 64, O, l, hh);
  }
}

struct NaMask {
  const float* bias;
  int brow;
  int wq;
  int hh;
  __device__ __forceinline__ void operator()(f32x16 (&S)[2]) const {
    int cs = wq - 8;
    cs = cs < 0 ? 0 : (cs > 48 ? 48 : cs);
#pragma unroll
    for (int kb = 0; kb < 2; ++kb)
#pragma unroll
      for (int g = 0; g < 16; ++g) {
        int c = 32 * kb + (g & 3) + 8 * (g >> 2) + 4 * hh;
        bool valid = (c >= cs) && (c < cs + 16);
        int ci = c - wq + 15;
        ci = ci < 0 ? 0 : (ci > 30 ? 30 : ci);
        float bv = bias[brow * 31 + ci];
        S[kb][g] = valid ? S[kb][g] + bv : -1e30f;
      }
  }
};
__device__ void phase_na(const Params& p, int layer, char* smem) {
  const int tid = threadIdx.x, lane = tid & 63, w = tid >> 6, r = lane & 31, hh = lane >> 5;
  char* sK = smem;
  char* sV = smem + 16384;
  float* sBias = (float*)(smem + 16384 + 17408);
  const int nitems = layer == 0 ? 1088 : 1024;
  const int set = w >> 1, qhalf = w & 1;
  for (int item = blockIdx.x; item < nitems; item += gridDim.x) {
    int b, hp, row = 0, rs = 0, qtok0, kt0, kt1;
    if (item < 1024) {
      b = item >> 8; row = (item >> 2) & 63; hp = item & 3;
      rs = row - 4; rs = rs < 0 ? 0 : (rs > 56 ? 56 : rs);
      qtok0 = b * 4096 + row * 64; kt0 = 0; kt1 = 12;
    } else {
      int it = item - 1024;
      b = it >> 4; hp = (it >> 2) & 3;
      qtok0 = TLAT + b * 256 + (it & 3) * 64; kt0 = 8; kt1 = 12;
    }
    const int head = 2 * hp + set;
    __syncthreads();
    for (int i = tid; i < 930; i += 256) {
      int s = i / 465, j = i % 465;
      sBias[i] = p.rpb[((size_t)layer * 8 + 2 * hp + s) * 465 + j] * LOG2E;
    }
    bf16x8 bq[4];
    {
      const bf16_t* qp = p.qC + (size_t)(qtok0 + 32 * qhalf + r) * 512 + head * 64 + 8 * hh;
#pragma unroll
      for (int s = 0; s < 4; ++s) bq[s] = *(const bf16x8*)(qp + 16 * s);
    }
    const int krow0 = tid >> 3, kch0 = tid & 7;
    const int ksto = krow0 * 128 + ((kch0 ^ (krow0 & 7)) << 4);
    const int vsto = krow0 * 136 + kch0 * 16;
    f32x16 O[2];
    O[0] = zero16();
    O[1] = zero16();
    float m = -1e30f, l = 0.f;
    for (int kt = kt0; kt < kt1; ++kt) {
      int tokK, pallb;
      if (kt < 8) { tokK = b * 4096 + (rs + kt) * 64; pallb = 256 + (rs + kt) * 64; }
      else { tokK = TLAT + b * 256 + (kt - 8) * 64; pallb = (kt - 8) * 64; }
      __syncthreads();
#pragma unroll
      for (int s = 0; s < 2; ++s) {
        const bf16_t* kg = p.kC + (size_t)(tokK + krow0) * 512 + (2 * hp + s) * 64 + kch0 * 8;
        const bf16_t* vg = p.vCT + ((size_t)(b * 8 + 2 * hp + s) * 64 + krow0) * PALL + pallb + kch0 * 8;
        uint4 k0 = *(const uint4*)kg, k1 = *(const uint4*)(kg + 32 * 512);
        uint4 v0 = *(const uint4*)vg, v1 = *(const uint4*)(vg + (size_t)32 * PALL);
        *(uint4*)(sK + s * 8192 + ksto) = k0;
        *(uint4*)(sK + s * 8192 + 4096 + ksto) = k1;
        char* d0 = sV + s * 8704 + vsto;
        *(uint2*)d0 = make_uint2(v0.x, v0.y);
        *(uint2*)(d0 + 8) = make_uint2(v0.z, v0.w);
        *(uint2*)(d0 + 32 * 136) = make_uint2(v1.x, v1.y);
        *(uint2*)(d0 + 32 * 136 + 8) = make_uint2(v1.z, v1.w);
      }
      __syncthreads();
      if (kt < 8) {
        NaMask mk;
        mk.bias = sBias + set * 465;
        mk.brow = rs + kt - row + 7;
        mk.wq = 32 * qhalf + r;
        mk.hh = hh;
        attn_tile(sK + set * 8192, sV + set * 8704, bq, O, m, l, r, hh, mk);
      } else {
        attn_tile(sK + set * 8192, sV + set * 8704, bq, O, m, l, r, hh, NoMask());
      }
    }
    attn_write_out(p.oC + (size_t)(qtok0 + 32 * qhalf + r) * 512 + head * 64, O, l, hh);
  }
}

__device__ __forceinline__ float log_sigmoidf_(float x) { return fminf(x, 0.f) - log1pf(__expf(-fabsf(x))); }
__device__ __forceinline__ void gla_prep(const Params& p, int layer, int hd, int dir, int tok0, float* sWg, float* sBc) {
  const int tid = threadIdx.x, lane = tid & 63, w = tid >> 6;
  for (int i = tid; i < 1024; i += 256) {
    int rr = i >> 6, d = i & 63;
    sWg[i] = p.gla_wg[(((size_t)layer * 2 + dir) * 16 + rr) * 256 + hd * 64 + d];
  }
  __syncthreads();
  {
    int pos = tid >> 2, dg = tid & 3;
    float a[16];
    const float* ap = p.aB + (size_t)(tok0 + pos) * 32 + dir * 16;
#pragma unroll
    for (int i = 0; i < 4; ++i) {
      float4 t = *(const float4*)(ap + 4 * i);
      a[4 * i] = t.x; a[4 * i + 1] = t.y; a[4 * i + 2] = t.z; a[4 * i + 3] = t.w;
    }
    const float* bg = p.gla_bg + ((size_t)layer * 2 + dir) * 256 + hd * 64 + dg * 16;
#pragma unroll
    for (int dd = 0; dd < 16; ++dd) {
      float xv = bg[dd];
#pragma unroll
      for (int rr = 0; rr < 16; ++rr) xv += a[rr] * sWg[rr * 64 + dg * 16 + dd];
      sBc[pos * 65 + dg * 16 + dd] = log_sigmoidf_(xv) * (1.f / 16.f);
    }
  }
  __syncthreads();
  {
    const int idx = dir ? 63 - lane : lane;
#pragma unroll 1
    for (int dd = 0; dd < 16; ++dd) {
      int d = w * 16 + dd;
      float v = sBc[idx * 65 + d];
#pragma unroll
      for (int o = 1; o < 64; o <<= 1) {
        float t = __shfl_up(v, o);
        if (lane >= o) v += t;
      }
      sBc[idx * 65 + d] = v;
    }
  }
  __syncthreads();
}
__device__ __forceinline__ void chunk_pos(int b, int dir, int c, int& tok0, int& pall0) {
  if (c < 4) { int pc = dir ? 3 - c : c; tok0 = TLAT + b * 256 + pc * 64; pall0 = pc * 64; }
  else { int j = c - 4; int pc = dir ? 63 - j : j; tok0 = b * 4096 + pc * 64; pall0 = 256 + pc * 64; }
}
__device__ void phase_gla1(const Params& p, int layer, char* smem) {
  float* sWg = (float*)smem;
  float* sBc = (float*)(smem + 4096);
  bf16_t* sKt = (bf16_t*)(smem + 20736);
  bf16_t* sVt = (bf16_t*)(smem + 29952);
  const int tid = threadIdx.x, lane = tid & 63, w = tid >> 6, r = lane & 31, hh = lane >> 5;
  for (int item = blockIdx.x; item < 32 * NCHUNK; item += gridDim.x) {
    const int ch = item / NCHUNK, c = item % NCHUNK;
    const int dir = ch & 1, hd = (ch >> 1) & 3, b = ch >> 3;
    int tok0, pall0;
    chunk_pos(b, dir, c, tok0, pall0);
    __syncthreads();
    gla_prep(p, layer, hd, dir, tok0, sWg, sBc);
    {
      int pos = tid >> 2, dg = tid & 3;
      const bf16_t* kp = p.kB + (size_t)(tok0 + pos) * 256 + hd * 64 + dg * 16;
      uint4 k0 = *(const uint4*)kp, k1 = *(const uint4*)(kp + 8);
      unsigned ku[8] = {k0.x, k0.y, k0.z, k0.w, k1.x, k1.y, k1.z, k1.w};
#pragma unroll
      for (int e = 0; e < 16; ++e) {
        int d = dg * 16 + e;
        float kv = bf2f((bf16_t)((e & 1) ? (ku[e >> 1] >> 16) : (ku[e >> 1] & 0xffff)));
        float bend = sBc[(dir ? 0 : 63) * 65 + d];
        sKt[d * 72 + pos] = f2bf(kv * __expf(bend - sBc[pos * 65 + d]));
      }
      const bf16_t* vb = p.vBT + (size_t)(b * 4 + hd) * 128 * PALL + pall0;
#pragma unroll
      for (int i = 0; i < 4; ++i) {
        int q = tid + 256 * i, dv = q >> 3, cc = q & 7;
        *(uint4*)(sVt + dv * 72 + cc * 8) = *(const uint4*)(vb + (size_t)dv * PALL + cc * 8);
      }
      if (tid < 64) p.decay[(size_t)item * 64 + tid] = __expf(sBc[(dir ? 0 : 63) * 65 + tid]);
    }
    __syncthreads();
    f32x16 acc[2];
    acc[0] = zero16();
    acc[1] = zero16();
#pragma unroll
    for (int s = 0; s < 4; ++s) {
      bf16x8 a = *(const bf16x8*)(sVt + (32 * w + r) * 72 + 16 * s + 8 * hh);
      bf16x8 b0 = *(const bf16x8*)(sKt + r * 72 + 16 * s + 8 * hh);
      bf16x8 b1 = *(const bf16x8*)(sKt + (32 + r) * 72 + 16 * s + 8 * hh);
      acc[0] = mfma32(a, b0, acc[0]);
      acc[1] = mfma32(a, b1, acc[1]);
    }
    float* dst = p.KVt + (size_t)item * 8192;
#pragma unroll
    for (int jb = 0; jb < 2; ++jb)
#pragma unroll
      for (int g = 0; g < 16; ++g) {
        int dv = 32 * w + (g & 3) + 8 * (g >> 2) + 4 * hh;
        dst[dv * 64 + 32 * jb + r] = acc[jb][g];
      }
  }
}
__device__ void phase_gla2(const Params& p) {
  for (int idx = blockIdx.x * 256 + threadIdx.x; idx < 32 * 8192; idx += gridDim.x * 256) {
    const int ch = idx >> 13, e = idx & 8191;
    float S = 0.f;
    const float* kv = p.KVt + (size_t)ch * NCHUNK * 8192 + e;
    const float* dc = p.decay + (size_t)ch * NCHUNK * 64 + (e & 63);
    bf16_t* sp = p.SP + (size_t)ch * NCHUNK * 8192 + e;
#pragma unroll 4
    for (int c = 0; c < NCHUNK; ++c) {
      sp[(size_t)c * 8192] = f2bf(S);
      S = dc[c * 64] * S + kv[(size_t)c * 8192];
    }
  }
}
__device__ void phase_gla3(const Params& p, int layer, char* smem) {
  float* sWg = (float*)smem;
  float* sBc = (float*)(smem + 4096);
  bf16_t* sQ = (bf16_t*)(smem + 20736);
  bf16_t* sK = (bf16_t*)(smem + 29952);
  bf16_t* sVt = (bf16_t*)(smem + 39168);
  float* sRed = (float*)(smem + 57600);
  const int tid = threadIdx.x, lane = tid & 63, w = tid >> 6, r = lane & 31, hh = lane >> 5;
  const int npc = layer == 0 ? 68 : 64;
  for (int item = blockIdx.x; item < 16 * npc; item += gridDim.x) {
    const int bh = item / npc;
    const int pca = (layer == 0) ? (item % npc) : (4 + item % npc);
    const int b = bh >> 2, hd = bh & 3;
    int tok0, pall0;
    chunk_pos(b, 0, pca, tok0, pall0);
    f32x16 O[2];
    O[0] = zero16();
    O[1] = zero16();
    __syncthreads();
    {
      const bf16_t* vb = p.vBT + (size_t)(b * 4 + hd) * 128 * PALL + pall0;
#pragma unroll
      for (int i = 0; i < 4; ++i) {
        int q = tid + 256 * i, dv = q >> 3, cc = q & 7;
        *(uint4*)(sVt + dv * 72 + cc * 8) = *(const uint4*)(vb + (size_t)dv * PALL + cc * 8);
      }
    }
#pragma unroll 1
    for (int dir = 0; dir < 2; ++dir) {
      __syncthreads();
      gla_prep(p, layer, hd, dir, tok0, sWg, sBc);
      {
        int pos = tid >> 2, dg = tid & 3;
        const bf16_t* qp = p.qB + (size_t)(tok0 + pos) * 256 + hd * 64 + dg * 16;
        const bf16_t* kp = p.kB + (size_t)(tok0 + pos) * 256 + hd * 64 + dg * 16;
        uint4 q0 = *(const uint4*)qp, q1 = *(const uint4*)(qp + 8);
        uint4 k0 = *(const uint4*)kp, k1 = *(const uint4*)(kp + 8);
        unsigned qu[8] = {q0.x, q0.y, q0.z, q0.w, q1.x, q1.y, q1.z, q1.w};
        unsigned ku[8] = {k0.x, k0.y, k0.z, k0.w, k1.x, k1.y, k1.z, k1.w};
        unsigned qo[8], ko[8];
#pragma unroll
        for (int e2 = 0; e2 < 8; ++e2) {
          float b0 = sBc[pos * 65 + dg * 16 + 2 * e2], b1 = sBc[pos * 65 + dg * 16 + 2 * e2 + 1];
          float ea0 = __expf(b0), ea1 = __expf(b1);
          qo[e2] = pack2(bf2f((bf16_t)(qu[e2] & 0xffff)) * ea0, bf2f((bf16_t)(qu[e2] >> 16)) * ea1);
          ko[e2] = pack2(bf2f((bf16_t)(ku[e2] & 0xffff)) / ea0, bf2f((bf16_t)(ku[e2] >> 16)) / ea1);
        }
        *(uint4*)(sQ + pos * 72 + dg * 16) = make_uint4(qo[0], qo[1], qo[2], qo[3]);
        *(uint4*)(sQ + pos * 72 + dg * 16 + 8) = make_uint4(qo[4], qo[5], qo[6], qo[7]);
        *(uint4*)(sK + pos * 72 + dg * 16) = make_uint4(ko[0], ko[1], ko[2], ko[3]);
        *(uint4*)(sK + pos * 72 + dg * 16 + 8) = make_uint4(ko[4], ko[5], ko[6], ko[7]);
      }
      __syncthreads();
      int c;
      if (pca < 4) c = dir ? 3 - pca : pca;
      else c = dir ? 4 + (63 - (pca - 4)) : pca;
      const int ch = (b * 4 + hd) * 2 + dir;
      const bf16_t* sp = p.SP + ((size_t)ch * NCHUNK + c) * 8192 + (size_t)(32 * w + r) * 64 + 8 * hh;
      bf16x8 bqf[2][4];
#pragma unroll
      for (int tb = 0; tb < 2; ++tb)
#pragma unroll
        for (int ks = 0; ks < 4; ++ks) bqf[tb][ks] = *(const bf16x8*)(sQ + (32 * tb + r) * 72 + 16 * ks + 8 * hh);
#pragma unroll
      for (int ks = 0; ks < 4; ++ks) {
        bf16x8 a = *(const bf16x8*)(sp + 16 * ks);
        O[0] = mfma32(a, bqf[0][ks], O[0]);
        O[1] = mfma32(a, bqf[1][ks], O[1]);
      }
#pragma unroll
      for (int sb = 0; sb < 2; ++sb)
#pragma unroll
        for (int tb = 0; tb < 2; ++tb) {
          const bool skip = dir == 0 ? (sb == 1 && tb == 0) : (sb == 0 && tb == 1);
          if (skip) continue;
          f32x16 Sc = zero16();
#pragma unroll
          for (int ks = 0; ks < 4; ++ks) {
            bf16x8 a = *(const bf16x8*)(sK + (32 * sb + r) * 72 + 16 * ks + 8 * hh);
            Sc = mfma32(a, bqf[tb][ks], Sc);
          }
          const int t = 32 * tb + r;
#pragma unroll
          for (int g = 0; g < 16; ++g) {
            int s = 32 * sb + (g & 3) + 8 * (g >> 2) + 4 * hh;
            bool keep = dir == 0 ? (t >= s) : (s >= t);
            Sc[g] = keep ? Sc[g] : 0.f;
          }
#pragma unroll
          for (int s2 = 0; s2 < 2; ++s2) {
            const int sp4 = 2 * sb + s2;
            bf16x8 bp;
#pragma unroll
            for (int j = 0; j < 8; ++j) bp[j] = (short)f2bf(Sc[8 * s2 + j]);
            const char* vp = (const char*)(sVt + (32 * w + r) * 72) + (16 * sp4 + 4 * hh) * 2;
            bf16x4 lo = *(const bf16x4*)vp;
            bf16x4 hi = *(const bf16x4*)(vp + 16);
            bf16x8 av = __builtin_shufflevector(lo, hi, 0, 1, 2, 3, 4, 5, 6, 7);
            O[tb] = mfma32(av, bp, O[tb]);
          }
        }
    }
    float ss[2];
#pragma unroll
    for (int tb = 0; tb < 2; ++tb) {
      float s = 0.f;
#pragma unroll
      for (int g = 0; g < 16; ++g) s += O[tb][g] * O[tb][g];
      s += __shfl_xor(s, 32);
      ss[tb] = s;
    }
    if (hh == 0) { sRed[w * 64 + r] = ss[0]; sRed[w * 64 + 32 + r] = ss[1]; }
    __syncthreads();
#pragma unroll
    for (int tb = 0; tb < 2; ++tb) {
      int t = 32 * tb + r;
      float tot = sRed[t] + sRed[64 + t] + sRed[128 + t] + sRed[192 + t];
      float rstd = rsqrtf(tot * (1.f / 128.f) + 1e-6f);
      const int tok = tok0 + t;
#pragma unroll
      for (int g4 = 0; g4 < 4; ++g4) {
        int dv = 32 * w + 8 * g4 + 4 * hh;
        uint2 rr = *(const uint2*)(p.rB + (size_t)tok * 512 + hd * 128 + dv);
        float rg[4] = {bf2f((bf16_t)(rr.x & 0xffff)), bf2f((bf16_t)(rr.x >> 16)), bf2f((bf16_t)(rr.y & 0xffff)), bf2f((bf16_t)(rr.y >> 16))};
        float o[4];
#pragma unroll
        for (int e = 0; e < 4; ++e) o[e] = O[tb][4 * g4 + e] * rstd * p.gla_norm[layer * 128 + dv + e] * siluf(rg[e]);
        *(uint2*)(p.oB + (size_t)tok * 512 + hd * 128 + dv) = make_uint2(pack2(o[0], o[1]), pack2(o[2], o[3]));
      }
    }
  }
}

#define PHASE_KERNEL(name, call)                                               \
  __global__ void __launch_bounds__(256, 2) name(Params p, int layer) {        \
    __shared__ __attribute__((aligned(16))) char smem[SMEM_BYTES];             \
    call;                                                                      \
  }
PHASE_KERNEL(k_setup, phase_setup(p, smem))
PHASE_KERNEL(k_modreduce, phase_modreduce(p))
PHASE_KERNEL(k_convert, phase_convert(p, layer, smem))
PHASE_KERNEL(k_rowpass0, phase_rowpass0(p))
PHASE_KERNEL(k_inproj, phase_inproj(p, layer, smem))
PHASE_KERNEL(k_attnA, phase_attnA(p, layer, smem))
PHASE_KERNEL(k_na, phase_na(p, layer, smem))
PHASE_KERNEL(k_gla1, phase_gla1(p, layer, smem))
PHASE_KERNEL(k_gla2, phase_gla2(p))
PHASE_KERNEL(k_gla3, phase_gla3(p, layer, smem))
PHASE_KERNEL(k_merge, phase_merge(p, layer, smem))
PHASE_KERNEL(k_outproj, phase_outproj(p, layer, smem))
PHASE_KERNEL(k_rowpass1, phase_rowpass1(p, layer, smem))
PHASE_KERNEL(k_moe1, phase_moe1(p, layer, smem))
PHASE_KERNEL(k_moe2, phase_moe2(p, layer, smem))
PHASE_KERNEL(k_rowpass2, phase_rowpass2(p, layer))

static inline size_t align_up(size_t v, size_t a) { return (v + a - 1) / a * a; }

extern "C" void kernel_launch(void* const* d_in, const int* in_sizes, int n_in, void* d_out, int out_size, void* d_ws, size_t ws_size,
                              hipStream_t stream) {
  Params p{};
  const float* const* in = (const float* const*)d_in;
  p.x = in[0]; p.c = in[1]; p.ctx = in[2]; p.c_ctx = in[3]; p.w_mod = in[4]; p.b_mod = in[5]; p.w_in = in[6]; p.b_in = in[7];
  p.q_norm = in[8]; p.k_norm = in[9]; p.gla_wg = in[10]; p.gla_bg = in[11]; p.gla_norm = in[12]; p.rpb = in[13];
  p.w_br_attn = in[14]; p.w_br_gla = in[15]; p.w_br_na = in[16]; p.w_out = in[17]; p.ln1_g = in[18]; p.ln1_b = in[19];
  p.w_rg = in[20]; p.b_rg = in[21]; p.w_re = in[22]; p.b_re = in[23]; p.w1 = in[24]; p.w3 = in[25]; p.w2 = in[26];
  p.ln2_g = in[27]; p.ln2_b = in[28];
  p.out = (float*)d_out;

  char* base = (char*)d_ws;
  size_t off = 0;
  auto take = [&](size_t bytes) { char* q = base + off; off = align_up(off + bytes, 256); return q; };
  p.mod_part = (float*)take((size_t)16 * 2 * 5 * NMOD * 4);
  p.mod = (float*)take((size_t)2 * 5 * NMOD * 4);
  p.rope = (float*)take(2048 * 4);
  p.cnt = (int*)take(32 * 4);
  p.estart = (int*)take(32 * 4);
  p.list = (int*)take((size_t)32 * MOE_CAP * 4);
  p.tok_e = (int*)take((size_t)TALL * 2 * 4);
  p.tok_pos = (int*)take((size_t)TALL * 2 * 4);
  p.tok_gate = (float*)take((size_t)TALL * 2 * 4);
  p.wt_in = (bf16_t*)take((size_t)3968 * 1024 * 2);
  p.wt_gate = (bf16_t*)take((size_t)3072 * 1024 * 2);
  p.wt_br = (bf16_t*)take((size_t)3 * 1024 * 512 * 2);
  p.wt_out = (bf16_t*)take((size_t)1024 * 1024 * 2);
  p.wt_13 = (bf16_t*)take((size_t)32 * 1024 * 1024 * 2);
  p.wt_2 = (bf16_t*)take((size_t)32 * 1024 * 512 * 2);
  p.xres = (float*)take((size_t)TALL * D * 4);
  p.h = (bf16_t*)take((size_t)TALL * D * 2);
  size_t r1 = off;
  p.qA = (bf16_t*)take((size_t)TALL * 512 * 2);
  p.kA = (bf16_t*)take((size_t)4 * 2 * PALL * 64 * 2);
  p.vAT = (bf16_t*)take((size_t)4 * 2 * 64 * PALL * 2);
  p.qB = (bf16_t*)take((size_t)TALL * 256 * 2);
  p.kB = (bf16_t*)take((size_t)TALL * 256 * 2);
  p.vBT = (bf16_t*)take((size_t)4 * 4 * 128 * PALL * 2);
  p.rB = (bf16_t*)take((size_t)TALL * 512 * 2);
  p.aB = (float*)take((size_t)TALL * 32 * 4);
  p.qC = (bf16_t*)take((size_t)TALL * 512 * 2);
  p.kC = (bf16_t*)take((size_t)TALL * 512 * 2);
  p.vCT = (bf16_t*)take((size_t)4 * 8 * 64 * PALL * 2);
  p.oA = (bf16_t*)take((size_t)TALL * 512 * 2);
  p.oB = (bf16_t*)take((size_t)TALL * 512 * 2);
  p.oC = (bf16_t*)take((size_t)TALL * 512 * 2);
  size_t r1_end = off;
  {
    size_t o2 = r1;
    p.act = (bf16_t*)(base + o2); o2 = align_up(o2 + (size_t)MAX_MBLK * 128 * 512 * 2, 256);
    p.ysl = (bf16_t*)(base + o2); o2 = align_up(o2 + (size_t)MAX_MBLK * 128 * 1024 * 2, 256);
    if (o2 > r1_end) off = o2;
  }
  p.KVt = (float*)take((size_t)32 * NCHUNK * 8192 * 4);
  p.SP = (bf16_t*)take((size_t)32 * NCHUNK * 8192 * 2);
  p.decay = (float*)take((size_t)32 * NCHUNK * 64 * 4);
  p.m = (bf16_t*)p.KVt;
  p.h2 = p.SP;
  if (off > ws_size) {
    fprintf(stderr, "workspace too small: need %zu have %zu\n", off, ws_size);
    return;
  }
  const dim3 blk(256);
  const int G = 1024;
  k_setup<<<769, blk, 0, stream>>>(p, 0);
  k_modreduce<<<240, blk, 0, stream>>>(p, 0);
  k_rowpass0<<<G, blk, 0, stream>>>(p, 0);
  for (int l = 0; l < 2; ++l) {
    k_convert<<<2048, blk, 0, stream>>>(p, l);
    k_inproj<<<G, blk, 0, stream>>>(p, l);
    k_attnA<<<1088, blk, 0, stream>>>(p, l);
    k_na<<<1088, blk, 0, stream>>>(p, l);
    k_gla1<<<G, blk, 0, stream>>>(p, l);
    k_gla2<<<G, blk, 0, stream>>>(p, l);
    k_gla3<<<1088, blk, 0, stream>>>(p, l);
    k_merge<<<G, blk, 0, stream>>>(p, l);
    k_outproj<<<G, blk, 0, stream>>>(p, l);
    k_rowpass1<<<G, blk, 0, stream>>>(p, l);
    k_moe1<<<G, blk, 0, stream>>>(p, l);
    k_moe2<<<G, blk, 0, stream>>>(p, l);
    k_rowpass2<<<G, blk, 0, stream>>>(p, l);
  }
}
```

```cpp
#include <hip/hip_runtime.h>
#include <hip/hip_cooperative_groups.h>
#include <stdint.h>
#include <stdio.h>
namespace cg = cooperative_groups;

typedef unsigned short bf16_t;
typedef __attribute__((ext_vector_type(8))) short bf16x8;
typedef __attribute__((ext_vector_type(4))) short bf16x4;
typedef __attribute__((ext_vector_type(16))) float f32x16;

constexpr int D = 1024;
constexpr int TLAT = 16384, TCTX = 1024, TALL = 17408, PALL = 4352;
constexpr int NIN_SRC = 6944, NMOD = 6144;
constexpr int NT_IN = 31;
constexpr int SMEM_BYTES = 69632;
constexpr int LDC = 132;
constexpr float LOG2E = 1.4426950408889634f;
constexpr float QSCALE = 0.125f * LOG2E;
constexpr float ALPHA = 1.4142135623730951f;
constexpr int NCHUNK = 68;
constexpr int MOE_CAP = TALL;
constexpr int MAX_MBLK = 304;

struct Params {
  const float *x, *c, *ctx, *c_ctx, *w_mod, *b_mod, *w_in, *b_in, *q_norm, *k_norm, *gla_wg, *gla_bg, *gla_norm, *rpb,
      *w_br_attn, *w_br_gla, *w_br_na, *w_out, *ln1_g, *ln1_b, *w_rg, *b_rg, *w_re, *b_re, *w1, *w3, *w2, *ln2_g, *ln2_b;
  float* out;
  float *mod_part, *mod, *rope;
  bf16_t *wt_in, *wt_gate, *wt_br, *wt_out, *wt_13, *wt_2;
  float* xres;
  bf16_t *h, *h2;
  bf16_t *qA, *kA, *vAT, *qB, *kB, *vBT, *rB;
  float* aB;
  bf16_t *qC, *kC, *vCT;
  bf16_t *oA, *oB, *oC;
  float* KVt;
  bf16_t* SP;
  float* decay;
  bf16_t* m;
  bf16_t *act, *ysl;
  int *cnt, *list, *tok_e, *tok_pos, *estart;
  float* tok_gate;
};


__device__ __forceinline__ int tid_() { int t = __builtin_amdgcn_workitem_id_x(); asm volatile("" : "+v"(t)); return t; }
__device__ __forceinline__ int bid_() { int t = __builtin_amdgcn_workgroup_id_x(); asm volatile("" : "+s"(t)); return t; }
__device__ __forceinline__ bf16_t f2bf(float f) {
  unsigned u = __float_as_uint(f);
  u += 0x7fffu + ((u >> 16) & 1u);
  return (bf16_t)(u >> 16);
}
__device__ __forceinline__ float bf2f(bf16_t b) { return __uint_as_float(((unsigned)b) << 16); }
__device__ __forceinline__ unsigned pack2(float a, float b) { return (unsigned)f2bf(a) | ((unsigned)f2bf(b) << 16); }
__device__ __forceinline__ float wave_sum(float v) {
#pragma unroll
  for (int o = 32; o > 0; o >>= 1) v += __shfl_xor(v, o);
  return v;
}
__device__ __forceinline__ float siluf(float x) { return x / (1.f + __expf(-x)); }
__device__ __forceinline__ float sigmoidf_(float x) { return 1.f / (1.f + __expf(-x)); }
__device__ __forceinline__ f32x16 zero16() {
  f32x16 z;
#pragma unroll
  for (int i = 0; i < 16; ++i) z[i] = 0.f;
  return z;
}
__device__ __forceinline__ f32x16 mfma32(bf16x8 a, bf16x8 b, f32x16 c) {
  return __builtin_amdgcn_mfma_f32_32x32x16_bf16(a, b, c, 0, 0, 0);
}
__device__ __forceinline__ int tok_modrow(int tok) { return tok < TLAT ? (tok >> 12) : 4; }

__device__ void phase_setup(const Params& p, char* smem) {
  float* sS = (float*)smem;
  const int tid = tid_();
  for (int item = bid_(); item < 769; item += gridDim.x) {
    if (item == 768) {
      for (int i = tid; i < 1024; i += 256) {
        int pos = i >> 4, f = i & 15;
        float inv = powf(10000.f, -(float)f / 16.f);
        float ang = (float)pos * inv;
        p.rope[i] = cosf(ang);
        p.rope[1024 + i] = sinf(ang);
      }
      continue;
    }
    int nb = item % 24, ks = (item / 24) % 16, l = item / 384;
    __syncthreads();
    for (int i = tid; i < 320; i += 256) {
      int r = i >> 6, k = ks * 64 + (i & 63);
      float cv = (r < 4) ? p.c[r * 1024 + k] : p.c_ctx[k];
      sS[i] = siluf(cv);
    }
    __syncthreads();
    int n = nb * 256 + tid;
    const float* w = p.w_mod + ((size_t)l * 1024 + ks * 64) * NMOD + n;
    float acc[5] = {0.f, 0.f, 0.f, 0.f, 0.f};
#pragma unroll 8
    for (int k = 0; k < 64; ++k) {
      float wv = w[(size_t)k * NMOD];
#pragma unroll
      for (int r = 0; r < 5; ++r) acc[r] += sS[r * 64 + k] * wv;
    }
#pragma unroll
    for (int r = 0; r < 5; ++r) p.mod_part[(((size_t)ks * 2 + l) * 5 + r) * NMOD + n] = acc[r];
  }
}
__device__ void phase_modreduce(const Params& p) {
  for (int i = bid_() * 256 + tid_(); i < 2 * 5 * NMOD; i += gridDim.x * 256) {
    int n = i % NMOD, l = i / (5 * NMOD);
    float s = p.b_mod[l * NMOD + n];
#pragma unroll
    for (int ks = 0; ks < 16; ++ks) s += p.mod_part[(size_t)ks * 2 * 5 * NMOD + i];
    p.mod[i] = s;
  }
}

__device__ __forceinline__ void conv_tile(const float* src, int ldsrc, int srccol, bool zero, int k0, bf16_t* dst, int lddst,
                                          int n0, float* sT) {
  const int tid = tid_();
  __syncthreads();
#pragma unroll
  for (int i = 0; i < 4; ++i) {
    int kr = (tid >> 4) + 16 * i, c4 = (tid & 15) * 4;
    float4 v = make_float4(0.f, 0.f, 0.f, 0.f);
    if (!zero) v = *(const float4*)(src + (size_t)(k0 + kr) * ldsrc + srccol + c4);
    float* d = sT + kr * 65 + c4;
    d[0] = v.x; d[1] = v.y; d[2] = v.z; d[3] = v.w;
  }
  __syncthreads();
#pragma unroll
  for (int i = 0; i < 2; ++i) {
    int n = (tid >> 3) + 32 * i, kc = (tid & 7) * 8;
    unsigned o[4];
#pragma unroll
    for (int e = 0; e < 4; ++e) o[e] = pack2(sT[(kc + 2 * e) * 65 + n], sT[(kc + 2 * e + 1) * 65 + n]);
    *(uint4*)(dst + (size_t)(n0 + n) * lddst + k0 + kc) = make_uint4(o[0], o[1], o[2], o[3]);
  }
}
constexpr int CV_IN = 16 * 62, CV_GATE = 16 * 48, CV_BR = 8 * 16, CV_OUT = 16 * 16, CV_13 = 16 * 16, CV_2 = 8 * 16;
constexpr int CV_O1 = CV_IN, CV_O2 = CV_O1 + CV_GATE, CV_O3 = CV_O2 + 3 * CV_BR, CV_O4 = CV_O3 + CV_OUT, CV_O5 = CV_O4 + 32 * CV_13,
              CV_TOTAL = CV_O5 + 32 * CV_2;
__device__ void phase_convert(const Params& p, int layer, char* smem) {
  float* sT = (float*)smem;
  for (int item = bid_(); item < CV_TOTAL; item += gridDim.x) {
    if (item < CV_O1) {
      int kt = item & 15, ntile = item >> 4;
      int n0 = ntile * 64;
      int srccol;
      bool zero = false;
      if (n0 < 2304) srccol = n0;
      else if (n0 < 3840) srccol = n0 + 32;
      else if (n0 == 3840) srccol = 2304;
      else { srccol = 0; zero = true; }
      const float* src = p.w_in + (size_t)layer * 1024 * NIN_SRC;
      if (n0 == 3840) {
        const int tid = tid_();
        __syncthreads();
#pragma unroll
        for (int i = 0; i < 4; ++i) {
          int kr = (tid >> 4) + 16 * i, c4 = (tid & 15) * 4;
          float4 v = make_float4(0.f, 0.f, 0.f, 0.f);
          if (c4 < 32) v = *(const float4*)(src + (size_t)(kt * 64 + kr) * NIN_SRC + 2304 + c4);
          float* d = sT + kr * 65 + c4;
          d[0] = v.x; d[1] = v.y; d[2] = v.z; d[3] = v.w;
        }
        __syncthreads();
#pragma unroll
        for (int i = 0; i < 2; ++i) {
          int n = (tid >> 3) + 32 * i, kc = (tid & 7) * 8;
          unsigned o[4];
#pragma unroll
          for (int e = 0; e < 4; ++e) o[e] = pack2(sT[(kc + 2 * e) * 65 + n], sT[(kc + 2 * e + 1) * 65 + n]);
          *(uint4*)(p.wt_in + (size_t)(n0 + n) * 1024 + kt * 64 + kc) = make_uint4(o[0], o[1], o[2], o[3]);
        }
      } else {
        conv_tile(src, NIN_SRC, srccol, zero, kt * 64, p.wt_in, 1024, n0, sT);
      }
    } else if (item < CV_O2) {
      int it = item - CV_O1;
      int kt = it & 15, ntile = it >> 4;
      conv_tile(p.w_in + (size_t)layer * 1024 * NIN_SRC, NIN_SRC, 3872 + ntile * 64, false, kt * 64, p.wt_gate, 1024, ntile * 64, sT);
    } else if (item < CV_O3) {
      int it = item - CV_O2;
      int br = it / CV_BR, t = it % CV_BR;
      int kt = t & 7, ntile = t >> 3;
      const float* src = (br == 0 ? p.w_br_attn : (br == 1 ? p.w_br_gla : p.w_br_na)) + (size_t)layer * 512 * 1024;
      conv_tile(src, 1024, ntile * 64, false, kt * 64, p.wt_br + (size_t)br * 1024 * 512, 512, ntile * 64, sT);
    } else if (item < CV_O4) {
      int it = item - CV_O3;
      int kt = it & 15, ntile = it >> 4;
      conv_tile(p.w_out + (size_t)layer * 1024 * 1024, 1024, ntile * 64, false, kt * 64, p.wt_out, 1024, ntile * 64, sT);
    } else if (item < CV_O5) {
      int it = item - CV_O4;
      int e = it >> 8, t = it & 255;
      int kt = t & 15, ntile = t >> 4;
      int j = ntile >> 1, isw3 = ntile & 1;
      const float* src = (isw3 ? p.w3 : p.w1) + ((size_t)layer * 32 + e) * 1024 * 512;
      conv_tile(src, 512, j * 64, false, kt * 64, p.wt_13 + (size_t)e * 1024 * 1024, 1024, ntile * 64, sT);
    } else {
      int it = item - CV_O5;
      int e = it >> 7, t = it & 127;
      int kt = t & 7, ntile = t >> 3;
      conv_tile(p.w2 + ((size_t)layer * 32 + e) * 512 * 1024, 1024, ntile * 64, false, kt * 64, p.wt_2 + (size_t)e * 1024 * 512, 512,
                ntile * 64, sT);
    }
  }
}

__device__ __forceinline__ void row_stats(const float (&v)[16], float& mean, float& rstd) {
  float s = 0.f;
#pragma unroll
  for (int i = 0; i < 16; ++i) s += v[i];
  mean = wave_sum(s) * (1.f / 1024.f);
  float q = 0.f;
#pragma unroll
  for (int i = 0; i < 16; ++i) { float d = v[i] - mean; q += d * d; }
  float var = wave_sum(q) * (1.f / 1024.f);
  rstd = rsqrtf(var + 1e-6f);
}
__device__ __forceinline__ void load_row(const float* src, int lane, float (&v)[16]) {
#pragma unroll
  for (int i = 0; i < 4; ++i) {
    float4 t = *(const float4*)(src + lane * 4 + 256 * i);
    v[4 * i] = t.x; v[4 * i + 1] = t.y; v[4 * i + 2] = t.z; v[4 * i + 3] = t.w;
  }
}
__device__ __forceinline__ void store_row(float* dst, int lane, const float (&v)[16]) {
#pragma unroll
  for (int i = 0; i < 4; ++i) *(float4*)(dst + lane * 4 + 256 * i) = make_float4(v[4 * i], v[4 * i + 1], v[4 * i + 2], v[4 * i + 3]);
}
__device__ __forceinline__ void store_row_bf(bf16_t* dst, int lane, const float (&v)[16]) {
#pragma unroll
  for (int i = 0; i < 4; ++i) {
    uint2 o = make_uint2(pack2(v[4 * i], v[4 * i + 1]), pack2(v[4 * i + 2], v[4 * i + 3]));
    *(uint2*)(dst + lane * 4 + 256 * i) = o;
  }
}
__device__ __forceinline__ void modulate_row(const float (&x)[16], const float* shift, const float* scale, int lane, float (&h)[16]) {
  float mean, rstd;
  row_stats(x, mean, rstd);
  float sh[16], sc[16];
  load_row(shift, lane, sh);
  load_row(scale, lane, sc);
#pragma unroll
  for (int i = 0; i < 16; ++i) h[i] = (x[i] - mean) * rstd * (1.f + sc[i]) + sh[i];
}

__device__ void phase_rowpass0(const Params& p) {
  const int lane = tid_() & 63, w = tid_() >> 6;
  for (int tok = bid_() * 4 + w; tok < TALL; tok += gridDim.x * 4) {
    const float* src = tok < TLAT ? p.x + (size_t)tok * D : p.ctx + (size_t)(tok - TLAT) * D;
    const float* md = p.mod + (size_t)tok_modrow(tok) * NMOD;
    float x[16], h[16];
    load_row(src, lane, x);
    modulate_row(x, md, md + 1024, lane, h);
    store_row_bf(p.h + (size_t)tok * D, lane, h);
  }
}

__device__ void phase_rowpass1(const Params& p, int layer, char* smem) {
  float* sH = (float*)smem;
  float* sLe = sH + 8 * 1024;
  float* sLg = sLe + 8 * 32;
  const int tid = tid_(), lane = tid & 63, w = tid >> 6;
  const int ntok = layer == 0 ? TALL : TLAT;
  const float* lg = p.ln1_g + layer * D;
  const float* lb = p.ln1_b + layer * D;
  const float* wre = p.w_re + (size_t)layer * 1024 * 32;
  const float* wrg = p.w_rg + (size_t)layer * 1024 * 4;
  for (int g0 = bid_() * 8; g0 < ntok; g0 += gridDim.x * 8) {
    __syncthreads();
#pragma unroll 1
    for (int rr = 0; rr < 2; ++rr) {
      int tok = g0 + w * 2 + rr;
      float v[16], x1[16], h2[16], gg[16], bb[16];
      load_row(p.xres + (size_t)tok * D, lane, v);
      float mean, rstd;
      row_stats(v, mean, rstd);
      load_row(lg, lane, gg);
      load_row(lb, lane, bb);
#pragma unroll
      for (int i = 0; i < 16; ++i) x1[i] = (v[i] - mean) * rstd * gg[i] + bb[i];
      store_row(p.xres + (size_t)tok * D, lane, x1);
      const float* md = p.mod + ((size_t)layer * 5 + tok_modrow(tok)) * NMOD;
      modulate_row(x1, md + 3072, md + 4096, lane, h2);
      store_row_bf(p.h2 + (size_t)tok * D, lane, h2);
      store_row(sH + (w * 2 + rr) * 1024, lane, h2);
    }
    __syncthreads();
    {
      int row = tid >> 5, e = tid & 31;
      const float* hr = sH + row * 1024;
      float ae = 0.f, ag = 0.f;
#pragma unroll 8
      for (int k = 0; k < 1024; ++k) {
        float hv = hr[k];
        ae += hv * wre[k * 32 + e];
        ag += hv * wrg[k * 4 + (e & 3)];
      }
      sLe[row * 32 + e] = ae + p.b_re[layer * 32 + e];
      if (e < 4) sLg[row * 4 + e] = ag + p.b_rg[layer * 4 + e];
    }
    __syncthreads();
    if (tid < 8) {
      int tok = g0 + tid;
      float g[4];
#pragma unroll
      for (int i = 0; i < 4; ++i) g[i] = sLg[tid * 4 + i];
      int grp = 0;
      float gm = g[0];
#pragma unroll
      for (int i = 1; i < 4; ++i) if (g[i] > gm) { gm = g[i]; grp = i; }
      float gs = 0.f;
#pragma unroll
      for (int i = 0; i < 4; ++i) gs += __expf(g[i] - gm);
      float pg = 1.f / gs;
      float sv[8];
#pragma unroll
      for (int i = 0; i < 8; ++i) sv[i] = sLe[tid * 32 + grp * 8 + i];
      int i0 = 0;
      float v0 = sv[0];
#pragma unroll
      for (int i = 1; i < 8; ++i) if (sv[i] > v0) { v0 = sv[i]; i0 = i; }
      int i1 = -1;
      float v1 = -3.0e38f;
#pragma unroll
      for (int i = 0; i < 8; ++i) if (i != i0 && sv[i] > v1) { v1 = sv[i]; i1 = i; }
      float e1 = __expf(v1 - v0);
      float w0 = pg / (1.f + e1), w1 = pg * e1 / (1.f + e1);
      int ex0 = grp * 8 + i0, ex1 = grp * 8 + i1;
      int p0 = atomicAdd(&p.cnt[ex0], 1);
      int p1 = atomicAdd(&p.cnt[ex1], 1);
      p.list[ex0 * MOE_CAP + p0] = tok;
      p.list[ex1 * MOE_CAP + p1] = tok;
      p.tok_e[tok * 2] = ex0; p.tok_e[tok * 2 + 1] = ex1;
      p.tok_pos[tok * 2] = p0; p.tok_pos[tok * 2 + 1] = p1;
      p.tok_gate[tok * 2] = w0; p.tok_gate[tok * 2 + 1] = w1;
    }
  }
}

__device__ void phase_rowpass2(const Params& p, int layer) {
  const int lane = tid_() & 63, w = tid_() >> 6;
  const bool last = layer == 1;
  const int ntok = last ? TLAT : TALL;
  const float* lg = p.ln2_g + layer * D;
  const float* lb = p.ln2_b + layer * D;
  for (int tok = bid_() * 4 + w; tok < ntok; tok += gridDim.x * 4) {
    float x1[16], g2[16], v[16], x2[16], gg[16], bb[16];
    load_row(p.xres + (size_t)tok * D, lane, x1);
    const float* md = p.mod + ((size_t)layer * 5 + tok_modrow(tok)) * NMOD;
    load_row(md + 5120, lane, g2);
    int e0 = p.tok_e[tok * 2], e1 = p.tok_e[tok * 2 + 1];
    int s0 = p.estart[e0] * 128 + p.tok_pos[tok * 2], s1 = p.estart[e1] * 128 + p.tok_pos[tok * 2 + 1];
    float w0 = p.tok_gate[tok * 2], w1 = p.tok_gate[tok * 2 + 1];
    const bf16_t* y0 = p.ysl + (size_t)s0 * D;
    const bf16_t* y1 = p.ysl + (size_t)s1 * D;
#pragma unroll
    for (int i = 0; i < 4; ++i) {
      uint2 a = *(const uint2*)(y0 + lane * 4 + 256 * i);
      uint2 b = *(const uint2*)(y1 + lane * 4 + 256 * i);
      float ya[4] = {bf2f(a.x & 0xffff), bf2f(a.x >> 16), bf2f(a.y & 0xffff), bf2f(a.y >> 16)};
      float yb[4] = {bf2f(b.x & 0xffff), bf2f(b.x >> 16), bf2f(b.y & 0xffff), bf2f(b.y >> 16)};
#pragma unroll
      for (int e = 0; e < 4; ++e) v[4 * i + e] = ALPHA * x1[4 * i + e] + g2[4 * i + e] * (w0 * ya[e] + w1 * yb[e]);
    }
    float mean, rstd;
    row_stats(v, mean, rstd);
    load_row(lg, lane, gg);
    load_row(lb, lane, bb);
#pragma unroll
    for (int i = 0; i < 16; ++i) x2[i] = (v[i] - mean) * rstd * gg[i] + bb[i];
    if (last) {
      store_row(p.out + (size_t)tok * D, lane, x2);
    } else {
      store_row(p.xres + (size_t)tok * D, lane, x2);
      const float* mdn = p.mod + ((size_t)(layer + 1) * 5 + tok_modrow(tok)) * NMOD;
      float h[16];
      modulate_row(x2, mdn, mdn + 1024, lane, h);
      store_row_bf(p.h + (size_t)tok * D, lane, h);
    }
  }
}

struct Ptr4 { const bf16_t* p[4]; };

template <int NJ>
__device__ __forceinline__ void gemm_mainloop(const Ptr4& ap, const Ptr4& bp, int nk, f32x16 (&acc)[2][NJ], char* smem) {
  const int tid = tid_(), lane = tid & 63, w = tid >> 6, wr = w >> 1, wc = w & 1, r = lane & 31, hh = lane >> 5;
  const int lrow = tid >> 3, lch = tid & 7;
  const int wofs = lrow * 128 + ((lch ^ (lrow & 7)) << 4);
  char* sA = smem;
  char* sB = smem + 32768;
  uint4 ra[4], rb[2 * NJ];
#pragma unroll
  for (int i = 0; i < 4; ++i) ra[i] = *(const uint4*)(ap.p[i]);
#pragma unroll
  for (int i = 0; i < 2 * NJ; ++i) rb[i] = *(const uint4*)(bp.p[i]);
#pragma unroll
  for (int i = 0; i < 4; ++i) *(uint4*)(sA + wofs + i * 4096) = ra[i];
#pragma unroll
  for (int i = 0; i < 2 * NJ; ++i) *(uint4*)(sB + wofs + i * 4096) = rb[i];
  __syncthreads();
  for (int kt = 0; kt < nk; ++kt) {
    const int cur = kt & 1;
    if (kt + 1 < nk) {
#pragma unroll
      for (int i = 0; i < 4; ++i) ra[i] = *(const uint4*)(ap.p[i] + (kt + 1) * 64);
#pragma unroll
      for (int i = 0; i < 2 * NJ; ++i) rb[i] = *(const uint4*)(bp.p[i] + (kt + 1) * 64);
    }
    const char* cA = sA + cur * 16384 + (wr * 64 + r) * 128;
    const char* cB = sB + cur * 16384 + (wc * 32 * NJ + r) * 128;
#pragma unroll
    for (int s = 0; s < 4; ++s) {
      const int co = ((2 * s + hh) ^ (r & 7)) << 4;
      bf16x8 a0 = *(const bf16x8*)(cA + co);
      bf16x8 a1 = *(const bf16x8*)(cA + 4096 + co);
      bf16x8 b[NJ];
#pragma unroll
      for (int j = 0; j < NJ; ++j) b[j] = *(const bf16x8*)(cB + j * 4096 + co);
#pragma unroll
      for (int j = 0; j < NJ; ++j) {
        acc[0][j] = mfma32(a0, b[j], acc[0][j]);
        acc[1][j] = mfma32(a1, b[j], acc[1][j]);
      }
    }
    if (kt + 1 < nk) {
      char* dA = sA + (cur ^ 1) * 16384 + wofs;
      char* dB = sB + (cur ^ 1) * 16384 + wofs;
#pragma unroll
      for (int i = 0; i < 4; ++i) *(uint4*)(dA + i * 4096) = ra[i];
#pragma unroll
      for (int i = 0; i < 2 * NJ; ++i) *(uint4*)(dB + i * 4096) = rb[i];
    }
    __syncthreads();
  }
}
__device__ __forceinline__ Ptr4 rows_contig(const bf16_t* base, int ld) {
  Ptr4 q;
  const int lrow = tid_() >> 3, lch = tid_() & 7;
#pragma unroll
  for (int i = 0; i < 4; ++i) q.p[i] = base + (size_t)(lrow + 32 * i) * ld + lch * 8;
  return q;
}
__device__ __forceinline__ void acc_to_lds(const f32x16 (&acc)[2][2], float* sC) {
  const int lane = tid_() & 63, w = tid_() >> 6, wr = w >> 1, wc = w & 1, r = lane & 31, hh = lane >> 5;
#pragma unroll
  for (int i = 0; i < 2; ++i)
#pragma unroll
    for (int j = 0; j < 2; ++j)
#pragma unroll
      for (int g = 0; g < 16; ++g) {
        int row = wr * 64 + i * 32 + (g & 3) + 8 * (g >> 2) + 4 * hh, col = wc * 64 + j * 32 + r;
        sC[row * LDC + col] = acc[i][j][g];
      }
}
__device__ __forceinline__ void acc_to_lds_T(const f32x16 (&acc)[2][2], float* sC) {
  const int lane = tid_() & 63, w = tid_() >> 6, wr = w >> 1, wc = w & 1, r = lane & 31, hh = lane >> 5;
#pragma unroll
  for (int i = 0; i < 2; ++i)
#pragma unroll
    for (int j = 0; j < 2; ++j)
#pragma unroll
      for (int g4 = 0; g4 < 4; ++g4) {
        int row = wr * 64 + i * 32 + 8 * g4 + 4 * hh, col = wc * 64 + j * 32 + r;
        *(float4*)(sC + col * LDC + row) = make_float4(acc[i][j][4 * g4], acc[i][j][4 * g4 + 1], acc[i][j][4 * g4 + 2], acc[i][j][4 * g4 + 3]);
      }
}
__device__ __forceinline__ void lds_read8(const float* s, float (&v)[8]) {
  float4 a = *(const float4*)s, b = *(const float4*)(s + 4);
  v[0] = a.x; v[1] = a.y; v[2] = a.z; v[3] = a.w; v[4] = b.x; v[5] = b.y; v[6] = b.z; v[7] = b.w;
}
__device__ __forceinline__ uint4 pack8(const float (&v)[8]) {
  return make_uint4(pack2(v[0], v[1]), pack2(v[2], v[3]), pack2(v[4], v[5]), pack2(v[6], v[7]));
}

__device__ void phase_inproj(const Params& p, int layer, char* smem) {
  float* sC = (float*)smem;
  const int tid = tid_();
  const int nitems = 136 * NT_IN;
  const float* bias = p.b_in + layer * NIN_SRC;
  for (int item = bid_(); item < nitems; item += gridDim.x) {
    const int mt = item / NT_IN, nt = item % NT_IN;
    f32x16 acc[2][2];
#pragma unroll
    for (int i = 0; i < 2; ++i)
#pragma unroll
      for (int j = 0; j < 2; ++j) acc[i][j] = zero16();
    Ptr4 ap = rows_contig(p.h + (size_t)mt * 128 * D, D);
    Ptr4 bp = rows_contig(p.wt_in + (size_t)nt * 128 * D, D);
    gemm_mainloop<2>(ap, bp, 16, acc, smem);
    const bool transposed = (nt == 5) || (nt >= 10 && nt <= 13) || (nt >= 26 && nt <= 29);
    if (transposed) acc_to_lds_T(acc, sC); else acc_to_lds(acc, sC);
    __syncthreads();
    const int tok0 = mt * 128;
    const bool lat = tok0 < TLAT;
    int b, pos0, pall0;
    if (lat) { b = tok0 >> 12; pos0 = tok0 & 4095; pall0 = 256 + pos0; }
    else { int ci = tok0 - TLAT; b = ci >> 8; pos0 = ci & 255; pall0 = pos0; }
    const int n0 = nt * 128;
    const int srcc0 = (nt < 18) ? n0 : (nt < 30 ? n0 + 32 : 2304);
    if (transposed) {
#pragma unroll 1
      for (int ps = 0; ps < 8; ++ps) {
        int col = ps * 16 + (tid >> 4), tc = tid & 15;
        float v[8];
        lds_read8(sC + col * LDC + tc * 8, v);
        float bv = bias[srcc0 + col];
#pragma unroll
        for (int e = 0; e < 8; ++e) v[e] += bv;
        bf16_t* dst;
        if (nt == 5) dst = p.vAT + ((size_t)(b * 2 + (col >> 6)) * 64 + (col & 63)) * PALL;
        else if (nt <= 13) dst = p.vBT + ((size_t)(b * 4 + (nt - 10)) * 128 + col) * PALL;
        else dst = p.vCT + ((size_t)(b * 8 + (nt - 26) * 2 + (col >> 6)) * 64 + (col & 63)) * PALL;
        *(uint4*)(dst + pall0 + tc * 8) = pack8(v);
      }
    } else if (nt <= 4) {
      const float* gn = (nt < 4 ? p.q_norm : p.k_norm) + layer * 64;
      const float osc = nt < 4 ? QSCALE : 1.f;
#pragma unroll 1
      for (int ps = 0; ps < 8; ++ps) {
        int row = ps * 16 + (tid >> 4), c8 = tid & 15;
        float v[8], pv[8];
        lds_read8(sC + row * LDC + c8 * 8, v);
        lds_read8(sC + row * LDC + ((c8 * 8) ^ 16), pv);
        float ss = 0.f;
#pragma unroll
        for (int e = 0; e < 8; ++e) {
          v[e] += bias[srcc0 + c8 * 8 + e];
          pv[e] += bias[srcc0 + ((c8 * 8) ^ 16) + e];
          ss += v[e] * v[e];
        }
        ss += __shfl_xor(ss, 1);
        ss += __shfl_xor(ss, 2);
        ss += __shfl_xor(ss, 4);
        float rstd = rsqrtf(ss * (1.f / 64.f) + 1e-6f);
        const int d0 = (c8 & 7) * 8;
        float o[8];
#pragma unroll
        for (int e = 0; e < 8; ++e) {
          float xn = v[e] * rstd * gn[d0 + e];
          float pn = pv[e] * rstd * gn[(d0 ^ 16) + e];
          if (lat) {
            int t = pos0 + row;
            int qd = d0 >> 4;
            int pp = (qd < 2) ? (t >> 6) : (t & 63);
            int f = (d0 & 15) + e;
            float cs = p.rope[pp * 16 + f], sn = p.rope[1024 + pp * 16 + f];
            o[e] = (xn * cs + ((qd & 1) ? pn : -pn) * sn) * osc;
          } else {
            o[e] = xn * osc;
          }
        }
        bf16_t* dst;
        if (nt < 4) dst = p.qA + (size_t)(tok0 + row) * 512 + nt * 128 + c8 * 8;
        else dst = p.kA + ((size_t)(b * 2 + (c8 >> 3)) * PALL + pall0 + row) * 64 + d0;
        *(uint4*)dst = pack8(o);
      }
    } else if (nt == 30) {
      for (int i = tid; i < 128 * 32; i += 256) {
        int row = i >> 5, col = i & 31;
        p.aB[(size_t)(tok0 + row) * 32 + col] = sC[row * LDC + col] + bias[2304 + col];
      }
    } else {
      bf16_t* base;
      int ld, cofs;
      float osc = 1.f;
      if (nt <= 7) { base = p.qB; ld = 256; cofs = (nt - 6) * 128; osc = 0.125f; }
      else if (nt <= 9) { base = p.kB; ld = 256; cofs = (nt - 8) * 128; }
      else if (nt <= 17) { base = p.rB; ld = 512; cofs = (nt - 14) * 128; }
      else if (nt <= 21) { base = p.qC; ld = 512; cofs = (nt - 18) * 128; osc = QSCALE; }
      else { base = p.kC; ld = 512; cofs = (nt - 22) * 128; }
#pragma unroll 1
      for (int ps = 0; ps < 8; ++ps) {
        int row = ps * 16 + (tid >> 4), c8 = tid & 15;
        float v[8];
        lds_read8(sC + row * LDC + c8 * 8, v);
#pragma unroll
        for (int e = 0; e < 8; ++e) v[e] = (v[e] + bias[srcc0 + c8 * 8 + e]) * osc;
        *(uint4*)(base + (size_t)(tok0 + row) * ld + cofs + c8 * 8) = pack8(v);
      }
    }
    __syncthreads();
  }
}

__device__ void phase_merge(const Params& p, int layer, char* smem) {
  float* sC = (float*)smem;
  const int tid = tid_(), lane = tid & 63, w = tid >> 6, wr = w >> 1, wc = w & 1, r = lane & 31, hh = lane >> 5;
  const int nmt = layer == 0 ? 136 : 128;
  const float* bias = p.b_in + layer * NIN_SRC + 3872;
  if (bid_() == 0 && tid < 32) p.cnt[tid] = 0;
  for (int item = bid_(); item < nmt * 16; item += gridDim.x) {
    const int mt = item >> 4, nt = item & 15;
    f32x16 tot[2][1];
    tot[0][0] = zero16();
    tot[1][0] = zero16();
#pragma unroll 1
    for (int br = 0; br < 3; ++br) {
      f32x16 acc[2][1];
      acc[0][0] = zero16();
      acc[1][0] = zero16();
      gemm_mainloop<1>(rows_contig(p.h + (size_t)mt * 128 * D, D), rows_contig(p.wt_gate + (size_t)(br * 1024 + nt * 64) * D, D), 16, acc, smem);
      unsigned sg[2][8];
      {
        float bv = bias[br * 1024 + nt * 64 + wc * 32 + r];
#pragma unroll
        for (int i = 0; i < 2; ++i)
#pragma unroll
          for (int g = 0; g < 8; ++g)
            sg[i][g] = pack2(sigmoidf_(acc[i][0][2 * g] + bv), sigmoidf_(acc[i][0][2 * g + 1] + bv));
      }
      acc[0][0] = zero16();
      acc[1][0] = zero16();
      const bf16_t* ob = (br == 0 ? p.oA : (br == 1 ? p.oB : p.oC));
      gemm_mainloop<1>(rows_contig(ob + (size_t)mt * 128 * 512, 512), rows_contig(p.wt_br + ((size_t)br * 1024 + nt * 64) * 512, 512), 8, acc, smem);
#pragma unroll
      for (int i = 0; i < 2; ++i)
#pragma unroll
        for (int g = 0; g < 8; ++g) {
          tot[i][0][2 * g] += bf2f((bf16_t)(sg[i][g] & 0xffff)) * acc[i][0][2 * g];
          tot[i][0][2 * g + 1] += bf2f((bf16_t)(sg[i][g] >> 16)) * acc[i][0][2 * g + 1];
        }
    }
#pragma unroll
    for (int i = 0; i < 2; ++i)
#pragma unroll
      for (int g = 0; g < 16; ++g) {
        int row = wr * 64 + i * 32 + (g & 3) + 8 * (g >> 2) + 4 * hh, col = wc * 32 + r;
        sC[row * LDC + col] = tot[i][0][g];
      }
    __syncthreads();
#pragma unroll 1
    for (int ps = 0; ps < 4; ++ps) {
      int row = ps * 32 + (tid >> 3), c8 = tid & 7;
      float v[8];
      lds_read8(sC + row * LDC + c8 * 8, v);
      *(uint4*)(p.m + (size_t)(mt * 128 + row) * D + nt * 64 + c8 * 8) = pack8(v);
    }
    __syncthreads();
  }
}

__device__ void phase_outproj(const Params& p, int layer, char* smem) {
  const int tid = tid_(), lane = tid & 63, w = tid >> 6, wr = w >> 1, wc = w & 1, r = lane & 31, hh = lane >> 5;
  const int nmt = layer == 0 ? 136 : 128;
  for (int item = bid_(); item < nmt * 8; item += gridDim.x) {
    const int mt = item >> 3, nt = item & 7;
    f32x16 acc[2][2];
#pragma unroll
    for (int i = 0; i < 2; ++i)
#pragma unroll
      for (int j = 0; j < 2; ++j) acc[i][j] = zero16();
    gemm_mainloop<2>(rows_contig(p.m + (size_t)mt * 128 * D, D), rows_contig(p.wt_out + (size_t)nt * 128 * D, D), 16, acc, smem);
    const int tok0 = mt * 128;
    const float* g1 = p.mod + ((size_t)layer * 5 + tok_modrow(tok0)) * NMOD + 2048;
#pragma unroll
    for (int j = 0; j < 2; ++j) {
      int col = nt * 128 + wc * 64 + j * 32 + r;
      float gv = g1[col];
#pragma unroll
      for (int i = 0; i < 2; ++i)
#pragma unroll
        for (int g = 0; g < 16; ++g) {
          int tok = tok0 + wr * 64 + i * 32 + (g & 3) + 8 * (g >> 2) + 4 * hh;
          float xv;
          if (layer == 0) xv = tok < TLAT ? p.x[(size_t)tok * D + col] : p.ctx[(size_t)(tok - TLAT) * D + col];
          else xv = p.xres[(size_t)tok * D + col];
          p.xres[(size_t)tok * D + col] = ALPHA * xv + gv * acc[i][j][g];
        }
    }
  }
}

__device__ __forceinline__ bool moe_block_lookup(const Params& p, int mb, int& e, int& lb, int& cnt_e) {
  int start = 0;
  for (int i = 0; i < 32; ++i) {
    int c = p.cnt[i];
    int nb = (c + 127) >> 7;
    if (mb < start + nb) { e = i; lb = mb - start; cnt_e = c; return true; }
    start += nb;
  }
  return false;
}
__device__ void phase_moe1(const Params& p, int layer, char* smem) {
  float* sC = (float*)smem;
  const int tid = tid_();
  if (bid_() == 0 && tid == 0) {
    int start = 0;
    for (int i = 0; i < 32; ++i) { p.estart[i] = start; start += (p.cnt[i] + 127) >> 7; }
  }
  for (int item = bid_(); item < MAX_MBLK * 8; item += gridDim.x) {
    const int mb = item >> 3, nt = item & 7;
    int e, lb, ce;
    if (!moe_block_lookup(p, mb, e, lb, ce)) continue;
    Ptr4 ap;
    {
      const int lrow = tid >> 3, lch = tid & 7;
#pragma unroll
      for (int i = 0; i < 4; ++i) {
        int sl = lb * 128 + lrow + 32 * i;
        int tok = sl < ce ? p.list[e * MOE_CAP + sl] : 0;
        ap.p[i] = p.h2 + (size_t)tok * D + lch * 8;
      }
    }
    f32x16 acc[2][2];
#pragma unroll
    for (int i = 0; i < 2; ++i)
#pragma unroll
      for (int j = 0; j < 2; ++j) acc[i][j] = zero16();
    gemm_mainloop<2>(ap, rows_contig(p.wt_13 + ((size_t)e * 1024 + nt * 128) * D, D), 16, acc, smem);
    acc_to_lds(acc, sC);
    __syncthreads();
#pragma unroll 1
    for (int ps = 0; ps < 8; ++ps) {
      int row = ps * 16 + (tid >> 4), c4 = (tid & 15) * 4;
      float4 a = *(const float4*)(sC + row * LDC + c4);
      float4 b = *(const float4*)(sC + row * LDC + 64 + c4);
      uint2 o = make_uint2(pack2(siluf(a.x) * b.x, siluf(a.y) * b.y), pack2(siluf(a.z) * b.z, siluf(a.w) * b.w));
      *(uint2*)(p.act + (size_t)(mb * 128 + row) * 512 + nt * 64 + c4) = o;
    }
    __syncthreads();
  }
}
__device__ void phase_moe2(const Params& p, int layer, char* smem) {
  float* sC = (float*)smem;
  const int tid = tid_();
  for (int item = bid_(); item < MAX_MBLK * 8; item += gridDim.x) {
    const int mb = item >> 3, nt = item & 7;
    int e, lb, ce;
    if (!moe_block_lookup(p, mb, e, lb, ce)) continue;
    f32x16 acc[2][2];
#pragma unroll
    for (int i = 0; i < 2; ++i)
#pragma unroll
      for (int j = 0; j < 2; ++j) acc[i][j] = zero16();
    gemm_mainloop<2>(rows_contig(p.act + (size_t)mb * 128 * 512, 512), rows_contig(p.wt_2 + ((size_t)e * 1024 + nt * 128) * 512, 512), 8, acc, smem);
    acc_to_lds(acc, sC);
    __syncthreads();
#pragma unroll 1
    for (int ps = 0; ps < 8; ++ps) {
      int row = ps * 16 + (tid >> 4), c8 = tid & 15;
      float v[8];
      lds_read8(sC + row * LDC + c8 * 8, v);
      *(uint4*)(p.ysl + (size_t)(mb * 128 + row) * D + nt * 128 + c8 * 8) = pack8(v);
    }
    __syncthreads();
  }
}

template <class MaskF>
__device__ __forceinline__ void attn_tile(const char* sK, const char* sV, const bf16x8 (&bq)[4], f32x16 (&O)[2], float& m, float& l,
                                          int r, int hh, MaskF maskf) {
  f32x16 S[2];
  S[0] = zero16();
  S[1] = zero16();
  const char* kp = sK + r * 128;
#pragma unroll
  for (int s = 0; s < 4; ++s) {
    const int co = ((2 * s + hh) ^ (r & 7)) << 4;
    bf16x8 a0 = *(const bf16x8*)(kp + co);
    bf16x8 a1 = *(const bf16x8*)(kp + 4096 + co);
    S[0] = mfma32(a0, bq[s], S[0]);
    S[1] = mfma32(a1, bq[s], S[1]);
  }
  maskf(S);
  float mx = S[0][0];
#pragma unroll
  for (int g = 1; g < 16; ++g) mx = fmaxf(mx, S[0][g]);
#pragma unroll
  for (int g = 0; g < 16; ++g) mx = fmaxf(mx, S[1][g]);
  mx = fmaxf(mx, __shfl_xor(mx, 32));
  const float mn = fmaxf(m, mx);
  const float alpha = __builtin_amdgcn_exp2f(m - mn);
  m = mn;
  float ls = 0.f;
#pragma unroll
  for (int kb = 0; kb < 2; ++kb)
#pragma unroll
    for (int g = 0; g < 16; ++g) {
      float pv = __builtin_amdgcn_exp2f(S[kb][g] - mn);
      S[kb][g] = pv;
      ls += pv;
    }
  l = l * alpha + ls;
#pragma unroll
  for (int g = 0; g < 16; ++g) { O[0][g] *= alpha; O[1][g] *= alpha; }
  const char* vp = sV + r * 136 + hh * 8;
#pragma unroll
  for (int sp = 0; sp < 4; ++sp) {
    bf16x8 bp;
#pragma unroll
    for (int j = 0; j < 8; ++j) bp[j] = (short)f2bf(S[sp >> 1][8 * (sp & 1) + j]);
#pragma unroll
    for (int db = 0; db < 2; ++db) {
      bf16x4 lo = *(const bf16x4*)(vp + db * 32 * 136 + sp * 32);
      bf16x4 hi = *(const bf16x4*)(vp + db * 32 * 136 + sp * 32 + 16);
      bf16x8 av = __builtin_shufflevector(lo, hi, 0, 1, 2, 3, 4, 5, 6, 7);
      O[db] = mfma32(av, bp, O[db]);
    }
  }
}
struct NoMask { __device__ __forceinline__ void operator()(f32x16 (&)[2]) const {} };

__device__ __forceinline__ void attn_write_out(bf16_t* dst  , const f32x16 (&O)[2], float l, int hh) {
  float lt = l + __shfl_xor(l, 32);
  float inv = 1.f / lt;
#pragma unroll
  for (int db = 0; db < 2; ++db)
#pragma unroll
    for (int g4 = 0; g4 < 4; ++g4) {
      uint2 o = make_uint2(pack2(O[db][4 * g4] * inv, O[db][4 * g4 + 1] * inv), pack2(O[db][4 * g4 + 2] * inv, O[db][4 * g4 + 3] * inv));
      *(uint2*)(dst + 32 * db + 8 * g4 + 4 * hh) = o;
    }
}

__device__ void phase_attnA(const Params& p, int layer, char* smem) {
  const int tid = tid_(), lane = tid & 63, w = tid >> 6, r = lane & 31, hh = lane >> 5;
  char* sK = smem;
  char* sV = smem + 16384;
  const int nitems = layer == 0 ? 1088 : 1024;
  for (int item = bid_(); item < nitems; item += gridDim.x) {
    int b, kvh, qtok0, nkt;
    if (item < 1024) { b = item >> 8; kvh = (item >> 7) & 1; qtok0 = b * 4096 + (item & 127) * 32; nkt = 68; }
    else { int it = item - 1024; b = it >> 4; kvh = (it >> 3) & 1; qtok0 = TLAT + b * 256 + (it & 7) * 32; nkt = 4; }
    const int head = kvh * 4 + w;
    bf16x8 bq[4];
    {
      const bf16_t* qp = p.qA + (size_t)(qtok0 + r) * 512 + head * 64 + 8 * hh;
#pragma unroll
      for (int s = 0; s < 4; ++s) bq[s] = *(const bf16x8*)(qp + 16 * s);
    }
    const bf16_t* kbase = p.kA + (size_t)(b * 2 + kvh) * PALL * 64;
    const bf16_t* vbase = p.vAT + (size_t)(b * 2 + kvh) * 64 * PALL;
    const int krow0 = tid >> 3, kch0 = tid & 7;
    const bf16_t* kg = kbase + (size_t)krow0 * 64 + kch0 * 8;
    const bf16_t* vg = vbase + (size_t)krow0 * PALL + kch0 * 8;
    const int ksto = krow0 * 128 + ((kch0 ^ (krow0 & 7)) << 4);
    const int vsto = krow0 * 136 + kch0 * 16;
    uint4 rk0, rk1, rv0, rv1;
#define ATTN_GLOAD(kt)                                                    \
  {                                                                       \
    rk0 = *(const uint4*)(kg + (size_t)(kt) * 4096);                      \
    rk1 = *(const uint4*)(kg + (size_t)(kt) * 4096 + 2048);               \
    rv0 = *(const uint4*)(vg + (kt) * 64);                                \
    rv1 = *(const uint4*)(vg + (size_t)32 * PALL + (kt) * 64);            \
  }
#define ATTN_LSTORE(buf)                                                  \
  {                                                                       \
    *(uint4*)(sK + (buf) * 8192 + ksto) = rk0;                            \
    *(uint4*)(sK + (buf) * 8192 + 4096 + ksto) = rk1;                     \
    char* d0 = sV + (buf) * 8704 + vsto;                                  \
    *(uint2*)d0 = make_uint2(rv0.x, rv0.y);                               \
    *(uint2*)(d0 + 8) = make_uint2(rv0.z, rv0.w);                         \
    *(uint2*)(d0 + 32 * 136) = make_uint2(rv1.x, rv1.y);                  \
    *(uint2*)(d0 + 32 * 136 + 8) = make_uint2(rv1.z, rv1.w);              \
  }
    f32x16 O[2];
    O[0] = zero16();
    O[1] = zero16();
    float m = -1e30f, l = 0.f;
    __syncthreads();
    ATTN_GLOAD(0);
    ATTN_LSTORE(0);
    __syncthreads();
    for (int kt = 0; kt < nkt; ++kt) {
      const int cur = kt & 1;
      if (kt + 1 < nkt) ATTN_GLOAD(kt + 1);
      attn_tile(sK + cur * 8192, sV + cur * 8704, bq, O, m, l, r, hh, NoMask());
      if (kt + 1 < nkt) ATTN_LSTORE(cur ^ 1);
      __syncthreads();
    }
    attn_write_out(p.oA + (size_t)(qtok0 + r) * 512 + head * 64, O, l, hh);
  }
}

struct NaMask {
  const float* bias;
  int brow;
  int wq;
  int hh;
  __device__ __forceinline__ void operator()(f32x16 (&S)[2]) const {
    int cs = wq - 8;
    cs = cs < 0 ? 0 : (cs > 48 ? 48 : cs);
#pragma unroll
    for (int kb = 0; kb < 2; ++kb)
#pragma unroll
      for (int g = 0; g < 16; ++g) {
        int c = 32 * kb + (g & 3) + 8 * (g >> 2) + 4 * hh;
        bool valid = (c >= cs) && (c < cs + 16);
        int ci = c - wq + 15;
        ci = ci < 0 ? 0 : (ci > 30 ? 30 : ci);
        float bv = bias[brow * 31 + ci];
        S[kb][g] = valid ? S[kb][g] + bv : -1e30f;
      }
  }
};
__device__ void phase_na(const Params& p, int layer, char* smem) {
  const int tid = tid_(), lane = tid & 63, w = tid >> 6, r = lane & 31, hh = lane >> 5;
  char* sK = smem;
  char* sV = smem + 16384;
  float* sBias = (float*)(smem + 16384 + 17408);
  const int nitems = layer == 0 ? 1088 : 1024;
  const int set = w >> 1, qhalf = w & 1;
  for (int item = bid_(); item < nitems; item += gridDim.x) {
    int b, hp, row = 0, rs = 0, qtok0, kt0, kt1;
    if (item < 1024) {
      b = item >> 8; row = (item >> 2) & 63; hp = item & 3;
      rs = row - 4; rs = rs < 0 ? 0 : (rs > 56 ? 56 : rs);
      qtok0 = b * 4096 + row * 64; kt0 = 0; kt1 = 12;
    } else {
      int it = item - 1024;
      b = it >> 4; hp = (it >> 2) & 3;
      qtok0 = TLAT + b * 256 + (it & 3) * 64; kt0 = 8; kt1 = 12;
    }
    const int head = 2 * hp + set;
    __syncthreads();
    for (int i = tid; i < 930; i += 256) {
      int s = i / 465, j = i % 465;
      sBias[i] = p.rpb[((size_t)layer * 8 + 2 * hp + s) * 465 + j] * LOG2E;
    }
    bf16x8 bq[4];
    {
      const bf16_t* qp = p.qC + (size_t)(qtok0 + 32 * qhalf + r) * 512 + head * 64 + 8 * hh;
#pragma unroll
      for (int s = 0; s < 4; ++s) bq[s] = *(const bf16x8*)(qp + 16 * s);
    }
    const int krow0 = tid >> 3, kch0 = tid & 7;
    const int ksto = krow0 * 128 + ((kch0 ^ (krow0 & 7)) << 4);
    const int vsto = krow0 * 136 + kch0 * 16;
    f32x16 O[2];
    O[0] = zero16();
    O[1] = zero16();
    float m = -1e30f, l = 0.f;
    for (int kt = kt0; kt < kt1; ++kt) {
      int tokK, pallb;
      if (kt < 8) { tokK = b * 4096 + (rs + kt) * 64; pallb = 256 + (rs + kt) * 64; }
      else { tokK = TLAT + b * 256 + (kt - 8) * 64; pallb = (kt - 8) * 64; }
      __syncthreads();
#pragma unroll
      for (int s = 0; s < 2; ++s) {
        const bf16_t* kg = p.kC + (size_t)(tokK + krow0) * 512 + (2 * hp + s) * 64 + kch0 * 8;
        const bf16_t* vg = p.vCT + ((size_t)(b * 8 + 2 * hp + s) * 64 + krow0) * PALL + pallb + kch0 * 8;
        uint4 k0 = *(const uint4*)kg, k1 = *(const uint4*)(kg + 32 * 512);
        uint4 v0 = *(const uint4*)vg, v1 = *(const uint4*)(vg + (size_t)32 * PALL);
        *(uint4*)(sK + s * 8192 + ksto) = k0;
        *(uint4*)(sK + s * 8192 + 4096 + ksto) = k1;
        char* d0 = sV + s * 8704 + vsto;
        *(uint2*)d0 = make_uint2(v0.x, v0.y);
        *(uint2*)(d0 + 8) = make_uint2(v0.z, v0.w);
        *(uint2*)(d0 + 32 * 136) = make_uint2(v1.x, v1.y);
        *(uint2*)(d0 + 32 * 136 + 8) = make_uint2(v1.z, v1.w);
      }
      __syncthreads();
      if (kt < 8) {
        NaMask mk;
        mk.bias = sBias + set * 465;
        mk.brow = rs + kt - row + 7;
        mk.wq = 32 * qhalf + r;
        mk.hh = hh;
        attn_tile(sK + set * 8192, sV + set * 8704, bq, O, m, l, r, hh, mk);
      } else {
        attn_tile(sK + set * 8192, sV + set * 8704, bq, O, m, l, r, hh, NoMask());
      }
    }
    attn_write_out(p.oC + (size_t)(qtok0 + 32 * qhalf + r) * 512 + head * 64, O, l, hh);
  }
}

__device__ __forceinline__ float log_sigmoidf_(float x) { return fminf(x, 0.f) - log1pf(__expf(-fabsf(x))); }
__device__ __forceinline__ void gla_prep(const Params& p, int layer, int hd, int dir, int tok0, float* sWg, float* sBc) {
  const int tid = tid_(), lane = tid & 63, w = tid >> 6;
  for (int i = tid; i < 1024; i += 256) {
    int rr = i >> 6, d = i & 63;
    sWg[i] = p.gla_wg[(((size_t)layer * 2 + dir) * 16 + rr) * 256 + hd * 64 + d];
  }
  __syncthreads();
  {
    int pos = tid >> 2, dg = tid & 3;
    float a[16];
    const float* ap = p.aB + (size_t)(tok0 + pos) * 32 + dir * 16;
#pragma unroll
    for (int i = 0; i < 4; ++i) {
      float4 t = *(const float4*)(ap + 4 * i);
      a[4 * i] = t.x; a[4 * i + 1] = t.y; a[4 * i + 2] = t.z; a[4 * i + 3] = t.w;
    }
    const float* bg = p.gla_bg + ((size_t)layer * 2 + dir) * 256 + hd * 64 + dg * 16;
#pragma unroll
    for (int dd = 0; dd < 16; ++dd) {
      float xv = bg[dd];
#pragma unroll
      for (int rr = 0; rr < 16; ++rr) xv += a[rr] * sWg[rr * 64 + dg * 16 + dd];
      sBc[pos * 65 + dg * 16 + dd] = log_sigmoidf_(xv) * (1.f / 16.f);
    }
  }
  __syncthreads();
  {
    const int idx = dir ? 63 - lane : lane;
#pragma unroll 1
    for (int dd = 0; dd < 16; ++dd) {
      int d = w * 16 + dd;
      float v = sBc[idx * 65 + d];
#pragma unroll
      for (int o = 1; o < 64; o <<= 1) {
        float t = __shfl_up(v, o);
        if (lane >= o) v += t;
      }
      sBc[idx * 65 + d] = v;
    }
  }
  __syncthreads();
}
__device__ __forceinline__ void chunk_pos(int b, int dir, int c, int& tok0, int& pall0) {
  if (c < 4) { int pc = dir ? 3 - c : c; tok0 = TLAT + b * 256 + pc * 64; pall0 = pc * 64; }
  else { int j = c - 4; int pc = dir ? 63 - j : j; tok0 = b * 4096 + pc * 64; pall0 = 256 + pc * 64; }
}
__device__ void phase_gla1(const Params& p, int layer, char* smem) {
  float* sWg = (float*)smem;
  float* sBc = (float*)(smem + 4096);
  bf16_t* sKt = (bf16_t*)(smem + 20736);
  bf16_t* sVt = (bf16_t*)(smem + 29952);
  const int tid = tid_(), lane = tid & 63, w = tid >> 6, r = lane & 31, hh = lane >> 5;
  for (int item = bid_(); item < 32 * NCHUNK; item += gridDim.x) {
    const int ch = item / NCHUNK, c = item % NCHUNK;
    const int dir = ch & 1, hd = (ch >> 1) & 3, b = ch >> 3;
    int tok0, pall0;
    chunk_pos(b, dir, c, tok0, pall0);
    __syncthreads();
    gla_prep(p, layer, hd, dir, tok0, sWg, sBc);
    {
      int pos = tid >> 2, dg = tid & 3;
      const bf16_t* kp = p.kB + (size_t)(tok0 + pos) * 256 + hd * 64 + dg * 16;
      uint4 k0 = *(const uint4*)kp, k1 = *(const uint4*)(kp + 8);
      unsigned ku[8] = {k0.x, k0.y, k0.z, k0.w, k1.x, k1.y, k1.z, k1.w};
#pragma unroll
      for (int e = 0; e < 16; ++e) {
        int d = dg * 16 + e;
        float kv = bf2f((bf16_t)((e & 1) ? (ku[e >> 1] >> 16) : (ku[e >> 1] & 0xffff)));
        float bend = sBc[(dir ? 0 : 63) * 65 + d];
        sKt[d * 72 + pos] = f2bf(kv * __expf(bend - sBc[pos * 65 + d]));
      }
      const bf16_t* vb = p.vBT + (size_t)(b * 4 + hd) * 128 * PALL + pall0;
#pragma unroll
      for (int i = 0; i < 4; ++i) {
        int q = tid + 256 * i, dv = q >> 3, cc = q & 7;
        *(uint4*)(sVt + dv * 72 + cc * 8) = *(const uint4*)(vb + (size_t)dv * PALL + cc * 8);
      }
      if (tid < 64) p.decay[(size_t)item * 64 + tid] = __expf(sBc[(dir ? 0 : 63) * 65 + tid]);
    }
    __syncthreads();
    f32x16 acc[2];
    acc[0] = zero16();
    acc[1] = zero16();
#pragma unroll
    for (int s = 0; s < 4; ++s) {
      bf16x8 a = *(const bf16x8*)(sVt + (32 * w + r) * 72 + 16 * s + 8 * hh);
      bf16x8 b0 = *(const bf16x8*)(sKt + r * 72 + 16 * s + 8 * hh);
      bf16x8 b1 = *(const bf16x8*)(sKt + (32 + r) * 72 + 16 * s + 8 * hh);
      acc[0] = mfma32(a, b0, acc[0]);
      acc[1] = mfma32(a, b1, acc[1]);
    }
    float* dst = p.KVt + (size_t)item * 8192;
#pragma unroll
    for (int jb = 0; jb < 2; ++jb)
#pragma unroll
      for (int g = 0; g < 16; ++g) {
        int dv = 32 * w + (g & 3) + 8 * (g >> 2) + 4 * hh;
        dst[dv * 64 + 32 * jb + r] = acc[jb][g];
      }
  }
}
__device__ void phase_gla2(const Params& p) {
  for (int idx = bid_() * 256 + tid_(); idx < 32 * 8192; idx += gridDim.x * 256) {
    const int ch = idx >> 13, e = idx & 8191;
    float S = 0.f;
    const float* kv = p.KVt + (size_t)ch * NCHUNK * 8192 + e;
    const float* dc = p.decay + (size_t)ch * NCHUNK * 64 + (e & 63);
    bf16_t* sp = p.SP + (size_t)ch * NCHUNK * 8192 + e;
#pragma unroll 4
    for (int c = 0; c < NCHUNK; ++c) {
      sp[(size_t)c * 8192] = f2bf(S);
      S = dc[c * 64] * S + kv[(size_t)c * 8192];
    }
  }
}
__device__ void phase_gla3(const Params& p, int layer, char* smem) {
  float* sWg = (float*)smem;
  float* sBc = (float*)(smem + 4096);
  bf16_t* sQ = (bf16_t*)(smem + 20736);
  bf16_t* sK = (bf16_t*)(smem + 29952);
  bf16_t* sVt = (bf16_t*)(smem + 39168);
  float* sRed = (float*)(smem + 57600);
  const int tid = tid_(), lane = tid & 63, w = tid >> 6, r = lane & 31, hh = lane >> 5;
  const int npc = layer == 0 ? 68 : 64;
  for (int item = bid_(); item < 16 * npc; item += gridDim.x) {
    const int bh = item / npc;
    const int pca = (layer == 0) ? (item % npc) : (4 + item % npc);
    const int b = bh >> 2, hd = bh & 3;
    int tok0, pall0;
    chunk_pos(b, 0, pca, tok0, pall0);
    f32x16 O[2];
    O[0] = zero16();
    O[1] = zero16();
    __syncthreads();
    {
      const bf16_t* vb = p.vBT + (size_t)(b * 4 + hd) * 128 * PALL + pall0;
#pragma unroll
      for (int i = 0; i < 4; ++i) {
        int q = tid + 256 * i, dv = q >> 3, cc = q & 7;
        *(uint4*)(sVt + dv * 72 + cc * 8) = *(const uint4*)(vb + (size_t)dv * PALL + cc * 8);
      }
    }
#pragma unroll 1
    for (int dir = 0; dir < 2; ++dir) {
      __syncthreads();
      gla_prep(p, layer, hd, dir, tok0, sWg, sBc);
      {
        int pos = tid >> 2, dg = tid & 3;
        const bf16_t* qp = p.qB + (size_t)(tok0 + pos) * 256 + hd * 64 + dg * 16;
        const bf16_t* kp = p.kB + (size_t)(tok0 + pos) * 256 + hd * 64 + dg * 16;
        uint4 q0 = *(const uint4*)qp, q1 = *(const uint4*)(qp + 8);
        uint4 k0 = *(const uint4*)kp, k1 = *(const uint4*)(kp + 8);
        unsigned qu[8] = {q0.x, q0.y, q0.z, q0.w, q1.x, q1.y, q1.z, q1.w};
        unsigned ku[8] = {k0.x, k0.y, k0.z, k0.w, k1.x, k1.y, k1.z, k1.w};
        unsigned qo[8], ko[8];
#pragma unroll
        for (int e2 = 0; e2 < 8; ++e2) {
          float b0 = sBc[pos * 65 + dg * 16 + 2 * e2], b1 = sBc[pos * 65 + dg * 16 + 2 * e2 + 1];
          float ea0 = __expf(b0), ea1 = __expf(b1);
          qo[e2] = pack2(bf2f((bf16_t)(qu[e2] & 0xffff)) * ea0, bf2f((bf16_t)(qu[e2] >> 16)) * ea1);
          ko[e2] = pack2(bf2f((bf16_t)(ku[e2] & 0xffff)) / ea0, bf2f((bf16_t)(ku[e2] >> 16)) / ea1);
        }
        *(uint4*)(sQ + pos * 72 + dg * 16) = make_uint4(qo[0], qo[1], qo[2], qo[3]);
        *(uint4*)(sQ + pos * 72 + dg * 16 + 8) = make_uint4(qo[4], qo[5], qo[6], qo[7]);
        *(uint4*)(sK + pos * 72 + dg * 16) = make_uint4(ko[0], ko[1], ko[2], ko[3]);
        *(uint4*)(sK + pos * 72 + dg * 16 + 8) = make_uint4(ko[4], ko[5], ko[6], ko[7]);
      }
      __syncthreads();
      int c;
      if (pca < 4) c = dir ? 3 - pca : pca;
      else c = dir ? 4 + (63 - (pca - 4)) : pca;
      const int ch = (b * 4 + hd) * 2 + dir;
      const bf16_t* sp = p.SP + ((size_t)ch * NCHUNK + c) * 8192 + (size_t)(32 * w + r) * 64 + 8 * hh;
      bf16x8 bqf[2][4];
#pragma unroll
      for (int tb = 0; tb < 2; ++tb)
#pragma unroll
        for (int ks = 0; ks < 4; ++ks) bqf[tb][ks] = *(const bf16x8*)(sQ + (32 * tb + r) * 72 + 16 * ks + 8 * hh);
#pragma unroll
      for (int ks = 0; ks < 4; ++ks) {
        bf16x8 a = *(const bf16x8*)(sp + 16 * ks);
        O[0] = mfma32(a, bqf[0][ks], O[0]);
        O[1] = mfma32(a, bqf[1][ks], O[1]);
      }
#pragma unroll
      for (int sb = 0; sb < 2; ++sb)
#pragma unroll
        for (int tb = 0; tb < 2; ++tb) {
          const bool skip = dir == 0 ? (sb == 1 && tb == 0) : (sb == 0 && tb == 1);
          if (skip) continue;
          f32x16 Sc = zero16();
#pragma unroll
          for (int ks = 0; ks < 4; ++ks) {
            bf16x8 a = *(const bf16x8*)(sK + (32 * sb + r) * 72 + 16 * ks + 8 * hh);
            Sc = mfma32(a, bqf[tb][ks], Sc);
          }
          const int t = 32 * tb + r;
#pragma unroll
          for (int g = 0; g < 16; ++g) {
            int s = 32 * sb + (g & 3) + 8 * (g >> 2) + 4 * hh;
            bool keep = dir == 0 ? (t >= s) : (s >= t);
            Sc[g] = keep ? Sc[g] : 0.f;
          }
#pragma unroll
          for (int s2 = 0; s2 < 2; ++s2) {
            const int sp4 = 2 * sb + s2;
            bf16x8 bp;
#pragma unroll
            for (int j = 0; j < 8; ++j) bp[j] = (short)f2bf(Sc[8 * s2 + j]);
            const char* vp = (const char*)(sVt + (32 * w + r) * 72) + (16 * sp4 + 4 * hh) * 2;
            bf16x4 lo = *(const bf16x4*)vp;
            bf16x4 hi = *(const bf16x4*)(vp + 16);
            bf16x8 av = __builtin_shufflevector(lo, hi, 0, 1, 2, 3, 4, 5, 6, 7);
            O[tb] = mfma32(av, bp, O[tb]);
          }
        }
    }
    float ss[2];
#pragma unroll
    for (int tb = 0; tb < 2; ++tb) {
      float s = 0.f;
#pragma unroll
      for (int g = 0; g < 16; ++g) s += O[tb][g] * O[tb][g];
      s += __shfl_xor(s, 32);
      ss[tb] = s;
    }
    if (hh == 0) { sRed[w * 64 + r] = ss[0]; sRed[w * 64 + 32 + r] = ss[1]; }
    __syncthreads();
#pragma unroll
    for (int tb = 0; tb < 2; ++tb) {
      int t = 32 * tb + r;
      float tot = sRed[t] + sRed[64 + t] + sRed[128 + t] + sRed[192 + t];
      float rstd = rsqrtf(tot * (1.f / 128.f) + 1e-6f);
      const int tok = tok0 + t;
#pragma unroll
      for (int g4 = 0; g4 < 4; ++g4) {
        int dv = 32 * w + 8 * g4 + 4 * hh;
        uint2 rr = *(const uint2*)(p.rB + (size_t)tok * 512 + hd * 128 + dv);
        float rg[4] = {bf2f((bf16_t)(rr.x & 0xffff)), bf2f((bf16_t)(rr.x >> 16)), bf2f((bf16_t)(rr.y & 0xffff)), bf2f((bf16_t)(rr.y >> 16))};
        float o[4];
#pragma unroll
        for (int e = 0; e < 4; ++e) o[e] = O[tb][4 * g4 + e] * rstd * p.gla_norm[layer * 128 + dv + e] * siluf(rg[e]);
        *(uint2*)(p.oB + (size_t)tok * 512 + hd * 128 + dv) = make_uint2(pack2(o[0], o[1]), pack2(o[2], o[3]));
      }
    }
  }
}

#define PHASE_KERNEL(name, call)                                               \
  __global__ void __launch_bounds__(256, 2) name(Params p, int layer) {        \
    __shared__ __attribute__((aligned(16))) char smem[SMEM_BYTES];             \
    call;                                                                      \
  }
PHASE_KERNEL(k_setup, phase_setup(p, smem))
PHASE_KERNEL(k_modreduce, phase_modreduce(p))
PHASE_KERNEL(k_convert, phase_convert(p, layer, smem))
PHASE_KERNEL(k_rowpass0, phase_rowpass0(p))
PHASE_KERNEL(k_inproj, phase_inproj(p, layer, smem))
PHASE_KERNEL(k_attnA, phase_attnA(p, layer, smem))
PHASE_KERNEL(k_na, phase_na(p, layer, smem))
PHASE_KERNEL(k_gla1, phase_gla1(p, layer, smem))
PHASE_KERNEL(k_gla2, phase_gla2(p))
PHASE_KERNEL(k_gla3, phase_gla3(p, layer, smem))
PHASE_KERNEL(k_merge, phase_merge(p, layer, smem))
PHASE_KERNEL(k_outproj, phase_outproj(p, layer, smem))
PHASE_KERNEL(k_rowpass1, phase_rowpass1(p, layer, smem))
PHASE_KERNEL(k_moe1, phase_moe1(p, layer, smem))
PHASE_KERNEL(k_moe2, phase_moe2(p, layer, smem))
PHASE_KERNEL(k_rowpass2, phase_rowpass2(p, layer))

__global__ void __launch_bounds__(256, 2) k_mega(Params p) {
  __shared__ __attribute__((aligned(16))) char smem[SMEM_BYTES];
  cg::grid_group grid = cg::this_grid();
  phase_setup(p, smem);
  phase_convert(p, 0, smem);
  grid.sync();
  phase_modreduce(p);
  grid.sync();
  phase_rowpass0(p);
  grid.sync();
#pragma unroll 1
  for (int l = 0; l < 2; ++l) {
    phase_inproj(p, l, smem);
    grid.sync();
    phase_gla1(p, l, smem);
    phase_na(p, l, smem);
    grid.sync();
    phase_gla2(p);
    phase_attnA(p, l, smem);
    grid.sync();
    phase_gla3(p, l, smem);
    grid.sync();
    phase_merge(p, l, smem);
    grid.sync();
    phase_outproj(p, l, smem);
    grid.sync();
    phase_rowpass1(p, l, smem);
    grid.sync();
    phase_moe1(p, l, smem);
    grid.sync();
    phase_moe2(p, l, smem);
    grid.sync();
    phase_rowpass2(p, l);
    if (l == 0) {
      phase_convert(p, 1, smem);
      grid.sync();
    }
  }
}

static inline size_t align_up(size_t v, size_t a) { return (v + a - 1) / a * a; }

extern "C" void kernel_launch(void* const* d_in, const int* in_sizes, int n_in, void* d_out, int out_size, void* d_ws, size_t ws_size,
                              hipStream_t stream) {
  Params p{};
  const float* const* in = (const float* const*)d_in;
  p.x = in[0]; p.c = in[1]; p.ctx = in[2]; p.c_ctx = in[3]; p.w_mod = in[4]; p.b_mod = in[5]; p.w_in = in[6]; p.b_in = in[7];
  p.q_norm = in[8]; p.k_norm = in[9]; p.gla_wg = in[10]; p.gla_bg = in[11]; p.gla_norm = in[12]; p.rpb = in[13];
  p.w_br_attn = in[14]; p.w_br_gla = in[15]; p.w_br_na = in[16]; p.w_out = in[17]; p.ln1_g = in[18]; p.ln1_b = in[19];
  p.w_rg = in[20]; p.b_rg = in[21]; p.w_re = in[22]; p.b_re = in[23]; p.w1 = in[24]; p.w3 = in[25]; p.w2 = in[26];
  p.ln2_g = in[27]; p.ln2_b = in[28];
  p.out = (float*)d_out;

  char* base = (char*)d_ws;
  size_t off = 0;
  auto take = [&](size_t bytes) { char* q = base + off; off = align_up(off + bytes, 256); return q; };
  p.mod_part = (float*)take((size_t)16 * 2 * 5 * NMOD * 4);
  p.mod = (float*)take((size_t)2 * 5 * NMOD * 4);
  p.rope = (float*)take(2048 * 4);
  p.cnt = (int*)take(32 * 4);
  p.estart = (int*)take(32 * 4);
  p.list = (int*)take((size_t)32 * MOE_CAP * 4);
  p.tok_e = (int*)take((size_t)TALL * 2 * 4);
  p.tok_pos = (int*)take((size_t)TALL * 2 * 4);
  p.tok_gate = (float*)take((size_t)TALL * 2 * 4);
  p.wt_in = (bf16_t*)take((size_t)3968 * 1024 * 2);
  p.wt_gate = (bf16_t*)take((size_t)3072 * 1024 * 2);
  p.wt_br = (bf16_t*)take((size_t)3 * 1024 * 512 * 2);
  p.wt_out = (bf16_t*)take((size_t)1024 * 1024 * 2);
  p.wt_13 = (bf16_t*)take((size_t)32 * 1024 * 1024 * 2);
  p.wt_2 = (bf16_t*)take((size_t)32 * 1024 * 512 * 2);
  p.xres = (float*)take((size_t)TALL * D * 4);
  p.h = (bf16_t*)take((size_t)TALL * D * 2);
  size_t r1 = off;
  p.qA = (bf16_t*)take((size_t)TALL * 512 * 2);
  p.kA = (bf16_t*)take((size_t)4 * 2 * PALL * 64 * 2);
  p.vAT = (bf16_t*)take((size_t)4 * 2 * 64 * PALL * 2);
  p.qB = (bf16_t*)take((size_t)TALL * 256 * 2);
  p.kB = (bf16_t*)take((size_t)TALL * 256 * 2);
  p.vBT = (bf16_t*)take((size_t)4 * 4 * 128 * PALL * 2);
  p.rB = (bf16_t*)take((size_t)TALL * 512 * 2);
  p.aB = (float*)take((size_t)TALL * 32 * 4);
  p.qC = (bf16_t*)take((size_t)TALL * 512 * 2);
  p.kC = (bf16_t*)take((size_t)TALL * 512 * 2);
  p.vCT = (bf16_t*)take((size_t)4 * 8 * 64 * PALL * 2);
  p.oA = (bf16_t*)take((size_t)TALL * 512 * 2);
  p.oB = (bf16_t*)take((size_t)TALL * 512 * 2);
  p.oC = (bf16_t*)take((size_t)TALL * 512 * 2);
  size_t r1_end = off;
  {
    size_t o2 = r1;
    p.act = (bf16_t*)(base + o2); o2 = align_up(o2 + (size_t)MAX_MBLK * 128 * 512 * 2, 256);
    p.ysl = (bf16_t*)(base + o2); o2 = align_up(o2 + (size_t)MAX_MBLK * 128 * 1024 * 2, 256);
    if (o2 > r1_end) off = o2;
  }
  p.KVt = (float*)take((size_t)32 * NCHUNK * 8192 * 4);
  p.SP = (bf16_t*)take((size_t)32 * NCHUNK * 8192 * 2);
  p.decay = (float*)take((size_t)32 * NCHUNK * 64 * 4);
  p.m = (bf16_t*)p.KVt;
  p.h2 = p.SP;
  if (off > ws_size) {
    fprintf(stderr, "workspace too small: need %zu have %zu\n", off, ws_size);
    return;
  }
  const dim3 blk(256);
#ifdef MK_MULTI
  const int G = 1024;
  k_setup<<<769, blk, 0, stream>>>(p, 0);
  k_convert<<<2048, blk, 0, stream>>>(p, 0);
  k_modreduce<<<240, blk, 0, stream>>>(p, 0);
  k_rowpass0<<<G, blk, 0, stream>>>(p, 0);
  for (int l = 0; l < 2; ++l) {
    k_inproj<<<G, blk, 0, stream>>>(p, l);
    k_gla1<<<G, blk, 0, stream>>>(p, l);
    k_na<<<1088, blk, 0, stream>>>(p, l);
    k_gla2<<<G, blk, 0, stream>>>(p, l);
    k_attnA<<<1088, blk, 0, stream>>>(p, l);
    k_gla3<<<1088, blk, 0, stream>>>(p, l);
    k_merge<<<G, blk, 0, stream>>>(p, l);
    k_outproj<<<G, blk, 0, stream>>>(p, l);
    k_rowpass1<<<G, blk, 0, stream>>>(p, l);
    k_moe1<<<G, blk, 0, stream>>>(p, l);
    k_moe2<<<G, blk, 0, stream>>>(p, l);
    k_rowpass2<<<G, blk, 0, stream>>>(p, l);
    if (l == 0) k_convert<<<2048, blk, 0, stream>>>(p, 1);
  }
#else
  static int grid_blocks = 0;
  if (!grid_blocks) {
    int dev = 0, cus = 0, per_cu = 0;
    hipGetDevice(&dev);
    hipDeviceGetAttribute(&cus, hipDeviceAttributeMultiprocessorCount, dev);
    hipOccupancyMaxActiveBlocksPerMultiprocessor(&per_cu, k_mega, 256, 0);
    if (per_cu > 2) per_cu = 2;
    grid_blocks = cus * per_cu;
  }
  void* args[] = {&p};
  hipError_t e = hipLaunchCooperativeKernel((void*)k_mega, dim3(grid_blocks), blk, args, 0, stream);
  if (e != hipSuccess) fprintf(stderr, "cooperative launch failed: %s (grid %d)\n", hipGetErrorString(e), grid_blocks);
#endif
}
```

```cpp
#include <hip/hip_runtime.h>
#include <hip/hip_cooperative_groups.h>
#include <stdint.h>
#include <stdio.h>
namespace cg = cooperative_groups;

typedef unsigned short bf16_t;
typedef __attribute__((ext_vector_type(8))) short bf16x8;
typedef __attribute__((ext_vector_type(4))) short bf16x4;
typedef __attribute__((ext_vector_type(16))) float f32x16;
typedef __attribute__((ext_vector_type(4))) unsigned u32x4;
typedef __attribute__((ext_vector_type(4))) float f32x4v;

#ifndef XCD_MAP_ENABLE
#define XCD_MAP_ENABLE 0
#endif
constexpr int D = 1024;
constexpr int TLAT = 16384, TCTX = 1024, TALL = 17408, PALL = 4352;
constexpr int NIN_SRC = 6944, NMOD = 6144;
constexpr int NT_IN = 31;
constexpr int SMEM_BYTES = 69632;
constexpr int LDC = 132;
constexpr float LOG2E = 1.4426950408889634f;
constexpr float QSCALE = 0.125f * LOG2E;
constexpr float ALPHA = 1.4142135623730951f;
constexpr int NCHUNK = 68;
constexpr int MOE_CAP = TALL;
constexpr int MOE_BLK = 256;
constexpr int MAX_MBLK = 168;

struct Params {
  const float *x, *c, *ctx, *c_ctx, *w_mod, *b_mod, *w_in, *b_in, *q_norm, *k_norm, *gla_wg, *gla_bg, *gla_norm, *rpb,
      *w_br_attn, *w_br_gla, *w_br_na, *w_out, *ln1_g, *ln1_b, *w_rg, *b_rg, *w_re, *b_re, *w1, *w3, *w2, *ln2_g, *ln2_b;
  float* out;
  float *mod_part, *mod, *rope, *wrp;
  bf16_t *wt_in, *wt_gate, *wt_br, *wt_out, *wt_13, *wt_2, *G;
  float* xres;
  bf16_t *h, *h2;
  bf16_t *qA, *kA, *vAT, *qB, *kB, *vBT, *rB;
  float* aB;
  bf16_t *qC, *kC, *vCT;
  bf16_t *oA, *oB, *oC;
  float* KVt;
  float* bcum;
  bf16_t* SP;
  float* decay;
  bf16_t* m;
  bf16_t *act, *ysl;
  int *cnt, *cntg, *list, *tok_e, *tok_pos, *estart;
  float* tok_gate;
  unsigned* bar;
};

typedef const __attribute__((address_space(4))) Params& PRef;
__device__ __forceinline__ PRef params_view() {
  const __attribute__((address_space(4))) Params* pp = (const __attribute__((address_space(4))) Params*)__builtin_amdgcn_kernarg_segment_ptr();
  asm volatile("" : "+s"(pp));
  return *pp;
}

__device__ __forceinline__ int tid_() { int t = __builtin_amdgcn_workitem_id_x() & 255; asm volatile("" : "+v"(t)); return t; }
__device__ __forceinline__ int half_() { int h = __builtin_amdgcn_readfirstlane(__builtin_amdgcn_workitem_id_x() >> 8); asm volatile("" : "+s"(h)); return h; }
__device__ __forceinline__ int bid_() { int t = 2 * __builtin_amdgcn_workgroup_id_x() + half_(); asm volatile("" : "+s"(t)); return t; }
__device__ __forceinline__ int vgrid_() { return 2 * (int)gridDim.x; }
typedef __attribute__((ext_vector_type(2))) __bf16 bf16x2n;
typedef __attribute__((ext_vector_type(2))) float f32x2n;
__device__ __forceinline__ bf16_t f2bf(float f) { return __builtin_bit_cast(bf16_t, (__bf16)f); }
__device__ __forceinline__ float bf2f(bf16_t b) { return __uint_as_float(((unsigned)b) << 16); }
__device__ __forceinline__ unsigned pack2(float a, float b) {
  f32x2n v = {a, b};
  return __builtin_bit_cast(unsigned, __builtin_convertvector(v, bf16x2n));
}
__device__ __forceinline__ float wave_sum(float v) {
  int x;
  x = __builtin_amdgcn_update_dpp(0, __float_as_int(v), 0xB1, 0xf, 0xf, true);  v += __int_as_float(x);
  x = __builtin_amdgcn_update_dpp(0, __float_as_int(v), 0x4E, 0xf, 0xf, true);  v += __int_as_float(x);
  x = __builtin_amdgcn_update_dpp(0, __float_as_int(v), 0x141, 0xf, 0xf, true); v += __int_as_float(x);
  x = __builtin_amdgcn_update_dpp(0, __float_as_int(v), 0x140, 0xf, 0xf, true); v += __int_as_float(x);
  x = __builtin_amdgcn_update_dpp(0, __float_as_int(v), 0x142, 0xa, 0xf, false); v += __int_as_float(x);
  x = __builtin_amdgcn_update_dpp(0, __float_as_int(v), 0x143, 0xc, 0xf, false); v += __int_as_float(x);
  return __int_as_float(__builtin_amdgcn_readlane(__float_as_int(v), 63));
}
__device__ __forceinline__ float siluf(float x) { return x * __builtin_amdgcn_rcpf(1.f + __expf(-x)); }
__device__ __forceinline__ float sigmoidf_(float x) { return __builtin_amdgcn_rcpf(1.f + __expf(-x)); }
__device__ __forceinline__ f32x16 zero16() {
  f32x16 z;
#pragma unroll
  for (int i = 0; i < 16; ++i) z[i] = 0.f;
  return z;
}
__device__ __forceinline__ f32x16 mfma32(bf16x8 a, bf16x8 b, f32x16 c) {
  return __builtin_amdgcn_mfma_f32_32x32x16_bf16(a, b, c, 0, 0, 0);
}
__device__ __forceinline__ int tok_modrow(int tok) { return tok < TLAT ? (tok >> 12) : 4; }

__device__ __forceinline__ void phase_setup(PRef p, char* smem) {
  float* sS = (float*)smem;
  const int tid = tid_();
  for (int item = bid_(); item < 769 + 96; item += vgrid_()) {
    if (item >= 769) {
      int it = item - 769;
      int l = it / 48, chunk = it % 48;
      for (int i = tid; i < 1024; i += 256) {
        int idx = chunk * 1024 + i;
        int e = idx & 3, ln = (idx >> 2) & 63, t = (idx >> 8) & 63, nt = idx >> 14;
        int k = 16 * t + 4 * (ln >> 4) + e, n = 16 * nt + (ln & 15);
        float v = 0.f;
        if (n < 32) v = p.w_re[((size_t)l * 1024 + k) * 32 + n];
        else if (n < 36) v = p.w_rg[((size_t)l * 1024 + k) * 4 + (n - 32)];
        p.wrp[(size_t)l * 49152 + idx] = v;
      }
      continue;
    }
    if (item == 768) {
      for (int i = tid; i < 1024; i += 256) {
        int pos = i >> 4, f = i & 15;
        float inv = powf(10000.f, -(float)f / 16.f);
        float ang = (float)pos * inv;
        p.rope[i] = cosf(ang);
        p.rope[1024 + i] = sinf(ang);
      }
      continue;
    }
    int nb = item % 24, ks = (item / 24) % 16, l = item / 384;
    __syncthreads();
    for (int i = tid; i < 320; i += 256) {
      int r = i >> 6, k = ks * 64 + (i & 63);
      float cv = (r < 4) ? p.c[r * 1024 + k] : p.c_ctx[k];
      sS[i] = siluf(cv);
    }
    __syncthreads();
    int n = nb * 256 + tid;
    const float* w = p.w_mod + ((size_t)l * 1024 + ks * 64) * NMOD + n;
    float acc[5] = {0.f, 0.f, 0.f, 0.f, 0.f};
#pragma unroll 8
    for (int k = 0; k < 64; ++k) {
      float wv = w[(size_t)k * NMOD];
#pragma unroll
      for (int r = 0; r < 5; ++r) acc[r] += sS[r * 64 + k] * wv;
    }
#pragma unroll
    for (int r = 0; r < 5; ++r) p.mod_part[(((size_t)ks * 2 + l) * 5 + r) * NMOD + n] = acc[r];
  }
}
__device__ __forceinline__ void phase_modreduce(PRef p) {
  for (int i = bid_() * 256 + tid_(); i < 2 * 5 * NMOD; i += vgrid_() * 256) {
    int n = i % NMOD, l = i / (5 * NMOD);
    float s = p.b_mod[l * NMOD + n];
#pragma unroll
    for (int ks = 0; ks < 16; ++ks) s += p.mod_part[(size_t)ks * 2 * 5 * NMOD + i];
    p.mod[i] = s;
  }
}

constexpr int CV_IN = 16 * 62, CV_GATE = 16 * 48, CV_BR = 8 * 16, CV_OUT = 16 * 16, CV_13 = 16 * 16, CV_2 = 8 * 16;
constexpr int CV_O1 = CV_IN, CV_O2 = CV_O1 + CV_GATE, CV_O3 = CV_O2 + 3 * CV_BR, CV_O4 = CV_O3 + CV_OUT, CV_O5 = CV_O4 + 32 * CV_13,
              CV_TOTAL = CV_O5 + 32 * CV_2;
struct ConvDesc { const float* src; int ldsrc; int ncols; bf16_t* dst; int lddst; };
__device__ __forceinline__ ConvDesc conv_desc(PRef p, int layer, int item) {
  ConvDesc d;
  d.ncols = 64;
  if (item < CV_O1) {
    int kt = item & 15, ntile = item >> 4;
    int n0 = ntile * 64, srccol;
    if (n0 < 2304) srccol = n0;
    else if (n0 < 3840) srccol = n0 + 32;
    else if (n0 == 3840) { srccol = 2304; d.ncols = 32; }
    else { srccol = 0; d.ncols = 0; }
    d.src = p.w_in + (size_t)layer * 1024 * NIN_SRC + (size_t)(kt * 64) * NIN_SRC + srccol; d.ldsrc = NIN_SRC;
    d.dst = p.wt_in + (size_t)n0 * 1024 + kt * 64; d.lddst = 1024;
  } else if (item < CV_O2) {
    int it = item - CV_O1, kt = it & 15, ntile = it >> 4;
    d.src = p.w_in + (size_t)layer * 1024 * NIN_SRC + (size_t)(kt * 64) * NIN_SRC + 3872 + ntile * 64; d.ldsrc = NIN_SRC;
    d.dst = p.wt_gate + (size_t)(ntile * 64) * 1024 + kt * 64; d.lddst = 1024;
  } else if (item < CV_O3) {
    int it = item - CV_O2, br = it / CV_BR, t = it % CV_BR, kt = t & 7, ntile = t >> 3;
    const float* s0 = (br == 0 ? p.w_br_attn : (br == 1 ? p.w_br_gla : p.w_br_na)) + (size_t)layer * 512 * 1024;
    d.src = s0 + (size_t)(kt * 64) * 1024 + ntile * 64; d.ldsrc = 1024;
    d.dst = p.wt_br + (size_t)br * 1024 * 512 + (size_t)(ntile * 64) * 512 + kt * 64; d.lddst = 512;
  } else if (item < CV_O4) {
    int it = item - CV_O3, kt = it & 15, ntile = it >> 4;
    d.src = p.w_out + (size_t)layer * 1024 * 1024 + (size_t)(kt * 64) * 1024 + ntile * 64; d.ldsrc = 1024;
    d.dst = p.wt_out + (size_t)(ntile * 64) * 1024 + kt * 64; d.lddst = 1024;
  } else if (item < CV_O5) {
    int it = item - CV_O4, e = it >> 8, t = it & 255, kt = t & 15, ntile = t >> 4;
    int j = ntile >> 1, isw3 = ntile & 1;
    d.src = (isw3 ? p.w3 : p.w1) + ((size_t)layer * 32 + e) * 1024 * 512 + (size_t)(kt * 64) * 512 + j * 64; d.ldsrc = 512;
    d.dst = p.wt_13 + (size_t)e * 1024 * 1024 + (size_t)(ntile * 64) * 1024 + kt * 64; d.lddst = 1024;
  } else {
    int it = item - CV_O5, e = it >> 7, t = it & 127, kt = t & 7, ntile = t >> 3;
    d.src = p.w2 + ((size_t)layer * 32 + e) * 512 * 1024 + (size_t)(kt * 64) * 1024 + ntile * 64; d.ldsrc = 1024;
    d.dst = p.wt_2 + (size_t)e * 1024 * 512 + (size_t)(ntile * 64) * 512 + kt * 64; d.lddst = 512;
  }
  return d;
}
__device__ __forceinline__ void conv_load8(const ConvDesc& d, int nhalf, int lane, f32x4v (&v)[8]) {
  const int kb = lane >> 3, c0 = nhalf * 32 + (lane & 7) * 4;
  const float* sp = d.src + (size_t)(kb * 8) * d.ldsrc + c0;
  const bool ok = c0 < d.ncols;
#pragma unroll
  for (int j = 0; j < 8; ++j) {
    f32x4v z = {0.f, 0.f, 0.f, 0.f};
    v[j] = ok ? *(const f32x4v*)(sp + (size_t)j * d.ldsrc) : z;
  }
}
__device__ __forceinline__ void phase_convert(PRef p, int layer_part, char* smem) {
  const int tid = tid_(), lane = tid & 63, w = tid >> 6;
  const int layer = layer_part & 15, part = layer_part >> 4;
  const int begin = part ? CV_O4 : 0, ntiles = part ? (CV_TOTAL - CV_O4) : CV_O4;
  const int nw = vgrid_() * 4;
  int wt = bid_() * 4 + w;
  if (wt >= 2 * ntiles) return;
  ConvDesc d0 = conv_desc(p, layer, begin + (wt >> 1));
  f32x4v v0[8], v1[8];
  conv_load8(d0, wt & 1, lane, v0);
  for (;;) {
    const int nwt = wt + nw;
    const bool more = nwt < 2 * ntiles;
    ConvDesc d1 = d0;
    if (more) { d1 = conv_desc(p, layer, begin + (nwt >> 1)); conv_load8(d1, nwt & 1, lane, v1); }
    {
      const int kb = lane >> 3, c0 = (wt & 1) * 32 + (lane & 7) * 4;
      bf16_t* dp = d0.dst + (size_t)c0 * d0.lddst + kb * 8;
#pragma unroll
      for (int c = 0; c < 4; ++c) {
        const uint4 o = make_uint4(pack2(v0[0][c], v0[1][c]), pack2(v0[2][c], v0[3][c]), pack2(v0[4][c], v0[5][c]), pack2(v0[6][c], v0[7][c]));
        *(uint4*)(dp + (size_t)c * d0.lddst) = o;
      }
    }
    if (!more) break;
    wt = nwt;
    d0 = d1;
#pragma unroll
    for (int j = 0; j < 8; ++j) v0[j] = v1[j];
  }
}

__device__ __forceinline__ void row_stats(const float (&v)[16], float& mean, float& rstd) {
  float s = 0.f;
#pragma unroll
  for (int i = 0; i < 16; ++i) s += v[i];
  mean = wave_sum(s) * (1.f / 1024.f);
  float q = 0.f;
#pragma unroll
  for (int i = 0; i < 16; ++i) { float d = v[i] - mean; q += d * d; }
  float var = wave_sum(q) * (1.f / 1024.f);
  rstd = rsqrtf(var + 1e-6f);
}
__device__ __forceinline__ void load_row(const float* src, int lane, float (&v)[16]) {
#pragma unroll
  for (int i = 0; i < 4; ++i) {
    float4 t = *(const float4*)(src + lane * 4 + 256 * i);
    v[4 * i] = t.x; v[4 * i + 1] = t.y; v[4 * i + 2] = t.z; v[4 * i + 3] = t.w;
  }
}
__device__ __forceinline__ void store_row(float* dst, int lane, const float (&v)[16]) {
#pragma unroll
  for (int i = 0; i < 4; ++i) *(float4*)(dst + lane * 4 + 256 * i) = make_float4(v[4 * i], v[4 * i + 1], v[4 * i + 2], v[4 * i + 3]);
}
__device__ __forceinline__ void store_row_bf(bf16_t* dst, int lane, const float (&v)[16]) {
#pragma unroll
  for (int i = 0; i < 4; ++i) {
    uint2 o = make_uint2(pack2(v[4 * i], v[4 * i + 1]), pack2(v[4 * i + 2], v[4 * i + 3]));
    *(uint2*)(dst + lane * 4 + 256 * i) = o;
  }
}
__device__ __forceinline__ void modulate_row(const float (&x)[16], const float* shift, const float* scale, int lane, float (&h)[16]) {
  float mean, rstd;
  row_stats(x, mean, rstd);
  float sh[16], sc[16];
  load_row(shift, lane, sh);
  load_row(scale, lane, sc);
#pragma unroll
  for (int i = 0; i < 16; ++i) h[i] = (x[i] - mean) * rstd * (1.f + sc[i]) + sh[i];
}

__device__ __forceinline__ void phase_rowpass0(PRef p) {
  const int lane = tid_() & 63, w = tid_() >> 6;
  for (int tok = bid_() * 4 + w; tok < TALL; tok += vgrid_() * 4) {
    const float* src = tok < TLAT ? p.x + (size_t)tok * D : p.ctx + (size_t)(tok - TLAT) * D;
    const float* md = p.mod + (size_t)tok_modrow(tok) * NMOD;
    float x[16], h[16];
    load_row(src, lane, x);
    modulate_row(x, md, md + 1024, lane, h);
    store_row_bf(p.h + (size_t)tok * D, lane, h);
  }
}

typedef __attribute__((ext_vector_type(4))) float f32x4;
__device__ __forceinline__ void phase_rowpass1(PRef p, int layer, char* smem) {
  float* sH = (float*)smem;
  float* sPart = (float*)smem;
  int* sE = (int*)(smem + 16384);
  const int tid = tid_(), lane = tid & 63, w = tid >> 6;
  const int ntok = layer == 0 ? TALL : TLAT;
  const float* lg = p.ln1_g + layer * D;
  const float* lb = p.ln1_b + layer * D;
  const float* wrp = p.wrp + (size_t)layer * 49152;
  for (int g0 = bid_() * 16; g0 < ntok; g0 += vgrid_() * 16) {
    __syncthreads();
    {
      float v[4][16];
#pragma unroll
      for (int rr = 0; rr < 4; ++rr) load_row(p.xres + (size_t)(g0 + w * 4 + rr) * D, lane, v[rr]);
      float gg[16], bb[16];
      load_row(lg, lane, gg);
      load_row(lb, lane, bb);
#pragma unroll
      for (int rr = 0; rr < 4; ++rr) {
        const int tok = g0 + w * 4 + rr;
        float mean, rstd;
        row_stats(v[rr], mean, rstd);
        float x1[16], h2[16];
#pragma unroll
        for (int i = 0; i < 16; ++i) x1[i] = (v[rr][i] - mean) * rstd * gg[i] + bb[i];
        store_row(p.xres + (size_t)tok * D, lane, x1);
        const float* md = p.mod + ((size_t)layer * 5 + tok_modrow(tok)) * NMOD;
        modulate_row(x1, md + 3072, md + 4096, lane, h2);
        store_row_bf(p.h2 + (size_t)tok * D, lane, h2);
        store_row(sH + (w * 4 + rr) * 1028, lane, h2);
      }
    }
    __syncthreads();
    f32x4 acc0 = {0.f, 0.f, 0.f, 0.f}, acc1 = acc0, acc2 = acc0;
    {
      const float* ap = sH + (lane & 15) * 1028 + 4 * (lane >> 4) + 256 * w;
      const float* bp = wrp + (size_t)(16 * w) * 256 + lane * 4;
#pragma unroll 8
      for (int t = 0; t < 16; ++t) {
        float4 a = *(const float4*)(ap + 16 * t);
        float4 b0 = *(const float4*)(bp + t * 256);
        float4 b1 = *(const float4*)(bp + t * 256 + 16384);
        float4 b2 = *(const float4*)(bp + t * 256 + 32768);
        acc0 = __builtin_amdgcn_mfma_f32_16x16x4f32(a.x, b0.x, acc0, 0, 0, 0);
        acc1 = __builtin_amdgcn_mfma_f32_16x16x4f32(a.x, b1.x, acc1, 0, 0, 0);
        acc2 = __builtin_amdgcn_mfma_f32_16x16x4f32(a.x, b2.x, acc2, 0, 0, 0);
        acc0 = __builtin_amdgcn_mfma_f32_16x16x4f32(a.y, b0.y, acc0, 0, 0, 0);
        acc1 = __builtin_amdgcn_mfma_f32_16x16x4f32(a.y, b1.y, acc1, 0, 0, 0);
        acc2 = __builtin_amdgcn_mfma_f32_16x16x4f32(a.y, b2.y, acc2, 0, 0, 0);
        acc0 = __builtin_amdgcn_mfma_f32_16x16x4f32(a.z, b0.z, acc0, 0, 0, 0);
        acc1 = __builtin_amdgcn_mfma_f32_16x16x4f32(a.z, b1.z, acc1, 0, 0, 0);
        acc2 = __builtin_amdgcn_mfma_f32_16x16x4f32(a.z, b2.z, acc2, 0, 0, 0);
        acc0 = __builtin_amdgcn_mfma_f32_16x16x4f32(a.w, b0.w, acc0, 0, 0, 0);
        acc1 = __builtin_amdgcn_mfma_f32_16x16x4f32(a.w, b1.w, acc1, 0, 0, 0);
        acc2 = __builtin_amdgcn_mfma_f32_16x16x4f32(a.w, b2.w, acc2, 0, 0, 0);
      }
    }
    __syncthreads();
#pragma unroll
    for (int g = 0; g < 4; ++g) {
      const int row = (lane >> 4) * 4 + g, col = lane & 15;
      sPart[(w * 16 + row) * 48 + col] = acc0[g];
      sPart[(w * 16 + row) * 48 + 16 + col] = acc1[g];
      sPart[(w * 16 + row) * 48 + 32 + col] = acc2[g];
    }
    __syncthreads();
    if (tid < 16) {
      int tok = g0 + tid;
      const float* l0 = sPart + tid * 48;
      float g[4];
#pragma unroll
      for (int i = 0; i < 4; ++i) g[i] = ((l0[32 + i] + l0[768 + 32 + i]) + (l0[1536 + 32 + i] + l0[2304 + 32 + i])) + p.b_rg[layer * 4 + i];
      int grp = 0;
      float gm = g[0];
#pragma unroll
      for (int i = 1; i < 4; ++i) if (g[i] > gm) { gm = g[i]; grp = i; }
      float gs = 0.f;
#pragma unroll
      for (int i = 0; i < 4; ++i) gs += __expf(g[i] - gm);
      float pg = 1.f / gs;
      float sv[8];
#pragma unroll
      for (int i = 0; i < 8; ++i) {
        const int c = grp * 8 + i;
        sv[i] = ((l0[c] + l0[768 + c]) + (l0[1536 + c] + l0[2304 + c])) + p.b_re[layer * 32 + c];
      }
      int i0 = 0;
      float v0 = sv[0];
#pragma unroll
      for (int i = 1; i < 8; ++i) if (sv[i] > v0) { v0 = sv[i]; i0 = i; }
      int i1 = -1;
      float v1 = -3.0e38f;
#pragma unroll
      for (int i = 0; i < 8; ++i) if (i != i0 && sv[i] > v1) { v1 = sv[i]; i1 = i; }
      float e1 = __expf(v1 - v0);
      float w0 = pg / (1.f + e1), w1 = pg * e1 / (1.f + e1);
      int ex0 = grp * 8 + i0, ex1 = grp * 8 + i1;
      sE[tid * 2] = ex0; sE[tid * 2 + 1] = ex1;
      p.tok_e[tok * 2] = ex0; p.tok_e[tok * 2 + 1] = ex1;
      p.tok_gate[tok * 2] = w0; p.tok_gate[tok * 2 + 1] = w1;
    }
    __syncthreads();
    if (tid < 32) {
      int c = 0;
#pragma unroll 8
      for (int i = 0; i < 32; ++i) c += (sE[i] == tid) ? 1 : 0;
      p.cntg[(size_t)(g0 >> 4) * 32 + tid] = c;
      const int mine = sE[tid];
      int rk = 0;
      for (int i = 0; i < (tid & ~1); ++i) rk += (sE[i] == mine) ? 1 : 0;
      p.tok_pos[(g0 + (tid >> 1)) * 2 + (tid & 1)] = rk;
    }
  }
}

__device__ __forceinline__ void phase_moescan(PRef p, int layer, char* smem) {
  int* sOff = (int*)smem;
  int* sScan = sOff + 1280;
  const int tid = tid_();
  const int e = bid_();
  if (e >= 32) return;
  const int ntok = layer == 0 ? TALL : TLAT;
  const int ng = ntok >> 4;
  __syncthreads();
  int loc[5], s = 0;
#pragma unroll
  for (int i = 0; i < 5; ++i) {
    const int g = tid * 5 + i;
    loc[i] = g < ng ? p.cntg[(size_t)g * 32 + e] : 0;
    s += loc[i];
  }
  sScan[tid] = s;
  __syncthreads();
  for (int o = 1; o < 256; o <<= 1) {
    int v = tid >= o ? sScan[tid - o] : 0;
    __syncthreads();
    sScan[tid] += v;
    __syncthreads();
  }
  int run = sScan[tid] - s;
#pragma unroll
  for (int i = 0; i < 5; ++i) { sOff[tid * 5 + i] = run; run += loc[i]; }
  if (tid == 255) p.cnt[e] = sScan[255];
  __syncthreads();
  for (int tok = tid; tok < ntok; tok += 256) {
    const int e0 = p.tok_e[tok * 2], e1 = p.tok_e[tok * 2 + 1];
    if (e0 == e) { const int pos = sOff[tok >> 4] + p.tok_pos[tok * 2]; p.list[e * MOE_CAP + pos] = tok; p.tok_pos[tok * 2] = pos; }
    if (e1 == e) { const int pos = sOff[tok >> 4] + p.tok_pos[tok * 2 + 1]; p.list[e * MOE_CAP + pos] = tok; p.tok_pos[tok * 2 + 1] = pos; }
  }
}

__device__ __forceinline__ void phase_rowpass2(PRef p, int layer) {
  const int lane = tid_() & 63, w = tid_() >> 6;
  const bool last = layer == 1;
  const int ntok = last ? TLAT : TALL;
  const float* lg = p.ln2_g + layer * D;
  const float* lb = p.ln2_b + layer * D;
  const int stride = vgrid_() * 4;
  for (int tokA = bid_() * 4 + w; tokA < ntok; tokA += 2 * stride) {
    const bool hasB = tokA + stride < ntok;
    int tk[2];
    tk[0] = tokA; tk[1] = hasB ? tokA + stride : tokA;
    int s0[2], s1[2];
    float w0[2], w1[2];
#pragma unroll
    for (int u = 0; u < 2; ++u) {
      const int t = tk[u];
      const int e0 = p.tok_e[t * 2], e1 = p.tok_e[t * 2 + 1];
      s0[u] = p.estart[e0] * MOE_BLK + p.tok_pos[t * 2];
      s1[u] = p.estart[e1] * MOE_BLK + p.tok_pos[t * 2 + 1];
      w0[u] = p.tok_gate[t * 2]; w1[u] = p.tok_gate[t * 2 + 1];
    }
    float x1[2][16], g2[2][16];
    uint2 ya[2][4], yb[2][4];
#pragma unroll
    for (int u = 0; u < 2; ++u) {
      const int t = tk[u];
      load_row(p.xres + (size_t)t * D, lane, x1[u]);
      load_row(p.mod + ((size_t)layer * 5 + tok_modrow(t)) * NMOD + 5120, lane, g2[u]);
      const bf16_t* y0 = p.ysl + (size_t)s0[u] * D;
      const bf16_t* y1 = p.ysl + (size_t)s1[u] * D;
#pragma unroll
      for (int i = 0; i < 4; ++i) { ya[u][i] = *(const uint2*)(y0 + lane * 4 + 256 * i); yb[u][i] = *(const uint2*)(y1 + lane * 4 + 256 * i); }
    }
    float gg[16], bb[16];
    load_row(lg, lane, gg);
    load_row(lb, lane, bb);
#pragma unroll
    for (int u = 0; u < 2; ++u) {
      if (u == 1 && !hasB) break;
      const int tok = tk[u];
      float v[16], x2[16];
#pragma unroll
      for (int i = 0; i < 4; ++i) {
        const uint2 a = ya[u][i], b = yb[u][i];
        float fa[4] = {bf2f(a.x & 0xffff), bf2f(a.x >> 16), bf2f(a.y & 0xffff), bf2f(a.y >> 16)};
        float fb[4] = {bf2f(b.x & 0xffff), bf2f(b.x >> 16), bf2f(b.y & 0xffff), bf2f(b.y >> 16)};
#pragma unroll
        for (int e = 0; e < 4; ++e) v[4 * i + e] = ALPHA * x1[u][4 * i + e] + g2[u][4 * i + e] * (w0[u] * fa[e] + w1[u] * fb[e]);
      }
      float mean, rstd;
      row_stats(v, mean, rstd);
#pragma unroll
      for (int i = 0; i < 16; ++i) x2[i] = (v[i] - mean) * rstd * gg[i] + bb[i];
      if (last) {
        store_row(p.out + (size_t)tok * D, lane, x2);
      } else {
        store_row(p.xres + (size_t)tok * D, lane, x2);
        const float* mdn = p.mod + ((size_t)(layer + 1) * 5 + tok_modrow(tok)) * NMOD;
        float h[16];
        modulate_row(x2, mdn, mdn + 1024, lane, h);
        store_row_bf(p.h + (size_t)tok * D, lane, h);
      }
    }
  }
}

struct Ptr4 { const bf16_t* p[4]; };

template <int NJ>
__device__ __forceinline__ void gemm_compute_tile(const char* cA, const char* cB, int r, int hh, f32x16 (&acc)[2][NJ]) {
#pragma unroll
  for (int s = 0; s < 4; ++s) {
    const int co = ((2 * s + hh) ^ ((r >> 1) & 7)) << 4;
    bf16x8 a0 = *(const bf16x8*)(cA + co);
    bf16x8 a1 = *(const bf16x8*)(cA + 4096 + co);
    bf16x8 b[NJ];
#pragma unroll
    for (int j = 0; j < NJ; ++j) b[j] = *(const bf16x8*)(cB + j * 4096 + co);
#pragma unroll
    for (int j = 0; j < NJ; ++j) {
      acc[0][j] = mfma32(a0, b[j], acc[0][j]);
      acc[1][j] = mfma32(a1, b[j], acc[1][j]);
    }
  }
}
#define LAS3 __attribute__((address_space(3)))
__device__ __forceinline__ void dma_sync() { asm volatile("s_waitcnt vmcnt(0)" ::: "memory"); __syncthreads(); }
template <int NJ>
__device__ __forceinline__ void g_stage(const Ptr4& ap, const Ptr4& bp, int kt, char* dA, char* dB) {
#pragma unroll
  for (int i = 0; i < 4; ++i) __builtin_amdgcn_global_load_lds((const unsigned*)(ap.p[i] + kt * 64), (LAS3 unsigned*)(dA + i * 4096), 16, 0, 0);
#pragma unroll
  for (int i = 0; i < 2 * NJ; ++i) __builtin_amdgcn_global_load_lds((const unsigned*)(bp.p[i] + kt * 64), (LAS3 unsigned*)(dB + i * 4096), 16, 0, 0);
}
template <int NJ>
__device__ __forceinline__ void gemm_mainloop(const Ptr4& ap, const Ptr4& bp, int nk, f32x16 (&acc)[2][NJ], char* smem) {
  const int tid = tid_(), lane = tid & 63, w = tid >> 6, wr = w >> 1, wc = w & 1, r = lane & 31, hh = lane >> 5;
  char* sA = smem;
  char* sB = smem + 32768;
  const int dofs = tid * 16;
  g_stage<NJ>(ap, bp, 0, sA + dofs, sB + dofs);
  dma_sync();
  const char* cA = sA + (wr * 64 + r) * 128;
  const char* cB = sB + (wc * 32 * NJ + r) * 128;
  for (int kt = 0; kt < nk; ++kt) {
    const int cur = kt & 1;
    if (kt + 1 < nk) g_stage<NJ>(ap, bp, kt + 1, sA + (cur ^ 1) * 16384 + dofs, sB + (cur ^ 1) * 16384 + dofs);
    gemm_compute_tile<NJ>(cA + cur * 16384, cB + cur * 16384, r, hh, acc);
    dma_sync();
  }
}
__device__ __forceinline__ Ptr4 rows_contig(const bf16_t* base, int ld) {
  Ptr4 q;
  const int lrow = tid_() >> 3, lch = tid_() & 7;
#pragma unroll
  for (int i = 0; i < 4; ++i) q.p[i] = base + (size_t)(lrow + 32 * i) * ld + ((lch ^ ((lrow >> 1) & 7)) * 8);
  return q;
}
__device__ __forceinline__ void acc_to_lds(const f32x16 (&acc)[2][2], float* sC) {
  const int lane = tid_() & 63, w = tid_() >> 6, wr = w >> 1, wc = w & 1, r = lane & 31, hh = lane >> 5;
#pragma unroll
  for (int i = 0; i < 2; ++i)
#pragma unroll
    for (int j = 0; j < 2; ++j)
#pragma unroll
      for (int g = 0; g < 16; ++g) {
        int row = wr * 64 + i * 32 + (g & 3) + 8 * (g >> 2) + 4 * hh, col = wc * 64 + j * 32 + r;
        sC[row * LDC + col] = acc[i][j][g];
      }
}
__device__ __forceinline__ void acc_to_lds_T(const f32x16 (&acc)[2][2], float* sC) {
  const int lane = tid_() & 63, w = tid_() >> 6, wr = w >> 1, wc = w & 1, r = lane & 31, hh = lane >> 5;
#pragma unroll
  for (int i = 0; i < 2; ++i)
#pragma unroll
    for (int j = 0; j < 2; ++j)
#pragma unroll
      for (int g4 = 0; g4 < 4; ++g4) {
        int row = wr * 64 + i * 32 + 8 * g4 + 4 * hh, col = wc * 64 + j * 32 + r;
        *(float4*)(sC + col * LDC + row) = make_float4(acc[i][j][4 * g4], acc[i][j][4 * g4 + 1], acc[i][j][4 * g4 + 2], acc[i][j][4 * g4 + 3]);
      }
}
__device__ __forceinline__ void lds_read8(const float* s, float (&v)[8]) {
  float4 a = *(const float4*)s, b = *(const float4*)(s + 4);
  v[0] = a.x; v[1] = a.y; v[2] = a.z; v[3] = a.w; v[4] = b.x; v[5] = b.y; v[6] = b.z; v[7] = b.w;
}
__device__ __forceinline__ uint4 pack8(const float (&v)[8]) {
  return make_uint4(pack2(v[0], v[1]), pack2(v[2], v[3]), pack2(v[4], v[5]), pack2(v[6], v[7]));
}
__device__ __forceinline__ void st_nt16(void* q, const uint4 v) {
  typedef unsigned nt_u32x4 __attribute__((ext_vector_type(4)));
  const nt_u32x4 t = {v.x, v.y, v.z, v.w};
  __builtin_nontemporal_store(t, (nt_u32x4*)q);
}


__device__ __forceinline__ int xcd_rounds(const char*, int nMt, int nNt) { return (nMt * nNt + vgrid_() - 1) / vgrid_(); }
__device__ __forceinline__ bool xcd_tile(const char*, int round, int nMt, int nNt, int& mt, int& nt) {
  const int item = round * vgrid_() + bid_();
  mt = item / nNt; nt = item % nNt;
  return item < nMt * nNt;
}

namespace pg8 {
constexpr int BK = 64, HALF = 128, HTB = HALF * BK * 2, STAGE_BYTES = 8 * HTB;
__device__ __forceinline__ int lds_byte(int r, int c) { const int st = (r >> 4) * 2 + (c >> 5), rr = r & 15, cc = c & 31, ob = rr * 64 + cc * 2; return st * 1024 + (ob ^ (((ob >> 9) & 1) << 5)); }
__device__ __forceinline__ void stage_rc(int b, int& R, int& C) { const int st = b / 1024, sb = b % 1024, swz = sb ^ (((sb >> 9) & 1) << 5); R = (st >> 1) * 16 + swz / 64; C = (st & 1) * 32 + (swz % 64) / 2; }
typedef float f32x4 __attribute__((ext_vector_type(4)));
__device__ __forceinline__ int perm32(int rho) { const int n = rho >> 4, i = rho & 15; return 8 * (i >> 2) + 4 * n + (i & 3); }
template <bool PERM = false>
__device__ __forceinline__ void gemm_unit(LAS3 unsigned char* lds, const char* cA0, const char* cA1, const unsigned (&voffA0)[2], const unsigned (&voffA1)[2],
                                          const char* cB, int K, f32x4 (&acc)[2][2][4][2]) {
  int tid = __builtin_amdgcn_workitem_id_x();
  asm volatile("" : "+v"(tid));
  const int wid = __builtin_amdgcn_readfirstlane(tid >> 6), lane = tid & 63, wr = wid >> 2, wc = wid & 3, fr = lane & 15, fq = lane >> 4;
  const int nt = K / BK;
  unsigned voffB[2];
#pragma unroll
  for (int i = 0; i < 2; ++i) { int R, C; stage_rc(tid * 16 + i * 8192, R, C); const int Rb = PERM ? ((R & ~31) + perm32(R & 31)) : R; voffB[i] = (unsigned)(Rb * K + C) * 2u; }
  const size_t kstep = (size_t)(BK * 2);
  const size_t hstep = (size_t)HALF * K * 2;
  const unsigned ldsw = (unsigned)wid * 1024u;
  const int aoff = lds_byte(wr * 64 + fr, fq * 8), boff = lds_byte(wc * 32 + fr, fq * 8);
#define PG8_SA(b, h) (((b) * 2 + (h)) * HTB)
#define PG8_SB(b, h) ((4 + (b) * 2 + (h)) * HTB)
#define PG8_STAGE(bufoff, gbase, voff) do { _Pragma("unroll") for (int _i = 0; _i < 2; ++_i) \
        __builtin_amdgcn_global_load_lds((const unsigned*)((const char*)(gbase) + (voff)[_i]), (LAS3 unsigned*)(lds + (bufoff) + ldsw + _i * 8192), 16, 0, 0); } while (0)
#define PG8_LDA(dst, b, h) do { _Pragma("unroll") for (int m = 0; m < 4; ++m) _Pragma("unroll") for (int k = 0; k < 2; ++k) dst[m][k] = *(const LAS3 bf16x8*)(lds + PG8_SA(b, h) + aoff + m * 2048 + k * 1024); } while (0)
#define PG8_LDB(dst, b, h) do { _Pragma("unroll") for (int n = 0; n < 2; ++n) _Pragma("unroll") for (int k = 0; k < 2; ++k) dst[n][k] = *(const LAS3 bf16x8*)(lds + PG8_SB(b, h) + boff + n * 2048 + k * 1024); } while (0)
#define PG8_MMA(ai, bj, At, Bt) do { __builtin_amdgcn_s_setprio(1); _Pragma("unroll") for (int m = 0; m < 4; ++m) _Pragma("unroll") for (int n = 0; n < 2; ++n) _Pragma("unroll") for (int k = 0; k < 2; ++k) \
        acc[ai][bj][m][n] = __builtin_amdgcn_mfma_f32_16x16x32_bf16(Bt[n][k], At[m][k], acc[ai][bj][m][n], 0, 0, 0); __builtin_amdgcn_s_setprio(0); } while (0)
#define PG8_WAIT_V(n) asm volatile("s_waitcnt vmcnt(" #n ")" ::: "memory")
#define PG8_WAIT_L(n) asm volatile("s_waitcnt lgkmcnt(" #n ")" ::: "memory")
#define PG8_BAR __builtin_amdgcn_s_barrier()
#define PG8_SCHED __builtin_amdgcn_sched_barrier(0)
#pragma unroll
  for (int a = 0; a < 2; ++a)
#pragma unroll
    for (int b = 0; b < 2; ++b)
#pragma unroll
      for (int m = 0; m < 4; ++m)
#pragma unroll
        for (int n = 0; n < 2; ++n) acc[a][b][m][n] = (f32x4){0.f, 0.f, 0.f, 0.f};
  bf16x8 At[4][2], B0[2][2], B1[2][2];
  PG8_STAGE(PG8_SB(0, 0), cB, voffB); PG8_STAGE(PG8_SA(0, 0), cA0, voffA0); PG8_STAGE(PG8_SB(0, 1), cB + hstep, voffB); PG8_STAGE(PG8_SA(0, 1), cA1, voffA1);
  if (wr == 1) PG8_BAR;
  PG8_WAIT_V(4); PG8_BAR;
  PG8_STAGE(PG8_SB(1, 0), cB + kstep, voffB); PG8_STAGE(PG8_SA(1, 0), cA0 + kstep, voffA0); PG8_STAGE(PG8_SB(1, 1), cB + hstep + kstep, voffB);
  PG8_WAIT_V(6); PG8_BAR;
  for (int t = 0; t < nt; t += 2) {
    const bool last = (t == nt - 2);
    const size_t o1 = (size_t)(t + 1) * kstep;
    const size_t o2 = last ? 0 : (size_t)(t + 2) * kstep;
    const size_t o3 = o2 + kstep;
    PG8_LDB(B0, 0, 0); PG8_SCHED; PG8_LDA(At, 0, 0); PG8_STAGE(PG8_SA(1, 1), cA1 + o1, voffA1);
    PG8_WAIT_L(8); PG8_BAR; PG8_WAIT_L(0); PG8_MMA(0, 0, At, B0); PG8_BAR; PG8_SCHED;
    PG8_LDB(B1, 0, 1); PG8_STAGE(PG8_SB(0, 0), cB + o2, voffB);
    PG8_BAR; PG8_WAIT_L(0); PG8_MMA(0, 1, At, B1); PG8_BAR;
    PG8_LDA(At, 0, 1); PG8_STAGE(PG8_SA(0, 0), cA0 + o2, voffA0);
    PG8_BAR; PG8_WAIT_L(0); PG8_MMA(1, 0, At, B0); PG8_BAR; PG8_SCHED;
    PG8_STAGE(PG8_SB(0, 1), cB + hstep + o2, voffB);
    PG8_WAIT_V(6); PG8_BAR; PG8_MMA(1, 1, At, B1); PG8_BAR;
    PG8_LDB(B0, 1, 0); PG8_SCHED; PG8_LDA(At, 1, 0); PG8_STAGE(PG8_SA(0, 1), cA1 + o2, voffA1);
    PG8_WAIT_L(8); PG8_BAR; PG8_WAIT_L(0); PG8_MMA(0, 0, At, B0); PG8_BAR; PG8_SCHED;
    PG8_LDB(B1, 1, 1); PG8_STAGE(PG8_SB(1, 0), cB + o3, voffB);
    PG8_BAR; PG8_WAIT_L(0); PG8_MMA(0, 1, At, B1); PG8_BAR;
    PG8_LDA(At, 1, 1); PG8_STAGE(PG8_SA(1, 0), cA0 + o3, voffA0);
    PG8_BAR; PG8_WAIT_L(0); PG8_MMA(1, 0, At, B0); PG8_BAR; PG8_SCHED;
    PG8_STAGE(PG8_SB(1, 1), cB + hstep + o3, voffB);
    PG8_WAIT_V(6); PG8_BAR; PG8_MMA(1, 1, At, B1); PG8_BAR;
  }
  PG8_WAIT_V(0);
  if (wr == 0) PG8_BAR;
  PG8_BAR;
#undef PG8_SA
#undef PG8_SB
#undef PG8_STAGE
#undef PG8_LDA
#undef PG8_LDB
#undef PG8_MMA
#undef PG8_WAIT_V
#undef PG8_WAIT_L
#undef PG8_BAR
#undef PG8_SCHED
}
struct UnitAB { const char* a; const char* b; };
template <bool PERM, class Prov, class Epi>
__device__ __forceinline__ void gemm_stream(LAS3 unsigned char* lds, int K, Prov prov, Epi epi) {
  int tid = __builtin_amdgcn_workitem_id_x();
  asm volatile("" : "+v"(tid));
  const int wid = __builtin_amdgcn_readfirstlane(tid >> 6), lane = tid & 63, wr = wid >> 2, wc = wid & 3, fr = lane & 15, fq = lane >> 4;
  const int nt = K / BK;
  UnitAB cur, nxt;
  if (!prov(0, cur)) return;
  unsigned voffA[2], voffB[2];
#pragma unroll
  for (int i = 0; i < 2; ++i) { int R, C; stage_rc(tid * 16 + i * 8192, R, C); const int Rb = PERM ? ((R & ~31) + perm32(R & 31)) : R;
    voffA[i] = (unsigned)(R * K + C) * 2u; voffB[i] = (unsigned)(Rb * K + C) * 2u; }
  const size_t kstep = (size_t)(BK * 2);
  const size_t hstep = (size_t)HALF * K * 2;
  const unsigned ldsw = (unsigned)wid * 1024u;
  const int aoff = lds_byte(wr * 64 + fr, fq * 8), boff = lds_byte(wc * 32 + fr, fq * 8);
#define PG8_SA(b, h) (((b) * 2 + (h)) * HTB)
#define PG8_SB(b, h) ((4 + (b) * 2 + (h)) * HTB)
#define PG8_STAGE(bufoff, gbase, voff) do { _Pragma("unroll") for (int _i = 0; _i < 2; ++_i) \
        __builtin_amdgcn_global_load_lds((const unsigned*)((const char*)(gbase) + (voff)[_i]), (LAS3 unsigned*)(lds + (bufoff) + ldsw + _i * 8192), 16, 0, 0); } while (0)
#define PG8_LDA(dst, b, h) do { _Pragma("unroll") for (int m = 0; m < 4; ++m) _Pragma("unroll") for (int k = 0; k < 2; ++k) dst[m][k] = *(const LAS3 bf16x8*)(lds + PG8_SA(b, h) + aoff + m * 2048 + k * 1024); } while (0)
#define PG8_LDB(dst, b, h) do { _Pragma("unroll") for (int n = 0; n < 2; ++n) _Pragma("unroll") for (int k = 0; k < 2; ++k) dst[n][k] = *(const LAS3 bf16x8*)(lds + PG8_SB(b, h) + boff + n * 2048 + k * 1024); } while (0)
#define PG8_MMA(ai, bj, At, Bt) do { __builtin_amdgcn_s_setprio(1); _Pragma("unroll") for (int m = 0; m < 4; ++m) _Pragma("unroll") for (int n = 0; n < 2; ++n) _Pragma("unroll") for (int k = 0; k < 2; ++k) \
        acc[ai][bj][m][n] = __builtin_amdgcn_mfma_f32_16x16x32_bf16(Bt[n][k], At[m][k], acc[ai][bj][m][n], 0, 0, 0); __builtin_amdgcn_s_setprio(0); } while (0)
#define PG8_WAIT_V(n) asm volatile("s_waitcnt vmcnt(" #n ")" ::: "memory")
#define PG8_WAIT_L(n) asm volatile("s_waitcnt lgkmcnt(" #n ")" ::: "memory")
#define PG8_BAR __builtin_amdgcn_s_barrier()
#define PG8_SCHED __builtin_amdgcn_sched_barrier(0)
#define PG8_ZERO() do { _Pragma("unroll") for (int a = 0; a < 2; ++a) _Pragma("unroll") for (int b = 0; b < 2; ++b) _Pragma("unroll") for (int m = 0; m < 4; ++m) \
        _Pragma("unroll") for (int n = 0; n < 2; ++n) acc[a][b][m][n] = (f32x4){0.f, 0.f, 0.f, 0.f}; } while (0)
  f32x4 acc[2][2][4][2];
  PG8_ZERO();
  bf16x8 At[4][2], B0[2][2], B1[2][2];
  const char* cA = cur.a; const char* cB = cur.b;
  PG8_STAGE(PG8_SB(0, 0), cB, voffB); PG8_STAGE(PG8_SA(0, 0), cA, voffA); PG8_STAGE(PG8_SB(0, 1), cB + hstep, voffB); PG8_STAGE(PG8_SA(0, 1), cA + hstep, voffA);
  if (wr == 1) PG8_BAR;
  PG8_WAIT_V(4); PG8_BAR;
  PG8_STAGE(PG8_SB(1, 0), cB + kstep, voffB); PG8_STAGE(PG8_SA(1, 0), cA + kstep, voffA); PG8_STAGE(PG8_SB(1, 1), cB + hstep + kstep, voffB);
  PG8_WAIT_V(6); PG8_BAR;
  for (int ui = 0;; ++ui) {
    const bool has_next = prov(ui + 1, nxt);
    const char* nA = has_next ? nxt.a : cA; const char* nB = has_next ? nxt.b : cB;
    for (int t = 0; t < nt; t += 2) {
      const bool last = (t == nt - 2);
      const char* a1 = cA + (size_t)(t + 1) * kstep;
      const char* a2 = last ? nA : cA + (size_t)(t + 2) * kstep; const char* b2 = last ? nB : cB + (size_t)(t + 2) * kstep;
      const char* a3 = a2 + kstep; const char* b3 = b2 + kstep;
      PG8_LDB(B0, 0, 0); PG8_SCHED; PG8_LDA(At, 0, 0); PG8_STAGE(PG8_SA(1, 1), a1 + hstep, voffA);
      PG8_WAIT_L(8); PG8_BAR; PG8_WAIT_L(0); PG8_MMA(0, 0, At, B0); PG8_BAR; PG8_SCHED;
      PG8_LDB(B1, 0, 1); PG8_STAGE(PG8_SB(0, 0), b2, voffB);
      PG8_BAR; PG8_WAIT_L(0); PG8_MMA(0, 1, At, B1); PG8_BAR;
      PG8_LDA(At, 0, 1); PG8_STAGE(PG8_SA(0, 0), a2, voffA);
      PG8_BAR; PG8_WAIT_L(0); PG8_MMA(1, 0, At, B0); PG8_BAR; PG8_SCHED;
      PG8_STAGE(PG8_SB(0, 1), b2 + hstep, voffB);
      PG8_WAIT_V(6); PG8_BAR; PG8_MMA(1, 1, At, B1); PG8_BAR;
      PG8_LDB(B0, 1, 0); PG8_SCHED; PG8_LDA(At, 1, 0); PG8_STAGE(PG8_SA(0, 1), a2 + hstep, voffA);
      PG8_WAIT_L(8); PG8_BAR; PG8_WAIT_L(0); PG8_MMA(0, 0, At, B0); PG8_BAR; PG8_SCHED;
      PG8_LDB(B1, 1, 1); PG8_STAGE(PG8_SB(1, 0), b3, voffB);
      PG8_BAR; PG8_WAIT_L(0); PG8_MMA(0, 1, At, B1); PG8_BAR;
      PG8_LDA(At, 1, 1); PG8_STAGE(PG8_SA(1, 0), a3, voffA);
      PG8_BAR; PG8_WAIT_L(0); PG8_MMA(1, 0, At, B0); PG8_BAR; PG8_SCHED;
      PG8_STAGE(PG8_SB(1, 1), b3 + hstep, voffB);
      PG8_WAIT_V(6); PG8_BAR; PG8_MMA(1, 1, At, B1); PG8_BAR;
    }
    epi(ui, acc);
    if (!has_next) break;
    PG8_ZERO();
    cA = nA; cB = nB;
  }
  PG8_WAIT_V(0);
  if (wr == 0) PG8_BAR;
  PG8_BAR;
#undef PG8_SA
#undef PG8_SB
#undef PG8_STAGE
#undef PG8_LDA
#undef PG8_LDB
#undef PG8_MMA
#undef PG8_WAIT_V
#undef PG8_WAIT_L
#undef PG8_BAR
#undef PG8_SCHED
#undef PG8_ZERO
}
__device__ __forceinline__ void voff_contig(int K, unsigned (&voff)[2]) {
  int tid = __builtin_amdgcn_workitem_id_x();
  asm volatile("" : "+v"(tid));
#pragma unroll
  for (int i = 0; i < 2; ++i) { int R, C; stage_rc(tid * 16 + i * 8192, R, C); voff[i] = (unsigned)(R * K + C) * 2u; }
}
template <int ai, int bj>
__device__ __forceinline__ void acc_to_lds(const f32x4 (&acc)[2][2][4][2], bool transposed, float* sC) {
  int tid = __builtin_amdgcn_workitem_id_x();
  asm volatile("" : "+v"(tid));
  const int wid = tid >> 6, lane = tid & 63, wr = wid >> 2, wc = wid & 3, fr = lane & 15, fq = lane >> 4;
#pragma unroll
  for (int m = 0; m < 4; ++m)
#pragma unroll
    for (int n = 0; n < 2; ++n) {
      const int row = 64 * wr + 16 * m + fr, col = 32 * wc + 16 * n + 4 * fq;
      const f32x4 v = acc[ai][bj][m][n];
      if (!transposed) *(f32x4*)(sC + row * LDC + col) = v;
      else { sC[col * LDC + row] = v[0]; sC[(col + 1) * LDC + row] = v[1]; sC[(col + 2) * LDC + row] = v[2]; sC[(col + 3) * LDC + row] = v[3]; }
    }
}
template <class F>
__device__ __forceinline__ void for_each_piece(const f32x4 (&acc)[2][2][4][2], F f) {
  int tid = __builtin_amdgcn_workitem_id_x();
  asm volatile("" : "+v"(tid));
  const int wid = tid >> 6, lane = tid & 63, wr = wid >> 2, wc = wid & 3, fr = lane & 15, fq = lane >> 4;
#pragma unroll
  for (int ai = 0; ai < 2; ++ai)
#pragma unroll
    for (int m = 0; m < 4; ++m)
#pragma unroll
      for (int bj = 0; bj < 2; ++bj) {
        const f32x4 a = acc[ai][bj][m][0], b = acc[ai][bj][m][1];
        float v[8] = {a[0], a[1], a[2], a[3], b[0], b[1], b[2], b[3]};
        f(128 * ai + 64 * wr + 16 * m + fr, 128 * bj + 32 * wc + 8 * fq, v);
      }
}
__device__ __forceinline__ int unit_linear(int i) { return i * (int)gridDim.x + (int)__builtin_amdgcn_workgroup_id_x(); }
__device__ __forceinline__ bool unit_map(int L, int nM, int nN, int& pm, int& pn) {
  const int nwg = nM * nN;
  if (L >= nwg) return false;
  int wgid = L;
  { const int q = nwg / 8, r = nwg % 8, xcd = wgid % 8, off = wgid / 8; wgid = (xcd < r ? xcd * (q + 1) : r * (q + 1) + (xcd - r) * q) + off; }
  const int nig = 8 * nN, gid = wgid / nig, fm = gid * 8, gsz = (nM - fm) < 8 ? (nM - fm) : 8;
  pm = fm + ((wgid % nig) % gsz); pn = (wgid % nig) / gsz;
  return true;
}
}

__device__ __forceinline__ bool inproj_transposed(int nt) { return (nt == 5) || (nt >= 10 && nt <= 13) || (nt >= 26 && nt <= 29); }
__device__ __forceinline__ void inproj_epilogue(PRef p, int layer, int mt, int nt, const float* sC, int tid) {
  const float* bias = p.b_in + layer * NIN_SRC;
  const bool transposed = inproj_transposed(nt);
  const int tok0 = mt * 128;
  const bool lat = tok0 < TLAT;
  int b, pos0, pall0;
  if (lat) { b = tok0 >> 12; pos0 = tok0 & 4095; pall0 = 256 + pos0; }
  else { int ci = tok0 - TLAT; b = ci >> 8; pos0 = ci & 255; pall0 = pos0; }
  const int n0 = nt * 128;
  const int srcc0 = (nt < 18) ? n0 : n0 + 32;
  if (transposed) {
    const int tc = tid & 15, cb = tid >> 4;
    float bv[8];
#pragma unroll
    for (int ps = 0; ps < 8; ++ps) bv[ps] = bias[srcc0 + ps * 16 + cb];
#pragma unroll
    for (int ps = 0; ps < 8; ++ps) {
      const int col = ps * 16 + cb;
      float v[8];
      lds_read8(sC + col * LDC + tc * 8, v);
#pragma unroll
      for (int e = 0; e < 8; ++e) v[e] += bv[ps];
      bf16_t* dst;
      if (nt == 5) dst = p.vAT + ((size_t)(b * 2 + (col >> 6)) * 64 + (col & 63)) * PALL;
      else if (nt <= 13) dst = p.vBT + ((size_t)(b * 4 + (nt - 10)) * 128 + col) * PALL;
      else dst = p.vCT + ((size_t)(b * 8 + (nt - 26) * 2 + (col >> 6)) * 64 + (col & 63)) * PALL;
      *(uint4*)(dst + pall0 + tc * 8) = pack8(v);
    }
  } else if (nt <= 4) {
    const float* gn = (nt < 4 ? p.q_norm : p.k_norm) + layer * 64;
    const float osc = nt < 4 ? QSCALE : 1.f;
    const int c8 = tid & 15, rb = tid >> 4, d0 = (c8 & 7) * 8;
    float bs[8], bp[8], g0[8], g1[8];
    {
      const float4 t0 = *(const float4*)(bias + srcc0 + c8 * 8), t1 = *(const float4*)(bias + srcc0 + c8 * 8 + 4);
      const float4 u0 = *(const float4*)(bias + srcc0 + ((c8 * 8) ^ 16)), u1 = *(const float4*)(bias + srcc0 + ((c8 * 8) ^ 16) + 4);
      const float4 a0 = *(const float4*)(gn + d0), a1 = *(const float4*)(gn + d0 + 4);
      const float4 c0 = *(const float4*)(gn + (d0 ^ 16)), c1 = *(const float4*)(gn + (d0 ^ 16) + 4);
      bs[0] = t0.x; bs[1] = t0.y; bs[2] = t0.z; bs[3] = t0.w; bs[4] = t1.x; bs[5] = t1.y; bs[6] = t1.z; bs[7] = t1.w;
      bp[0] = u0.x; bp[1] = u0.y; bp[2] = u0.z; bp[3] = u0.w; bp[4] = u1.x; bp[5] = u1.y; bp[6] = u1.z; bp[7] = u1.w;
      g0[0] = a0.x; g0[1] = a0.y; g0[2] = a0.z; g0[3] = a0.w; g0[4] = a1.x; g0[5] = a1.y; g0[6] = a1.z; g0[7] = a1.w;
      g1[0] = c0.x; g1[1] = c0.y; g1[2] = c0.z; g1[3] = c0.w; g1[4] = c1.x; g1[5] = c1.y; g1[6] = c1.z; g1[7] = c1.w;
    }
    const int qd = d0 >> 4;
    const float sgn = (qd & 1) ? 1.f : -1.f;
#pragma unroll 2
    for (int ps = 0; ps < 8; ++ps) {
      const int row = ps * 16 + rb;
      float v[8], pv[8];
      lds_read8(sC + row * LDC + c8 * 8, v);
      lds_read8(sC + row * LDC + ((c8 * 8) ^ 16), pv);
      float cs[8], sn[8];
      if (lat) {
        const int t = pos0 + row;
        const int pp = (qd < 2) ? (t >> 6) : (t & 63);
        const float* rp = p.rope + pp * 16 + (d0 & 15);
        const float4 r0 = *(const float4*)rp, r1 = *(const float4*)(rp + 4), s0 = *(const float4*)(rp + 1024), s1 = *(const float4*)(rp + 1028);
        cs[0] = r0.x; cs[1] = r0.y; cs[2] = r0.z; cs[3] = r0.w; cs[4] = r1.x; cs[5] = r1.y; cs[6] = r1.z; cs[7] = r1.w;
        sn[0] = s0.x; sn[1] = s0.y; sn[2] = s0.z; sn[3] = s0.w; sn[4] = s1.x; sn[5] = s1.y; sn[6] = s1.z; sn[7] = s1.w;
      } else {
#pragma unroll
        for (int e = 0; e < 8; ++e) { cs[e] = 1.f; sn[e] = 0.f; }
      }
      float ss = 0.f;
#pragma unroll
      for (int e = 0; e < 8; ++e) { v[e] += bs[e]; pv[e] += bp[e]; ss += v[e] * v[e]; }
      ss += __shfl_xor(ss, 1);
      ss += __shfl_xor(ss, 2);
      ss += __shfl_xor(ss, 4);
      const float rstd = rsqrtf(ss * (1.f / 64.f) + 1e-6f);
      float o[8];
#pragma unroll
      for (int e = 0; e < 8; ++e) {
        const float xn = v[e] * rstd * g0[e], pn = pv[e] * rstd * g1[e];
        o[e] = (xn * cs[e] + sgn * pn * sn[e]) * osc;
      }
      bf16_t* dst;
      if (nt < 4) dst = p.qA + (size_t)(tok0 + row) * 512 + nt * 128 + c8 * 8;
      else dst = p.kA + ((size_t)(b * 2 + (c8 >> 3)) * PALL + pall0 + row) * 64 + d0;
      *(uint4*)dst = pack8(o);
    }
  } else {
    bf16_t* base;
    int ld, cofs;
    float osc = 1.f;
    if (nt <= 7) { base = p.qB; ld = 256; cofs = (nt - 6) * 128; osc = 0.125f; }
    else if (nt <= 9) { base = p.kB; ld = 256; cofs = (nt - 8) * 128; }
    else if (nt <= 17) { base = p.rB; ld = 512; cofs = (nt - 14) * 128; }
    else if (nt <= 21) { base = p.qC; ld = 512; cofs = (nt - 18) * 128; osc = QSCALE; }
    else { base = p.kC; ld = 512; cofs = (nt - 22) * 128; }
    const int c8 = tid & 15, rb = tid >> 4;
    float bs[8];
    {
      const float4 t0 = *(const float4*)(bias + srcc0 + c8 * 8), t1 = *(const float4*)(bias + srcc0 + c8 * 8 + 4);
      bs[0] = t0.x; bs[1] = t0.y; bs[2] = t0.z; bs[3] = t0.w; bs[4] = t1.x; bs[5] = t1.y; bs[6] = t1.z; bs[7] = t1.w;
    }
#pragma unroll
    for (int ps = 0; ps < 8; ++ps) {
      const int row = ps * 16 + rb;
      float v[8];
      lds_read8(sC + row * LDC + c8 * 8, v);
#pragma unroll
      for (int e = 0; e < 8; ++e) v[e] = (v[e] + bs[e]) * osc;
      *(uint4*)(base + (size_t)(tok0 + row) * ld + cofs + c8 * 8) = pack8(v);
    }
  }
}

__device__ __forceinline__ void gate_epilogue(PRef p, int layer, int mt, int nt, const float* sC, int tid) {
  const float* bias = p.b_in + layer * NIN_SRC + 3872 + nt * 128;
  const int c8 = tid & 15, rb = tid >> 4;
  float bs[8];
  {
    const float4 t0 = *(const float4*)(bias + c8 * 8), t1 = *(const float4*)(bias + c8 * 8 + 4);
    bs[0] = t0.x; bs[1] = t0.y; bs[2] = t0.z; bs[3] = t0.w; bs[4] = t1.x; bs[5] = t1.y; bs[6] = t1.z; bs[7] = t1.w;
  }
#pragma unroll
  for (int ps = 0; ps < 8; ++ps) {
    const int row = ps * 16 + rb;
    float v[8];
    lds_read8(sC + row * LDC + c8 * 8, v);
#pragma unroll
    for (int e = 0; e < 8; ++e) v[e] = sigmoidf_(v[e] + bs[e]);
    *(uint4*)(p.G + (size_t)(mt * 128 + row) * 3072 + nt * 128 + c8 * 8) = pack8(v);
  }
}
__device__ __forceinline__ void phase_inproj(PRef p, int layer, char* smem_all) {
  LAS3 unsigned char* lds = (LAS3 unsigned char*)smem_all;
  constexpr int NSTREAM_IN = 68 * 12, NSTREAM = NSTREAM_IN + 64 * 12, NOLD = 68 * 3;
  {
    unsigned voffA[2];
    pg8::voff_contig(D, voffA);
    const int G = (int)gridDim.x, c = (int)__builtin_amdgcn_workgroup_id_x();
    const int rem = NSTREAM % G;
    for (int j = (c - rem + G) % G; j < NOLD; j += G) {
      int pm, pn;
      pg8::unit_map(j, 68, 3, pm, pn);
      pg8::f32x4 acc[2][2][4][2];
      const char* a0 = (const char*)(p.h + (size_t)pm * 256 * D);
      pg8::gemm_unit(lds, a0, a0 + (size_t)128 * D * 2, voffA, voffA, (const char*)(p.wt_in + (size_t)pn * 256 * D), D, acc);
      asm volatile("" : "+s"(pm), "+s"(pn));
      PRef pe = params_view();
      const int etid = tid_();
      const int half = half_();
      float* sCh = (float*)(smem_all + half * SMEM_BYTES);
      pg8::acc_to_lds<0, 0>(acc, inproj_transposed(2 * pn), (float*)smem_all);
      pg8::acc_to_lds<0, 1>(acc, inproj_transposed(2 * pn + 1), (float*)(smem_all + SMEM_BYTES));
      __syncthreads();
      inproj_epilogue(pe, layer, 2 * pm, 2 * pn + half, sCh, etid);
      __syncthreads();
      pg8::acc_to_lds<1, 0>(acc, inproj_transposed(2 * pn), (float*)smem_all);
      pg8::acc_to_lds<1, 1>(acc, inproj_transposed(2 * pn + 1), (float*)(smem_all + SMEM_BYTES));
      __syncthreads();
      inproj_epilogue(pe, layer, 2 * pm + 1, 2 * pn + half, sCh, etid);
      __syncthreads();
    }
  }
  {
    PRef pg = params_view();
    const bf16_t* hbase = pg.h;
    const bf16_t* win = pg.wt_in;
    const bf16_t* wg = pg.wt_gate;
    const float* bias = pg.b_in + layer * NIN_SRC;
    bf16_t* gbase = pg.G;
    pg8::gemm_stream<true>(lds, D,
      [&](int ui, pg8::UnitAB& u) {
        const int s = pg8::unit_linear(ui);
        int pm, pn;
        if (s < NSTREAM_IN) {
          pg8::unit_map(s, 68, 12, pm, pn);
          pn += 3;
          const char* hr = (const char*)(hbase + (size_t)pm * 256 * D);
          const char* wr_ = (const char*)(win + (size_t)pn * 256 * D);
          const bool T = (pn == 5) || (pn == 6) || (pn >= 13);
          u.a = T ? wr_ : hr;
          u.b = T ? hr : wr_;
          return true;
        }
        if (!pg8::unit_map(s - NSTREAM_IN, 64, 12, pm, pn)) return false;
        u.a = (const char*)(hbase + (size_t)pm * 256 * D);
        u.b = (const char*)(wg + (size_t)pn * 256 * D);
        return true;
      },
      [&](int ui, const pg8::f32x4 (&acc)[2][2][4][2]) {
        const int s = pg8::unit_linear(ui);
        int lt = __builtin_amdgcn_workitem_id_x();
        asm volatile("" : "+v"(lt));
        const int wc = (lt >> 6) & 3, wr = lt >> 8, fr = lt & 15, fq = (lt & 63) >> 4;
        const int cbase = 32 * wc + 8 * fq;
        int pm, pn;
        if (s >= NSTREAM_IN) {
          pg8::unit_map(s - NSTREAM_IN, 64, 12, pm, pn);
          const float* gb = bias + 3872 + pn * 256;
          bf16_t* gdst = gbase + (size_t)pm * 256 * 3072 + pn * 256;
          const float4 ba0 = *(const float4*)(gb + cbase), ba1 = *(const float4*)(gb + cbase + 4);
          const float4 bb0 = *(const float4*)(gb + 128 + cbase), bb1 = *(const float4*)(gb + 128 + cbase + 4);
          pg8::for_each_piece(acc, [&](int row, int col, float (&v)[8]) {
            const float4 b0 = col < 128 ? ba0 : bb0, b1 = col < 128 ? ba1 : bb1;
            v[0] = sigmoidf_(v[0] + b0.x); v[1] = sigmoidf_(v[1] + b0.y); v[2] = sigmoidf_(v[2] + b0.z); v[3] = sigmoidf_(v[3] + b0.w);
            v[4] = sigmoidf_(v[4] + b1.x); v[5] = sigmoidf_(v[5] + b1.y); v[6] = sigmoidf_(v[6] + b1.z); v[7] = sigmoidf_(v[7] + b1.w);
            st_nt16(gdst + (size_t)row * 3072 + col, pack8(v));
          });
          return;
        }
        pg8::unit_map(s, 68, 12, pm, pn);
        pn += 3;
        const float* bsrc = bias + (pn < 9 ? pn * 256 : pn * 256 + 32);
        const bool T = (pn == 5) || (pn == 6) || (pn >= 13);
        if (!T) {
          bf16_t* base; int ld, cofs0; float osc = 1.f;
          if (pn == 3) { base = pg.qB; ld = 256; cofs0 = 0; osc = 0.125f; }
          else if (pn == 4) { base = pg.kB; ld = 256; cofs0 = 0; }
          else if (pn <= 8) { base = pg.rB; ld = 512; cofs0 = (pn - 7) * 256; }
          else if (pn <= 10) { base = pg.qC; ld = 512; cofs0 = (pn - 9) * 256; osc = QSCALE; }
          else { base = pg.kC; ld = 512; cofs0 = (pn - 11) * 256; }
          const float4 ba0 = *(const float4*)(bsrc + cbase), ba1 = *(const float4*)(bsrc + cbase + 4);
          const float4 bb0 = *(const float4*)(bsrc + 128 + cbase), bb1 = *(const float4*)(bsrc + 128 + cbase + 4);
          bf16_t* d0 = base + (size_t)pm * 256 * ld + cofs0;
          pg8::for_each_piece(acc, [&](int row, int col, float (&v)[8]) {
            const float4 b0 = col < 128 ? ba0 : bb0, b1 = col < 128 ? ba1 : bb1;
            v[0] = (v[0] + b0.x) * osc; v[1] = (v[1] + b0.y) * osc; v[2] = (v[2] + b0.z) * osc; v[3] = (v[3] + b0.w) * osc;
            v[4] = (v[4] + b1.x) * osc; v[5] = (v[5] + b1.y) * osc; v[6] = (v[6] + b1.z) * osc; v[7] = (v[7] + b1.w) * osc;
            st_nt16(d0 + (size_t)row * ld + col, pack8(v));
          });
        } else {
          bf16_t* tb; int f0;
          if (pn <= 6) { tb = pg.vBT; f0 = (pn - 5) * 256; } else { tb = pg.vCT; f0 = (pn - 13) * 256; }
          const int tok0 = pm * 256;
          int b, pall0;
          if (tok0 < TLAT) { b = tok0 >> 12; pall0 = 256 + (tok0 & 4095); } else { const int ci = tok0 - TLAT; b = ci >> 8; pall0 = ci & 255; }
          bf16_t* d0 = tb + (size_t)(b * 512 + f0) * PALL + pall0;
          const int rbase = 64 * wr + fr;
          float bv[2][4];
#pragma unroll
          for (int ai = 0; ai < 2; ++ai)
#pragma unroll
            for (int m = 0; m < 4; ++m) bv[ai][m] = bsrc[128 * ai + rbase + 16 * m];
#pragma unroll
          for (int ai = 0; ai < 2; ++ai)
#pragma unroll
            for (int m = 0; m < 4; ++m)
#pragma unroll
              for (int bj = 0; bj < 2; ++bj) {
                const pg8::f32x4 x0 = acc[ai][bj][m][0], x1 = acc[ai][bj][m][1];
                const float bb = bv[ai][m];
                float v[8] = {x0[0] + bb, x0[1] + bb, x0[2] + bb, x0[3] + bb, x1[0] + bb, x1[1] + bb, x1[2] + bb, x1[3] + bb};
                st_nt16(d0 + (size_t)(128 * ai + rbase + 16 * m) * PALL + 128 * bj + cbase, pack8(v));
              }
        }
      });
  }
  {
    const int vtid = tid_();
    char* smem = smem_all + half_() * SMEM_BYTES;
    float* sC = (float*)smem;
    const int lane = vtid & 63, w = vtid >> 6, wr = w >> 1, wc = w & 1, r = lane & 31, hh = lane >> 5;
    for (int mt = bid_(); mt < 136; mt += vgrid_()) {
      f32x16 acc[2][1];
      acc[0][0] = zero16();
      acc[1][0] = zero16();
      gemm_mainloop<1>(rows_contig(p.h + (size_t)mt * 128 * D, D), rows_contig(p.wt_in + (size_t)3840 * D, D), 16, acc, smem);
#pragma unroll
      for (int i2 = 0; i2 < 2; ++i2)
#pragma unroll
        for (int g = 0; g < 16; ++g) {
          int row = wr * 64 + i2 * 32 + (g & 3) + 8 * (g >> 2) + 4 * hh, col = wc * 32 + r;
          sC[row * LDC + col] = acc[i2][0][g];
        }
      __syncthreads();
      for (int i2 = vtid; i2 < 128 * 32; i2 += 256) {
        int row = i2 >> 5, col = i2 & 31;
        p.aB[(size_t)(mt * 128 + row) * 32 + col] = sC[row * LDC + col] + p.b_in[layer * NIN_SRC + 2304 + col];
      }
      __syncthreads();
    }
  }
}

__device__ __forceinline__ void merge_tiles(PRef p, int layer, char* smem, int mt0, int nmt) {
  float* sC = (float*)smem;
  const int tid = tid_(), lane = tid & 63, w = tid >> 6, wr = w >> 1, wc = w & 1, r = lane & 31, hh = lane >> 5;
  const float* bias = p.b_in + layer * NIN_SRC + 3872;
  const int nrounds = xcd_rounds(smem, nmt, 16);
  for (int rd = 0; rd < nrounds; ++rd) {
    int mt, nt;
    if (!xcd_tile(smem, rd, nmt, 16, mt, nt)) continue;
    mt += mt0;
    f32x16 tot[2][1];
    tot[0][0] = zero16();
    tot[1][0] = zero16();
#pragma unroll 1
    for (int br = 0; br < 3; ++br) {
      f32x16 acc[2][1];
      acc[0][0] = zero16();
      acc[1][0] = zero16();
      gemm_mainloop<1>(rows_contig(p.h + (size_t)mt * 128 * D, D), rows_contig(p.wt_gate + (size_t)(br * 1024 + nt * 64) * D, D), 16, acc, smem);
      unsigned sg[2][8];
      {
        float bv = bias[br * 1024 + nt * 64 + wc * 32 + r];
#pragma unroll
        for (int i = 0; i < 2; ++i)
#pragma unroll
          for (int g = 0; g < 8; ++g)
            sg[i][g] = pack2(sigmoidf_(acc[i][0][2 * g] + bv), sigmoidf_(acc[i][0][2 * g + 1] + bv));
      }
      acc[0][0] = zero16();
      acc[1][0] = zero16();
      const bf16_t* ob = (br == 0 ? p.oA : (br == 1 ? p.oB : p.oC));
      gemm_mainloop<1>(rows_contig(ob + (size_t)mt * 128 * 512, 512), rows_contig(p.wt_br + ((size_t)br * 1024 + nt * 64) * 512, 512), 8, acc, smem);
#pragma unroll
      for (int i = 0; i < 2; ++i)
#pragma unroll
        for (int g = 0; g < 8; ++g) {
          tot[i][0][2 * g] += bf2f((bf16_t)(sg[i][g] & 0xffff)) * acc[i][0][2 * g];
          tot[i][0][2 * g + 1] += bf2f((bf16_t)(sg[i][g] >> 16)) * acc[i][0][2 * g + 1];
        }
    }
#pragma unroll
    for (int i = 0; i < 2; ++i)
#pragma unroll
      for (int g = 0; g < 16; ++g) {
        int row = wr * 64 + i * 32 + (g & 3) + 8 * (g >> 2) + 4 * hh, col = wc * 32 + r;
        sC[row * LDC + col] = tot[i][0][g];
      }
    __syncthreads();
#pragma unroll 1
    for (int ps = 0; ps < 4; ++ps) {
      int row = ps * 32 + (tid >> 3), c8 = tid & 7;
      float v[8];
      lds_read8(sC + row * LDC + c8 * 8, v);
      *(uint4*)(p.m + (size_t)(mt * 128 + row) * D + nt * 64 + c8 * 8) = pack8(v);
    }
    __syncthreads();
  }
}

__device__ __forceinline__ void merge_epilogue(PRef p, int br, int mt, int nt, const float* sC, int tid) {
  const int c8 = tid & 15, rb = tid >> 4;
#pragma unroll 1
  for (int hb = 0; hb < 2; ++hb) {
    u32x4 gv[4], mv[4];
#pragma unroll
    for (int q = 0; q < 4; ++q) {
      const size_t tok = (size_t)(mt * 128 + (hb * 4 + q) * 16 + rb);
      gv[q] = *(const u32x4*)(p.G + tok * 3072 + br * 1024 + nt * 128 + c8 * 8);
      if (br > 0) mv[q] = *(const u32x4*)(p.m + tok * D + nt * 128 + c8 * 8);
    }
#pragma unroll
    for (int q = 0; q < 4; ++q) {
      const int row = (hb * 4 + q) * 16 + rb;
      float v[8];
      lds_read8(sC + row * LDC + c8 * 8, v);
#pragma unroll
      for (int e2 = 0; e2 < 4; ++e2) {
        v[2 * e2] *= bf2f((bf16_t)(gv[q][e2] & 0xffff));
        v[2 * e2 + 1] *= bf2f((bf16_t)(gv[q][e2] >> 16));
        if (br > 0) { v[2 * e2] += bf2f((bf16_t)(mv[q][e2] & 0xffff)); v[2 * e2 + 1] += bf2f((bf16_t)(mv[q][e2] >> 16)); }
      }
      *(uint4*)(p.m + (size_t)(mt * 128 + row) * D + nt * 128 + c8 * 8) = pack8(v);
    }
  }
}
__device__ __forceinline__ void phase_merge(PRef p, int layer, char* smem_all) {
  LAS3 unsigned char* lds = (LAS3 unsigned char*)smem_all;
  {
    PRef pe = params_view();
    const bf16_t* oA = pe.oA; const bf16_t* oB = pe.oB; const bf16_t* oC = pe.oC;
    const bf16_t* wbr = pe.wt_br;
    const bf16_t* Gp = pe.G;
    bf16_t* mp = pe.m;
    pg8::gemm_stream<true>(lds, 512,
      [&](int ui, pg8::UnitAB& u) {
        const int br = ui % 3;
        int pm, pn;
        if (!pg8::unit_map(pg8::unit_linear(ui / 3), 64, 4, pm, pn)) return false;
        const bf16_t* ob = (br == 0 ? oA : (br == 1 ? oB : oC));
        u.a = (const char*)(ob + (size_t)pm * 256 * 512);
        u.b = (const char*)(wbr + ((size_t)br * 1024 + pn * 256) * 512);
        return true;
      },
      [&](int ui, const pg8::f32x4 (&acc)[2][2][4][2]) {
        const int br = ui % 3;
        int pm, pn;
        pg8::unit_map(pg8::unit_linear(ui / 3), 64, 4, pm, pn);
        const bf16_t* gsrc = Gp + (size_t)pm * 256 * 3072 + br * 1024 + pn * 256;
        bf16_t* mdst = mp + (size_t)pm * 256 * D + pn * 256;
        const bool rmw = br > 0;
        int lt = __builtin_amdgcn_workitem_id_x();
        asm volatile("" : "+v"(lt));
        const int wid = lt >> 6, lane = lt & 63, wr = wid >> 2, wc = wid & 3, fr = lane & 15, fq = lane >> 4;
#pragma unroll
        for (int ai = 0; ai < 2; ++ai) {
          u32x4 gq[4][2], mq[4][2];
#pragma unroll
          for (int m = 0; m < 4; ++m)
#pragma unroll
            for (int bj = 0; bj < 2; ++bj) {
              const int row = 128 * ai + 64 * wr + 16 * m + fr, col = 128 * bj + 32 * wc + 8 * fq;
              gq[m][bj] = *(const u32x4*)(gsrc + (size_t)row * 3072 + col);
              if (rmw) mq[m][bj] = *(const u32x4*)(mdst + (size_t)row * D + col);
            }
#pragma unroll
          for (int m = 0; m < 4; ++m)
#pragma unroll
            for (int bj = 0; bj < 2; ++bj) {
              const int row = 128 * ai + 64 * wr + 16 * m + fr, col = 128 * bj + 32 * wc + 8 * fq;
              const pg8::f32x4 a = acc[ai][bj][m][0], b = acc[ai][bj][m][1];
              float v[8] = {a[0], a[1], a[2], a[3], b[0], b[1], b[2], b[3]};
              const u32x4 g = gq[m][bj];
#pragma unroll
              for (int e2 = 0; e2 < 4; ++e2) {
                v[2 * e2] *= bf2f((bf16_t)(g[e2] & 0xffff));
                v[2 * e2 + 1] *= bf2f((bf16_t)(g[e2] >> 16));
                if (rmw) { v[2 * e2] += bf2f((bf16_t)(mq[m][bj][e2] & 0xffff)); v[2 * e2 + 1] += bf2f((bf16_t)(mq[m][bj][e2] >> 16)); }
              }
              *(uint4*)(mdst + (size_t)row * D + col) = pack8(v);
            }
        }
      });
  }
  if (layer == 0) merge_tiles(p, layer, smem_all + half_() * SMEM_BYTES, 128, 8);
}

__device__ __forceinline__ void outproj_epilogue(PRef p, int layer, int mt, int nt, const float* sC, int tid) {
  const int tok0 = mt * 128;
  const float* g1 = p.mod + ((size_t)layer * 5 + tok_modrow(tok0)) * NMOD + 2048 + nt * 128;
  const int c8 = tid & 15, rb = tid >> 4;
  const float4 ga = *(const float4*)(g1 + c8 * 8), gb = *(const float4*)(g1 + c8 * 8 + 4);
#pragma unroll 1
  for (int hb = 0; hb < 2; ++hb) {
    float4 x0[4], x1[4];
#pragma unroll
    for (int q = 0; q < 4; ++q) {
      const int tok = tok0 + (hb * 4 + q) * 16 + rb;
      const float* xp;
      if (layer == 0) xp = tok < TLAT ? p.x + (size_t)tok * D : p.ctx + (size_t)(tok - TLAT) * D;
      else xp = p.xres + (size_t)tok * D;
      xp += nt * 128 + c8 * 8;
      x0[q] = *(const float4*)xp; x1[q] = *(const float4*)(xp + 4);
    }
#pragma unroll
    for (int q = 0; q < 4; ++q) {
      const int row = (hb * 4 + q) * 16 + rb;
      float v[8];
      lds_read8(sC + row * LDC + c8 * 8, v);
      float4 o0 = make_float4(ALPHA * x0[q].x + ga.x * v[0], ALPHA * x0[q].y + ga.y * v[1], ALPHA * x0[q].z + ga.z * v[2], ALPHA * x0[q].w + ga.w * v[3]);
      float4 o1 = make_float4(ALPHA * x1[q].x + gb.x * v[4], ALPHA * x1[q].y + gb.y * v[5], ALPHA * x1[q].z + gb.z * v[6], ALPHA * x1[q].w + gb.w * v[7]);
      float* op = p.xres + (size_t)(tok0 + row) * D + nt * 128 + c8 * 8;
      *(float4*)op = o0;
      *(float4*)(op + 4) = o1;
    }
  }
}
__device__ __forceinline__ void phase_outproj(PRef p, int layer, char* smem_all) {
  LAS3 unsigned char* lds = (LAS3 unsigned char*)smem_all;
  unsigned voffA[2];
  pg8::voff_contig(D, voffA);
  for (int i = 0;; ++i) {
    int pm, pn;
    if (!pg8::unit_map(pg8::unit_linear(i), 64, 4, pm, pn)) break;
    pg8::f32x4 acc[2][2][4][2];
    const char* a0 = (const char*)(p.m + (size_t)pm * 256 * D);
    pg8::gemm_unit(lds, a0, a0 + (size_t)128 * D * 2, voffA, voffA, (const char*)(p.wt_out + (size_t)pn * 256 * D), D, acc);
    asm volatile("" : "+s"(pm), "+s"(pn));
    PRef pe = params_view();
    const int etid = tid_();
    const int half = half_();
    float* sCh = (float*)(smem_all + half * SMEM_BYTES);
    pg8::acc_to_lds<0, 0>(acc, false, (float*)smem_all);
    pg8::acc_to_lds<0, 1>(acc, false, (float*)(smem_all + SMEM_BYTES));
    __syncthreads();
    outproj_epilogue(pe, layer, 2 * pm, 2 * pn + half, sCh, etid);
    __syncthreads();
    pg8::acc_to_lds<1, 0>(acc, false, (float*)smem_all);
    pg8::acc_to_lds<1, 1>(acc, false, (float*)(smem_all + SMEM_BYTES));
    __syncthreads();
    outproj_epilogue(pe, layer, 2 * pm + 1, 2 * pn + half, sCh, etid);
    __syncthreads();
  }
  if (layer == 0) {
    char* smem = smem_all + half_() * SMEM_BYTES;
    float* sC = (float*)smem;
    const int tid = tid_();
    for (int item = bid_(); item < 64; item += vgrid_()) {
      const int mt = 128 + (item >> 3), nt = item & 7;
      f32x16 acc[2][2];
#pragma unroll
      for (int i = 0; i < 2; ++i)
#pragma unroll
        for (int j = 0; j < 2; ++j) acc[i][j] = zero16();
      gemm_mainloop<2>(rows_contig(p.m + (size_t)mt * 128 * D, D), rows_contig(p.wt_out + (size_t)nt * 128 * D, D), 16, acc, smem);
      acc_to_lds(acc, sC);
      __syncthreads();
      outproj_epilogue(p, layer, mt, nt, sC, tid);
      __syncthreads();
    }
  }
}

__device__ __forceinline__ bool moe_block_lookup(PRef p, int mb, int& e, int& lb, int& cnt_e) {
  int start = 0;
  for (int i = 0; i < 32; ++i) {
    int c = p.cnt[i];
    int nb = (c + MOE_BLK - 1) / MOE_BLK;
    if (mb < start + nb) { e = i; lb = mb - start; cnt_e = c; return true; }
    start += nb;
  }
  return false;
}
__device__ __forceinline__ void moe1_epilogue(PRef p, int slot0, int nt, const float* sC, int tid) {
#pragma unroll
  for (int ps = 0; ps < 8; ++ps) {
    const int row = ps * 16 + (tid >> 4), c4 = (tid & 15) * 4;
    const float4 a = *(const float4*)(sC + row * LDC + c4);
    const float4 b = *(const float4*)(sC + row * LDC + 64 + c4);
    const uint2 o = make_uint2(pack2(siluf(a.x) * b.x, siluf(a.y) * b.y), pack2(siluf(a.z) * b.z, siluf(a.w) * b.w));
    *(uint2*)(p.act + (size_t)(slot0 + row) * 512 + nt * 64 + c4) = o;
  }
}
__device__ __forceinline__ void moe2_epilogue(PRef p, int slot0, int nt, const float* sC, int tid) {
#pragma unroll
  for (int ps = 0; ps < 8; ++ps) {
    const int row = ps * 16 + (tid >> 4), c8 = tid & 15;
    float v[8];
    lds_read8(sC + row * LDC + c8 * 8, v);
    *(uint4*)(p.ysl + (size_t)(slot0 + row) * D + nt * 128 + c8 * 8) = pack8(v);
  }
}
__device__ __forceinline__ void phase_moe1(PRef p, int layer, char* smem_all) {
  LAS3 unsigned char* lds = (LAS3 unsigned char*)smem_all;
  if (__builtin_amdgcn_workgroup_id_x() == 0 && __builtin_amdgcn_workitem_id_x() == 0) {
    int start = 0;
    for (int i = 0; i < 32; ++i) { p.estart[i] = start; start += (p.cnt[i] + MOE_BLK - 1) / MOE_BLK; }
  }
  for (int i = 0;; ++i) {
    const int L = pg8::unit_linear(i);
    int mb = L >> 2, pn = L & 3;
    if (mb >= MAX_MBLK) break;
    int e, lb, ce;
    if (!moe_block_lookup(p, mb, e, lb, ce)) break;
    unsigned voffA0[2], voffA1[2];
    {
      int tid = __builtin_amdgcn_workitem_id_x();
      asm volatile("" : "+v"(tid));
#pragma unroll
      for (int q = 0; q < 2; ++q) {
        int R, C;
        pg8::stage_rc(tid * 16 + q * 8192, R, C);
        const int s0 = lb * MOE_BLK + R, s1 = s0 + 128;
        const int t0 = s0 < ce ? p.list[e * MOE_CAP + s0] : 0;
        const int t1 = s1 < ce ? p.list[e * MOE_CAP + s1] : 0;
        voffA0[q] = (unsigned)(t0 * D + C) * 2u;
        voffA1[q] = (unsigned)(t1 * D + C) * 2u;
      }
    }
    pg8::f32x4 acc[2][2][4][2];
    pg8::gemm_unit(lds, (const char*)p.h2, (const char*)p.h2, voffA0, voffA1, (const char*)(p.wt_13 + ((size_t)e * 1024 + pn * 256) * D), D, acc);
    asm volatile("" : "+s"(mb), "+s"(pn));
    PRef pe = params_view();
    const int etid = tid_();
    const int half = half_();
    float* sCh = (float*)(smem_all + half * SMEM_BYTES);
    pg8::acc_to_lds<0, 0>(acc, false, (float*)smem_all);
    pg8::acc_to_lds<0, 1>(acc, false, (float*)(smem_all + SMEM_BYTES));
    __syncthreads();
    moe1_epilogue(pe, mb * MOE_BLK, 2 * pn + half, sCh, etid);
    __syncthreads();
    pg8::acc_to_lds<1, 0>(acc, false, (float*)smem_all);
    pg8::acc_to_lds<1, 1>(acc, false, (float*)(smem_all + SMEM_BYTES));
    __syncthreads();
    moe1_epilogue(pe, mb * MOE_BLK + 128, 2 * pn + half, sCh, etid);
    __syncthreads();
  }
}
__device__ __forceinline__ void phase_moe2(PRef p, int layer, char* smem_all) {
  LAS3 unsigned char* lds = (LAS3 unsigned char*)smem_all;
  const bf16_t* actp = p.act;
  const bf16_t* w2p = p.wt_2;
  bf16_t* yp = p.ysl;
  const int* cntp = p.cnt;
  auto lookup = [&](int mb, int& e) {
    int start = 0;
    for (int i = 0; i < 32; ++i) {
      const int nb = (cntp[i] + MOE_BLK - 1) / MOE_BLK;
      if (mb < start + nb) { e = i; return true; }
      start += nb;
    }
    return false;
  };
  pg8::gemm_stream<true>(lds, 512,
    [&](int ui, pg8::UnitAB& u) {
      const int L = pg8::unit_linear(ui);
      const int mb = L >> 2, pn = L & 3;
      int e;
      if (mb >= MAX_MBLK || !lookup(mb, e)) return false;
      u.a = (const char*)(actp + (size_t)mb * MOE_BLK * 512);
      u.b = (const char*)(w2p + ((size_t)e * 1024 + pn * 256) * 512);
      return true;
    },
    [&](int ui, const pg8::f32x4 (&acc)[2][2][4][2]) {
      const int L = pg8::unit_linear(ui);
      const int mb = L >> 2, pn = L & 3;
      bf16_t* ydst = yp + (size_t)mb * MOE_BLK * D + pn * 256;
      pg8::for_each_piece(acc, [&](int row, int col, float (&v)[8]) { st_nt16(ydst + (size_t)row * D + col, pack8(v)); });
    });
}

struct AttnState { f32x16 negm; f32x16 L; };
__device__ __forceinline__ void attn_qk(const char* sK, const bf16x8 (&bq)[4], const f32x16& negm, f32x16 (&S)[2], int r, int hh) {
  const int pr = 16 * (r >> 4) + 8 * ((r >> 2) & 1) + 4 * ((r >> 3) & 1) + (r & 3);
  const char* kp = sK + pr * 128;
#pragma unroll
  for (int s = 0; s < 4; ++s) {
    const int co = ((2 * s + hh) ^ ((pr >> 1) & 7)) << 4;
    bf16x8 a0 = *(const bf16x8*)(kp + co);
    bf16x8 a1 = *(const bf16x8*)(kp + 4096 + co);
    if (s == 0) { S[0] = mfma32(a0, bq[0], negm); S[1] = mfma32(a1, bq[0], negm); }
    else { S[0] = mfma32(a0, bq[s], S[0]); S[1] = mfma32(a1, bq[s], S[1]); }
  }
}
template <class MaskF>
__device__ __forceinline__ float attn_softmax_pv(f32x16 (&S)[2], const char* sV, f32x16 (&O)[2], AttnState& st, bf16x8 ones, int r, int hh,
                                                 MaskF maskf, const bool FIRST) {
  maskf(S);
  float mx = S[0][0];
#pragma unroll
  for (int g = 1; g < 16; ++g) mx = fmaxf(mx, S[0][g]);
#pragma unroll
  for (int g = 0; g < 16; ++g) mx = fmaxf(mx, S[1][g]);
  {
    auto sw = __builtin_amdgcn_permlane32_swap(__float_as_uint(mx), __float_as_uint(mx), false, false);
    mx = fmaxf(__uint_as_float(sw[0]), __uint_as_float(sw[1]));
  }
  float dshift = 0.f;
  if (FIRST || __any(mx > 8.f)) {
    const float d = FIRST ? mx : fmaxf(mx, 0.f);
    dshift = d;
    const float alpha = __builtin_amdgcn_exp2f(-d);
#pragma unroll
    for (int g = 0; g < 16; ++g) {
      st.negm[g] -= d;
      S[0][g] -= d; S[1][g] -= d;
      O[0][g] *= alpha; O[1][g] *= alpha;
    }
    st.L[0] *= alpha;
  }
#pragma unroll
  for (int kb = 0; kb < 2; ++kb)
#pragma unroll
    for (int g = 0; g < 16; ++g) S[kb][g] = __builtin_amdgcn_exp2f(S[kb][g]);
  const char* vp = sV + r * 128;
  const int vsw = (r >> 1) & 7;
#pragma unroll
  for (int sp = 0; sp < 4; ++sp) {
    const int sb_ = sp >> 1, so_ = 8 * (sp & 1);
    u32x4 bpu = {pack2(S[sb_][so_], S[sb_][so_ + 1]), pack2(S[sb_][so_ + 2], S[sb_][so_ + 3]), pack2(S[sb_][so_ + 4], S[sb_][so_ + 5]),
                 pack2(S[sb_][so_ + 6], S[sb_][so_ + 7])};
    bf16x8 bp = __builtin_bit_cast(bf16x8, bpu);
#pragma unroll
    for (int db = 0; db < 2; ++db) {
      bf16x8 av = *(const bf16x8*)(vp + db * 4096 + (((2 * sp + hh) ^ vsw) << 4));
      O[db] = mfma32(av, bp, O[db]);
    }
    st.L = mfma32(ones, bp, st.L);
  }
  return dshift;
}
template <class MaskF>
__device__ __forceinline__ void attn_tile(const char* sK, const char* sV, const bf16x8 (&bq)[4], f32x16 (&O)[2], AttnState& st, bf16x8 ones,
                                          int r, int hh, MaskF maskf, const bool FIRST) {
  f32x16 S[2];
  attn_qk(sK, bq, st.negm, S, r, hh);
  (void)attn_softmax_pv(S, sV, O, st, ones, r, hh, maskf, FIRST);
}
__device__ __forceinline__ void attn_state_init(AttnState& st, bf16x8& ones, int r) {
  st.negm = zero16();
  st.L = zero16();
  const short one = (r == 0) ? (short)0x3F80 : (short)0;
  ones = (bf16x8){one, one, one, one, one, one, one, one};
}

__device__ __forceinline__ void attn_stage(const bf16_t* kg, size_t kstride, const bf16_t* vg, size_t vstride, char* sKd, char* sVd, int tid) {
  const int row = tid >> 3, u = ((tid & 7) ^ ((tid >> 4) & 7)) * 8;
#pragma unroll
  for (int i = 0; i < 2; ++i) {
    __builtin_amdgcn_global_load_lds((const unsigned*)(kg + (size_t)(row + 32 * i) * kstride + u), (LAS3 unsigned*)(sKd + tid * 16 + i * 4096), 16, 0, 0);
    __builtin_amdgcn_global_load_lds((const unsigned*)(vg + (size_t)(row + 32 * i) * vstride + u), (LAS3 unsigned*)(sVd + tid * 16 + i * 4096), 16, 0, 0);
  }
}
struct NoMask { __device__ __forceinline__ void operator()(f32x16 (&)[2]) const {} };

__device__ __forceinline__ void attn_write_out(bf16_t* dst  , const f32x16 (&O)[2], float l, int hh) {
  float lt = l + __shfl_xor(l, 32);
  float inv = 1.f / lt;
#pragma unroll
  for (int db = 0; db < 2; ++db)
#pragma unroll
    for (int g4 = 0; g4 < 4; ++g4) {
      uint2 o = make_uint2(pack2(O[db][4 * g4] * inv, O[db][4 * g4 + 1] * inv), pack2(O[db][4 * g4 + 2] * inv, O[db][4 * g4 + 3] * inv));
      *(uint2*)(dst + 32 * db + 8 * g4 + 4 * hh) = o;
    }
}

__device__ __forceinline__ void phase_attnA(PRef p, int layer, char* smem_all) {
  int tid = __builtin_amdgcn_workitem_id_x();
  asm volatile("" : "+v"(tid));
  const int lane = tid & 63, w8 = tid >> 6, w = w8 & 3, qsub = w8 >> 2, r = lane & 31, hh = lane >> 5;
  char* sK = smem_all;
  char* sV = smem_all + 32768;
  const int nitems = layer == 0 ? 544 : 512;
  const int G = (int)gridDim.x;
  for (int item = (int)__builtin_amdgcn_workgroup_id_x(); item < nitems; item += G) {
    int b, kvh, qtok0, nkt;
    if (item < 512) { b = item >> 7; kvh = (item >> 6) & 1; qtok0 = b * 4096 + (item & 63) * 64 + qsub * 32; nkt = 68; }
    else { int it = item - 512; b = it >> 3; kvh = (it >> 2) & 1; qtok0 = TLAT + b * 256 + (it & 3) * 64 + qsub * 32; nkt = 4; }
    const int head = kvh * 4 + w;
    bf16x8 bq[4];
    {
      const bf16_t* qp = p.qA + (size_t)(qtok0 + r) * 512 + head * 64 + 8 * hh;
#pragma unroll
      for (int s = 0; s < 4; ++s) bq[s] = *(const bf16x8*)(qp + 16 * s);
    }
    const bf16_t* kbase = p.kA + (size_t)(b * 2 + kvh) * PALL * 64;
    const bf16_t* vbase = p.vAT + (size_t)(b * 2 + kvh) * 64 * PALL;
    const int srow = tid >> 3, su = ((tid & 7) ^ ((tid >> 4) & 7)) * 8;
    const bf16_t* kg = kbase + (size_t)srow * 64 + su;
    const bf16_t* vg = vbase + (size_t)srow * PALL + su;
    f32x16 O[2];
    O[0] = zero16();
    O[1] = zero16();
    AttnState st;
    bf16x8 ones;
    attn_state_init(st, ones, r);
    __syncthreads();
#define ATT_STAGE(KT)                                                                                                                     \
  {                                                                                                                                       \
    __builtin_amdgcn_global_load_lds((const unsigned*)(kg + (size_t)(KT) * 4096), (LAS3 unsigned*)(sK + ((KT) & 3) * 8192 + tid * 16), 16, 0, 0); \
    __builtin_amdgcn_global_load_lds((const unsigned*)(vg + (KT) * 64), (LAS3 unsigned*)(sV + ((KT) & 3) * 8192 + tid * 16), 16, 0, 0);           \
  }
    ATT_STAGE(0);
    ATT_STAGE(1);
    dma_sync();
    f32x16 Sa[2], Sb[2];
    attn_qk(sK, bq, st.negm, Sa, r, hh);
#define ATT_STEP(KT, CUR, NXT)                                                                                              \
  {                                                                                                                         \
    if ((KT) > 0) dma_sync();                \
    if ((KT) + 2 < nkt) ATT_STAGE((KT) + 2);                                                                                \
    if ((KT) + 1 < nkt) attn_qk(sK + (((KT) + 1) & 3) * 8192, bq, st.negm, NXT, r, hh);                                     \
    const float d_ = attn_softmax_pv(CUR, sV + ((KT) & 3) * 8192, O, st, ones, r, hh, NoMask(), (KT) == 0);                 \
    if ((KT) + 1 < nkt && __any(d_ != 0.f)) {      \
      _Pragma("unroll") for (int g = 0; g < 16; ++g) { NXT[0][g] -= d_; NXT[1][g] -= d_; }                                  \
    }                                                                                                                       \
  }
    for (int kt = 0; kt < nkt; kt += 2) {
      ATT_STEP(kt, Sa, Sb);
      ATT_STEP(kt + 1, Sb, Sa);
    }
#undef ATT_STEP
#undef ATT_STAGE
    attn_write_out(p.oA + (size_t)(qtok0 + r) * 512 + head * 64, O, st.L[0], hh);
  }
}

struct NaMask {
  const float* bp;
  int cofs;
  bool on;
  __device__ __forceinline__ void operator()(f32x16 (&S)[2]) const {
    if (!on) return;
#pragma unroll
    for (int kb = 0; kb < 2; ++kb)
#pragma unroll
      for (int g = 0; g < 16; ++g) {
        const int cc = 32 * kb + 16 * (g >> 3) + 4 * ((g >> 2) & 1) + (g & 3);
        const bool valid = (unsigned)(cc + cofs) < 16u;
        const float bv = bp[cc];
        S[kb][g] = valid ? S[kb][g] + bv : -1e30f;
      }
  }
};
__device__ __forceinline__ void phase_na(PRef p, int layer, char* smem) {
  const int tid = tid_(), lane = tid & 63, w = tid >> 6, r = lane & 31, hh = lane >> 5;
  char* sK = smem;
  char* sV = smem + 32768;
  float* sBias = (float*)(smem + 65536);
  const int nitems = layer == 0 ? 1088 : 1024;
  const int set = w >> 1, qhalf = w & 1;
  for (int item = bid_(); item < nitems; item += vgrid_()) {
    int b, hp, row = 0, rs = 0, qtok0, kt0, kt1;
    if (item < 1024) {
      b = item >> 8; row = (item >> 2) & 63; hp = item & 3;
      rs = row - 4; rs = rs < 0 ? 0 : (rs > 56 ? 56 : rs);
      qtok0 = b * 4096 + row * 64; kt0 = 0; kt1 = 12;
    } else {
      int it = item - 1024;
      b = it >> 4; hp = (it >> 2) & 3;
      qtok0 = TLAT + b * 256 + (it & 3) * 64; kt0 = 8; kt1 = 12;
    }
    const int head = 2 * hp + set;
    __syncthreads();
    for (int i = tid; i < 930; i += 256) {
      int s = i / 465, j = i % 465;
      sBias[i] = p.rpb[((size_t)layer * 8 + 2 * hp + s) * 465 + j] * LOG2E;
    }
    bf16x8 bq[4];
    {
      const bf16_t* qp = p.qC + (size_t)(qtok0 + 32 * qhalf + r) * 512 + head * 64 + 8 * hh;
#pragma unroll
      for (int s = 0; s < 4; ++s) bq[s] = *(const bf16x8*)(qp + 16 * s);
    }
    f32x16 O[2];
    O[0] = zero16();
    O[1] = zero16();
    AttnState st;
    bf16x8 ones;
    attn_state_init(st, ones, r);
#define NA_STAGE(KT, BUF)                                                                                          \
  {                                                                                                                \
    int tokK, pallb;                                                                                               \
    if ((KT) < 8) { tokK = b * 4096 + (rs + (KT)) * 64; pallb = 256 + (rs + (KT)) * 64; }                          \
    else { tokK = TLAT + b * 256 + ((KT) - 8) * 64; pallb = ((KT) - 8) * 64; }                                     \
    _Pragma("unroll") for (int s2 = 0; s2 < 2; ++s2)                                                               \
      attn_stage(p.kC + (size_t)tokK * 512 + (2 * hp + s2) * 64, 512, p.vCT + (size_t)(b * 8 + 2 * hp + s2) * 64 * PALL + pallb, PALL, \
                 sK + (BUF) * 16384 + s2 * 8192, sV + (BUF) * 16384 + s2 * 8192, tid);                             \
  }
    NA_STAGE(kt0, 0);
    for (int kt = kt0; kt < kt1; ++kt) {
      const int cur = (kt - kt0) & 1;
      dma_sync();
      if (kt + 1 < kt1) NA_STAGE(kt + 1, cur ^ 1);
      {
        NaMask mk;
        const int wq = 32 * qhalf + r;
        int cs = wq - 8;
        cs = cs < 0 ? 0 : (cs > 48 ? 48 : cs);
        mk.on = kt < 8;
        mk.bp = sBias + set * 465 + (mk.on ? (rs + kt - row + 7) * 31 : 0) - wq + 15 + 8 * hh;
        mk.cofs = 8 * hh - cs;
        attn_tile(sK + cur * 16384 + set * 8192, sV + cur * 16384 + set * 8192, bq, O, st, ones, r, hh, mk, kt == kt0);
      }
    }
#undef NA_STAGE
    attn_write_out(p.oC + (size_t)(qtok0 + 32 * qhalf + r) * 512 + head * 64, O, st.L[0], hh);
  }
}

__device__ __forceinline__ float log_sigmoidf_(float x) { return fminf(x, 0.f) - __logf(1.f + __expf(-fabsf(x))); }
struct GlaPre { f32x4v a0, a1, a2, a3, wg0, wg1; float bg; };
__device__ __forceinline__ void gla_prep_load(PRef p, int layer, int hd, int dir, int tok0, GlaPre& R) {
  const int tid = tid_(), lane = tid & 63, w = tid >> 6, r = lane & 31, hh = lane >> 5, pb = w >> 1, db = w & 1;
  const float* ap = p.aB + (size_t)(tok0 + 32 * pb + r) * 32 + dir * 16;
  R.a0 = *(const f32x4v*)(ap); R.a1 = *(const f32x4v*)(ap + 4); R.a2 = *(const f32x4v*)(ap + 8); R.a3 = *(const f32x4v*)(ap + 12);
  const float* wp = p.gla_wg + (((size_t)layer * 2 + dir) * 16 + hh) * 256 + hd * 64 + 32 * db + r;
  R.wg0 = (f32x4v){wp[0], wp[2 * 256], wp[4 * 256], wp[6 * 256]};
  R.wg1 = (f32x4v){wp[8 * 256], wp[10 * 256], wp[12 * 256], wp[14 * 256]};
  R.bg = p.gla_bg[((size_t)layer * 2 + dir) * 256 + hd * 64 + 32 * db + r];
}
#define GLA_DPP_ADD(v, ctrl, rmask) v += __builtin_bit_cast(float, __builtin_amdgcn_update_dpp(0, __builtin_bit_cast(int, v), ctrl, rmask, 0xf, false))
__device__ __forceinline__ void gla_prep_compute(const GlaPre& R, int dir, float* sBc) {
  const int tid = tid_(), lane = tid & 63, w = tid >> 6, r = lane & 31, hh = lane >> 5, pb = w >> 1, db = w & 1;
  {
    f32x16 x;
#pragma unroll
    for (int g = 0; g < 16; ++g) x[g] = R.bg;
    const float ae[8] = {R.a0[0], R.a0[2], R.a1[0], R.a1[2], R.a2[0], R.a2[2], R.a3[0], R.a3[2]};
    const float ao[8] = {R.a0[1], R.a0[3], R.a1[1], R.a1[3], R.a2[1], R.a2[3], R.a3[1], R.a3[3]};
    const float wv[8] = {R.wg0[0], R.wg0[1], R.wg0[2], R.wg0[3], R.wg1[0], R.wg1[1], R.wg1[2], R.wg1[3]};
#pragma unroll
    for (int s = 0; s < 8; ++s) x = __builtin_amdgcn_mfma_f32_32x32x2f32(hh ? ao[s] : ae[s], wv[s], x, 0, 0, 0);
#pragma unroll
    for (int g = 0; g < 16; ++g) {
      const int pos = 32 * pb + (g & 3) + 8 * (g >> 2) + 4 * hh;
      sBc[pos * 65 + 32 * db + r] = log_sigmoidf_(x[g]) * (1.f / 16.f);
    }
  }
  __syncthreads();
  {
    const int idx = dir ? 63 - lane : lane;
    float v[16];
#pragma unroll
    for (int dd = 0; dd < 16; ++dd) v[dd] = sBc[idx * 65 + w * 16 + dd];
#pragma unroll
    for (int dd = 0; dd < 16; ++dd) GLA_DPP_ADD(v[dd], 0x111, 0xf);
#pragma unroll
    for (int dd = 0; dd < 16; ++dd) GLA_DPP_ADD(v[dd], 0x112, 0xf);
#pragma unroll
    for (int dd = 0; dd < 16; ++dd) GLA_DPP_ADD(v[dd], 0x114, 0xf);
#pragma unroll
    for (int dd = 0; dd < 16; ++dd) GLA_DPP_ADD(v[dd], 0x118, 0xf);
#pragma unroll
    for (int dd = 0; dd < 16; ++dd) GLA_DPP_ADD(v[dd], 0x142, 0xa);
#pragma unroll
    for (int dd = 0; dd < 16; ++dd) GLA_DPP_ADD(v[dd], 0x143, 0xc);
#pragma unroll
    for (int dd = 0; dd < 16; ++dd) sBc[idx * 65 + w * 16 + dd] = v[dd];
  }
  __syncthreads();
}
__device__ __forceinline__ void chunk_pos(int b, int dir, int c, int& tok0, int& pall0) {
  if (c < 4) { int pc = dir ? 3 - c : c; tok0 = TLAT + b * 256 + pc * 64; pall0 = pc * 64; }
  else { int j = c - 4; int pc = dir ? 63 - j : j; tok0 = b * 4096 + pc * 64; pall0 = 256 + pc * 64; }
}
__device__ __forceinline__ void phase_gla1(PRef p, int layer, char* smem) {
  float* sWg = (float*)smem;
  float* sBc = (float*)(smem + 4096);
  bf16_t* sKt = (bf16_t*)(smem + 20736);
  bf16_t* sVt = (bf16_t*)(smem + 29952);
  const int tid = tid_(), lane = tid & 63, w = tid >> 6, r = lane & 31, hh = lane >> 5;
  for (int item = bid_(); item < 32 * NCHUNK; item += vgrid_()) {
    const int ch = item / NCHUNK, c = item % NCHUNK;
    const int dir = ch & 1, hd = (ch >> 1) & 3, b = ch >> 3;
    int tok0, pall0;
    chunk_pos(b, dir, c, tok0, pall0);
    GlaPre R;
    gla_prep_load(p, layer, hd, dir, tok0, R);
    u32x4 k0, k1, vv0, vv1, vv2, vv3;
    {
      const int pos = tid >> 2, dg = tid & 3;
      const bf16_t* kp = p.kB + (size_t)(tok0 + pos) * 256 + hd * 64 + dg * 16;
      k0 = *(const u32x4*)kp; k1 = *(const u32x4*)(kp + 8);
      const bf16_t* vb = p.vBT + (size_t)(b * 4 + hd) * 128 * PALL + pall0 + (tid & 7) * 8;
      vv0 = *(const u32x4*)(vb + (size_t)(tid >> 3) * PALL);
      vv1 = *(const u32x4*)(vb + (size_t)((tid >> 3) + 32) * PALL);
      vv2 = *(const u32x4*)(vb + (size_t)((tid >> 3) + 64) * PALL);
      vv3 = *(const u32x4*)(vb + (size_t)((tid >> 3) + 96) * PALL);
    }
    __syncthreads();
    gla_prep_compute(R, dir, sBc);
    {
      const int pos = tid >> 2, dg = tid & 3;
      float* bd = p.bcum + (size_t)item * 4096 + pos * 64 + dg * 16;
#pragma unroll
      for (int q4 = 0; q4 < 4; ++q4)
        *(float4*)(bd + 4 * q4) = make_float4(sBc[pos * 65 + dg * 16 + 4 * q4], sBc[pos * 65 + dg * 16 + 4 * q4 + 1], sBc[pos * 65 + dg * 16 + 4 * q4 + 2], sBc[pos * 65 + dg * 16 + 4 * q4 + 3]);
    }
    {
      int pos = tid >> 2, dg = tid & 3;
      unsigned ku[8] = {k0[0], k0[1], k0[2], k0[3], k1[0], k1[1], k1[2], k1[3]};
#pragma unroll
      for (int e = 0; e < 16; ++e) {
        int d = dg * 16 + e;
        float kv = bf2f((bf16_t)((e & 1) ? (ku[e >> 1] >> 16) : (ku[e >> 1] & 0xffff)));
        float bend = sBc[(dir ? 0 : 63) * 65 + d];
        sKt[d * 72 + pos] = f2bf(kv * __expf(bend - sBc[pos * 65 + d]));
      }
      {
        const int dv = tid >> 3, cc = tid & 7;
        *(u32x4*)(sVt + dv * 72 + cc * 8) = vv0;
        *(u32x4*)(sVt + (dv + 32) * 72 + cc * 8) = vv1;
        *(u32x4*)(sVt + (dv + 64) * 72 + cc * 8) = vv2;
        *(u32x4*)(sVt + (dv + 96) * 72 + cc * 8) = vv3;
      }
      if (tid < 64) p.decay[(size_t)item * 64 + tid] = __expf(sBc[(dir ? 0 : 63) * 65 + tid]);
    }
    __syncthreads();
    f32x16 acc[2];
    acc[0] = zero16();
    acc[1] = zero16();
#pragma unroll
    for (int s = 0; s < 4; ++s) {
      bf16x8 a = *(const bf16x8*)(sVt + (32 * w + r) * 72 + 16 * s + 8 * hh);
      bf16x8 b0 = *(const bf16x8*)(sKt + r * 72 + 16 * s + 8 * hh);
      bf16x8 b1 = *(const bf16x8*)(sKt + (32 + r) * 72 + 16 * s + 8 * hh);
      acc[0] = mfma32(b0, a, acc[0]);
      acc[1] = mfma32(b1, a, acc[1]);
    }
    float* dst = p.KVt + (size_t)item * 8192 + (32 * w + r) * 64 + 4 * hh;
#pragma unroll
    for (int jb = 0; jb < 2; ++jb)
#pragma unroll
      for (int g4 = 0; g4 < 4; ++g4)
        *(float4*)(dst + 32 * jb + 8 * g4) = make_float4(acc[jb][4 * g4], acc[jb][4 * g4 + 1], acc[jb][4 * g4 + 2], acc[jb][4 * g4 + 3]);
  }
}
__device__ __forceinline__ void phase_gla2(PRef p) {
  for (int idx = bid_() * 256 + tid_(); idx < 32 * 8192; idx += vgrid_() * 256) {
    const int ch = idx >> 13, e = idx & 8191;
    float S = 0.f;
    const float* kv = p.KVt + (size_t)ch * NCHUNK * 8192 + e;
    const float* dc = p.decay + (size_t)ch * NCHUNK * 64 + (e & 63);
    bf16_t* sp = p.SP + (size_t)ch * NCHUNK * 8192 + e;
#pragma unroll 4
    for (int c = 0; c < NCHUNK; ++c) {
      sp[(size_t)c * 8192] = f2bf(S);
      S = dc[c * 64] * S + kv[(size_t)c * 8192];
    }
  }
}
__device__ __forceinline__ void phase_gla3(PRef p, int layer, char* smem) {
  float* sWg = (float*)smem;
  float* sBc = (float*)(smem + 4096);
  bf16_t* sQ = (bf16_t*)(smem + 20736);
  bf16_t* sK = (bf16_t*)(smem + 29952);
  bf16_t* sVt = (bf16_t*)(smem + 39168);
  float* sRed = (float*)(smem + 57600);
  const int tid = tid_(), lane = tid & 63, w = tid >> 6, r = lane & 31, hh = lane >> 5;
  const int npc = layer == 0 ? 68 : 64;
  const int pr = 16 * (r >> 4) + 8 * ((r >> 2) & 1) + 4 * ((r >> 3) & 1) + (r & 3);
  for (int item = bid_(); item < 16 * npc; item += vgrid_()) {
    const int bh = item / npc;
    const int pca = (layer == 0) ? (item % npc) : (4 + item % npc);
    const int b = bh >> 2, hd = bh & 3;
    int tok0, pall0;
    chunk_pos(b, 0, pca, tok0, pall0);
    f32x16 O[2];
    O[0] = zero16();
    O[1] = zero16();
    const int c0 = pca, c1 = (pca < 4) ? 3 - pca : 4 + (63 - (pca - 4));
    f32x4v bA[4], bB[4];
    u32x4 q0, q1, k0, k1, vv0, vv1, vv2, vv3;
    {
      const int pos = tid >> 2, dg = tid & 3;
      const float* b0p = p.bcum + ((size_t)((b * 4 + hd) * 2 + 0) * NCHUNK + c0) * 4096 + pos * 64 + dg * 16;
      const float* b1p = p.bcum + ((size_t)((b * 4 + hd) * 2 + 1) * NCHUNK + c1) * 4096 + pos * 64 + dg * 16;
#pragma unroll
      for (int q4 = 0; q4 < 4; ++q4) { bA[q4] = *(const f32x4v*)(b0p + 4 * q4); bB[q4] = *(const f32x4v*)(b1p + 4 * q4); }
      const bf16_t* qp = p.qB + (size_t)(tok0 + pos) * 256 + hd * 64 + dg * 16;
      const bf16_t* kp = p.kB + (size_t)(tok0 + pos) * 256 + hd * 64 + dg * 16;
      q0 = *(const u32x4*)qp; q1 = *(const u32x4*)(qp + 8);
      k0 = *(const u32x4*)kp; k1 = *(const u32x4*)(kp + 8);
      const bf16_t* vb = p.vBT + (size_t)(b * 4 + hd) * 128 * PALL + pall0 + (tid & 7) * 8;
      vv0 = *(const u32x4*)(vb + (size_t)(tid >> 3) * PALL);
      vv1 = *(const u32x4*)(vb + (size_t)((tid >> 3) + 32) * PALL);
      vv2 = *(const u32x4*)(vb + (size_t)((tid >> 3) + 64) * PALL);
      vv3 = *(const u32x4*)(vb + (size_t)((tid >> 3) + 96) * PALL);
    }
    __syncthreads();
    {
      const int dv = tid >> 3, cc = tid & 7;
      *(u32x4*)(sVt + dv * 72 + cc * 8) = vv0;
      *(u32x4*)(sVt + (dv + 32) * 72 + cc * 8) = vv1;
      *(u32x4*)(sVt + (dv + 64) * 72 + cc * 8) = vv2;
      *(u32x4*)(sVt + (dv + 96) * 72 + cc * 8) = vv3;
    }
#pragma unroll
    for (int dir = 0; dir < 2; ++dir) {
      if (dir == 1) __syncthreads();
      {
        int pos = tid >> 2, dg = tid & 3;
        unsigned qu[8] = {q0[0], q0[1], q0[2], q0[3], q1[0], q1[1], q1[2], q1[3]};
        unsigned ku[8] = {k0[0], k0[1], k0[2], k0[3], k1[0], k1[1], k1[2], k1[3]};
        unsigned qo[8], ko[8];
#pragma unroll
        for (int e2 = 0; e2 < 8; ++e2) {
          const float b0 = dir ? bB[e2 >> 1][(2 * e2) & 3] : bA[e2 >> 1][(2 * e2) & 3];
          const float b1 = dir ? bB[e2 >> 1][(2 * e2 + 1) & 3] : bA[e2 >> 1][(2 * e2 + 1) & 3];
          const float ea0 = __expf(b0), ea1 = __expf(b1), ia0 = __builtin_amdgcn_rcpf(ea0), ia1 = __builtin_amdgcn_rcpf(ea1);
          qo[e2] = pack2(bf2f((bf16_t)(qu[e2] & 0xffff)) * ea0, bf2f((bf16_t)(qu[e2] >> 16)) * ea1);
          ko[e2] = pack2(bf2f((bf16_t)(ku[e2] & 0xffff)) * ia0, bf2f((bf16_t)(ku[e2] >> 16)) * ia1);
        }
        *(uint4*)(sQ + pos * 72 + dg * 16) = make_uint4(qo[0], qo[1], qo[2], qo[3]);
        *(uint4*)(sQ + pos * 72 + dg * 16 + 8) = make_uint4(qo[4], qo[5], qo[6], qo[7]);
        *(uint4*)(sK + pos * 72 + dg * 16) = make_uint4(ko[0], ko[1], ko[2], ko[3]);
        *(uint4*)(sK + pos * 72 + dg * 16 + 8) = make_uint4(ko[4], ko[5], ko[6], ko[7]);
      }
      __syncthreads();
      const int c = dir ? c1 : c0;
      const int ch = (b * 4 + hd) * 2 + dir;
      const bf16_t* sp = p.SP + ((size_t)ch * NCHUNK + c) * 8192 + (size_t)(32 * w + r) * 64 + 8 * hh;
      bf16x8 bqf[2][4];
#pragma unroll
      for (int tb = 0; tb < 2; ++tb)
#pragma unroll
        for (int ks = 0; ks < 4; ++ks) bqf[tb][ks] = *(const bf16x8*)(sQ + (32 * tb + r) * 72 + 16 * ks + 8 * hh);
#pragma unroll
      for (int ks = 0; ks < 4; ++ks) {
        bf16x8 a = *(const bf16x8*)(sp + 16 * ks);
        O[0] = mfma32(a, bqf[0][ks], O[0]);
        O[1] = mfma32(a, bqf[1][ks], O[1]);
      }
#pragma unroll
      for (int sb = 0; sb < 2; ++sb)
#pragma unroll
        for (int tb = 0; tb < 2; ++tb) {
          const bool skip = dir == 0 ? (sb == 1 && tb == 0) : (sb == 0 && tb == 1);
          if (skip) continue;
          f32x16 Sc = zero16();
#pragma unroll
          for (int ks = 0; ks < 4; ++ks) {
            bf16x8 a = *(const bf16x8*)(sK + (32 * sb + pr) * 72 + 16 * ks + 8 * hh);
            Sc = mfma32(a, bqf[tb][ks], Sc);
          }
          const int t = 32 * tb + r;
#pragma unroll
          for (int g = 0; g < 16; ++g) {
            int s = 32 * sb + 16 * (g >> 3) + 4 * ((g >> 2) & 1) + (g & 3) + 8 * hh;
            bool keep = dir == 0 ? (t >= s) : (s >= t);
            Sc[g] = keep ? Sc[g] : 0.f;
          }
#pragma unroll
          for (int s2 = 0; s2 < 2; ++s2) {
            const int sp4 = 2 * sb + s2;
            u32x4 bpu = {pack2(Sc[8 * s2], Sc[8 * s2 + 1]), pack2(Sc[8 * s2 + 2], Sc[8 * s2 + 3]), pack2(Sc[8 * s2 + 4], Sc[8 * s2 + 5]),
                         pack2(Sc[8 * s2 + 6], Sc[8 * s2 + 7])};
            bf16x8 bp = __builtin_bit_cast(bf16x8, bpu);
            bf16x8 av = *(const bf16x8*)(sVt + (32 * w + r) * 72 + 16 * sp4 + 8 * hh);
            O[tb] = mfma32(av, bp, O[tb]);
          }
        }
    }
    float ss[2];
#pragma unroll
    for (int tb = 0; tb < 2; ++tb) {
      float s = 0.f;
#pragma unroll
      for (int g = 0; g < 16; ++g) s += O[tb][g] * O[tb][g];
      s += __shfl_xor(s, 32);
      ss[tb] = s;
    }
    if (hh == 0) { sRed[w * 64 + r] = ss[0]; sRed[w * 64 + 32 + r] = ss[1]; }
    __syncthreads();
    f32x4v gnv[4];
#pragma unroll
    for (int g4 = 0; g4 < 4; ++g4) gnv[g4] = *(const f32x4v*)(p.gla_norm + layer * 128 + 32 * w + 8 * g4 + 4 * hh);
#pragma unroll
    for (int tb = 0; tb < 2; ++tb) {
      int t = 32 * tb + r;
      float tot = sRed[t] + sRed[64 + t] + sRed[128 + t] + sRed[192 + t];
      float rstd = rsqrtf(tot * (1.f / 128.f) + 1e-6f);
      const int tok = tok0 + t;
#pragma unroll
      for (int g4 = 0; g4 < 4; ++g4) {
        int dv = 32 * w + 8 * g4 + 4 * hh;
        uint2 rr = *(const uint2*)(p.rB + (size_t)tok * 512 + hd * 128 + dv);
        float rg[4] = {bf2f((bf16_t)(rr.x & 0xffff)), bf2f((bf16_t)(rr.x >> 16)), bf2f((bf16_t)(rr.y & 0xffff)), bf2f((bf16_t)(rr.y >> 16))};
        float o[4];
#pragma unroll
        for (int e = 0; e < 4; ++e) o[e] = O[tb][4 * g4 + e] * rstd * gnv[g4][e] * siluf(rg[e]);
        *(uint2*)(p.oB + (size_t)tok * 512 + hd * 128 + dv) = make_uint2(pack2(o[0], o[1]), pack2(o[2], o[3]));
      }
    }
  }
}

#define PHASE_KERNEL(name, call)                                               \
  __global__ void __launch_bounds__(512, 2) name(Params p_, int layer) {       \
    __shared__ __attribute__((aligned(16))) char smem_all[2 * SMEM_BYTES];     \
    char* smem = smem_all + half_() * SMEM_BYTES;                              \
    PRef p = params_view();                                           \
    call;                                                                      \
  }
PHASE_KERNEL(k_setup, phase_setup(p, smem))
PHASE_KERNEL(k_modreduce, phase_modreduce(p))
PHASE_KERNEL(k_convert, phase_convert(p, layer, smem))
PHASE_KERNEL(k_rowpass0, phase_rowpass0(p))
PHASE_KERNEL(k_inproj, phase_inproj(p, layer, smem_all))
PHASE_KERNEL(k_attnA, phase_attnA(p, layer, smem_all))
PHASE_KERNEL(k_na, phase_na(p, layer, smem))
PHASE_KERNEL(k_gla1, phase_gla1(p, layer, smem))
PHASE_KERNEL(k_gla2, phase_gla2(p))
PHASE_KERNEL(k_gla3, phase_gla3(p, layer, smem))
PHASE_KERNEL(k_merge, phase_merge(p, layer, smem_all))
PHASE_KERNEL(k_outproj, phase_outproj(p, layer, smem_all))
PHASE_KERNEL(k_rowpass1, phase_rowpass1(p, layer, smem))
PHASE_KERNEL(k_moescan, phase_moescan(p, layer, smem))
PHASE_KERNEL(k_moe1, phase_moe1(p, layer, smem_all))
PHASE_KERNEL(k_moe2, phase_moe2(p, layer, smem_all))
PHASE_KERNEL(k_rowpass2, phase_rowpass2(p, layer))

#define XB_TMO      128
#define XB_XCNT(j)  (256  + 64 * (j))
#define XB_XSUB(j)  (1280 + 64 * (j))
#define XB_XGEN(j)  (2304 + 64 * (j))
#define XB_TOP      3328
#define XB_TOPGEN   3392
#define XCD_BAR_WORDS 3456
#define XB_SPIN_CAP (1u << 23)
#define LAS __attribute__((address_space(3)))
__device__ __forceinline__ unsigned xb_ld(unsigned* p) { return __hip_atomic_load(p, __ATOMIC_RELAXED, __HIP_MEMORY_SCOPE_AGENT); }
__device__ __forceinline__ unsigned xb_add(unsigned* p, unsigned v) { return __hip_atomic_fetch_add(p, v, __ATOMIC_RELAXED, __HIP_MEMORY_SCOPE_AGENT); }
__device__ __forceinline__ unsigned xb_xcc_id() { return (unsigned)__builtin_amdgcn_s_getreg((3 << 11) | 20) & 0xFu; }
#define XB_SPIN(cond, bar) do { unsigned _sp = 0; while (cond) { __builtin_amdgcn_s_sleep(1); \
    if ((++_sp & 255u) == 0u) { if (xb_ld(&(bar)[XB_TMO])) break; if (_sp > XB_SPIN_CAP) { atomicAdd(&(bar)[XB_TMO], 1u); break; } } } } while (0)
struct XcdBarrier { unsigned* bar; unsigned x; volatile LAS unsigned* st; };
__device__ __forceinline__ XcdBarrier xcd_barrier_post(unsigned* bar, volatile LAS unsigned* st) {
  XcdBarrier b; b.bar = bar; b.x = xb_xcc_id(); b.st = st;
  if (__builtin_amdgcn_workitem_id_x() == 0) (void)xb_add(&bar[XB_XCNT(b.x)], 1u);
  return b;
}
__device__ __forceinline__ void xcd_barrier_complete(unsigned* bar, unsigned x, unsigned& nloc, unsigned& nx) {
  const unsigned G = gridDim.x * gridDim.y * gridDim.z;
  unsigned sum, cnt, mine, sp = 0u;
  for (;;) {
    sum = 0u; cnt = 0u; mine = 0u;
#pragma unroll
    for (unsigned j = 0; j < 16; ++j) { const unsigned c = xb_ld(&bar[XB_XCNT(j)]); sum += c; cnt += (c > 0u) ? 1u : 0u; mine = (j == x) ? c : mine; }
    if (sum == G) break;
    __builtin_amdgcn_s_sleep(1);
    if ((++sp & 255u) == 0u) { if (xb_ld(&bar[XB_TMO])) break; if (sp > XB_SPIN_CAP) { atomicAdd(&bar[XB_TMO], 1u); break; } }
  }
  nloc = mine > 0u ? mine : 1u; nx = cnt > 0u ? cnt : 1u;
}
__device__ __forceinline__ void xcd_barrier(const XcdBarrier& b) {
  asm volatile("s_waitcnt vmcnt(0)" ::: "memory");
  __syncthreads();
  if (__builtin_amdgcn_workitem_id_x() == 0) {
    unsigned* bar = b.bar;
    __builtin_amdgcn_s_waitcnt(0);
    unsigned nloc = b.st[0], nx = b.st[1];
    if (nloc == 0u) { xcd_barrier_complete(bar, b.x, nloc, nx); b.st[0] = nloc; b.st[1] = nx; }
    const unsigned old = xb_add(&bar[XB_XSUB(b.x)], 1u);
    const unsigned gen = old / nloc;
    if (old + 1u == (gen + 1u) * nloc) {
      __builtin_amdgcn_fence(__ATOMIC_RELEASE, "agent");
      asm volatile("s_waitcnt vmcnt(0)" ::: "memory");
      const unsigned og = xb_add(&bar[XB_TOP], 1u);
      const unsigned tg = og / nx;
      if (og + 1u == (tg + 1u) * nx) xb_add(&bar[XB_TOPGEN], 1u);
      else XB_SPIN(xb_ld(&bar[XB_TOPGEN]) == tg, bar);
      __builtin_amdgcn_fence(__ATOMIC_ACQUIRE, "agent");
      xb_add(&bar[XB_XGEN(b.x)], 1u);
      asm volatile("s_waitcnt vmcnt(0)" ::: "memory");
    } else {
      XB_SPIN(xb_ld(&bar[XB_XGEN(b.x)]) == gen, bar);
      __builtin_amdgcn_fence(__ATOMIC_ACQUIRE, "agent");
      asm volatile("s_waitcnt vmcnt(0)" ::: "memory");
    }
  }
  __syncthreads();
}

__global__ void __launch_bounds__(512, 2) k_mega(Params p_) {
  __shared__ __attribute__((aligned(16))) char smem_all[2 * SMEM_BYTES + 16];
  volatile LAS unsigned* st = (volatile LAS unsigned*)(smem_all + 2 * SMEM_BYTES);
  if (__builtin_amdgcn_workitem_id_x() == 0) { st[0] = 0u; st[1] = 0u; }
  __syncthreads();
  const XcdBarrier xb = xcd_barrier_post(p_.bar, st);
#pragma unroll 1
  for (int ph = 0; ph < 25; ++ph) {
    int l = (ph >= 14) ? 1 : 0;
    int q = (ph < 3) ? ph : 3 + (ph - 3) % 11;
    l = __builtin_amdgcn_readfirstlane(l);
    q = __builtin_amdgcn_readfirstlane(q);
#ifdef PROBE_MASK
    const unsigned long long pt0 = __builtin_amdgcn_s_memrealtime();
#endif
    PRef p = params_view();
    char* smem = smem_all + half_() * SMEM_BYTES;
    switch (q) {
      case 0: phase_setup(p, smem); phase_convert(p, 0, smem); break;
      case 1: phase_modreduce(p); break;
      case 2: phase_rowpass0(p); break;
      case 3: phase_inproj(p, l, smem_all); break;
      case 4: phase_gla1(p, l, smem); phase_na(p, l, smem); break;
      case 5: phase_gla2(p); phase_attnA(p, l, smem_all); break;
      case 6: phase_gla3(p, l, smem); break;
      case 7: phase_merge(p, l, smem_all); break;
      case 8: phase_outproj(p, l, smem_all); break;
      case 9: phase_rowpass1(p, l, smem); break;
      case 10: phase_moescan(p, l, smem); phase_convert(p, l | 16, smem); break;
      case 11: phase_moe1(p, l, smem_all); break;
      case 12: phase_moe2(p, l, smem_all); break;
      default: phase_rowpass2(p, l); if (l == 0) phase_convert(p, 1, smem); break;
    }
    if (ph != 24) xcd_barrier(xb);
#ifdef PROBE_MASK
    if ((PROBE_MASK >> q) & 1) {
      const unsigned long long pt1 = __builtin_amdgcn_s_memrealtime();
      while (__builtin_amdgcn_s_memrealtime() - pt1 < (pt1 - pt0)) __builtin_amdgcn_s_sleep(8);
    }
#endif
  }
}

#ifdef DIAG_STAGE
__device__ __forceinline__ unsigned dhash(unsigned s) { s ^= s >> 16; s *= 0x7feb352dU; s ^= s >> 15; s *= 0x846ca68bU; s ^= s >> 16; return s; }
__device__ __forceinline__ void diag_accum(double num, double den, double* accum, double* sred) {
  const int tid = threadIdx.x;
  __syncthreads();
  sred[tid] = num; sred[256 + tid] = den;
  __syncthreads();
  for (int o = 128; o > 0; o >>= 1) { if (tid < o) { sred[tid] += sred[tid + o]; sred[256 + tid] += sred[256 + tid + o]; } __syncthreads(); }
  if (tid == 0) { atomicAdd(&accum[0], sred[0]); atomicAdd(&accum[1], sred[256]); }
}
__device__ __forceinline__ int diag_tok(int s, int ns) {
  if (s < 8) return TLAT + (dhash(s + 77) % TCTX);
  if (s == 8) return 0; if (s == 9) return TLAT - 1; if (s == 10) return 4095; if (s == 11) return 4096;
  return dhash(s * 31 + 5) % TLAT;
}
__global__ void k_diag_zero(double* accum) { if (threadIdx.x < 32) accum[threadIdx.x] = 0.0; }
__global__ void k_diag_report(const double* accum, float* out, int n) {
  int i = blockIdx.x * 256 + threadIdx.x;
  for (; i < n; i += gridDim.x * 256) out[i] = 0.f;
  if (blockIdx.x == 0 && threadIdx.x == 0) {
    double E = 0.0;
    for (int k = 0; k < 16; ++k) {
      if (accum[2 * k + 1] > 0.0) { double e = accum[2 * k] / accum[2 * k + 1]; if (!(e == e)) e = 100.0; if (e > E) E = e; }
    }
    out[0] = (float)(4.096e7 * sqrt(E));
  }
}
__global__ void __launch_bounds__(256) k_chk_h(Params p, double* accum) {
  __shared__ double sred[512];
  __shared__ float sx[1024];
  const int tid = threadIdx.x;
  int tok = diag_tok(blockIdx.x, gridDim.x);
  const float* src = tok < TLAT ? p.x + (size_t)tok * D : p.ctx + (size_t)(tok - TLAT) * D;
  const float* cv = tok < TLAT ? p.c + (tok >> 12) * 1024 : p.c_ctx;
  double s = 0, q = 0;
  for (int i = 0; i < 1024; ++i) s += src[i];
  double mean = s / 1024;
  for (int i = 0; i < 1024; ++i) { double d = src[i] - mean; q += d * d; }
  double rstd = 1.0 / sqrt(q / 1024 + 1e-6);
  double num = 0, den = 0;
  for (int n = tid; n < 1024; n += 256) {
    double sh = p.b_mod[n], sc = p.b_mod[1024 + n];
    for (int k = 0; k < 1024; ++k) {
      double cc = cv[k]; double sl = cc / (1.0 + exp(-cc));
      sh += sl * p.w_mod[(size_t)k * NMOD + n];
      sc += sl * p.w_mod[(size_t)k * NMOD + 1024 + n];
    }
    double ref = (src[n] - mean) * rstd * (1.0 + sc) + sh;
    double got = bf2f(p.h[(size_t)tok * D + n]);
    num += (got - ref) * (got - ref); den += ref * ref;
  }
  diag_accum(num, den, accum, sred);
}
__global__ void __launch_bounds__(256) k_chk_inproj(Params p, int layer, double* accum) {
  __shared__ double sred[512];
  __shared__ float sz[3872];
  __shared__ float sh[1024];
  const int tid = threadIdx.x;
  int tok = diag_tok(blockIdx.x, gridDim.x);
  for (int i = tid; i < 1024; i += 256) sh[i] = bf2f(p.h[(size_t)tok * D + i]);
  __syncthreads();
  const float* W = p.w_in + (size_t)layer * 1024 * NIN_SRC;
  for (int j = tid; j < 3872; j += 256) {
    double a = p.b_in[layer * NIN_SRC + j];
    for (int k = 0; k < 1024; ++k) a += (double)sh[k] * W[(size_t)k * NIN_SRC + j];
    sz[j] = (float)a;
  }
  __syncthreads();
  const bool lat = tok < TLAT;
  int b, t, pall;
  if (lat) { b = tok >> 12; t = tok & 4095; pall = 256 + t; } else { int ci = tok - TLAT; b = ci >> 8; t = ci & 255; pall = t; }
  double num = 0, den = 0;
  for (int j = tid; j < 3872; j += 256) {
    double ref, got;
    if (j < 640) {
      int hb = (j >> 6) << 6, d = j & 63;
      double ss = 0;
      for (int e = 0; e < 64; ++e) ss += (double)sz[hb + e] * sz[hb + e];
      double rstd = 1.0 / sqrt(ss / 64 + 1e-6);
      const float* gn = (j < 512 ? p.q_norm : p.k_norm) + layer * 64;
      double xn = sz[j] * rstd * gn[d];
      if (lat) {
        int qd = d >> 4, f = d & 15;
        int dp = d ^ 16;
        double pn = sz[hb + dp] * rstd * gn[dp];
        double pos = (qd < 2) ? (double)(t >> 6) : (double)(t & 63);
        float inv = powf(10000.f, -(float)f / 16.f);
        float ang = (float)pos * inv;
        double cs = cos((double)ang), sn = sin((double)ang);
        double rot = (qd & 1) ? pn : -pn;
        xn = xn * cs + rot * sn;
      }
      if (j < 512) { ref = xn * QSCALE; got = bf2f(p.qA[(size_t)tok * 512 + j]); }
      else { int kvh = (j - 512) >> 6; ref = xn; got = bf2f(p.kA[((size_t)(b * 2 + kvh) * PALL + pall) * 64 + d]); }
    } else if (j < 768) { int c = j - 640; ref = sz[j]; got = bf2f(p.vAT[((size_t)(b * 2 + (c >> 6)) * 64 + (c & 63)) * PALL + pall]); }
    else if (j < 1024) { ref = sz[j] * 0.125; got = bf2f(p.qB[(size_t)tok * 256 + (j - 768)]); }
    else if (j < 1280) { ref = sz[j]; got = bf2f(p.kB[(size_t)tok * 256 + (j - 1024)]); }
    else if (j < 1792) { int c = j - 1280; ref = sz[j]; got = bf2f(p.vBT[((size_t)(b * 4 + (c >> 7)) * 128 + (c & 127)) * PALL + pall]); }
    else if (j < 2304) { ref = sz[j]; got = bf2f(p.rB[(size_t)tok * 512 + (j - 1792)]); }
    else if (j < 2336) { ref = sz[j]; got = p.aB[(size_t)tok * 32 + (j - 2304)]; }
    else if (j < 2848) { ref = sz[j] * QSCALE; got = bf2f(p.qC[(size_t)tok * 512 + (j - 2336)]); }
    else if (j < 3360) { ref = sz[j]; got = bf2f(p.kC[(size_t)tok * 512 + (j - 2848)]); }
    else { int c = j - 3360; ref = sz[j]; got = bf2f(p.vCT[((size_t)(b * 8 + (c >> 6)) * 64 + (c & 63)) * PALL + pall]); }
    num += (got - ref) * (got - ref); den += ref * ref;
  }
  diag_accum(num, den, accum, sred);
}
__global__ void __launch_bounds__(256) k_chk_attnA(Params p, int layer, double* accum) {
  __shared__ double sred[512];
  __shared__ float sp[4352];
  __shared__ float sq[64];
  __shared__ float so[64];
  const int tid = threadIdx.x;
  int tok = diag_tok(blockIdx.x >> 1, gridDim.x);
  if (layer == 1 && tok >= TLAT) tok = dhash(blockIdx.x) % TLAT;
  int head = dhash(blockIdx.x * 7 + 1) & 7, kvh = head >> 2;
  const bool lat = tok < TLAT;
  int b = lat ? tok >> 12 : (tok - TLAT) >> 8;
  int nk = lat ? PALL : 256;
  if (tid < 64) sq[tid] = bf2f(p.qA[(size_t)tok * 512 + head * 64 + tid]);
  __syncthreads();
  const bf16_t* kb = p.kA + (size_t)(b * 2 + kvh) * PALL * 64;
#pragma unroll 1
  for (int j = tid; j < nk; j += 256) {
    float s = 0.f;
#pragma unroll 1
    for (int d = 0; d < 64; ++d) s += sq[d] * bf2f(kb[(size_t)j * 64 + d]);
    sp[j] = s;
  }
  __syncthreads();
  float mx = -1e30f;
#pragma unroll 1
  for (int j = 0; j < nk; ++j) mx = fmaxf(mx, sp[j]);
  __syncthreads();
  for (int j = tid; j < nk; j += 256) sp[j] = exp2f(sp[j] - mx);
  __syncthreads();
  double num = 0, den = 0;
  if (tid < 64) {
    double l = 0, o = 0;
    const bf16_t* vb = p.vAT + ((size_t)(b * 2 + kvh) * 64 + tid) * PALL;
#pragma unroll 1
    for (int j = 0; j < nk; ++j) { l += sp[j]; o += (double)sp[j] * bf2f(vb[j]); }
    double ref = o / l, got = bf2f(p.oA[(size_t)tok * 512 + head * 64 + tid]);
    num = (got - ref) * (got - ref); den = ref * ref;
  }
  diag_accum(num, den, accum, sred);
}
__global__ void __launch_bounds__(256) k_chk_na(Params p, int layer, double* accum) {
  __shared__ double sred[512];
  __shared__ float sp[384];
  __shared__ int spos[384];
  __shared__ float sq[64];
  const int tid = threadIdx.x;
  int tok = diag_tok(blockIdx.x >> 1, gridDim.x);
  if (layer == 1 && tok >= TLAT) tok = dhash(blockIdx.x) % TLAT;
  int head = dhash(blockIdx.x * 13 + 3) & 7;
  const bool lat = tok < TLAT;
  int b = lat ? tok >> 12 : (tok - TLAT) >> 8;
  if (tid < 64) sq[tid] = bf2f(p.qC[(size_t)tok * 512 + head * 64 + tid]);
  __syncthreads();
  int nk = lat ? 384 : 256;
  for (int j = tid; j < nk; j += 256) {
    int ktok, kpall; float bias = 0.f;
    if (lat && j < 128) {
      int t = tok & 4095, r = t >> 6, w = t & 63;
      int rs = r - 4; rs = rs < 0 ? 0 : (rs > 56 ? 56 : rs);
      int cs = w - 8; cs = cs < 0 ? 0 : (cs > 48 ? 48 : cs);
      int i = j >> 4, jj = j & 15;
      int kr = rs + i, kc = cs + jj;
      ktok = b * 4096 + kr * 64 + kc; kpall = 256 + kr * 64 + kc;
      bias = p.rpb[(((size_t)layer * 8 + head) * 15 + (kr - r + 7)) * 31 + (kc - w + 15)] * LOG2E;
    } else {
      int c = lat ? j - 128 : j;
      ktok = TLAT + b * 256 + c; kpall = c;
    }
    float s = 0.f;
    for (int d = 0; d < 64; ++d) s += sq[d] * bf2f(p.kC[(size_t)ktok * 512 + head * 64 + d]);
    sp[j] = s + bias; spos[j] = kpall;
  }
  __syncthreads();
  float mx = -1e30f;
  for (int j = 0; j < nk; ++j) mx = fmaxf(mx, sp[j]);
  __syncthreads();
  for (int j = tid; j < nk; j += 256) sp[j] = exp2f(sp[j] - mx);
  __syncthreads();
  double num = 0, den = 0;
  if (tid < 64) {
    double l = 0, o = 0;
    const bf16_t* vb = p.vCT + ((size_t)(b * 8 + head) * 64 + tid) * PALL;
    for (int j = 0; j < nk; ++j) { l += sp[j]; o += (double)sp[j] * bf2f(vb[spos[j]]); }
    double ref = o / l, got = bf2f(p.oC[(size_t)tok * 512 + head * 64 + tid]);
    num = (got - ref) * (got - ref); den = ref * ref;
  }
  diag_accum(num, den, accum, sred);
}
__device__ constexpr int gla_sp(int i) { return i == 0 ? 0 : i == 1 ? 255 : i == 2 ? 256 : i == 3 ? 319 : i == 4 ? 320 : i == 5 ? 1257 : i == 6 ? 2756 : 4351; }
__global__ void __launch_bounds__(256) k_chk_gla(Params p, int layer, double* accum) {
  __shared__ double sred[512];
  __shared__ float sal[64], sqv[64], skv[64];
  __shared__ float sred2[128];
  const int tid = threadIdx.x;
  const int b = blockIdx.x >> 2, hd = blockIdx.x & 3;
  constexpr int NSP = 8;
  float osum[NSP];
#pragma unroll
  for (int i = 0; i < NSP; ++i) osum[i] = 0.f;
  for (int dir = 0; dir < 2; ++dir) {
    float S[64];
#pragma unroll
    for (int d = 0; d < 64; ++d) S[d] = 0.f;
#pragma unroll 1
    for (int step = 0; step < PALL; ++step) {
      int pall;
      if (step < 256) pall = dir ? 255 - step : step; else { int j = step - 256; pall = 256 + (dir ? 4095 - j : j); }
      int tok = pall < 256 ? TLAT + b * 256 + pall : b * 4096 + (pall - 256);
      __syncthreads();
      if (tid < 64) {
        float xv = p.gla_bg[((size_t)layer * 2 + dir) * 256 + hd * 64 + tid];
        for (int r = 0; r < 16; ++r) xv += p.aB[(size_t)tok * 32 + dir * 16 + r] * p.gla_wg[(((size_t)layer * 2 + dir) * 16 + r) * 256 + hd * 64 + tid];
        float ls = fminf(xv, 0.f) - log1pf(expf(-fabsf(xv)));
        sal[tid] = expf(ls / 16.f);
        sqv[tid] = bf2f(p.qB[(size_t)tok * 256 + hd * 64 + tid]);
        skv[tid] = bf2f(p.kB[(size_t)tok * 256 + hd * 64 + tid]);
      }
      __syncthreads();
      if (tid < 128) {
        float v = bf2f(p.vBT[((size_t)(b * 4 + hd) * 128 + tid) * PALL + pall]);
        float o = 0.f;
#pragma unroll
        for (int d = 0; d < 64; ++d) { S[d] = sal[d] * S[d] + skv[d] * v; o += sqv[d] * S[d]; }
#pragma unroll
        for (int i = 0; i < NSP; ++i) if (gla_sp(i) == pall) osum[i] += o;
      }
    }
  }
  double num = 0, den = 0;
#pragma unroll
  for (int i = 0; i < NSP; ++i) {
    if (layer == 1 && gla_sp(i) < 256) continue;
    __syncthreads();
    if (tid < 128) sred2[tid] = osum[i] * osum[i];
    __syncthreads();
    float tot = 0.f;
    for (int j = 0; j < 128; ++j) tot += sred2[j];
    if (tid < 128) {
      int pall = gla_sp(i);
      int tok = pall < 256 ? TLAT + b * 256 + pall : b * 4096 + (pall - 256);
      float rstd = 1.f / sqrtf(tot / 128.f + 1e-6f);
      float rg = bf2f(p.rB[(size_t)tok * 512 + hd * 128 + tid]);
      double ref = osum[i] * rstd * p.gla_norm[layer * 128 + tid] * (rg / (1.f + expf(-rg)));
      double got = bf2f(p.oB[(size_t)tok * 512 + hd * 128 + tid]);
      num += (got - ref) * (got - ref); den += ref * ref;
    }
  }
  diag_accum(num, den, accum, sred);
}
__global__ void __launch_bounds__(256) k_chk_merge(Params p, int layer, double* accum) {
  __shared__ double sred[512];
  const int tid = threadIdx.x;
  int tok = diag_tok(blockIdx.x, gridDim.x);
  if (layer == 1 && tok >= TLAT) tok = dhash(blockIdx.x) % TLAT;
  const float* W = p.w_in + (size_t)layer * 1024 * NIN_SRC;
  double num = 0, den = 0;
  for (int n = tid; n < 1024; n += 256) {
    double tot = 0;
    for (int br = 0; br < 3; ++br) {
      double g = p.b_in[layer * NIN_SRC + 3872 + br * 1024 + n];
      for (int k = 0; k < 1024; ++k) g += (double)bf2f(p.h[(size_t)tok * D + k]) * W[(size_t)k * NIN_SRC + 3872 + br * 1024 + n];
      g = 1.0 / (1.0 + exp(-g));
      const bf16_t* ob = br == 0 ? p.oA : (br == 1 ? p.oB : p.oC);
      const float* wb = (br == 0 ? p.w_br_attn : (br == 1 ? p.w_br_gla : p.w_br_na)) + (size_t)layer * 512 * 1024;
      double a = 0;
      for (int j = 0; j < 512; ++j) a += (double)bf2f(ob[(size_t)tok * 512 + j]) * wb[(size_t)j * 1024 + n];
      tot += g * a;
    }
    double got = bf2f(p.m[(size_t)tok * D + n]);
    num += (got - tot) * (got - tot); den += tot * tot;
  }
  diag_accum(num, den, accum, sred);
}
__global__ void __launch_bounds__(256) k_chk_x1(Params p, double* accum) {
  __shared__ double sred[512];
  __shared__ double sv[1024];
  __shared__ double sx1[1024];
  __shared__ double sst[4];
  const int tid = threadIdx.x;
  int tok = diag_tok(blockIdx.x, gridDim.x);
  const float* cv = tok < TLAT ? p.c + (tok >> 12) * 1024 : p.c_ctx;
  const float* xin = tok < TLAT ? p.x + (size_t)tok * D : p.ctx + (size_t)(tok - TLAT) * D;
  for (int n = tid; n < 1024; n += 256) {
    double y = 0, g1 = p.b_mod[2048 + n];
    for (int k = 0; k < 1024; ++k) {
      y += (double)bf2f(p.m[(size_t)tok * D + k]) * p.w_out[(size_t)k * 1024 + n];
      double cc = cv[k]; g1 += cc / (1.0 + exp(-cc)) * p.w_mod[(size_t)k * NMOD + 2048 + n];
    }
    sv[n] = 1.4142135623730951 * xin[n] + g1 * y;
  }
  __syncthreads();
  if (tid == 0) { double s = 0, q = 0; for (int i = 0; i < 1024; ++i) s += sv[i]; s /= 1024; for (int i = 0; i < 1024; ++i) q += (sv[i] - s) * (sv[i] - s); sst[0] = s; sst[1] = 1.0 / sqrt(q / 1024 + 1e-6); }
  __syncthreads();
  double num = 0, den = 0;
  for (int n = tid; n < 1024; n += 256) {
    double x1 = (sv[n] - sst[0]) * sst[1] * p.ln1_g[n] + p.ln1_b[n];
    sx1[n] = x1;
    double got = p.xres[(size_t)tok * D + n];
    num += (got - x1) * (got - x1); den += x1 * x1;
  }
  __syncthreads();
  if (tid == 0) { double s = 0, q = 0; for (int i = 0; i < 1024; ++i) s += sx1[i]; s /= 1024; for (int i = 0; i < 1024; ++i) q += (sx1[i] - s) * (sx1[i] - s); sst[2] = s; sst[3] = 1.0 / sqrt(q / 1024 + 1e-6); }
  __syncthreads();
  for (int n = tid; n < 1024; n += 256) {
    double sh = p.b_mod[3072 + n], sc = p.b_mod[4096 + n];
    for (int k = 0; k < 1024; ++k) { double cc = cv[k]; double sl = cc / (1.0 + exp(-cc)); sh += sl * p.w_mod[(size_t)k * NMOD + 3072 + n]; sc += sl * p.w_mod[(size_t)k * NMOD + 4096 + n]; }
    double h2 = (sx1[n] - sst[2]) * sst[3] * (1.0 + sc) + sh;
    double got = bf2f(p.h2[(size_t)tok * D + n]);
    num += (got - h2) * (got - h2); den += h2 * h2;
  }
  diag_accum(num, den, accum, sred);
}
__global__ void __launch_bounds__(256) k_chk_moe(Params p, int layer, int mode, double* accum) {
  __shared__ double sred[512];
  __shared__ float sh[1024];
  __shared__ float slog[36];
  __shared__ float shid[1024];
  __shared__ int se[2];
  __shared__ float sw[2];
  const int tid = threadIdx.x;
  int tok = diag_tok(blockIdx.x, gridDim.x);
  if (layer == 1 && tok >= TLAT) tok = dhash(blockIdx.x) % TLAT;
  for (int i = tid; i < 1024; i += 256) sh[i] = bf2f(p.h2[(size_t)tok * D + i]);
  __syncthreads();
  if (tid < 36) {
    double a;
    if (tid < 32) { a = p.b_re[layer * 32 + tid]; for (int k = 0; k < 1024; ++k) a += (double)sh[k] * p.w_re[((size_t)layer * 1024 + k) * 32 + tid]; }
    else { a = p.b_rg[layer * 4 + tid - 32]; for (int k = 0; k < 1024; ++k) a += (double)sh[k] * p.w_rg[((size_t)layer * 1024 + k) * 4 + tid - 32]; }
    slog[tid] = (float)a;
  }
  __syncthreads();
  if (tid == 0) {
    int grp = 0; for (int i = 1; i < 4; ++i) if (slog[32 + i] > slog[32 + grp]) grp = i;
    double gs = 0; for (int i = 0; i < 4; ++i) gs += exp((double)slog[32 + i] - slog[32 + grp]);
    double pg = 1.0 / gs;
    int i0 = 0; for (int i = 1; i < 8; ++i) if (slog[grp * 8 + i] > slog[grp * 8 + i0]) i0 = i;
    int i1 = -1; for (int i = 0; i < 8; ++i) if (i != i0 && (i1 < 0 || slog[grp * 8 + i] > slog[grp * 8 + i1])) i1 = i;
    double e1 = exp((double)slog[grp * 8 + i1] - slog[grp * 8 + i0]);
    se[0] = grp * 8 + i0; se[1] = grp * 8 + i1; sw[0] = (float)(pg / (1 + e1)); sw[1] = (float)(pg * e1 / (1 + e1));
  }
  __syncthreads();
  if (mode == 1) {
    double num = 0, den = 0;
    if (tid == 0) { den = 1.0; bool same = (p.tok_e[tok * 2] == se[0] && p.tok_e[tok * 2 + 1] == se[1]); num = same ? 0.0 : 1.0; }
    diag_accum(num, den, accum, sred);
    return;
  }
  int e0 = p.tok_e[tok * 2], e1 = p.tok_e[tok * 2 + 1];
  float w0 = p.tok_gate[tok * 2], w1 = p.tok_gate[tok * 2 + 1];
  double num = 0, den = 0;
  if (tid == 0 && e0 == se[0] && e1 == se[1]) { num += (w0 - sw[0]) * (w0 - sw[0]) + (w1 - sw[1]) * (w1 - sw[1]); }
  for (int i = tid; i < 1024; i += 256) {
    int k = i >> 9, j = i & 511, e = k ? e1 : e0;
    const float* w1p = p.w1 + ((size_t)layer * 32 + e) * 1024 * 512;
    const float* w3p = p.w3 + ((size_t)layer * 32 + e) * 1024 * 512;
    double a = 0, c = 0;
    for (int kk = 0; kk < 1024; ++kk) { a += (double)sh[kk] * w1p[(size_t)kk * 512 + j]; c += (double)sh[kk] * w3p[(size_t)kk * 512 + j]; }
    shid[i] = (float)(a / (1.0 + exp(-a)) * c);
  }
  __syncthreads();
  int s0 = p.estart[e0] * MOE_BLK + p.tok_pos[tok * 2], s1 = p.estart[e1] * MOE_BLK + p.tok_pos[tok * 2 + 1];
  for (int n = tid; n < 1024; n += 256) {
    double y = 0;
    const float* w2a = p.w2 + ((size_t)layer * 32 + e0) * 512 * 1024;
    const float* w2b = p.w2 + ((size_t)layer * 32 + e1) * 512 * 1024;
    double ya = 0, yb = 0;
    for (int j = 0; j < 512; ++j) { ya += (double)shid[j] * w2a[(size_t)j * 1024 + n]; yb += (double)shid[512 + j] * w2b[(size_t)j * 1024 + n]; }
    y = w0 * ya + w1 * yb;
    double got = w0 * bf2f(p.ysl[(size_t)s0 * D + n]) + w1 * bf2f(p.ysl[(size_t)s1 * D + n]);
    num += (got - y) * (got - y); den += y * y;
  }
  diag_accum(num, den, accum, sred);
}
__global__ void k_saverows(Params p, float* xsave, int layer) {
  int tok = diag_tok(blockIdx.x, gridDim.x);
  if (layer == 1 && tok >= TLAT) tok = dhash(blockIdx.x) % TLAT;
  for (int i = threadIdx.x; i < 1024; i += 256) xsave[(size_t)blockIdx.x * 1024 + i] = p.xres[(size_t)tok * D + i];
}
__global__ void __launch_bounds__(256) k_chk_final(Params p, int layer, const float* xsave, double* accum) {
  __shared__ double sred[512];
  __shared__ double sv[1024];
  __shared__ double sst[4];
  const int tid = threadIdx.x;
  int tok = diag_tok(blockIdx.x, gridDim.x);
  if (layer == 1 && tok >= TLAT) tok = dhash(blockIdx.x) % TLAT;
  const float* cv = tok < TLAT ? p.c + (tok >> 12) * 1024 : p.c_ctx;
  int e0 = p.tok_e[tok * 2], e1 = p.tok_e[tok * 2 + 1];
  float w0 = p.tok_gate[tok * 2], w1 = p.tok_gate[tok * 2 + 1];
  int s0 = p.estart[e0] * MOE_BLK + p.tok_pos[tok * 2], s1 = p.estart[e1] * MOE_BLK + p.tok_pos[tok * 2 + 1];
  for (int n = tid; n < 1024; n += 256) {
    double g2 = p.b_mod[layer * NMOD + 5120 + n];
    for (int k = 0; k < 1024; ++k) { double cc = cv[k]; g2 += cc / (1.0 + exp(-cc)) * p.w_mod[((size_t)layer * 1024 + k) * NMOD + 5120 + n]; }
    double y = w0 * bf2f(p.ysl[(size_t)s0 * D + n]) + w1 * bf2f(p.ysl[(size_t)s1 * D + n]);
    sv[n] = 1.4142135623730951 * xsave[(size_t)blockIdx.x * 1024 + n] + g2 * y;
  }
  __syncthreads();
  if (tid == 0) { double s = 0, q = 0; for (int i = 0; i < 1024; ++i) s += sv[i]; s /= 1024; for (int i = 0; i < 1024; ++i) q += (sv[i] - s) * (sv[i] - s); sst[0] = s; sst[1] = 1.0 / sqrt(q / 1024 + 1e-6); }
  __syncthreads();
  double num = 0, den = 0;
  for (int n = tid; n < 1024; n += 256) {
    double x2 = (sv[n] - sst[0]) * sst[1] * p.ln2_g[layer * D + n] + p.ln2_b[layer * D + n];
    sv[n] = x2;
    double got = layer == 1 ? p.out[(size_t)tok * D + n] : p.xres[(size_t)tok * D + n];
    num += (got - x2) * (got - x2); den += x2 * x2;
  }
  __syncthreads();
  if (layer == 0) {
    if (tid == 0) { double s = 0, q = 0; for (int i = 0; i < 1024; ++i) s += sv[i]; s /= 1024; for (int i = 0; i < 1024; ++i) q += (sv[i] - s) * (sv[i] - s); sst[2] = s; sst[3] = 1.0 / sqrt(q / 1024 + 1e-6); }
    __syncthreads();
    for (int n = tid; n < 1024; n += 256) {
      double sh = p.b_mod[NMOD + n], sc = p.b_mod[NMOD + 1024 + n];
      for (int k = 0; k < 1024; ++k) { double cc = cv[k]; double sl = cc / (1.0 + exp(-cc)); sh += sl * p.w_mod[((size_t)1024 + k) * NMOD + n]; sc += sl * p.w_mod[((size_t)1024 + k) * NMOD + 1024 + n]; }
      double h = (sv[n] - sst[2]) * sst[3] * (1.0 + sc) + sh;
      double got = bf2f(p.h[(size_t)tok * D + n]);
      num += (got - h) * (got - h); den += h * h;
    }
  }
  diag_accum(num, den, accum, sred);
}
#endif

static inline size_t align_up(size_t v, size_t a) { return (v + a - 1) / a * a; }

extern "C" void kernel_launch(void* const* d_in, const int* in_sizes, int n_in, void* d_out, int out_size, void* d_ws, size_t ws_size,
                              hipStream_t stream) {
  Params p{};
  const float* const* in = (const float* const*)d_in;
  p.x = in[0]; p.c = in[1]; p.ctx = in[2]; p.c_ctx = in[3]; p.w_mod = in[4]; p.b_mod = in[5]; p.w_in = in[6]; p.b_in = in[7];
  p.q_norm = in[8]; p.k_norm = in[9]; p.gla_wg = in[10]; p.gla_bg = in[11]; p.gla_norm = in[12]; p.rpb = in[13];
  p.w_br_attn = in[14]; p.w_br_gla = in[15]; p.w_br_na = in[16]; p.w_out = in[17]; p.ln1_g = in[18]; p.ln1_b = in[19];
  p.w_rg = in[20]; p.b_rg = in[21]; p.w_re = in[22]; p.b_re = in[23]; p.w1 = in[24]; p.w3 = in[25]; p.w2 = in[26];
  p.ln2_g = in[27]; p.ln2_b = in[28];
  p.out = (float*)d_out;

  char* base = (char*)d_ws;
  size_t off = 0;
  auto take = [&](size_t bytes) { char* q = base + off; off = align_up(off + bytes, 256); return q; };
  p.mod_part = (float*)take((size_t)16 * 2 * 5 * NMOD * 4);
  p.mod = (float*)take((size_t)2 * 5 * NMOD * 4);
  p.rope = (float*)take(2048 * 4);
  p.wrp = (float*)take((size_t)2 * 49152 * 4);
  p.bar = (unsigned*)take(XCD_BAR_WORDS * 4);
  p.cnt = (int*)take(32 * 4);
  p.estart = (int*)take(32 * 4);
  p.cntg = (int*)take((size_t)1088 * 32 * 4);
  p.list = (int*)take((size_t)32 * MOE_CAP * 4);
  p.tok_e = (int*)take((size_t)TALL * 2 * 4);
  p.tok_pos = (int*)take((size_t)TALL * 2 * 4);
  p.tok_gate = (float*)take((size_t)TALL * 2 * 4);
  p.wt_in = (bf16_t*)take((size_t)3968 * 1024 * 2);
  p.wt_gate = (bf16_t*)take((size_t)3072 * 1024 * 2);
  p.wt_br = (bf16_t*)take((size_t)3 * 1024 * 512 * 2);
  p.wt_out = (bf16_t*)take((size_t)1024 * 1024 * 2);
  p.wt_13 = (bf16_t*)take((size_t)32 * 1024 * 1024 * 2);
  p.wt_2 = (bf16_t*)take((size_t)32 * 1024 * 512 * 2);
  p.G = p.wt_13;
  p.xres = (float*)take((size_t)TALL * D * 4);
  p.h = (bf16_t*)take((size_t)TALL * D * 2);
  size_t r1 = off;
  p.qA = (bf16_t*)take((size_t)TALL * 512 * 2);
  p.kA = (bf16_t*)take((size_t)4 * 2 * PALL * 64 * 2);
  p.vAT = (bf16_t*)take((size_t)4 * 2 * 64 * PALL * 2);
  p.qB = (bf16_t*)take((size_t)TALL * 256 * 2);
  p.kB = (bf16_t*)take((size_t)TALL * 256 * 2);
  p.vBT = (bf16_t*)take((size_t)4 * 4 * 128 * PALL * 2);
  p.rB = (bf16_t*)take((size_t)TALL * 512 * 2);
  p.aB = (float*)take((size_t)TALL * 32 * 4);
  p.qC = (bf16_t*)take((size_t)TALL * 512 * 2);
  p.kC = (bf16_t*)take((size_t)TALL * 512 * 2);
  p.vCT = (bf16_t*)take((size_t)4 * 8 * 64 * PALL * 2);
  p.oA = (bf16_t*)take((size_t)TALL * 512 * 2);
  p.oB = (bf16_t*)take((size_t)TALL * 512 * 2);
  p.oC = (bf16_t*)take((size_t)TALL * 512 * 2);
  size_t r1_end = off;
  {
    size_t o2 = r1;
    p.act = (bf16_t*)(base + o2); o2 = align_up(o2 + (size_t)MAX_MBLK * MOE_BLK * 512 * 2, 256);
    p.ysl = (bf16_t*)(base + o2); o2 = align_up(o2 + (size_t)MAX_MBLK * MOE_BLK * 1024 * 2, 256);
    if (o2 > r1_end) off = o2;
  }
  p.KVt = (float*)take((size_t)32 * NCHUNK * 8192 * 4);
  p.SP = (bf16_t*)take((size_t)32 * NCHUNK * 8192 * 2);
  p.decay = (float*)take((size_t)32 * NCHUNK * 64 * 4);
  p.bcum = (float*)take((size_t)32 * NCHUNK * 4096 * 4);
  p.m = (bf16_t*)p.KVt;
  p.h2 = p.SP;
  if (off > ws_size) {
    fprintf(stderr, "workspace too small: need %zu have %zu\n", off, ws_size);
    return;
  }
  const dim3 blk(256);
#ifdef DIAG_STAGE
  {
    double* accum = (double*)take(64);
    float* xsave = (float*)take((size_t)64 * 1024 * 4);
    if (off > ws_size) return;
    const int G = 1024;
    const int DL = DIAG_LAYER, DS = DIAG_STAGE;
    k_diag_zero<<<1, 64, 0, stream>>>(accum);
    k_setup<<<((769 + 96) + 1) / 2, dim3(512), 0, stream>>>(p, 0);
    k_convert<<<((2048) + 1) / 2, dim3(512), 0, stream>>>(p, 0);
    k_modreduce<<<((240) + 1) / 2, dim3(512), 0, stream>>>(p, 0);
    k_rowpass0<<<((G) + 1) / 2, dim3(512), 0, stream>>>(p, 0);
    if (DS == 1 || DS == 0) k_chk_h<<<32, blk, 0, stream>>>(p, accum + 2);
    for (int l = 0; l <= DL; ++l) {
      const bool chk = (l == DL);
      k_inproj<<<((G) + 1) / 2, dim3(512), 0, stream>>>(p, l);
      if (chk && (DS == 2 || DS == 0)) k_chk_inproj<<<64, blk, 0, stream>>>(p, l, accum + 4);
      k_gla1<<<((G) + 1) / 2, dim3(512), 0, stream>>>(p, l);
      k_na<<<((1088) + 1) / 2, dim3(512), 0, stream>>>(p, l);
      if (chk && (DS == 4 || DS == 0)) k_chk_na<<<128, blk, 0, stream>>>(p, l, accum + 8);
      k_gla2<<<((G) + 1) / 2, dim3(512), 0, stream>>>(p, l);
      k_attnA<<<((1088) + 1) / 2, dim3(512), 0, stream>>>(p, l);
      if (chk && (DS == 3 || DS == 0)) k_chk_attnA<<<128, blk, 0, stream>>>(p, l, accum + 6);
      k_gla3<<<((1088) + 1) / 2, dim3(512), 0, stream>>>(p, l);
      if (chk && (DS == 5 || DS == 0)) k_chk_gla<<<16, blk, 0, stream>>>(p, l, accum + 10);
      k_merge<<<((G) + 1) / 2, dim3(512), 0, stream>>>(p, l);
      if (chk && (DS == 6 || DS == 0)) k_chk_merge<<<32, blk, 0, stream>>>(p, l, accum + 12);
      k_outproj<<<((G) + 1) / 2, dim3(512), 0, stream>>>(p, l);
      k_rowpass1<<<((G) + 1) / 2, dim3(512), 0, stream>>>(p, l);
      if (chk && l == 0 && (DS == 7 || DS == 0)) k_chk_x1<<<32, blk, 0, stream>>>(p, accum + 14);
      k_moescan<<<((32) + 1) / 2, dim3(512), 0, stream>>>(p, l);
      k_convert<<<((2048) + 1) / 2, dim3(512), 0, stream>>>(p, l | 16);
    k_moe1<<<((G) + 1) / 2, dim3(512), 0, stream>>>(p, l);
      k_moe2<<<((G) + 1) / 2, dim3(512), 0, stream>>>(p, l);
      if (chk && (DS == 8 || DS == 0)) k_chk_moe<<<32, blk, 0, stream>>>(p, l, 0, accum + 16);
      if (chk && DS == 9) k_chk_moe<<<512, blk, 0, stream>>>(p, l, 1, accum + 18);
      if (chk && (DS == 10 || DS == 0)) k_saverows<<<32, blk, 0, stream>>>(p, xsave, l);
      k_rowpass2<<<((G) + 1) / 2, dim3(512), 0, stream>>>(p, l);
      if (chk && (DS == 10 || DS == 0)) k_chk_final<<<32, blk, 0, stream>>>(p, l, xsave, accum + 20);
      if (l == 0) k_convert<<<((2048) + 1) / 2, dim3(512), 0, stream>>>(p, 1);
    }
    k_diag_report<<<1024, blk, 0, stream>>>(accum, p.out, TLAT * D);
    return;
  }
#endif
#ifdef MK_MULTI
  const int G = 1024;
  k_setup<<<((769 + 96) + 1) / 2, dim3(512), 0, stream>>>(p, 0);
  k_convert<<<((2048) + 1) / 2, dim3(512), 0, stream>>>(p, 0);
  k_modreduce<<<((240) + 1) / 2, dim3(512), 0, stream>>>(p, 0);
  k_rowpass0<<<((G) + 1) / 2, dim3(512), 0, stream>>>(p, 0);
  for (int l = 0; l < 2; ++l) {
    k_inproj<<<((G) + 1) / 2, dim3(512), 0, stream>>>(p, l);
    k_gla1<<<((G) + 1) / 2, dim3(512), 0, stream>>>(p, l);
    k_na<<<((1088) + 1) / 2, dim3(512), 0, stream>>>(p, l);
    k_gla2<<<((G) + 1) / 2, dim3(512), 0, stream>>>(p, l);
    k_attnA<<<((1088) + 1) / 2, dim3(512), 0, stream>>>(p, l);
    k_gla3<<<((1088) + 1) / 2, dim3(512), 0, stream>>>(p, l);
    k_merge<<<((G) + 1) / 2, dim3(512), 0, stream>>>(p, l);
    k_outproj<<<((G) + 1) / 2, dim3(512), 0, stream>>>(p, l);
    k_rowpass1<<<((G) + 1) / 2, dim3(512), 0, stream>>>(p, l);
    k_moescan<<<((32) + 1) / 2, dim3(512), 0, stream>>>(p, l);
    k_convert<<<((2048) + 1) / 2, dim3(512), 0, stream>>>(p, l | 16);
    k_moe1<<<((G) + 1) / 2, dim3(512), 0, stream>>>(p, l);
    k_moe2<<<((G) + 1) / 2, dim3(512), 0, stream>>>(p, l);
    k_rowpass2<<<((G) + 1) / 2, dim3(512), 0, stream>>>(p, l);
    if (l == 0) k_convert<<<((2048) + 1) / 2, dim3(512), 0, stream>>>(p, 1);
  }
#else
  static int grid_blocks = 0;
  if (!grid_blocks) {
    int dev = 0, cus = 0, per_cu = 0;
    hipGetDevice(&dev);
    hipDeviceGetAttribute(&cus, hipDeviceAttributeMultiprocessorCount, dev);
    hipOccupancyMaxActiveBlocksPerMultiprocessor(&per_cu, k_mega, 512, 0);
    per_cu = 1;
    grid_blocks = cus * per_cu;
  }
  hipMemsetAsync(p.bar, 0, XCD_BAR_WORDS * 4, stream);
  k_mega<<<dim3(grid_blocks), dim3(512), 0, stream>>>(p);
#endif
}
```

```cpp
#include <hip/hip_runtime.h>
#include <hip/hip_cooperative_groups.h>
#include <stdint.h>
#include <stdio.h>
namespace cg = cooperative_groups;

typedef unsigned short bf16_t;
typedef __attribute__((ext_vector_type(8))) short bf16x8;
typedef __attribute__((ext_vector_type(4))) short bf16x4;
typedef __attribute__((ext_vector_type(16))) float f32x16;
typedef __attribute__((ext_vector_type(4))) unsigned u32x4;
typedef __attribute__((ext_vector_type(4))) float f32x4v;

#ifndef XCD_MAP_ENABLE
#define XCD_MAP_ENABLE 0
#endif
constexpr int D = 1024;
constexpr int TLAT = 16384, TCTX = 1024, TALL = 17408, PALL = 4352;
constexpr int NIN_SRC = 6944, NMOD = 6144;
constexpr int NT_IN = 31;
constexpr int SMEM_BYTES = 69632;
constexpr int LDC = 132;
constexpr float LOG2E = 1.4426950408889634f;
constexpr float QSCALE = 0.125f * LOG2E;
constexpr float ALPHA = 1.4142135623730951f;
constexpr int NCHUNK = 68;
constexpr int MOE_CAP = TALL;
constexpr int MOE_BLK = 256;
constexpr int MAX_MBLK = 168;

struct Params {
  const float *x, *c, *ctx, *c_ctx, *w_mod, *b_mod, *w_in, *b_in, *q_norm, *k_norm, *gla_wg, *gla_bg, *gla_norm, *rpb,
      *w_br_attn, *w_br_gla, *w_br_na, *w_out, *ln1_g, *ln1_b, *w_rg, *b_rg, *w_re, *b_re, *w1, *w3, *w2, *ln2_g, *ln2_b;
  float* out;
  float *mod_part, *mod, *rope, *wrp;
  bf16_t *wt_in, *wt_gate, *wt_br, *wt_out, *wt_13, *wt_2, *G;
  float* xres;
  bf16_t *h, *h2;
  bf16_t *qA, *kA, *vAT, *qB, *kB, *vBT, *rB;
  float* aB;
  bf16_t *qC, *kC, *vCT;
  bf16_t *oA, *oB, *oC;
  float* KVt;
  float* bcum;
  bf16_t* SP;
  float* decay;
  bf16_t* m;
  bf16_t *act, *ysl;
  int *cnt, *cntg, *list, *tok_e, *tok_pos, *estart;
  float* tok_gate;
  unsigned* bar;
};

typedef const __attribute__((address_space(4))) Params& PRef;
__device__ __forceinline__ PRef params_view() {
  const __attribute__((address_space(4))) Params* pp = (const __attribute__((address_space(4))) Params*)__builtin_amdgcn_kernarg_segment_ptr();
  asm volatile("" : "+s"(pp));
  return *pp;
}

__device__ __forceinline__ int tid_() { int t = __builtin_amdgcn_workitem_id_x() & 255; asm volatile("" : "+v"(t)); return t; }
__device__ __forceinline__ int half_() { int h = __builtin_amdgcn_readfirstlane(__builtin_amdgcn_workitem_id_x() >> 8); asm volatile("" : "+s"(h)); return h; }
__device__ __forceinline__ int bid_() { int t = 2 * __builtin_amdgcn_workgroup_id_x() + half_(); asm volatile("" : "+s"(t)); return t; }
__device__ __forceinline__ int vgrid_() { return 2 * (int)gridDim.x; }
typedef __attribute__((ext_vector_type(2))) __bf16 bf16x2n;
typedef __attribute__((ext_vector_type(2))) float f32x2n;
__device__ __forceinline__ bf16_t f2bf(float f) { return __builtin_bit_cast(bf16_t, (__bf16)f); }
__device__ __forceinline__ float bf2f(bf16_t b) { return __uint_as_float(((unsigned)b) << 16); }
__device__ __forceinline__ unsigned pack2(float a, float b) {
  f32x2n v = {a, b};
  return __builtin_bit_cast(unsigned, __builtin_convertvector(v, bf16x2n));
}
__device__ __forceinline__ float wave_sum(float v) {
  int x;
  x = __builtin_amdgcn_update_dpp(0, __float_as_int(v), 0xB1, 0xf, 0xf, true);  v += __int_as_float(x);
  x = __builtin_amdgcn_update_dpp(0, __float_as_int(v), 0x4E, 0xf, 0xf, true);  v += __int_as_float(x);
  x = __builtin_amdgcn_update_dpp(0, __float_as_int(v), 0x141, 0xf, 0xf, true); v += __int_as_float(x);
  x = __builtin_amdgcn_update_dpp(0, __float_as_int(v), 0x140, 0xf, 0xf, true); v += __int_as_float(x);
  x = __builtin_amdgcn_update_dpp(0, __float_as_int(v), 0x142, 0xa, 0xf, false); v += __int_as_float(x);
  x = __builtin_amdgcn_update_dpp(0, __float_as_int(v), 0x143, 0xc, 0xf, false); v += __int_as_float(x);
  return __int_as_float(__builtin_amdgcn_readlane(__float_as_int(v), 63));
}
__device__ __forceinline__ float siluf(float x) { return x * __builtin_amdgcn_rcpf(1.f + __expf(-x)); }
__device__ __forceinline__ float sigmoidf_(float x) { return __builtin_amdgcn_rcpf(1.f + __expf(-x)); }
__device__ __forceinline__ f32x16 zero16() {
  f32x16 z;
#pragma unroll
  for (int i = 0; i < 16; ++i) z[i] = 0.f;
  return z;
}
__device__ __forceinline__ f32x16 mfma32(bf16x8 a, bf16x8 b, f32x16 c) {
  return __builtin_amdgcn_mfma_f32_32x32x16_bf16(a, b, c, 0, 0, 0);
}
__device__ __forceinline__ int tok_modrow(int tok) { return tok < TLAT ? (tok >> 12) : 4; }

__device__ __forceinline__ void phase_setup(PRef p, char* smem) {
  float* sS = (float*)smem;
  const int tid = tid_();
  for (int item = bid_(); item < 769 + 96; item += vgrid_()) {
    if (item >= 769) {
      int it = item - 769;
      int l = it / 48, chunk = it % 48;
      for (int i = tid; i < 1024; i += 256) {
        int idx = chunk * 1024 + i;
        int e = idx & 3, ln = (idx >> 2) & 63, t = (idx >> 8) & 63, nt = idx >> 14;
        int k = 16 * t + 4 * (ln >> 4) + e, n = 16 * nt + (ln & 15);
        float v = 0.f;
        if (n < 32) v = p.w_re[((size_t)l * 1024 + k) * 32 + n];
        else if (n < 36) v = p.w_rg[((size_t)l * 1024 + k) * 4 + (n - 32)];
        p.wrp[(size_t)l * 49152 + idx] = v;
      }
      continue;
    }
    if (item == 768) {
      for (int i = tid; i < 1024; i += 256) {
        int pos = i >> 4, f = i & 15;
        float inv = powf(10000.f, -(float)f / 16.f);
        float ang = (float)pos * inv;
        p.rope[i] = cosf(ang);
        p.rope[1024 + i] = sinf(ang);
      }
      continue;
    }
    int nb = item % 24, ks = (item / 24) % 16, l = item / 384;
    __syncthreads();
    for (int i = tid; i < 320; i += 256) {
      int r = i >> 6, k = ks * 64 + (i & 63);
      float cv = (r < 4) ? p.c[r * 1024 + k] : p.c_ctx[k];
      sS[i] = siluf(cv);
    }
    __syncthreads();
    int n = nb * 256 + tid;
    const float* w = p.w_mod + ((size_t)l * 1024 + ks * 64) * NMOD + n;
    float acc[5] = {0.f, 0.f, 0.f, 0.f, 0.f};
#pragma unroll 8
    for (int k = 0; k < 64; ++k) {
      float wv = w[(size_t)k * NMOD];
#pragma unroll
      for (int r = 0; r < 5; ++r) acc[r] += sS[r * 64 + k] * wv;
    }
#pragma unroll
    for (int r = 0; r < 5; ++r) p.mod_part[(((size_t)ks * 2 + l) * 5 + r) * NMOD + n] = acc[r];
  }
}
__device__ __forceinline__ void phase_modreduce(PRef p) {
  for (int i = bid_() * 256 + tid_(); i < 2 * 5 * NMOD; i += vgrid_() * 256) {
    int n = i % NMOD, l = i / (5 * NMOD);
    float s = p.b_mod[l * NMOD + n];
#pragma unroll
    for (int ks = 0; ks < 16; ++ks) s += p.mod_part[(size_t)ks * 2 * 5 * NMOD + i];
    p.mod[i] = s;
  }
}

constexpr int CV_IN = 16 * 62, CV_GATE = 16 * 48, CV_BR = 8 * 16, CV_OUT = 16 * 16, CV_13 = 16 * 16, CV_2 = 8 * 16;
constexpr int CV_O1 = CV_IN, CV_O2 = CV_O1 + CV_GATE, CV_O3 = CV_O2 + 3 * CV_BR, CV_O4 = CV_O3 + CV_OUT, CV_O5 = CV_O4 + 32 * CV_13,
              CV_TOTAL = CV_O5 + 32 * CV_2;
struct ConvDesc { const float* src; int ldsrc; int ncols; bf16_t* dst; int lddst; };
__device__ __forceinline__ ConvDesc conv_desc(PRef p, int layer, int item) {
  ConvDesc d;
  d.ncols = 64;
  if (item < CV_O1) {
    int kt = item & 15, ntile = item >> 4;
    int n0 = ntile * 64, srccol;
    if (n0 < 2304) srccol = n0;
    else if (n0 < 3840) srccol = n0 + 32;
    else if (n0 == 3840) { srccol = 2304; d.ncols = 32; }
    else { srccol = 0; d.ncols = 0; }
    d.src = p.w_in + (size_t)layer * 1024 * NIN_SRC + (size_t)(kt * 64) * NIN_SRC + srccol; d.ldsrc = NIN_SRC;
    d.dst = p.wt_in + (size_t)n0 * 1024 + kt * 64; d.lddst = 1024;
  } else if (item < CV_O2) {
    int it = item - CV_O1, kt = it & 15, ntile = it >> 4;
    d.src = p.w_in + (size_t)layer * 1024 * NIN_SRC + (size_t)(kt * 64) * NIN_SRC + 3872 + ntile * 64; d.ldsrc = NIN_SRC;
    d.dst = p.wt_gate + (size_t)(ntile * 64) * 1024 + kt * 64; d.lddst = 1024;
  } else if (item < CV_O3) {
    int it = item - CV_O2, br = it / CV_BR, t = it % CV_BR, kt = t & 7, ntile = t >> 3;
    const float* s0 = (br == 0 ? p.w_br_attn : (br == 1 ? p.w_br_gla : p.w_br_na)) + (size_t)layer * 512 * 1024;
    d.src = s0 + (size_t)(kt * 64) * 1024 + ntile * 64; d.ldsrc = 1024;
    d.dst = p.wt_br + (size_t)br * 1024 * 512 + (size_t)(ntile * 64) * 512 + kt * 64; d.lddst = 512;
  } else if (item < CV_O4) {
    int it = item - CV_O3, kt = it & 15, ntile = it >> 4;
    d.src = p.w_out + (size_t)layer * 1024 * 1024 + (size_t)(kt * 64) * 1024 + ntile * 64; d.ldsrc = 1024;
    d.dst = p.wt_out + (size_t)(ntile * 64) * 1024 + kt * 64; d.lddst = 1024;
  } else if (item < CV_O5) {
    int it = item - CV_O4, e = it >> 8, t = it & 255, kt = t & 15, ntile = t >> 4;
    int j = ntile >> 1, isw3 = ntile & 1;
    d.src = (isw3 ? p.w3 : p.w1) + ((size_t)layer * 32 + e) * 1024 * 512 + (size_t)(kt * 64) * 512 + j * 64; d.ldsrc = 512;
    d.dst = p.wt_13 + (size_t)e * 1024 * 1024 + (size_t)(ntile * 64) * 1024 + kt * 64; d.lddst = 1024;
  } else {
    int it = item - CV_O5, e = it >> 7, t = it & 127, kt = t & 7, ntile = t >> 3;
    d.src = p.w2 + ((size_t)layer * 32 + e) * 512 * 1024 + (size_t)(kt * 64) * 1024 + ntile * 64; d.ldsrc = 1024;
    d.dst = p.wt_2 + (size_t)e * 1024 * 512 + (size_t)(ntile * 64) * 512 + kt * 64; d.lddst = 512;
  }
  return d;
}
__device__ __forceinline__ void conv_load8(const ConvDesc& d, int nhalf, int lane, f32x4v (&v)[8]) {
  const int kb = lane >> 3, c0 = nhalf * 32 + (lane & 7) * 4;
  const float* sp = d.src + (size_t)(kb * 8) * d.ldsrc + c0;
  const bool ok = c0 < d.ncols;
#pragma unroll
  for (int j = 0; j < 8; ++j) {
    f32x4v z = {0.f, 0.f, 0.f, 0.f};
    v[j] = ok ? *(const f32x4v*)(sp + (size_t)j * d.ldsrc) : z;
  }
}
__device__ __forceinline__ void phase_convert(PRef p, int layer_part, char* smem) {
  const int tid = tid_(), lane = tid & 63, w = tid >> 6;
  const int layer = layer_part & 15, part = layer_part >> 4;
  const int begin = part ? CV_O4 : 0, ntiles = part ? (CV_TOTAL - CV_O4) : CV_O4;
  const int nw = vgrid_() * 4;
  int wt = bid_() * 4 + w;
  if (wt >= 2 * ntiles) return;
  ConvDesc d0 = conv_desc(p, layer, begin + (wt >> 1));
  f32x4v v0[8], v1[8];
  conv_load8(d0, wt & 1, lane, v0);
  for (;;) {
    const int nwt = wt + nw;
    const bool more = nwt < 2 * ntiles;
    ConvDesc d1 = d0;
    if (more) { d1 = conv_desc(p, layer, begin + (nwt >> 1)); conv_load8(d1, nwt & 1, lane, v1); }
    {
      const int kb = lane >> 3, c0 = (wt & 1) * 32 + (lane & 7) * 4;
      bf16_t* dp = d0.dst + (size_t)c0 * d0.lddst + kb * 8;
#pragma unroll
      for (int c = 0; c < 4; ++c) {
        const uint4 o = make_uint4(pack2(v0[0][c], v0[1][c]), pack2(v0[2][c], v0[3][c]), pack2(v0[4][c], v0[5][c]), pack2(v0[6][c], v0[7][c]));
        *(uint4*)(dp + (size_t)c * d0.lddst) = o;
      }
    }
    if (!more) break;
    wt = nwt;
    d0 = d1;
#pragma unroll
    for (int j = 0; j < 8; ++j) v0[j] = v1[j];
  }
}

__device__ __forceinline__ void row_stats(const float (&v)[16], float& mean, float& rstd) {
  float s = 0.f;
#pragma unroll
  for (int i = 0; i < 16; ++i) s += v[i];
  mean = wave_sum(s) * (1.f / 1024.f);
  float q = 0.f;
#pragma unroll
  for (int i = 0; i < 16; ++i) { float d = v[i] - mean; q += d * d; }
  float var = wave_sum(q) * (1.f / 1024.f);
  rstd = rsqrtf(var + 1e-6f);
}
__device__ __forceinline__ void load_row(const float* src, int lane, float (&v)[16]) {
#pragma unroll
  for (int i = 0; i < 4; ++i) {
    float4 t = *(const float4*)(src + lane * 4 + 256 * i);
    v[4 * i] = t.x; v[4 * i + 1] = t.y; v[4 * i + 2] = t.z; v[4 * i + 3] = t.w;
  }
}
__device__ __forceinline__ void store_row(float* dst, int lane, const float (&v)[16]) {
#pragma unroll
  for (int i = 0; i < 4; ++i) *(float4*)(dst + lane * 4 + 256 * i) = make_float4(v[4 * i], v[4 * i + 1], v[4 * i + 2], v[4 * i + 3]);
}
__device__ __forceinline__ void store_row_bf(bf16_t* dst, int lane, const float (&v)[16]) {
#pragma unroll
  for (int i = 0; i < 4; ++i) {
    uint2 o = make_uint2(pack2(v[4 * i], v[4 * i + 1]), pack2(v[4 * i + 2], v[4 * i + 3]));
    *(uint2*)(dst + lane * 4 + 256 * i) = o;
  }
}
__device__ __forceinline__ void modulate_row(const float (&x)[16], const float* shift, const float* scale, int lane, float (&h)[16]) {
  float mean, rstd;
  row_stats(x, mean, rstd);
  float sh[16], sc[16];
  load_row(shift, lane, sh);
  load_row(scale, lane, sc);
#pragma unroll
  for (int i = 0; i < 16; ++i) h[i] = (x[i] - mean) * rstd * (1.f + sc[i]) + sh[i];
}

__device__ __forceinline__ void phase_rowpass0(PRef p) {
  const int lane = tid_() & 63, w = tid_() >> 6;
  for (int tok = bid_() * 4 + w; tok < TALL; tok += vgrid_() * 4) {
    const float* src = tok < TLAT ? p.x + (size_t)tok * D : p.ctx + (size_t)(tok - TLAT) * D;
    const float* md = p.mod + (size_t)tok_modrow(tok) * NMOD;
    float x[16], h[16];
    load_row(src, lane, x);
    modulate_row(x, md, md + 1024, lane, h);
    store_row_bf(p.h + (size_t)tok * D, lane, h);
  }
}

typedef __attribute__((ext_vector_type(4))) float f32x4;
__device__ __forceinline__ void phase_rowpass1(PRef p, int layer, char* smem) {
  float* sH = (float*)smem;
  float* sPart = (float*)smem;
  int* sE = (int*)(smem + 16384);
  const int tid = tid_(), lane = tid & 63, w = tid >> 6;
  const int ntok = layer == 0 ? TALL : TLAT;
  const float* lg = p.ln1_g + layer * D;
  const float* lb = p.ln1_b + layer * D;
  const float* wrp = p.wrp + (size_t)layer * 49152;
  for (int g0 = bid_() * 16; g0 < ntok; g0 += vgrid_() * 16) {
    __syncthreads();
    {
      float v[4][16];
#pragma unroll
      for (int rr = 0; rr < 4; ++rr) load_row(p.xres + (size_t)(g0 + w * 4 + rr) * D, lane, v[rr]);
      float gg[16], bb[16];
      load_row(lg, lane, gg);
      load_row(lb, lane, bb);
#pragma unroll
      for (int rr = 0; rr < 4; ++rr) {
        const int tok = g0 + w * 4 + rr;
        float mean, rstd;
        row_stats(v[rr], mean, rstd);
        float x1[16], h2[16];
#pragma unroll
        for (int i = 0; i < 16; ++i) x1[i] = (v[rr][i] - mean) * rstd * gg[i] + bb[i];
        store_row(p.xres + (size_t)tok * D, lane, x1);
        const float* md = p.mod + ((size_t)layer * 5 + tok_modrow(tok)) * NMOD;
        modulate_row(x1, md + 3072, md + 4096, lane, h2);
        store_row_bf(p.h2 + (size_t)tok * D, lane, h2);
        store_row(sH + (w * 4 + rr) * 1028, lane, h2);
      }
    }
    __syncthreads();
    f32x4 acc0 = {0.f, 0.f, 0.f, 0.f}, acc1 = acc0, acc2 = acc0;
    {
      const float* ap = sH + (lane & 15) * 1028 + 4 * (lane >> 4) + 256 * w;
      const float* bp = wrp + (size_t)(16 * w) * 256 + lane * 4;
#pragma unroll 8
      for (int t = 0; t < 16; ++t) {
        float4 a = *(const float4*)(ap + 16 * t);
        float4 b0 = *(const float4*)(bp + t * 256);
        float4 b1 = *(const float4*)(bp + t * 256 + 16384);
        float4 b2 = *(const float4*)(bp + t * 256 + 32768);
        acc0 = __builtin_amdgcn_mfma_f32_16x16x4f32(a.x, b0.x, acc0, 0, 0, 0);
        acc1 = __builtin_amdgcn_mfma_f32_16x16x4f32(a.x, b1.x, acc1, 0, 0, 0);
        acc2 = __builtin_amdgcn_mfma_f32_16x16x4f32(a.x, b2.x, acc2, 0, 0, 0);
        acc0 = __builtin_amdgcn_mfma_f32_16x16x4f32(a.y, b0.y, acc0, 0, 0, 0);
        acc1 = __builtin_amdgcn_mfma_f32_16x16x4f32(a.y, b1.y, acc1, 0, 0, 0);
        acc2 = __builtin_amdgcn_mfma_f32_16x16x4f32(a.y, b2.y, acc2, 0, 0, 0);
        acc0 = __builtin_amdgcn_mfma_f32_16x16x4f32(a.z, b0.z, acc0, 0, 0, 0);
        acc1 = __builtin_amdgcn_mfma_f32_16x16x4f32(a.z, b1.z, acc1, 0, 0, 0);
        acc2 = __builtin_amdgcn_mfma_f32_16x16x4f32(a.z, b2.z, acc2, 0, 0, 0);
        acc0 = __builtin_amdgcn_mfma_f32_16x16x4f32(a.w, b0.w, acc0, 0, 0, 0);
        acc1 = __builtin_amdgcn_mfma_f32_16x16x4f32(a.w, b1.w, acc1, 0, 0, 0);
        acc2 = __builtin_amdgcn_mfma_f32_16x16x4f32(a.w, b2.w, acc2, 0, 0, 0);
      }
    }
    __syncthreads();
#pragma unroll
    for (int g = 0; g < 4; ++g) {
      const int row = (lane >> 4) * 4 + g, col = lane & 15;
      sPart[(w * 16 + row) * 48 + col] = acc0[g];
      sPart[(w * 16 + row) * 48 + 16 + col] = acc1[g];
      sPart[(w * 16 + row) * 48 + 32 + col] = acc2[g];
    }
    __syncthreads();
    if (tid < 16) {
      int tok = g0 + tid;
      const float* l0 = sPart + tid * 48;
      float g[4];
#pragma unroll
      for (int i = 0; i < 4; ++i) g[i] = ((l0[32 + i] + l0[768 + 32 + i]) + (l0[1536 + 32 + i] + l0[2304 + 32 + i])) + p.b_rg[layer * 4 + i];
      int grp = 0;
      float gm = g[0];
#pragma unroll
      for (int i = 1; i < 4; ++i) if (g[i] > gm) { gm = g[i]; grp = i; }
      float gs = 0.f;
#pragma unroll
      for (int i = 0; i < 4; ++i) gs += __expf(g[i] - gm);
      float pg = 1.f / gs;
      float sv[8];
#pragma unroll
      for (int i = 0; i < 8; ++i) {
        const int c = grp * 8 + i;
        sv[i] = ((l0[c] + l0[768 + c]) + (l0[1536 + c] + l0[2304 + c])) + p.b_re[layer * 32 + c];
      }
      int i0 = 0;
      float v0 = sv[0];
#pragma unroll
      for (int i = 1; i < 8; ++i) if (sv[i] > v0) { v0 = sv[i]; i0 = i; }
      int i1 = -1;
      float v1 = -3.0e38f;
#pragma unroll
      for (int i = 0; i < 8; ++i) if (i != i0 && sv[i] > v1) { v1 = sv[i]; i1 = i; }
      float e1 = __expf(v1 - v0);
      float w0 = pg / (1.f + e1), w1 = pg * e1 / (1.f + e1);
      int ex0 = grp * 8 + i0, ex1 = grp * 8 + i1;
      sE[tid * 2] = ex0; sE[tid * 2 + 1] = ex1;
      p.tok_e[tok * 2] = ex0; p.tok_e[tok * 2 + 1] = ex1;
      p.tok_gate[tok * 2] = w0; p.tok_gate[tok * 2 + 1] = w1;
    }
    __syncthreads();
    if (tid < 32) {
      int c = 0;
#pragma unroll 8
      for (int i = 0; i < 32; ++i) c += (sE[i] == tid) ? 1 : 0;
      p.cntg[(size_t)(g0 >> 4) * 32 + tid] = c;
      const int mine = sE[tid];
      int rk = 0;
      for (int i = 0; i < (tid & ~1); ++i) rk += (sE[i] == mine) ? 1 : 0;
      p.tok_pos[(g0 + (tid >> 1)) * 2 + (tid & 1)] = rk;
    }
  }
}

__device__ __forceinline__ void phase_moescan(PRef p, int layer, char* smem) {
  int* sOff = (int*)smem;
  int* sScan = sOff + 1280;
  const int tid = tid_();
  const int e = bid_();
  if (e >= 32) return;
  const int ntok = layer == 0 ? TALL : TLAT;
  const int ng = ntok >> 4;
  __syncthreads();
  int loc[5], s = 0;
#pragma unroll
  for (int i = 0; i < 5; ++i) {
    const int g = tid * 5 + i;
    loc[i] = g < ng ? p.cntg[(size_t)g * 32 + e] : 0;
    s += loc[i];
  }
  sScan[tid] = s;
  __syncthreads();
  for (int o = 1; o < 256; o <<= 1) {
    int v = tid >= o ? sScan[tid - o] : 0;
    __syncthreads();
    sScan[tid] += v;
    __syncthreads();
  }
  int run = sScan[tid] - s;
#pragma unroll
  for (int i = 0; i < 5; ++i) { sOff[tid * 5 + i] = run; run += loc[i]; }
  if (tid == 255) p.cnt[e] = sScan[255];
  __syncthreads();
  for (int tok = tid; tok < ntok; tok += 256) {
    const int e0 = p.tok_e[tok * 2], e1 = p.tok_e[tok * 2 + 1];
    if (e0 == e) { const int pos = sOff[tok >> 4] + p.tok_pos[tok * 2]; p.list[e * MOE_CAP + pos] = tok; p.tok_pos[tok * 2] = pos; }
    if (e1 == e) { const int pos = sOff[tok >> 4] + p.tok_pos[tok * 2 + 1]; p.list[e * MOE_CAP + pos] = tok; p.tok_pos[tok * 2 + 1] = pos; }
  }
}

__device__ __forceinline__ void phase_rowpass2(PRef p, int layer) {
  const int lane = tid_() & 63, w = tid_() >> 6;
  const bool last = layer == 1;
  const int ntok = last ? TLAT : TALL;
  const float* lg = p.ln2_g + layer * D;
  const float* lb = p.ln2_b + layer * D;
  const int stride = vgrid_() * 4;
  for (int tokA = bid_() * 4 + w; tokA < ntok; tokA += 2 * stride) {
    const bool hasB = tokA + stride < ntok;
    int tk[2];
    tk[0] = tokA; tk[1] = hasB ? tokA + stride : tokA;
    int s0[2], s1[2];
    float w0[2], w1[2];
#pragma unroll
    for (int u = 0; u < 2; ++u) {
      const int t = tk[u];
      const int e0 = p.tok_e[t * 2], e1 = p.tok_e[t * 2 + 1];
      s0[u] = p.estart[e0] * MOE_BLK + p.tok_pos[t * 2];
      s1[u] = p.estart[e1] * MOE_BLK + p.tok_pos[t * 2 + 1];
      w0[u] = p.tok_gate[t * 2]; w1[u] = p.tok_gate[t * 2 + 1];
    }
    float x1[2][16], g2[2][16];
    uint2 ya[2][4], yb[2][4];
#pragma unroll
    for (int u = 0; u < 2; ++u) {
      const int t = tk[u];
      load_row(p.xres + (size_t)t * D, lane, x1[u]);
      load_row(p.mod + ((size_t)layer * 5 + tok_modrow(t)) * NMOD + 5120, lane, g2[u]);
      const bf16_t* y0 = p.ysl + (size_t)s0[u] * D;
      const bf16_t* y1 = p.ysl + (size_t)s1[u] * D;
#pragma unroll
      for (int i = 0; i < 4; ++i) { ya[u][i] = *(const uint2*)(y0 + lane * 4 + 256 * i); yb[u][i] = *(const uint2*)(y1 + lane * 4 + 256 * i); }
    }
    float gg[16], bb[16];
    load_row(lg, lane, gg);
    load_row(lb, lane, bb);
#pragma unroll
    for (int u = 0; u < 2; ++u) {
      if (u == 1 && !hasB) break;
      const int tok = tk[u];
      float v[16], x2[16];
#pragma unroll
      for (int i = 0; i < 4; ++i) {
        const uint2 a = ya[u][i], b = yb[u][i];
        float fa[4] = {bf2f(a.x & 0xffff), bf2f(a.x >> 16), bf2f(a.y & 0xffff), bf2f(a.y >> 16)};
        float fb[4] = {bf2f(b.x & 0xffff), bf2f(b.x >> 16), bf2f(b.y & 0xffff), bf2f(b.y >> 16)};
#pragma unroll
        for (int e = 0; e < 4; ++e) v[4 * i + e] = ALPHA * x1[u][4 * i + e] + g2[u][4 * i + e] * (w0[u] * fa[e] + w1[u] * fb[e]);
      }
      float mean, rstd;
      row_stats(v, mean, rstd);
#pragma unroll
      for (int i = 0; i < 16; ++i) x2[i] = (v[i] - mean) * rstd * gg[i] + bb[i];
      if (last) {
        store_row(p.out + (size_t)tok * D, lane, x2);
      } else {
        store_row(p.xres + (size_t)tok * D, lane, x2);
        const float* mdn = p.mod + ((size_t)(layer + 1) * 5 + tok_modrow(tok)) * NMOD;
        float h[16];
        modulate_row(x2, mdn, mdn + 1024, lane, h);
        store_row_bf(p.h + (size_t)tok * D, lane, h);
      }
    }
  }
}

struct Ptr4 { const bf16_t* p[4]; };

template <int NJ>
__device__ __forceinline__ void gemm_compute_tile(const char* cA, const char* cB, int r, int hh, f32x16 (&acc)[2][NJ]) {
#pragma unroll
  for (int s = 0; s < 4; ++s) {
    const int co = ((2 * s + hh) ^ ((r >> 1) & 7)) << 4;
    bf16x8 a0 = *(const bf16x8*)(cA + co);
    bf16x8 a1 = *(const bf16x8*)(cA + 4096 + co);
    bf16x8 b[NJ];
#pragma unroll
    for (int j = 0; j < NJ; ++j) b[j] = *(const bf16x8*)(cB + j * 4096 + co);
#pragma unroll
    for (int j = 0; j < NJ; ++j) {
      acc[0][j] = mfma32(a0, b[j], acc[0][j]);
      acc[1][j] = mfma32(a1, b[j], acc[1][j]);
    }
  }
}
#define LAS3 __attribute__((address_space(3)))
__device__ __forceinline__ void dma_sync() { asm volatile("s_waitcnt vmcnt(0)" ::: "memory"); __syncthreads(); }
template <int NJ>
__device__ __forceinline__ void g_stage(const Ptr4& ap, const Ptr4& bp, int kt, char* dA, char* dB) {
#pragma unroll
  for (int i = 0; i < 4; ++i) __builtin_amdgcn_global_load_lds((const unsigned*)(ap.p[i] + kt * 64), (LAS3 unsigned*)(dA + i * 4096), 16, 0, 0);
#pragma unroll
  for (int i = 0; i < 2 * NJ; ++i) __builtin_amdgcn_global_load_lds((const unsigned*)(bp.p[i] + kt * 64), (LAS3 unsigned*)(dB + i * 4096), 16, 0, 0);
}
template <int NJ>
__device__ __forceinline__ void gemm_mainloop(const Ptr4& ap, const Ptr4& bp, int nk, f32x16 (&acc)[2][NJ], char* smem) {
  const int tid = tid_(), lane = tid & 63, w = tid >> 6, wr = w >> 1, wc = w & 1, r = lane & 31, hh = lane >> 5;
  char* sA = smem;
  char* sB = smem + 32768;
  const int dofs = tid * 16;
  g_stage<NJ>(ap, bp, 0, sA + dofs, sB + dofs);
  dma_sync();
  const char* cA = sA + (wr * 64 + r) * 128;
  const char* cB = sB + (wc * 32 * NJ + r) * 128;
  for (int kt = 0; kt < nk; ++kt) {
    const int cur = kt & 1;
    if (kt + 1 < nk) g_stage<NJ>(ap, bp, kt + 1, sA + (cur ^ 1) * 16384 + dofs, sB + (cur ^ 1) * 16384 + dofs);
    gemm_compute_tile<NJ>(cA + cur * 16384, cB + cur * 16384, r, hh, acc);
    dma_sync();
  }
}
__device__ __forceinline__ Ptr4 rows_contig(const bf16_t* base, int ld) {
  Ptr4 q;
  const int lrow = tid_() >> 3, lch = tid_() & 7;
#pragma unroll
  for (int i = 0; i < 4; ++i) q.p[i] = base + (size_t)(lrow + 32 * i) * ld + ((lch ^ ((lrow >> 1) & 7)) * 8);
  return q;
}
__device__ __forceinline__ void acc_to_lds(const f32x16 (&acc)[2][2], float* sC) {
  const int lane = tid_() & 63, w = tid_() >> 6, wr = w >> 1, wc = w & 1, r = lane & 31, hh = lane >> 5;
#pragma unroll
  for (int i = 0; i < 2; ++i)
#pragma unroll
    for (int j = 0; j < 2; ++j)
#pragma unroll
      for (int g = 0; g < 16; ++g) {
        int row = wr * 64 + i * 32 + (g & 3) + 8 * (g >> 2) + 4 * hh, col = wc * 64 + j * 32 + r;
        sC[row * LDC + col] = acc[i][j][g];
      }
}
__device__ __forceinline__ void acc_to_lds_T(const f32x16 (&acc)[2][2], float* sC) {
  const int lane = tid_() & 63, w = tid_() >> 6, wr = w >> 1, wc = w & 1, r = lane & 31, hh = lane >> 5;
#pragma unroll
  for (int i = 0; i < 2; ++i)
#pragma unroll
    for (int j = 0; j < 2; ++j)
#pragma unroll
      for (int g4 = 0; g4 < 4; ++g4) {
        int row = wr * 64 + i * 32 + 8 * g4 + 4 * hh, col = wc * 64 + j * 32 + r;
        *(float4*)(sC + col * LDC + row) = make_float4(acc[i][j][4 * g4], acc[i][j][4 * g4 + 1], acc[i][j][4 * g4 + 2], acc[i][j][4 * g4 + 3]);
      }
}
__device__ __forceinline__ void lds_read8(const float* s, float (&v)[8]) {
  float4 a = *(const float4*)s, b = *(const float4*)(s + 4);
  v[0] = a.x; v[1] = a.y; v[2] = a.z; v[3] = a.w; v[4] = b.x; v[5] = b.y; v[6] = b.z; v[7] = b.w;
}
__device__ __forceinline__ uint4 pack8(const float (&v)[8]) {
  return make_uint4(pack2(v[0], v[1]), pack2(v[2], v[3]), pack2(v[4], v[5]), pack2(v[6], v[7]));
}
__device__ __forceinline__ void st_nt16(void* q, const uint4 v) {
  typedef unsigned nt_u32x4 __attribute__((ext_vector_type(4)));
  const nt_u32x4 t = {v.x, v.y, v.z, v.w};
  __builtin_nontemporal_store(t, (nt_u32x4*)q);
}


__device__ __forceinline__ int xcd_rounds(const char*, int nMt, int nNt) { return (nMt * nNt + vgrid_() - 1) / vgrid_(); }
__device__ __forceinline__ bool xcd_tile(const char*, int round, int nMt, int nNt, int& mt, int& nt) {
  const int item = round * vgrid_() + bid_();
  mt = item / nNt; nt = item % nNt;
  return item < nMt * nNt;
}

namespace pg8 {
constexpr int BK = 64, HALF = 128, HTB = HALF * BK * 2, STAGE_BYTES = 8 * HTB;
__device__ __forceinline__ int lds_byte(int r, int c) { const int st = (r >> 4) * 2 + (c >> 5), rr = r & 15, cc = c & 31, ob = rr * 64 + cc * 2; return st * 1024 + (ob ^ (((ob >> 9) & 1) << 5)); }
__device__ __forceinline__ void stage_rc(int b, int& R, int& C) { const int st = b / 1024, sb = b % 1024, swz = sb ^ (((sb >> 9) & 1) << 5); R = (st >> 1) * 16 + swz / 64; C = (st & 1) * 32 + (swz % 64) / 2; }
typedef float f32x4 __attribute__((ext_vector_type(4)));
__device__ __forceinline__ int perm32(int rho) { const int n = rho >> 4, i = rho & 15; return 8 * (i >> 2) + 4 * n + (i & 3); }
template <bool PERM = false>
__device__ __forceinline__ void gemm_unit(LAS3 unsigned char* lds, const char* cA0, const char* cA1, const unsigned (&voffA0)[2], const unsigned (&voffA1)[2],
                                          const char* cB, int K, f32x4 (&acc)[2][2][4][2]) {
  int tid = __builtin_amdgcn_workitem_id_x();
  asm volatile("" : "+v"(tid));
  const int wid = __builtin_amdgcn_readfirstlane(tid >> 6), lane = tid & 63, wr = wid >> 2, wc = wid & 3, fr = lane & 15, fq = lane >> 4;
  const int nt = K / BK;
  unsigned voffB[2];
#pragma unroll
  for (int i = 0; i < 2; ++i) { int R, C; stage_rc(tid * 16 + i * 8192, R, C); const int Rb = PERM ? ((R & ~31) + perm32(R & 31)) : R; voffB[i] = (unsigned)(Rb * K + C) * 2u; }
  const size_t kstep = (size_t)(BK * 2);
  const size_t hstep = (size_t)HALF * K * 2;
  const unsigned ldsw = (unsigned)wid * 1024u;
  const int aoff = lds_byte(wr * 64 + fr, fq * 8), boff = lds_byte(wc * 32 + fr, fq * 8);
#define PG8_SA(b, h) (((b) * 2 + (h)) * HTB)
#define PG8_SB(b, h) ((4 + (b) * 2 + (h)) * HTB)
#define PG8_STAGE(bufoff, gbase, voff) do { _Pragma("unroll") for (int _i = 0; _i < 2; ++_i) \
        __builtin_amdgcn_global_load_lds((const unsigned*)((const char*)(gbase) + (voff)[_i]), (LAS3 unsigned*)(lds + (bufoff) + ldsw + _i * 8192), 16, 0, 0); } while (0)
#define PG8_LDA(dst, b, h) do { _Pragma("unroll") for (int m = 0; m < 4; ++m) _Pragma("unroll") for (int k = 0; k < 2; ++k) dst[m][k] = *(const LAS3 bf16x8*)(lds + PG8_SA(b, h) + aoff + m * 2048 + k * 1024); } while (0)
#define PG8_LDB(dst, b, h) do { _Pragma("unroll") for (int n = 0; n < 2; ++n) _Pragma("unroll") for (int k = 0; k < 2; ++k) dst[n][k] = *(const LAS3 bf16x8*)(lds + PG8_SB(b, h) + boff + n * 2048 + k * 1024); } while (0)
#define PG8_MMA(ai, bj, At, Bt) do { __builtin_amdgcn_s_setprio(1); _Pragma("unroll") for (int m = 0; m < 4; ++m) _Pragma("unroll") for (int n = 0; n < 2; ++n) _Pragma("unroll") for (int k = 0; k < 2; ++k) \
        acc[ai][bj][m][n] = __builtin_amdgcn_mfma_f32_16x16x32_bf16(Bt[n][k], At[m][k], acc[ai][bj][m][n], 0, 0, 0); __builtin_amdgcn_s_setprio(0); } while (0)
#define PG8_WAIT_V(n) asm volatile("s_waitcnt vmcnt(" #n ")" ::: "memory")
#define PG8_WAIT_L(n) asm volatile("s_waitcnt lgkmcnt(" #n ")" ::: "memory")
#define PG8_BAR __builtin_amdgcn_s_barrier()
#define PG8_SCHED __builtin_amdgcn_sched_barrier(0)
#pragma unroll
  for (int a = 0; a < 2; ++a)
#pragma unroll
    for (int b = 0; b < 2; ++b)
#pragma unroll
      for (int m = 0; m < 4; ++m)
#pragma unroll
        for (int n = 0; n < 2; ++n) acc[a][b][m][n] = (f32x4){0.f, 0.f, 0.f, 0.f};
  bf16x8 At[4][2], B0[2][2], B1[2][2];
  PG8_STAGE(PG8_SB(0, 0), cB, voffB); PG8_STAGE(PG8_SA(0, 0), cA0, voffA0); PG8_STAGE(PG8_SB(0, 1), cB + hstep, voffB); PG8_STAGE(PG8_SA(0, 1), cA1, voffA1);
  if (wr == 1) PG8_BAR;
  PG8_WAIT_V(4); PG8_BAR;
  PG8_STAGE(PG8_SB(1, 0), cB + kstep, voffB); PG8_STAGE(PG8_SA(1, 0), cA0 + kstep, voffA0); PG8_STAGE(PG8_SB(1, 1), cB + hstep + kstep, voffB);
  PG8_WAIT_V(6); PG8_BAR;
  for (int t = 0; t < nt; t += 2) {
    const bool last = (t == nt - 2);
    const size_t o1 = (size_t)(t + 1) * kstep;
    const size_t o2 = last ? 0 : (size_t)(t + 2) * kstep;
    const size_t o3 = o2 + kstep;
    PG8_LDB(B0, 0, 0); PG8_SCHED; PG8_LDA(At, 0, 0); PG8_STAGE(PG8_SA(1, 1), cA1 + o1, voffA1);
    PG8_WAIT_L(8); PG8_BAR; PG8_WAIT_L(0); PG8_MMA(0, 0, At, B0); PG8_BAR; PG8_SCHED;
    PG8_LDB(B1, 0, 1); PG8_STAGE(PG8_SB(0, 0), cB + o2, voffB);
    PG8_BAR; PG8_WAIT_L(0); PG8_MMA(0, 1, At, B1); PG8_BAR;
    PG8_LDA(At, 0, 1); PG8_STAGE(PG8_SA(0, 0), cA0 + o2, voffA0);
    PG8_BAR; PG8_WAIT_L(0); PG8_MMA(1, 0, At, B0); PG8_BAR; PG8_SCHED;
    PG8_STAGE(PG8_SB(0, 1), cB + hstep + o2, voffB);
    PG8_WAIT_V(6); PG8_BAR; PG8_MMA(1, 1, At, B1); PG8_BAR;
    PG8_LDB(B0, 1, 0); PG8_SCHED; PG8_LDA(At, 1, 0); PG8_STAGE(PG8_SA(0, 1), cA1 + o2, voffA1);
    PG8_WAIT_L(8); PG8_BAR; PG8_WAIT_L(0); PG8_MMA(0, 0, At, B0); PG8_BAR; PG8_SCHED;
    PG8_LDB(B1, 1, 1); PG8_STAGE(PG8_SB(1, 0), cB + o3, voffB);
    PG8_BAR; PG8_WAIT_L(0); PG8_MMA(0, 1, At, B1); PG8_BAR;
    PG8_LDA(At, 1, 1); PG8_STAGE(PG8_SA(1, 0), cA0 + o3, voffA0);
    PG8_BAR; PG8_WAIT_L(0); PG8_MMA(1, 0, At, B0); PG8_BAR; PG8_SCHED;
    PG8_STAGE(PG8_SB(1, 1), cB + hstep + o3, voffB);
    PG8_WAIT_V(6); PG8_BAR; PG8_MMA(1, 1, At, B1); PG8_BAR;
  }
  PG8_WAIT_V(0);
  if (wr == 0) PG8_BAR;
  PG8_BAR;
#undef PG8_SA
#undef PG8_SB
#undef PG8_STAGE
#undef PG8_LDA
#undef PG8_LDB
#undef PG8_MMA
#undef PG8_WAIT_V
#undef PG8_WAIT_L
#undef PG8_BAR
#undef PG8_SCHED
}
struct UnitAB { const char* a; const char* b; };
template <bool PERM, class Prov, class Epi>
__device__ __forceinline__ void gemm_stream(LAS3 unsigned char* lds, int K, Prov prov, Epi epi) {
  int tid = __builtin_amdgcn_workitem_id_x();
  asm volatile("" : "+v"(tid));
  const int wid = __builtin_amdgcn_readfirstlane(tid >> 6), lane = tid & 63, wr = wid >> 2, wc = wid & 3, fr = lane & 15, fq = lane >> 4;
  const int nt = K / BK;
  UnitAB cur, nxt;
  if (!prov(0, cur)) return;
  unsigned voffA[2], voffB[2];
#pragma unroll
  for (int i = 0; i < 2; ++i) { int R, C; stage_rc(tid * 16 + i * 8192, R, C); const int Rb = PERM ? ((R & ~31) + perm32(R & 31)) : R;
    voffA[i] = (unsigned)(R * K + C) * 2u; voffB[i] = (unsigned)(Rb * K + C) * 2u; }
  const size_t kstep = (size_t)(BK * 2);
  const size_t hstep = (size_t)HALF * K * 2;
  const unsigned ldsw = (unsigned)wid * 1024u;
  const int aoff = lds_byte(wr * 64 + fr, fq * 8), boff = lds_byte(wc * 32 + fr, fq * 8);
#define PG8_SA(b, h) (((b) * 2 + (h)) * HTB)
#define PG8_SB(b, h) ((4 + (b) * 2 + (h)) * HTB)
#define PG8_STAGE(bufoff, gbase, voff) do { _Pragma("unroll") for (int _i = 0; _i < 2; ++_i) \
        __builtin_amdgcn_global_load_lds((const unsigned*)((const char*)(gbase) + (voff)[_i]), (LAS3 unsigned*)(lds + (bufoff) + ldsw + _i * 8192), 16, 0, 0); } while (0)
#define PG8_LDA(dst, b, h) do { _Pragma("unroll") for (int m = 0; m < 4; ++m) _Pragma("unroll") for (int k = 0; k < 2; ++k) dst[m][k] = *(const LAS3 bf16x8*)(lds + PG8_SA(b, h) + aoff + m * 2048 + k * 1024); } while (0)
#define PG8_LDB(dst, b, h) do { _Pragma("unroll") for (int n = 0; n < 2; ++n) _Pragma("unroll") for (int k = 0; k < 2; ++k) dst[n][k] = *(const LAS3 bf16x8*)(lds + PG8_SB(b, h) + boff + n * 2048 + k * 1024); } while (0)
#define PG8_MMA(ai, bj, At, Bt) do { __builtin_amdgcn_s_setprio(1); _Pragma("unroll") for (int m = 0; m < 4; ++m) _Pragma("unroll") for (int n = 0; n < 2; ++n) _Pragma("unroll") for (int k = 0; k < 2; ++k) \
        acc[ai][bj][m][n] = __builtin_amdgcn_mfma_f32_16x16x32_bf16(Bt[n][k], At[m][k], acc[ai][bj][m][n], 0, 0, 0); __builtin_amdgcn_s_setprio(0); } while (0)
#define PG8_WAIT_V(n) asm volatile("s_waitcnt vmcnt(" #n ")" ::: "memory")
#define PG8_WAIT_L(n) asm volatile("s_waitcnt lgkmcnt(" #n ")" ::: "memory")
#define PG8_BAR __builtin_amdgcn_s_barrier()
#define PG8_SCHED __builtin_amdgcn_sched_barrier(0)
#define PG8_ZERO() do { _Pragma("unroll") for (int a = 0; a < 2; ++a) _Pragma("unroll") for (int b = 0; b < 2; ++b) _Pragma("unroll") for (int m = 0; m < 4; ++m) \
        _Pragma("unroll") for (int n = 0; n < 2; ++n) acc[a][b][m][n] = (f32x4){0.f, 0.f, 0.f, 0.f}; } while (0)
  f32x4 acc[2][2][4][2];
  PG8_ZERO();
  bf16x8 At[4][2], B0[2][2], B1[2][2];
  const char* cA = cur.a; const char* cB = cur.b;
  PG8_STAGE(PG8_SB(0, 0), cB, voffB); PG8_STAGE(PG8_SA(0, 0), cA, voffA); PG8_STAGE(PG8_SB(0, 1), cB + hstep, voffB); PG8_STAGE(PG8_SA(0, 1), cA + hstep, voffA);
  if (wr == 1) PG8_BAR;
  PG8_WAIT_V(4); PG8_BAR;
  PG8_STAGE(PG8_SB(1, 0), cB + kstep, voffB); PG8_STAGE(PG8_SA(1, 0), cA + kstep, voffA); PG8_STAGE(PG8_SB(1, 1), cB + hstep + kstep, voffB);
  PG8_WAIT_V(6); PG8_BAR;
  for (int ui = 0;; ++ui) {
    const bool has_next = prov(ui + 1, nxt);
    const char* nA = has_next ? nxt.a : cA; const char* nB = has_next ? nxt.b : cB;
    for (int t = 0; t < nt; t += 2) {
      const bool last = (t == nt - 2);
      const char* a1 = cA + (size_t)(t + 1) * kstep;
      const char* a2 = last ? nA : cA + (size_t)(t + 2) * kstep; const char* b2 = last ? nB : cB + (size_t)(t + 2) * kstep;
      const char* a3 = a2 + kstep; const char* b3 = b2 + kstep;
      PG8_LDB(B0, 0, 0); PG8_SCHED; PG8_LDA(At, 0, 0); PG8_STAGE(PG8_SA(1, 1), a1 + hstep, voffA);
      PG8_WAIT_L(8); PG8_BAR; PG8_WAIT_L(0); PG8_MMA(0, 0, At, B0); PG8_BAR; PG8_SCHED;
      PG8_LDB(B1, 0, 1); PG8_STAGE(PG8_SB(0, 0), b2, voffB);
      PG8_BAR; PG8_WAIT_L(0); PG8_MMA(0, 1, At, B1); PG8_BAR;
      PG8_LDA(At, 0, 1); PG8_STAGE(PG8_SA(0, 0), a2, voffA);
      PG8_BAR; PG8_WAIT_L(0); PG8_MMA(1, 0, At, B0); PG8_BAR; PG8_SCHED;
      PG8_STAGE(PG8_SB(0, 1), b2 + hstep, voffB);
      PG8_WAIT_V(6); PG8_BAR; PG8_MMA(1, 1, At, B1); PG8_BAR;
      PG8_LDB(B0, 1, 0); PG8_SCHED; PG8_LDA(At, 1, 0); PG8_STAGE(PG8_SA(0, 1), a2 + hstep, voffA);
      PG8_WAIT_L(8); PG8_BAR; PG8_WAIT_L(0); PG8_MMA(0, 0, At, B0); PG8_BAR; PG8_SCHED;
      PG8_LDB(B1, 1, 1); PG8_STAGE(PG8_SB(1, 0), b3, voffB);
      PG8_BAR; PG8_WAIT_L(0); PG8_MMA(0, 1, At, B1); PG8_BAR;
      PG8_LDA(At, 1, 1); PG8_STAGE(PG8_SA(1, 0), a3, voffA);
      PG8_BAR; PG8_WAIT_L(0); PG8_MMA(1, 0, At, B0); PG8_BAR; PG8_SCHED;
      PG8_STAGE(PG8_SB(1, 1), b3 + hstep, voffB);
      PG8_WAIT_V(6); PG8_BAR; PG8_MMA(1, 1, At, B1); PG8_BAR;
    }
    epi(ui, acc);
    if (!has_next) break;
    PG8_ZERO();
    cA = nA; cB = nB;
  }
  PG8_WAIT_V(0);
  if (wr == 0) PG8_BAR;
  PG8_BAR;
#undef PG8_SA
#undef PG8_SB
#undef PG8_STAGE
#undef PG8_LDA
#undef PG8_LDB
#undef PG8_MMA
#undef PG8_WAIT_V
#undef PG8_WAIT_L
#undef PG8_BAR
#undef PG8_SCHED
#undef PG8_ZERO
}
__device__ __forceinline__ void voff_contig(int K, unsigned (&voff)[2]) {
  int tid = __builtin_amdgcn_workitem_id_x();
  asm volatile("" : "+v"(tid));
#pragma unroll
  for (int i = 0; i < 2; ++i) { int R, C; stage_rc(tid * 16 + i * 8192, R, C); voff[i] = (unsigned)(R * K + C) * 2u; }
}
template <int ai, int bj>
__device__ __forceinline__ void acc_to_lds(const f32x4 (&acc)[2][2][4][2], bool transposed, float* sC) {
  int tid = __builtin_amdgcn_workitem_id_x();
  asm volatile("" : "+v"(tid));
  const int wid = tid >> 6, lane = tid & 63, wr = wid >> 2, wc = wid & 3, fr = lane & 15, fq = lane >> 4;
#pragma unroll
  for (int m = 0; m < 4; ++m)
#pragma unroll
    for (int n = 0; n < 2; ++n) {
      const int row = 64 * wr + 16 * m + fr, col = 32 * wc + 16 * n + 4 * fq;
      const f32x4 v = acc[ai][bj][m][n];
      if (!transposed) *(f32x4*)(sC + row * LDC + col) = v;
      else { sC[col * LDC + row] = v[0]; sC[(col + 1) * LDC + row] = v[1]; sC[(col + 2) * LDC + row] = v[2]; sC[(col + 3) * LDC + row] = v[3]; }
    }
}
template <class F>
__device__ __forceinline__ void for_each_piece(const f32x4 (&acc)[2][2][4][2], F f) {
  int tid = __builtin_amdgcn_workitem_id_x();
  asm volatile("" : "+v"(tid));
  const int wid = tid >> 6, lane = tid & 63, wr = wid >> 2, wc = wid & 3, fr = lane & 15, fq = lane >> 4;
#pragma unroll
  for (int ai = 0; ai < 2; ++ai)
#pragma unroll
    for (int m = 0; m < 4; ++m)
#pragma unroll
      for (int bj = 0; bj < 2; ++bj) {
        const f32x4 a = acc[ai][bj][m][0], b = acc[ai][bj][m][1];
        float v[8] = {a[0], a[1], a[2], a[3], b[0], b[1], b[2], b[3]};
        f(128 * ai + 64 * wr + 16 * m + fr, 128 * bj + 32 * wc + 8 * fq, v);
      }
}
__device__ __forceinline__ int unit_linear(int i) { return i * (int)gridDim.x + (int)__builtin_amdgcn_workgroup_id_x(); }
__device__ __forceinline__ bool unit_map(int L, int nM, int nN, int& pm, int& pn) {
  const int nwg = nM * nN;
  if (L >= nwg) return false;
  int wgid = L;
  { const int q = nwg / 8, r = nwg % 8, xcd = wgid % 8, off = wgid / 8; wgid = (xcd < r ? xcd * (q + 1) : r * (q + 1) + (xcd - r) * q) + off; }
  const int nig = 8 * nN, gid = wgid / nig, fm = gid * 8, gsz = (nM - fm) < 8 ? (nM - fm) : 8;
  pm = fm + ((wgid % nig) % gsz); pn = (wgid % nig) / gsz;
  return true;
}
}

__device__ __forceinline__ bool inproj_transposed(int nt) { return (nt == 5) || (nt >= 10 && nt <= 13) || (nt >= 26 && nt <= 29); }
__device__ __forceinline__ void inproj_epilogue(PRef p, int layer, int mt, int nt, const float* sC, int tid) {
  const float* bias = p.b_in + layer * NIN_SRC;
  const bool transposed = inproj_transposed(nt);
  const int tok0 = mt * 128;
  const bool lat = tok0 < TLAT;
  int b, pos0, pall0;
  if (lat) { b = tok0 >> 12; pos0 = tok0 & 4095; pall0 = 256 + pos0; }
  else { int ci = tok0 - TLAT; b = ci >> 8; pos0 = ci & 255; pall0 = pos0; }
  const int n0 = nt * 128;
  const int srcc0 = (nt < 18) ? n0 : n0 + 32;
  if (transposed) {
    const int tc = tid & 15, cb = tid >> 4;
    float bv[8];
#pragma unroll
    for (int ps = 0; ps < 8; ++ps) bv[ps] = bias[srcc0 + ps * 16 + cb];
#pragma unroll
    for (int ps = 0; ps < 8; ++ps) {
      const int col = ps * 16 + cb;
      float v[8];
      lds_read8(sC + col * LDC + tc * 8, v);
#pragma unroll
      for (int e = 0; e < 8; ++e) v[e] += bv[ps];
      bf16_t* dst;
      if (nt == 5) dst = p.vAT + ((size_t)(b * 2 + (col >> 6)) * 64 + (col & 63)) * PALL;
      else if (nt <= 13) dst = p.vBT + ((size_t)(b * 4 + (nt - 10)) * 128 + col) * PALL;
      else dst = p.vCT + ((size_t)(b * 8 + (nt - 26) * 2 + (col >> 6)) * 64 + (col & 63)) * PALL;
      *(uint4*)(dst + pall0 + tc * 8) = pack8(v);
    }
  } else if (nt <= 4) {
    const float* gn = (nt < 4 ? p.q_norm : p.k_norm) + layer * 64;
    const float osc = nt < 4 ? QSCALE : 1.f;
    const int c8 = tid & 15, rb = tid >> 4, d0 = (c8 & 7) * 8;
    float bs[8], bp[8], g0[8], g1[8];
    {
      const float4 t0 = *(const float4*)(bias + srcc0 + c8 * 8), t1 = *(const float4*)(bias + srcc0 + c8 * 8 + 4);
      const float4 u0 = *(const float4*)(bias + srcc0 + ((c8 * 8) ^ 16)), u1 = *(const float4*)(bias + srcc0 + ((c8 * 8) ^ 16) + 4);
      const float4 a0 = *(const float4*)(gn + d0), a1 = *(const float4*)(gn + d0 + 4);
      const float4 c0 = *(const float4*)(gn + (d0 ^ 16)), c1 = *(const float4*)(gn + (d0 ^ 16) + 4);
      bs[0] = t0.x; bs[1] = t0.y; bs[2] = t0.z; bs[3] = t0.w; bs[4] = t1.x; bs[5] = t1.y; bs[6] = t1.z; bs[7] = t1.w;
      bp[0] = u0.x; bp[1] = u0.y; bp[2] = u0.z; bp[3] = u0.w; bp[4] = u1.x; bp[5] = u1.y; bp[6] = u1.z; bp[7] = u1.w;
      g0[0] = a0.x; g0[1] = a0.y; g0[2] = a0.z; g0[3] = a0.w; g0[4] = a1.x; g0[5] = a1.y; g0[6] = a1.z; g0[7] = a1.w;
      g1[0] = c0.x; g1[1] = c0.y; g1[2] = c0.z; g1[3] = c0.w; g1[4] = c1.x; g1[5] = c1.y; g1[6] = c1.z; g1[7] = c1.w;
    }
    const int qd = d0 >> 4;
    const float sgn = (qd & 1) ? 1.f : -1.f;
#pragma unroll 2
    for (int ps = 0; ps < 8; ++ps) {
      const int row = ps * 16 + rb;
      float v[8], pv[8];
      lds_read8(sC + row * LDC + c8 * 8, v);
      lds_read8(sC + row * LDC + ((c8 * 8) ^ 16), pv);
      float cs[8], sn[8];
      if (lat) {
        const int t = pos0 + row;
        const int pp = (qd < 2) ? (t >> 6) : (t & 63);
        const float* rp = p.rope + pp * 16 + (d0 & 15);
        const float4 r0 = *(const float4*)rp, r1 = *(const float4*)(rp + 4), s0 = *(const float4*)(rp + 1024), s1 = *(const float4*)(rp + 1028);
        cs[0] = r0.x; cs[1] = r0.y; cs[2] = r0.z; cs[3] = r0.w; cs[4] = r1.x; cs[5] = r1.y; cs[6] = r1.z; cs[7] = r1.w;
        sn[0] = s0.x; sn[1] = s0.y; sn[2] = s0.z; sn[3] = s0.w; sn[4] = s1.x; sn[5] = s1.y; sn[6] = s1.z; sn[7] = s1.w;
      } else {
#pragma unroll
        for (int e = 0; e < 8; ++e) { cs[e] = 1.f; sn[e] = 0.f; }
      }
      float ss = 0.f;
#pragma unroll
      for (int e = 0; e < 8; ++e) { v[e] += bs[e]; pv[e] += bp[e]; ss += v[e] * v[e]; }
      ss += __shfl_xor(ss, 1);
      ss += __shfl_xor(ss, 2);
      ss += __shfl_xor(ss, 4);
      const float rstd = rsqrtf(ss * (1.f / 64.f) + 1e-6f);
      float o[8];
#pragma unroll
      for (int e = 0; e < 8; ++e) {
        const float xn = v[e] * rstd * g0[e], pn = pv[e] * rstd * g1[e];
        o[e] = (xn * cs[e] + sgn * pn * sn[e]) * osc;
      }
      bf16_t* dst;
      if (nt < 4) dst = p.qA + (size_t)(tok0 + row) * 512 + nt * 128 + c8 * 8;
      else dst = p.kA + ((size_t)(b * 2 + (c8 >> 3)) * PALL + pall0 + row) * 64 + d0;
      *(uint4*)dst = pack8(o);
    }
  } else {
    bf16_t* base;
    int ld, cofs;
    float osc = 1.f;
    if (nt <= 7) { base = p.qB; ld = 256; cofs = (nt - 6) * 128; osc = 0.125f; }
    else if (nt <= 9) { base = p.kB; ld = 256; cofs = (nt - 8) * 128; }
    else if (nt <= 17) { base = p.rB; ld = 512; cofs = (nt - 14) * 128; }
    else if (nt <= 21) { base = p.qC; ld = 512; cofs = (nt - 18) * 128; osc = QSCALE; }
    else { base = p.kC; ld = 512; cofs = (nt - 22) * 128; }
    const int c8 = tid & 15, rb = tid >> 4;
    float bs[8];
    {
      const float4 t0 = *(const float4*)(bias + srcc0 + c8 * 8), t1 = *(const float4*)(bias + srcc0 + c8 * 8 + 4);
      bs[0] = t0.x; bs[1] = t0.y; bs[2] = t0.z; bs[3] = t0.w; bs[4] = t1.x; bs[5] = t1.y; bs[6] = t1.z; bs[7] = t1.w;
    }
#pragma unroll
    for (int ps = 0; ps < 8; ++ps) {
      const int row = ps * 16 + rb;
      float v[8];
      lds_read8(sC + row * LDC + c8 * 8, v);
#pragma unroll
      for (int e = 0; e < 8; ++e) v[e] = (v[e] + bs[e]) * osc;
      *(uint4*)(base + (size_t)(tok0 + row) * ld + cofs + c8 * 8) = pack8(v);
    }
  }
}

__device__ __forceinline__ void gate_epilogue(PRef p, int layer, int mt, int nt, const float* sC, int tid) {
  const float* bias = p.b_in + layer * NIN_SRC + 3872 + nt * 128;
  const int c8 = tid & 15, rb = tid >> 4;
  float bs[8];
  {
    const float4 t0 = *(const float4*)(bias + c8 * 8), t1 = *(const float4*)(bias + c8 * 8 + 4);
    bs[0] = t0.x; bs[1] = t0.y; bs[2] = t0.z; bs[3] = t0.w; bs[4] = t1.x; bs[5] = t1.y; bs[6] = t1.z; bs[7] = t1.w;
  }
#pragma unroll
  for (int ps = 0; ps < 8; ++ps) {
    const int row = ps * 16 + rb;
    float v[8];
    lds_read8(sC + row * LDC + c8 * 8, v);
#pragma unroll
    for (int e = 0; e < 8; ++e) v[e] = sigmoidf_(v[e] + bs[e]);
    *(uint4*)(p.G + (size_t)(mt * 128 + row) * 3072 + nt * 128 + c8 * 8) = pack8(v);
  }
}
__device__ __forceinline__ void phase_inproj(PRef p, int layer, char* smem_all) {
  LAS3 unsigned char* lds = (LAS3 unsigned char*)smem_all;
  constexpr int NSTREAM_IN = 68 * 12, NSTREAM = NSTREAM_IN + 64 * 12, NOLD = 68 * 3;
  {
    unsigned voffA[2];
    pg8::voff_contig(D, voffA);
    const int G = (int)gridDim.x, c = (int)__builtin_amdgcn_workgroup_id_x();
    const int rem = NSTREAM % G;
    for (int j = (c - rem + G) % G; j < NOLD; j += G) {
      int pm, pn;
      pg8::unit_map(j, 68, 3, pm, pn);
      pg8::f32x4 acc[2][2][4][2];
      const char* a0 = (const char*)(p.h + (size_t)pm * 256 * D);
      pg8::gemm_unit(lds, a0, a0 + (size_t)128 * D * 2, voffA, voffA, (const char*)(p.wt_in + (size_t)pn * 256 * D), D, acc);
      asm volatile("" : "+s"(pm), "+s"(pn));
      PRef pe = params_view();
      const int etid = tid_();
      const int half = half_();
      float* sCh = (float*)(smem_all + half * SMEM_BYTES);
      pg8::acc_to_lds<0, 0>(acc, inproj_transposed(2 * pn), (float*)smem_all);
      pg8::acc_to_lds<0, 1>(acc, inproj_transposed(2 * pn + 1), (float*)(smem_all + SMEM_BYTES));
      __syncthreads();
      inproj_epilogue(pe, layer, 2 * pm, 2 * pn + half, sCh, etid);
      __syncthreads();
      pg8::acc_to_lds<1, 0>(acc, inproj_transposed(2 * pn), (float*)smem_all);
      pg8::acc_to_lds<1, 1>(acc, inproj_transposed(2 * pn + 1), (float*)(smem_all + SMEM_BYTES));
      __syncthreads();
      inproj_epilogue(pe, layer, 2 * pm + 1, 2 * pn + half, sCh, etid);
      __syncthreads();
    }
  }
  {
    PRef pg = params_view();
    const bf16_t* hbase = pg.h;
    const bf16_t* win = pg.wt_in;
    const bf16_t* wg = pg.wt_gate;
    const float* bias = pg.b_in + layer * NIN_SRC;
    bf16_t* gbase = pg.G;
    pg8::gemm_stream<true>(lds, D,
      [&](int ui, pg8::UnitAB& u) {
        const int s = pg8::unit_linear(ui);
        int pm, pn;
        if (s < NSTREAM_IN) {
          pg8::unit_map(s, 68, 12, pm, pn);
          pn += 3;
          const char* hr = (const char*)(hbase + (size_t)pm * 256 * D);
          const char* wr_ = (const char*)(win + (size_t)pn * 256 * D);
          const bool T = (pn == 5) || (pn == 6) || (pn >= 13);
          u.a = T ? wr_ : hr;
          u.b = T ? hr : wr_;
          return true;
        }
        if (!pg8::unit_map(s - NSTREAM_IN, 64, 12, pm, pn)) return false;
        u.a = (const char*)(hbase + (size_t)pm * 256 * D);
        u.b = (const char*)(wg + (size_t)pn * 256 * D);
        return true;
      },
      [&](int ui, const pg8::f32x4 (&acc)[2][2][4][2]) {
        const int s = pg8::unit_linear(ui);
        int lt = __builtin_amdgcn_workitem_id_x();
        asm volatile("" : "+v"(lt));
        const int wc = (lt >> 6) & 3, wr = lt >> 8, fr = lt & 15, fq = (lt & 63) >> 4;
        const int cbase = 32 * wc + 8 * fq;
        int pm, pn;
        if (s >= NSTREAM_IN) {
          pg8::unit_map(s - NSTREAM_IN, 64, 12, pm, pn);
          const float* gb = bias + 3872 + pn * 256;
          bf16_t* gdst = gbase + (size_t)pm * 256 * 3072 + pn * 256;
          const float4 ba0 = *(const float4*)(gb + cbase), ba1 = *(const float4*)(gb + cbase + 4);
          const float4 bb0 = *(const float4*)(gb + 128 + cbase), bb1 = *(const float4*)(gb + 128 + cbase + 4);
          pg8::for_each_piece(acc, [&](int row, int col, float (&v)[8]) {
            const float4 b0 = col < 128 ? ba0 : bb0, b1 = col < 128 ? ba1 : bb1;
            v[0] = sigmoidf_(v[0] + b0.x); v[1] = sigmoidf_(v[1] + b0.y); v[2] = sigmoidf_(v[2] + b0.z); v[3] = sigmoidf_(v[3] + b0.w);
            v[4] = sigmoidf_(v[4] + b1.x); v[5] = sigmoidf_(v[5] + b1.y); v[6] = sigmoidf_(v[6] + b1.z); v[7] = sigmoidf_(v[7] + b1.w);
            st_nt16(gdst + (size_t)row * 3072 + col, pack8(v));
          });
          return;
        }
        pg8::unit_map(s, 68, 12, pm, pn);
        pn += 3;
        const float* bsrc = bias + (pn < 9 ? pn * 256 : pn * 256 + 32);
        const bool T = (pn == 5) || (pn == 6) || (pn >= 13);
        if (!T) {
          bf16_t* base; int ld, cofs0; float osc = 1.f;
          if (pn == 3) { base = pg.qB; ld = 256; cofs0 = 0; osc = 0.125f; }
          else if (pn == 4) { base = pg.kB; ld = 256; cofs0 = 0; }
          else if (pn <= 8) { base = pg.rB; ld = 512; cofs0 = (pn - 7) * 256; }
          else if (pn <= 10) { base = pg.qC; ld = 512; cofs0 = (pn - 9) * 256; osc = QSCALE; }
          else { base = pg.kC; ld = 512; cofs0 = (pn - 11) * 256; }
          const float4 ba0 = *(const float4*)(bsrc + cbase), ba1 = *(const float4*)(bsrc + cbase + 4);
          const float4 bb0 = *(const float4*)(bsrc + 128 + cbase), bb1 = *(const float4*)(bsrc + 128 + cbase + 4);
          bf16_t* d0 = base + (size_t)pm * 256 * ld + cofs0;
          pg8::for_each_piece(acc, [&](int row, int col, float (&v)[8]) {
            const float4 b0 = col < 128 ? ba0 : bb0, b1 = col < 128 ? ba1 : bb1;
            v[0] = (v[0] + b0.x) * osc; v[1] = (v[1] + b0.y) * osc; v[2] = (v[2] + b0.z) * osc; v[3] = (v[3] + b0.w) * osc;
            v[4] = (v[4] + b1.x) * osc; v[5] = (v[5] + b1.y) * osc; v[6] = (v[6] + b1.z) * osc; v[7] = (v[7] + b1.w) * osc;
            st_nt16(d0 + (size_t)row * ld + col, pack8(v));
          });
        } else {
          bf16_t* tb; int f0;
          if (pn <= 6) { tb = pg.vBT; f0 = (pn - 5) * 256; } else { tb = pg.vCT; f0 = (pn - 13) * 256; }
          const int tok0 = pm * 256;
          int b, pall0;
          if (tok0 < TLAT) { b = tok0 >> 12; pall0 = 256 + (tok0 & 4095); } else { const int ci = tok0 - TLAT; b = ci >> 8; pall0 = ci & 255; }
          bf16_t* d0 = tb + (size_t)(b * 512 + f0) * PALL + pall0;
          const int rbase = 64 * wr + fr;
          float bv[2][4];
#pragma unroll
          for (int ai = 0; ai < 2; ++ai)
#pragma unroll
            for (int m = 0; m < 4; ++m) bv[ai][m] = bsrc[128 * ai + rbase + 16 * m];
#pragma unroll
          for (int ai = 0; ai < 2; ++ai)
#pragma unroll
            for (int m = 0; m < 4; ++m)
#pragma unroll
              for (int bj = 0; bj < 2; ++bj) {
                const pg8::f32x4 x0 = acc[ai][bj][m][0], x1 = acc[ai][bj][m][1];
                const float bb = bv[ai][m];
                float v[8] = {x0[0] + bb, x0[1] + bb, x0[2] + bb, x0[3] + bb, x1[0] + bb, x1[1] + bb, x1[2] + bb, x1[3] + bb};
                st_nt16(d0 + (size_t)(128 * ai + rbase + 16 * m) * PALL + 128 * bj + cbase, pack8(v));
              }
        }
      });
  }
  {
    const int vtid = tid_();
    char* smem = smem_all + half_() * SMEM_BYTES;
    float* sC = (float*)smem;
    const int lane = vtid & 63, w = vtid >> 6, wr = w >> 1, wc = w & 1, r = lane & 31, hh = lane >> 5;
    for (int mt = bid_(); mt < 136; mt += vgrid_()) {
      f32x16 acc[2][1];
      acc[0][0] = zero16();
      acc[1][0] = zero16();
      gemm_mainloop<1>(rows_contig(p.h + (size_t)mt * 128 * D, D), rows_contig(p.wt_in + (size_t)3840 * D, D), 16, acc, smem);
#pragma unroll
      for (int i2 = 0; i2 < 2; ++i2)
#pragma unroll
        for (int g = 0; g < 16; ++g) {
          int row = wr * 64 + i2 * 32 + (g & 3) + 8 * (g >> 2) + 4 * hh, col = wc * 32 + r;
          sC[row * LDC + col] = acc[i2][0][g];
        }
      __syncthreads();
      for (int i2 = vtid; i2 < 128 * 32; i2 += 256) {
        int row = i2 >> 5, col = i2 & 31;
        p.aB[(size_t)(mt * 128 + row) * 32 + col] = sC[row * LDC + col] + p.b_in[layer * NIN_SRC + 2304 + col];
      }
      __syncthreads();
    }
  }
}

__device__ __forceinline__ void merge_tiles(PRef p, int layer, char* smem, int mt0, int nmt) {
  float* sC = (float*)smem;
  const int tid = tid_(), lane = tid & 63, w = tid >> 6, wr = w >> 1, wc = w & 1, r = lane & 31, hh = lane >> 5;
  const float* bias = p.b_in + layer * NIN_SRC + 3872;
  const int nrounds = xcd_rounds(smem, nmt, 16);
  for (int rd = 0; rd < nrounds; ++rd) {
    int mt, nt;
    if (!xcd_tile(smem, rd, nmt, 16, mt, nt)) continue;
    mt += mt0;
    f32x16 tot[2][1];
    tot[0][0] = zero16();
    tot[1][0] = zero16();
#pragma unroll 1
    for (int br = 0; br < 3; ++br) {
      f32x16 acc[2][1];
      acc[0][0] = zero16();
      acc[1][0] = zero16();
      gemm_mainloop<1>(rows_contig(p.h + (size_t)mt * 128 * D, D), rows_contig(p.wt_gate + (size_t)(br * 1024 + nt * 64) * D, D), 16, acc, smem);
      unsigned sg[2][8];
      {
        float bv = bias[br * 1024 + nt * 64 + wc * 32 + r];
#pragma unroll
        for (int i = 0; i < 2; ++i)
#pragma unroll
          for (int g = 0; g < 8; ++g)
            sg[i][g] = pack2(sigmoidf_(acc[i][0][2 * g] + bv), sigmoidf_(acc[i][0][2 * g + 1] + bv));
      }
      acc[0][0] = zero16();
      acc[1][0] = zero16();
      const bf16_t* ob = (br == 0 ? p.oA : (br == 1 ? p.oB : p.oC));
      gemm_mainloop<1>(rows_contig(ob + (size_t)mt * 128 * 512, 512), rows_contig(p.wt_br + ((size_t)br * 1024 + nt * 64) * 512, 512), 8, acc, smem);
#pragma unroll
      for (int i = 0; i < 2; ++i)
#pragma unroll
        for (int g = 0; g < 8; ++g) {
          tot[i][0][2 * g] += bf2f((bf16_t)(sg[i][g] & 0xffff)) * acc[i][0][2 * g];
          tot[i][0][2 * g + 1] += bf2f((bf16_t)(sg[i][g] >> 16)) * acc[i][0][2 * g + 1];
        }
    }
#pragma unroll
    for (int i = 0; i < 2; ++i)
#pragma unroll
      for (int g = 0; g < 16; ++g) {
        int row = wr * 64 + i * 32 + (g & 3) + 8 * (g >> 2) + 4 * hh, col = wc * 32 + r;
        sC[row * LDC + col] = tot[i][0][g];
      }
    __syncthreads();
#pragma unroll 1
    for (int ps = 0; ps < 4; ++ps) {
      int row = ps * 32 + (tid >> 3), c8 = tid & 7;
      float v[8];
      lds_read8(sC + row * LDC + c8 * 8, v);
      *(uint4*)(p.m + (size_t)(mt * 128 + row) * D + nt * 64 + c8 * 8) = pack8(v);
    }
    __syncthreads();
  }
}

__device__ __forceinline__ void merge_epilogue(PRef p, int br, int mt, int nt, const float* sC, int tid) {
  const int c8 = tid & 15, rb = tid >> 4;
#pragma unroll 1
  for (int hb = 0; hb < 2; ++hb) {
    u32x4 gv[4], mv[4];
#pragma unroll
    for (int q = 0; q < 4; ++q) {
      const size_t tok = (size_t)(mt * 128 + (hb * 4 + q) * 16 + rb);
      gv[q] = *(const u32x4*)(p.G + tok * 3072 + br * 1024 + nt * 128 + c8 * 8);
      if (br > 0) mv[q] = *(const u32x4*)(p.m + tok * D + nt * 128 + c8 * 8);
    }
#pragma unroll
    for (int q = 0; q < 4; ++q) {
      const int row = (hb * 4 + q) * 16 + rb;
      float v[8];
      lds_read8(sC + row * LDC + c8 * 8, v);
#pragma unroll
      for (int e2 = 0; e2 < 4; ++e2) {
        v[2 * e2] *= bf2f((bf16_t)(gv[q][e2] & 0xffff));
        v[2 * e2 + 1] *= bf2f((bf16_t)(gv[q][e2] >> 16));
        if (br > 0) { v[2 * e2] += bf2f((bf16_t)(mv[q][e2] & 0xffff)); v[2 * e2 + 1] += bf2f((bf16_t)(mv[q][e2] >> 16)); }
      }
      *(uint4*)(p.m + (size_t)(mt * 128 + row) * D + nt * 128 + c8 * 8) = pack8(v);
    }
  }
}
__device__ __forceinline__ void phase_merge(PRef p, int layer, char* smem_all) {
  LAS3 unsigned char* lds = (LAS3 unsigned char*)smem_all;
  {
    PRef pe = params_view();
    const bf16_t* oA = pe.oA; const bf16_t* oB = pe.oB; const bf16_t* oC = pe.oC;
    const bf16_t* wbr = pe.wt_br;
    const bf16_t* Gp = pe.G;
    bf16_t* mp = pe.m;
    pg8::gemm_stream<true>(lds, 512,
      [&](int ui, pg8::UnitAB& u) {
        const int br = ui % 3;
        int pm, pn;
        if (!pg8::unit_map(pg8::unit_linear(ui / 3), 64, 4, pm, pn)) return false;
        const bf16_t* ob = (br == 0 ? oA : (br == 1 ? oB : oC));
        u.a = (const char*)(ob + (size_t)pm * 256 * 512);
        u.b = (const char*)(wbr + ((size_t)br * 1024 + pn * 256) * 512);
        return true;
      },
      [&](int ui, const pg8::f32x4 (&acc)[2][2][4][2]) {
        const int br = ui % 3;
        int pm, pn;
        pg8::unit_map(pg8::unit_linear(ui / 3), 64, 4, pm, pn);
        const bf16_t* gsrc = Gp + (size_t)pm * 256 * 3072 + br * 1024 + pn * 256;
        bf16_t* mdst = mp + (size_t)pm * 256 * D + pn * 256;
        const bool rmw = br > 0;
        int lt = __builtin_amdgcn_workitem_id_x();
        asm volatile("" : "+v"(lt));
        const int wid = lt >> 6, lane = lt & 63, wr = wid >> 2, wc = wid & 3, fr = lane & 15, fq = lane >> 4;
#pragma unroll
        for (int ai = 0; ai < 2; ++ai) {
          u32x4 gq[4][2], mq[4][2];
#pragma unroll
          for (int m = 0; m < 4; ++m)
#pragma unroll
            for (int bj = 0; bj < 2; ++bj) {
              const int row = 128 * ai + 64 * wr + 16 * m + fr, col = 128 * bj + 32 * wc + 8 * fq;
              gq[m][bj] = *(const u32x4*)(gsrc + (size_t)row * 3072 + col);
              if (rmw) mq[m][bj] = *(const u32x4*)(mdst + (size_t)row * D + col);
            }
#pragma unroll
          for (int m = 0; m < 4; ++m)
#pragma unroll
            for (int bj = 0; bj < 2; ++bj) {
              const int row = 128 * ai + 64 * wr + 16 * m + fr, col = 128 * bj + 32 * wc + 8 * fq;
              const pg8::f32x4 a = acc[ai][bj][m][0], b = acc[ai][bj][m][1];
              float v[8] = {a[0], a[1], a[2], a[3], b[0], b[1], b[2], b[3]};
              const u32x4 g = gq[m][bj];
#pragma unroll
              for (int e2 = 0; e2 < 4; ++e2) {
                v[2 * e2] *= bf2f((bf16_t)(g[e2] & 0xffff));
                v[2 * e2 + 1] *= bf2f((bf16_t)(g[e2] >> 16));
                if (rmw) { v[2 * e2] += bf2f((bf16_t)(mq[m][bj][e2] & 0xffff)); v[2 * e2 + 1] += bf2f((bf16_t)(mq[m][bj][e2] >> 16)); }
              }
              *(uint4*)(mdst + (size_t)row * D + col) = pack8(v);
            }
        }
      });
  }
  if (layer == 0) merge_tiles(p, layer, smem_all + half_() * SMEM_BYTES, 128, 8);
}

__device__ __forceinline__ void outproj_epilogue(PRef p, int layer, int mt, int nt, const float* sC, int tid) {
  const int tok0 = mt * 128;
  const float* g1 = p.mod + ((size_t)layer * 5 + tok_modrow(tok0)) * NMOD + 2048 + nt * 128;
  const int c8 = tid & 15, rb = tid >> 4;
  const float4 ga = *(const float4*)(g1 + c8 * 8), gb = *(const float4*)(g1 + c8 * 8 + 4);
#pragma unroll 1
  for (int hb = 0; hb < 2; ++hb) {
    float4 x0[4], x1[4];
#pragma unroll
    for (int q = 0; q < 4; ++q) {
      const int tok = tok0 + (hb * 4 + q) * 16 + rb;
      const float* xp;
      if (layer == 0) xp = tok < TLAT ? p.x + (size_t)tok * D : p.ctx + (size_t)(tok - TLAT) * D;
      else xp = p.xres + (size_t)tok * D;
      xp += nt * 128 + c8 * 8;
      x0[q] = *(const float4*)xp; x1[q] = *(const float4*)(xp + 4);
    }
#pragma unroll
    for (int q = 0; q < 4; ++q) {
      const int row = (hb * 4 + q) * 16 + rb;
      float v[8];
      lds_read8(sC + row * LDC + c8 * 8, v);
      float4 o0 = make_float4(ALPHA * x0[q].x + ga.x * v[0], ALPHA * x0[q].y + ga.y * v[1], ALPHA * x0[q].z + ga.z * v[2], ALPHA * x0[q].w + ga.w * v[3]);
      float4 o1 = make_float4(ALPHA * x1[q].x + gb.x * v[4], ALPHA * x1[q].y + gb.y * v[5], ALPHA * x1[q].z + gb.z * v[6], ALPHA * x1[q].w + gb.w * v[7]);
      float* op = p.xres + (size_t)(tok0 + row) * D + nt * 128 + c8 * 8;
      *(float4*)op = o0;
      *(float4*)(op + 4) = o1;
    }
  }
}
__device__ __forceinline__ void phase_outproj(PRef p, int layer, char* smem_all) {
  LAS3 unsigned char* lds = (LAS3 unsigned char*)smem_all;
  unsigned voffA[2];
  pg8::voff_contig(D, voffA);
  for (int i = 0;; ++i) {
    int pm, pn;
    if (!pg8::unit_map(pg8::unit_linear(i), 64, 4, pm, pn)) break;
    pg8::f32x4 acc[2][2][4][2];
    const char* a0 = (const char*)(p.m + (size_t)pm * 256 * D);
    pg8::gemm_unit(lds, a0, a0 + (size_t)128 * D * 2, voffA, voffA, (const char*)(p.wt_out + (size_t)pn * 256 * D), D, acc);
    asm volatile("" : "+s"(pm), "+s"(pn));
    PRef pe = params_view();
    const int etid = tid_();
    const int half = half_();
    float* sCh = (float*)(smem_all + half * SMEM_BYTES);
    pg8::acc_to_lds<0, 0>(acc, false, (float*)smem_all);
    pg8::acc_to_lds<0, 1>(acc, false, (float*)(smem_all + SMEM_BYTES));
    __syncthreads();
    outproj_epilogue(pe, layer, 2 * pm, 2 * pn + half, sCh, etid);
    __syncthreads();
    pg8::acc_to_lds<1, 0>(acc, false, (float*)smem_all);
    pg8::acc_to_lds<1, 1>(acc, false, (float*)(smem_all + SMEM_BYTES));
    __syncthreads();
    outproj_epilogue(pe, layer, 2 * pm + 1, 2 * pn + half, sCh, etid);
    __syncthreads();
  }
  if (layer == 0) {
    char* smem = smem_all + half_() * SMEM_BYTES;
    float* sC = (float*)smem;
    const int tid = tid_();
    for (int item = bid_(); item < 64; item += vgrid_()) {
      const int mt = 128 + (item >> 3), nt = item & 7;
      f32x16 acc[2][2];
#pragma unroll
      for (int i = 0; i < 2; ++i)
#pragma unroll
        for (int j = 0; j < 2; ++j) acc[i][j] = zero16();
      gemm_mainloop<2>(rows_contig(p.m + (size_t)mt * 128 * D, D), rows_contig(p.wt_out + (size_t)nt * 128 * D, D), 16, acc, smem);
      acc_to_lds(acc, sC);
      __syncthreads();
      outproj_epilogue(p, layer, mt, nt, sC, tid);
      __syncthreads();
    }
  }
}

__device__ __forceinline__ bool moe_block_lookup(PRef p, int mb, int& e, int& lb, int& cnt_e) {
  int start = 0;
  for (int i = 0; i < 32; ++i) {
    int c = p.cnt[i];
    int nb = (c + MOE_BLK - 1) / MOE_BLK;
    if (mb < start + nb) { e = i; lb = mb - start; cnt_e = c; return true; }
    start += nb;
  }
  return false;
}
__device__ __forceinline__ void moe1_epilogue(PRef p, int slot0, int nt, const float* sC, int tid) {
#pragma unroll
  for (int ps = 0; ps < 8; ++ps) {
    const int row = ps * 16 + (tid >> 4), c4 = (tid & 15) * 4;
    const float4 a = *(const float4*)(sC + row * LDC + c4);
    const float4 b = *(const float4*)(sC + row * LDC + 64 + c4);
    const uint2 o = make_uint2(pack2(siluf(a.x) * b.x, siluf(a.y) * b.y), pack2(siluf(a.z) * b.z, siluf(a.w) * b.w));
    *(uint2*)(p.act + (size_t)(slot0 + row) * 512 + nt * 64 + c4) = o;
  }
}
__device__ __forceinline__ void moe2_epilogue(PRef p, int slot0, int nt, const float* sC, int tid) {
#pragma unroll
  for (int ps = 0; ps < 8; ++ps) {
    const int row = ps * 16 + (tid >> 4), c8 = tid & 15;
    float v[8];
    lds_read8(sC + row * LDC + c8 * 8, v);
    *(uint4*)(p.ysl + (size_t)(slot0 + row) * D + nt * 128 + c8 * 8) = pack8(v);
  }
}
__device__ __forceinline__ void phase_moe1(PRef p, int layer, char* smem_all) {
  LAS3 unsigned char* lds = (LAS3 unsigned char*)smem_all;
  if (__builtin_amdgcn_workgroup_id_x() == 0 && __builtin_amdgcn_workitem_id_x() == 0) {
    int start = 0;
    for (int i = 0; i < 32; ++i) { p.estart[i] = start; start += (p.cnt[i] + MOE_BLK - 1) / MOE_BLK; }
  }
  for (int i = 0;; ++i) {
    const int L = pg8::unit_linear(i);
    int mb = L >> 2, pn = L & 3;
    if (mb >= MAX_MBLK) break;
    int e, lb, ce;
    if (!moe_block_lookup(p, mb, e, lb, ce)) break;
    unsigned voffA0[2], voffA1[2];
    {
      int tid = __builtin_amdgcn_workitem_id_x();
      asm volatile("" : "+v"(tid));
#pragma unroll
      for (int q = 0; q < 2; ++q) {
        int R, C;
        pg8::stage_rc(tid * 16 + q * 8192, R, C);
        const int s0 = lb * MOE_BLK + R, s1 = s0 + 128;
        const int t0 = s0 < ce ? p.list[e * MOE_CAP + s0] : 0;
        const int t1 = s1 < ce ? p.list[e * MOE_CAP + s1] : 0;
        voffA0[q] = (unsigned)(t0 * D + C) * 2u;
        voffA1[q] = (unsigned)(t1 * D + C) * 2u;
      }
    }
    pg8::f32x4 acc[2][2][4][2];
    pg8::gemm_unit(lds, (const char*)p.h2, (const char*)p.h2, voffA0, voffA1, (const char*)(p.wt_13 + ((size_t)e * 1024 + pn * 256) * D), D, acc);
    asm volatile("" : "+s"(mb), "+s"(pn));
    PRef pe = params_view();
    const int etid = tid_();
    const int half = half_();
    float* sCh = (float*)(smem_all + half * SMEM_BYTES);
    pg8::acc_to_lds<0, 0>(acc, false, (float*)smem_all);
    pg8::acc_to_lds<0, 1>(acc, false, (float*)(smem_all + SMEM_BYTES));
    __syncthreads();
    moe1_epilogue(pe, mb * MOE_BLK, 2 * pn + half, sCh, etid);
    __syncthreads();
    pg8::acc_to_lds<1, 0>(acc, false, (float*)smem_all);
    pg8::acc_to_lds<1, 1>(acc, false, (float*)(smem_all + SMEM_BYTES));
    __syncthreads();
    moe1_epilogue(pe, mb * MOE_BLK + 128, 2 * pn + half, sCh, etid);
    __syncthreads();
  }
}
__device__ __forceinline__ void phase_moe2(PRef p, int layer, char* smem_all) {
  LAS3 unsigned char* lds = (LAS3 unsigned char*)smem_all;
  const bf16_t* actp = p.act;
  const bf16_t* w2p = p.wt_2;
  bf16_t* yp = p.ysl;
  const int* cntp = p.cnt;
  auto lookup = [&](int mb, int& e) {
    int start = 0;
    for (int i = 0; i < 32; ++i) {
      const int nb = (cntp[i] + MOE_BLK - 1) / MOE_BLK;
      if (mb < start + nb) { e = i; return true; }
      start += nb;
    }
    return false;
  };
  pg8::gemm_stream<true>(lds, 512,
    [&](int ui, pg8::UnitAB& u) {
      const int L = pg8::unit_linear(ui);
      const int mb = L >> 2, pn = L & 3;
      int e;
      if (mb >= MAX_MBLK || !lookup(mb, e)) return false;
      u.a = (const char*)(actp + (size_t)mb * MOE_BLK * 512);
      u.b = (const char*)(w2p + ((size_t)e * 1024 + pn * 256) * 512);
      return true;
    },
    [&](int ui, const pg8::f32x4 (&acc)[2][2][4][2]) {
      const int L = pg8::unit_linear(ui);
      const int mb = L >> 2, pn = L & 3;
      bf16_t* ydst = yp + (size_t)mb * MOE_BLK * D + pn * 256;
      pg8::for_each_piece(acc, [&](int row, int col, float (&v)[8]) { st_nt16(ydst + (size_t)row * D + col, pack8(v)); });
    });
}

struct AttnState { f32x16 negm; f32x16 L; };
__device__ __forceinline__ void attn_qk(const char* sK, const bf16x8 (&bq)[4], const f32x16& negm, f32x16 (&S)[2], int r, int hh) {
  const int pr = 16 * (r >> 4) + 8 * ((r >> 2) & 1) + 4 * ((r >> 3) & 1) + (r & 3);
  const char* kp = sK + pr * 128;
#pragma unroll
  for (int s = 0; s < 4; ++s) {
    const int co = ((2 * s + hh) ^ ((pr >> 1) & 7)) << 4;
    bf16x8 a0 = *(const bf16x8*)(kp + co);
    bf16x8 a1 = *(const bf16x8*)(kp + 4096 + co);
    if (s == 0) { S[0] = mfma32(a0, bq[0], negm); S[1] = mfma32(a1, bq[0], negm); }
    else { S[0] = mfma32(a0, bq[s], S[0]); S[1] = mfma32(a1, bq[s], S[1]); }
  }
}
template <class MaskF>
__device__ __forceinline__ float attn_softmax_pv(f32x16 (&S)[2], const char* sV, f32x16 (&O)[2], AttnState& st, bf16x8 ones, int r, int hh,
                                                 MaskF maskf, const bool FIRST) {
  maskf(S);
  float mx = S[0][0];
#pragma unroll
  for (int g = 1; g < 16; ++g) mx = fmaxf(mx, S[0][g]);
#pragma unroll
  for (int g = 0; g < 16; ++g) mx = fmaxf(mx, S[1][g]);
  {
    auto sw = __builtin_amdgcn_permlane32_swap(__float_as_uint(mx), __float_as_uint(mx), false, false);
    mx = fmaxf(__uint_as_float(sw[0]), __uint_as_float(sw[1]));
  }
  float dshift = 0.f;
  if (FIRST || __any(mx > 8.f)) {
    const float d = FIRST ? mx : fmaxf(mx, 0.f);
    dshift = d;
    const float alpha = __builtin_amdgcn_exp2f(-d);
#pragma unroll
    for (int g = 0; g < 16; ++g) {
      st.negm[g] -= d;
      S[0][g] -= d; S[1][g] -= d;
      O[0][g] *= alpha; O[1][g] *= alpha;
    }
    st.L[0] *= alpha;
  }
#pragma unroll
  for (int kb = 0; kb < 2; ++kb)
#pragma unroll
    for (int g = 0; g < 16; ++g) S[kb][g] = __builtin_amdgcn_exp2f(S[kb][g]);
  const char* vp = sV + r * 128;
  const int vsw = (r >> 1) & 7;
#pragma unroll
  for (int sp = 0; sp < 4; ++sp) {
    const int sb_ = sp >> 1, so_ = 8 * (sp & 1);
    u32x4 bpu = {pack2(S[sb_][so_], S[sb_][so_ + 1]), pack2(S[sb_][so_ + 2], S[sb_][so_ + 3]), pack2(S[sb_][so_ + 4], S[sb_][so_ + 5]),
                 pack2(S[sb_][so_ + 6], S[sb_][so_ + 7])};
    bf16x8 bp = __builtin_bit_cast(bf16x8, bpu);
#pragma unroll
    for (int db = 0; db < 2; ++db) {
      bf16x8 av = *(const bf16x8*)(vp + db * 4096 + (((2 * sp + hh) ^ vsw) << 4));
      O[db] = mfma32(av, bp, O[db]);
    }
    st.L = mfma32(ones, bp, st.L);
  }
  return dshift;
}
template <class MaskF>
__device__ __forceinline__ void attn_tile(const char* sK, const char* sV, const bf16x8 (&bq)[4], f32x16 (&O)[2], AttnState& st, bf16x8 ones,
                                          int r, int hh, MaskF maskf, const bool FIRST) {
  f32x16 S[2];
  attn_qk(sK, bq, st.negm, S, r, hh);
  (void)attn_softmax_pv(S, sV, O, st, ones, r, hh, maskf, FIRST);
}
__device__ __forceinline__ void attn_state_init(AttnState& st, bf16x8& ones, int r) {
  st.negm = zero16();
  st.L = zero16();
  const short one = (r == 0) ? (short)0x3F80 : (short)0;
  ones = (bf16x8){one, one, one, one, one, one, one, one};
}

__device__ __forceinline__ void attn_stage(const bf16_t* kg, size_t kstride, const bf16_t* vg, size_t vstride, char* sKd, char* sVd, int tid) {
  const int row = tid >> 3, u = ((tid & 7) ^ ((tid >> 4) & 7)) * 8;
#pragma unroll
  for (int i = 0; i < 2; ++i) {
    __builtin_amdgcn_global_load_lds((const unsigned*)(kg + (size_t)(row + 32 * i) * kstride + u), (LAS3 unsigned*)(sKd + tid * 16 + i * 4096), 16, 0, 0);
    __builtin_amdgcn_global_load_lds((const unsigned*)(vg + (size_t)(row + 32 * i) * vstride + u), (LAS3 unsigned*)(sVd + tid * 16 + i * 4096), 16, 0, 0);
  }
}
struct NoMask { __device__ __forceinline__ void operator()(f32x16 (&)[2]) const {} };

__device__ __forceinline__ void attn_write_out(bf16_t* dst  , const f32x16 (&O)[2], float l, int hh) {
  float lt = l + __shfl_xor(l, 32);
  float inv = 1.f / lt;
#pragma unroll
  for (int db = 0; db < 2; ++db)
#pragma unroll
    for (int g4 = 0; g4 < 4; ++g4) {
      uint2 o = make_uint2(pack2(O[db][4 * g4] * inv, O[db][4 * g4 + 1] * inv), pack2(O[db][4 * g4 + 2] * inv, O[db][4 * g4 + 3] * inv));
      *(uint2*)(dst + 32 * db + 8 * g4 + 4 * hh) = o;
    }
}

__device__ __forceinline__ void phase_attnA(PRef p, int layer, char* smem_all) {
  int tid = __builtin_amdgcn_workitem_id_x();
  asm volatile("" : "+v"(tid));
  const int lane = tid & 63, w8 = tid >> 6, w = w8 & 3, qsub = w8 >> 2, r = lane & 31, hh = lane >> 5;
  char* sK = smem_all;
  char* sV = smem_all + 32768;
  const int nitems = layer == 0 ? 544 : 512;
  const int G = (int)gridDim.x;
  for (int item = (int)__builtin_amdgcn_workgroup_id_x(); item < nitems; item += G) {
    int b, kvh, qtok0, nkt;
    if (item < 512) { b = item >> 7; kvh = (item >> 6) & 1; qtok0 = b * 4096 + (item & 63) * 64 + qsub * 32; nkt = 68; }
    else { int it = item - 512; b = it >> 3; kvh = (it >> 2) & 1; qtok0 = TLAT + b * 256 + (it & 3) * 64 + qsub * 32; nkt = 4; }
    const int head = kvh * 4 + w;
    bf16x8 bq[4];
    {
      const bf16_t* qp = p.qA + (size_t)(qtok0 + r) * 512 + head * 64 + 8 * hh;
#pragma unroll
      for (int s = 0; s < 4; ++s) bq[s] = *(const bf16x8*)(qp + 16 * s);
    }
    const bf16_t* kbase = p.kA + (size_t)(b * 2 + kvh) * PALL * 64;
    const bf16_t* vbase = p.vAT + (size_t)(b * 2 + kvh) * 64 * PALL;
    const int srow = tid >> 3, su = ((tid & 7) ^ ((tid >> 4) & 7)) * 8;
    const bf16_t* kg = kbase + (size_t)srow * 64 + su;
    const bf16_t* vg = vbase + (size_t)srow * PALL + su;
    f32x16 O[2];
    O[0] = zero16();
    O[1] = zero16();
    AttnState st;
    bf16x8 ones;
    attn_state_init(st, ones, r);
    __syncthreads();
#define ATT_STAGE(KT)                                                                                                                     \
  {                                                                                                                                       \
    __builtin_amdgcn_global_load_lds((const unsigned*)(kg + (size_t)(KT) * 4096), (LAS3 unsigned*)(sK + ((KT) & 3) * 8192 + tid * 16), 16, 0, 0); \
    __builtin_amdgcn_global_load_lds((const unsigned*)(vg + (KT) * 64), (LAS3 unsigned*)(sV + ((KT) & 3) * 8192 + tid * 16), 16, 0, 0);           \
  }
    ATT_STAGE(0);
    ATT_STAGE(1);
    dma_sync();
    f32x16 Sa[2], Sb[2];
    attn_qk(sK, bq, st.negm, Sa, r, hh);
#define ATT_STEP(KT, CUR, NXT)                                                                                              \
  {                                                                                                                         \
    if ((KT) > 0) dma_sync();                \
    if ((KT) + 2 < nkt) ATT_STAGE((KT) + 2);                                                                                \
    if ((KT) + 1 < nkt) attn_qk(sK + (((KT) + 1) & 3) * 8192, bq, st.negm, NXT, r, hh);                                     \
    const float d_ = attn_softmax_pv(CUR, sV + ((KT) & 3) * 8192, O, st, ones, r, hh, NoMask(), (KT) == 0);                 \
    if ((KT) + 1 < nkt && __any(d_ != 0.f)) {      \
      _Pragma("unroll") for (int g = 0; g < 16; ++g) { NXT[0][g] -= d_; NXT[1][g] -= d_; }                                  \
    }                                                                                                                       \
  }
    for (int kt = 0; kt < nkt; kt += 2) {
      ATT_STEP(kt, Sa, Sb);
      ATT_STEP(kt + 1, Sb, Sa);
    }
#undef ATT_STEP
#undef ATT_STAGE
    attn_write_out(p.oA + (size_t)(qtok0 + r) * 512 + head * 64, O, st.L[0], hh);
  }
}

struct NaMask {
  const float* bp;
  int cofs;
  bool on;
  __device__ __forceinline__ void operator()(f32x16 (&S)[2]) const {
    if (!on) return;
    f32x16 bv[2];
#pragma unroll
    for (int kb = 0; kb < 2; ++kb)
#pragma unroll
      for (int g = 0; g < 16; ++g) bv[kb][g] = bp[32 * kb + 16 * (g >> 3) + 4 * ((g >> 2) & 1) + (g & 3)];
    asm volatile("" : "+v"(bv[0]), "+v"(bv[1]));
#pragma unroll
    for (int kb = 0; kb < 2; ++kb)
#pragma unroll
      for (int g = 0; g < 16; ++g) {
        const int cc = 32 * kb + 16 * (g >> 3) + 4 * ((g >> 2) & 1) + (g & 3);
        const bool valid = (unsigned)(cc + cofs) < 16u;
        S[kb][g] = valid ? S[kb][g] + bv[kb][g] : -1e30f;
      }
  }
};
__device__ __forceinline__ void phase_na(PRef p, int layer, char* smem) {
  const int tid = tid_(), lane = tid & 63, w = tid >> 6, r = lane & 31, hh = lane >> 5;
  char* sK = smem;
  char* sV = smem + 32768;
  float* sBias = (float*)(smem + 65536);
  const int nitems = layer == 0 ? 1088 : 1024;
  const int set = w >> 1, qhalf = w & 1;
  for (int item = bid_(); item < nitems; item += vgrid_()) {
    int b, hp, row = 0, rs = 0, qtok0, kt0, kt1;
    if (item < 1024) {
      b = item >> 8; row = (item >> 2) & 63; hp = item & 3;
      rs = row - 4; rs = rs < 0 ? 0 : (rs > 56 ? 56 : rs);
      qtok0 = b * 4096 + row * 64; kt0 = 0; kt1 = 12;
    } else {
      int it = item - 1024;
      b = it >> 4; hp = (it >> 2) & 3;
      qtok0 = TLAT + b * 256 + (it & 3) * 64; kt0 = 8; kt1 = 12;
    }
    const int head = 2 * hp + set;
    __syncthreads();
    for (int i = tid; i < 930; i += 256) {
      int s = i / 465, j = i % 465;
      sBias[i] = p.rpb[((size_t)layer * 8 + 2 * hp + s) * 465 + j] * LOG2E;
    }
    bf16x8 bq[4];
    {
      const bf16_t* qp = p.qC + (size_t)(qtok0 + 32 * qhalf + r) * 512 + head * 64 + 8 * hh;
#pragma unroll
      for (int s = 0; s < 4; ++s) bq[s] = *(const bf16x8*)(qp + 16 * s);
    }
    f32x16 O[2];
    O[0] = zero16();
    O[1] = zero16();
    AttnState st;
    bf16x8 ones;
    attn_state_init(st, ones, r);
#define NA_STAGE(KT, BUF)                                                                                          \
  {                                                                                                                \
    int tokK, pallb;                                                                                               \
    if ((KT) < 8) { tokK = b * 4096 + (rs + (KT)) * 64; pallb = 256 + (rs + (KT)) * 64; }                          \
    else { tokK = TLAT + b * 256 + ((KT) - 8) * 64; pallb = ((KT) - 8) * 64; }                                     \
    _Pragma("unroll") for (int s2 = 0; s2 < 2; ++s2)                                                               \
      attn_stage(p.kC + (size_t)tokK * 512 + (2 * hp + s2) * 64, 512, p.vCT + (size_t)(b * 8 + 2 * hp + s2) * 64 * PALL + pallb, PALL, \
                 sK + (BUF) * 16384 + s2 * 8192, sV + (BUF) * 16384 + s2 * 8192, tid);                             \
  }
    NA_STAGE(kt0, 0);
    for (int kt = kt0; kt < kt1; ++kt) {
      const int cur = (kt - kt0) & 1;
      dma_sync();
      if (kt + 1 < kt1) NA_STAGE(kt + 1, cur ^ 1);
      {
        NaMask mk;
        const int wq = 32 * qhalf + r;
        int cs = wq - 8;
        cs = cs < 0 ? 0 : (cs > 48 ? 48 : cs);
        mk.on = kt < 8;
        mk.bp = sBias + set * 465 + (mk.on ? (rs + kt - row + 7) * 31 : 0) - wq + 15 + 8 * hh;
        mk.cofs = 8 * hh - cs;
        attn_tile(sK + cur * 16384 + set * 8192, sV + cur * 16384 + set * 8192, bq, O, st, ones, r, hh, mk, kt == kt0);
      }
    }
#undef NA_STAGE
    attn_write_out(p.oC + (size_t)(qtok0 + 32 * qhalf + r) * 512 + head * 64, O, st.L[0], hh);
  }
}

__device__ __forceinline__ float log_sigmoidf_(float x) { return fminf(x, 0.f) - __logf(1.f + __expf(-fabsf(x))); }
struct GlaPre { f32x4v a0, a1, a2, a3, wg0, wg1; float bg; };
__device__ __forceinline__ void gla_prep_load(PRef p, int layer, int hd, int dir, int tok0, GlaPre& R) {
  const int tid = tid_(), lane = tid & 63, w = tid >> 6, r = lane & 31, hh = lane >> 5, pb = w >> 1, db = w & 1;
  const float* ap = p.aB + (size_t)(tok0 + 32 * pb + r) * 32 + dir * 16;
  R.a0 = *(const f32x4v*)(ap); R.a1 = *(const f32x4v*)(ap + 4); R.a2 = *(const f32x4v*)(ap + 8); R.a3 = *(const f32x4v*)(ap + 12);
  const float* wp = p.gla_wg + (((size_t)layer * 2 + dir) * 16 + hh) * 256 + hd * 64 + 32 * db + r;
  R.wg0 = (f32x4v){wp[0], wp[2 * 256], wp[4 * 256], wp[6 * 256]};
  R.wg1 = (f32x4v){wp[8 * 256], wp[10 * 256], wp[12 * 256], wp[14 * 256]};
  R.bg = p.gla_bg[((size_t)layer * 2 + dir) * 256 + hd * 64 + 32 * db + r];
}
#define GLA_DPP_ADD(v, ctrl, rmask) v += __builtin_bit_cast(float, __builtin_amdgcn_update_dpp(0, __builtin_bit_cast(int, v), ctrl, rmask, 0xf, false))
__device__ __forceinline__ void gla_prep_compute(const GlaPre& R, int dir, float* sBc) {
  const int tid = tid_(), lane = tid & 63, w = tid >> 6, r = lane & 31, hh = lane >> 5, pb = w >> 1, db = w & 1;
  {
    f32x16 x;
#pragma unroll
    for (int g = 0; g < 16; ++g) x[g] = R.bg;
    const float ae[8] = {R.a0[0], R.a0[2], R.a1[0], R.a1[2], R.a2[0], R.a2[2], R.a3[0], R.a3[2]};
    const float ao[8] = {R.a0[1], R.a0[3], R.a1[1], R.a1[3], R.a2[1], R.a2[3], R.a3[1], R.a3[3]};
    const float wv[8] = {R.wg0[0], R.wg0[1], R.wg0[2], R.wg0[3], R.wg1[0], R.wg1[1], R.wg1[2], R.wg1[3]};
#pragma unroll
    for (int s = 0; s < 8; ++s) x = __builtin_amdgcn_mfma_f32_32x32x2f32(hh ? ao[s] : ae[s], wv[s], x, 0, 0, 0);
#pragma unroll
    for (int g = 0; g < 16; ++g) {
      const int pos = 32 * pb + (g & 3) + 8 * (g >> 2) + 4 * hh;
      sBc[pos * 65 + 32 * db + r] = log_sigmoidf_(x[g]) * (1.f / 16.f);
    }
  }
  __syncthreads();
  {
    const int idx = dir ? 63 - lane : lane;
    float v[16];
#pragma unroll
    for (int dd = 0; dd < 16; ++dd) v[dd] = sBc[idx * 65 + w * 16 + dd];
#pragma unroll
    for (int dd = 0; dd < 16; ++dd) GLA_DPP_ADD(v[dd], 0x111, 0xf);
#pragma unroll
    for (int dd = 0; dd < 16; ++dd) GLA_DPP_ADD(v[dd], 0x112, 0xf);
#pragma unroll
    for (int dd = 0; dd < 16; ++dd) GLA_DPP_ADD(v[dd], 0x114, 0xf);
#pragma unroll
    for (int dd = 0; dd < 16; ++dd) GLA_DPP_ADD(v[dd], 0x118, 0xf);
#pragma unroll
    for (int dd = 0; dd < 16; ++dd) GLA_DPP_ADD(v[dd], 0x142, 0xa);
#pragma unroll
    for (int dd = 0; dd < 16; ++dd) GLA_DPP_ADD(v[dd], 0x143, 0xc);
#pragma unroll
    for (int dd = 0; dd < 16; ++dd) sBc[idx * 65 + w * 16 + dd] = v[dd];
  }
  __syncthreads();
}
__device__ __forceinline__ void chunk_pos(int b, int dir, int c, int& tok0, int& pall0) {
  if (c < 4) { int pc = dir ? 3 - c : c; tok0 = TLAT + b * 256 + pc * 64; pall0 = pc * 64; }
  else { int j = c - 4; int pc = dir ? 63 - j : j; tok0 = b * 4096 + pc * 64; pall0 = 256 + pc * 64; }
}
__device__ __forceinline__ void phase_gla1(PRef p, int layer, char* smem) {
  float* sWg = (float*)smem;
  float* sBc = (float*)(smem + 4096);
  bf16_t* sKt = (bf16_t*)(smem + 20736);
  bf16_t* sVt = (bf16_t*)(smem + 29952);
  const int tid = tid_(), lane = tid & 63, w = tid >> 6, r = lane & 31, hh = lane >> 5;
  for (int item = bid_(); item < 32 * NCHUNK; item += vgrid_()) {
    const int ch = item / NCHUNK, c = item % NCHUNK;
    const int dir = ch & 1, hd = (ch >> 1) & 3, b = ch >> 3;
    int tok0, pall0;
    chunk_pos(b, dir, c, tok0, pall0);
    GlaPre R;
    gla_prep_load(p, layer, hd, dir, tok0, R);
    u32x4 k0, k1, vv0, vv1, vv2, vv3;
    {
      const int pos = tid >> 2, dg = tid & 3;
      const bf16_t* kp = p.kB + (size_t)(tok0 + pos) * 256 + hd * 64 + dg * 16;
      k0 = *(const u32x4*)kp; k1 = *(const u32x4*)(kp + 8);
      const bf16_t* vb = p.vBT + (size_t)(b * 4 + hd) * 128 * PALL + pall0 + (tid & 7) * 8;
      vv0 = *(const u32x4*)(vb + (size_t)(tid >> 3) * PALL);
      vv1 = *(const u32x4*)(vb + (size_t)((tid >> 3) + 32) * PALL);
      vv2 = *(const u32x4*)(vb + (size_t)((tid >> 3) + 64) * PALL);
      vv3 = *(const u32x4*)(vb + (size_t)((tid >> 3) + 96) * PALL);
    }
    __syncthreads();
    gla_prep_compute(R, dir, sBc);
    {
      const int pos = tid >> 2, dg = tid & 3;
      float* bd = p.bcum + (size_t)item * 4096 + pos * 64 + dg * 16;
#pragma unroll
      for (int q4 = 0; q4 < 4; ++q4)
        *(float4*)(bd + 4 * q4) = make_float4(sBc[pos * 65 + dg * 16 + 4 * q4], sBc[pos * 65 + dg * 16 + 4 * q4 + 1], sBc[pos * 65 + dg * 16 + 4 * q4 + 2], sBc[pos * 65 + dg * 16 + 4 * q4 + 3]);
    }
    {
      int pos = tid >> 2, dg = tid & 3;
      unsigned ku[8] = {k0[0], k0[1], k0[2], k0[3], k1[0], k1[1], k1[2], k1[3]};
#pragma unroll
      for (int e = 0; e < 16; ++e) {
        int d = dg * 16 + e;
        float kv = bf2f((bf16_t)((e & 1) ? (ku[e >> 1] >> 16) : (ku[e >> 1] & 0xffff)));
        float bend = sBc[(dir ? 0 : 63) * 65 + d];
        sKt[d * 72 + pos] = f2bf(kv * __expf(bend - sBc[pos * 65 + d]));
      }
      {
        const int dv = tid >> 3, cc = tid & 7;
        *(u32x4*)(sVt + dv * 72 + cc * 8) = vv0;
        *(u32x4*)(sVt + (dv + 32) * 72 + cc * 8) = vv1;
        *(u32x4*)(sVt + (dv + 64) * 72 + cc * 8) = vv2;
        *(u32x4*)(sVt + (dv + 96) * 72 + cc * 8) = vv3;
      }
      if (tid < 64) p.decay[(size_t)item * 64 + tid] = __expf(sBc[(dir ? 0 : 63) * 65 + tid]);
    }
    __syncthreads();
    f32x16 acc[2];
    acc[0] = zero16();
    acc[1] = zero16();
#pragma unroll
    for (int s = 0; s < 4; ++s) {
      bf16x8 a = *(const bf16x8*)(sVt + (32 * w + r) * 72 + 16 * s + 8 * hh);
      bf16x8 b0 = *(const bf16x8*)(sKt + r * 72 + 16 * s + 8 * hh);
      bf16x8 b1 = *(const bf16x8*)(sKt + (32 + r) * 72 + 16 * s + 8 * hh);
      acc[0] = mfma32(b0, a, acc[0]);
      acc[1] = mfma32(b1, a, acc[1]);
    }
    float* dst = p.KVt + (size_t)item * 8192 + (32 * w + r) * 64 + 4 * hh;
#pragma unroll
    for (int jb = 0; jb < 2; ++jb)
#pragma unroll
      for (int g4 = 0; g4 < 4; ++g4)
        *(float4*)(dst + 32 * jb + 8 * g4) = make_float4(acc[jb][4 * g4], acc[jb][4 * g4 + 1], acc[jb][4 * g4 + 2], acc[jb][4 * g4 + 3]);
  }
}
__device__ __forceinline__ void phase_gla2(PRef p) {
  for (int idx = bid_() * 256 + tid_(); idx < 32 * 8192; idx += vgrid_() * 256) {
    const int ch = idx >> 13, e = idx & 8191;
    float S = 0.f;
    const float* kv = p.KVt + (size_t)ch * NCHUNK * 8192 + e;
    const float* dc = p.decay + (size_t)ch * NCHUNK * 64 + (e & 63);
    bf16_t* sp = p.SP + (size_t)ch * NCHUNK * 8192 + e;
#pragma unroll 4
    for (int c = 0; c < NCHUNK; ++c) {
      sp[(size_t)c * 8192] = f2bf(S);
      S = dc[c * 64] * S + kv[(size_t)c * 8192];
    }
  }
}
__device__ __forceinline__ void phase_gla3(PRef p, int layer, char* smem) {
  float* sWg = (float*)smem;
  float* sBc = (float*)(smem + 4096);
  bf16_t* sQ = (bf16_t*)(smem + 20736);
  bf16_t* sK = (bf16_t*)(smem + 29952);
  bf16_t* sVt = (bf16_t*)(smem + 39168);
  float* sRed = (float*)(smem + 57600);
  const int tid = tid_(), lane = tid & 63, w = tid >> 6, r = lane & 31, hh = lane >> 5;
  const int npc = layer == 0 ? 68 : 64;
  const int pr = 16 * (r >> 4) + 8 * ((r >> 2) & 1) + 4 * ((r >> 3) & 1) + (r & 3);
  for (int item = bid_(); item < 16 * npc; item += vgrid_()) {
    const int bh = item / npc;
    const int pca = (layer == 0) ? (item % npc) : (4 + item % npc);
    const int b = bh >> 2, hd = bh & 3;
    int tok0, pall0;
    chunk_pos(b, 0, pca, tok0, pall0);
    f32x16 O[2];
    O[0] = zero16();
    O[1] = zero16();
    const int c0 = pca, c1 = (pca < 4) ? 3 - pca : 4 + (63 - (pca - 4));
    f32x4v bA[4], bB[4];
    u32x4 q0, q1, k0, k1, vv0, vv1, vv2, vv3;
    {
      const int pos = tid >> 2, dg = tid & 3;
      const float* b0p = p.bcum + ((size_t)((b * 4 + hd) * 2 + 0) * NCHUNK + c0) * 4096 + pos * 64 + dg * 16;
      const float* b1p = p.bcum + ((size_t)((b * 4 + hd) * 2 + 1) * NCHUNK + c1) * 4096 + pos * 64 + dg * 16;
#pragma unroll
      for (int q4 = 0; q4 < 4; ++q4) { bA[q4] = *(const f32x4v*)(b0p + 4 * q4); bB[q4] = *(const f32x4v*)(b1p + 4 * q4); }
      const bf16_t* qp = p.qB + (size_t)(tok0 + pos) * 256 + hd * 64 + dg * 16;
      const bf16_t* kp = p.kB + (size_t)(tok0 + pos) * 256 + hd * 64 + dg * 16;
      q0 = *(const u32x4*)qp; q1 = *(const u32x4*)(qp + 8);
      k0 = *(const u32x4*)kp; k1 = *(const u32x4*)(kp + 8);
      const bf16_t* vb = p.vBT + (size_t)(b * 4 + hd) * 128 * PALL + pall0 + (tid & 7) * 8;
      vv0 = *(const u32x4*)(vb + (size_t)(tid >> 3) * PALL);
      vv1 = *(const u32x4*)(vb + (size_t)((tid >> 3) + 32) * PALL);
      vv2 = *(const u32x4*)(vb + (size_t)((tid >> 3) + 64) * PALL);
      vv3 = *(const u32x4*)(vb + (size_t)((tid >> 3) + 96) * PALL);
    }
    __syncthreads();
    {
      const int dv = tid >> 3, cc = tid & 7;
      *(u32x4*)(sVt + dv * 72 + cc * 8) = vv0;
      *(u32x4*)(sVt + (dv + 32) * 72 + cc * 8) = vv1;
      *(u32x4*)(sVt + (dv + 64) * 72 + cc * 8) = vv2;
      *(u32x4*)(sVt + (dv + 96) * 72 + cc * 8) = vv3;
    }
#pragma unroll
    for (int dir = 0; dir < 2; ++dir) {
      if (dir == 1) __syncthreads();
      {
        int pos = tid >> 2, dg = tid & 3;
        unsigned qu[8] = {q0[0], q0[1], q0[2], q0[3], q1[0], q1[1], q1[2], q1[3]};
        unsigned ku[8] = {k0[0], k0[1], k0[2], k0[3], k1[0], k1[1], k1[2], k1[3]};
        unsigned qo[8], ko[8];
#pragma unroll
        for (int e2 = 0; e2 < 8; ++e2) {
          const float b0 = dir ? bB[e2 >> 1][(2 * e2) & 3] : bA[e2 >> 1][(2 * e2) & 3];
          const float b1 = dir ? bB[e2 >> 1][(2 * e2 + 1) & 3] : bA[e2 >> 1][(2 * e2 + 1) & 3];
          const float ea0 = __expf(b0), ea1 = __expf(b1), ia0 = __builtin_amdgcn_rcpf(ea0), ia1 = __builtin_amdgcn_rcpf(ea1);
          qo[e2] = pack2(bf2f((bf16_t)(qu[e2] & 0xffff)) * ea0, bf2f((bf16_t)(qu[e2] >> 16)) * ea1);
          ko[e2] = pack2(bf2f((bf16_t)(ku[e2] & 0xffff)) * ia0, bf2f((bf16_t)(ku[e2] >> 16)) * ia1);
        }
        *(uint4*)(sQ + pos * 72 + dg * 16) = make_uint4(qo[0], qo[1], qo[2], qo[3]);
        *(uint4*)(sQ + pos * 72 + dg * 16 + 8) = make_uint4(qo[4], qo[5], qo[6], qo[7]);
        *(uint4*)(sK + pos * 72 + dg * 16) = make_uint4(ko[0], ko[1], ko[2], ko[3]);
        *(uint4*)(sK + pos * 72 + dg * 16 + 8) = make_uint4(ko[4], ko[5], ko[6], ko[7]);
      }
      __syncthreads();
      const int c = dir ? c1 : c0;
      const int ch = (b * 4 + hd) * 2 + dir;
      const bf16_t* sp = p.SP + ((size_t)ch * NCHUNK + c) * 8192 + (size_t)(32 * w + r) * 64 + 8 * hh;
      bf16x8 bqf[2][4];
#pragma unroll
      for (int tb = 0; tb < 2; ++tb)
#pragma unroll
        for (int ks = 0; ks < 4; ++ks) bqf[tb][ks] = *(const bf16x8*)(sQ + (32 * tb + r) * 72 + 16 * ks + 8 * hh);
#pragma unroll
      for (int ks = 0; ks < 4; ++ks) {
        bf16x8 a = *(const bf16x8*)(sp + 16 * ks);
        O[0] = mfma32(a, bqf[0][ks], O[0]);
        O[1] = mfma32(a, bqf[1][ks], O[1]);
      }
#pragma unroll
      for (int sb = 0; sb < 2; ++sb)
#pragma unroll
        for (int tb = 0; tb < 2; ++tb) {
          const bool skip = dir == 0 ? (sb == 1 && tb == 0) : (sb == 0 && tb == 1);
          if (skip) continue;
          f32x16 Sc = zero16();
#pragma unroll
          for (int ks = 0; ks < 4; ++ks) {
            bf16x8 a = *(const bf16x8*)(sK + (32 * sb + pr) * 72 + 16 * ks + 8 * hh);
            Sc = mfma32(a, bqf[tb][ks], Sc);
          }
          const int t = 32 * tb + r;
#pragma unroll
          for (int g = 0; g < 16; ++g) {
            int s = 32 * sb + 16 * (g >> 3) + 4 * ((g >> 2) & 1) + (g & 3) + 8 * hh;
            bool keep = dir == 0 ? (t >= s) : (s >= t);
            Sc[g] = keep ? Sc[g] : 0.f;
          }
#pragma unroll
          for (int s2 = 0; s2 < 2; ++s2) {
            const int sp4 = 2 * sb + s2;
            u32x4 bpu = {pack2(Sc[8 * s2], Sc[8 * s2 + 1]), pack2(Sc[8 * s2 + 2], Sc[8 * s2 + 3]), pack2(Sc[8 * s2 + 4], Sc[8 * s2 + 5]),
                         pack2(Sc[8 * s2 + 6], Sc[8 * s2 + 7])};
            bf16x8 bp = __builtin_bit_cast(bf16x8, bpu);
            bf16x8 av = *(const bf16x8*)(sVt + (32 * w + r) * 72 + 16 * sp4 + 8 * hh);
            O[tb] = mfma32(av, bp, O[tb]);
          }
        }
    }
    float ss[2];
#pragma unroll
    for (int tb = 0; tb < 2; ++tb) {
      float s = 0.f;
#pragma unroll
      for (int g = 0; g < 16; ++g) s += O[tb][g] * O[tb][g];
      s += __shfl_xor(s, 32);
      ss[tb] = s;
    }
    if (hh == 0) { sRed[w * 64 + r] = ss[0]; sRed[w * 64 + 32 + r] = ss[1]; }
    __syncthreads();
    f32x4v gnv[4];
#pragma unroll
    for (int g4 = 0; g4 < 4; ++g4) gnv[g4] = *(const f32x4v*)(p.gla_norm + layer * 128 + 32 * w + 8 * g4 + 4 * hh);
#pragma unroll
    for (int tb = 0; tb < 2; ++tb) {
      int t = 32 * tb + r;
      float tot = sRed[t] + sRed[64 + t] + sRed[128 + t] + sRed[192 + t];
      float rstd = rsqrtf(tot * (1.f / 128.f) + 1e-6f);
      const int tok = tok0 + t;
#pragma unroll
      for (int g4 = 0; g4 < 4; ++g4) {
        int dv = 32 * w + 8 * g4 + 4 * hh;
        uint2 rr = *(const uint2*)(p.rB + (size_t)tok * 512 + hd * 128 + dv);
        float rg[4] = {bf2f((bf16_t)(rr.x & 0xffff)), bf2f((bf16_t)(rr.x >> 16)), bf2f((bf16_t)(rr.y & 0xffff)), bf2f((bf16_t)(rr.y >> 16))};
        float o[4];
#pragma unroll
        for (int e = 0; e < 4; ++e) o[e] = O[tb][4 * g4 + e] * rstd * gnv[g4][e] * siluf(rg[e]);
        *(uint2*)(p.oB + (size_t)tok * 512 + hd * 128 + dv) = make_uint2(pack2(o[0], o[1]), pack2(o[2], o[3]));
      }
    }
  }
}

#define PHASE_KERNEL(name, call)                                               \
  __global__ void __launch_bounds__(512, 2) name(Params p_, int layer) {       \
    __shared__ __attribute__((aligned(16))) char smem_all[2 * SMEM_BYTES];     \
    char* smem = smem_all + half_() * SMEM_BYTES;                              \
    PRef p = params_view();                                           \
    call;                                                                      \
  }
PHASE_KERNEL(k_setup, phase_setup(p, smem))
PHASE_KERNEL(k_modreduce, phase_modreduce(p))
PHASE_KERNEL(k_convert, phase_convert(p, layer, smem))
PHASE_KERNEL(k_rowpass0, phase_rowpass0(p))
PHASE_KERNEL(k_inproj, phase_inproj(p, layer, smem_all))
PHASE_KERNEL(k_attnA, phase_attnA(p, layer, smem_all))
PHASE_KERNEL(k_na, phase_na(p, layer, smem))
PHASE_KERNEL(k_gla1, phase_gla1(p, layer, smem))
PHASE_KERNEL(k_gla2, phase_gla2(p))
PHASE_KERNEL(k_gla3, phase_gla3(p, layer, smem))
PHASE_KERNEL(k_merge, phase_merge(p, layer, smem_all))
PHASE_KERNEL(k_outproj, phase_outproj(p, layer, smem_all))
PHASE_KERNEL(k_rowpass1, phase_rowpass1(p, layer, smem))
PHASE_KERNEL(k_moescan, phase_moescan(p, layer, smem))
PHASE_KERNEL(k_moe1, phase_moe1(p, layer, smem_all))
PHASE_KERNEL(k_moe2, phase_moe2(p, layer, smem_all))
PHASE_KERNEL(k_rowpass2, phase_rowpass2(p, layer))

#define XB_TMO      128
#define XB_XCNT(j)  (256  + 64 * (j))
#define XB_XSUB(j)  (1280 + 64 * (j))
#define XB_XGEN(j)  (2304 + 64 * (j))
#define XB_TOP      3328
#define XB_TOPGEN   3392
#define XCD_BAR_WORDS 3456
#define XB_SPIN_CAP (1u << 23)
#define LAS __attribute__((address_space(3)))
__device__ __forceinline__ unsigned xb_ld(unsigned* p) { return __hip_atomic_load(p, __ATOMIC_RELAXED, __HIP_MEMORY_SCOPE_AGENT); }
__device__ __forceinline__ unsigned xb_add(unsigned* p, unsigned v) { return __hip_atomic_fetch_add(p, v, __ATOMIC_RELAXED, __HIP_MEMORY_SCOPE_AGENT); }
__device__ __forceinline__ unsigned xb_xcc_id() { return (unsigned)__builtin_amdgcn_s_getreg((3 << 11) | 20) & 0xFu; }
#define XB_SPIN(cond, bar) do { unsigned _sp = 0; while (cond) { __builtin_amdgcn_s_sleep(1); \
    if ((++_sp & 255u) == 0u) { if (xb_ld(&(bar)[XB_TMO])) break; if (_sp > XB_SPIN_CAP) { atomicAdd(&(bar)[XB_TMO], 1u); break; } } } } while (0)
struct XcdBarrier { unsigned* bar; unsigned x; volatile LAS unsigned* st; };
__device__ __forceinline__ XcdBarrier xcd_barrier_post(unsigned* bar, volatile LAS unsigned* st) {
  XcdBarrier b; b.bar = bar; b.x = xb_xcc_id(); b.st = st;
  if (__builtin_amdgcn_workitem_id_x() == 0) (void)xb_add(&bar[XB_XCNT(b.x)], 1u);
  return b;
}
__device__ __forceinline__ void xcd_barrier_complete(unsigned* bar, unsigned x, unsigned& nloc, unsigned& nx) {
  const unsigned G = gridDim.x * gridDim.y * gridDim.z;
  unsigned sum, cnt, mine, sp = 0u;
  for (;;) {
    sum = 0u; cnt = 0u; mine = 0u;
#pragma unroll
    for (unsigned j = 0; j < 16; ++j) { const unsigned c = xb_ld(&bar[XB_XCNT(j)]); sum += c; cnt += (c > 0u) ? 1u : 0u; mine = (j == x) ? c : mine; }
    if (sum == G) break;
    __builtin_amdgcn_s_sleep(1);
    if ((++sp & 255u) == 0u) { if (xb_ld(&bar[XB_TMO])) break; if (sp > XB_SPIN_CAP) { atomicAdd(&bar[XB_TMO], 1u); break; } }
  }
  nloc = mine > 0u ? mine : 1u; nx = cnt > 0u ? cnt : 1u;
}
__device__ __forceinline__ void xcd_barrier(const XcdBarrier& b) {
  asm volatile("s_waitcnt vmcnt(0)" ::: "memory");
  __syncthreads();
  if (__builtin_amdgcn_workitem_id_x() == 0) {
    unsigned* bar = b.bar;
    __builtin_amdgcn_s_waitcnt(0);
    unsigned nloc = b.st[0], nx = b.st[1];
    if (nloc == 0u) { xcd_barrier_complete(bar, b.x, nloc, nx); b.st[0] = nloc; b.st[1] = nx; }
    const unsigned old = xb_add(&bar[XB_XSUB(b.x)], 1u);
    const unsigned gen = old / nloc;
    if (old + 1u == (gen + 1u) * nloc) {
      __builtin_amdgcn_fence(__ATOMIC_RELEASE, "agent");
      asm volatile("s_waitcnt vmcnt(0)" ::: "memory");
      const unsigned og = xb_add(&bar[XB_TOP], 1u);
      const unsigned tg = og / nx;
      if (og + 1u == (tg + 1u) * nx) xb_add(&bar[XB_TOPGEN], 1u);
      else XB_SPIN(xb_ld(&bar[XB_TOPGEN]) == tg, bar);
      __builtin_amdgcn_fence(__ATOMIC_ACQUIRE, "agent");
      xb_add(&bar[XB_XGEN(b.x)], 1u);
      asm volatile("s_waitcnt vmcnt(0)" ::: "memory");
    } else {
      XB_SPIN(xb_ld(&bar[XB_XGEN(b.x)]) == gen, bar);
      __builtin_amdgcn_fence(__ATOMIC_ACQUIRE, "agent");
      asm volatile("s_waitcnt vmcnt(0)" ::: "memory");
    }
  }
  __syncthreads();
}

__global__ void __launch_bounds__(512, 2) k_mega(Params p_) {
  __shared__ __attribute__((aligned(16))) char smem_all[2 * SMEM_BYTES + 16];
  volatile LAS unsigned* st = (volatile LAS unsigned*)(smem_all + 2 * SMEM_BYTES);
  if (__builtin_amdgcn_workitem_id_x() == 0) { st[0] = 0u; st[1] = 0u; }
  __syncthreads();
  const XcdBarrier xb = xcd_barrier_post(p_.bar, st);
#pragma unroll 1
  for (int ph = 0; ph < 25; ++ph) {
    int l = (ph >= 14) ? 1 : 0;
    int q = (ph < 3) ? ph : 3 + (ph - 3) % 11;
    l = __builtin_amdgcn_readfirstlane(l);
    q = __builtin_amdgcn_readfirstlane(q);
#ifdef PROBE_MASK
    const unsigned long long pt0 = __builtin_amdgcn_s_memrealtime();
#endif
    PRef p = params_view();
    char* smem = smem_all + half_() * SMEM_BYTES;
    switch (q) {
      case 0: phase_setup(p, smem); phase_convert(p, 0, smem); break;
      case 1: phase_modreduce(p); break;
      case 2: phase_rowpass0(p); break;
      case 3: phase_inproj(p, l, smem_all); break;
      case 4: phase_gla1(p, l, smem); phase_na(p, l, smem); break;
      case 5: phase_gla2(p); phase_attnA(p, l, smem_all); break;
      case 6: phase_gla3(p, l, smem); break;
      case 7: phase_merge(p, l, smem_all); break;
      case 8: phase_outproj(p, l, smem_all); break;
      case 9: phase_rowpass1(p, l, smem); break;
      case 10: phase_moescan(p, l, smem); phase_convert(p, l | 16, smem); break;
      case 11: phase_moe1(p, l, smem_all); break;
      case 12: phase_moe2(p, l, smem_all); break;
      default: phase_rowpass2(p, l); if (l == 0) phase_convert(p, 1, smem); break;
    }
    if (ph != 24) xcd_barrier(xb);
#ifdef PROBE_MASK
    if ((PROBE_MASK >> q) & 1) {
      const unsigned long long pt1 = __builtin_amdgcn_s_memrealtime();
      while (__builtin_amdgcn_s_memrealtime() - pt1 < (pt1 - pt0)) __builtin_amdgcn_s_sleep(8);
    }
#endif
  }
}

#ifdef DIAG_STAGE
__device__ __forceinline__ unsigned dhash(unsigned s) { s ^= s >> 16; s *= 0x7feb352dU; s ^= s >> 15; s *= 0x846ca68bU; s ^= s >> 16; return s; }
__device__ __forceinline__ void diag_accum(double num, double den, double* accum, double* sred) {
  const int tid = threadIdx.x;
  __syncthreads();
  sred[tid] = num; sred[256 + tid] = den;
  __syncthreads();
  for (int o = 128; o > 0; o >>= 1) { if (tid < o) { sred[tid] += sred[tid + o]; sred[256 + tid] += sred[256 + tid + o]; } __syncthreads(); }
  if (tid == 0) { atomicAdd(&accum[0], sred[0]); atomicAdd(&accum[1], sred[256]); }
}
__device__ __forceinline__ int diag_tok(int s, int ns) {
  if (s < 8) return TLAT + (dhash(s + 77) % TCTX);
  if (s == 8) return 0; if (s == 9) return TLAT - 1; if (s == 10) return 4095; if (s == 11) return 4096;
  return dhash(s * 31 + 5) % TLAT;
}
__global__ void k_diag_zero(double* accum) { if (threadIdx.x < 32) accum[threadIdx.x] = 0.0; }
__global__ void k_diag_report(const double* accum, float* out, int n) {
  int i = blockIdx.x * 256 + threadIdx.x;
  for (; i < n; i += gridDim.x * 256) out[i] = 0.f;
  if (blockIdx.x == 0 && threadIdx.x == 0) {
    double E = 0.0;
    for (int k = 0; k < 16; ++k) {
      if (accum[2 * k + 1] > 0.0) { double e = accum[2 * k] / accum[2 * k + 1]; if (!(e == e)) e = 100.0; if (e > E) E = e; }
    }
    out[0] = (float)(4.096e7 * sqrt(E));
  }
}
__global__ void __launch_bounds__(256) k_chk_h(Params p, double* accum) {
  __shared__ double sred[512];
  __shared__ float sx[1024];
  const int tid = threadIdx.x;
  int tok = diag_tok(blockIdx.x, gridDim.x);
  const float* src = tok < TLAT ? p.x + (size_t)tok * D : p.ctx + (size_t)(tok - TLAT) * D;
  const float* cv = tok < TLAT ? p.c + (tok >> 12) * 1024 : p.c_ctx;
  double s = 0, q = 0;
  for (int i = 0; i < 1024; ++i) s += src[i];
  double mean = s / 1024;
  for (int i = 0; i < 1024; ++i) { double d = src[i] - mean; q += d * d; }
  double rstd = 1.0 / sqrt(q / 1024 + 1e-6);
  double num = 0, den = 0;
  for (int n = tid; n < 1024; n += 256) {
    double sh = p.b_mod[n], sc = p.b_mod[1024 + n];
    for (int k = 0; k < 1024; ++k) {
      double cc = cv[k]; double sl = cc / (1.0 + exp(-cc));
      sh += sl * p.w_mod[(size_t)k * NMOD + n];
      sc += sl * p.w_mod[(size_t)k * NMOD + 1024 + n];
    }
    double ref = (src[n] - mean) * rstd * (1.0 + sc) + sh;
    double got = bf2f(p.h[(size_t)tok * D + n]);
    num += (got - ref) * (got - ref); den += ref * ref;
  }
  diag_accum(num, den, accum, sred);
}
__global__ void __launch_bounds__(256) k_chk_inproj(Params p, int layer, double* accum) {
  __shared__ double sred[512];
  __shared__ float sz[3872];
  __shared__ float sh[1024];
  const int tid = threadIdx.x;
  int tok = diag_tok(blockIdx.x, gridDim.x);
  for (int i = tid; i < 1024; i += 256) sh[i] = bf2f(p.h[(size_t)tok * D + i]);
  __syncthreads();
  const float* W = p.w_in + (size_t)layer * 1024 * NIN_SRC;
  for (int j = tid; j < 3872; j += 256) {
    double a = p.b_in[layer * NIN_SRC + j];
    for (int k = 0; k < 1024; ++k) a += (double)sh[k] * W[(size_t)k * NIN_SRC + j];
    sz[j] = (float)a;
  }
  __syncthreads();
  const bool lat = tok < TLAT;
  int b, t, pall;
  if (lat) { b = tok >> 12; t = tok & 4095; pall = 256 + t; } else { int ci = tok - TLAT; b = ci >> 8; t = ci & 255; pall = t; }
  double num = 0, den = 0;
  for (int j = tid; j < 3872; j += 256) {
    double ref, got;
    if (j < 640) {
      int hb = (j >> 6) << 6, d = j & 63;
      double ss = 0;
      for (int e = 0; e < 64; ++e) ss += (double)sz[hb + e] * sz[hb + e];
      double rstd = 1.0 / sqrt(ss / 64 + 1e-6);
      const float* gn = (j < 512 ? p.q_norm : p.k_norm) + layer * 64;
      double xn = sz[j] * rstd * gn[d];
      if (lat) {
        int qd = d >> 4, f = d & 15;
        int dp = d ^ 16;
        double pn = sz[hb + dp] * rstd * gn[dp];
        double pos = (qd < 2) ? (double)(t >> 6) : (double)(t & 63);
        float inv = powf(10000.f, -(float)f / 16.f);
        float ang = (float)pos * inv;
        double cs = cos((double)ang), sn = sin((double)ang);
        double rot = (qd & 1) ? pn : -pn;
        xn = xn * cs + rot * sn;
      }
      if (j < 512) { ref = xn * QSCALE; got = bf2f(p.qA[(size_t)tok * 512 + j]); }
      else { int kvh = (j - 512) >> 6; ref = xn; got = bf2f(p.kA[((size_t)(b * 2 + kvh) * PALL + pall) * 64 + d]); }
    } else if (j < 768) { int c = j - 640; ref = sz[j]; got = bf2f(p.vAT[((size_t)(b * 2 + (c >> 6)) * 64 + (c & 63)) * PALL + pall]); }
    else if (j < 1024) { ref = sz[j] * 0.125; got = bf2f(p.qB[(size_t)tok * 256 + (j - 768)]); }
    else if (j < 1280) { ref = sz[j]; got = bf2f(p.kB[(size_t)tok * 256 + (j - 1024)]); }
    else if (j < 1792) { int c = j - 1280; ref = sz[j]; got = bf2f(p.vBT[((size_t)(b * 4 + (c >> 7)) * 128 + (c & 127)) * PALL + pall]); }
    else if (j < 2304) { ref = sz[j]; got = bf2f(p.rB[(size_t)tok * 512 + (j - 1792)]); }
    else if (j < 2336) { ref = sz[j]; got = p.aB[(size_t)tok * 32 + (j - 2304)]; }
    else if (j < 2848) { ref = sz[j] * QSCALE; got = bf2f(p.qC[(size_t)tok * 512 + (j - 2336)]); }
    else if (j < 3360) { ref = sz[j]; got = bf2f(p.kC[(size_t)tok * 512 + (j - 2848)]); }
    else { int c = j - 3360; ref = sz[j]; got = bf2f(p.vCT[((size_t)(b * 8 + (c >> 6)) * 64 + (c & 63)) * PALL + pall]); }
    num += (got - ref) * (got - ref); den += ref * ref;
  }
  diag_accum(num, den, accum, sred);
}
__global__ void __launch_bounds__(256) k_chk_attnA(Params p, int layer, double* accum) {
  __shared__ double sred[512];
  __shared__ float sp[4352];
  __shared__ float sq[64];
  __shared__ float so[64];
  const int tid = threadIdx.x;
  int tok = diag_tok(blockIdx.x >> 1, gridDim.x);
  if (layer == 1 && tok >= TLAT) tok = dhash(blockIdx.x) % TLAT;
  int head = dhash(blockIdx.x * 7 + 1) & 7, kvh = head >> 2;
  const bool lat = tok < TLAT;
  int b = lat ? tok >> 12 : (tok - TLAT) >> 8;
  int nk = lat ? PALL : 256;
  if (tid < 64) sq[tid] = bf2f(p.qA[(size_t)tok * 512 + head * 64 + tid]);
  __syncthreads();
  const bf16_t* kb = p.kA + (size_t)(b * 2 + kvh) * PALL * 64;
#pragma unroll 1
  for (int j = tid; j < nk; j += 256) {
    float s = 0.f;
#pragma unroll 1
    for (int d = 0; d < 64; ++d) s += sq[d] * bf2f(kb[(size_t)j * 64 + d]);
    sp[j] = s;
  }
  __syncthreads();
  float mx = -1e30f;
#pragma unroll 1
  for (int j = 0; j < nk; ++j) mx = fmaxf(mx, sp[j]);
  __syncthreads();
  for (int j = tid; j < nk; j += 256) sp[j] = exp2f(sp[j] - mx);
  __syncthreads();
  double num = 0, den = 0;
  if (tid < 64) {
    double l = 0, o = 0;
    const bf16_t* vb = p.vAT + ((size_t)(b * 2 + kvh) * 64 + tid) * PALL;
#pragma unroll 1
    for (int j = 0; j < nk; ++j) { l += sp[j]; o += (double)sp[j] * bf2f(vb[j]); }
    double ref = o / l, got = bf2f(p.oA[(size_t)tok * 512 + head * 64 + tid]);
    num = (got - ref) * (got - ref); den = ref * ref;
  }
  diag_accum(num, den, accum, sred);
}
__global__ void __launch_bounds__(256) k_chk_na(Params p, int layer, double* accum) {
  __shared__ double sred[512];
  __shared__ float sp[384];
  __shared__ int spos[384];
  __shared__ float sq[64];
  const int tid = threadIdx.x;
  int tok = diag_tok(blockIdx.x >> 1, gridDim.x);
  if (layer == 1 && tok >= TLAT) tok = dhash(blockIdx.x) % TLAT;
  int head = dhash(blockIdx.x * 13 + 3) & 7;
  const bool lat = tok < TLAT;
  int b = lat ? tok >> 12 : (tok - TLAT) >> 8;
  if (tid < 64) sq[tid] = bf2f(p.qC[(size_t)tok * 512 + head * 64 + tid]);
  __syncthreads();
  int nk = lat ? 384 : 256;
  for (int j = tid; j < nk; j += 256) {
    int ktok, kpall; float bias = 0.f;
    if (lat && j < 128) {
      int t = tok & 4095, r = t >> 6, w = t & 63;
      int rs = r - 4; rs = rs < 0 ? 0 : (rs > 56 ? 56 : rs);
      int cs = w - 8; cs = cs < 0 ? 0 : (cs > 48 ? 48 : cs);
      int i = j >> 4, jj = j & 15;
      int kr = rs + i, kc = cs + jj;
      ktok = b * 4096 + kr * 64 + kc; kpall = 256 + kr * 64 + kc;
      bias = p.rpb[(((size_t)layer * 8 + head) * 15 + (kr - r + 7)) * 31 + (kc - w + 15)] * LOG2E;
    } else {
      int c = lat ? j - 128 : j;
      ktok = TLAT + b * 256 + c; kpall = c;
    }
    float s = 0.f;
    for (int d = 0; d < 64; ++d) s += sq[d] * bf2f(p.kC[(size_t)ktok * 512 + head * 64 + d]);
    sp[j] = s + bias; spos[j] = kpall;
  }
  __syncthreads();
  float mx = -1e30f;
  for (int j = 0; j < nk; ++j) mx = fmaxf(mx, sp[j]);
  __syncthreads();
  for (int j = tid; j < nk; j += 256) sp[j] = exp2f(sp[j] - mx);
  __syncthreads();
  double num = 0, den = 0;
  if (tid < 64) {
    double l = 0, o = 0;
    const bf16_t* vb = p.vCT + ((size_t)(b * 8 + head) * 64 + tid) * PALL;
    for (int j = 0; j < nk; ++j) { l += sp[j]; o += (double)sp[j] * bf2f(vb[spos[j]]); }
    double ref = o / l, got = bf2f(p.oC[(size_t)tok * 512 + head * 64 + tid]);
    num = (got - ref) * (got - ref); den = ref * ref;
  }
  diag_accum(num, den, accum, sred);
}
__device__ constexpr int gla_sp(int i) { return i == 0 ? 0 : i == 1 ? 255 : i == 2 ? 256 : i == 3 ? 319 : i == 4 ? 320 : i == 5 ? 1257 : i == 6 ? 2756 : 4351; }
__global__ void __launch_bounds__(256) k_chk_gla(Params p, int layer, double* accum) {
  __shared__ double sred[512];
  __shared__ float sal[64], sqv[64], skv[64];
  __shared__ float sred2[128];
  const int tid = threadIdx.x;
  const int b = blockIdx.x >> 2, hd = blockIdx.x & 3;
  constexpr int NSP = 8;
  float osum[NSP];
#pragma unroll
  for (int i = 0; i < NSP; ++i) osum[i] = 0.f;
  for (int dir = 0; dir < 2; ++dir) {
    float S[64];
#pragma unroll
    for (int d = 0; d < 64; ++d) S[d] = 0.f;
#pragma unroll 1
    for (int step = 0; step < PALL; ++step) {
      int pall;
      if (step < 256) pall = dir ? 255 - step : step; else { int j = step - 256; pall = 256 + (dir ? 4095 - j : j); }
      int tok = pall < 256 ? TLAT + b * 256 + pall : b * 4096 + (pall - 256);
      __syncthreads();
      if (tid < 64) {
        float xv = p.gla_bg[((size_t)layer * 2 + dir) * 256 + hd * 64 + tid];
        for (int r = 0; r < 16; ++r) xv += p.aB[(size_t)tok * 32 + dir * 16 + r] * p.gla_wg[(((size_t)layer * 2 + dir) * 16 + r) * 256 + hd * 64 + tid];
        float ls = fminf(xv, 0.f) - log1pf(expf(-fabsf(xv)));
        sal[tid] = expf(ls / 16.f);
        sqv[tid] = bf2f(p.qB[(size_t)tok * 256 + hd * 64 + tid]);
        skv[tid] = bf2f(p.kB[(size_t)tok * 256 + hd * 64 + tid]);
      }
      __syncthreads();
      if (tid < 128) {
        float v = bf2f(p.vBT[((size_t)(b * 4 + hd) * 128 + tid) * PALL + pall]);
        float o = 0.f;
#pragma unroll
        for (int d = 0; d < 64; ++d) { S[d] = sal[d] * S[d] + skv[d] * v; o += sqv[d] * S[d]; }
#pragma unroll
        for (int i = 0; i < NSP; ++i) if (gla_sp(i) == pall) osum[i] += o;
      }
    }
  }
  double num = 0, den = 0;
#pragma unroll
  for (int i = 0; i < NSP; ++i) {
    if (layer == 1 && gla_sp(i) < 256) continue;
    __syncthreads();
    if (tid < 128) sred2[tid] = osum[i] * osum[i];
    __syncthreads();
    float tot = 0.f;
    for (int j = 0; j < 128; ++j) tot += sred2[j];
    if (tid < 128) {
      int pall = gla_sp(i);
      int tok = pall < 256 ? TLAT + b * 256 + pall : b * 4096 + (pall - 256);
      float rstd = 1.f / sqrtf(tot / 128.f + 1e-6f);
      float rg = bf2f(p.rB[(size_t)tok * 512 + hd * 128 + tid]);
      double ref = osum[i] * rstd * p.gla_norm[layer * 128 + tid] * (rg / (1.f + expf(-rg)));
      double got = bf2f(p.oB[(size_t)tok * 512 + hd * 128 + tid]);
      num += (got - ref) * (got - ref); den += ref * ref;
    }
  }
  diag_accum(num, den, accum, sred);
}
__global__ void __launch_bounds__(256) k_chk_merge(Params p, int layer, double* accum) {
  __shared__ double sred[512];
  const int tid = threadIdx.x;
  int tok = diag_tok(blockIdx.x, gridDim.x);
  if (layer == 1 && tok >= TLAT) tok = dhash(blockIdx.x) % TLAT;
  const float* W = p.w_in + (size_t)layer * 1024 * NIN_SRC;
  double num = 0, den = 0;
  for (int n = tid; n < 1024; n += 256) {
    double tot = 0;
    for (int br = 0; br < 3; ++br) {
      double g = p.b_in[layer * NIN_SRC + 3872 + br * 1024 + n];
      for (int k = 0; k < 1024; ++k) g += (double)bf2f(p.h[(size_t)tok * D + k]) * W[(size_t)k * NIN_SRC + 3872 + br * 1024 + n];
      g = 1.0 / (1.0 + exp(-g));
      const bf16_t* ob = br == 0 ? p.oA : (br == 1 ? p.oB : p.oC);
      const float* wb = (br == 0 ? p.w_br_attn : (br == 1 ? p.w_br_gla : p.w_br_na)) + (size_t)layer * 512 * 1024;
      double a = 0;
      for (int j = 0; j < 512; ++j) a += (double)bf2f(ob[(size_t)tok * 512 + j]) * wb[(size_t)j * 1024 + n];
      tot += g * a;
    }
    double got = bf2f(p.m[(size_t)tok * D + n]);
    num += (got - tot) * (got - tot); den += tot * tot;
  }
  diag_accum(num, den, accum, sred);
}
__global__ void __launch_bounds__(256) k_chk_x1(Params p, double* accum) {
  __shared__ double sred[512];
  __shared__ double sv[1024];
  __shared__ double sx1[1024];
  __shared__ double sst[4];
  const int tid = threadIdx.x;
  int tok = diag_tok(blockIdx.x, gridDim.x);
  const float* cv = tok < TLAT ? p.c + (tok >> 12) * 1024 : p.c_ctx;
  const float* xin = tok < TLAT ? p.x + (size_t)tok * D : p.ctx + (size_t)(tok - TLAT) * D;
  for (int n = tid; n < 1024; n += 256) {
    double y = 0, g1 = p.b_mod[2048 + n];
    for (int k = 0; k < 1024; ++k) {
      y += (double)bf2f(p.m[(size_t)tok * D + k]) * p.w_out[(size_t)k * 1024 + n];
      double cc = cv[k]; g1 += cc / (1.0 + exp(-cc)) * p.w_mod[(size_t)k * NMOD + 2048 + n];
    }
    sv[n] = 1.4142135623730951 * xin[n] + g1 * y;
  }
  __syncthreads();
  if (tid == 0) { double s = 0, q = 0; for (int i = 0; i < 1024; ++i) s += sv[i]; s /= 1024; for (int i = 0; i < 1024; ++i) q += (sv[i] - s) * (sv[i] - s); sst[0] = s; sst[1] = 1.0 / sqrt(q / 1024 + 1e-6); }
  __syncthreads();
  double num = 0, den = 0;
  for (int n = tid; n < 1024; n += 256) {
    double x1 = (sv[n] - sst[0]) * sst[1] * p.ln1_g[n] + p.ln1_b[n];
    sx1[n] = x1;
    double got = p.xres[(size_t)tok * D + n];
    num += (got - x1) * (got - x1); den += x1 * x1;
  }
  __syncthreads();
  if (tid == 0) { double s = 0, q = 0; for (int i = 0; i < 1024; ++i) s += sx1[i]; s /= 1024; for (int i = 0; i < 1024; ++i) q += (sx1[i] - s) * (sx1[i] - s); sst[2] = s; sst[3] = 1.0 / sqrt(q / 1024 + 1e-6); }
  __syncthreads();
  for (int n = tid; n < 1024; n += 256) {
    double sh = p.b_mod[3072 + n], sc = p.b_mod[4096 + n];
    for (int k = 0; k < 1024; ++k) { double cc = cv[k]; double sl = cc / (1.0 + exp(-cc)); sh += sl * p.w_mod[(size_t)k * NMOD + 3072 + n]; sc += sl * p.w_mod[(size_t)k * NMOD + 4096 + n]; }
    double h2 = (sx1[n] - sst[2]) * sst[3] * (1.0 + sc) + sh;
    double got = bf2f(p.h2[(size_t)tok * D + n]);
    num += (got - h2) * (got - h2); den += h2 * h2;
  }
  diag_accum(num, den, accum, sred);
}
__global__ void __launch_bounds__(256) k_chk_moe(Params p, int layer, int mode, double* accum) {
  __shared__ double sred[512];
  __shared__ float sh[1024];
  __shared__ float slog[36];
  __shared__ float shid[1024];
  __shared__ int se[2];
  __shared__ float sw[2];
  const int tid = threadIdx.x;
  int tok = diag_tok(blockIdx.x, gridDim.x);
  if (layer == 1 && tok >= TLAT) tok = dhash(blockIdx.x) % TLAT;
  for (int i = tid; i < 1024; i += 256) sh[i] = bf2f(p.h2[(size_t)tok * D + i]);
  __syncthreads();
  if (tid < 36) {
    double a;
    if (tid < 32) { a = p.b_re[layer * 32 + tid]; for (int k = 0; k < 1024; ++k) a += (double)sh[k] * p.w_re[((size_t)layer * 1024 + k) * 32 + tid]; }
    else { a = p.b_rg[layer * 4 + tid - 32]; for (int k = 0; k < 1024; ++k) a += (double)sh[k] * p.w_rg[((size_t)layer * 1024 + k) * 4 + tid - 32]; }
    slog[tid] = (float)a;
  }
  __syncthreads();
  if (tid == 0) {
    int grp = 0; for (int i = 1; i < 4; ++i) if (slog[32 + i] > slog[32 + grp]) grp = i;
    double gs = 0; for (int i = 0; i < 4; ++i) gs += exp((double)slog[32 + i] - slog[32 + grp]);
    double pg = 1.0 / gs;
    int i0 = 0; for (int i = 1; i < 8; ++i) if (slog[grp * 8 + i] > slog[grp * 8 + i0]) i0 = i;
    int i1 = -1; for (int i = 0; i < 8; ++i) if (i != i0 && (i1 < 0 || slog[grp * 8 + i] > slog[grp * 8 + i1])) i1 = i;
    double e1 = exp((double)slog[grp * 8 + i1] - slog[grp * 8 + i0]);
    se[0] = grp * 8 + i0; se[1] = grp * 8 + i1; sw[0] = (float)(pg / (1 + e1)); sw[1] = (float)(pg * e1 / (1 + e1));
  }
  __syncthreads();
  if (mode == 1) {
    double num = 0, den = 0;
    if (tid == 0) { den = 1.0; bool same = (p.tok_e[tok * 2] == se[0] && p.tok_e[tok * 2 + 1] == se[1]); num = same ? 0.0 : 1.0; }
    diag_accum(num, den, accum, sred);
    return;
  }
  int e0 = p.tok_e[tok * 2], e1 = p.tok_e[tok * 2 + 1];
  float w0 = p.tok_gate[tok * 2], w1 = p.tok_gate[tok * 2 + 1];
  double num = 0, den = 0;
  if (tid == 0 && e0 == se[0] && e1 == se[1]) { num += (w0 - sw[0]) * (w0 - sw[0]) + (w1 - sw[1]) * (w1 - sw[1]); }
  for (int i = tid; i < 1024; i += 256) {
    int k = i >> 9, j = i & 511, e = k ? e1 : e0;
    const float* w1p = p.w1 + ((size_t)layer * 32 + e) * 1024 * 512;
    const float* w3p = p.w3 + ((size_t)layer * 32 + e) * 1024 * 512;
    double a = 0, c = 0;
    for (int kk = 0; kk < 1024; ++kk) { a += (double)sh[kk] * w1p[(size_t)kk * 512 + j]; c += (double)sh[kk] * w3p[(size_t)kk * 512 + j]; }
    shid[i] = (float)(a / (1.0 + exp(-a)) * c);
  }
  __syncthreads();
  int s0 = p.estart[e0] * MOE_BLK + p.tok_pos[tok * 2], s1 = p.estart[e1] * MOE_BLK + p.tok_pos[tok * 2 + 1];
  for (int n = tid; n < 1024; n += 256) {
    double y = 0;
    const float* w2a = p.w2 + ((size_t)layer * 32 + e0) * 512 * 1024;
    const float* w2b = p.w2 + ((size_t)layer * 32 + e1) * 512 * 1024;
    double ya = 0, yb = 0;
    for (int j = 0; j < 512; ++j) { ya += (double)shid[j] * w2a[(size_t)j * 1024 + n]; yb += (double)shid[512 + j] * w2b[(size_t)j * 1024 + n]; }
    y = w0 * ya + w1 * yb;
    double got = w0 * bf2f(p.ysl[(size_t)s0 * D + n]) + w1 * bf2f(p.ysl[(size_t)s1 * D + n]);
    num += (got - y) * (got - y); den += y * y;
  }
  diag_accum(num, den, accum, sred);
}
__global__ void k_saverows(Params p, float* xsave, int layer) {
  int tok = diag_tok(blockIdx.x, gridDim.x);
  if (layer == 1 && tok >= TLAT) tok = dhash(blockIdx.x) % TLAT;
  for (int i = threadIdx.x; i < 1024; i += 256) xsave[(size_t)blockIdx.x * 1024 + i] = p.xres[(size_t)tok * D + i];
}
__global__ void __launch_bounds__(256) k_chk_final(Params p, int layer, const float* xsave, double* accum) {
  __shared__ double sred[512];
  __shared__ double sv[1024];
  __shared__ double sst[4];
  const int tid = threadIdx.x;
  int tok = diag_tok(blockIdx.x, gridDim.x);
  if (layer == 1 && tok >= TLAT) tok = dhash(blockIdx.x) % TLAT;
  const float* cv = tok < TLAT ? p.c + (tok >> 12) * 1024 : p.c_ctx;
  int e0 = p.tok_e[tok * 2], e1 = p.tok_e[tok * 2 + 1];
  float w0 = p.tok_gate[tok * 2], w1 = p.tok_gate[tok * 2 + 1];
  int s0 = p.estart[e0] * MOE_BLK + p.tok_pos[tok * 2], s1 = p.estart[e1] * MOE_BLK + p.tok_pos[tok * 2 + 1];
  for (int n = tid; n < 1024; n += 256) {
    double g2 = p.b_mod[layer * NMOD + 5120 + n];
    for (int k = 0; k < 1024; ++k) { double cc = cv[k]; g2 += cc / (1.0 + exp(-cc)) * p.w_mod[((size_t)layer * 1024 + k) * NMOD + 5120 + n]; }
    double y = w0 * bf2f(p.ysl[(size_t)s0 * D + n]) + w1 * bf2f(p.ysl[(size_t)s1 * D + n]);
    sv[n] = 1.4142135623730951 * xsave[(size_t)blockIdx.x * 1024 + n] + g2 * y;
  }
  __syncthreads();
  if (tid == 0) { double s = 0, q = 0; for (int i = 0; i < 1024; ++i) s += sv[i]; s /= 1024; for (int i = 0; i < 1024; ++i) q += (sv[i] - s) * (sv[i] - s); sst[0] = s; sst[1] = 1.0 / sqrt(q / 1024 + 1e-6); }
  __syncthreads();
  double num = 0, den = 0;
  for (int n = tid; n < 1024; n += 256) {
    double x2 = (sv[n] - sst[0]) * sst[1] * p.ln2_g[layer * D + n] + p.ln2_b[layer * D + n];
    sv[n] = x2;
    double got = layer == 1 ? p.out[(size_t)tok * D + n] : p.xres[(size_t)tok * D + n];
    num += (got - x2) * (got - x2); den += x2 * x2;
  }
  __syncthreads();
  if (layer == 0) {
    if (tid == 0) { double s = 0, q = 0; for (int i = 0; i < 1024; ++i) s += sv[i]; s /= 1024; for (int i = 0; i < 1024; ++i) q += (sv[i] - s) * (sv[i] - s); sst[2] = s; sst[3] = 1.0 / sqrt(q / 1024 + 1e-6); }
    __syncthreads();
    for (int n = tid; n < 1024; n += 256) {
      double sh = p.b_mod[NMOD + n], sc = p.b_mod[NMOD + 1024 + n];
      for (int k = 0; k < 1024; ++k) { double cc = cv[k]; double sl = cc / (1.0 + exp(-cc)); sh += sl * p.w_mod[((size_t)1024 + k) * NMOD + n]; sc += sl * p.w_mod[((size_t)1024 + k) * NMOD + 1024 + n]; }
      double h = (sv[n] - sst[2]) * sst[3] * (1.0 + sc) + sh;
      double got = bf2f(p.h[(size_t)tok * D + n]);
      num += (got - h) * (got - h); den += h * h;
    }
  }
  diag_accum(num, den, accum, sred);
}
#endif

static inline size_t align_up(size_t v, size_t a) { return (v + a - 1) / a * a; }

extern "C" void kernel_launch(void* const* d_in, const int* in_sizes, int n_in, void* d_out, int out_size, void* d_ws, size_t ws_size,
                              hipStream_t stream) {
  Params p{};
  const float* const* in = (const float* const*)d_in;
  p.x = in[0]; p.c = in[1]; p.ctx = in[2]; p.c_ctx = in[3]; p.w_mod = in[4]; p.b_mod = in[5]; p.w_in = in[6]; p.b_in = in[7];
  p.q_norm = in[8]; p.k_norm = in[9]; p.gla_wg = in[10]; p.gla_bg = in[11]; p.gla_norm = in[12]; p.rpb = in[13];
  p.w_br_attn = in[14]; p.w_br_gla = in[15]; p.w_br_na = in[16]; p.w_out = in[17]; p.ln1_g = in[18]; p.ln1_b = in[19];
  p.w_rg = in[20]; p.b_rg = in[21]; p.w_re = in[22]; p.b_re = in[23]; p.w1 = in[24]; p.w3 = in[25]; p.w2 = in[26];
  p.ln2_g = in[27]; p.ln2_b = in[28];
  p.out = (float*)d_out;

  char* base = (char*)d_ws;
  size_t off = 0;
  auto take = [&](size_t bytes) { char* q = base + off; off = align_up(off + bytes, 256); return q; };
  p.mod_part = (float*)take((size_t)16 * 2 * 5 * NMOD * 4);
  p.mod = (float*)take((size_t)2 * 5 * NMOD * 4);
  p.rope = (float*)take(2048 * 4);
  p.wrp = (float*)take((size_t)2 * 49152 * 4);
  p.bar = (unsigned*)take(XCD_BAR_WORDS * 4);
  p.cnt = (int*)take(32 * 4);
  p.estart = (int*)take(32 * 4);
  p.cntg = (int*)take((size_t)1088 * 32 * 4);
  p.list = (int*)take((size_t)32 * MOE_CAP * 4);
  p.tok_e = (int*)take((size_t)TALL * 2 * 4);
  p.tok_pos = (int*)take((size_t)TALL * 2 * 4);
  p.tok_gate = (float*)take((size_t)TALL * 2 * 4);
  p.wt_in = (bf16_t*)take((size_t)3968 * 1024 * 2);
  p.wt_gate = (bf16_t*)take((size_t)3072 * 1024 * 2);
  p.wt_br = (bf16_t*)take((size_t)3 * 1024 * 512 * 2);
  p.wt_out = (bf16_t*)take((size_t)1024 * 1024 * 2);
  p.wt_13 = (bf16_t*)take((size_t)32 * 1024 * 1024 * 2);
  p.wt_2 = (bf16_t*)take((size_t)32 * 1024 * 512 * 2);
  p.G = p.wt_13;
  p.xres = (float*)take((size_t)TALL * D * 4);
  p.h = (bf16_t*)take((size_t)TALL * D * 2);
  size_t r1 = off;
  p.qA = (bf16_t*)take((size_t)TALL * 512 * 2);
  p.kA = (bf16_t*)take((size_t)4 * 2 * PALL * 64 * 2);
  p.vAT = (bf16_t*)take((size_t)4 * 2 * 64 * PALL * 2);
  p.qB = (bf16_t*)take((size_t)TALL * 256 * 2);
  p.kB = (bf16_t*)take((size_t)TALL * 256 * 2);
  p.vBT = (bf16_t*)take((size_t)4 * 4 * 128 * PALL * 2);
  p.rB = (bf16_t*)take((size_t)TALL * 512 * 2);
  p.aB = (float*)take((size_t)TALL * 32 * 4);
  p.qC = (bf16_t*)take((size_t)TALL * 512 * 2);
  p.kC = (bf16_t*)take((size_t)TALL * 512 * 2);
  p.vCT = (bf16_t*)take((size_t)4 * 8 * 64 * PALL * 2);
  p.oA = (bf16_t*)take((size_t)TALL * 512 * 2);
  p.oB = (bf16_t*)take((size_t)TALL * 512 * 2);
  p.oC = (bf16_t*)take((size_t)TALL * 512 * 2);
  size_t r1_end = off;
  {
    size_t o2 = r1;
    p.act = (bf16_t*)(base + o2); o2 = align_up(o2 + (size_t)MAX_MBLK * MOE_BLK * 512 * 2, 256);
    p.ysl = (bf16_t*)(base + o2); o2 = align_up(o2 + (size_t)MAX_MBLK * MOE_BLK * 1024 * 2, 256);
    if (o2 > r1_end) off = o2;
  }
  p.KVt = (float*)take((size_t)32 * NCHUNK * 8192 * 4);
  p.SP = (bf16_t*)take((size_t)32 * NCHUNK * 8192 * 2);
  p.decay = (float*)take((size_t)32 * NCHUNK * 64 * 4);
  p.bcum = (float*)take((size_t)32 * NCHUNK * 4096 * 4);
  p.m = (bf16_t*)p.KVt;
  p.h2 = p.SP;
  if (off > ws_size) {
    fprintf(stderr, "workspace too small: need %zu have %zu\n", off, ws_size);
    return;
  }
  const dim3 blk(256);
#ifdef DIAG_STAGE
  {
    double* accum = (double*)take(64);
    float* xsave = (float*)take((size_t)64 * 1024 * 4);
    if (off > ws_size) return;
    const int G = 1024;
    const int DL = DIAG_LAYER, DS = DIAG_STAGE;
    k_diag_zero<<<1, 64, 0, stream>>>(accum);
    k_setup<<<((769 + 96) + 1) / 2, dim3(512), 0, stream>>>(p, 0);
    k_convert<<<((2048) + 1) / 2, dim3(512), 0, stream>>>(p, 0);
    k_modreduce<<<((240) + 1) / 2, dim3(512), 0, stream>>>(p, 0);
    k_rowpass0<<<((G) + 1) / 2, dim3(512), 0, stream>>>(p, 0);
    if (DS == 1 || DS == 0) k_chk_h<<<32, blk, 0, stream>>>(p, accum + 2);
    for (int l = 0; l <= DL; ++l) {
      const bool chk = (l == DL);
      k_inproj<<<((G) + 1) / 2, dim3(512), 0, stream>>>(p, l);
      if (chk && (DS == 2 || DS == 0)) k_chk_inproj<<<64, blk, 0, stream>>>(p, l, accum + 4);
      k_gla1<<<((G) + 1) / 2, dim3(512), 0, stream>>>(p, l);
      k_na<<<((1088) + 1) / 2, dim3(512), 0, stream>>>(p, l);
      if (chk && (DS == 4 || DS == 0)) k_chk_na<<<128, blk, 0, stream>>>(p, l, accum + 8);
      k_gla2<<<((G) + 1) / 2, dim3(512), 0, stream>>>(p, l);
      k_attnA<<<((1088) + 1) / 2, dim3(512), 0, stream>>>(p, l);
      if (chk && (DS == 3 || DS == 0)) k_chk_attnA<<<128, blk, 0, stream>>>(p, l, accum + 6);
      k_gla3<<<((1088) + 1) / 2, dim3(512), 0, stream>>>(p, l);
      if (chk && (DS == 5 || DS == 0)) k_chk_gla<<<16, blk, 0, stream>>>(p, l, accum + 10);
      k_merge<<<((G) + 1) / 2, dim3(512), 0, stream>>>(p, l);
      if (chk && (DS == 6 || DS == 0)) k_chk_merge<<<32, blk, 0, stream>>>(p, l, accum + 12);
      k_outproj<<<((G) + 1) / 2, dim3(512), 0, stream>>>(p, l);
      k_rowpass1<<<((G) + 1) / 2, dim3(512), 0, stream>>>(p, l);
      if (chk && l == 0 && (DS == 7 || DS == 0)) k_chk_x1<<<32, blk, 0, stream>>>(p, accum + 14);
      k_moescan<<<((32) + 1) / 2, dim3(512), 0, stream>>>(p, l);
      k_convert<<<((2048) + 1) / 2, dim3(512), 0, stream>>>(p, l | 16);
    k_moe1<<<((G) + 1) / 2, dim3(512), 0, stream>>>(p, l);
      k_moe2<<<((G) + 1) / 2, dim3(512), 0, stream>>>(p, l);
      if (chk && (DS == 8 || DS == 0)) k_chk_moe<<<32, blk, 0, stream>>>(p, l, 0, accum + 16);
      if (chk && DS == 9) k_chk_moe<<<512, blk, 0, stream>>>(p, l, 1, accum + 18);
      if (chk && (DS == 10 || DS == 0)) k_saverows<<<32, blk, 0, stream>>>(p, xsave, l);
      k_rowpass2<<<((G) + 1) / 2, dim3(512), 0, stream>>>(p, l);
      if (chk && (DS == 10 || DS == 0)) k_chk_final<<<32, blk, 0, stream>>>(p, l, xsave, accum + 20);
      if (l == 0) k_convert<<<((2048) + 1) / 2, dim3(512), 0, stream>>>(p, 1);
    }
    k_diag_report<<<1024, blk, 0, stream>>>(accum, p.out, TLAT * D);
    return;
  }
#endif
#ifdef MK_MULTI
  const int G = 1024;
  k_setup<<<((769 + 96) + 1) / 2, dim3(512), 0, stream>>>(p, 0);
  k_convert<<<((2048) + 1) / 2, dim3(512), 0, stream>>>(p, 0);
  k_modreduce<<<((240) + 1) / 2, dim3(512), 0, stream>>>(p, 0);
  k_rowpass0<<<((G) + 1) / 2, dim3(512), 0, stream>>>(p, 0);
  for (int l = 0; l < 2; ++l) {
    k_inproj<<<((G) + 1) / 2, dim3(512), 0, stream>>>(p, l);
    k_gla1<<<((G) + 1) / 2, dim3(512), 0, stream>>>(p, l);
    k_na<<<((1088) + 1) / 2, dim3(512), 0, stream>>>(p, l);
    k_gla2<<<((G) + 1) / 2, dim3(512), 0, stream>>>(p, l);
    k_attnA<<<((1088) + 1) / 2, dim3(512), 0, stream>>>(p, l);
    k_gla3<<<((1088) + 1) / 2, dim3(512), 0, stream>>>(p, l);
    k_merge<<<((G) + 1) / 2, dim3(512), 0, stream>>>(p, l);
    k_outproj<<<((G) + 1) / 2, dim3(512), 0, stream>>>(p, l);
    k_rowpass1<<<((G) + 1) / 2, dim3(512), 0, stream>>>(p, l);
    k_moescan<<<((32) + 1) / 2, dim3(512), 0, stream>>>(p, l);
    k_convert<<<((2048) + 1) / 2, dim3(512), 0, stream>>>(p, l | 16);
    k_moe1<<<((G) + 1) / 2, dim3(512), 0, stream>>>(p, l);
    k_moe2<<<((G) + 1) / 2, dim3(512), 0, stream>>>(p, l);
    k_rowpass2<<<((G) + 1) / 2, dim3(512), 0, stream>>>(p, l);
    if (l == 0) k_convert<<<((2048) + 1) / 2, dim3(512), 0, stream>>>(p, 1);
  }
#else
  static int grid_blocks = 0;
  if (!grid_blocks) {
    int dev = 0, cus = 0, per_cu = 0;
    hipGetDevice(&dev);
    hipDeviceGetAttribute(&cus, hipDeviceAttributeMultiprocessorCount, dev);
    hipOccupancyMaxActiveBlocksPerMultiprocessor(&per_cu, k_mega, 512, 0);
    per_cu = 1;
    grid_blocks = cus * per_cu;
  }
  hipMemsetAsync(p.bar, 0, XCD_BAR_WORDS * 4, stream);
  k_mega<<<dim3(grid_blocks), dim3(512), 0, stream>>>(p);
#endif
}
```

```cpp
#include <hip/hip_runtime.h>
#include <hip/hip_cooperative_groups.h>
#include <stdint.h>
#include <stdio.h>
namespace cg = cooperative_groups;

typedef unsigned short bf16_t;
typedef __attribute__((ext_vector_type(8))) short bf16x8;
typedef __attribute__((ext_vector_type(4))) short bf16x4;
typedef __attribute__((ext_vector_type(16))) float f32x16;
typedef __attribute__((ext_vector_type(4))) unsigned u32x4;
typedef __attribute__((ext_vector_type(4))) float f32x4v;

#ifndef XCD_MAP_ENABLE
#define XCD_MAP_ENABLE 0
#endif
constexpr int D = 1024;
constexpr int TLAT = 16384, TCTX = 1024, TALL = 17408, PALL = 4352;
constexpr int NIN_SRC = 6944, NMOD = 6144;
constexpr int NT_IN = 31;
constexpr int SMEM_BYTES = 69632;
constexpr int LDC = 132;
constexpr float LOG2E = 1.4426950408889634f;
constexpr float QSCALE = 0.125f * LOG2E;
constexpr float ALPHA = 1.4142135623730951f;
constexpr int NCHUNK = 68;
constexpr int MOE_CAP = TALL;
constexpr int MOE_BLK = 256;
constexpr int MAX_MBLK = 168;

struct Params {
  const float *x, *c, *ctx, *c_ctx, *w_mod, *b_mod, *w_in, *b_in, *q_norm, *k_norm, *gla_wg, *gla_bg, *gla_norm, *rpb,
      *w_br_attn, *w_br_gla, *w_br_na, *w_out, *ln1_g, *ln1_b, *w_rg, *b_rg, *w_re, *b_re, *w1, *w3, *w2, *ln2_g, *ln2_b;
  float* out;
  float *mod_part, *mod, *rope, *wrp;
  bf16_t *wt_in, *wt_gate, *wt_br, *wt_out, *wt_13, *wt_2, *G;
  float* xres;
  bf16_t *h, *h2;
  bf16_t *qA, *kA, *vAT, *qB, *kB, *vBT, *rB;
  float* aB;
  bf16_t *qC, *kC, *vCT;
  bf16_t *oA, *oB, *oC;
  float* KVt;
  float* bcum;
  bf16_t* SP;
  float* decay;
  bf16_t* m;
  bf16_t *act, *ysl;
  int *cnt, *cntg, *list, *tok_e, *tok_pos, *estart;
  float* tok_gate;
  unsigned* bar;
};

typedef const __attribute__((address_space(4))) Params& PRef;
__device__ __forceinline__ PRef params_view() {
  const __attribute__((address_space(4))) Params* pp = (const __attribute__((address_space(4))) Params*)__builtin_amdgcn_kernarg_segment_ptr();
  asm volatile("" : "+s"(pp));
  return *pp;
}

__device__ __forceinline__ int tid_() { int t = __builtin_amdgcn_workitem_id_x() & 255; asm volatile("" : "+v"(t)); return t; }
__device__ __forceinline__ int half_() { int h = __builtin_amdgcn_readfirstlane(__builtin_amdgcn_workitem_id_x() >> 8); asm volatile("" : "+s"(h)); return h; }
__device__ __forceinline__ int bid_() { int t = 2 * __builtin_amdgcn_workgroup_id_x() + half_(); asm volatile("" : "+s"(t)); return t; }
__device__ __forceinline__ int vgrid_() { return 2 * (int)gridDim.x; }
typedef __attribute__((ext_vector_type(2))) __bf16 bf16x2n;
typedef __attribute__((ext_vector_type(2))) float f32x2n;
__device__ __forceinline__ bf16_t f2bf(float f) { return __builtin_bit_cast(bf16_t, (__bf16)f); }
__device__ __forceinline__ float bf2f(bf16_t b) { return __uint_as_float(((unsigned)b) << 16); }
__device__ __forceinline__ unsigned pack2(float a, float b) {
  f32x2n v = {a, b};
  return __builtin_bit_cast(unsigned, __builtin_convertvector(v, bf16x2n));
}
__device__ __forceinline__ float wave_sum(float v) {
  int x;
  x = __builtin_amdgcn_update_dpp(0, __float_as_int(v), 0xB1, 0xf, 0xf, true);  v += __int_as_float(x);
  x = __builtin_amdgcn_update_dpp(0, __float_as_int(v), 0x4E, 0xf, 0xf, true);  v += __int_as_float(x);
  x = __builtin_amdgcn_update_dpp(0, __float_as_int(v), 0x141, 0xf, 0xf, true); v += __int_as_float(x);
  x = __builtin_amdgcn_update_dpp(0, __float_as_int(v), 0x140, 0xf, 0xf, true); v += __int_as_float(x);
  x = __builtin_amdgcn_update_dpp(0, __float_as_int(v), 0x142, 0xa, 0xf, false); v += __int_as_float(x);
  x = __builtin_amdgcn_update_dpp(0, __float_as_int(v), 0x143, 0xc, 0xf, false); v += __int_as_float(x);
  return __int_as_float(__builtin_amdgcn_readlane(__float_as_int(v), 63));
}
__device__ __forceinline__ float siluf(float x) { return x * __builtin_amdgcn_rcpf(1.f + __expf(-x)); }
__device__ __forceinline__ float sigmoidf_(float x) { return __builtin_amdgcn_rcpf(1.f + __expf(-x)); }
__device__ __forceinline__ f32x16 zero16() {
  f32x16 z;
#pragma unroll
  for (int i = 0; i < 16; ++i) z[i] = 0.f;
  return z;
}
__device__ __forceinline__ f32x16 mfma32(bf16x8 a, bf16x8 b, f32x16 c) {
  return __builtin_amdgcn_mfma_f32_32x32x16_bf16(a, b, c, 0, 0, 0);
}
__device__ __forceinline__ int tok_modrow(int tok) { return tok < TLAT ? (tok >> 12) : 4; }

__device__ __forceinline__ void phase_setup(PRef p, char* smem) {
  float* sS = (float*)smem;
  const int tid = tid_();
  for (int item = bid_(); item < 769 + 96; item += vgrid_()) {
    if (item >= 769) {
      int it = item - 769;
      int l = it / 48, chunk = it % 48;
      for (int i = tid; i < 1024; i += 256) {
        int idx = chunk * 1024 + i;
        int e = idx & 3, ln = (idx >> 2) & 63, t = (idx >> 8) & 63, nt = idx >> 14;
        int k = 16 * t + 4 * (ln >> 4) + e, n = 16 * nt + (ln & 15);
        float v = 0.f;
        if (n < 32) v = p.w_re[((size_t)l * 1024 + k) * 32 + n];
        else if (n < 36) v = p.w_rg[((size_t)l * 1024 + k) * 4 + (n - 32)];
        p.wrp[(size_t)l * 49152 + idx] = v;
      }
      continue;
    }
    if (item == 768) {
      for (int i = tid; i < 1024; i += 256) {
        int pos = i >> 4, f = i & 15;
        float inv = powf(10000.f, -(float)f / 16.f);
        float ang = (float)pos * inv;
        p.rope[i] = cosf(ang);
        p.rope[1024 + i] = sinf(ang);
      }
      continue;
    }
    int nb = item % 24, ks = (item / 24) % 16, l = item / 384;
    __syncthreads();
    for (int i = tid; i < 320; i += 256) {
      int r = i >> 6, k = ks * 64 + (i & 63);
      float cv = (r < 4) ? p.c[r * 1024 + k] : p.c_ctx[k];
      sS[i] = siluf(cv);
    }
    __syncthreads();
    int n = nb * 256 + tid;
    const float* w = p.w_mod + ((size_t)l * 1024 + ks * 64) * NMOD + n;
    float acc[5] = {0.f, 0.f, 0.f, 0.f, 0.f};
#pragma unroll 8
    for (int k = 0; k < 64; ++k) {
      float wv = w[(size_t)k * NMOD];
#pragma unroll
      for (int r = 0; r < 5; ++r) acc[r] += sS[r * 64 + k] * wv;
    }
#pragma unroll
    for (int r = 0; r < 5; ++r) p.mod_part[(((size_t)ks * 2 + l) * 5 + r) * NMOD + n] = acc[r];
  }
}
__device__ __forceinline__ void phase_modreduce(PRef p) {
  for (int i = bid_() * 256 + tid_(); i < 2 * 5 * NMOD; i += vgrid_() * 256) {
    int n = i % NMOD, l = i / (5 * NMOD);
    float s = p.b_mod[l * NMOD + n];
#pragma unroll
    for (int ks = 0; ks < 16; ++ks) s += p.mod_part[(size_t)ks * 2 * 5 * NMOD + i];
    p.mod[i] = s;
  }
}

constexpr int CV_IN = 16 * 62, CV_GATE = 16 * 48, CV_BR = 8 * 16, CV_OUT = 16 * 16, CV_13 = 16 * 16, CV_2 = 8 * 16;
constexpr int CV_O1 = CV_IN, CV_O2 = CV_O1 + CV_GATE, CV_O3 = CV_O2 + 3 * CV_BR, CV_O4 = CV_O3 + CV_OUT, CV_O5 = CV_O4 + 32 * CV_13,
              CV_TOTAL = CV_O5 + 32 * CV_2;
struct ConvDesc { const float* src; int ldsrc; int ncols; bf16_t* dst; int lddst; };
__device__ __forceinline__ ConvDesc conv_desc(PRef p, int layer, int item) {
  ConvDesc d;
  d.ncols = 64;
  if (item < CV_O1) {
    int kt = item & 15, ntile = item >> 4;
    int n0 = ntile * 64, srccol;
    if (n0 < 2304) srccol = n0;
    else if (n0 < 3840) srccol = n0 + 32;
    else if (n0 == 3840) { srccol = 2304; d.ncols = 32; }
    else { srccol = 0; d.ncols = 0; }
    d.src = p.w_in + (size_t)layer * 1024 * NIN_SRC + (size_t)(kt * 64) * NIN_SRC + srccol; d.ldsrc = NIN_SRC;
    d.dst = p.wt_in + (size_t)n0 * 1024 + kt * 64; d.lddst = 1024;
  } else if (item < CV_O2) {
    int it = item - CV_O1, kt = it & 15, ntile = it >> 4;
    d.src = p.w_in + (size_t)layer * 1024 * NIN_SRC + (size_t)(kt * 64) * NIN_SRC + 3872 + ntile * 64; d.ldsrc = NIN_SRC;
    d.dst = p.wt_gate + (size_t)(ntile * 64) * 1024 + kt * 64; d.lddst = 1024;
  } else if (item < CV_O3) {
    int it = item - CV_O2, br = it / CV_BR, t = it % CV_BR, kt = t & 7, ntile = t >> 3;
    const float* s0 = (br == 0 ? p.w_br_attn : (br == 1 ? p.w_br_gla : p.w_br_na)) + (size_t)layer * 512 * 1024;
    d.src = s0 + (size_t)(kt * 64) * 1024 + ntile * 64; d.ldsrc = 1024;
    d.dst = p.wt_br + (size_t)br * 1024 * 512 + (size_t)(ntile * 64) * 512 + kt * 64; d.lddst = 512;
  } else if (item < CV_O4) {
    int it = item - CV_O3, kt = it & 15, ntile = it >> 4;
    d.src = p.w_out + (size_t)layer * 1024 * 1024 + (size_t)(kt * 64) * 1024 + ntile * 64; d.ldsrc = 1024;
    d.dst = p.wt_out + (size_t)(ntile * 64) * 1024 + kt * 64; d.lddst = 1024;
  } else if (item < CV_O5) {
    int it = item - CV_O4, e = it >> 8, t = it & 255, kt = t & 15, ntile = t >> 4;
    int j = ntile >> 1, isw3 = ntile & 1;
    d.src = (isw3 ? p.w3 : p.w1) + ((size_t)layer * 32 + e) * 1024 * 512 + (size_t)(kt * 64) * 512 + j * 64; d.ldsrc = 512;
    d.dst = p.wt_13 + (size_t)e * 1024 * 1024 + (size_t)(ntile * 64) * 1024 + kt * 64; d.lddst = 1024;
  } else {
    int it = item - CV_O5, e = it >> 7, t = it & 127, kt = t & 7, ntile = t >> 3;
    d.src = p.w2 + ((size_t)layer * 32 + e) * 512 * 1024 + (size_t)(kt * 64) * 1024 + ntile * 64; d.ldsrc = 1024;
    d.dst = p.wt_2 + (size_t)e * 1024 * 512 + (size_t)(ntile * 64) * 512 + kt * 64; d.lddst = 512;
  }
  return d;
}
__device__ __forceinline__ void conv_load8(const ConvDesc& d, int nhalf, int lane, f32x4v (&v)[8]) {
  const int kb = lane >> 3, c0 = nhalf * 32 + (lane & 7) * 4;
  const float* sp = d.src + (size_t)(kb * 8) * d.ldsrc + c0;
  const bool ok = c0 < d.ncols;
#pragma unroll
  for (int j = 0; j < 8; ++j) {
    f32x4v z = {0.f, 0.f, 0.f, 0.f};
    v[j] = ok ? *(const f32x4v*)(sp + (size_t)j * d.ldsrc) : z;
  }
}
__device__ __forceinline__ void phase_convert(PRef p, int layer_part, char* smem) {
  const int tid = tid_(), lane = tid & 63, w = tid >> 6;
  const int layer = layer_part & 15, part = layer_part >> 4;
  const int begin = part ? CV_O4 : 0, ntiles = part ? (CV_TOTAL - CV_O4) : CV_O4;
  const int nw = vgrid_() * 4;
  int wt = bid_() * 4 + w;
  if (wt >= 2 * ntiles) return;
  ConvDesc d0 = conv_desc(p, layer, begin + (wt >> 1));
  f32x4v v0[8], v1[8];
  conv_load8(d0, wt & 1, lane, v0);
  for (;;) {
    const int nwt = wt + nw;
    const bool more = nwt < 2 * ntiles;
    ConvDesc d1 = d0;
    if (more) { d1 = conv_desc(p, layer, begin + (nwt >> 1)); conv_load8(d1, nwt & 1, lane, v1); }
    {
      const int kb = lane >> 3, c0 = (wt & 1) * 32 + (lane & 7) * 4;
      bf16_t* dp = d0.dst + (size_t)c0 * d0.lddst + kb * 8;
#pragma unroll
      for (int c = 0; c < 4; ++c) {
        const uint4 o = make_uint4(pack2(v0[0][c], v0[1][c]), pack2(v0[2][c], v0[3][c]), pack2(v0[4][c], v0[5][c]), pack2(v0[6][c], v0[7][c]));
        *(uint4*)(dp + (size_t)c * d0.lddst) = o;
      }
    }
    if (!more) break;
    wt = nwt;
    d0 = d1;
#pragma unroll
    for (int j = 0; j < 8; ++j) v0[j] = v1[j];
  }
}

__device__ __forceinline__ void row_stats(const float (&v)[16], float& mean, float& rstd) {
  float s = 0.f;
#pragma unroll
  for (int i = 0; i < 16; ++i) s += v[i];
  mean = wave_sum(s) * (1.f / 1024.f);
  float q = 0.f;
#pragma unroll
  for (int i = 0; i < 16; ++i) { float d = v[i] - mean; q += d * d; }
  float var = wave_sum(q) * (1.f / 1024.f);
  rstd = rsqrtf(var + 1e-6f);
}
__device__ __forceinline__ void load_row(const float* src, int lane, float (&v)[16]) {
#pragma unroll
  for (int i = 0; i < 4; ++i) {
    float4 t = *(const float4*)(src + lane * 4 + 256 * i);
    v[4 * i] = t.x; v[4 * i + 1] = t.y; v[4 * i + 2] = t.z; v[4 * i + 3] = t.w;
  }
}
__device__ __forceinline__ void store_row(float* dst, int lane, const float (&v)[16]) {
#pragma unroll
  for (int i = 0; i < 4; ++i) *(float4*)(dst + lane * 4 + 256 * i) = make_float4(v[4 * i], v[4 * i + 1], v[4 * i + 2], v[4 * i + 3]);
}
__device__ __forceinline__ void store_row_bf(bf16_t* dst, int lane, const float (&v)[16]) {
#pragma unroll
  for (int i = 0; i < 4; ++i) {
    uint2 o = make_uint2(pack2(v[4 * i], v[4 * i + 1]), pack2(v[4 * i + 2], v[4 * i + 3]));
    *(uint2*)(dst + lane * 4 + 256 * i) = o;
  }
}
__device__ __forceinline__ void modulate_row(const float (&x)[16], const float* shift, const float* scale, int lane, float (&h)[16]) {
  float mean, rstd;
  row_stats(x, mean, rstd);
  float sh[16], sc[16];
  load_row(shift, lane, sh);
  load_row(scale, lane, sc);
#pragma unroll
  for (int i = 0; i < 16; ++i) h[i] = (x[i] - mean) * rstd * (1.f + sc[i]) + sh[i];
}

__device__ __forceinline__ void phase_rowpass0(PRef p) {
  const int lane = tid_() & 63, w = tid_() >> 6;
  for (int tok = bid_() * 4 + w; tok < TALL; tok += vgrid_() * 4) {
    const float* src = tok < TLAT ? p.x + (size_t)tok * D : p.ctx + (size_t)(tok - TLAT) * D;
    const float* md = p.mod + (size_t)tok_modrow(tok) * NMOD;
    float x[16], h[16];
    load_row(src, lane, x);
    modulate_row(x, md, md + 1024, lane, h);
    store_row_bf(p.h + (size_t)tok * D, lane, h);
  }
}

typedef __attribute__((ext_vector_type(4))) float f32x4;
__device__ __forceinline__ void phase_rowpass1(PRef p, int layer, char* smem) {
  float* sH = (float*)smem;
  float* sPart = (float*)smem;
  int* sE = (int*)(smem + 16384);
  const int tid = tid_(), lane = tid & 63, w = tid >> 6;
  const int ntok = layer == 0 ? TALL : TLAT;
  const float* lg = p.ln1_g + layer * D;
  const float* lb = p.ln1_b + layer * D;
  const float* wrp = p.wrp + (size_t)layer * 49152;
  for (int g0 = bid_() * 16; g0 < ntok; g0 += vgrid_() * 16) {
    __syncthreads();
    {
      float v[4][16];
#pragma unroll
      for (int rr = 0; rr < 4; ++rr) load_row(p.xres + (size_t)(g0 + w * 4 + rr) * D, lane, v[rr]);
      float gg[16], bb[16];
      load_row(lg, lane, gg);
      load_row(lb, lane, bb);
#pragma unroll
      for (int rr = 0; rr < 4; ++rr) {
        const int tok = g0 + w * 4 + rr;
        float mean, rstd;
        row_stats(v[rr], mean, rstd);
        float x1[16], h2[16];
#pragma unroll
        for (int i = 0; i < 16; ++i) x1[i] = (v[rr][i] - mean) * rstd * gg[i] + bb[i];
        store_row(p.xres + (size_t)tok * D, lane, x1);
        const float* md = p.mod + ((size_t)layer * 5 + tok_modrow(tok)) * NMOD;
        modulate_row(x1, md + 3072, md + 4096, lane, h2);
        store_row_bf(p.h2 + (size_t)tok * D, lane, h2);
        store_row(sH + (w * 4 + rr) * 1028, lane, h2);
      }
    }
    __syncthreads();
    f32x4 acc0 = {0.f, 0.f, 0.f, 0.f}, acc1 = acc0, acc2 = acc0;
    {
      const float* ap = sH + (lane & 15) * 1028 + 4 * (lane >> 4) + 256 * w;
      const float* bp = wrp + (size_t)(16 * w) * 256 + lane * 4;
#pragma unroll 8
      for (int t = 0; t < 16; ++t) {
        float4 a = *(const float4*)(ap + 16 * t);
        float4 b0 = *(const float4*)(bp + t * 256);
        float4 b1 = *(const float4*)(bp + t * 256 + 16384);
        float4 b2 = *(const float4*)(bp + t * 256 + 32768);
        acc0 = __builtin_amdgcn_mfma_f32_16x16x4f32(a.x, b0.x, acc0, 0, 0, 0);
        acc1 = __builtin_amdgcn_mfma_f32_16x16x4f32(a.x, b1.x, acc1, 0, 0, 0);
        acc2 = __builtin_amdgcn_mfma_f32_16x16x4f32(a.x, b2.x, acc2, 0, 0, 0);
        acc0 = __builtin_amdgcn_mfma_f32_16x16x4f32(a.y, b0.y, acc0, 0, 0, 0);
        acc1 = __builtin_amdgcn_mfma_f32_16x16x4f32(a.y, b1.y, acc1, 0, 0, 0);
        acc2 = __builtin_amdgcn_mfma_f32_16x16x4f32(a.y, b2.y, acc2, 0, 0, 0);
        acc0 = __builtin_amdgcn_mfma_f32_16x16x4f32(a.z, b0.z, acc0, 0, 0, 0);
        acc1 = __builtin_amdgcn_mfma_f32_16x16x4f32(a.z, b1.z, acc1, 0, 0, 0);
        acc2 = __builtin_amdgcn_mfma_f32_16x16x4f32(a.z, b2.z, acc2, 0, 0, 0);
        acc0 = __builtin_amdgcn_mfma_f32_16x16x4f32(a.w, b0.w, acc0, 0, 0, 0);
        acc1 = __builtin_amdgcn_mfma_f32_16x16x4f32(a.w, b1.w, acc1, 0, 0, 0);
        acc2 = __builtin_amdgcn_mfma_f32_16x16x4f32(a.w, b2.w, acc2, 0, 0, 0);
      }
    }
    __syncthreads();
#pragma unroll
    for (int g = 0; g < 4; ++g) {
      const int row = (lane >> 4) * 4 + g, col = lane & 15;
      sPart[(w * 16 + row) * 48 + col] = acc0[g];
      sPart[(w * 16 + row) * 48 + 16 + col] = acc1[g];
      sPart[(w * 16 + row) * 48 + 32 + col] = acc2[g];
    }
    __syncthreads();
    if (tid < 16) {
      int tok = g0 + tid;
      const float* l0 = sPart + tid * 48;
      float g[4];
#pragma unroll
      for (int i = 0; i < 4; ++i) g[i] = ((l0[32 + i] + l0[768 + 32 + i]) + (l0[1536 + 32 + i] + l0[2304 + 32 + i])) + p.b_rg[layer * 4 + i];
      int grp = 0;
      float gm = g[0];
#pragma unroll
      for (int i = 1; i < 4; ++i) if (g[i] > gm) { gm = g[i]; grp = i; }
      float gs = 0.f;
#pragma unroll
      for (int i = 0; i < 4; ++i) gs += __expf(g[i] - gm);
      float pg = 1.f / gs;
      float sv[8];
#pragma unroll
      for (int i = 0; i < 8; ++i) {
        const int c = grp * 8 + i;
        sv[i] = ((l0[c] + l0[768 + c]) + (l0[1536 + c] + l0[2304 + c])) + p.b_re[layer * 32 + c];
      }
      int i0 = 0;
      float v0 = sv[0];
#pragma unroll
      for (int i = 1; i < 8; ++i) if (sv[i] > v0) { v0 = sv[i]; i0 = i; }
      int i1 = -1;
      float v1 = -3.0e38f;
#pragma unroll
      for (int i = 0; i < 8; ++i) if (i != i0 && sv[i] > v1) { v1 = sv[i]; i1 = i; }
      float e1 = __expf(v1 - v0);
      float w0 = pg / (1.f + e1), w1 = pg * e1 / (1.f + e1);
      int ex0 = grp * 8 + i0, ex1 = grp * 8 + i1;
      sE[tid * 2] = ex0; sE[tid * 2 + 1] = ex1;
      p.tok_e[tok * 2] = ex0; p.tok_e[tok * 2 + 1] = ex1;
      p.tok_gate[tok * 2] = w0; p.tok_gate[tok * 2 + 1] = w1;
    }
    __syncthreads();
    if (tid < 32) {
      int c = 0;
#pragma unroll 8
      for (int i = 0; i < 32; ++i) c += (sE[i] == tid) ? 1 : 0;
      p.cntg[(size_t)(g0 >> 4) * 32 + tid] = c;
      const int mine = sE[tid];
      int rk = 0;
      for (int i = 0; i < (tid & ~1); ++i) rk += (sE[i] == mine) ? 1 : 0;
      p.tok_pos[(g0 + (tid >> 1)) * 2 + (tid & 1)] = rk;
    }
  }
}

__device__ __forceinline__ void phase_moescan(PRef p, int layer, char* smem) {
  int* sOff = (int*)smem;
  int* sScan = sOff + 1280;
  const int tid = tid_();
  const int e = bid_();
  if (e >= 32) return;
  const int ntok = layer == 0 ? TALL : TLAT;
  const int ng = ntok >> 4;
  __syncthreads();
  int loc[5], s = 0;
#pragma unroll
  for (int i = 0; i < 5; ++i) {
    const int g = tid * 5 + i;
    loc[i] = g < ng ? p.cntg[(size_t)g * 32 + e] : 0;
    s += loc[i];
  }
  sScan[tid] = s;
  __syncthreads();
  for (int o = 1; o < 256; o <<= 1) {
    int v = tid >= o ? sScan[tid - o] : 0;
    __syncthreads();
    sScan[tid] += v;
    __syncthreads();
  }
  int run = sScan[tid] - s;
#pragma unroll
  for (int i = 0; i < 5; ++i) { sOff[tid * 5 + i] = run; run += loc[i]; }
  if (tid == 255) p.cnt[e] = sScan[255];
  __syncthreads();
  typedef int i32x2v __attribute__((ext_vector_type(2)));
  for (int base = 0; base < ntok; base += 2048) {
    i32x2v te[8], tp[8];
#pragma unroll
    for (int u = 0; u < 8; ++u) {
      const int tok = base + u * 256 + tid;
      const int tc = tok < ntok ? tok : 0;
      te[u] = *(const i32x2v*)(p.tok_e + tc * 2);
      tp[u] = *(const i32x2v*)(p.tok_pos + tc * 2);
      if (tok >= ntok) te[u] = (i32x2v){-1, -1};
    }
#pragma unroll
    for (int u = 0; u < 8; ++u) {
      const int tok = base + u * 256 + tid;
      if (te[u][0] == e) { const int pos = sOff[tok >> 4] + tp[u][0]; p.list[e * MOE_CAP + pos] = tok; p.tok_pos[tok * 2] = pos; }
      if (te[u][1] == e) { const int pos = sOff[tok >> 4] + tp[u][1]; p.list[e * MOE_CAP + pos] = tok; p.tok_pos[tok * 2 + 1] = pos; }
    }
  }
}

__device__ __forceinline__ void phase_rowpass2(PRef p, int layer) {
  const int lane = tid_() & 63, w = tid_() >> 6;
  const bool last = layer == 1;
  const int ntok = last ? TLAT : TALL;
  const float* lg = p.ln2_g + layer * D;
  const float* lb = p.ln2_b + layer * D;
  const int stride = vgrid_() * 4;
  for (int tokA = bid_() * 4 + w; tokA < ntok; tokA += 2 * stride) {
    const bool hasB = tokA + stride < ntok;
    int tk[2];
    tk[0] = tokA; tk[1] = hasB ? tokA + stride : tokA;
    int s0[2], s1[2];
    float w0[2], w1[2];
#pragma unroll
    for (int u = 0; u < 2; ++u) {
      const int t = tk[u];
      const int e0 = p.tok_e[t * 2], e1 = p.tok_e[t * 2 + 1];
      s0[u] = p.estart[e0] * MOE_BLK + p.tok_pos[t * 2];
      s1[u] = p.estart[e1] * MOE_BLK + p.tok_pos[t * 2 + 1];
      w0[u] = p.tok_gate[t * 2]; w1[u] = p.tok_gate[t * 2 + 1];
    }
    float x1[2][16], g2[2][16];
    uint2 ya[2][4], yb[2][4];
#pragma unroll
    for (int u = 0; u < 2; ++u) {
      const int t = tk[u];
      load_row(p.xres + (size_t)t * D, lane, x1[u]);
      load_row(p.mod + ((size_t)layer * 5 + tok_modrow(t)) * NMOD + 5120, lane, g2[u]);
      const bf16_t* y0 = p.ysl + (size_t)s0[u] * D;
      const bf16_t* y1 = p.ysl + (size_t)s1[u] * D;
#pragma unroll
      for (int i = 0; i < 4; ++i) { ya[u][i] = *(const uint2*)(y0 + lane * 4 + 256 * i); yb[u][i] = *(const uint2*)(y1 + lane * 4 + 256 * i); }
    }
    float gg[16], bb[16];
    load_row(lg, lane, gg);
    load_row(lb, lane, bb);
#pragma unroll
    for (int u = 0; u < 2; ++u) {
      if (u == 1 && !hasB) break;
      const int tok = tk[u];
      float v[16], x2[16];
#pragma unroll
      for (int i = 0; i < 4; ++i) {
        const uint2 a = ya[u][i], b = yb[u][i];
        float fa[4] = {bf2f(a.x & 0xffff), bf2f(a.x >> 16), bf2f(a.y & 0xffff), bf2f(a.y >> 16)};
        float fb[4] = {bf2f(b.x & 0xffff), bf2f(b.x >> 16), bf2f(b.y & 0xffff), bf2f(b.y >> 16)};
#pragma unroll
        for (int e = 0; e < 4; ++e) v[4 * i + e] = ALPHA * x1[u][4 * i + e] + g2[u][4 * i + e] * (w0[u] * fa[e] + w1[u] * fb[e]);
      }
      float mean, rstd;
      row_stats(v, mean, rstd);
#pragma unroll
      for (int i = 0; i < 16; ++i) x2[i] = (v[i] - mean) * rstd * gg[i] + bb[i];
      if (last) {
        store_row(p.out + (size_t)tok * D, lane, x2);
      } else {
        store_row(p.xres + (size_t)tok * D, lane, x2);
        const float* mdn = p.mod + ((size_t)(layer + 1) * 5 + tok_modrow(tok)) * NMOD;
        float h[16];
        modulate_row(x2, mdn, mdn + 1024, lane, h);
        store_row_bf(p.h + (size_t)tok * D, lane, h);
      }
    }
  }
}

struct Ptr4 { const bf16_t* p[4]; };

template <int NJ>
__device__ __forceinline__ void gemm_compute_tile(const char* cA, const char* cB, int r, int hh, f32x16 (&acc)[2][NJ]) {
#pragma unroll
  for (int s = 0; s < 4; ++s) {
    const int co = ((2 * s + hh) ^ ((r >> 1) & 7)) << 4;
    bf16x8 a0 = *(const bf16x8*)(cA + co);
    bf16x8 a1 = *(const bf16x8*)(cA + 4096 + co);
    bf16x8 b[NJ];
#pragma unroll
    for (int j = 0; j < NJ; ++j) b[j] = *(const bf16x8*)(cB + j * 4096 + co);
#pragma unroll
    for (int j = 0; j < NJ; ++j) {
      acc[0][j] = mfma32(a0, b[j], acc[0][j]);
      acc[1][j] = mfma32(a1, b[j], acc[1][j]);
    }
  }
}
#define LAS3 __attribute__((address_space(3)))
__device__ __forceinline__ void dma_sync() { asm volatile("s_waitcnt vmcnt(0)" ::: "memory"); __syncthreads(); }
template <int NJ>
__device__ __forceinline__ void g_stage(const Ptr4& ap, const Ptr4& bp, int kt, char* dA, char* dB) {
#pragma unroll
  for (int i = 0; i < 4; ++i) __builtin_amdgcn_global_load_lds((const unsigned*)(ap.p[i] + kt * 64), (LAS3 unsigned*)(dA + i * 4096), 16, 0, 0);
#pragma unroll
  for (int i = 0; i < 2 * NJ; ++i) __builtin_amdgcn_global_load_lds((const unsigned*)(bp.p[i] + kt * 64), (LAS3 unsigned*)(dB + i * 4096), 16, 0, 0);
}
template <int NJ>
__device__ __forceinline__ void gemm_mainloop(const Ptr4& ap, const Ptr4& bp, int nk, f32x16 (&acc)[2][NJ], char* smem) {
  const int tid = tid_(), lane = tid & 63, w = tid >> 6, wr = w >> 1, wc = w & 1, r = lane & 31, hh = lane >> 5;
  char* sA = smem;
  char* sB = smem + 32768;
  const int dofs = tid * 16;
  g_stage<NJ>(ap, bp, 0, sA + dofs, sB + dofs);
  dma_sync();
  const char* cA = sA + (wr * 64 + r) * 128;
  const char* cB = sB + (wc * 32 * NJ + r) * 128;
  for (int kt = 0; kt < nk; ++kt) {
    const int cur = kt & 1;
    if (kt + 1 < nk) g_stage<NJ>(ap, bp, kt + 1, sA + (cur ^ 1) * 16384 + dofs, sB + (cur ^ 1) * 16384 + dofs);
    gemm_compute_tile<NJ>(cA + cur * 16384, cB + cur * 16384, r, hh, acc);
    dma_sync();
  }
}
__device__ __forceinline__ Ptr4 rows_contig(const bf16_t* base, int ld) {
  Ptr4 q;
  const int lrow = tid_() >> 3, lch = tid_() & 7;
#pragma unroll
  for (int i = 0; i < 4; ++i) q.p[i] = base + (size_t)(lrow + 32 * i) * ld + ((lch ^ ((lrow >> 1) & 7)) * 8);
  return q;
}
__device__ __forceinline__ void acc_to_lds(const f32x16 (&acc)[2][2], float* sC) {
  const int lane = tid_() & 63, w = tid_() >> 6, wr = w >> 1, wc = w & 1, r = lane & 31, hh = lane >> 5;
#pragma unroll
  for (int i = 0; i < 2; ++i)
#pragma unroll
    for (int j = 0; j < 2; ++j)
#pragma unroll
      for (int g = 0; g < 16; ++g) {
        int row = wr * 64 + i * 32 + (g & 3) + 8 * (g >> 2) + 4 * hh, col = wc * 64 + j * 32 + r;
        sC[row * LDC + col] = acc[i][j][g];
      }
}
__device__ __forceinline__ void acc_to_lds_T(const f32x16 (&acc)[2][2], float* sC) {
  const int lane = tid_() & 63, w = tid_() >> 6, wr = w >> 1, wc = w & 1, r = lane & 31, hh = lane >> 5;
#pragma unroll
  for (int i = 0; i < 2; ++i)
#pragma unroll
    for (int j = 0; j < 2; ++j)
#pragma unroll
      for (int g4 = 0; g4 < 4; ++g4) {
        int row = wr * 64 + i * 32 + 8 * g4 + 4 * hh, col = wc * 64 + j * 32 + r;
        *(float4*)(sC + col * LDC + row) = make_float4(acc[i][j][4 * g4], acc[i][j][4 * g4 + 1], acc[i][j][4 * g4 + 2], acc[i][j][4 * g4 + 3]);
      }
}
__device__ __forceinline__ void lds_read8(const float* s, float (&v)[8]) {
  float4 a = *(const float4*)s, b = *(const float4*)(s + 4);
  v[0] = a.x; v[1] = a.y; v[2] = a.z; v[3] = a.w; v[4] = b.x; v[5] = b.y; v[6] = b.z; v[7] = b.w;
}
__device__ __forceinline__ uint4 pack8(const float (&v)[8]) {
  return make_uint4(pack2(v[0], v[1]), pack2(v[2], v[3]), pack2(v[4], v[5]), pack2(v[6], v[7]));
}
__device__ __forceinline__ void st_nt16(void* q, const uint4 v) {
  typedef unsigned nt_u32x4 __attribute__((ext_vector_type(4)));
  const nt_u32x4 t = {v.x, v.y, v.z, v.w};
  __builtin_nontemporal_store(t, (nt_u32x4*)q);
}


__device__ __forceinline__ int xcd_rounds(const char*, int nMt, int nNt) { return (nMt * nNt + vgrid_() - 1) / vgrid_(); }
__device__ __forceinline__ bool xcd_tile(const char*, int round, int nMt, int nNt, int& mt, int& nt) {
  const int item = round * vgrid_() + bid_();
  mt = item / nNt; nt = item % nNt;
  return item < nMt * nNt;
}

namespace pg8 {
constexpr int BK = 64, HALF = 128, HTB = HALF * BK * 2, STAGE_BYTES = 8 * HTB;
__device__ __forceinline__ int lds_byte(int r, int c) { const int st = (r >> 4) * 2 + (c >> 5), rr = r & 15, cc = c & 31, ob = rr * 64 + cc * 2; return st * 1024 + (ob ^ (((ob >> 9) & 1) << 5)); }
__device__ __forceinline__ void stage_rc(int b, int& R, int& C) { const int st = b / 1024, sb = b % 1024, swz = sb ^ (((sb >> 9) & 1) << 5); R = (st >> 1) * 16 + swz / 64; C = (st & 1) * 32 + (swz % 64) / 2; }
typedef float f32x4 __attribute__((ext_vector_type(4)));
__device__ __forceinline__ int perm32(int rho) { const int n = rho >> 4, i = rho & 15; return 8 * (i >> 2) + 4 * n + (i & 3); }
template <bool PERM = false>
__device__ __forceinline__ void gemm_unit(LAS3 unsigned char* lds, const char* cA0, const char* cA1, const unsigned (&voffA0)[2], const unsigned (&voffA1)[2],
                                          const char* cB, int K, f32x4 (&acc)[2][2][4][2]) {
  int tid = __builtin_amdgcn_workitem_id_x();
  asm volatile("" : "+v"(tid));
  const int wid = __builtin_amdgcn_readfirstlane(tid >> 6), lane = tid & 63, wr = wid >> 2, wc = wid & 3, fr = lane & 15, fq = lane >> 4;
  const int nt = K / BK;
  unsigned voffB[2];
#pragma unroll
  for (int i = 0; i < 2; ++i) { int R, C; stage_rc(tid * 16 + i * 8192, R, C); const int Rb = PERM ? ((R & ~31) + perm32(R & 31)) : R; voffB[i] = (unsigned)(Rb * K + C) * 2u; }
  const size_t kstep = (size_t)(BK * 2);
  const size_t hstep = (size_t)HALF * K * 2;
  const unsigned ldsw = (unsigned)wid * 1024u;
  const int aoff = lds_byte(wr * 64 + fr, fq * 8), boff = lds_byte(wc * 32 + fr, fq * 8);
#define PG8_SA(b, h) (((b) * 2 + (h)) * HTB)
#define PG8_SB(b, h) ((4 + (b) * 2 + (h)) * HTB)
#define PG8_STAGE(bufoff, gbase, voff) do { _Pragma("unroll") for (int _i = 0; _i < 2; ++_i) \
        __builtin_amdgcn_global_load_lds((const unsigned*)((const char*)(gbase) + (voff)[_i]), (LAS3 unsigned*)(lds + (bufoff) + ldsw + _i * 8192), 16, 0, 0); } while (0)
#define PG8_LDA(dst, b, h) do { _Pragma("unroll") for (int m = 0; m < 4; ++m) _Pragma("unroll") for (int k = 0; k < 2; ++k) dst[m][k] = *(const LAS3 bf16x8*)(lds + PG8_SA(b, h) + aoff + m * 2048 + k * 1024); } while (0)
#define PG8_LDB(dst, b, h) do { _Pragma("unroll") for (int n = 0; n < 2; ++n) _Pragma("unroll") for (int k = 0; k < 2; ++k) dst[n][k] = *(const LAS3 bf16x8*)(lds + PG8_SB(b, h) + boff + n * 2048 + k * 1024); } while (0)
#define PG8_MMA(ai, bj, At, Bt) do { __builtin_amdgcn_s_setprio(1); _Pragma("unroll") for (int m = 0; m < 4; ++m) _Pragma("unroll") for (int n = 0; n < 2; ++n) _Pragma("unroll") for (int k = 0; k < 2; ++k) \
        acc[ai][bj][m][n] = __builtin_amdgcn_mfma_f32_16x16x32_bf16(Bt[n][k], At[m][k], acc[ai][bj][m][n], 0, 0, 0); __builtin_amdgcn_s_setprio(0); } while (0)
#define PG8_WAIT_V(n) asm volatile("s_waitcnt vmcnt(" #n ")" ::: "memory")
#define PG8_WAIT_L(n) asm volatile("s_waitcnt lgkmcnt(" #n ")" ::: "memory")
#define PG8_BAR __builtin_amdgcn_s_barrier()
#define PG8_SCHED __builtin_amdgcn_sched_barrier(0)
#pragma unroll
  for (int a = 0; a < 2; ++a)
#pragma unroll
    for (int b = 0; b < 2; ++b)
#pragma unroll
      for (int m = 0; m < 4; ++m)
#pragma unroll
        for (int n = 0; n < 2; ++n) acc[a][b][m][n] = (f32x4){0.f, 0.f, 0.f, 0.f};
  bf16x8 At[4][2], B0[2][2], B1[2][2];
  PG8_STAGE(PG8_SB(0, 0), cB, voffB); PG8_STAGE(PG8_SA(0, 0), cA0, voffA0); PG8_STAGE(PG8_SB(0, 1), cB + hstep, voffB); PG8_STAGE(PG8_SA(0, 1), cA1, voffA1);
  if (wr == 1) PG8_BAR;
  PG8_WAIT_V(4); PG8_BAR;
  PG8_STAGE(PG8_SB(1, 0), cB + kstep, voffB); PG8_STAGE(PG8_SA(1, 0), cA0 + kstep, voffA0); PG8_STAGE(PG8_SB(1, 1), cB + hstep + kstep, voffB);
  PG8_WAIT_V(6); PG8_BAR;
  for (int t = 0; t < nt; t += 2) {
    const bool last = (t == nt - 2);
    const size_t o1 = (size_t)(t + 1) * kstep;
    const size_t o2 = last ? 0 : (size_t)(t + 2) * kstep;
    const size_t o3 = o2 + kstep;
    PG8_LDB(B0, 0, 0); PG8_SCHED; PG8_LDA(At, 0, 0); PG8_STAGE(PG8_SA(1, 1), cA1 + o1, voffA1);
    PG8_WAIT_L(8); PG8_BAR; PG8_WAIT_L(0); PG8_MMA(0, 0, At, B0); PG8_BAR; PG8_SCHED;
    PG8_LDB(B1, 0, 1); PG8_STAGE(PG8_SB(0, 0), cB + o2, voffB);
    PG8_BAR; PG8_WAIT_L(0); PG8_MMA(0, 1, At, B1); PG8_BAR;
    PG8_LDA(At, 0, 1); PG8_STAGE(PG8_SA(0, 0), cA0 + o2, voffA0);
    PG8_BAR; PG8_WAIT_L(0); PG8_MMA(1, 0, At, B0); PG8_BAR; PG8_SCHED;
    PG8_STAGE(PG8_SB(0, 1), cB + hstep + o2, voffB);
    PG8_WAIT_V(6); PG8_BAR; PG8_MMA(1, 1, At, B1); PG8_BAR;
    PG8_LDB(B0, 1, 0); PG8_SCHED; PG8_LDA(At, 1, 0); PG8_STAGE(PG8_SA(0, 1), cA1 + o2, voffA1);
    PG8_WAIT_L(8); PG8_BAR; PG8_WAIT_L(0); PG8_MMA(0, 0, At, B0); PG8_BAR; PG8_SCHED;
    PG8_LDB(B1, 1, 1); PG8_STAGE(PG8_SB(1, 0), cB + o3, voffB);
    PG8_BAR; PG8_WAIT_L(0); PG8_MMA(0, 1, At, B1); PG8_BAR;
    PG8_LDA(At, 1, 1); PG8_STAGE(PG8_SA(1, 0), cA0 + o3, voffA0);
    PG8_BAR; PG8_WAIT_L(0); PG8_MMA(1, 0, At, B0); PG8_BAR; PG8_SCHED;
    PG8_STAGE(PG8_SB(1, 1), cB + hstep + o3, voffB);
    PG8_WAIT_V(6); PG8_BAR; PG8_MMA(1, 1, At, B1); PG8_BAR;
  }
  PG8_WAIT_V(0);
  if (wr == 0) PG8_BAR;
  PG8_BAR;
#undef PG8_SA
#undef PG8_SB
#undef PG8_STAGE
#undef PG8_LDA
#undef PG8_LDB
#undef PG8_MMA
#undef PG8_WAIT_V
#undef PG8_WAIT_L
#undef PG8_BAR
#undef PG8_SCHED
}
struct UnitAB { const char* a; const char* b; };
template <bool PERM, class Prov, class Epi>
__device__ __forceinline__ void gemm_stream(LAS3 unsigned char* lds, int K, Prov prov, Epi epi) {
  int tid = __builtin_amdgcn_workitem_id_x();
  asm volatile("" : "+v"(tid));
  const int wid = __builtin_amdgcn_readfirstlane(tid >> 6), lane = tid & 63, wr = wid >> 2, wc = wid & 3, fr = lane & 15, fq = lane >> 4;
  const int nt = K / BK;
  UnitAB cur, nxt;
  if (!prov(0, cur)) return;
  unsigned voffA[2], voffB[2];
#pragma unroll
  for (int i = 0; i < 2; ++i) { int R, C; stage_rc(tid * 16 + i * 8192, R, C); const int Rb = PERM ? ((R & ~31) + perm32(R & 31)) : R;
    voffA[i] = (unsigned)(R * K + C) * 2u; voffB[i] = (unsigned)(Rb * K + C) * 2u; }
  const size_t kstep = (size_t)(BK * 2);
  const size_t hstep = (size_t)HALF * K * 2;
  const unsigned ldsw = (unsigned)wid * 1024u;
  const int aoff = lds_byte(wr * 64 + fr, fq * 8), boff = lds_byte(wc * 32 + fr, fq * 8);
#define PG8_SA(b, h) (((b) * 2 + (h)) * HTB)
#define PG8_SB(b, h) ((4 + (b) * 2 + (h)) * HTB)
#define PG8_STAGE(bufoff, gbase, voff) do { _Pragma("unroll") for (int _i = 0; _i < 2; ++_i) \
        __builtin_amdgcn_global_load_lds((const unsigned*)((const char*)(gbase) + (voff)[_i]), (LAS3 unsigned*)(lds + (bufoff) + ldsw + _i * 8192), 16, 0, 0); } while (0)
#define PG8_LDA(dst, b, h) do { _Pragma("unroll") for (int m = 0; m < 4; ++m) _Pragma("unroll") for (int k = 0; k < 2; ++k) dst[m][k] = *(const LAS3 bf16x8*)(lds + PG8_SA(b, h) + aoff + m * 2048 + k * 1024); } while (0)
#define PG8_LDB(dst, b, h) do { _Pragma("unroll") for (int n = 0; n < 2; ++n) _Pragma("unroll") for (int k = 0; k < 2; ++k) dst[n][k] = *(const LAS3 bf16x8*)(lds + PG8_SB(b, h) + boff + n * 2048 + k * 1024); } while (0)
#define PG8_MMA(ai, bj, At, Bt) do { __builtin_amdgcn_s_setprio(1); _Pragma("unroll") for (int m = 0; m < 4; ++m) _Pragma("unroll") for (int n = 0; n < 2; ++n) _Pragma("unroll") for (int k = 0; k < 2; ++k) \
        acc[ai][bj][m][n] = __builtin_amdgcn_mfma_f32_16x16x32_bf16(Bt[n][k], At[m][k], acc[ai][bj][m][n], 0, 0, 0); __builtin_amdgcn_s_setprio(0); } while (0)
#define PG8_WAIT_V(n) asm volatile("s_waitcnt vmcnt(" #n ")" ::: "memory")
#define PG8_WAIT_L(n) asm volatile("s_waitcnt lgkmcnt(" #n ")" ::: "memory")
#define PG8_BAR __builtin_amdgcn_s_barrier()
#define PG8_SCHED __builtin_amdgcn_sched_barrier(0)
#define PG8_ZERO() do { _Pragma("unroll") for (int a = 0; a < 2; ++a) _Pragma("unroll") for (int b = 0; b < 2; ++b) _Pragma("unroll") for (int m = 0; m < 4; ++m) \
        _Pragma("unroll") for (int n = 0; n < 2; ++n) acc[a][b][m][n] = (f32x4){0.f, 0.f, 0.f, 0.f}; } while (0)
  f32x4 acc[2][2][4][2];
  PG8_ZERO();
  bf16x8 At[4][2], B0[2][2], B1[2][2];
  const char* cA = cur.a; const char* cB = cur.b;
  PG8_STAGE(PG8_SB(0, 0), cB, voffB); PG8_STAGE(PG8_SA(0, 0), cA, voffA); PG8_STAGE(PG8_SB(0, 1), cB + hstep, voffB); PG8_STAGE(PG8_SA(0, 1), cA + hstep, voffA);
  if (wr == 1) PG8_BAR;
  PG8_WAIT_V(4); PG8_BAR;
  PG8_STAGE(PG8_SB(1, 0), cB + kstep, voffB); PG8_STAGE(PG8_SA(1, 0), cA + kstep, voffA); PG8_STAGE(PG8_SB(1, 1), cB + hstep + kstep, voffB);
  PG8_WAIT_V(6); PG8_BAR;
  for (int ui = 0;; ++ui) {
    const bool has_next = prov(ui + 1, nxt);
    const char* nA = has_next ? nxt.a : cA; const char* nB = has_next ? nxt.b : cB;
    for (int t = 0; t < nt; t += 2) {
      const bool last = (t == nt - 2);
      const char* a1 = cA + (size_t)(t + 1) * kstep;
      const char* a2 = last ? nA : cA + (size_t)(t + 2) * kstep; const char* b2 = last ? nB : cB + (size_t)(t + 2) * kstep;
      const char* a3 = a2 + kstep; const char* b3 = b2 + kstep;
      PG8_LDB(B0, 0, 0); PG8_SCHED; PG8_LDA(At, 0, 0); PG8_STAGE(PG8_SA(1, 1), a1 + hstep, voffA);
      PG8_WAIT_L(8); PG8_BAR; PG8_WAIT_L(0); PG8_MMA(0, 0, At, B0); PG8_BAR; PG8_SCHED;
      PG8_LDB(B1, 0, 1); PG8_STAGE(PG8_SB(0, 0), b2, voffB);
      PG8_BAR; PG8_WAIT_L(0); PG8_MMA(0, 1, At, B1); PG8_BAR;
      PG8_LDA(At, 0, 1); PG8_STAGE(PG8_SA(0, 0), a2, voffA);
      PG8_BAR; PG8_WAIT_L(0); PG8_MMA(1, 0, At, B0); PG8_BAR; PG8_SCHED;
      PG8_STAGE(PG8_SB(0, 1), b2 + hstep, voffB);
      PG8_WAIT_V(6); PG8_BAR; PG8_MMA(1, 1, At, B1); PG8_BAR;
      PG8_LDB(B0, 1, 0); PG8_SCHED; PG8_LDA(At, 1, 0); PG8_STAGE(PG8_SA(0, 1), a2 + hstep, voffA);
      PG8_WAIT_L(8); PG8_BAR; PG8_WAIT_L(0); PG8_MMA(0, 0, At, B0); PG8_BAR; PG8_SCHED;
      PG8_LDB(B1, 1, 1); PG8_STAGE(PG8_SB(1, 0), b3, voffB);
      PG8_BAR; PG8_WAIT_L(0); PG8_MMA(0, 1, At, B1); PG8_BAR;
      PG8_LDA(At, 1, 1); PG8_STAGE(PG8_SA(1, 0), a3, voffA);
      PG8_BAR; PG8_WAIT_L(0); PG8_MMA(1, 0, At, B0); PG8_BAR; PG8_SCHED;
      PG8_STAGE(PG8_SB(1, 1), b3 + hstep, voffB);
      PG8_WAIT_V(6); PG8_BAR; PG8_MMA(1, 1, At, B1); PG8_BAR;
    }
    epi(ui, acc);
    if (!has_next) break;
    PG8_ZERO();
    cA = nA; cB = nB;
  }
  PG8_WAIT_V(0);
  if (wr == 0) PG8_BAR;
  PG8_BAR;
#undef PG8_SA
#undef PG8_SB
#undef PG8_STAGE
#undef PG8_LDA
#undef PG8_LDB
#undef PG8_MMA
#undef PG8_WAIT_V
#undef PG8_WAIT_L
#undef PG8_BAR
#undef PG8_SCHED
#undef PG8_ZERO
}
__device__ __forceinline__ void voff_contig(int K, unsigned (&voff)[2]) {
  int tid = __builtin_amdgcn_workitem_id_x();
  asm volatile("" : "+v"(tid));
#pragma unroll
  for (int i = 0; i < 2; ++i) { int R, C; stage_rc(tid * 16 + i * 8192, R, C); voff[i] = (unsigned)(R * K + C) * 2u; }
}
template <int ai, int bj>
__device__ __forceinline__ void acc_to_lds(const f32x4 (&acc)[2][2][4][2], bool transposed, float* sC) {
  int tid = __builtin_amdgcn_workitem_id_x();
  asm volatile("" : "+v"(tid));
  const int wid = tid >> 6, lane = tid & 63, wr = wid >> 2, wc = wid & 3, fr = lane & 15, fq = lane >> 4;
#pragma unroll
  for (int m = 0; m < 4; ++m)
#pragma unroll
    for (int n = 0; n < 2; ++n) {
      const int row = 64 * wr + 16 * m + fr, col = 32 * wc + 16 * n + 4 * fq;
      const f32x4 v = acc[ai][bj][m][n];
      if (!transposed) *(f32x4*)(sC + row * LDC + col) = v;
      else { sC[col * LDC + row] = v[0]; sC[(col + 1) * LDC + row] = v[1]; sC[(col + 2) * LDC + row] = v[2]; sC[(col + 3) * LDC + row] = v[3]; }
    }
}
template <class F>
__device__ __forceinline__ void for_each_piece(const f32x4 (&acc)[2][2][4][2], F f) {
  int tid = __builtin_amdgcn_workitem_id_x();
  asm volatile("" : "+v"(tid));
  const int wid = tid >> 6, lane = tid & 63, wr = wid >> 2, wc = wid & 3, fr = lane & 15, fq = lane >> 4;
#pragma unroll
  for (int ai = 0; ai < 2; ++ai)
#pragma unroll
    for (int m = 0; m < 4; ++m)
#pragma unroll
      for (int bj = 0; bj < 2; ++bj) {
        const f32x4 a = acc[ai][bj][m][0], b = acc[ai][bj][m][1];
        float v[8] = {a[0], a[1], a[2], a[3], b[0], b[1], b[2], b[3]};
        f(128 * ai + 64 * wr + 16 * m + fr, 128 * bj + 32 * wc + 8 * fq, v);
      }
}
__device__ __forceinline__ int unit_linear(int i) { return i * (int)gridDim.x + (int)__builtin_amdgcn_workgroup_id_x(); }
__device__ __forceinline__ bool unit_map(int L, int nM, int nN, int& pm, int& pn) {
  const int nwg = nM * nN;
  if (L >= nwg) return false;
  int wgid = L;
  { const int q = nwg / 8, r = nwg % 8, xcd = wgid % 8, off = wgid / 8; wgid = (xcd < r ? xcd * (q + 1) : r * (q + 1) + (xcd - r) * q) + off; }
  const int nig = 8 * nN, gid = wgid / nig, fm = gid * 8, gsz = (nM - fm) < 8 ? (nM - fm) : 8;
  pm = fm + ((wgid % nig) % gsz); pn = (wgid % nig) / gsz;
  return true;
}
}

__device__ __forceinline__ bool inproj_transposed(int nt) { return (nt == 5) || (nt >= 10 && nt <= 13) || (nt >= 26 && nt <= 29); }
__device__ __forceinline__ void inproj_epilogue(PRef p, int layer, int mt, int nt, const float* sC, int tid) {
  const float* bias = p.b_in + layer * NIN_SRC;
  const bool transposed = inproj_transposed(nt);
  const int tok0 = mt * 128;
  const bool lat = tok0 < TLAT;
  int b, pos0, pall0;
  if (lat) { b = tok0 >> 12; pos0 = tok0 & 4095; pall0 = 256 + pos0; }
  else { int ci = tok0 - TLAT; b = ci >> 8; pos0 = ci & 255; pall0 = pos0; }
  const int n0 = nt * 128;
  const int srcc0 = (nt < 18) ? n0 : n0 + 32;
  if (transposed) {
    const int tc = tid & 15, cb = tid >> 4;
    float bv[8];
#pragma unroll
    for (int ps = 0; ps < 8; ++ps) bv[ps] = bias[srcc0 + ps * 16 + cb];
#pragma unroll
    for (int ps = 0; ps < 8; ++ps) {
      const int col = ps * 16 + cb;
      float v[8];
      lds_read8(sC + col * LDC + tc * 8, v);
#pragma unroll
      for (int e = 0; e < 8; ++e) v[e] += bv[ps];
      bf16_t* dst;
      if (nt == 5) dst = p.vAT + ((size_t)(b * 2 + (col >> 6)) * 64 + (col & 63)) * PALL;
      else if (nt <= 13) dst = p.vBT + ((size_t)(b * 4 + (nt - 10)) * 128 + col) * PALL;
      else dst = p.vCT + ((size_t)(b * 8 + (nt - 26) * 2 + (col >> 6)) * 64 + (col & 63)) * PALL;
      *(uint4*)(dst + pall0 + tc * 8) = pack8(v);
    }
  } else if (nt <= 4) {
    const float* gn = (nt < 4 ? p.q_norm : p.k_norm) + layer * 64;
    const float osc = nt < 4 ? QSCALE : 1.f;
    const int c8 = tid & 15, rb = tid >> 4, d0 = (c8 & 7) * 8;
    float bs[8], bp[8], g0[8], g1[8];
    {
      const float4 t0 = *(const float4*)(bias + srcc0 + c8 * 8), t1 = *(const float4*)(bias + srcc0 + c8 * 8 + 4);
      const float4 u0 = *(const float4*)(bias + srcc0 + ((c8 * 8) ^ 16)), u1 = *(const float4*)(bias + srcc0 + ((c8 * 8) ^ 16) + 4);
      const float4 a0 = *(const float4*)(gn + d0), a1 = *(const float4*)(gn + d0 + 4);
      const float4 c0 = *(const float4*)(gn + (d0 ^ 16)), c1 = *(const float4*)(gn + (d0 ^ 16) + 4);
      bs[0] = t0.x; bs[1] = t0.y; bs[2] = t0.z; bs[3] = t0.w; bs[4] = t1.x; bs[5] = t1.y; bs[6] = t1.z; bs[7] = t1.w;
      bp[0] = u0.x; bp[1] = u0.y; bp[2] = u0.z; bp[3] = u0.w; bp[4] = u1.x; bp[5] = u1.y; bp[6] = u1.z; bp[7] = u1.w;
      g0[0] = a0.x; g0[1] = a0.y; g0[2] = a0.z; g0[3] = a0.w; g0[4] = a1.x; g0[5] = a1.y; g0[6] = a1.z; g0[7] = a1.w;
      g1[0] = c0.x; g1[1] = c0.y; g1[2] = c0.z; g1[3] = c0.w; g1[4] = c1.x; g1[5] = c1.y; g1[6] = c1.z; g1[7] = c1.w;
    }
    const int qd = d0 >> 4;
    const float sgn = (qd & 1) ? 1.f : -1.f;
#pragma unroll 2
    for (int ps = 0; ps < 8; ++ps) {
      const int row = ps * 16 + rb;
      float v[8], pv[8];
      lds_read8(sC + row * LDC + c8 * 8, v);
      lds_read8(sC + row * LDC + ((c8 * 8) ^ 16), pv);
      float cs[8], sn[8];
      if (lat) {
        const int t = pos0 + row;
        const int pp = (qd < 2) ? (t >> 6) : (t & 63);
        const float* rp = p.rope + pp * 16 + (d0 & 15);
        const float4 r0 = *(const float4*)rp, r1 = *(const float4*)(rp + 4), s0 = *(const float4*)(rp + 1024), s1 = *(const float4*)(rp + 1028);
        cs[0] = r0.x; cs[1] = r0.y; cs[2] = r0.z; cs[3] = r0.w; cs[4] = r1.x; cs[5] = r1.y; cs[6] = r1.z; cs[7] = r1.w;
        sn[0] = s0.x; sn[1] = s0.y; sn[2] = s0.z; sn[3] = s0.w; sn[4] = s1.x; sn[5] = s1.y; sn[6] = s1.z; sn[7] = s1.w;
      } else {
#pragma unroll
        for (int e = 0; e < 8; ++e) { cs[e] = 1.f; sn[e] = 0.f; }
      }
      float ss = 0.f;
#pragma unroll
      for (int e = 0; e < 8; ++e) { v[e] += bs[e]; pv[e] += bp[e]; ss += v[e] * v[e]; }
      ss += __shfl_xor(ss, 1);
      ss += __shfl_xor(ss, 2);
      ss += __shfl_xor(ss, 4);
      const float rstd = rsqrtf(ss * (1.f / 64.f) + 1e-6f);
      float o[8];
#pragma unroll
      for (int e = 0; e < 8; ++e) {
        const float xn = v[e] * rstd * g0[e], pn = pv[e] * rstd * g1[e];
        o[e] = (xn * cs[e] + sgn * pn * sn[e]) * osc;
      }
      bf16_t* dst;
      if (nt < 4) dst = p.qA + (size_t)(tok0 + row) * 512 + nt * 128 + c8 * 8;
      else dst = p.kA + ((size_t)(b * 2 + (c8 >> 3)) * PALL + pall0 + row) * 64 + d0;
      *(uint4*)dst = pack8(o);
    }
  } else {
    bf16_t* base;
    int ld, cofs;
    float osc = 1.f;
    if (nt <= 7) { base = p.qB; ld = 256; cofs = (nt - 6) * 128; osc = 0.125f; }
    else if (nt <= 9) { base = p.kB; ld = 256; cofs = (nt - 8) * 128; }
    else if (nt <= 17) { base = p.rB; ld = 512; cofs = (nt - 14) * 128; }
    else if (nt <= 21) { base = p.qC; ld = 512; cofs = (nt - 18) * 128; osc = QSCALE; }
    else { base = p.kC; ld = 512; cofs = (nt - 22) * 128; }
    const int c8 = tid & 15, rb = tid >> 4;
    float bs[8];
    {
      const float4 t0 = *(const float4*)(bias + srcc0 + c8 * 8), t1 = *(const float4*)(bias + srcc0 + c8 * 8 + 4);
      bs[0] = t0.x; bs[1] = t0.y; bs[2] = t0.z; bs[3] = t0.w; bs[4] = t1.x; bs[5] = t1.y; bs[6] = t1.z; bs[7] = t1.w;
    }
#pragma unroll
    for (int ps = 0; ps < 8; ++ps) {
      const int row = ps * 16 + rb;
      float v[8];
      lds_read8(sC + row * LDC + c8 * 8, v);
#pragma unroll
      for (int e = 0; e < 8; ++e) v[e] = (v[e] + bs[e]) * osc;
      *(uint4*)(base + (size_t)(tok0 + row) * ld + cofs + c8 * 8) = pack8(v);
    }
  }
}

__device__ __forceinline__ void gate_epilogue(PRef p, int layer, int mt, int nt, const float* sC, int tid) {
  const float* bias = p.b_in + layer * NIN_SRC + 3872 + nt * 128;
  const int c8 = tid & 15, rb = tid >> 4;
  float bs[8];
  {
    const float4 t0 = *(const float4*)(bias + c8 * 8), t1 = *(const float4*)(bias + c8 * 8 + 4);
    bs[0] = t0.x; bs[1] = t0.y; bs[2] = t0.z; bs[3] = t0.w; bs[4] = t1.x; bs[5] = t1.y; bs[6] = t1.z; bs[7] = t1.w;
  }
#pragma unroll
  for (int ps = 0; ps < 8; ++ps) {
    const int row = ps * 16 + rb;
    float v[8];
    lds_read8(sC + row * LDC + c8 * 8, v);
#pragma unroll
    for (int e = 0; e < 8; ++e) v[e] = sigmoidf_(v[e] + bs[e]);
    *(uint4*)(p.G + (size_t)(mt * 128 + row) * 3072 + nt * 128 + c8 * 8) = pack8(v);
  }
}
__device__ __forceinline__ void phase_inproj(PRef p, int layer, char* smem_all) {
  LAS3 unsigned char* lds = (LAS3 unsigned char*)smem_all;
  constexpr int NSTREAM_IN = 68 * 12, NSTREAM = NSTREAM_IN + 64 * 12, NOLD = 68 * 3;
  {
    unsigned voffA[2];
    pg8::voff_contig(D, voffA);
    const int G = (int)gridDim.x, c = (int)__builtin_amdgcn_workgroup_id_x();
    const int rem = NSTREAM % G;
    for (int j = (c - rem + G) % G; j < NOLD; j += G) {
      int pm, pn;
      pg8::unit_map(j, 68, 3, pm, pn);
      pg8::f32x4 acc[2][2][4][2];
      const char* a0 = (const char*)(p.h + (size_t)pm * 256 * D);
      pg8::gemm_unit(lds, a0, a0 + (size_t)128 * D * 2, voffA, voffA, (const char*)(p.wt_in + (size_t)pn * 256 * D), D, acc);
      asm volatile("" : "+s"(pm), "+s"(pn));
      PRef pe = params_view();
      const int etid = tid_();
      const int half = half_();
      float* sCh = (float*)(smem_all + half * SMEM_BYTES);
      pg8::acc_to_lds<0, 0>(acc, inproj_transposed(2 * pn), (float*)smem_all);
      pg8::acc_to_lds<0, 1>(acc, inproj_transposed(2 * pn + 1), (float*)(smem_all + SMEM_BYTES));
      __syncthreads();
      inproj_epilogue(pe, layer, 2 * pm, 2 * pn + half, sCh, etid);
      __syncthreads();
      pg8::acc_to_lds<1, 0>(acc, inproj_transposed(2 * pn), (float*)smem_all);
      pg8::acc_to_lds<1, 1>(acc, inproj_transposed(2 * pn + 1), (float*)(smem_all + SMEM_BYTES));
      __syncthreads();
      inproj_epilogue(pe, layer, 2 * pm + 1, 2 * pn + half, sCh, etid);
      __syncthreads();
    }
  }
  {
    PRef pg = params_view();
    const bf16_t* hbase = pg.h;
    const bf16_t* win = pg.wt_in;
    const bf16_t* wg = pg.wt_gate;
    const float* bias = pg.b_in + layer * NIN_SRC;
    bf16_t* gbase = pg.G;
    pg8::gemm_stream<true>(lds, D,
      [&](int ui, pg8::UnitAB& u) {
        const int s = pg8::unit_linear(ui);
        int pm, pn;
        if (s < NSTREAM_IN) {
          pg8::unit_map(s, 68, 12, pm, pn);
          pn += 3;
          const char* hr = (const char*)(hbase + (size_t)pm * 256 * D);
          const char* wr_ = (const char*)(win + (size_t)pn * 256 * D);
          const bool T = (pn == 5) || (pn == 6) || (pn >= 13);
          u.a = T ? wr_ : hr;
          u.b = T ? hr : wr_;
          return true;
        }
        if (!pg8::unit_map(s - NSTREAM_IN, 64, 12, pm, pn)) return false;
        u.a = (const char*)(hbase + (size_t)pm * 256 * D);
        u.b = (const char*)(wg + (size_t)pn * 256 * D);
        return true;
      },
      [&](int ui, const pg8::f32x4 (&acc)[2][2][4][2]) {
        const int s = pg8::unit_linear(ui);
        int lt = __builtin_amdgcn_workitem_id_x();
        asm volatile("" : "+v"(lt));
        const int wc = (lt >> 6) & 3, wr = lt >> 8, fr = lt & 15, fq = (lt & 63) >> 4;
        const int cbase = 32 * wc + 8 * fq;
        int pm, pn;
        if (s >= NSTREAM_IN) {
          pg8::unit_map(s - NSTREAM_IN, 64, 12, pm, pn);
          const float* gb = bias + 3872 + pn * 256;
          bf16_t* gdst = gbase + (size_t)pm * 256 * 3072 + pn * 256;
          const float4 ba0 = *(const float4*)(gb + cbase), ba1 = *(const float4*)(gb + cbase + 4);
          const float4 bb0 = *(const float4*)(gb + 128 + cbase), bb1 = *(const float4*)(gb + 128 + cbase + 4);
          pg8::for_each_piece(acc, [&](int row, int col, float (&v)[8]) {
            const float4 b0 = col < 128 ? ba0 : bb0, b1 = col < 128 ? ba1 : bb1;
            v[0] = sigmoidf_(v[0] + b0.x); v[1] = sigmoidf_(v[1] + b0.y); v[2] = sigmoidf_(v[2] + b0.z); v[3] = sigmoidf_(v[3] + b0.w);
            v[4] = sigmoidf_(v[4] + b1.x); v[5] = sigmoidf_(v[5] + b1.y); v[6] = sigmoidf_(v[6] + b1.z); v[7] = sigmoidf_(v[7] + b1.w);
            st_nt16(gdst + (size_t)row * 3072 + col, pack8(v));
          });
          return;
        }
        pg8::unit_map(s, 68, 12, pm, pn);
        pn += 3;
        const float* bsrc = bias + (pn < 9 ? pn * 256 : pn * 256 + 32);
        const bool T = (pn == 5) || (pn == 6) || (pn >= 13);
        if (!T) {
          bf16_t* base; int ld, cofs0; float osc = 1.f;
          if (pn == 3) { base = pg.qB; ld = 256; cofs0 = 0; osc = 0.125f; }
          else if (pn == 4) { base = pg.kB; ld = 256; cofs0 = 0; }
          else if (pn <= 8) { base = pg.rB; ld = 512; cofs0 = (pn - 7) * 256; }
          else if (pn <= 10) { base = pg.qC; ld = 512; cofs0 = (pn - 9) * 256; osc = QSCALE; }
          else { base = pg.kC; ld = 512; cofs0 = (pn - 11) * 256; }
          const float4 ba0 = *(const float4*)(bsrc + cbase), ba1 = *(const float4*)(bsrc + cbase + 4);
          const float4 bb0 = *(const float4*)(bsrc + 128 + cbase), bb1 = *(const float4*)(bsrc + 128 + cbase + 4);
          bf16_t* d0 = base + (size_t)pm * 256 * ld + cofs0;
          pg8::for_each_piece(acc, [&](int row, int col, float (&v)[8]) {
            const float4 b0 = col < 128 ? ba0 : bb0, b1 = col < 128 ? ba1 : bb1;
            v[0] = (v[0] + b0.x) * osc; v[1] = (v[1] + b0.y) * osc; v[2] = (v[2] + b0.z) * osc; v[3] = (v[3] + b0.w) * osc;
            v[4] = (v[4] + b1.x) * osc; v[5] = (v[5] + b1.y) * osc; v[6] = (v[6] + b1.z) * osc; v[7] = (v[7] + b1.w) * osc;
            st_nt16(d0 + (size_t)row * ld + col, pack8(v));
          });
        } else {
          bf16_t* tb; int f0;
          if (pn <= 6) { tb = pg.vBT; f0 = (pn - 5) * 256; } else { tb = pg.vCT; f0 = (pn - 13) * 256; }
          const int tok0 = pm * 256;
          int b, pall0;
          if (tok0 < TLAT) { b = tok0 >> 12; pall0 = 256 + (tok0 & 4095); } else { const int ci = tok0 - TLAT; b = ci >> 8; pall0 = ci & 255; }
          bf16_t* d0 = tb + (size_t)(b * 512 + f0) * PALL + pall0;
          const int rbase = 64 * wr + fr;
          float bv[2][4];
#pragma unroll
          for (int ai = 0; ai < 2; ++ai)
#pragma unroll
            for (int m = 0; m < 4; ++m) bv[ai][m] = bsrc[128 * ai + rbase + 16 * m];
#pragma unroll
          for (int ai = 0; ai < 2; ++ai)
#pragma unroll
            for (int m = 0; m < 4; ++m)
#pragma unroll
              for (int bj = 0; bj < 2; ++bj) {
                const pg8::f32x4 x0 = acc[ai][bj][m][0], x1 = acc[ai][bj][m][1];
                const float bb = bv[ai][m];
                float v[8] = {x0[0] + bb, x0[1] + bb, x0[2] + bb, x0[3] + bb, x1[0] + bb, x1[1] + bb, x1[2] + bb, x1[3] + bb};
                st_nt16(d0 + (size_t)(128 * ai + rbase + 16 * m) * PALL + 128 * bj + cbase, pack8(v));
              }
        }
      });
  }
  {
    const int vtid = tid_();
    char* smem = smem_all + half_() * SMEM_BYTES;
    float* sC = (float*)smem;
    const int lane = vtid & 63, w = vtid >> 6, wr = w >> 1, wc = w & 1, r = lane & 31, hh = lane >> 5;
    for (int mt = bid_(); mt < 136; mt += vgrid_()) {
      f32x16 acc[2][1];
      acc[0][0] = zero16();
      acc[1][0] = zero16();
      gemm_mainloop<1>(rows_contig(p.h + (size_t)mt * 128 * D, D), rows_contig(p.wt_in + (size_t)3840 * D, D), 16, acc, smem);
#pragma unroll
      for (int i2 = 0; i2 < 2; ++i2)
#pragma unroll
        for (int g = 0; g < 16; ++g) {
          int row = wr * 64 + i2 * 32 + (g & 3) + 8 * (g >> 2) + 4 * hh, col = wc * 32 + r;
          sC[row * LDC + col] = acc[i2][0][g];
        }
      __syncthreads();
      for (int i2 = vtid; i2 < 128 * 32; i2 += 256) {
        int row = i2 >> 5, col = i2 & 31;
        p.aB[(size_t)(mt * 128 + row) * 32 + col] = sC[row * LDC + col] + p.b_in[layer * NIN_SRC + 2304 + col];
      }
      __syncthreads();
    }
  }
}

__device__ __forceinline__ void merge_tiles(PRef p, int layer, char* smem, int mt0, int nmt) {
  float* sC = (float*)smem;
  const int tid = tid_(), lane = tid & 63, w = tid >> 6, wr = w >> 1, wc = w & 1, r = lane & 31, hh = lane >> 5;
  const float* bias = p.b_in + layer * NIN_SRC + 3872;
  const int nrounds = xcd_rounds(smem, nmt, 16);
  for (int rd = 0; rd < nrounds; ++rd) {
    int mt, nt;
    if (!xcd_tile(smem, rd, nmt, 16, mt, nt)) continue;
    mt += mt0;
    f32x16 tot[2][1];
    tot[0][0] = zero16();
    tot[1][0] = zero16();
#pragma unroll 1
    for (int br = 0; br < 3; ++br) {
      f32x16 acc[2][1];
      acc[0][0] = zero16();
      acc[1][0] = zero16();
      gemm_mainloop<1>(rows_contig(p.h + (size_t)mt * 128 * D, D), rows_contig(p.wt_gate + (size_t)(br * 1024 + nt * 64) * D, D), 16, acc, smem);
      unsigned sg[2][8];
      {
        float bv = bias[br * 1024 + nt * 64 + wc * 32 + r];
#pragma unroll
        for (int i = 0; i < 2; ++i)
#pragma unroll
          for (int g = 0; g < 8; ++g)
            sg[i][g] = pack2(sigmoidf_(acc[i][0][2 * g] + bv), sigmoidf_(acc[i][0][2 * g + 1] + bv));
      }
      acc[0][0] = zero16();
      acc[1][0] = zero16();
      const bf16_t* ob = (br == 0 ? p.oA : (br == 1 ? p.oB : p.oC));
      gemm_mainloop<1>(rows_contig(ob + (size_t)mt * 128 * 512, 512), rows_contig(p.wt_br + ((size_t)br * 1024 + nt * 64) * 512, 512), 8, acc, smem);
#pragma unroll
      for (int i = 0; i < 2; ++i)
#pragma unroll
        for (int g = 0; g < 8; ++g) {
          tot[i][0][2 * g] += bf2f((bf16_t)(sg[i][g] & 0xffff)) * acc[i][0][2 * g];
          tot[i][0][2 * g + 1] += bf2f((bf16_t)(sg[i][g] >> 16)) * acc[i][0][2 * g + 1];
        }
    }
#pragma unroll
    for (int i = 0; i < 2; ++i)
#pragma unroll
      for (int g = 0; g < 16; ++g) {
        int row = wr * 64 + i * 32 + (g & 3) + 8 * (g >> 2) + 4 * hh, col = wc * 32 + r;
        sC[row * LDC + col] = tot[i][0][g];
      }
    __syncthreads();
#pragma unroll 1
    for (int ps = 0; ps < 4; ++ps) {
      int row = ps * 32 + (tid >> 3), c8 = tid & 7;
      float v[8];
      lds_read8(sC + row * LDC + c8 * 8, v);
      *(uint4*)(p.m + (size_t)(mt * 128 + row) * D + nt * 64 + c8 * 8) = pack8(v);
    }
    __syncthreads();
  }
}

__device__ __forceinline__ void merge_epilogue(PRef p, int br, int mt, int nt, const float* sC, int tid) {
  const int c8 = tid & 15, rb = tid >> 4;
#pragma unroll 1
  for (int hb = 0; hb < 2; ++hb) {
    u32x4 gv[4], mv[4];
#pragma unroll
    for (int q = 0; q < 4; ++q) {
      const size_t tok = (size_t)(mt * 128 + (hb * 4 + q) * 16 + rb);
      gv[q] = *(const u32x4*)(p.G + tok * 3072 + br * 1024 + nt * 128 + c8 * 8);
      if (br > 0) mv[q] = *(const u32x4*)(p.m + tok * D + nt * 128 + c8 * 8);
    }
#pragma unroll
    for (int q = 0; q < 4; ++q) {
      const int row = (hb * 4 + q) * 16 + rb;
      float v[8];
      lds_read8(sC + row * LDC + c8 * 8, v);
#pragma unroll
      for (int e2 = 0; e2 < 4; ++e2) {
        v[2 * e2] *= bf2f((bf16_t)(gv[q][e2] & 0xffff));
        v[2 * e2 + 1] *= bf2f((bf16_t)(gv[q][e2] >> 16));
        if (br > 0) { v[2 * e2] += bf2f((bf16_t)(mv[q][e2] & 0xffff)); v[2 * e2 + 1] += bf2f((bf16_t)(mv[q][e2] >> 16)); }
      }
      *(uint4*)(p.m + (size_t)(mt * 128 + row) * D + nt * 128 + c8 * 8) = pack8(v);
    }
  }
}
__device__ __forceinline__ void phase_merge(PRef p, int layer, char* smem_all) {
  LAS3 unsigned char* lds = (LAS3 unsigned char*)smem_all;
  {
    PRef pe = params_view();
    const bf16_t* oA = pe.oA; const bf16_t* oB = pe.oB; const bf16_t* oC = pe.oC;
    const bf16_t* wbr = pe.wt_br;
    const bf16_t* Gp = pe.G;
    bf16_t* mp = pe.m;
    pg8::gemm_stream<true>(lds, 512,
      [&](int ui, pg8::UnitAB& u) {
        const int br = ui % 3;
        int pm, pn;
        if (!pg8::unit_map(pg8::unit_linear(ui / 3), 64, 4, pm, pn)) return false;
        const bf16_t* ob = (br == 0 ? oA : (br == 1 ? oB : oC));
        u.a = (const char*)(ob + (size_t)pm * 256 * 512);
        u.b = (const char*)(wbr + ((size_t)br * 1024 + pn * 256) * 512);
        return true;
      },
      [&](int ui, const pg8::f32x4 (&acc)[2][2][4][2]) {
        const int br = ui % 3;
        int pm, pn;
        pg8::unit_map(pg8::unit_linear(ui / 3), 64, 4, pm, pn);
        const bf16_t* gsrc = Gp + (size_t)pm * 256 * 3072 + br * 1024 + pn * 256;
        bf16_t* mdst = mp + (size_t)pm * 256 * D + pn * 256;
        const bool rmw = br > 0;
        int lt = __builtin_amdgcn_workitem_id_x();
        asm volatile("" : "+v"(lt));
        const int wid = lt >> 6, lane = lt & 63, wr = wid >> 2, wc = wid & 3, fr = lane & 15, fq = lane >> 4;
#pragma unroll
        for (int ai = 0; ai < 2; ++ai) {
          u32x4 gq[4][2], mq[4][2];
#pragma unroll
          for (int m = 0; m < 4; ++m)
#pragma unroll
            for (int bj = 0; bj < 2; ++bj) {
              const int row = 128 * ai + 64 * wr + 16 * m + fr, col = 128 * bj + 32 * wc + 8 * fq;
              gq[m][bj] = *(const u32x4*)(gsrc + (size_t)row * 3072 + col);
              if (rmw) mq[m][bj] = *(const u32x4*)(mdst + (size_t)row * D + col);
            }
#pragma unroll
          for (int m = 0; m < 4; ++m)
#pragma unroll
            for (int bj = 0; bj < 2; ++bj) {
              const int row = 128 * ai + 64 * wr + 16 * m + fr, col = 128 * bj + 32 * wc + 8 * fq;
              const pg8::f32x4 a = acc[ai][bj][m][0], b = acc[ai][bj][m][1];
              float v[8] = {a[0], a[1], a[2], a[3], b[0], b[1], b[2], b[3]};
              const u32x4 g = gq[m][bj];
#pragma unroll
              for (int e2 = 0; e2 < 4; ++e2) {
                v[2 * e2] *= bf2f((bf16_t)(g[e2] & 0xffff));
                v[2 * e2 + 1] *= bf2f((bf16_t)(g[e2] >> 16));
                if (rmw) { v[2 * e2] += bf2f((bf16_t)(mq[m][bj][e2] & 0xffff)); v[2 * e2 + 1] += bf2f((bf16_t)(mq[m][bj][e2] >> 16)); }
              }
              *(uint4*)(mdst + (size_t)row * D + col) = pack8(v);
            }
        }
      });
  }
  if (layer == 0) merge_tiles(p, layer, smem_all + half_() * SMEM_BYTES, 128, 8);
}

__device__ __forceinline__ void outproj_epilogue(PRef p, int layer, int mt, int nt, const float* sC, int tid) {
  const int tok0 = mt * 128;
  const float* g1 = p.mod + ((size_t)layer * 5 + tok_modrow(tok0)) * NMOD + 2048 + nt * 128;
  const int c8 = tid & 15, rb = tid >> 4;
  const float4 ga = *(const float4*)(g1 + c8 * 8), gb = *(const float4*)(g1 + c8 * 8 + 4);
#pragma unroll 1
  for (int hb = 0; hb < 2; ++hb) {
    float4 x0[4], x1[4];
#pragma unroll
    for (int q = 0; q < 4; ++q) {
      const int tok = tok0 + (hb * 4 + q) * 16 + rb;
      const float* xp;
      if (layer == 0) xp = tok < TLAT ? p.x + (size_t)tok * D : p.ctx + (size_t)(tok - TLAT) * D;
      else xp = p.xres + (size_t)tok * D;
      xp += nt * 128 + c8 * 8;
      x0[q] = *(const float4*)xp; x1[q] = *(const float4*)(xp + 4);
    }
#pragma unroll
    for (int q = 0; q < 4; ++q) {
      const int row = (hb * 4 + q) * 16 + rb;
      float v[8];
      lds_read8(sC + row * LDC + c8 * 8, v);
      float4 o0 = make_float4(ALPHA * x0[q].x + ga.x * v[0], ALPHA * x0[q].y + ga.y * v[1], ALPHA * x0[q].z + ga.z * v[2], ALPHA * x0[q].w + ga.w * v[3]);
      float4 o1 = make_float4(ALPHA * x1[q].x + gb.x * v[4], ALPHA * x1[q].y + gb.y * v[5], ALPHA * x1[q].z + gb.z * v[6], ALPHA * x1[q].w + gb.w * v[7]);
      float* op = p.xres + (size_t)(tok0 + row) * D + nt * 128 + c8 * 8;
      *(float4*)op = o0;
      *(float4*)(op + 4) = o1;
    }
  }
}
__device__ __forceinline__ void phase_outproj(PRef p, int layer, char* smem_all) {
  LAS3 unsigned char* lds = (LAS3 unsigned char*)smem_all;
  unsigned voffA[2];
  pg8::voff_contig(D, voffA);
  for (int i = 0;; ++i) {
    int pm, pn;
    if (!pg8::unit_map(pg8::unit_linear(i), 64, 4, pm, pn)) break;
    pg8::f32x4 acc[2][2][4][2];
    const char* a0 = (const char*)(p.m + (size_t)pm * 256 * D);
    pg8::gemm_unit(lds, a0, a0 + (size_t)128 * D * 2, voffA, voffA, (const char*)(p.wt_out + (size_t)pn * 256 * D), D, acc);
    asm volatile("" : "+s"(pm), "+s"(pn));
    PRef pe = params_view();
    const int etid = tid_();
    const int half = half_();
    float* sCh = (float*)(smem_all + half * SMEM_BYTES);
    pg8::acc_to_lds<0, 0>(acc, false, (float*)smem_all);
    pg8::acc_to_lds<0, 1>(acc, false, (float*)(smem_all + SMEM_BYTES));
    __syncthreads();
    outproj_epilogue(pe, layer, 2 * pm, 2 * pn + half, sCh, etid);
    __syncthreads();
    pg8::acc_to_lds<1, 0>(acc, false, (float*)smem_all);
    pg8::acc_to_lds<1, 1>(acc, false, (float*)(smem_all + SMEM_BYTES));
    __syncthreads();
    outproj_epilogue(pe, layer, 2 * pm + 1, 2 * pn + half, sCh, etid);
    __syncthreads();
  }
  if (layer == 0) {
    char* smem = smem_all + half_() * SMEM_BYTES;
    float* sC = (float*)smem;
    const int tid = tid_();
    for (int item = bid_(); item < 64; item += vgrid_()) {
      const int mt = 128 + (item >> 3), nt = item & 7;
      f32x16 acc[2][2];
#pragma unroll
      for (int i = 0; i < 2; ++i)
#pragma unroll
        for (int j = 0; j < 2; ++j) acc[i][j] = zero16();
      gemm_mainloop<2>(rows_contig(p.m + (size_t)mt * 128 * D, D), rows_contig(p.wt_out + (size_t)nt * 128 * D, D), 16, acc, smem);
      acc_to_lds(acc, sC);
      __syncthreads();
      outproj_epilogue(p, layer, mt, nt, sC, tid);
      __syncthreads();
    }
  }
}

__device__ __forceinline__ bool moe_block_lookup(PRef p, int mb, int& e, int& lb, int& cnt_e) {
  int start = 0;
  for (int i = 0; i < 32; ++i) {
    int c = p.cnt[i];
    int nb = (c + MOE_BLK - 1) / MOE_BLK;
    if (mb < start + nb) { e = i; lb = mb - start; cnt_e = c; return true; }
    start += nb;
  }
  return false;
}
__device__ __forceinline__ void moe1_epilogue(PRef p, int slot0, int nt, const float* sC, int tid) {
#pragma unroll
  for (int ps = 0; ps < 8; ++ps) {
    const int row = ps * 16 + (tid >> 4), c4 = (tid & 15) * 4;
    const float4 a = *(const float4*)(sC + row * LDC + c4);
    const float4 b = *(const float4*)(sC + row * LDC + 64 + c4);
    const uint2 o = make_uint2(pack2(siluf(a.x) * b.x, siluf(a.y) * b.y), pack2(siluf(a.z) * b.z, siluf(a.w) * b.w));
    *(uint2*)(p.act + (size_t)(slot0 + row) * 512 + nt * 64 + c4) = o;
  }
}
__device__ __forceinline__ void moe2_epilogue(PRef p, int slot0, int nt, const float* sC, int tid) {
#pragma unroll
  for (int ps = 0; ps < 8; ++ps) {
    const int row = ps * 16 + (tid >> 4), c8 = tid & 15;
    float v[8];
    lds_read8(sC + row * LDC + c8 * 8, v);
    *(uint4*)(p.ysl + (size_t)(slot0 + row) * D + nt * 128 + c8 * 8) = pack8(v);
  }
}
__device__ __forceinline__ void phase_moe1(PRef p, int layer, char* smem_all) {
  LAS3 unsigned char* lds = (LAS3 unsigned char*)smem_all;
  if (__builtin_amdgcn_workgroup_id_x() == 0 && __builtin_amdgcn_workitem_id_x() == 0) {
    int start = 0;
    for (int i = 0; i < 32; ++i) { p.estart[i] = start; start += (p.cnt[i] + MOE_BLK - 1) / MOE_BLK; }
  }
  for (int i = 0;; ++i) {
    const int L = pg8::unit_linear(i);
    int mb = L >> 2, pn = L & 3;
    if (mb >= MAX_MBLK) break;
    int e, lb, ce;
    if (!moe_block_lookup(p, mb, e, lb, ce)) break;
    unsigned voffA0[2], voffA1[2];
    {
      int tid = __builtin_amdgcn_workitem_id_x();
      asm volatile("" : "+v"(tid));
#pragma unroll
      for (int q = 0; q < 2; ++q) {
        int R, C;
        pg8::stage_rc(tid * 16 + q * 8192, R, C);
        const int s0 = lb * MOE_BLK + R, s1 = s0 + 128;
        const int t0 = s0 < ce ? p.list[e * MOE_CAP + s0] : 0;
        const int t1 = s1 < ce ? p.list[e * MOE_CAP + s1] : 0;
        voffA0[q] = (unsigned)(t0 * D + C) * 2u;
        voffA1[q] = (unsigned)(t1 * D + C) * 2u;
      }
    }
    pg8::f32x4 acc[2][2][4][2];
    pg8::gemm_unit(lds, (const char*)p.h2, (const char*)p.h2, voffA0, voffA1, (const char*)(p.wt_13 + ((size_t)e * 1024 + pn * 256) * D), D, acc);
    asm volatile("" : "+s"(mb), "+s"(pn));
    PRef pe = params_view();
    const int etid = tid_();
    const int half = half_();
    float* sCh = (float*)(smem_all + half * SMEM_BYTES);
    pg8::acc_to_lds<0, 0>(acc, false, (float*)smem_all);
    pg8::acc_to_lds<0, 1>(acc, false, (float*)(smem_all + SMEM_BYTES));
    __syncthreads();
    moe1_epilogue(pe, mb * MOE_BLK, 2 * pn + half, sCh, etid);
    __syncthreads();
    pg8::acc_to_lds<1, 0>(acc, false, (float*)smem_all);
    pg8::acc_to_lds<1, 1>(acc, false, (float*)(smem_all + SMEM_BYTES));
    __syncthreads();
    moe1_epilogue(pe, mb * MOE_BLK + 128, 2 * pn + half, sCh, etid);
    __syncthreads();
  }
}
__device__ __forceinline__ void phase_moe2(PRef p, int layer, char* smem_all) {
  LAS3 unsigned char* lds = (LAS3 unsigned char*)smem_all;
  const bf16_t* actp = p.act;
  const bf16_t* w2p = p.wt_2;
  bf16_t* yp = p.ysl;
  const int* cntp = p.cnt;
  auto lookup = [&](int mb, int& e) {
    int start = 0;
    for (int i = 0; i < 32; ++i) {
      const int nb = (cntp[i] + MOE_BLK - 1) / MOE_BLK;
      if (mb < start + nb) { e = i; return true; }
      start += nb;
    }
    return false;
  };
  pg8::gemm_stream<true>(lds, 512,
    [&](int ui, pg8::UnitAB& u) {
      const int L = pg8::unit_linear(ui);
      const int mb = L >> 2, pn = L & 3;
      int e;
      if (mb >= MAX_MBLK || !lookup(mb, e)) return false;
      u.a = (const char*)(actp + (size_t)mb * MOE_BLK * 512);
      u.b = (const char*)(w2p + ((size_t)e * 1024 + pn * 256) * 512);
      return true;
    },
    [&](int ui, const pg8::f32x4 (&acc)[2][2][4][2]) {
      const int L = pg8::unit_linear(ui);
      const int mb = L >> 2, pn = L & 3;
      bf16_t* ydst = yp + (size_t)mb * MOE_BLK * D + pn * 256;
      pg8::for_each_piece(acc, [&](int row, int col, float (&v)[8]) { st_nt16(ydst + (size_t)row * D + col, pack8(v)); });
    });
}

struct AttnState { f32x16 negm; f32x16 L; };
__device__ __forceinline__ void attn_qk(const char* sK, const bf16x8 (&bq)[4], const f32x16& negm, f32x16 (&S)[2], int r, int hh) {
  const int pr = 16 * (r >> 4) + 8 * ((r >> 2) & 1) + 4 * ((r >> 3) & 1) + (r & 3);
  const char* kp = sK + pr * 128;
#pragma unroll
  for (int s = 0; s < 4; ++s) {
    const int co = ((2 * s + hh) ^ ((pr >> 1) & 7)) << 4;
    bf16x8 a0 = *(const bf16x8*)(kp + co);
    bf16x8 a1 = *(const bf16x8*)(kp + 4096 + co);
    if (s == 0) { S[0] = mfma32(a0, bq[0], negm); S[1] = mfma32(a1, bq[0], negm); }
    else { S[0] = mfma32(a0, bq[s], S[0]); S[1] = mfma32(a1, bq[s], S[1]); }
  }
}
template <class MaskF>
__device__ __forceinline__ float attn_softmax_pv(f32x16 (&S)[2], const char* sV, f32x16 (&O)[2], AttnState& st, bf16x8 ones, int r, int hh,
                                                 MaskF maskf, const bool FIRST) {
  maskf(S);
  float mx = S[0][0];
#pragma unroll
  for (int g = 1; g < 16; ++g) mx = fmaxf(mx, S[0][g]);
#pragma unroll
  for (int g = 0; g < 16; ++g) mx = fmaxf(mx, S[1][g]);
  {
    auto sw = __builtin_amdgcn_permlane32_swap(__float_as_uint(mx), __float_as_uint(mx), false, false);
    mx = fmaxf(__uint_as_float(sw[0]), __uint_as_float(sw[1]));
  }
  float dshift = 0.f;
  if (FIRST || __any(mx > 8.f)) {
    const float d = FIRST ? mx : fmaxf(mx, 0.f);
    dshift = d;
    const float alpha = __builtin_amdgcn_exp2f(-d);
#pragma unroll
    for (int g = 0; g < 16; ++g) {
      st.negm[g] -= d;
      S[0][g] -= d; S[1][g] -= d;
      O[0][g] *= alpha; O[1][g] *= alpha;
    }
    st.L[0] *= alpha;
  }
#pragma unroll
  for (int kb = 0; kb < 2; ++kb)
#pragma unroll
    for (int g = 0; g < 16; ++g) S[kb][g] = __builtin_amdgcn_exp2f(S[kb][g]);
  const char* vp = sV + r * 128;
  const int vsw = (r >> 1) & 7;
#pragma unroll
  for (int sp = 0; sp < 4; ++sp) {
    const int sb_ = sp >> 1, so_ = 8 * (sp & 1);
    u32x4 bpu = {pack2(S[sb_][so_], S[sb_][so_ + 1]), pack2(S[sb_][so_ + 2], S[sb_][so_ + 3]), pack2(S[sb_][so_ + 4], S[sb_][so_ + 5]),
                 pack2(S[sb_][so_ + 6], S[sb_][so_ + 7])};
    bf16x8 bp = __builtin_bit_cast(bf16x8, bpu);
#pragma unroll
    for (int db = 0; db < 2; ++db) {
      bf16x8 av = *(const bf16x8*)(vp + db * 4096 + (((2 * sp + hh) ^ vsw) << 4));
      O[db] = mfma32(av, bp, O[db]);
    }
    st.L = mfma32(ones, bp, st.L);
  }
  return dshift;
}
template <class MaskF>
__device__ __forceinline__ void attn_tile(const char* sK, const char* sV, const bf16x8 (&bq)[4], f32x16 (&O)[2], AttnState& st, bf16x8 ones,
                                          int r, int hh, MaskF maskf, const bool FIRST) {
  f32x16 S[2];
  attn_qk(sK, bq, st.negm, S, r, hh);
  (void)attn_softmax_pv(S, sV, O, st, ones, r, hh, maskf, FIRST);
}
__device__ __forceinline__ void attn_state_init(AttnState& st, bf16x8& ones, int r) {
  st.negm = zero16();
  st.L = zero16();
  const short one = (r == 0) ? (short)0x3F80 : (short)0;
  ones = (bf16x8){one, one, one, one, one, one, one, one};
}

__device__ __forceinline__ void attn_stage(const bf16_t* kg, size_t kstride, const bf16_t* vg, size_t vstride, char* sKd, char* sVd, int tid) {
  const int row = tid >> 3, u = ((tid & 7) ^ ((tid >> 4) & 7)) * 8;
#pragma unroll
  for (int i = 0; i < 2; ++i) {
    __builtin_amdgcn_global_load_lds((const unsigned*)(kg + (size_t)(row + 32 * i) * kstride + u), (LAS3 unsigned*)(sKd + tid * 16 + i * 4096), 16, 0, 0);
    __builtin_amdgcn_global_load_lds((const unsigned*)(vg + (size_t)(row + 32 * i) * vstride + u), (LAS3 unsigned*)(sVd + tid * 16 + i * 4096), 16, 0, 0);
  }
}
struct NoMask { __device__ __forceinline__ void operator()(f32x16 (&)[2]) const {} };

__device__ __forceinline__ void attn_write_out(bf16_t* dst  , const f32x16 (&O)[2], float l, int hh) {
  float lt = l + __shfl_xor(l, 32);
  float inv = 1.f / lt;
#pragma unroll
  for (int db = 0; db < 2; ++db)
#pragma unroll
    for (int g4 = 0; g4 < 4; ++g4) {
      uint2 o = make_uint2(pack2(O[db][4 * g4] * inv, O[db][4 * g4 + 1] * inv), pack2(O[db][4 * g4 + 2] * inv, O[db][4 * g4 + 3] * inv));
      *(uint2*)(dst + 32 * db + 8 * g4 + 4 * hh) = o;
    }
}

__device__ __forceinline__ void phase_attnA(PRef p, int layer, char* smem_all) {
  int tid = __builtin_amdgcn_workitem_id_x();
  asm volatile("" : "+v"(tid));
  const int lane = tid & 63, w8 = tid >> 6, w = w8 & 3, qsub = w8 >> 2, r = lane & 31, hh = lane >> 5;
  char* sK = smem_all;
  char* sV = smem_all + 32768;
  const int nitems = layer == 0 ? 544 : 512;
  const int G = (int)gridDim.x;
  for (int item = (int)__builtin_amdgcn_workgroup_id_x(); item < nitems; item += G) {
    int b, kvh, qtok0, nkt;
    if (item < 512) { b = item >> 7; kvh = (item >> 6) & 1; qtok0 = b * 4096 + (item & 63) * 64 + qsub * 32; nkt = 68; }
    else { int it = item - 512; b = it >> 3; kvh = (it >> 2) & 1; qtok0 = TLAT + b * 256 + (it & 3) * 64 + qsub * 32; nkt = 4; }
    const int head = kvh * 4 + w;
    bf16x8 bq[4];
    {
      const bf16_t* qp = p.qA + (size_t)(qtok0 + r) * 512 + head * 64 + 8 * hh;
#pragma unroll
      for (int s = 0; s < 4; ++s) bq[s] = *(const bf16x8*)(qp + 16 * s);
    }
    const bf16_t* kbase = p.kA + (size_t)(b * 2 + kvh) * PALL * 64;
    const bf16_t* vbase = p.vAT + (size_t)(b * 2 + kvh) * 64 * PALL;
    const int srow = tid >> 3, su = ((tid & 7) ^ ((tid >> 4) & 7)) * 8;
    const bf16_t* kg = kbase + (size_t)srow * 64 + su;
    const bf16_t* vg = vbase + (size_t)srow * PALL + su;
    f32x16 O[2];
    O[0] = zero16();
    O[1] = zero16();
    AttnState st;
    bf16x8 ones;
    attn_state_init(st, ones, r);
    __syncthreads();
#define ATT_STAGE(KT)                                                                                                                     \
  {                                                                                                                                       \
    __builtin_amdgcn_global_load_lds((const unsigned*)(kg + (size_t)(KT) * 4096), (LAS3 unsigned*)(sK + ((KT) & 3) * 8192 + tid * 16), 16, 0, 0); \
    __builtin_amdgcn_global_load_lds((const unsigned*)(vg + (KT) * 64), (LAS3 unsigned*)(sV + ((KT) & 3) * 8192 + tid * 16), 16, 0, 0);           \
  }
    ATT_STAGE(0);
    ATT_STAGE(1);
    dma_sync();
    f32x16 Sa[2], Sb[2];
    attn_qk(sK, bq, st.negm, Sa, r, hh);
#define ATT_STEP(KT, CUR, NXT)                                                                                              \
  {                                                                                                                         \
    if ((KT) > 0) dma_sync();                \
    if ((KT) + 2 < nkt) ATT_STAGE((KT) + 2);                                                                                \
    if ((KT) + 1 < nkt) attn_qk(sK + (((KT) + 1) & 3) * 8192, bq, st.negm, NXT, r, hh);                                     \
    const float d_ = attn_softmax_pv(CUR, sV + ((KT) & 3) * 8192, O, st, ones, r, hh, NoMask(), (KT) == 0);                 \
    if ((KT) + 1 < nkt && __any(d_ != 0.f)) {      \
      _Pragma("unroll") for (int g = 0; g < 16; ++g) { NXT[0][g] -= d_; NXT[1][g] -= d_; }                                  \
    }                                                                                                                       \
  }
    for (int kt = 0; kt < nkt; kt += 2) {
      ATT_STEP(kt, Sa, Sb);
      ATT_STEP(kt + 1, Sb, Sa);
    }
#undef ATT_STEP
#undef ATT_STAGE
    attn_write_out(p.oA + (size_t)(qtok0 + r) * 512 + head * 64, O, st.L[0], hh);
  }
}

struct NaMask {
  const float* bp;
  int cofs;
  bool on;
  __device__ __forceinline__ void operator()(f32x16 (&S)[2]) const {
    if (!on) return;
    f32x16 bv[2];
#pragma unroll
    for (int kb = 0; kb < 2; ++kb)
#pragma unroll
      for (int g = 0; g < 16; ++g) bv[kb][g] = bp[32 * kb + 16 * (g >> 3) + 4 * ((g >> 2) & 1) + (g & 3)];
    asm volatile("" : "+v"(bv[0]), "+v"(bv[1]));
#pragma unroll
    for (int kb = 0; kb < 2; ++kb)
#pragma unroll
      for (int g = 0; g < 16; ++g) {
        const int cc = 32 * kb + 16 * (g >> 3) + 4 * ((g >> 2) & 1) + (g & 3);
        const bool valid = (unsigned)(cc + cofs) < 16u;
        S[kb][g] = valid ? S[kb][g] + bv[kb][g] : -1e30f;
      }
  }
};
__device__ __forceinline__ void phase_na(PRef p, int layer, char* smem) {
  const int tid = tid_(), lane = tid & 63, w = tid >> 6, r = lane & 31, hh = lane >> 5;
  char* sK = smem;
  char* sV = smem + 32768;
  float* sBias = (float*)(smem + 65536);
  const int nitems = layer == 0 ? 1088 : 1024;
  const int set = w >> 1, qhalf = w & 1;
  for (int item = bid_(); item < nitems; item += vgrid_()) {
    int b, hp, row = 0, rs = 0, qtok0, kt0, kt1;
    if (item < 1024) {
      b = item >> 8; row = (item >> 2) & 63; hp = item & 3;
      rs = row - 4; rs = rs < 0 ? 0 : (rs > 56 ? 56 : rs);
      qtok0 = b * 4096 + row * 64; kt0 = 0; kt1 = 12;
    } else {
      int it = item - 1024;
      b = it >> 4; hp = (it >> 2) & 3;
      qtok0 = TLAT + b * 256 + (it & 3) * 64; kt0 = 8; kt1 = 12;
    }
    const int head = 2 * hp + set;
    __syncthreads();
    for (int i = tid; i < 930; i += 256) {
      int s = i / 465, j = i % 465;
      sBias[i] = p.rpb[((size_t)layer * 8 + 2 * hp + s) * 465 + j] * LOG2E;
    }
    bf16x8 bq[4];
    {
      const bf16_t* qp = p.qC + (size_t)(qtok0 + 32 * qhalf + r) * 512 + head * 64 + 8 * hh;
#pragma unroll
      for (int s = 0; s < 4; ++s) bq[s] = *(const bf16x8*)(qp + 16 * s);
    }
    f32x16 O[2];
    O[0] = zero16();
    O[1] = zero16();
    AttnState st;
    bf16x8 ones;
    attn_state_init(st, ones, r);
#define NA_STAGE(KT, BUF)                                                                                          \
  {                                                                                                                \
    int tokK, pallb;                                                                                               \
    if ((KT) < 8) { tokK = b * 4096 + (rs + (KT)) * 64; pallb = 256 + (rs + (KT)) * 64; }                          \
    else { tokK = TLAT + b * 256 + ((KT) - 8) * 64; pallb = ((KT) - 8) * 64; }                                     \
    _Pragma("unroll") for (int s2 = 0; s2 < 2; ++s2)                                                               \
      attn_stage(p.kC + (size_t)tokK * 512 + (2 * hp + s2) * 64, 512, p.vCT + (size_t)(b * 8 + 2 * hp + s2) * 64 * PALL + pallb, PALL, \
                 sK + (BUF) * 16384 + s2 * 8192, sV + (BUF) * 16384 + s2 * 8192, tid);                             \
  }
    NA_STAGE(kt0, 0);
    for (int kt = kt0; kt < kt1; ++kt) {
      const int cur = (kt - kt0) & 1;
      dma_sync();
      if (kt + 1 < kt1) NA_STAGE(kt + 1, cur ^ 1);
      {
        NaMask mk;
        const int wq = 32 * qhalf + r;
        int cs = wq - 8;
        cs = cs < 0 ? 0 : (cs > 48 ? 48 : cs);
        mk.on = kt < 8;
        mk.bp = sBias + set * 465 + (mk.on ? (rs + kt - row + 7) * 31 : 0) - wq + 15 + 8 * hh;
        mk.cofs = 8 * hh - cs;
        attn_tile(sK + cur * 16384 + set * 8192, sV + cur * 16384 + set * 8192, bq, O, st, ones, r, hh, mk, kt == kt0);
      }
    }
#undef NA_STAGE
    attn_write_out(p.oC + (size_t)(qtok0 + 32 * qhalf + r) * 512 + head * 64, O, st.L[0], hh);
  }
}

__device__ __forceinline__ float log_sigmoidf_(float x) { return fminf(x, 0.f) - __logf(1.f + __expf(-fabsf(x))); }
struct GlaPre { f32x4v a0, a1, a2, a3, wg0, wg1; float bg; };
__device__ __forceinline__ void gla_prep_load(PRef p, int layer, int hd, int dir, int tok0, GlaPre& R) {
  const int tid = tid_(), lane = tid & 63, w = tid >> 6, r = lane & 31, hh = lane >> 5, pb = w >> 1, db = w & 1;
  const float* ap = p.aB + (size_t)(tok0 + 32 * pb + r) * 32 + dir * 16;
  R.a0 = *(const f32x4v*)(ap); R.a1 = *(const f32x4v*)(ap + 4); R.a2 = *(const f32x4v*)(ap + 8); R.a3 = *(const f32x4v*)(ap + 12);
  const float* wp = p.gla_wg + (((size_t)layer * 2 + dir) * 16 + hh) * 256 + hd * 64 + 32 * db + r;
  R.wg0 = (f32x4v){wp[0], wp[2 * 256], wp[4 * 256], wp[6 * 256]};
  R.wg1 = (f32x4v){wp[8 * 256], wp[10 * 256], wp[12 * 256], wp[14 * 256]};
  R.bg = p.gla_bg[((size_t)layer * 2 + dir) * 256 + hd * 64 + 32 * db + r];
}
#define GLA_DPP_ADD(v, ctrl, rmask) v += __builtin_bit_cast(float, __builtin_amdgcn_update_dpp(0, __builtin_bit_cast(int, v), ctrl, rmask, 0xf, false))
__device__ __forceinline__ void gla_prep_compute(const GlaPre& R, int dir, float* sBc) {
  const int tid = tid_(), lane = tid & 63, w = tid >> 6, r = lane & 31, hh = lane >> 5, pb = w >> 1, db = w & 1;
  {
    f32x16 x;
#pragma unroll
    for (int g = 0; g < 16; ++g) x[g] = R.bg;
    const float ae[8] = {R.a0[0], R.a0[2], R.a1[0], R.a1[2], R.a2[0], R.a2[2], R.a3[0], R.a3[2]};
    const float ao[8] = {R.a0[1], R.a0[3], R.a1[1], R.a1[3], R.a2[1], R.a2[3], R.a3[1], R.a3[3]};
    const float wv[8] = {R.wg0[0], R.wg0[1], R.wg0[2], R.wg0[3], R.wg1[0], R.wg1[1], R.wg1[2], R.wg1[3]};
#pragma unroll
    for (int s = 0; s < 8; ++s) x = __builtin_amdgcn_mfma_f32_32x32x2f32(hh ? ao[s] : ae[s], wv[s], x, 0, 0, 0);
#pragma unroll
    for (int g = 0; g < 16; ++g) {
      const int pos = 32 * pb + (g & 3) + 8 * (g >> 2) + 4 * hh;
      sBc[pos * 65 + 32 * db + r] = log_sigmoidf_(x[g]) * (1.f / 16.f);
    }
  }
  __syncthreads();
  {
    const int idx = dir ? 63 - lane : lane;
    float v[16];
#pragma unroll
    for (int dd = 0; dd < 16; ++dd) v[dd] = sBc[idx * 65 + w * 16 + dd];
#pragma unroll
    for (int dd = 0; dd < 16; ++dd) GLA_DPP_ADD(v[dd], 0x111, 0xf);
#pragma unroll
    for (int dd = 0; dd < 16; ++dd) GLA_DPP_ADD(v[dd], 0x112, 0xf);
#pragma unroll
    for (int dd = 0; dd < 16; ++dd) GLA_DPP_ADD(v[dd], 0x114, 0xf);
#pragma unroll
    for (int dd = 0; dd < 16; ++dd) GLA_DPP_ADD(v[dd], 0x118, 0xf);
#pragma unroll
    for (int dd = 0; dd < 16; ++dd) GLA_DPP_ADD(v[dd], 0x142, 0xa);
#pragma unroll
    for (int dd = 0; dd < 16; ++dd) GLA_DPP_ADD(v[dd], 0x143, 0xc);
#pragma unroll
    for (int dd = 0; dd < 16; ++dd) sBc[idx * 65 + w * 16 + dd] = v[dd];
  }
  __syncthreads();
}
__device__ __forceinline__ void chunk_pos(int b, int dir, int c, int& tok0, int& pall0) {
  if (c < 4) { int pc = dir ? 3 - c : c; tok0 = TLAT + b * 256 + pc * 64; pall0 = pc * 64; }
  else { int j = c - 4; int pc = dir ? 63 - j : j; tok0 = b * 4096 + pc * 64; pall0 = 256 + pc * 64; }
}
__device__ __forceinline__ void phase_gla1(PRef p, int layer, char* smem) {
  float* sWg = (float*)smem;
  float* sBc = (float*)(smem + 4096);
  bf16_t* sKt = (bf16_t*)(smem + 20736);
  bf16_t* sVt = (bf16_t*)(smem + 29952);
  const int tid = tid_(), lane = tid & 63, w = tid >> 6, r = lane & 31, hh = lane >> 5;
  for (int item = bid_(); item < 32 * NCHUNK; item += vgrid_()) {
    const int ch = item / NCHUNK, c = item % NCHUNK;
    const int dir = ch & 1, hd = (ch >> 1) & 3, b = ch >> 3;
    int tok0, pall0;
    chunk_pos(b, dir, c, tok0, pall0);
    GlaPre R;
    gla_prep_load(p, layer, hd, dir, tok0, R);
    u32x4 k0, k1, vv0, vv1, vv2, vv3;
    {
      const int pos = tid >> 2, dg = tid & 3;
      const bf16_t* kp = p.kB + (size_t)(tok0 + pos) * 256 + hd * 64 + dg * 16;
      k0 = *(const u32x4*)kp; k1 = *(const u32x4*)(kp + 8);
      const bf16_t* vb = p.vBT + (size_t)(b * 4 + hd) * 128 * PALL + pall0 + (tid & 7) * 8;
      vv0 = *(const u32x4*)(vb + (size_t)(tid >> 3) * PALL);
      vv1 = *(const u32x4*)(vb + (size_t)((tid >> 3) + 32) * PALL);
      vv2 = *(const u32x4*)(vb + (size_t)((tid >> 3) + 64) * PALL);
      vv3 = *(const u32x4*)(vb + (size_t)((tid >> 3) + 96) * PALL);
    }
    __syncthreads();
    gla_prep_compute(R, dir, sBc);
    {
      const int pos = tid >> 2, dg = tid & 3;
      float* bd = p.bcum + (size_t)item * 4096 + pos * 64 + dg * 16;
#pragma unroll
      for (int q4 = 0; q4 < 4; ++q4)
        *(float4*)(bd + 4 * q4) = make_float4(sBc[pos * 65 + dg * 16 + 4 * q4], sBc[pos * 65 + dg * 16 + 4 * q4 + 1], sBc[pos * 65 + dg * 16 + 4 * q4 + 2], sBc[pos * 65 + dg * 16 + 4 * q4 + 3]);
    }
    {
      int pos = tid >> 2, dg = tid & 3;
      unsigned ku[8] = {k0[0], k0[1], k0[2], k0[3], k1[0], k1[1], k1[2], k1[3]};
#pragma unroll
      for (int e = 0; e < 16; ++e) {
        int d = dg * 16 + e;
        float kv = bf2f((bf16_t)((e & 1) ? (ku[e >> 1] >> 16) : (ku[e >> 1] & 0xffff)));
        float bend = sBc[(dir ? 0 : 63) * 65 + d];
        sKt[d * 72 + pos] = f2bf(kv * __expf(bend - sBc[pos * 65 + d]));
      }
      {
        const int dv = tid >> 3, cc = tid & 7;
        *(u32x4*)(sVt + dv * 72 + cc * 8) = vv0;
        *(u32x4*)(sVt + (dv + 32) * 72 + cc * 8) = vv1;
        *(u32x4*)(sVt + (dv + 64) * 72 + cc * 8) = vv2;
        *(u32x4*)(sVt + (dv + 96) * 72 + cc * 8) = vv3;
      }
      if (tid < 64) p.decay[(size_t)item * 64 + tid] = __expf(sBc[(dir ? 0 : 63) * 65 + tid]);
    }
    __syncthreads();
    f32x16 acc[2];
    acc[0] = zero16();
    acc[1] = zero16();
#pragma unroll
    for (int s = 0; s < 4; ++s) {
      bf16x8 a = *(const bf16x8*)(sVt + (32 * w + r) * 72 + 16 * s + 8 * hh);
      bf16x8 b0 = *(const bf16x8*)(sKt + r * 72 + 16 * s + 8 * hh);
      bf16x8 b1 = *(const bf16x8*)(sKt + (32 + r) * 72 + 16 * s + 8 * hh);
      acc[0] = mfma32(b0, a, acc[0]);
      acc[1] = mfma32(b1, a, acc[1]);
    }
    float* dst = p.KVt + (size_t)item * 8192 + (32 * w + r) * 64 + 4 * hh;
#pragma unroll
    for (int jb = 0; jb < 2; ++jb)
#pragma unroll
      for (int g4 = 0; g4 < 4; ++g4)
        *(float4*)(dst + 32 * jb + 8 * g4) = make_float4(acc[jb][4 * g4], acc[jb][4 * g4 + 1], acc[jb][4 * g4 + 2], acc[jb][4 * g4 + 3]);
  }
}
__device__ __forceinline__ void phase_gla2(PRef p) {
  for (int idx = bid_() * 256 + tid_(); idx < 32 * 8192; idx += vgrid_() * 256) {
    const int ch = idx >> 13, e = idx & 8191;
    float S = 0.f;
    const float* kv = p.KVt + (size_t)ch * NCHUNK * 8192 + e;
    const float* dc = p.decay + (size_t)ch * NCHUNK * 64 + (e & 63);
    bf16_t* sp = p.SP + (size_t)ch * NCHUNK * 8192 + e;
#pragma unroll 4
    for (int c = 0; c < NCHUNK; ++c) {
      sp[(size_t)c * 8192] = f2bf(S);
      S = dc[c * 64] * S + kv[(size_t)c * 8192];
    }
  }
}
__device__ __forceinline__ void phase_gla3(PRef p, int layer, char* smem) {
  float* sWg = (float*)smem;
  float* sBc = (float*)(smem + 4096);
  bf16_t* sQ = (bf16_t*)(smem + 20736);
  bf16_t* sK = (bf16_t*)(smem + 29952);
  bf16_t* sVt = (bf16_t*)(smem + 39168);
  float* sRed = (float*)(smem + 57600);
  const int tid = tid_(), lane = tid & 63, w = tid >> 6, r = lane & 31, hh = lane >> 5;
  const int npc = layer == 0 ? 68 : 64;
  const int pr = 16 * (r >> 4) + 8 * ((r >> 2) & 1) + 4 * ((r >> 3) & 1) + (r & 3);
  for (int item = bid_(); item < 16 * npc; item += vgrid_()) {
    const int bh = item / npc;
    const int pca = (layer == 0) ? (item % npc) : (4 + item % npc);
    const int b = bh >> 2, hd = bh & 3;
    int tok0, pall0;
    chunk_pos(b, 0, pca, tok0, pall0);
    f32x16 O[2];
    O[0] = zero16();
    O[1] = zero16();
    const int c0 = pca, c1 = (pca < 4) ? 3 - pca : 4 + (63 - (pca - 4));
    f32x4v bA[4], bB[4];
    u32x4 q0, q1, k0, k1, vv0, vv1, vv2, vv3;
    {
      const int pos = tid >> 2, dg = tid & 3;
      const float* b0p = p.bcum + ((size_t)((b * 4 + hd) * 2 + 0) * NCHUNK + c0) * 4096 + pos * 64 + dg * 16;
      const float* b1p = p.bcum + ((size_t)((b * 4 + hd) * 2 + 1) * NCHUNK + c1) * 4096 + pos * 64 + dg * 16;
#pragma unroll
      for (int q4 = 0; q4 < 4; ++q4) { bA[q4] = *(const f32x4v*)(b0p + 4 * q4); bB[q4] = *(const f32x4v*)(b1p + 4 * q4); }
      const bf16_t* qp = p.qB + (size_t)(tok0 + pos) * 256 + hd * 64 + dg * 16;
      const bf16_t* kp = p.kB + (size_t)(tok0 + pos) * 256 + hd * 64 + dg * 16;
      q0 = *(const u32x4*)qp; q1 = *(const u32x4*)(qp + 8);
      k0 = *(const u32x4*)kp; k1 = *(const u32x4*)(kp + 8);
      const bf16_t* vb = p.vBT + (size_t)(b * 4 + hd) * 128 * PALL + pall0 + (tid & 7) * 8;
      vv0 = *(const u32x4*)(vb + (size_t)(tid >> 3) * PALL);
      vv1 = *(const u32x4*)(vb + (size_t)((tid >> 3) + 32) * PALL);
      vv2 = *(const u32x4*)(vb + (size_t)((tid >> 3) + 64) * PALL);
      vv3 = *(const u32x4*)(vb + (size_t)((tid >> 3) + 96) * PALL);
    }
    __syncthreads();
    {
      const int dv = tid >> 3, cc = tid & 7;
      *(u32x4*)(sVt + dv * 72 + cc * 8) = vv0;
      *(u32x4*)(sVt + (dv + 32) * 72 + cc * 8) = vv1;
      *(u32x4*)(sVt + (dv + 64) * 72 + cc * 8) = vv2;
      *(u32x4*)(sVt + (dv + 96) * 72 + cc * 8) = vv3;
    }
#pragma unroll
    for (int dir = 0; dir < 2; ++dir) {
      if (dir == 1) __syncthreads();
      {
        int pos = tid >> 2, dg = tid & 3;
        unsigned qu[8] = {q0[0], q0[1], q0[2], q0[3], q1[0], q1[1], q1[2], q1[3]};
        unsigned ku[8] = {k0[0], k0[1], k0[2], k0[3], k1[0], k1[1], k1[2], k1[3]};
        unsigned qo[8], ko[8];
#pragma unroll
        for (int e2 = 0; e2 < 8; ++e2) {
          const float b0 = dir ? bB[e2 >> 1][(2 * e2) & 3] : bA[e2 >> 1][(2 * e2) & 3];
          const float b1 = dir ? bB[e2 >> 1][(2 * e2 + 1) & 3] : bA[e2 >> 1][(2 * e2 + 1) & 3];
          const float ea0 = __expf(b0), ea1 = __expf(b1), ia0 = __builtin_amdgcn_rcpf(ea0), ia1 = __builtin_amdgcn_rcpf(ea1);
          qo[e2] = pack2(bf2f((bf16_t)(qu[e2] & 0xffff)) * ea0, bf2f((bf16_t)(qu[e2] >> 16)) * ea1);
          ko[e2] = pack2(bf2f((bf16_t)(ku[e2] & 0xffff)) * ia0, bf2f((bf16_t)(ku[e2] >> 16)) * ia1);
        }
        *(uint4*)(sQ + pos * 72 + dg * 16) = make_uint4(qo[0], qo[1], qo[2], qo[3]);
        *(uint4*)(sQ + pos * 72 + dg * 16 + 8) = make_uint4(qo[4], qo[5], qo[6], qo[7]);
        *(uint4*)(sK + pos * 72 + dg * 16) = make_uint4(ko[0], ko[1], ko[2], ko[3]);
        *(uint4*)(sK + pos * 72 + dg * 16 + 8) = make_uint4(ko[4], ko[5], ko[6], ko[7]);
      }
      __syncthreads();
      const int c = dir ? c1 : c0;
      const int ch = (b * 4 + hd) * 2 + dir;
      const bf16_t* sp = p.SP + ((size_t)ch * NCHUNK + c) * 8192 + (size_t)(32 * w + r) * 64 + 8 * hh;
      bf16x8 bqf[2][4];
#pragma unroll
      for (int tb = 0; tb < 2; ++tb)
#pragma unroll
        for (int ks = 0; ks < 4; ++ks) bqf[tb][ks] = *(const bf16x8*)(sQ + (32 * tb + r) * 72 + 16 * ks + 8 * hh);
#pragma unroll
      for (int ks = 0; ks < 4; ++ks) {
        bf16x8 a = *(const bf16x8*)(sp + 16 * ks);
        O[0] = mfma32(a, bqf[0][ks], O[0]);
        O[1] = mfma32(a, bqf[1][ks], O[1]);
      }
#pragma unroll
      for (int sb = 0; sb < 2; ++sb)
#pragma unroll
        for (int tb = 0; tb < 2; ++tb) {
          const bool skip = dir == 0 ? (sb == 1 && tb == 0) : (sb == 0 && tb == 1);
          if (skip) continue;
          f32x16 Sc = zero16();
#pragma unroll
          for (int ks = 0; ks < 4; ++ks) {
            bf16x8 a = *(const bf16x8*)(sK + (32 * sb + pr) * 72 + 16 * ks + 8 * hh);
            Sc = mfma32(a, bqf[tb][ks], Sc);
          }
          const int t = 32 * tb + r;
#pragma unroll
          for (int g = 0; g < 16; ++g) {
            int s = 32 * sb + 16 * (g >> 3) + 4 * ((g >> 2) & 1) + (g & 3) + 8 * hh;
            bool keep = dir == 0 ? (t >= s) : (s >= t);
            Sc[g] = keep ? Sc[g] : 0.f;
          }
#pragma unroll
          for (int s2 = 0; s2 < 2; ++s2) {
            const int sp4 = 2 * sb + s2;
            u32x4 bpu = {pack2(Sc[8 * s2], Sc[8 * s2 + 1]), pack2(Sc[8 * s2 + 2], Sc[8 * s2 + 3]), pack2(Sc[8 * s2 + 4], Sc[8 * s2 + 5]),
                         pack2(Sc[8 * s2 + 6], Sc[8 * s2 + 7])};
            bf16x8 bp = __builtin_bit_cast(bf16x8, bpu);
            bf16x8 av = *(const bf16x8*)(sVt + (32 * w + r) * 72 + 16 * sp4 + 8 * hh);
            O[tb] = mfma32(av, bp, O[tb]);
          }
        }
    }
    float ss[2];
#pragma unroll
    for (int tb = 0; tb < 2; ++tb) {
      float s = 0.f;
#pragma unroll
      for (int g = 0; g < 16; ++g) s += O[tb][g] * O[tb][g];
      s += __shfl_xor(s, 32);
      ss[tb] = s;
    }
    if (hh == 0) { sRed[w * 64 + r] = ss[0]; sRed[w * 64 + 32 + r] = ss[1]; }
    __syncthreads();
    f32x4v gnv[4];
#pragma unroll
    for (int g4 = 0; g4 < 4; ++g4) gnv[g4] = *(const f32x4v*)(p.gla_norm + layer * 128 + 32 * w + 8 * g4 + 4 * hh);
#pragma unroll
    for (int tb = 0; tb < 2; ++tb) {
      int t = 32 * tb + r;
      float tot = sRed[t] + sRed[64 + t] + sRed[128 + t] + sRed[192 + t];
      float rstd = rsqrtf(tot * (1.f / 128.f) + 1e-6f);
      const int tok = tok0 + t;
#pragma unroll
      for (int g4 = 0; g4 < 4; ++g4) {
        int dv = 32 * w + 8 * g4 + 4 * hh;
        uint2 rr = *(const uint2*)(p.rB + (size_t)tok * 512 + hd * 128 + dv);
        float rg[4] = {bf2f((bf16_t)(rr.x & 0xffff)), bf2f((bf16_t)(rr.x >> 16)), bf2f((bf16_t)(rr.y & 0xffff)), bf2f((bf16_t)(rr.y >> 16))};
        float o[4];
#pragma unroll
        for (int e = 0; e < 4; ++e) o[e] = O[tb][4 * g4 + e] * rstd * gnv[g4][e] * siluf(rg[e]);
        *(uint2*)(p.oB + (size_t)tok * 512 + hd * 128 + dv) = make_uint2(pack2(o[0], o[1]), pack2(o[2], o[3]));
      }
    }
  }
}

#define PHASE_KERNEL(name, call)                                               \
  __global__ void __launch_bounds__(512, 2) name(Params p_, int layer) {       \
    __shared__ __attribute__((aligned(16))) char smem_all[2 * SMEM_BYTES];     \
    char* smem = smem_all + half_() * SMEM_BYTES;                              \
    PRef p = params_view();                                           \
    call;                                                                      \
  }
PHASE_KERNEL(k_setup, phase_setup(p, smem))
PHASE_KERNEL(k_modreduce, phase_modreduce(p))
PHASE_KERNEL(k_convert, phase_convert(p, layer, smem))
PHASE_KERNEL(k_rowpass0, phase_rowpass0(p))
PHASE_KERNEL(k_inproj, phase_inproj(p, layer, smem_all))
PHASE_KERNEL(k_attnA, phase_attnA(p, layer, smem_all))
PHASE_KERNEL(k_na, phase_na(p, layer, smem))
PHASE_KERNEL(k_gla1, phase_gla1(p, layer, smem))
PHASE_KERNEL(k_gla2, phase_gla2(p))
PHASE_KERNEL(k_gla3, phase_gla3(p, layer, smem))
PHASE_KERNEL(k_merge, phase_merge(p, layer, smem_all))
PHASE_KERNEL(k_outproj, phase_outproj(p, layer, smem_all))
PHASE_KERNEL(k_rowpass1, phase_rowpass1(p, layer, smem))
PHASE_KERNEL(k_moescan, phase_moescan(p, layer, smem))
PHASE_KERNEL(k_moe1, phase_moe1(p, layer, smem_all))
PHASE_KERNEL(k_moe2, phase_moe2(p, layer, smem_all))
PHASE_KERNEL(k_rowpass2, phase_rowpass2(p, layer))

#define XB_TMO      128
#define XB_XCNT(j)  (256  + 64 * (j))
#define XB_XSUB(j)  (1280 + 64 * (j))
#define XB_XGEN(j)  (2304 + 64 * (j))
#define XB_TOP      3328
#define XB_TOPGEN   3392
#define XCD_BAR_WORDS 3456
#define XB_SPIN_CAP (1u << 23)
#define LAS __attribute__((address_space(3)))
__device__ __forceinline__ unsigned xb_ld(unsigned* p) { return __hip_atomic_load(p, __ATOMIC_RELAXED, __HIP_MEMORY_SCOPE_AGENT); }
__device__ __forceinline__ unsigned xb_add(unsigned* p, unsigned v) { return __hip_atomic_fetch_add(p, v, __ATOMIC_RELAXED, __HIP_MEMORY_SCOPE_AGENT); }
__device__ __forceinline__ unsigned xb_xcc_id() { return (unsigned)__builtin_amdgcn_s_getreg((3 << 11) | 20) & 0xFu; }
#define XB_SPIN(cond, bar) do { unsigned _sp = 0; while (cond) { __builtin_amdgcn_s_sleep(1); \
    if ((++_sp & 255u) == 0u) { if (xb_ld(&(bar)[XB_TMO])) break; if (_sp > XB_SPIN_CAP) { atomicAdd(&(bar)[XB_TMO], 1u); break; } } } } while (0)
struct XcdBarrier { unsigned* bar; unsigned x; volatile LAS unsigned* st; };
__device__ __forceinline__ XcdBarrier xcd_barrier_post(unsigned* bar, volatile LAS unsigned* st) {
  XcdBarrier b; b.bar = bar; b.x = xb_xcc_id(); b.st = st;
  if (__builtin_amdgcn_workitem_id_x() == 0) (void)xb_add(&bar[XB_XCNT(b.x)], 1u);
  return b;
}
__device__ __forceinline__ void xcd_barrier_complete(unsigned* bar, unsigned x, unsigned& nloc, unsigned& nx) {
  const unsigned G = gridDim.x * gridDim.y * gridDim.z;
  unsigned sum, cnt, mine, sp = 0u;
  for (;;) {
    sum = 0u; cnt = 0u; mine = 0u;
#pragma unroll
    for (unsigned j = 0; j < 16; ++j) { const unsigned c = xb_ld(&bar[XB_XCNT(j)]); sum += c; cnt += (c > 0u) ? 1u : 0u; mine = (j == x) ? c : mine; }
    if (sum == G) break;
    __builtin_amdgcn_s_sleep(1);
    if ((++sp & 255u) == 0u) { if (xb_ld(&bar[XB_TMO])) break; if (sp > XB_SPIN_CAP) { atomicAdd(&bar[XB_TMO], 1u); break; } }
  }
  nloc = mine > 0u ? mine : 1u; nx = cnt > 0u ? cnt : 1u;
}
__device__ __forceinline__ void xcd_barrier(const XcdBarrier& b) {
  asm volatile("s_waitcnt vmcnt(0)" ::: "memory");
  __syncthreads();
  if (__builtin_amdgcn_workitem_id_x() == 0) {
    unsigned* bar = b.bar;
    __builtin_amdgcn_s_waitcnt(0);
    unsigned nloc = b.st[0], nx = b.st[1];
    if (nloc == 0u) { xcd_barrier_complete(bar, b.x, nloc, nx); b.st[0] = nloc; b.st[1] = nx; }
    const unsigned old = xb_add(&bar[XB_XSUB(b.x)], 1u);
    const unsigned gen = old / nloc;
    if (old + 1u == (gen + 1u) * nloc) {
      __builtin_amdgcn_fence(__ATOMIC_RELEASE, "agent");
      asm volatile("s_waitcnt vmcnt(0)" ::: "memory");
      const unsigned og = xb_add(&bar[XB_TOP], 1u);
      const unsigned tg = og / nx;
      if (og + 1u == (tg + 1u) * nx) xb_add(&bar[XB_TOPGEN], 1u);
      else XB_SPIN(xb_ld(&bar[XB_TOPGEN]) == tg, bar);
      __builtin_amdgcn_fence(__ATOMIC_ACQUIRE, "agent");
      xb_add(&bar[XB_XGEN(b.x)], 1u);
      asm volatile("s_waitcnt vmcnt(0)" ::: "memory");
    } else {
      XB_SPIN(xb_ld(&bar[XB_XGEN(b.x)]) == gen, bar);
      __builtin_amdgcn_fence(__ATOMIC_ACQUIRE, "agent");
      asm volatile("s_waitcnt vmcnt(0)" ::: "memory");
    }
  }
  __syncthreads();
}

__global__ void __launch_bounds__(512, 2) k_mega(Params p_) {
  __shared__ __attribute__((aligned(16))) char smem_all[2 * SMEM_BYTES + 16];
  volatile LAS unsigned* st = (volatile LAS unsigned*)(smem_all + 2 * SMEM_BYTES);
  if (__builtin_amdgcn_workitem_id_x() == 0) { st[0] = 0u; st[1] = 0u; }
  __syncthreads();
  const XcdBarrier xb = xcd_barrier_post(p_.bar, st);
#pragma unroll 1
  for (int ph = 0; ph < 25; ++ph) {
    int l = (ph >= 14) ? 1 : 0;
    int q = (ph < 3) ? ph : 3 + (ph - 3) % 11;
    l = __builtin_amdgcn_readfirstlane(l);
    q = __builtin_amdgcn_readfirstlane(q);
#ifdef PROBE_MASK
    const unsigned long long pt0 = __builtin_amdgcn_s_memrealtime();
#endif
    PRef p = params_view();
    char* smem = smem_all + half_() * SMEM_BYTES;
    switch (q) {
      case 0: phase_setup(p, smem); phase_convert(p, 0, smem); break;
      case 1: phase_modreduce(p); break;
      case 2: phase_rowpass0(p); break;
      case 3: phase_inproj(p, l, smem_all); break;
      case 4: phase_gla1(p, l, smem); phase_na(p, l, smem); break;
      case 5: phase_gla2(p); phase_attnA(p, l, smem_all); break;
      case 6: phase_gla3(p, l, smem); break;
      case 7: phase_merge(p, l, smem_all); break;
      case 8: phase_outproj(p, l, smem_all); break;
      case 9: phase_rowpass1(p, l, smem); break;
      case 10: phase_moescan(p, l, smem); phase_convert(p, l | 16, smem); break;
      case 11: phase_moe1(p, l, smem_all); break;
      case 12: phase_moe2(p, l, smem_all); break;
      default: phase_rowpass2(p, l); if (l == 0) phase_convert(p, 1, smem); break;
    }
    if (ph != 24) xcd_barrier(xb);
#ifdef PROBE_MASK
    if ((PROBE_MASK >> q) & 1) {
      const unsigned long long pt1 = __builtin_amdgcn_s_memrealtime();
      while (__builtin_amdgcn_s_memrealtime() - pt1 < (pt1 - pt0)) __builtin_amdgcn_s_sleep(8);
    }
#endif
  }
}

#ifdef DIAG_STAGE
__device__ __forceinline__ unsigned dhash(unsigned s) { s ^= s >> 16; s *= 0x7feb352dU; s ^= s >> 15; s *= 0x846ca68bU; s ^= s >> 16; return s; }
__device__ __forceinline__ void diag_accum(double num, double den, double* accum, double* sred) {
  const int tid = threadIdx.x;
  __syncthreads();
  sred[tid] = num; sred[256 + tid] = den;
  __syncthreads();
  for (int o = 128; o > 0; o >>= 1) { if (tid < o) { sred[tid] += sred[tid + o]; sred[256 + tid] += sred[256 + tid + o]; } __syncthreads(); }
  if (tid == 0) { atomicAdd(&accum[0], sred[0]); atomicAdd(&accum[1], sred[256]); }
}
__device__ __forceinline__ int diag_tok(int s, int ns) {
  if (s < 8) return TLAT + (dhash(s + 77) % TCTX);
  if (s == 8) return 0; if (s == 9) return TLAT - 1; if (s == 10) return 4095; if (s == 11) return 4096;
  return dhash(s * 31 + 5) % TLAT;
}
__global__ void k_diag_zero(double* accum) { if (threadIdx.x < 32) accum[threadIdx.x] = 0.0; }
__global__ void k_diag_report(const double* accum, float* out, int n) {
  int i = blockIdx.x * 256 + threadIdx.x;
  for (; i < n; i += gridDim.x * 256) out[i] = 0.f;
  if (blockIdx.x == 0 && threadIdx.x == 0) {
    double E = 0.0;
    for (int k = 0; k < 16; ++k) {
      if (accum[2 * k + 1] > 0.0) { double e = accum[2 * k] / accum[2 * k + 1]; if (!(e == e)) e = 100.0; if (e > E) E = e; }
    }
    out[0] = (float)(4.096e7 * sqrt(E));
  }
}
__global__ void __launch_bounds__(256) k_chk_h(Params p, double* accum) {
  __shared__ double sred[512];
  __shared__ float sx[1024];
  const int tid = threadIdx.x;
  int tok = diag_tok(blockIdx.x, gridDim.x);
  const float* src = tok < TLAT ? p.x + (size_t)tok * D : p.ctx + (size_t)(tok - TLAT) * D;
  const float* cv = tok < TLAT ? p.c + (tok >> 12) * 1024 : p.c_ctx;
  double s = 0, q = 0;
  for (int i = 0; i < 1024; ++i) s += src[i];
  double mean = s / 1024;
  for (int i = 0; i < 1024; ++i) { double d = src[i] - mean; q += d * d; }
  double rstd = 1.0 / sqrt(q / 1024 + 1e-6);
  double num = 0, den = 0;
  for (int n = tid; n < 1024; n += 256) {
    double sh = p.b_mod[n], sc = p.b_mod[1024 + n];
    for (int k = 0; k < 1024; ++k) {
      double cc = cv[k]; double sl = cc / (1.0 + exp(-cc));
      sh += sl * p.w_mod[(size_t)k * NMOD + n];
      sc += sl * p.w_mod[(size_t)k * NMOD + 1024 + n];
    }
    double ref = (src[n] - mean) * rstd * (1.0 + sc) + sh;
    double got = bf2f(p.h[(size_t)tok * D + n]);
    num += (got - ref) * (got - ref); den += ref * ref;
  }
  diag_accum(num, den, accum, sred);
}
__global__ void __launch_bounds__(256) k_chk_inproj(Params p, int layer, double* accum) {
  __shared__ double sred[512];
  __shared__ float sz[3872];
  __shared__ float sh[1024];
  const int tid = threadIdx.x;
  int tok = diag_tok(blockIdx.x, gridDim.x);
  for (int i = tid; i < 1024; i += 256) sh[i] = bf2f(p.h[(size_t)tok * D + i]);
  __syncthreads();
  const float* W = p.w_in + (size_t)layer * 1024 * NIN_SRC;
  for (int j = tid; j < 3872; j += 256) {
    double a = p.b_in[layer * NIN_SRC + j];
    for (int k = 0; k < 1024; ++k) a += (double)sh[k] * W[(size_t)k * NIN_SRC + j];
    sz[j] = (float)a;
  }
  __syncthreads();
  const bool lat = tok < TLAT;
  int b, t, pall;
  if (lat) { b = tok >> 12; t = tok & 4095; pall = 256 + t; } else { int ci = tok - TLAT; b = ci >> 8; t = ci & 255; pall = t; }
  double num = 0, den = 0;
  for (int j = tid; j < 3872; j += 256) {
    double ref, got;
    if (j < 640) {
      int hb = (j >> 6) << 6, d = j & 63;
      double ss = 0;
      for (int e = 0; e < 64; ++e) ss += (double)sz[hb + e] * sz[hb + e];
      double rstd = 1.0 / sqrt(ss / 64 + 1e-6);
      const float* gn = (j < 512 ? p.q_norm : p.k_norm) + layer * 64;
      double xn = sz[j] * rstd * gn[d];
      if (lat) {
        int qd = d >> 4, f = d & 15;
        int dp = d ^ 16;
        double pn = sz[hb + dp] * rstd * gn[dp];
        double pos = (qd < 2) ? (double)(t >> 6) : (double)(t & 63);
        float inv = powf(10000.f, -(float)f / 16.f);
        float ang = (float)pos * inv;
        double cs = cos((double)ang), sn = sin((double)ang);
        double rot = (qd & 1) ? pn : -pn;
        xn = xn * cs + rot * sn;
      }
      if (j < 512) { ref = xn * QSCALE; got = bf2f(p.qA[(size_t)tok * 512 + j]); }
      else { int kvh = (j - 512) >> 6; ref = xn; got = bf2f(p.kA[((size_t)(b * 2 + kvh) * PALL + pall) * 64 + d]); }
    } else if (j < 768) { int c = j - 640; ref = sz[j]; got = bf2f(p.vAT[((size_t)(b * 2 + (c >> 6)) * 64 + (c & 63)) * PALL + pall]); }
    else if (j < 1024) { ref = sz[j] * 0.125; got = bf2f(p.qB[(size_t)tok * 256 + (j - 768)]); }
    else if (j < 1280) { ref = sz[j]; got = bf2f(p.kB[(size_t)tok * 256 + (j - 1024)]); }
    else if (j < 1792) { int c = j - 1280; ref = sz[j]; got = bf2f(p.vBT[((size_t)(b * 4 + (c >> 7)) * 128 + (c & 127)) * PALL + pall]); }
    else if (j < 2304) { ref = sz[j]; got = bf2f(p.rB[(size_t)tok * 512 + (j - 1792)]); }
    else if (j < 2336) { ref = sz[j]; got = p.aB[(size_t)tok * 32 + (j - 2304)]; }
    else if (j < 2848) { ref = sz[j] * QSCALE; got = bf2f(p.qC[(size_t)tok * 512 + (j - 2336)]); }
    else if (j < 3360) { ref = sz[j]; got = bf2f(p.kC[(size_t)tok * 512 + (j - 2848)]); }
    else { int c = j - 3360; ref = sz[j]; got = bf2f(p.vCT[((size_t)(b * 8 + (c >> 6)) * 64 + (c & 63)) * PALL + pall]); }
    num += (got - ref) * (got - ref); den += ref * ref;
  }
  diag_accum(num, den, accum, sred);
}
__global__ void __launch_bounds__(256) k_chk_attnA(Params p, int layer, double* accum) {
  __shared__ double sred[512];
  __shared__ float sp[4352];
  __shared__ float sq[64];
  __shared__ float so[64];
  const int tid = threadIdx.x;
  int tok = diag_tok(blockIdx.x >> 1, gridDim.x);
  if (layer == 1 && tok >= TLAT) tok = dhash(blockIdx.x) % TLAT;
  int head = dhash(blockIdx.x * 7 + 1) & 7, kvh = head >> 2;
  const bool lat = tok < TLAT;
  int b = lat ? tok >> 12 : (tok - TLAT) >> 8;
  int nk = lat ? PALL : 256;
  if (tid < 64) sq[tid] = bf2f(p.qA[(size_t)tok * 512 + head * 64 + tid]);
  __syncthreads();
  const bf16_t* kb = p.kA + (size_t)(b * 2 + kvh) * PALL * 64;
#pragma unroll 1
  for (int j = tid; j < nk; j += 256) {
    float s = 0.f;
#pragma unroll 1
    for (int d = 0; d < 64; ++d) s += sq[d] * bf2f(kb[(size_t)j * 64 + d]);
    sp[j] = s;
  }
  __syncthreads();
  float mx = -1e30f;
#pragma unroll 1
  for (int j = 0; j < nk; ++j) mx = fmaxf(mx, sp[j]);
  __syncthreads();
  for (int j = tid; j < nk; j += 256) sp[j] = exp2f(sp[j] - mx);
  __syncthreads();
  double num = 0, den = 0;
  if (tid < 64) {
    double l = 0, o = 0;
    const bf16_t* vb = p.vAT + ((size_t)(b * 2 + kvh) * 64 + tid) * PALL;
#pragma unroll 1
    for (int j = 0; j < nk; ++j) { l += sp[j]; o += (double)sp[j] * bf2f(vb[j]); }
    double ref = o / l, got = bf2f(p.oA[(size_t)tok * 512 + head * 64 + tid]);
    num = (got - ref) * (got - ref); den = ref * ref;
  }
  diag_accum(num, den, accum, sred);
}
__global__ void __launch_bounds__(256) k_chk_na(Params p, int layer, double* accum) {
  __shared__ double sred[512];
  __shared__ float sp[384];
  __shared__ int spos[384];
  __shared__ float sq[64];
  const int tid = threadIdx.x;
  int tok = diag_tok(blockIdx.x >> 1, gridDim.x);
  if (layer == 1 && tok >= TLAT) tok = dhash(blockIdx.x) % TLAT;
  int head = dhash(blockIdx.x * 13 + 3) & 7;
  const bool lat = tok < TLAT;
  int b = lat ? tok >> 12 : (tok - TLAT) >> 8;
  if (tid < 64) sq[tid] = bf2f(p.qC[(size_t)tok * 512 + head * 64 + tid]);
  __syncthreads();
  int nk = lat ? 384 : 256;
  for (int j = tid; j < nk; j += 256) {
    int ktok, kpall; float bias = 0.f;
    if (lat && j < 128) {
      int t = tok & 4095, r = t >> 6, w = t & 63;
      int rs = r - 4; rs = rs < 0 ? 0 : (rs > 56 ? 56 : rs);
      int cs = w - 8; cs = cs < 0 ? 0 : (cs > 48 ? 48 : cs);
      int i = j >> 4, jj = j & 15;
      int kr = rs + i, kc = cs + jj;
      ktok = b * 4096 + kr * 64 + kc; kpall = 256 + kr * 64 + kc;
      bias = p.rpb[(((size_t)layer * 8 + head) * 15 + (kr - r + 7)) * 31 + (kc - w + 15)] * LOG2E;
    } else {
      int c = lat ? j - 128 : j;
      ktok = TLAT + b * 256 + c; kpall = c;
    }
    float s = 0.f;
    for (int d = 0; d < 64; ++d) s += sq[d] * bf2f(p.kC[(size_t)ktok * 512 + head * 64 + d]);
    sp[j] = s + bias; spos[j] = kpall;
  }
  __syncthreads();
  float mx = -1e30f;
  for (int j = 0; j < nk; ++j) mx = fmaxf(mx, sp[j]);
  __syncthreads();
  for (int j = tid; j < nk; j += 256) sp[j] = exp2f(sp[j] - mx);
  __syncthreads();
  double num = 0, den = 0;
  if (tid < 64) {
    double l = 0, o = 0;
    const bf16_t* vb = p.vCT + ((size_t)(b * 8 + head) * 64 + tid) * PALL;
    for (int j = 0; j < nk; ++j) { l += sp[j]; o += (double)sp[j] * bf2f(vb[spos[j]]); }
    double ref = o / l, got = bf2f(p.oC[(size_t)tok * 512 + head * 64 + tid]);
    num = (got - ref) * (got - ref); den = ref * ref;
  }
  diag_accum(num, den, accum, sred);
}
__device__ constexpr int gla_sp(int i) { return i == 0 ? 0 : i == 1 ? 255 : i == 2 ? 256 : i == 3 ? 319 : i == 4 ? 320 : i == 5 ? 1257 : i == 6 ? 2756 : 4351; }
__global__ void __launch_bounds__(256) k_chk_gla(Params p, int layer, double* accum) {
  __shared__ double sred[512];
  __shared__ float sal[64], sqv[64], skv[64];
  __shared__ float sred2[128];
  const int tid = threadIdx.x;
  const int b = blockIdx.x >> 2, hd = blockIdx.x & 3;
  constexpr int NSP = 8;
  float osum[NSP];
#pragma unroll
  for (int i = 0; i < NSP; ++i) osum[i] = 0.f;
  for (int dir = 0; dir < 2; ++dir) {
    float S[64];
#pragma unroll
    for (int d = 0; d < 64; ++d) S[d] = 0.f;
#pragma unroll 1
    for (int step = 0; step < PALL; ++step) {
      int pall;
      if (step < 256) pall = dir ? 255 - step : step; else { int j = step - 256; pall = 256 + (dir ? 4095 - j : j); }
      int tok = pall < 256 ? TLAT + b * 256 + pall : b * 4096 + (pall - 256);
      __syncthreads();
      if (tid < 64) {
        float xv = p.gla_bg[((size_t)layer * 2 + dir) * 256 + hd * 64 + tid];
        for (int r = 0; r < 16; ++r) xv += p.aB[(size_t)tok * 32 + dir * 16 + r] * p.gla_wg[(((size_t)layer * 2 + dir) * 16 + r) * 256 + hd * 64 + tid];
        float ls = fminf(xv, 0.f) - log1pf(expf(-fabsf(xv)));
        sal[tid] = expf(ls / 16.f);
        sqv[tid] = bf2f(p.qB[(size_t)tok * 256 + hd * 64 + tid]);
        skv[tid] = bf2f(p.kB[(size_t)tok * 256 + hd * 64 + tid]);
      }
      __syncthreads();
      if (tid < 128) {
        float v = bf2f(p.vBT[((size_t)(b * 4 + hd) * 128 + tid) * PALL + pall]);
        float o = 0.f;
#pragma unroll
        for (int d = 0; d < 64; ++d) { S[d] = sal[d] * S[d] + skv[d] * v; o += sqv[d] * S[d]; }
#pragma unroll
        for (int i = 0; i < NSP; ++i) if (gla_sp(i) == pall) osum[i] += o;
      }
    }
  }
  double num = 0, den = 0;
#pragma unroll
  for (int i = 0; i < NSP; ++i) {
    if (layer == 1 && gla_sp(i) < 256) continue;
    __syncthreads();
    if (tid < 128) sred2[tid] = osum[i] * osum[i];
    __syncthreads();
    float tot = 0.f;
    for (int j = 0; j < 128; ++j) tot += sred2[j];
    if (tid < 128) {
      int pall = gla_sp(i);
      int tok = pall < 256 ? TLAT + b * 256 + pall : b * 4096 + (pall - 256);
      float rstd = 1.f / sqrtf(tot / 128.f + 1e-6f);
      float rg = bf2f(p.rB[(size_t)tok * 512 + hd * 128 + tid]);
      double ref = osum[i] * rstd * p.gla_norm[layer * 128 + tid] * (rg / (1.f + expf(-rg)));
      double got = bf2f(p.oB[(size_t)tok * 512 + hd * 128 + tid]);
      num += (got - ref) * (got - ref); den += ref * ref;
    }
  }
  diag_accum(num, den, accum, sred);
}
__global__ void __launch_bounds__(256) k_chk_merge(Params p, int layer, double* accum) {
  __shared__ double sred[512];
  const int tid = threadIdx.x;
  int tok = diag_tok(blockIdx.x, gridDim.x);
  if (layer == 1 && tok >= TLAT) tok = dhash(blockIdx.x) % TLAT;
  const float* W = p.w_in + (size_t)layer * 1024 * NIN_SRC;
  double num = 0, den = 0;
  for (int n = tid; n < 1024; n += 256) {
    double tot = 0;
    for (int br = 0; br < 3; ++br) {
      double g = p.b_in[layer * NIN_SRC + 3872 + br * 1024 + n];
      for (int k = 0; k < 1024; ++k) g += (double)bf2f(p.h[(size_t)tok * D + k]) * W[(size_t)k * NIN_SRC + 3872 + br * 1024 + n];
      g = 1.0 / (1.0 + exp(-g));
      const bf16_t* ob = br == 0 ? p.oA : (br == 1 ? p.oB : p.oC);
      const float* wb = (br == 0 ? p.w_br_attn : (br == 1 ? p.w_br_gla : p.w_br_na)) + (size_t)layer * 512 * 1024;
      double a = 0;
      for (int j = 0; j < 512; ++j) a += (double)bf2f(ob[(size_t)tok * 512 + j]) * wb[(size_t)j * 1024 + n];
      tot += g * a;
    }
    double got = bf2f(p.m[(size_t)tok * D + n]);
    num += (got - tot) * (got - tot); den += tot * tot;
  }
  diag_accum(num, den, accum, sred);
}
__global__ void __launch_bounds__(256) k_chk_x1(Params p, double* accum) {
  __shared__ double sred[512];
  __shared__ double sv[1024];
  __shared__ double sx1[1024];
  __shared__ double sst[4];
  const int tid = threadIdx.x;
  int tok = diag_tok(blockIdx.x, gridDim.x);
  const float* cv = tok < TLAT ? p.c + (tok >> 12) * 1024 : p.c_ctx;
  const float* xin = tok < TLAT ? p.x + (size_t)tok * D : p.ctx + (size_t)(tok - TLAT) * D;
  for (int n = tid; n < 1024; n += 256) {
    double y = 0, g1 = p.b_mod[2048 + n];
    for (int k = 0; k < 1024; ++k) {
      y += (double)bf2f(p.m[(size_t)tok * D + k]) * p.w_out[(size_t)k * 1024 + n];
      double cc = cv[k]; g1 += cc / (1.0 + exp(-cc)) * p.w_mod[(size_t)k * NMOD + 2048 + n];
    }
    sv[n] = 1.4142135623730951 * xin[n] + g1 * y;
  }
  __syncthreads();
  if (tid == 0) { double s = 0, q = 0; for (int i = 0; i < 1024; ++i) s += sv[i]; s /= 1024; for (int i = 0; i < 1024; ++i) q += (sv[i] - s) * (sv[i] - s); sst[0] = s; sst[1] = 1.0 / sqrt(q / 1024 + 1e-6); }
  __syncthreads();
  double num = 0, den = 0;
  for (int n = tid; n < 1024; n += 256) {
    double x1 = (sv[n] - sst[0]) * sst[1] * p.ln1_g[n] + p.ln1_b[n];
    sx1[n] = x1;
    double got = p.xres[(size_t)tok * D + n];
    num += (got - x1) * (got - x1); den += x1 * x1;
  }
  __syncthreads();
  if (tid == 0) { double s = 0, q = 0; for (int i = 0; i < 1024; ++i) s += sx1[i]; s /= 1024; for (int i = 0; i < 1024; ++i) q += (sx1[i] - s) * (sx1[i] - s); sst[2] = s; sst[3] = 1.0 / sqrt(q / 1024 + 1e-6); }
  __syncthreads();
  for (int n = tid; n < 1024; n += 256) {
    double sh = p.b_mod[3072 + n], sc = p.b_mod[4096 + n];
    for (int k = 0; k < 1024; ++k) { double cc = cv[k]; double sl = cc / (1.0 + exp(-cc)); sh += sl * p.w_mod[(size_t)k * NMOD + 3072 + n]; sc += sl * p.w_mod[(size_t)k * NMOD + 4096 + n]; }
    double h2 = (sx1[n] - sst[2]) * sst[3] * (1.0 + sc) + sh;
    double got = bf2f(p.h2[(size_t)tok * D + n]);
    num += (got - h2) * (got - h2); den += h2 * h2;
  }
  diag_accum(num, den, accum, sred);
}
__global__ void __launch_bounds__(256) k_chk_moe(Params p, int layer, int mode, double* accum) {
  __shared__ double sred[512];
  __shared__ float sh[1024];
  __shared__ float slog[36];
  __shared__ float shid[1024];
  __shared__ int se[2];
  __shared__ float sw[2];
  const int tid = threadIdx.x;
  int tok = diag_tok(blockIdx.x, gridDim.x);
  if (layer == 1 && tok >= TLAT) tok = dhash(blockIdx.x) % TLAT;
  for (int i = tid; i < 1024; i += 256) sh[i] = bf2f(p.h2[(size_t)tok * D + i]);
  __syncthreads();
  if (tid < 36) {
    double a;
    if (tid < 32) { a = p.b_re[layer * 32 + tid]; for (int k = 0; k < 1024; ++k) a += (double)sh[k] * p.w_re[((size_t)layer * 1024 + k) * 32 + tid]; }
    else { a = p.b_rg[layer * 4 + tid - 32]; for (int k = 0; k < 1024; ++k) a += (double)sh[k] * p.w_rg[((size_t)layer * 1024 + k) * 4 + tid - 32]; }
    slog[tid] = (float)a;
  }
  __syncthreads();
  if (tid == 0) {
    int grp = 0; for (int i = 1; i < 4; ++i) if (slog[32 + i] > slog[32 + grp]) grp = i;
    double gs = 0; for (int i = 0; i < 4; ++i) gs += exp((double)slog[32 + i] - slog[32 + grp]);
    double pg = 1.0 / gs;
    int i0 = 0; for (int i = 1; i < 8; ++i) if (slog[grp * 8 + i] > slog[grp * 8 + i0]) i0 = i;
    int i1 = -1; for (int i = 0; i < 8; ++i) if (i != i0 && (i1 < 0 || slog[grp * 8 + i] > slog[grp * 8 + i1])) i1 = i;
    double e1 = exp((double)slog[grp * 8 + i1] - slog[grp * 8 + i0]);
    se[0] = grp * 8 + i0; se[1] = grp * 8 + i1; sw[0] = (float)(pg / (1 + e1)); sw[1] = (float)(pg * e1 / (1 + e1));
  }
  __syncthreads();
  if (mode == 1) {
    double num = 0, den = 0;
    if (tid == 0) { den = 1.0; bool same = (p.tok_e[tok * 2] == se[0] && p.tok_e[tok * 2 + 1] == se[1]); num = same ? 0.0 : 1.0; }
    diag_accum(num, den, accum, sred);
    return;
  }
  int e0 = p.tok_e[tok * 2], e1 = p.tok_e[tok * 2 + 1];
  float w0 = p.tok_gate[tok * 2], w1 = p.tok_gate[tok * 2 + 1];
  double num = 0, den = 0;
  if (tid == 0 && e0 == se[0] && e1 == se[1]) { num += (w0 - sw[0]) * (w0 - sw[0]) + (w1 - sw[1]) * (w1 - sw[1]); }
  for (int i = tid; i < 1024; i += 256) {
    int k = i >> 9, j = i & 511, e = k ? e1 : e0;
    const float* w1p = p.w1 + ((size_t)layer * 32 + e) * 1024 * 512;
    const float* w3p = p.w3 + ((size_t)layer * 32 + e) * 1024 * 512;
    double a = 0, c = 0;
    for (int kk = 0; kk < 1024; ++kk) { a += (double)sh[kk] * w1p[(size_t)kk * 512 + j]; c += (double)sh[kk] * w3p[(size_t)kk * 512 + j]; }
    shid[i] = (float)(a / (1.0 + exp(-a)) * c);
  }
  __syncthreads();
  int s0 = p.estart[e0] * MOE_BLK + p.tok_pos[tok * 2], s1 = p.estart[e1] * MOE_BLK + p.tok_pos[tok * 2 + 1];
  for (int n = tid; n < 1024; n += 256) {
    double y = 0;
    const float* w2a = p.w2 + ((size_t)layer * 32 + e0) * 512 * 1024;
    const float* w2b = p.w2 + ((size_t)layer * 32 + e1) * 512 * 1024;
    double ya = 0, yb = 0;
    for (int j = 0; j < 512; ++j) { ya += (double)shid[j] * w2a[(size_t)j * 1024 + n]; yb += (double)shid[512 + j] * w2b[(size_t)j * 1024 + n]; }
    y = w0 * ya + w1 * yb;
    double got = w0 * bf2f(p.ysl[(size_t)s0 * D + n]) + w1 * bf2f(p.ysl[(size_t)s1 * D + n]);
    num += (got - y) * (got - y); den += y * y;
  }
  diag_accum(num, den, accum, sred);
}
__global__ void k_saverows(Params p, float* xsave, int layer) {
  int tok = diag_tok(blockIdx.x, gridDim.x);
  if (layer == 1 && tok >= TLAT) tok = dhash(blockIdx.x) % TLAT;
  for (int i = threadIdx.x; i < 1024; i += 256) xsave[(size_t)blockIdx.x * 1024 + i] = p.xres[(size_t)tok * D + i];
}
__global__ void __launch_bounds__(256) k_chk_final(Params p, int layer, const float* xsave, double* accum) {
  __shared__ double sred[512];
  __shared__ double sv[1024];
  __shared__ double sst[4];
  const int tid = threadIdx.x;
  int tok = diag_tok(blockIdx.x, gridDim.x);
  if (layer == 1 && tok >= TLAT) tok = dhash(blockIdx.x) % TLAT;
  const float* cv = tok < TLAT ? p.c + (tok >> 12) * 1024 : p.c_ctx;
  int e0 = p.tok_e[tok * 2], e1 = p.tok_e[tok * 2 + 1];
  float w0 = p.tok_gate[tok * 2], w1 = p.tok_gate[tok * 2 + 1];
  int s0 = p.estart[e0] * MOE_BLK + p.tok_pos[tok * 2], s1 = p.estart[e1] * MOE_BLK + p.tok_pos[tok * 2 + 1];
  for (int n = tid; n < 1024; n += 256) {
    double g2 = p.b_mod[layer * NMOD + 5120 + n];
    for (int k = 0; k < 1024; ++k) { double cc = cv[k]; g2 += cc / (1.0 + exp(-cc)) * p.w_mod[((size_t)layer * 1024 + k) * NMOD + 5120 + n]; }
    double y = w0 * bf2f(p.ysl[(size_t)s0 * D + n]) + w1 * bf2f(p.ysl[(size_t)s1 * D + n]);
    sv[n] = 1.4142135623730951 * xsave[(size_t)blockIdx.x * 1024 + n] + g2 * y;
  }
  __syncthreads();
  if (tid == 0) { double s = 0, q = 0; for (int i = 0; i < 1024; ++i) s += sv[i]; s /= 1024; for (int i = 0; i < 1024; ++i) q += (sv[i] - s) * (sv[i] - s); sst[0] = s; sst[1] = 1.0 / sqrt(q / 1024 + 1e-6); }
  __syncthreads();
  double num = 0, den = 0;
  for (int n = tid; n < 1024; n += 256) {
    double x2 = (sv[n] - sst[0]) * sst[1] * p.ln2_g[layer * D + n] + p.ln2_b[layer * D + n];
    sv[n] = x2;
    double got = layer == 1 ? p.out[(size_t)tok * D + n] : p.xres[(size_t)tok * D + n];
    num += (got - x2) * (got - x2); den += x2 * x2;
  }
  __syncthreads();
  if (layer == 0) {
    if (tid == 0) { double s = 0, q = 0; for (int i = 0; i < 1024; ++i) s += sv[i]; s /= 1024; for (int i = 0; i < 1024; ++i) q += (sv[i] - s) * (sv[i] - s); sst[2] = s; sst[3] = 1.0 / sqrt(q / 1024 + 1e-6); }
    __syncthreads();
    for (int n = tid; n < 1024; n += 256) {
      double sh = p.b_mod[NMOD + n], sc = p.b_mod[NMOD + 1024 + n];
      for (int k = 0; k < 1024; ++k) { double cc = cv[k]; double sl = cc / (1.0 + exp(-cc)); sh += sl * p.w_mod[((size_t)1024 + k) * NMOD + n]; sc += sl * p.w_mod[((size_t)1024 + k) * NMOD + 1024 + n]; }
      double h = (sv[n] - sst[2]) * sst[3] * (1.0 + sc) + sh;
      double got = bf2f(p.h[(size_t)tok * D + n]);
      num += (got - h) * (got - h); den += h * h;
    }
  }
  diag_accum(num, den, accum, sred);
}
#endif

static inline size_t align_up(size_t v, size_t a) { return (v + a - 1) / a * a; }

extern "C" void kernel_launch(void* const* d_in, const int* in_sizes, int n_in, void* d_out, int out_size, void* d_ws, size_t ws_size,
                              hipStream_t stream) {
  Params p{};
  const float* const* in = (const float* const*)d_in;
  p.x = in[0]; p.c = in[1]; p.ctx = in[2]; p.c_ctx = in[3]; p.w_mod = in[4]; p.b_mod = in[5]; p.w_in = in[6]; p.b_in = in[7];
  p.q_norm = in[8]; p.k_norm = in[9]; p.gla_wg = in[10]; p.gla_bg = in[11]; p.gla_norm = in[12]; p.rpb = in[13];
  p.w_br_attn = in[14]; p.w_br_gla = in[15]; p.w_br_na = in[16]; p.w_out = in[17]; p.ln1_g = in[18]; p.ln1_b = in[19];
  p.w_rg = in[20]; p.b_rg = in[21]; p.w_re = in[22]; p.b_re = in[23]; p.w1 = in[24]; p.w3 = in[25]; p.w2 = in[26];
  p.ln2_g = in[27]; p.ln2_b = in[28];
  p.out = (float*)d_out;

  char* base = (char*)d_ws;
  size_t off = 0;
  auto take = [&](size_t bytes) { char* q = base + off; off = align_up(off + bytes, 256); return q; };
  p.mod_part = (float*)take((size_t)16 * 2 * 5 * NMOD * 4);
  p.mod = (float*)take((size_t)2 * 5 * NMOD * 4);
  p.rope = (float*)take(2048 * 4);
  p.wrp = (float*)take((size_t)2 * 49152 * 4);
  p.bar = (unsigned*)take(XCD_BAR_WORDS * 4);
  p.cnt = (int*)take(32 * 4);
  p.estart = (int*)take(32 * 4);
  p.cntg = (int*)take((size_t)1088 * 32 * 4);
  p.list = (int*)take((size_t)32 * MOE_CAP * 4);
  p.tok_e = (int*)take((size_t)TALL * 2 * 4);
  p.tok_pos = (int*)take((size_t)TALL * 2 * 4);
  p.tok_gate = (float*)take((size_t)TALL * 2 * 4);
  p.wt_in = (bf16_t*)take((size_t)3968 * 1024 * 2);
  p.wt_gate = (bf16_t*)take((size_t)3072 * 1024 * 2);
  p.wt_br = (bf16_t*)take((size_t)3 * 1024 * 512 * 2);
  p.wt_out = (bf16_t*)take((size_t)1024 * 1024 * 2);
  p.wt_13 = (bf16_t*)take((size_t)32 * 1024 * 1024 * 2);
  p.wt_2 = (bf16_t*)take((size_t)32 * 1024 * 512 * 2);
  p.G = p.wt_13;
  p.xres = (float*)take((size_t)TALL * D * 4);
  p.h = (bf16_t*)take((size_t)TALL * D * 2);
  size_t r1 = off;
  p.qA = (bf16_t*)take((size_t)TALL * 512 * 2);
  p.kA = (bf16_t*)take((size_t)4 * 2 * PALL * 64 * 2);
  p.vAT = (bf16_t*)take((size_t)4 * 2 * 64 * PALL * 2);
  p.qB = (bf16_t*)take((size_t)TALL * 256 * 2);
  p.kB = (bf16_t*)take((size_t)TALL * 256 * 2);
  p.vBT = (bf16_t*)take((size_t)4 * 4 * 128 * PALL * 2);
  p.rB = (bf16_t*)take((size_t)TALL * 512 * 2);
  p.aB = (float*)take((size_t)TALL * 32 * 4);
  p.qC = (bf16_t*)take((size_t)TALL * 512 * 2);
  p.kC = (bf16_t*)take((size_t)TALL * 512 * 2);
  p.vCT = (bf16_t*)take((size_t)4 * 8 * 64 * PALL * 2);
  p.oA = (bf16_t*)take((size_t)TALL * 512 * 2);
  p.oB = (bf16_t*)take((size_t)TALL * 512 * 2);
  p.oC = (bf16_t*)take((size_t)TALL * 512 * 2);
  size_t r1_end = off;
  {
    size_t o2 = r1;
    p.act = (bf16_t*)(base + o2); o2 = align_up(o2 + (size_t)MAX_MBLK * MOE_BLK * 512 * 2, 256);
    p.ysl = (bf16_t*)(base + o2); o2 = align_up(o2 + (size_t)MAX_MBLK * MOE_BLK * 1024 * 2, 256);
    if (o2 > r1_end) off = o2;
  }
  p.KVt = (float*)take((size_t)32 * NCHUNK * 8192 * 4);
  p.SP = (bf16_t*)take((size_t)32 * NCHUNK * 8192 * 2);
  p.decay = (float*)take((size_t)32 * NCHUNK * 64 * 4);
  p.bcum = (float*)take((size_t)32 * NCHUNK * 4096 * 4);
  p.m = (bf16_t*)p.KVt;
  p.h2 = p.SP;
  if (off > ws_size) {
    fprintf(stderr, "workspace too small: need %zu have %zu\n", off, ws_size);
    return;
  }
  const dim3 blk(256);
#ifdef DIAG_STAGE
  {
    double* accum = (double*)take(64);
    float* xsave = (float*)take((size_t)64 * 1024 * 4);
    if (off > ws_size) return;
    const int G = 1024;
    const int DL = DIAG_LAYER, DS = DIAG_STAGE;
    k_diag_zero<<<1, 64, 0, stream>>>(accum);
    k_setup<<<((769 + 96) + 1) / 2, dim3(512), 0, stream>>>(p, 0);
    k_convert<<<((2048) + 1) / 2, dim3(512), 0, stream>>>(p, 0);
    k_modreduce<<<((240) + 1) / 2, dim3(512), 0, stream>>>(p, 0);
    k_rowpass0<<<((G) + 1) / 2, dim3(512), 0, stream>>>(p, 0);
    if (DS == 1 || DS == 0) k_chk_h<<<32, blk, 0, stream>>>(p, accum + 2);
    for (int l = 0; l <= DL; ++l) {
      const bool chk = (l == DL);
      k_inproj<<<((G) + 1) / 2, dim3(512), 0, stream>>>(p, l);
      if (chk && (DS == 2 || DS == 0)) k_chk_inproj<<<64, blk, 0, stream>>>(p, l, accum + 4);
      k_gla1<<<((G) + 1) / 2, dim3(512), 0, stream>>>(p, l);
      k_na<<<((1088) + 1) / 2, dim3(512), 0, stream>>>(p, l);
      if (chk && (DS == 4 || DS == 0)) k_chk_na<<<128, blk, 0, stream>>>(p, l, accum + 8);
      k_gla2<<<((G) + 1) / 2, dim3(512), 0, stream>>>(p, l);
      k_attnA<<<((1088) + 1) / 2, dim3(512), 0, stream>>>(p, l);
      if (chk && (DS == 3 || DS == 0)) k_chk_attnA<<<128, blk, 0, stream>>>(p, l, accum + 6);
      k_gla3<<<((1088) + 1) / 2, dim3(512), 0, stream>>>(p, l);
      if (chk && (DS == 5 || DS == 0)) k_chk_gla<<<16, blk, 0, stream>>>(p, l, accum + 10);
      k_merge<<<((G) + 1) / 2, dim3(512), 0, stream>>>(p, l);
      if (chk && (DS == 6 || DS == 0)) k_chk_merge<<<32, blk, 0, stream>>>(p, l, accum + 12);
      k_outproj<<<((G) + 1) / 2, dim3(512), 0, stream>>>(p, l);
      k_rowpass1<<<((G) + 1) / 2, dim3(512), 0, stream>>>(p, l);
      if (chk && l == 0 && (DS == 7 || DS == 0)) k_chk_x1<<<32, blk, 0, stream>>>(p, accum + 14);
      k_moescan<<<((32) + 1) / 2, dim3(512), 0, stream>>>(p, l);
      k_convert<<<((2048) + 1) / 2, dim3(512), 0, stream>>>(p, l | 16);
    k_moe1<<<((G) + 1) / 2, dim3(512), 0, stream>>>(p, l);
      k_moe2<<<((G) + 1) / 2, dim3(512), 0, stream>>>(p, l);
      if (chk && (DS == 8 || DS == 0)) k_chk_moe<<<32, blk, 0, stream>>>(p, l, 0, accum + 16);
      if (chk && DS == 9) k_chk_moe<<<512, blk, 0, stream>>>(p, l, 1, accum + 18);
      if (chk && (DS == 10 || DS == 0)) k_saverows<<<32, blk, 0, stream>>>(p, xsave, l);
      k_rowpass2<<<((G) + 1) / 2, dim3(512), 0, stream>>>(p, l);
      if (chk && (DS == 10 || DS == 0)) k_chk_final<<<32, blk, 0, stream>>>(p, l, xsave, accum + 20);
      if (l == 0) k_convert<<<((2048) + 1) / 2, dim3(512), 0, stream>>>(p, 1);
    }
    k_diag_report<<<1024, blk, 0, stream>>>(accum, p.out, TLAT * D);
    return;
  }
#endif
#ifdef MK_MULTI
  const int G = 1024;
  k_setup<<<((769 + 96) + 1) / 2, dim3(512), 0, stream>>>(p, 0);
  k_convert<<<((2048) + 1) / 2, dim3(512), 0, stream>>>(p, 0);
  k_modreduce<<<((240) + 1) / 2, dim3(512), 0, stream>>>(p, 0);
  k_rowpass0<<<((G) + 1) / 2, dim3(512), 0, stream>>>(p, 0);
  for (int l = 0; l < 2; ++l) {
    k_inproj<<<((G) + 1) / 2, dim3(512), 0, stream>>>(p, l);
    k_gla1<<<((G) + 1) / 2, dim3(512), 0, stream>>>(p, l);
    k_na<<<((1088) + 1) / 2, dim3(512), 0, stream>>>(p, l);
    k_gla2<<<((G) + 1) / 2, dim3(512), 0, stream>>>(p, l);
    k_attnA<<<((1088) + 1) / 2, dim3(512), 0, stream>>>(p, l);
    k_gla3<<<((1088) + 1) / 2, dim3(512), 0, stream>>>(p, l);
    k_merge<<<((G) + 1) / 2, dim3(512), 0, stream>>>(p, l);
    k_outproj<<<((G) + 1) / 2, dim3(512), 0, stream>>>(p, l);
    k_rowpass1<<<((G) + 1) / 2, dim3(512), 0, stream>>>(p, l);
    k_moescan<<<((32) + 1) / 2, dim3(512), 0, stream>>>(p, l);
    k_convert<<<((2048) + 1) / 2, dim3(512), 0, stream>>>(p, l | 16);
    k_moe1<<<((G) + 1) / 2, dim3(512), 0, stream>>>(p, l);
    k_moe2<<<((G) + 1) / 2, dim3(512), 0, stream>>>(p, l);
    k_rowpass2<<<((G) + 1) / 2, dim3(512), 0, stream>>>(p, l);
    if (l == 0) k_convert<<<((2048) + 1) / 2, dim3(512), 0, stream>>>(p, 1);
  }
#else
  static int grid_blocks = 0;
  if (!grid_blocks) {
    int dev = 0, cus = 0, per_cu = 0;
    hipGetDevice(&dev);
    hipDeviceGetAttribute(&cus, hipDeviceAttributeMultiprocessorCount, dev);
    hipOccupancyMaxActiveBlocksPerMultiprocessor(&per_cu, k_mega, 512, 0);
    per_cu = 1;
    grid_blocks = cus * per_cu;
  }
  hipMemsetAsync(p.bar, 0, XCD_BAR_WORDS * 4, stream);
  k_mega<<<dim3(grid_blocks), dim3(512), 0, stream>>>(p);
#endif
}
```

```cpp
#include <hip/hip_runtime.h>
#include <hip/hip_cooperative_groups.h>
#include <stdint.h>
#include <stdio.h>
namespace cg = cooperative_groups;

typedef unsigned short bf16_t;
typedef __attribute__((ext_vector_type(8))) short bf16x8;
typedef __attribute__((ext_vector_type(4))) short bf16x4;
typedef __attribute__((ext_vector_type(16))) float f32x16;
typedef __attribute__((ext_vector_type(4))) unsigned u32x4;
typedef __attribute__((ext_vector_type(4))) float f32x4v;

#ifndef XCD_MAP_ENABLE
#define XCD_MAP_ENABLE 0
#endif
constexpr int D = 1024;
constexpr int TLAT = 16384, TCTX = 1024, TALL = 17408, PALL = 4352;
constexpr int NIN_SRC = 6944, NMOD = 6144;
constexpr int NT_IN = 31;
constexpr int SMEM_BYTES = 69632;
constexpr int LDC = 132;
constexpr float LOG2E = 1.4426950408889634f;
constexpr float QSCALE = 0.125f * LOG2E;
constexpr float ALPHA = 1.4142135623730951f;
constexpr int NCHUNK = 68;
constexpr int MOE_CAP = TALL;
constexpr int MOE_BLK = 256;
constexpr int MAX_MBLK = 168;

struct Params {
  const float *x, *c, *ctx, *c_ctx, *w_mod, *b_mod, *w_in, *b_in, *q_norm, *k_norm, *gla_wg, *gla_bg, *gla_norm, *rpb,
      *w_br_attn, *w_br_gla, *w_br_na, *w_out, *ln1_g, *ln1_b, *w_rg, *b_rg, *w_re, *b_re, *w1, *w3, *w2, *ln2_g, *ln2_b;
  float* out;
  float *mod_part, *mod, *rope, *wrp;
  bf16_t *wt_in, *wt_gate, *wt_br, *wt_out, *wt_13, *wt_2, *G;
  float* xres;
  bf16_t *h, *h2;
  bf16_t *qA, *kA, *vAT, *qB, *kB, *vBT, *rB;
  float* aB;
  bf16_t *qC, *kC, *vCT;
  bf16_t *oA, *oB, *oC;
  float* KVt;
  float* bcum;
  bf16_t* SP;
  float* decay;
  bf16_t* m;
  bf16_t *act, *ysl;
  int *cnt, *cntg, *list, *tok_e, *tok_pos, *estart;
  float* tok_gate;
  unsigned* bar;
};

typedef const __attribute__((address_space(4))) Params& PRef;
__device__ __forceinline__ PRef params_view() {
  const __attribute__((address_space(4))) Params* pp = (const __attribute__((address_space(4))) Params*)__builtin_amdgcn_kernarg_segment_ptr();
  asm volatile("" : "+s"(pp));
  return *pp;
}

__device__ __forceinline__ int tid_() { int t = __builtin_amdgcn_workitem_id_x() & 255; asm volatile("" : "+v"(t)); return t; }
__device__ __forceinline__ int half_() { int h = __builtin_amdgcn_readfirstlane(__builtin_amdgcn_workitem_id_x() >> 8); asm volatile("" : "+s"(h)); return h; }
__device__ __forceinline__ int bid_() { int t = 2 * __builtin_amdgcn_workgroup_id_x() + half_(); asm volatile("" : "+s"(t)); return t; }
__device__ __forceinline__ int vgrid_() { return 2 * (int)gridDim.x; }
typedef __attribute__((ext_vector_type(2))) __bf16 bf16x2n;
typedef __attribute__((ext_vector_type(2))) float f32x2n;
__device__ __forceinline__ bf16_t f2bf(float f) { return __builtin_bit_cast(bf16_t, (__bf16)f); }
__device__ __forceinline__ float bf2f(bf16_t b) { return __uint_as_float(((unsigned)b) << 16); }
__device__ __forceinline__ unsigned pack2(float a, float b) {
  f32x2n v = {a, b};
  return __builtin_bit_cast(unsigned, __builtin_convertvector(v, bf16x2n));
}
__device__ __forceinline__ float wave_sum(float v) {
  int x;
  x = __builtin_amdgcn_update_dpp(0, __float_as_int(v), 0xB1, 0xf, 0xf, true);  v += __int_as_float(x);
  x = __builtin_amdgcn_update_dpp(0, __float_as_int(v), 0x4E, 0xf, 0xf, true);  v += __int_as_float(x);
  x = __builtin_amdgcn_update_dpp(0, __float_as_int(v), 0x141, 0xf, 0xf, true); v += __int_as_float(x);
  x = __builtin_amdgcn_update_dpp(0, __float_as_int(v), 0x140, 0xf, 0xf, true); v += __int_as_float(x);
  x = __builtin_amdgcn_update_dpp(0, __float_as_int(v), 0x142, 0xa, 0xf, false); v += __int_as_float(x);
  x = __builtin_amdgcn_update_dpp(0, __float_as_int(v), 0x143, 0xc, 0xf, false); v += __int_as_float(x);
  return __int_as_float(__builtin_amdgcn_readlane(__float_as_int(v), 63));
}
__device__ __forceinline__ float siluf(float x) { return x * __builtin_amdgcn_rcpf(1.f + __expf(-x)); }
__device__ __forceinline__ float sigmoidf_(float x) { return __builtin_amdgcn_rcpf(1.f + __expf(-x)); }
__device__ __forceinline__ f32x16 zero16() {
  f32x16 z;
#pragma unroll
  for (int i = 0; i < 16; ++i) z[i] = 0.f;
  return z;
}
__device__ __forceinline__ f32x16 mfma32(bf16x8 a, bf16x8 b, f32x16 c) {
  return __builtin_amdgcn_mfma_f32_32x32x16_bf16(a, b, c, 0, 0, 0);
}
__device__ __forceinline__ int tok_modrow(int tok) { return tok < TLAT ? (tok >> 12) : 4; }

__device__ __forceinline__ void phase_setup(PRef p, char* smem) {
  float* sS = (float*)smem;
  const int tid = tid_();
  for (int item = bid_(); item < 769 + 96; item += vgrid_()) {
    if (item >= 769) {
      int it = item - 769;
      int l = it / 48, chunk = it % 48;
      for (int i = tid; i < 1024; i += 256) {
        int idx = chunk * 1024 + i;
        int e = idx & 3, ln = (idx >> 2) & 63, t = (idx >> 8) & 63, nt = idx >> 14;
        int k = 16 * t + 4 * (ln >> 4) + e, n = 16 * nt + (ln & 15);
        float v = 0.f;
        if (n < 32) v = p.w_re[((size_t)l * 1024 + k) * 32 + n];
        else if (n < 36) v = p.w_rg[((size_t)l * 1024 + k) * 4 + (n - 32)];
        p.wrp[(size_t)l * 49152 + idx] = v;
      }
      continue;
    }
    if (item == 768) {
      for (int i = tid; i < 1024; i += 256) {
        int pos = i >> 4, f = i & 15;
        float inv = powf(10000.f, -(float)f / 16.f);
        float ang = (float)pos * inv;
        p.rope[i] = cosf(ang);
        p.rope[1024 + i] = sinf(ang);
      }
      continue;
    }
    int nb = item % 24, ks = (item / 24) % 16, l = item / 384;
    __syncthreads();
    for (int i = tid; i < 320; i += 256) {
      int r = i >> 6, k = ks * 64 + (i & 63);
      float cv = (r < 4) ? p.c[r * 1024 + k] : p.c_ctx[k];
      sS[i] = siluf(cv);
    }
    __syncthreads();
    int n = nb * 256 + tid;
    const float* w = p.w_mod + ((size_t)l * 1024 + ks * 64) * NMOD + n;
    float acc[5] = {0.f, 0.f, 0.f, 0.f, 0.f};
#pragma unroll
    for (int k0 = 0; k0 < 64; k0 += 32) {
      float wv[32];
#pragma unroll
      for (int k = 0; k < 32; ++k) wv[k] = w[(size_t)(k0 + k) * NMOD];
#pragma unroll
      for (int k = 0; k < 32; ++k)
#pragma unroll
        for (int r = 0; r < 5; ++r) acc[r] += sS[r * 64 + k0 + k] * wv[k];
    }
#pragma unroll
    for (int r = 0; r < 5; ++r) p.mod_part[(((size_t)ks * 2 + l) * 5 + r) * NMOD + n] = acc[r];
  }
}
__device__ __forceinline__ void phase_modreduce(PRef p) {
  for (int i = bid_() * 256 + tid_(); i < 2 * 5 * NMOD; i += vgrid_() * 256) {
    int n = i % NMOD, l = i / (5 * NMOD);
    float s = p.b_mod[l * NMOD + n];
#pragma unroll
    for (int ks = 0; ks < 16; ++ks) s += p.mod_part[(size_t)ks * 2 * 5 * NMOD + i];
    p.mod[i] = s;
  }
}

constexpr int CV_IN = 16 * 62, CV_GATE = 16 * 48, CV_BR = 8 * 16, CV_OUT = 16 * 16, CV_13 = 16 * 16, CV_2 = 8 * 16;
constexpr int CV_O1 = CV_IN, CV_O2 = CV_O1 + CV_GATE, CV_O3 = CV_O2 + 3 * CV_BR, CV_O4 = CV_O3 + CV_OUT, CV_O5 = CV_O4 + 32 * CV_13,
              CV_TOTAL = CV_O5 + 32 * CV_2;
struct ConvDesc { const float* src; int ldsrc; int ncols; bf16_t* dst; int lddst; };
__device__ __forceinline__ ConvDesc conv_desc(PRef p, int layer, int item) {
  ConvDesc d;
  d.ncols = 64;
  if (item < CV_O1) {
    int kt = item & 15, ntile = item >> 4;
    int n0 = ntile * 64, srccol;
    if (n0 < 2304) srccol = n0;
    else if (n0 < 3840) srccol = n0 + 32;
    else if (n0 == 3840) { srccol = 2304; d.ncols = 32; }
    else { srccol = 0; d.ncols = 0; }
    d.src = p.w_in + (size_t)layer * 1024 * NIN_SRC + (size_t)(kt * 64) * NIN_SRC + srccol; d.ldsrc = NIN_SRC;
    d.dst = p.wt_in + (size_t)n0 * 1024 + kt * 64; d.lddst = 1024;
  } else if (item < CV_O2) {
    int it = item - CV_O1, kt = it & 15, ntile = it >> 4;
    d.src = p.w_in + (size_t)layer * 1024 * NIN_SRC + (size_t)(kt * 64) * NIN_SRC + 3872 + ntile * 64; d.ldsrc = NIN_SRC;
    d.dst = p.wt_gate + (size_t)(ntile * 64) * 1024 + kt * 64; d.lddst = 1024;
  } else if (item < CV_O3) {
    int it = item - CV_O2, br = it / CV_BR, t = it % CV_BR, kt = t & 7, ntile = t >> 3;
    const float* s0 = (br == 0 ? p.w_br_attn : (br == 1 ? p.w_br_gla : p.w_br_na)) + (size_t)layer * 512 * 1024;
    d.src = s0 + (size_t)(kt * 64) * 1024 + ntile * 64; d.ldsrc = 1024;
    d.dst = p.wt_br + (size_t)br * 1024 * 512 + (size_t)(ntile * 64) * 512 + kt * 64; d.lddst = 512;
  } else if (item < CV_O4) {
    int it = item - CV_O3, kt = it & 15, ntile = it >> 4;
    d.src = p.w_out + (size_t)layer * 1024 * 1024 + (size_t)(kt * 64) * 1024 + ntile * 64; d.ldsrc = 1024;
    d.dst = p.wt_out + (size_t)(ntile * 64) * 1024 + kt * 64; d.lddst = 1024;
  } else if (item < CV_O5) {
    int it = item - CV_O4, e = it >> 8, t = it & 255, kt = t & 15, ntile = t >> 4;
    int j = ntile >> 1, isw3 = ntile & 1;
    d.src = (isw3 ? p.w3 : p.w1) + ((size_t)layer * 32 + e) * 1024 * 512 + (size_t)(kt * 64) * 512 + j * 64; d.ldsrc = 512;
    d.dst = p.wt_13 + (size_t)e * 1024 * 1024 + (size_t)(ntile * 64) * 1024 + kt * 64; d.lddst = 1024;
  } else {
    int it = item - CV_O5, e = it >> 7, t = it & 127, kt = t & 7, ntile = t >> 3;
    d.src = p.w2 + ((size_t)layer * 32 + e) * 512 * 1024 + (size_t)(kt * 64) * 1024 + ntile * 64; d.ldsrc = 1024;
    d.dst = p.wt_2 + (size_t)e * 1024 * 512 + (size_t)(ntile * 64) * 512 + kt * 64; d.lddst = 512;
  }
  return d;
}
__device__ __forceinline__ void conv_load8(const ConvDesc& d, int nhalf, int lane, f32x4v (&v)[8]) {
  const int kb = lane >> 3, c0 = nhalf * 32 + (lane & 7) * 4;
  const float* sp = d.src + (size_t)(kb * 8) * d.ldsrc + c0;
  const bool ok = c0 < d.ncols;
#pragma unroll
  for (int j = 0; j < 8; ++j) {
    f32x4v z = {0.f, 0.f, 0.f, 0.f};
    v[j] = ok ? *(const f32x4v*)(sp + (size_t)j * d.ldsrc) : z;
  }
}
__device__ __forceinline__ void phase_convert(PRef p, int layer_part, char* smem) {
  const int tid = tid_(), lane = tid & 63, w = tid >> 6;
  const int layer = layer_part & 15, part = layer_part >> 4;
  const int begin = part ? CV_O4 : 0, ntiles = part ? (CV_TOTAL - CV_O4) : CV_O4;
  const int nw = vgrid_() * 4;
  int wt = bid_() * 4 + w;
  if (wt >= 2 * ntiles) return;
  ConvDesc d0 = conv_desc(p, layer, begin + (wt >> 1));
  f32x4v v0[8], v1[8];
  conv_load8(d0, wt & 1, lane, v0);
  for (;;) {
    const int nwt = wt + nw;
    const bool more = nwt < 2 * ntiles;
    ConvDesc d1 = d0;
    if (more) { d1 = conv_desc(p, layer, begin + (nwt >> 1)); conv_load8(d1, nwt & 1, lane, v1); }
    {
      const int kb = lane >> 3, c0 = (wt & 1) * 32 + (lane & 7) * 4;
      bf16_t* dp = d0.dst + (size_t)c0 * d0.lddst + kb * 8;
#pragma unroll
      for (int c = 0; c < 4; ++c) {
        const uint4 o = make_uint4(pack2(v0[0][c], v0[1][c]), pack2(v0[2][c], v0[3][c]), pack2(v0[4][c], v0[5][c]), pack2(v0[6][c], v0[7][c]));
        *(uint4*)(dp + (size_t)c * d0.lddst) = o;
      }
    }
    if (!more) break;
    wt = nwt;
    d0 = d1;
#pragma unroll
    for (int j = 0; j < 8; ++j) v0[j] = v1[j];
  }
}

__device__ __forceinline__ void row_stats(const float (&v)[16], float& mean, float& rstd) {
  float s = 0.f;
#pragma unroll
  for (int i = 0; i < 16; ++i) s += v[i];
  mean = wave_sum(s) * (1.f / 1024.f);
  float q = 0.f;
#pragma unroll
  for (int i = 0; i < 16; ++i) { float d = v[i] - mean; q += d * d; }
  float var = wave_sum(q) * (1.f / 1024.f);
  rstd = rsqrtf(var + 1e-6f);
}
__device__ __forceinline__ void load_row(const float* src, int lane, float (&v)[16]) {
#pragma unroll
  for (int i = 0; i < 4; ++i) {
    float4 t = *(const float4*)(src + lane * 4 + 256 * i);
    v[4 * i] = t.x; v[4 * i + 1] = t.y; v[4 * i + 2] = t.z; v[4 * i + 3] = t.w;
  }
}
__device__ __forceinline__ void store_row(float* dst, int lane, const float (&v)[16]) {
#pragma unroll
  for (int i = 0; i < 4; ++i) *(float4*)(dst + lane * 4 + 256 * i) = make_float4(v[4 * i], v[4 * i + 1], v[4 * i + 2], v[4 * i + 3]);
}
__device__ __forceinline__ void store_row_bf(bf16_t* dst, int lane, const float (&v)[16]) {
#pragma unroll
  for (int i = 0; i < 4; ++i) {
    uint2 o = make_uint2(pack2(v[4 * i], v[4 * i + 1]), pack2(v[4 * i + 2], v[4 * i + 3]));
    *(uint2*)(dst + lane * 4 + 256 * i) = o;
  }
}
__device__ __forceinline__ void modulate_row(const float (&x)[16], const float* shift, const float* scale, int lane, float (&h)[16]) {
  float mean, rstd;
  row_stats(x, mean, rstd);
  float sh[16], sc[16];
  load_row(shift, lane, sh);
  load_row(scale, lane, sc);
#pragma unroll
  for (int i = 0; i < 16; ++i) h[i] = (x[i] - mean) * rstd * (1.f + sc[i]) + sh[i];
}

__device__ __forceinline__ void phase_rowpass0(PRef p) {
  const int lane = tid_() & 63, w = tid_() >> 6;
  for (int tok = bid_() * 4 + w; tok < TALL; tok += vgrid_() * 4) {
    const float* src = tok < TLAT ? p.x + (size_t)tok * D : p.ctx + (size_t)(tok - TLAT) * D;
    const float* md = p.mod + (size_t)tok_modrow(tok) * NMOD;
    float x[16], h[16];
    load_row(src, lane, x);
    modulate_row(x, md, md + 1024, lane, h);
    store_row_bf(p.h + (size_t)tok * D, lane, h);
  }
}

typedef __attribute__((ext_vector_type(4))) float f32x4;
__device__ __forceinline__ void phase_rowpass1(PRef p, int layer, char* smem) {
  float* sH = (float*)smem;
  float* sPart = (float*)smem;
  int* sE = (int*)(smem + 16384);
  const int tid = tid_(), lane = tid & 63, w = tid >> 6;
  const int ntok = layer == 0 ? TALL : TLAT;
  const float* lg = p.ln1_g + layer * D;
  const float* lb = p.ln1_b + layer * D;
  const float* wrp = p.wrp + (size_t)layer * 49152;
  for (int g0 = bid_() * 16; g0 < ntok; g0 += vgrid_() * 16) {
    __syncthreads();
    {
      float v[4][16];
#pragma unroll
      for (int rr = 0; rr < 4; ++rr) load_row(p.xres + (size_t)(g0 + w * 4 + rr) * D, lane, v[rr]);
      float gg[16], bb[16];
      load_row(lg, lane, gg);
      load_row(lb, lane, bb);
#pragma unroll
      for (int rr = 0; rr < 4; ++rr) {
        const int tok = g0 + w * 4 + rr;
        float mean, rstd;
        row_stats(v[rr], mean, rstd);
        float x1[16], h2[16];
#pragma unroll
        for (int i = 0; i < 16; ++i) x1[i] = (v[rr][i] - mean) * rstd * gg[i] + bb[i];
        store_row(p.xres + (size_t)tok * D, lane, x1);
        const float* md = p.mod + ((size_t)layer * 5 + tok_modrow(tok)) * NMOD;
        modulate_row(x1, md + 3072, md + 4096, lane, h2);
        store_row_bf(p.h2 + (size_t)tok * D, lane, h2);
        store_row(sH + (w * 4 + rr) * 1028, lane, h2);
      }
    }
    __syncthreads();
    f32x4 acc0 = {0.f, 0.f, 0.f, 0.f}, acc1 = acc0, acc2 = acc0;
    {
      const float* ap = sH + (lane & 15) * 1028 + 4 * (lane >> 4) + 256 * w;
      const float* bp = wrp + (size_t)(16 * w) * 256 + lane * 4;
#pragma unroll 8
      for (int t = 0; t < 16; ++t) {
        float4 a = *(const float4*)(ap + 16 * t);
        float4 b0 = *(const float4*)(bp + t * 256);
        float4 b1 = *(const float4*)(bp + t * 256 + 16384);
        float4 b2 = *(const float4*)(bp + t * 256 + 32768);
        acc0 = __builtin_amdgcn_mfma_f32_16x16x4f32(a.x, b0.x, acc0, 0, 0, 0);
        acc1 = __builtin_amdgcn_mfma_f32_16x16x4f32(a.x, b1.x, acc1, 0, 0, 0);
        acc2 = __builtin_amdgcn_mfma_f32_16x16x4f32(a.x, b2.x, acc2, 0, 0, 0);
        acc0 = __builtin_amdgcn_mfma_f32_16x16x4f32(a.y, b0.y, acc0, 0, 0, 0);
        acc1 = __builtin_amdgcn_mfma_f32_16x16x4f32(a.y, b1.y, acc1, 0, 0, 0);
        acc2 = __builtin_amdgcn_mfma_f32_16x16x4f32(a.y, b2.y, acc2, 0, 0, 0);
        acc0 = __builtin_amdgcn_mfma_f32_16x16x4f32(a.z, b0.z, acc0, 0, 0, 0);
        acc1 = __builtin_amdgcn_mfma_f32_16x16x4f32(a.z, b1.z, acc1, 0, 0, 0);
        acc2 = __builtin_amdgcn_mfma_f32_16x16x4f32(a.z, b2.z, acc2, 0, 0, 0);
        acc0 = __builtin_amdgcn_mfma_f32_16x16x4f32(a.w, b0.w, acc0, 0, 0, 0);
        acc1 = __builtin_amdgcn_mfma_f32_16x16x4f32(a.w, b1.w, acc1, 0, 0, 0);
        acc2 = __builtin_amdgcn_mfma_f32_16x16x4f32(a.w, b2.w, acc2, 0, 0, 0);
      }
    }
    __syncthreads();
#pragma unroll
    for (int g = 0; g < 4; ++g) {
      const int row = (lane >> 4) * 4 + g, col = lane & 15;
      sPart[(w * 16 + row) * 48 + col] = acc0[g];
      sPart[(w * 16 + row) * 48 + 16 + col] = acc1[g];
      sPart[(w * 16 + row) * 48 + 32 + col] = acc2[g];
    }
    __syncthreads();
    if (tid < 16) {
      int tok = g0 + tid;
      const float* l0 = sPart + tid * 48;
      float g[4];
#pragma unroll
      for (int i = 0; i < 4; ++i) g[i] = ((l0[32 + i] + l0[768 + 32 + i]) + (l0[1536 + 32 + i] + l0[2304 + 32 + i])) + p.b_rg[layer * 4 + i];
      int grp = 0;
      float gm = g[0];
#pragma unroll
      for (int i = 1; i < 4; ++i) if (g[i] > gm) { gm = g[i]; grp = i; }
      float gs = 0.f;
#pragma unroll
      for (int i = 0; i < 4; ++i) gs += __expf(g[i] - gm);
      float pg = 1.f / gs;
      float sv[8];
#pragma unroll
      for (int i = 0; i < 8; ++i) {
        const int c = grp * 8 + i;
        sv[i] = ((l0[c] + l0[768 + c]) + (l0[1536 + c] + l0[2304 + c])) + p.b_re[layer * 32 + c];
      }
      int i0 = 0;
      float v0 = sv[0];
#pragma unroll
      for (int i = 1; i < 8; ++i) if (sv[i] > v0) { v0 = sv[i]; i0 = i; }
      int i1 = -1;
      float v1 = -3.0e38f;
#pragma unroll
      for (int i = 0; i < 8; ++i) if (i != i0 && sv[i] > v1) { v1 = sv[i]; i1 = i; }
      float e1 = __expf(v1 - v0);
      float w0 = pg / (1.f + e1), w1 = pg * e1 / (1.f + e1);
      int ex0 = grp * 8 + i0, ex1 = grp * 8 + i1;
      sE[tid * 2] = ex0; sE[tid * 2 + 1] = ex1;
      p.tok_e[tok * 2] = ex0; p.tok_e[tok * 2 + 1] = ex1;
      p.tok_gate[tok * 2] = w0; p.tok_gate[tok * 2 + 1] = w1;
    }
    __syncthreads();
    if (tid < 32) {
      int c = 0;
#pragma unroll 8
      for (int i = 0; i < 32; ++i) c += (sE[i] == tid) ? 1 : 0;
      p.cntg[(size_t)(g0 >> 4) * 32 + tid] = c;
      const int mine = sE[tid];
      int rk = 0;
      for (int i = 0; i < (tid & ~1); ++i) rk += (sE[i] == mine) ? 1 : 0;
      p.tok_pos[(g0 + (tid >> 1)) * 2 + (tid & 1)] = rk;
    }
  }
}

__device__ __forceinline__ void phase_moescan(PRef p, int layer, char* smem) {
  int* sOff = (int*)smem;
  int* sScan = sOff + 1280;
  const int tid = tid_();
  const int e = bid_();
  if (e >= 32) return;
  const int ntok = layer == 0 ? TALL : TLAT;
  const int ng = ntok >> 4;
  __syncthreads();
  int loc[5], s = 0;
#pragma unroll
  for (int i = 0; i < 5; ++i) {
    const int g = tid * 5 + i;
    loc[i] = g < ng ? p.cntg[(size_t)g * 32 + e] : 0;
    s += loc[i];
  }
  sScan[tid] = s;
  __syncthreads();
  for (int o = 1; o < 256; o <<= 1) {
    int v = tid >= o ? sScan[tid - o] : 0;
    __syncthreads();
    sScan[tid] += v;
    __syncthreads();
  }
  int run = sScan[tid] - s;
#pragma unroll
  for (int i = 0; i < 5; ++i) { sOff[tid * 5 + i] = run; run += loc[i]; }
  if (tid == 255) p.cnt[e] = sScan[255];
  __syncthreads();
  typedef int i32x2v __attribute__((ext_vector_type(2)));
  for (int base = 0; base < ntok; base += 2048) {
    i32x2v te[8], tp[8];
#pragma unroll
    for (int u = 0; u < 8; ++u) {
      const int tok = base + u * 256 + tid;
      const int tc = tok < ntok ? tok : 0;
      te[u] = *(const i32x2v*)(p.tok_e + tc * 2);
      tp[u] = *(const i32x2v*)(p.tok_pos + tc * 2);
      if (tok >= ntok) te[u] = (i32x2v){-1, -1};
    }
#pragma unroll
    for (int u = 0; u < 8; ++u) {
      const int tok = base + u * 256 + tid;
      if (te[u][0] == e) { const int pos = sOff[tok >> 4] + tp[u][0]; p.list[e * MOE_CAP + pos] = tok; p.tok_pos[tok * 2] = pos; }
      if (te[u][1] == e) { const int pos = sOff[tok >> 4] + tp[u][1]; p.list[e * MOE_CAP + pos] = tok; p.tok_pos[tok * 2 + 1] = pos; }
    }
  }
}

__device__ __forceinline__ void phase_rowpass2(PRef p, int layer) {
  const int lane = tid_() & 63, w = tid_() >> 6;
  const bool last = layer == 1;
  const int ntok = last ? TLAT : TALL;
  const float* lg = p.ln2_g + layer * D;
  const float* lb = p.ln2_b + layer * D;
  const int stride = vgrid_() * 4;
  for (int tokA = bid_() * 4 + w; tokA < ntok; tokA += 2 * stride) {
    const bool hasB = tokA + stride < ntok;
    int tk[2];
    tk[0] = tokA; tk[1] = hasB ? tokA + stride : tokA;
    int s0[2], s1[2];
    float w0[2], w1[2];
#pragma unroll
    for (int u = 0; u < 2; ++u) {
      const int t = tk[u];
      const int e0 = p.tok_e[t * 2], e1 = p.tok_e[t * 2 + 1];
      s0[u] = p.estart[e0] * MOE_BLK + p.tok_pos[t * 2];
      s1[u] = p.estart[e1] * MOE_BLK + p.tok_pos[t * 2 + 1];
      w0[u] = p.tok_gate[t * 2]; w1[u] = p.tok_gate[t * 2 + 1];
    }
    float x1[2][16], g2[2][16];
    uint2 ya[2][4], yb[2][4];
#pragma unroll
    for (int u = 0; u < 2; ++u) {
      const int t = tk[u];
      load_row(p.xres + (size_t)t * D, lane, x1[u]);
      load_row(p.mod + ((size_t)layer * 5 + tok_modrow(t)) * NMOD + 5120, lane, g2[u]);
      const bf16_t* y0 = p.ysl + (size_t)s0[u] * D;
      const bf16_t* y1 = p.ysl + (size_t)s1[u] * D;
#pragma unroll
      for (int i = 0; i < 4; ++i) { ya[u][i] = *(const uint2*)(y0 + lane * 4 + 256 * i); yb[u][i] = *(const uint2*)(y1 + lane * 4 + 256 * i); }
    }
    float gg[16], bb[16];
    load_row(lg, lane, gg);
    load_row(lb, lane, bb);
#pragma unroll
    for (int u = 0; u < 2; ++u) {
      if (u == 1 && !hasB) break;
      const int tok = tk[u];
      float v[16], x2[16];
#pragma unroll
      for (int i = 0; i < 4; ++i) {
        const uint2 a = ya[u][i], b = yb[u][i];
        float fa[4] = {bf2f(a.x & 0xffff), bf2f(a.x >> 16), bf2f(a.y & 0xffff), bf2f(a.y >> 16)};
        float fb[4] = {bf2f(b.x & 0xffff), bf2f(b.x >> 16), bf2f(b.y & 0xffff), bf2f(b.y >> 16)};
#pragma unroll
        for (int e = 0; e < 4; ++e) v[4 * i + e] = ALPHA * x1[u][4 * i + e] + g2[u][4 * i + e] * (w0[u] * fa[e] + w1[u] * fb[e]);
      }
      float mean, rstd;
      row_stats(v, mean, rstd);
#pragma unroll
      for (int i = 0; i < 16; ++i) x2[i] = (v[i] - mean) * rstd * gg[i] + bb[i];
      if (last) {
        store_row(p.out + (size_t)tok * D, lane, x2);
      } else {
        store_row(p.xres + (size_t)tok * D, lane, x2);
        const float* mdn = p.mod + ((size_t)(layer + 1) * 5 + tok_modrow(tok)) * NMOD;
        float h[16];
        modulate_row(x2, mdn, mdn + 1024, lane, h);
        store_row_bf(p.h + (size_t)tok * D, lane, h);
      }
    }
  }
}

struct Ptr4 { const bf16_t* p[4]; };

template <int NJ>
__device__ __forceinline__ void gemm_compute_tile(const char* cA, const char* cB, int r, int hh, f32x16 (&acc)[2][NJ]) {
#pragma unroll
  for (int s = 0; s < 4; ++s) {
    const int co = ((2 * s + hh) ^ ((r >> 1) & 7)) << 4;
    bf16x8 a0 = *(const bf16x8*)(cA + co);
    bf16x8 a1 = *(const bf16x8*)(cA + 4096 + co);
    bf16x8 b[NJ];
#pragma unroll
    for (int j = 0; j < NJ; ++j) b[j] = *(const bf16x8*)(cB + j * 4096 + co);
#pragma unroll
    for (int j = 0; j < NJ; ++j) {
      acc[0][j] = mfma32(a0, b[j], acc[0][j]);
      acc[1][j] = mfma32(a1, b[j], acc[1][j]);
    }
  }
}
#define LAS3 __attribute__((address_space(3)))
__device__ __forceinline__ void dma_sync() { asm volatile("s_waitcnt vmcnt(0)" ::: "memory"); __syncthreads(); }
template <int NJ>
__device__ __forceinline__ void g_stage(const Ptr4& ap, const Ptr4& bp, int kt, char* dA, char* dB) {
#pragma unroll
  for (int i = 0; i < 4; ++i) __builtin_amdgcn_global_load_lds((const unsigned*)(ap.p[i] + kt * 64), (LAS3 unsigned*)(dA + i * 4096), 16, 0, 0);
#pragma unroll
  for (int i = 0; i < 2 * NJ; ++i) __builtin_amdgcn_global_load_lds((const unsigned*)(bp.p[i] + kt * 64), (LAS3 unsigned*)(dB + i * 4096), 16, 0, 0);
}
template <int NJ>
__device__ __forceinline__ void gemm_mainloop(const Ptr4& ap, const Ptr4& bp, int nk, f32x16 (&acc)[2][NJ], char* smem) {
  const int tid = tid_(), lane = tid & 63, w = tid >> 6, wr = w >> 1, wc = w & 1, r = lane & 31, hh = lane >> 5;
  char* sA = smem;
  char* sB = smem + 32768;
  const int dofs = tid * 16;
  g_stage<NJ>(ap, bp, 0, sA + dofs, sB + dofs);
  dma_sync();
  const char* cA = sA + (wr * 64 + r) * 128;
  const char* cB = sB + (wc * 32 * NJ + r) * 128;
  for (int kt = 0; kt < nk; ++kt) {
    const int cur = kt & 1;
    if (kt + 1 < nk) g_stage<NJ>(ap, bp, kt + 1, sA + (cur ^ 1) * 16384 + dofs, sB + (cur ^ 1) * 16384 + dofs);
    gemm_compute_tile<NJ>(cA + cur * 16384, cB + cur * 16384, r, hh, acc);
    dma_sync();
  }
}
__device__ __forceinline__ Ptr4 rows_contig(const bf16_t* base, int ld) {
  Ptr4 q;
  const int lrow = tid_() >> 3, lch = tid_() & 7;
#pragma unroll
  for (int i = 0; i < 4; ++i) q.p[i] = base + (size_t)(lrow + 32 * i) * ld + ((lch ^ ((lrow >> 1) & 7)) * 8);
  return q;
}
__device__ __forceinline__ void acc_to_lds(const f32x16 (&acc)[2][2], float* sC) {
  const int lane = tid_() & 63, w = tid_() >> 6, wr = w >> 1, wc = w & 1, r = lane & 31, hh = lane >> 5;
#pragma unroll
  for (int i = 0; i < 2; ++i)
#pragma unroll
    for (int j = 0; j < 2; ++j)
#pragma unroll
      for (int g = 0; g < 16; ++g) {
        int row = wr * 64 + i * 32 + (g & 3) + 8 * (g >> 2) + 4 * hh, col = wc * 64 + j * 32 + r;
        sC[row * LDC + col] = acc[i][j][g];
      }
}
__device__ __forceinline__ void acc_to_lds_T(const f32x16 (&acc)[2][2], float* sC) {
  const int lane = tid_() & 63, w = tid_() >> 6, wr = w >> 1, wc = w & 1, r = lane & 31, hh = lane >> 5;
#pragma unroll
  for (int i = 0; i < 2; ++i)
#pragma unroll
    for (int j = 0; j < 2; ++j)
#pragma unroll
      for (int g4 = 0; g4 < 4; ++g4) {
        int row = wr * 64 + i * 32 + 8 * g4 + 4 * hh, col = wc * 64 + j * 32 + r;
        *(float4*)(sC + col * LDC + row) = make_float4(acc[i][j][4 * g4], acc[i][j][4 * g4 + 1], acc[i][j][4 * g4 + 2], acc[i][j][4 * g4 + 3]);
      }
}
__device__ __forceinline__ void lds_read8(const float* s, float (&v)[8]) {
  float4 a = *(const float4*)s, b = *(const float4*)(s + 4);
  v[0] = a.x; v[1] = a.y; v[2] = a.z; v[3] = a.w; v[4] = b.x; v[5] = b.y; v[6] = b.z; v[7] = b.w;
}
__device__ __forceinline__ uint4 pack8(const float (&v)[8]) {
  return make_uint4(pack2(v[0], v[1]), pack2(v[2], v[3]), pack2(v[4], v[5]), pack2(v[6], v[7]));
}
__device__ __forceinline__ void st_nt16(void* q, const uint4 v) {
  typedef unsigned nt_u32x4 __attribute__((ext_vector_type(4)));
  const nt_u32x4 t = {v.x, v.y, v.z, v.w};
  __builtin_nontemporal_store(t, (nt_u32x4*)q);
}


__device__ __forceinline__ int xcd_rounds(const char*, int nMt, int nNt) { return (nMt * nNt + vgrid_() - 1) / vgrid_(); }
__device__ __forceinline__ bool xcd_tile(const char*, int round, int nMt, int nNt, int& mt, int& nt) {
  const int item = round * vgrid_() + bid_();
  mt = item / nNt; nt = item % nNt;
  return item < nMt * nNt;
}

namespace pg8 {
constexpr int BK = 64, HALF = 128, HTB = HALF * BK * 2, STAGE_BYTES = 8 * HTB;
__device__ __forceinline__ int lds_byte(int r, int c) { const int st = (r >> 4) * 2 + (c >> 5), rr = r & 15, cc = c & 31, ob = rr * 64 + cc * 2; return st * 1024 + (ob ^ (((ob >> 9) & 1) << 5)); }
__device__ __forceinline__ void stage_rc(int b, int& R, int& C) { const int st = b / 1024, sb = b % 1024, swz = sb ^ (((sb >> 9) & 1) << 5); R = (st >> 1) * 16 + swz / 64; C = (st & 1) * 32 + (swz % 64) / 2; }
typedef float f32x4 __attribute__((ext_vector_type(4)));
__device__ __forceinline__ int perm32(int rho) { const int n = rho >> 4, i = rho & 15; return 8 * (i >> 2) + 4 * n + (i & 3); }
template <bool PERM = false>
__device__ __forceinline__ void gemm_unit(LAS3 unsigned char* lds, const char* cA0, const char* cA1, const unsigned (&voffA0)[2], const unsigned (&voffA1)[2],
                                          const char* cB, int K, f32x4 (&acc)[2][2][4][2]) {
  int tid = __builtin_amdgcn_workitem_id_x();
  asm volatile("" : "+v"(tid));
  const int wid = __builtin_amdgcn_readfirstlane(tid >> 6), lane = tid & 63, wr = wid >> 2, wc = wid & 3, fr = lane & 15, fq = lane >> 4;
  const int nt = K / BK;
  unsigned voffB[2];
#pragma unroll
  for (int i = 0; i < 2; ++i) { int R, C; stage_rc(tid * 16 + i * 8192, R, C); const int Rb = PERM ? ((R & ~31) + perm32(R & 31)) : R; voffB[i] = (unsigned)(Rb * K + C) * 2u; }
  const size_t kstep = (size_t)(BK * 2);
  const size_t hstep = (size_t)HALF * K * 2;
  const unsigned ldsw = (unsigned)wid * 1024u;
  const int aoff = lds_byte(wr * 64 + fr, fq * 8), boff = lds_byte(wc * 32 + fr, fq * 8);
#define PG8_SA(b, h) (((b) * 2 + (h)) * HTB)
#define PG8_SB(b, h) ((4 + (b) * 2 + (h)) * HTB)
#define PG8_STAGE(bufoff, gbase, voff) do { _Pragma("unroll") for (int _i = 0; _i < 2; ++_i) \
        __builtin_amdgcn_global_load_lds((const unsigned*)((const char*)(gbase) + (voff)[_i]), (LAS3 unsigned*)(lds + (bufoff) + ldsw + _i * 8192), 16, 0, 0); } while (0)
#define PG8_LDA(dst, b, h) do { _Pragma("unroll") for (int m = 0; m < 4; ++m) _Pragma("unroll") for (int k = 0; k < 2; ++k) dst[m][k] = *(const LAS3 bf16x8*)(lds + PG8_SA(b, h) + aoff + m * 2048 + k * 1024); } while (0)
#define PG8_LDB(dst, b, h) do { _Pragma("unroll") for (int n = 0; n < 2; ++n) _Pragma("unroll") for (int k = 0; k < 2; ++k) dst[n][k] = *(const LAS3 bf16x8*)(lds + PG8_SB(b, h) + boff + n * 2048 + k * 1024); } while (0)
#define PG8_MMA(ai, bj, At, Bt) do { __builtin_amdgcn_s_setprio(1); _Pragma("unroll") for (int m = 0; m < 4; ++m) _Pragma("unroll") for (int n = 0; n < 2; ++n) _Pragma("unroll") for (int k = 0; k < 2; ++k) \
        acc[ai][bj][m][n] = __builtin_amdgcn_mfma_f32_16x16x32_bf16(Bt[n][k], At[m][k], acc[ai][bj][m][n], 0, 0, 0); __builtin_amdgcn_s_setprio(0); } while (0)
#define PG8_WAIT_V(n) asm volatile("s_waitcnt vmcnt(" #n ")" ::: "memory")
#define PG8_WAIT_L(n) asm volatile("s_waitcnt lgkmcnt(" #n ")" ::: "memory")
#define PG8_BAR __builtin_amdgcn_s_barrier()
#define PG8_SCHED __builtin_amdgcn_sched_barrier(0)
#pragma unroll
  for (int a = 0; a < 2; ++a)
#pragma unroll
    for (int b = 0; b < 2; ++b)
#pragma unroll
      for (int m = 0; m < 4; ++m)
#pragma unroll
        for (int n = 0; n < 2; ++n) acc[a][b][m][n] = (f32x4){0.f, 0.f, 0.f, 0.f};
  bf16x8 At[4][2], B0[2][2], B1[2][2];
  PG8_STAGE(PG8_SB(0, 0), cB, voffB); PG8_STAGE(PG8_SA(0, 0), cA0, voffA0); PG8_STAGE(PG8_SB(0, 1), cB + hstep, voffB); PG8_STAGE(PG8_SA(0, 1), cA1, voffA1);
  if (wr == 1) PG8_BAR;
  PG8_WAIT_V(4); PG8_BAR;
  PG8_STAGE(PG8_SB(1, 0), cB + kstep, voffB); PG8_STAGE(PG8_SA(1, 0), cA0 + kstep, voffA0); PG8_STAGE(PG8_SB(1, 1), cB + hstep + kstep, voffB);
  PG8_WAIT_V(6); PG8_BAR;
  for (int t = 0; t < nt; t += 2) {
    const bool last = (t == nt - 2);
    const size_t o1 = (size_t)(t + 1) * kstep;
    const size_t o2 = last ? 0 : (size_t)(t + 2) * kstep;
    const size_t o3 = o2 + kstep;
    PG8_LDB(B0, 0, 0); PG8_SCHED; PG8_LDA(At, 0, 0); PG8_STAGE(PG8_SA(1, 1), cA1 + o1, voffA1);
    PG8_WAIT_L(8); PG8_BAR; PG8_WAIT_L(0); PG8_MMA(0, 0, At, B0); PG8_BAR; PG8_SCHED;
    PG8_LDB(B1, 0, 1); PG8_STAGE(PG8_SB(0, 0), cB + o2, voffB);
    PG8_BAR; PG8_WAIT_L(0); PG8_MMA(0, 1, At, B1); PG8_BAR;
    PG8_LDA(At, 0, 1); PG8_STAGE(PG8_SA(0, 0), cA0 + o2, voffA0);
    PG8_BAR; PG8_WAIT_L(0); PG8_MMA(1, 0, At, B0); PG8_BAR; PG8_SCHED;
    PG8_STAGE(PG8_SB(0, 1), cB + hstep + o2, voffB);
    PG8_WAIT_V(6); PG8_BAR; PG8_MMA(1, 1, At, B1); PG8_BAR;
    PG8_LDB(B0, 1, 0); PG8_SCHED; PG8_LDA(At, 1, 0); PG8_STAGE(PG8_SA(0, 1), cA1 + o2, voffA1);
    PG8_WAIT_L(8); PG8_BAR; PG8_WAIT_L(0); PG8_MMA(0, 0, At, B0); PG8_BAR; PG8_SCHED;
    PG8_LDB(B1, 1, 1); PG8_STAGE(PG8_SB(1, 0), cB + o3, voffB);
    PG8_BAR; PG8_WAIT_L(0); PG8_MMA(0, 1, At, B1); PG8_BAR;
    PG8_LDA(At, 1, 1); PG8_STAGE(PG8_SA(1, 0), cA0 + o3, voffA0);
    PG8_BAR; PG8_WAIT_L(0); PG8_MMA(1, 0, At, B0); PG8_BAR; PG8_SCHED;
    PG8_STAGE(PG8_SB(1, 1), cB + hstep + o3, voffB);
    PG8_WAIT_V(6); PG8_BAR; PG8_MMA(1, 1, At, B1); PG8_BAR;
  }
  PG8_WAIT_V(0);
  if (wr == 0) PG8_BAR;
  PG8_BAR;
#undef PG8_SA
#undef PG8_SB
#undef PG8_STAGE
#undef PG8_LDA
#undef PG8_LDB
#undef PG8_MMA
#undef PG8_WAIT_V
#undef PG8_WAIT_L
#undef PG8_BAR
#undef PG8_SCHED
}
struct UnitAB { const char* a; const char* b; };
template <bool PERM, class Prov, class Epi>
__device__ __forceinline__ void gemm_stream(LAS3 unsigned char* lds, int K, Prov prov, Epi epi) {
  int tid = __builtin_amdgcn_workitem_id_x();
  asm volatile("" : "+v"(tid));
  const int wid = __builtin_amdgcn_readfirstlane(tid >> 6), lane = tid & 63, wr = wid >> 2, wc = wid & 3, fr = lane & 15, fq = lane >> 4;
  const int nt = K / BK;
  UnitAB cur, nxt;
  if (!prov(0, cur)) return;
  unsigned voffA[2], voffB[2];
#pragma unroll
  for (int i = 0; i < 2; ++i) { int R, C; stage_rc(tid * 16 + i * 8192, R, C); const int Rb = PERM ? ((R & ~31) + perm32(R & 31)) : R;
    voffA[i] = (unsigned)(R * K + C) * 2u; voffB[i] = (unsigned)(Rb * K + C) * 2u; }
  const size_t kstep = (size_t)(BK * 2);
  const size_t hstep = (size_t)HALF * K * 2;
  const unsigned ldsw = (unsigned)wid * 1024u;
  const int aoff = lds_byte(wr * 64 + fr, fq * 8), boff = lds_byte(wc * 32 + fr, fq * 8);
#define PG8_SA(b, h) (((b) * 2 + (h)) * HTB)
#define PG8_SB(b, h) ((4 + (b) * 2 + (h)) * HTB)
#define PG8_STAGE(bufoff, gbase, voff) do { _Pragma("unroll") for (int _i = 0; _i < 2; ++_i) \
        __builtin_amdgcn_global_load_lds((const unsigned*)((const char*)(gbase) + (voff)[_i]), (LAS3 unsigned*)(lds + (bufoff) + ldsw + _i * 8192), 16, 0, 0); } while (0)
#define PG8_LDA(dst, b, h) do { _Pragma("unroll") for (int m = 0; m < 4; ++m) _Pragma("unroll") for (int k = 0; k < 2; ++k) dst[m][k] = *(const LAS3 bf16x8*)(lds + PG8_SA(b, h) + aoff + m * 2048 + k * 1024); } while (0)
#define PG8_LDB(dst, b, h) do { _Pragma("unroll") for (int n = 0; n < 2; ++n) _Pragma("unroll") for (int k = 0; k < 2; ++k) dst[n][k] = *(const LAS3 bf16x8*)(lds + PG8_SB(b, h) + boff + n * 2048 + k * 1024); } while (0)
#define PG8_MMA(ai, bj, At, Bt) do { __builtin_amdgcn_s_setprio(1); _Pragma("unroll") for (int m = 0; m < 4; ++m) _Pragma("unroll") for (int n = 0; n < 2; ++n) _Pragma("unroll") for (int k = 0; k < 2; ++k) \
        acc[ai][bj][m][n] = __builtin_amdgcn_mfma_f32_16x16x32_bf16(Bt[n][k], At[m][k], acc[ai][bj][m][n], 0, 0, 0); __builtin_amdgcn_s_setprio(0); } while (0)
#define PG8_WAIT_V(n) asm volatile("s_waitcnt vmcnt(" #n ")" ::: "memory")
#define PG8_WAIT_L(n) asm volatile("s_waitcnt lgkmcnt(" #n ")" ::: "memory")
#define PG8_BAR __builtin_amdgcn_s_barrier()
#define PG8_SCHED __builtin_amdgcn_sched_barrier(0)
#define PG8_ZERO() do { _Pragma("unroll") for (int a = 0; a < 2; ++a) _Pragma("unroll") for (int b = 0; b < 2; ++b) _Pragma("unroll") for (int m = 0; m < 4; ++m) \
        _Pragma("unroll") for (int n = 0; n < 2; ++n) acc[a][b][m][n] = (f32x4){0.f, 0.f, 0.f, 0.f}; } while (0)
  f32x4 acc[2][2][4][2];
  PG8_ZERO();
  bf16x8 At[4][2], B0[2][2], B1[2][2];
  const char* cA = cur.a; const char* cB = cur.b;
  PG8_STAGE(PG8_SB(0, 0), cB, voffB); PG8_STAGE(PG8_SA(0, 0), cA, voffA); PG8_STAGE(PG8_SB(0, 1), cB + hstep, voffB); PG8_STAGE(PG8_SA(0, 1), cA + hstep, voffA);
  if (wr == 1) PG8_BAR;
  PG8_WAIT_V(4); PG8_BAR;
  PG8_STAGE(PG8_SB(1, 0), cB + kstep, voffB); PG8_STAGE(PG8_SA(1, 0), cA + kstep, voffA); PG8_STAGE(PG8_SB(1, 1), cB + hstep + kstep, voffB);
  PG8_WAIT_V(6); PG8_BAR;
  for (int ui = 0;; ++ui) {
    const bool has_next = prov(ui + 1, nxt);
    const char* nA = has_next ? nxt.a : cA; const char* nB = has_next ? nxt.b : cB;
    for (int t = 0; t < nt; t += 2) {
      const bool last = (t == nt - 2);
      const char* a1 = cA + (size_t)(t + 1) * kstep;
      const char* a2 = last ? nA : cA + (size_t)(t + 2) * kstep; const char* b2 = last ? nB : cB + (size_t)(t + 2) * kstep;
      const char* a3 = a2 + kstep; const char* b3 = b2 + kstep;
      PG8_LDB(B0, 0, 0); PG8_SCHED; PG8_LDA(At, 0, 0); PG8_STAGE(PG8_SA(1, 1), a1 + hstep, voffA);
      PG8_WAIT_L(8); PG8_BAR; PG8_WAIT_L(0); PG8_MMA(0, 0, At, B0); PG8_BAR; PG8_SCHED;
      PG8_LDB(B1, 0, 1); PG8_STAGE(PG8_SB(0, 0), b2, voffB);
      PG8_BAR; PG8_WAIT_L(0); PG8_MMA(0, 1, At, B1); PG8_BAR;
      PG8_LDA(At, 0, 1); PG8_STAGE(PG8_SA(0, 0), a2, voffA);
      PG8_BAR; PG8_WAIT_L(0); PG8_MMA(1, 0, At, B0); PG8_BAR; PG8_SCHED;
      PG8_STAGE(PG8_SB(0, 1), b2 + hstep, voffB);
      PG8_WAIT_V(6); PG8_BAR; PG8_MMA(1, 1, At, B1); PG8_BAR;
      PG8_LDB(B0, 1, 0); PG8_SCHED; PG8_LDA(At, 1, 0); PG8_STAGE(PG8_SA(0, 1), a2 + hstep, voffA);
      PG8_WAIT_L(8); PG8_BAR; PG8_WAIT_L(0); PG8_MMA(0, 0, At, B0); PG8_BAR; PG8_SCHED;
      PG8_LDB(B1, 1, 1); PG8_STAGE(PG8_SB(1, 0), b3, voffB);
      PG8_BAR; PG8_WAIT_L(0); PG8_MMA(0, 1, At, B1); PG8_BAR;
      PG8_LDA(At, 1, 1); PG8_STAGE(PG8_SA(1, 0), a3, voffA);
      PG8_BAR; PG8_WAIT_L(0); PG8_MMA(1, 0, At, B0); PG8_BAR; PG8_SCHED;
      PG8_STAGE(PG8_SB(1, 1), b3 + hstep, voffB);
      PG8_WAIT_V(6); PG8_BAR; PG8_MMA(1, 1, At, B1); PG8_BAR;
    }
    epi(ui, acc);
    if (!has_next) break;
    PG8_ZERO();
    cA = nA; cB = nB;
  }
  PG8_WAIT_V(0);
  if (wr == 0) PG8_BAR;
  PG8_BAR;
#undef PG8_SA
#undef PG8_SB
#undef PG8_STAGE
#undef PG8_LDA
#undef PG8_LDB
#undef PG8_MMA
#undef PG8_WAIT_V
#undef PG8_WAIT_L
#undef PG8_BAR
#undef PG8_SCHED
#undef PG8_ZERO
}
__device__ __forceinline__ void voff_contig(int K, unsigned (&voff)[2]) {
  int tid = __builtin_amdgcn_workitem_id_x();
  asm volatile("" : "+v"(tid));
#pragma unroll
  for (int i = 0; i < 2; ++i) { int R, C; stage_rc(tid * 16 + i * 8192, R, C); voff[i] = (unsigned)(R * K + C) * 2u; }
}
template <int ai, int bj>
__device__ __forceinline__ void acc_to_lds(const f32x4 (&acc)[2][2][4][2], bool transposed, float* sC) {
  int tid = __builtin_amdgcn_workitem_id_x();
  asm volatile("" : "+v"(tid));
  const int wid = tid >> 6, lane = tid & 63, wr = wid >> 2, wc = wid & 3, fr = lane & 15, fq = lane >> 4;
#pragma unroll
  for (int m = 0; m < 4; ++m)
#pragma unroll
    for (int n = 0; n < 2; ++n) {
      const int row = 64 * wr + 16 * m + fr, col = 32 * wc + 16 * n + 4 * fq;
      const f32x4 v = acc[ai][bj][m][n];
      if (!transposed) *(f32x4*)(sC + row * LDC + col) = v;
      else { sC[col * LDC + row] = v[0]; sC[(col + 1) * LDC + row] = v[1]; sC[(col + 2) * LDC + row] = v[2]; sC[(col + 3) * LDC + row] = v[3]; }
    }
}
template <class F>
__device__ __forceinline__ void for_each_piece(const f32x4 (&acc)[2][2][4][2], F f) {
  int tid = __builtin_amdgcn_workitem_id_x();
  asm volatile("" : "+v"(tid));
  const int wid = tid >> 6, lane = tid & 63, wr = wid >> 2, wc = wid & 3, fr = lane & 15, fq = lane >> 4;
#pragma unroll
  for (int ai = 0; ai < 2; ++ai)
#pragma unroll
    for (int m = 0; m < 4; ++m)
#pragma unroll
      for (int bj = 0; bj < 2; ++bj) {
        const f32x4 a = acc[ai][bj][m][0], b = acc[ai][bj][m][1];
        float v[8] = {a[0], a[1], a[2], a[3], b[0], b[1], b[2], b[3]};
        f(128 * ai + 64 * wr + 16 * m + fr, 128 * bj + 32 * wc + 8 * fq, v);
      }
}
__device__ __forceinline__ int unit_linear(int i) { return i * (int)gridDim.x + (int)__builtin_amdgcn_workgroup_id_x(); }
__device__ __forceinline__ bool unit_map(int L, int nM, int nN, int& pm, int& pn) {
  const int nwg = nM * nN;
  if (L >= nwg) return false;
  int wgid = L;
  { const int q = nwg / 8, r = nwg % 8, xcd = wgid % 8, off = wgid / 8; wgid = (xcd < r ? xcd * (q + 1) : r * (q + 1) + (xcd - r) * q) + off; }
  const int nig = 8 * nN, gid = wgid / nig, fm = gid * 8, gsz = (nM - fm) < 8 ? (nM - fm) : 8;
  pm = fm + ((wgid % nig) % gsz); pn = (wgid % nig) / gsz;
  return true;
}
}

__device__ __forceinline__ bool inproj_transposed(int nt) { return (nt == 5) || (nt >= 10 && nt <= 13) || (nt >= 26 && nt <= 29); }
__device__ __forceinline__ void inproj_epilogue(PRef p, int layer, int mt, int nt, const float* sC, int tid) {
  const float* bias = p.b_in + layer * NIN_SRC;
  const bool transposed = inproj_transposed(nt);
  const int tok0 = mt * 128;
  const bool lat = tok0 < TLAT;
  int b, pos0, pall0;
  if (lat) { b = tok0 >> 12; pos0 = tok0 & 4095; pall0 = 256 + pos0; }
  else { int ci = tok0 - TLAT; b = ci >> 8; pos0 = ci & 255; pall0 = pos0; }
  const int n0 = nt * 128;
  const int srcc0 = (nt < 18) ? n0 : n0 + 32;
  if (transposed) {
    const int tc = tid & 15, cb = tid >> 4;
    float bv[8];
#pragma unroll
    for (int ps = 0; ps < 8; ++ps) bv[ps] = bias[srcc0 + ps * 16 + cb];
#pragma unroll
    for (int ps = 0; ps < 8; ++ps) {
      const int col = ps * 16 + cb;
      float v[8];
      lds_read8(sC + col * LDC + tc * 8, v);
#pragma unroll
      for (int e = 0; e < 8; ++e) v[e] += bv[ps];
      bf16_t* dst;
      if (nt == 5) dst = p.vAT + ((size_t)(b * 2 + (col >> 6)) * 64 + (col & 63)) * PALL;
      else if (nt <= 13) dst = p.vBT + ((size_t)(b * 4 + (nt - 10)) * 128 + col) * PALL;
      else dst = p.vCT + ((size_t)(b * 8 + (nt - 26) * 2 + (col >> 6)) * 64 + (col & 63)) * PALL;
      *(uint4*)(dst + pall0 + tc * 8) = pack8(v);
    }
  } else if (nt <= 4) {
    const float* gn = (nt < 4 ? p.q_norm : p.k_norm) + layer * 64;
    const float osc = nt < 4 ? QSCALE : 1.f;
    const int c8 = tid & 15, rb = tid >> 4, d0 = (c8 & 7) * 8;
    float bs[8], bp[8], g0[8], g1[8];
    {
      const float4 t0 = *(const float4*)(bias + srcc0 + c8 * 8), t1 = *(const float4*)(bias + srcc0 + c8 * 8 + 4);
      const float4 u0 = *(const float4*)(bias + srcc0 + ((c8 * 8) ^ 16)), u1 = *(const float4*)(bias + srcc0 + ((c8 * 8) ^ 16) + 4);
      const float4 a0 = *(const float4*)(gn + d0), a1 = *(const float4*)(gn + d0 + 4);
      const float4 c0 = *(const float4*)(gn + (d0 ^ 16)), c1 = *(const float4*)(gn + (d0 ^ 16) + 4);
      bs[0] = t0.x; bs[1] = t0.y; bs[2] = t0.z; bs[3] = t0.w; bs[4] = t1.x; bs[5] = t1.y; bs[6] = t1.z; bs[7] = t1.w;
      bp[0] = u0.x; bp[1] = u0.y; bp[2] = u0.z; bp[3] = u0.w; bp[4] = u1.x; bp[5] = u1.y; bp[6] = u1.z; bp[7] = u1.w;
      g0[0] = a0.x; g0[1] = a0.y; g0[2] = a0.z; g0[3] = a0.w; g0[4] = a1.x; g0[5] = a1.y; g0[6] = a1.z; g0[7] = a1.w;
      g1[0] = c0.x; g1[1] = c0.y; g1[2] = c0.z; g1[3] = c0.w; g1[4] = c1.x; g1[5] = c1.y; g1[6] = c1.z; g1[7] = c1.w;
    }
    const int qd = d0 >> 4;
    const float sgn = (qd & 1) ? 1.f : -1.f;
#pragma unroll 2
    for (int ps = 0; ps < 8; ++ps) {
      const int row = ps * 16 + rb;
      float v[8], pv[8];
      lds_read8(sC + row * LDC + c8 * 8, v);
      lds_read8(sC + row * LDC + ((c8 * 8) ^ 16), pv);
      float cs[8], sn[8];
      if (lat) {
        const int t = pos0 + row;
        const int pp = (qd < 2) ? (t >> 6) : (t & 63);
        const float* rp = p.rope + pp * 16 + (d0 & 15);
        const float4 r0 = *(const float4*)rp, r1 = *(const float4*)(rp + 4), s0 = *(const float4*)(rp + 1024), s1 = *(const float4*)(rp + 1028);
        cs[0] = r0.x; cs[1] = r0.y; cs[2] = r0.z; cs[3] = r0.w; cs[4] = r1.x; cs[5] = r1.y; cs[6] = r1.z; cs[7] = r1.w;
        sn[0] = s0.x; sn[1] = s0.y; sn[2] = s0.z; sn[3] = s0.w; sn[4] = s1.x; sn[5] = s1.y; sn[6] = s1.z; sn[7] = s1.w;
      } else {
#pragma unroll
        for (int e = 0; e < 8; ++e) { cs[e] = 1.f; sn[e] = 0.f; }
      }
      float ss = 0.f;
#pragma unroll
      for (int e = 0; e < 8; ++e) { v[e] += bs[e]; pv[e] += bp[e]; ss += v[e] * v[e]; }
      ss += __shfl_xor(ss, 1);
      ss += __shfl_xor(ss, 2);
      ss += __shfl_xor(ss, 4);
      const float rstd = rsqrtf(ss * (1.f / 64.f) + 1e-6f);
      float o[8];
#pragma unroll
      for (int e = 0; e < 8; ++e) {
        const float xn = v[e] * rstd * g0[e], pn = pv[e] * rstd * g1[e];
        o[e] = (xn * cs[e] + sgn * pn * sn[e]) * osc;
      }
      bf16_t* dst;
      if (nt < 4) dst = p.qA + (size_t)(tok0 + row) * 512 + nt * 128 + c8 * 8;
      else dst = p.kA + ((size_t)(b * 2 + (c8 >> 3)) * PALL + pall0 + row) * 64 + d0;
      *(uint4*)dst = pack8(o);
    }
  } else {
    bf16_t* base;
    int ld, cofs;
    float osc = 1.f;
    if (nt <= 7) { base = p.qB; ld = 256; cofs = (nt - 6) * 128; osc = 0.125f; }
    else if (nt <= 9) { base = p.kB; ld = 256; cofs = (nt - 8) * 128; }
    else if (nt <= 17) { base = p.rB; ld = 512; cofs = (nt - 14) * 128; }
    else if (nt <= 21) { base = p.qC; ld = 512; cofs = (nt - 18) * 128; osc = QSCALE; }
    else { base = p.kC; ld = 512; cofs = (nt - 22) * 128; }
    const int c8 = tid & 15, rb = tid >> 4;
    float bs[8];
    {
      const float4 t0 = *(const float4*)(bias + srcc0 + c8 * 8), t1 = *(const float4*)(bias + srcc0 + c8 * 8 + 4);
      bs[0] = t0.x; bs[1] = t0.y; bs[2] = t0.z; bs[3] = t0.w; bs[4] = t1.x; bs[5] = t1.y; bs[6] = t1.z; bs[7] = t1.w;
    }
#pragma unroll
    for (int ps = 0; ps < 8; ++ps) {
      const int row = ps * 16 + rb;
      float v[8];
      lds_read8(sC + row * LDC + c8 * 8, v);
#pragma unroll
      for (int e = 0; e < 8; ++e) v[e] = (v[e] + bs[e]) * osc;
      *(uint4*)(base + (size_t)(tok0 + row) * ld + cofs + c8 * 8) = pack8(v);
    }
  }
}

__device__ __forceinline__ void gate_epilogue(PRef p, int layer, int mt, int nt, const float* sC, int tid) {
  const float* bias = p.b_in + layer * NIN_SRC + 3872 + nt * 128;
  const int c8 = tid & 15, rb = tid >> 4;
  float bs[8];
  {
    const float4 t0 = *(const float4*)(bias + c8 * 8), t1 = *(const float4*)(bias + c8 * 8 + 4);
    bs[0] = t0.x; bs[1] = t0.y; bs[2] = t0.z; bs[3] = t0.w; bs[4] = t1.x; bs[5] = t1.y; bs[6] = t1.z; bs[7] = t1.w;
  }
#pragma unroll
  for (int ps = 0; ps < 8; ++ps) {
    const int row = ps * 16 + rb;
    float v[8];
    lds_read8(sC + row * LDC + c8 * 8, v);
#pragma unroll
    for (int e = 0; e < 8; ++e) v[e] = sigmoidf_(v[e] + bs[e]);
    *(uint4*)(p.G + (size_t)(mt * 128 + row) * 3072 + nt * 128 + c8 * 8) = pack8(v);
  }
}
__device__ __forceinline__ void phase_inproj(PRef p, int layer, char* smem_all) {
  LAS3 unsigned char* lds = (LAS3 unsigned char*)smem_all;
  constexpr int NSTREAM_IN = 68 * 12, NSTREAM = NSTREAM_IN + 64 * 12, NOLD = 68 * 3;
  {
    unsigned voffA[2];
    pg8::voff_contig(D, voffA);
    const int G = (int)gridDim.x, c = (int)__builtin_amdgcn_workgroup_id_x();
    const int rem = NSTREAM % G;
    for (int j = (c - rem + G) % G; j < NOLD; j += G) {
      int pm, pn;
      pg8::unit_map(j, 68, 3, pm, pn);
      pg8::f32x4 acc[2][2][4][2];
      const char* a0 = (const char*)(p.h + (size_t)pm * 256 * D);
      pg8::gemm_unit(lds, a0, a0 + (size_t)128 * D * 2, voffA, voffA, (const char*)(p.wt_in + (size_t)pn * 256 * D), D, acc);
      asm volatile("" : "+s"(pm), "+s"(pn));
      PRef pe = params_view();
      const int etid = tid_();
      const int half = half_();
      float* sCh = (float*)(smem_all + half * SMEM_BYTES);
      pg8::acc_to_lds<0, 0>(acc, inproj_transposed(2 * pn), (float*)smem_all);
      pg8::acc_to_lds<0, 1>(acc, inproj_transposed(2 * pn + 1), (float*)(smem_all + SMEM_BYTES));
      __syncthreads();
      inproj_epilogue(pe, layer, 2 * pm, 2 * pn + half, sCh, etid);
      __syncthreads();
      pg8::acc_to_lds<1, 0>(acc, inproj_transposed(2 * pn), (float*)smem_all);
      pg8::acc_to_lds<1, 1>(acc, inproj_transposed(2 * pn + 1), (float*)(smem_all + SMEM_BYTES));
      __syncthreads();
      inproj_epilogue(pe, layer, 2 * pm + 1, 2 * pn + half, sCh, etid);
      __syncthreads();
    }
  }
  {
    PRef pg = params_view();
    const bf16_t* hbase = pg.h;
    const bf16_t* win = pg.wt_in;
    const bf16_t* wg = pg.wt_gate;
    const float* bias = pg.b_in + layer * NIN_SRC;
    bf16_t* gbase = pg.G;
    pg8::gemm_stream<true>(lds, D,
      [&](int ui, pg8::UnitAB& u) {
        const int s = pg8::unit_linear(ui);
        int pm, pn;
        if (s < NSTREAM_IN) {
          pg8::unit_map(s, 68, 12, pm, pn);
          pn += 3;
          const char* hr = (const char*)(hbase + (size_t)pm * 256 * D);
          const char* wr_ = (const char*)(win + (size_t)pn * 256 * D);
          const bool T = (pn == 5) || (pn == 6) || (pn >= 13);
          u.a = T ? wr_ : hr;
          u.b = T ? hr : wr_;
          return true;
        }
        if (!pg8::unit_map(s - NSTREAM_IN, 64, 12, pm, pn)) return false;
        u.a = (const char*)(hbase + (size_t)pm * 256 * D);
        u.b = (const char*)(wg + (size_t)pn * 256 * D);
        return true;
      },
      [&](int ui, const pg8::f32x4 (&acc)[2][2][4][2]) {
        const int s = pg8::unit_linear(ui);
        int lt = __builtin_amdgcn_workitem_id_x();
        asm volatile("" : "+v"(lt));
        const int wc = (lt >> 6) & 3, wr = lt >> 8, fr = lt & 15, fq = (lt & 63) >> 4;
        const int cbase = 32 * wc + 8 * fq;
        int pm, pn;
        if (s >= NSTREAM_IN) {
          pg8::unit_map(s - NSTREAM_IN, 64, 12, pm, pn);
          const float* gb = bias + 3872 + pn * 256;
          bf16_t* gdst = gbase + (size_t)pm * 256 * 3072 + pn * 256;
          const float4 ba0 = *(const float4*)(gb + cbase), ba1 = *(const float4*)(gb + cbase + 4);
          const float4 bb0 = *(const float4*)(gb + 128 + cbase), bb1 = *(const float4*)(gb + 128 + cbase + 4);
          pg8::for_each_piece(acc, [&](int row, int col, float (&v)[8]) {
            const float4 b0 = col < 128 ? ba0 : bb0, b1 = col < 128 ? ba1 : bb1;
            v[0] = sigmoidf_(v[0] + b0.x); v[1] = sigmoidf_(v[1] + b0.y); v[2] = sigmoidf_(v[2] + b0.z); v[3] = sigmoidf_(v[3] + b0.w);
            v[4] = sigmoidf_(v[4] + b1.x); v[5] = sigmoidf_(v[5] + b1.y); v[6] = sigmoidf_(v[6] + b1.z); v[7] = sigmoidf_(v[7] + b1.w);
            st_nt16(gdst + (size_t)row * 3072 + col, pack8(v));
          });
          return;
        }
        pg8::unit_map(s, 68, 12, pm, pn);
        pn += 3;
        const float* bsrc = bias + (pn < 9 ? pn * 256 : pn * 256 + 32);
        const bool T = (pn == 5) || (pn == 6) || (pn >= 13);
        if (!T) {
          bf16_t* base; int ld, cofs0; float osc = 1.f;
          if (pn == 3) { base = pg.qB; ld = 256; cofs0 = 0; osc = 0.125f; }
          else if (pn == 4) { base = pg.kB; ld = 256; cofs0 = 0; }
          else if (pn <= 8) { base = pg.rB; ld = 512; cofs0 = (pn - 7) * 256; }
          else if (pn <= 10) { base = pg.qC; ld = 512; cofs0 = (pn - 9) * 256; osc = QSCALE; }
          else { base = pg.kC; ld = 512; cofs0 = (pn - 11) * 256; }
          const float4 ba0 = *(const float4*)(bsrc + cbase), ba1 = *(const float4*)(bsrc + cbase + 4);
          const float4 bb0 = *(const float4*)(bsrc + 128 + cbase), bb1 = *(const float4*)(bsrc + 128 + cbase + 4);
          bf16_t* d0 = base + (size_t)pm * 256 * ld + cofs0;
          pg8::for_each_piece(acc, [&](int row, int col, float (&v)[8]) {
            const float4 b0 = col < 128 ? ba0 : bb0, b1 = col < 128 ? ba1 : bb1;
            v[0] = (v[0] + b0.x) * osc; v[1] = (v[1] + b0.y) * osc; v[2] = (v[2] + b0.z) * osc; v[3] = (v[3] + b0.w) * osc;
            v[4] = (v[4] + b1.x) * osc; v[5] = (v[5] + b1.y) * osc; v[6] = (v[6] + b1.z) * osc; v[7] = (v[7] + b1.w) * osc;
            st_nt16(d0 + (size_t)row * ld + col, pack8(v));
          });
        } else {
          bf16_t* tb; int f0;
          if (pn <= 6) { tb = pg.vBT; f0 = (pn - 5) * 256; } else { tb = pg.vCT; f0 = (pn - 13) * 256; }
          const int tok0 = pm * 256;
          int b, pall0;
          if (tok0 < TLAT) { b = tok0 >> 12; pall0 = 256 + (tok0 & 4095); } else { const int ci = tok0 - TLAT; b = ci >> 8; pall0 = ci & 255; }
          bf16_t* d0 = tb + (size_t)(b * 512 + f0) * PALL + pall0;
          const int rbase = 64 * wr + fr;
          float bv[2][4];
#pragma unroll
          for (int ai = 0; ai < 2; ++ai)
#pragma unroll
            for (int m = 0; m < 4; ++m) bv[ai][m] = bsrc[128 * ai + rbase + 16 * m];
#pragma unroll
          for (int ai = 0; ai < 2; ++ai)
#pragma unroll
            for (int m = 0; m < 4; ++m)
#pragma unroll
              for (int bj = 0; bj < 2; ++bj) {
                const pg8::f32x4 x0 = acc[ai][bj][m][0], x1 = acc[ai][bj][m][1];
                const float bb = bv[ai][m];
                float v[8] = {x0[0] + bb, x0[1] + bb, x0[2] + bb, x0[3] + bb, x1[0] + bb, x1[1] + bb, x1[2] + bb, x1[3] + bb};
                st_nt16(d0 + (size_t)(128 * ai + rbase + 16 * m) * PALL + 128 * bj + cbase, pack8(v));
              }
        }
      });
  }
  {
    const int vtid = tid_();
    char* smem = smem_all + half_() * SMEM_BYTES;
    float* sC = (float*)smem;
    const int lane = vtid & 63, w = vtid >> 6, wr = w >> 1, wc = w & 1, r = lane & 31, hh = lane >> 5;
    for (int mt = bid_(); mt < 136; mt += vgrid_()) {
      f32x16 acc[2][1];
      acc[0][0] = zero16();
      acc[1][0] = zero16();
      gemm_mainloop<1>(rows_contig(p.h + (size_t)mt * 128 * D, D), rows_contig(p.wt_in + (size_t)3840 * D, D), 16, acc, smem);
#pragma unroll
      for (int i2 = 0; i2 < 2; ++i2)
#pragma unroll
        for (int g = 0; g < 16; ++g) {
          int row = wr * 64 + i2 * 32 + (g & 3) + 8 * (g >> 2) + 4 * hh, col = wc * 32 + r;
          sC[row * LDC + col] = acc[i2][0][g];
        }
      __syncthreads();
      for (int i2 = vtid; i2 < 128 * 32; i2 += 256) {
        int row = i2 >> 5, col = i2 & 31;
        p.aB[(size_t)(mt * 128 + row) * 32 + col] = sC[row * LDC + col] + p.b_in[layer * NIN_SRC + 2304 + col];
      }
      __syncthreads();
    }
  }
}

__device__ __forceinline__ void merge_tiles(PRef p, int layer, char* smem, int mt0, int nmt) {
  float* sC = (float*)smem;
  const int tid = tid_(), lane = tid & 63, w = tid >> 6, wr = w >> 1, wc = w & 1, r = lane & 31, hh = lane >> 5;
  const float* bias = p.b_in + layer * NIN_SRC + 3872;
  const int nrounds = xcd_rounds(smem, nmt, 16);
  for (int rd = 0; rd < nrounds; ++rd) {
    int mt, nt;
    if (!xcd_tile(smem, rd, nmt, 16, mt, nt)) continue;
    mt += mt0;
    f32x16 tot[2][1];
    tot[0][0] = zero16();
    tot[1][0] = zero16();
#pragma unroll 1
    for (int br = 0; br < 3; ++br) {
      f32x16 acc[2][1];
      acc[0][0] = zero16();
      acc[1][0] = zero16();
      gemm_mainloop<1>(rows_contig(p.h + (size_t)mt * 128 * D, D), rows_contig(p.wt_gate + (size_t)(br * 1024 + nt * 64) * D, D), 16, acc, smem);
      unsigned sg[2][8];
      {
        float bv = bias[br * 1024 + nt * 64 + wc * 32 + r];
#pragma unroll
        for (int i = 0; i < 2; ++i)
#pragma unroll
          for (int g = 0; g < 8; ++g)
            sg[i][g] = pack2(sigmoidf_(acc[i][0][2 * g] + bv), sigmoidf_(acc[i][0][2 * g + 1] + bv));
      }
      acc[0][0] = zero16();
      acc[1][0] = zero16();
      const bf16_t* ob = (br == 0 ? p.oA : (br == 1 ? p.oB : p.oC));
      gemm_mainloop<1>(rows_contig(ob + (size_t)mt * 128 * 512, 512), rows_contig(p.wt_br + ((size_t)br * 1024 + nt * 64) * 512, 512), 8, acc, smem);
#pragma unroll
      for (int i = 0; i < 2; ++i)
#pragma unroll
        for (int g = 0; g < 8; ++g) {
          tot[i][0][2 * g] += bf2f((bf16_t)(sg[i][g] & 0xffff)) * acc[i][0][2 * g];
          tot[i][0][2 * g + 1] += bf2f((bf16_t)(sg[i][g] >> 16)) * acc[i][0][2 * g + 1];
        }
    }
#pragma unroll
    for (int i = 0; i < 2; ++i)
#pragma unroll
      for (int g = 0; g < 16; ++g) {
        int row = wr * 64 + i * 32 + (g & 3) + 8 * (g >> 2) + 4 * hh, col = wc * 32 + r;
        sC[row * LDC + col] = tot[i][0][g];
      }
    __syncthreads();
#pragma unroll 1
    for (int ps = 0; ps < 4; ++ps) {
      int row = ps * 32 + (tid >> 3), c8 = tid & 7;
      float v[8];
      lds_read8(sC + row * LDC + c8 * 8, v);
      *(uint4*)(p.m + (size_t)(mt * 128 + row) * D + nt * 64 + c8 * 8) = pack8(v);
    }
    __syncthreads();
  }
}

__device__ __forceinline__ void merge_epilogue(PRef p, int br, int mt, int nt, const float* sC, int tid) {
  const int c8 = tid & 15, rb = tid >> 4;
#pragma unroll 1
  for (int hb = 0; hb < 2; ++hb) {
    u32x4 gv[4], mv[4];
#pragma unroll
    for (int q = 0; q < 4; ++q) {
      const size_t tok = (size_t)(mt * 128 + (hb * 4 + q) * 16 + rb);
      gv[q] = *(const u32x4*)(p.G + tok * 3072 + br * 1024 + nt * 128 + c8 * 8);
      if (br > 0) mv[q] = *(const u32x4*)(p.m + tok * D + nt * 128 + c8 * 8);
    }
#pragma unroll
    for (int q = 0; q < 4; ++q) {
      const int row = (hb * 4 + q) * 16 + rb;
      float v[8];
      lds_read8(sC + row * LDC + c8 * 8, v);
#pragma unroll
      for (int e2 = 0; e2 < 4; ++e2) {
        v[2 * e2] *= bf2f((bf16_t)(gv[q][e2] & 0xffff));
        v[2 * e2 + 1] *= bf2f((bf16_t)(gv[q][e2] >> 16));
        if (br > 0) { v[2 * e2] += bf2f((bf16_t)(mv[q][e2] & 0xffff)); v[2 * e2 + 1] += bf2f((bf16_t)(mv[q][e2] >> 16)); }
      }
      *(uint4*)(p.m + (size_t)(mt * 128 + row) * D + nt * 128 + c8 * 8) = pack8(v);
    }
  }
}
__device__ __forceinline__ void phase_merge(PRef p, int layer, char* smem_all) {
  LAS3 unsigned char* lds = (LAS3 unsigned char*)smem_all;
  {
    PRef pe = params_view();
    const bf16_t* oA = pe.oA; const bf16_t* oB = pe.oB; const bf16_t* oC = pe.oC;
    const bf16_t* wbr = pe.wt_br;
    const bf16_t* Gp = pe.G;
    bf16_t* mp = pe.m;
    pg8::gemm_stream<true>(lds, 512,
      [&](int ui, pg8::UnitAB& u) {
        const int br = ui % 3;
        int pm, pn;
        if (!pg8::unit_map(pg8::unit_linear(ui / 3), 64, 4, pm, pn)) return false;
        const bf16_t* ob = (br == 0 ? oA : (br == 1 ? oB : oC));
        u.a = (const char*)(ob + (size_t)pm * 256 * 512);
        u.b = (const char*)(wbr + ((size_t)br * 1024 + pn * 256) * 512);
        return true;
      },
      [&](int ui, const pg8::f32x4 (&acc)[2][2][4][2]) {
        const int br = ui % 3;
        int pm, pn;
        pg8::unit_map(pg8::unit_linear(ui / 3), 64, 4, pm, pn);
        const bf16_t* gsrc = Gp + (size_t)pm * 256 * 3072 + br * 1024 + pn * 256;
        bf16_t* mdst = mp + (size_t)pm * 256 * D + pn * 256;
        const bool rmw = br > 0;
        int lt = __builtin_amdgcn_workitem_id_x();
        asm volatile("" : "+v"(lt));
        const int wid = lt >> 6, lane = lt & 63, wr = wid >> 2, wc = wid & 3, fr = lane & 15, fq = lane >> 4;
#pragma unroll
        for (int ai = 0; ai < 2; ++ai) {
          u32x4 gq[4][2], mq[4][2];
#pragma unroll
          for (int m = 0; m < 4; ++m)
#pragma unroll
            for (int bj = 0; bj < 2; ++bj) {
              const int row = 128 * ai + 64 * wr + 16 * m + fr, col = 128 * bj + 32 * wc + 8 * fq;
              gq[m][bj] = *(const u32x4*)(gsrc + (size_t)row * 3072 + col);
              if (rmw) mq[m][bj] = *(const u32x4*)(mdst + (size_t)row * D + col);
            }
#pragma unroll
          for (int m = 0; m < 4; ++m)
#pragma unroll
            for (int bj = 0; bj < 2; ++bj) {
              const int row = 128 * ai + 64 * wr + 16 * m + fr, col = 128 * bj + 32 * wc + 8 * fq;
              const pg8::f32x4 a = acc[ai][bj][m][0], b = acc[ai][bj][m][1];
              float v[8] = {a[0], a[1], a[2], a[3], b[0], b[1], b[2], b[3]};
              const u32x4 g = gq[m][bj];
#pragma unroll
              for (int e2 = 0; e2 < 4; ++e2) {
                v[2 * e2] *= bf2f((bf16_t)(g[e2] & 0xffff));
                v[2 * e2 + 1] *= bf2f((bf16_t)(g[e2] >> 16));
                if (rmw) { v[2 * e2] += bf2f((bf16_t)(mq[m][bj][e2] & 0xffff)); v[2 * e2 + 1] += bf2f((bf16_t)(mq[m][bj][e2] >> 16)); }
              }
              *(uint4*)(mdst + (size_t)row * D + col) = pack8(v);
            }
        }
      });
  }
  if (layer == 0) merge_tiles(p, layer, smem_all + half_() * SMEM_BYTES, 128, 8);
}

__device__ __forceinline__ void outproj_epilogue(PRef p, int layer, int mt, int nt, const float* sC, int tid) {
  const int tok0 = mt * 128;
  const float* g1 = p.mod + ((size_t)layer * 5 + tok_modrow(tok0)) * NMOD + 2048 + nt * 128;
  const int c8 = tid & 15, rb = tid >> 4;
  const float4 ga = *(const float4*)(g1 + c8 * 8), gb = *(const float4*)(g1 + c8 * 8 + 4);
#pragma unroll 1
  for (int hb = 0; hb < 2; ++hb) {
    float4 x0[4], x1[4];
#pragma unroll
    for (int q = 0; q < 4; ++q) {
      const int tok = tok0 + (hb * 4 + q) * 16 + rb;
      const float* xp;
      if (layer == 0) xp = tok < TLAT ? p.x + (size_t)tok * D : p.ctx + (size_t)(tok - TLAT) * D;
      else xp = p.xres + (size_t)tok * D;
      xp += nt * 128 + c8 * 8;
      x0[q] = *(const float4*)xp; x1[q] = *(const float4*)(xp + 4);
    }
#pragma unroll
    for (int q = 0; q < 4; ++q) {
      const int row = (hb * 4 + q) * 16 + rb;
      float v[8];
      lds_read8(sC + row * LDC + c8 * 8, v);
      float4 o0 = make_float4(ALPHA * x0[q].x + ga.x * v[0], ALPHA * x0[q].y + ga.y * v[1], ALPHA * x0[q].z + ga.z * v[2], ALPHA * x0[q].w + ga.w * v[3]);
      float4 o1 = make_float4(ALPHA * x1[q].x + gb.x * v[4], ALPHA * x1[q].y + gb.y * v[5], ALPHA * x1[q].z + gb.z * v[6], ALPHA * x1[q].w + gb.w * v[7]);
      float* op = p.xres + (size_t)(tok0 + row) * D + nt * 128 + c8 * 8;
      *(float4*)op = o0;
      *(float4*)(op + 4) = o1;
    }
  }
}
__device__ __forceinline__ void phase_outproj(PRef p, int layer, char* smem_all) {
  LAS3 unsigned char* lds = (LAS3 unsigned char*)smem_all;
  unsigned voffA[2];
  pg8::voff_contig(D, voffA);
  for (int i = 0;; ++i) {
    int pm, pn;
    if (!pg8::unit_map(pg8::unit_linear(i), 64, 4, pm, pn)) break;
    pg8::f32x4 acc[2][2][4][2];
    const char* a0 = (const char*)(p.m + (size_t)pm * 256 * D);
    pg8::gemm_unit(lds, a0, a0 + (size_t)128 * D * 2, voffA, voffA, (const char*)(p.wt_out + (size_t)pn * 256 * D), D, acc);
    asm volatile("" : "+s"(pm), "+s"(pn));
    PRef pe = params_view();
    const int etid = tid_();
    const int half = half_();
    float* sCh = (float*)(smem_all + half * SMEM_BYTES);
    pg8::acc_to_lds<0, 0>(acc, false, (float*)smem_all);
    pg8::acc_to_lds<0, 1>(acc, false, (float*)(smem_all + SMEM_BYTES));
    __syncthreads();
    outproj_epilogue(pe, layer, 2 * pm, 2 * pn + half, sCh, etid);
    __syncthreads();
    pg8::acc_to_lds<1, 0>(acc, false, (float*)smem_all);
    pg8::acc_to_lds<1, 1>(acc, false, (float*)(smem_all + SMEM_BYTES));
    __syncthreads();
    outproj_epilogue(pe, layer, 2 * pm + 1, 2 * pn + half, sCh, etid);
    __syncthreads();
  }
  if (layer == 0) {
    char* smem = smem_all + half_() * SMEM_BYTES;
    float* sC = (float*)smem;
    const int tid = tid_();
    for (int item = bid_(); item < 64; item += vgrid_()) {
      const int mt = 128 + (item >> 3), nt = item & 7;
      f32x16 acc[2][2];
#pragma unroll
      for (int i = 0; i < 2; ++i)
#pragma unroll
        for (int j = 0; j < 2; ++j) acc[i][j] = zero16();
      gemm_mainloop<2>(rows_contig(p.m + (size_t)mt * 128 * D, D), rows_contig(p.wt_out + (size_t)nt * 128 * D, D), 16, acc, smem);
      acc_to_lds(acc, sC);
      __syncthreads();
      outproj_epilogue(p, layer, mt, nt, sC, tid);
      __syncthreads();
    }
  }
}

__device__ __forceinline__ bool moe_block_lookup(PRef p, int mb, int& e, int& lb, int& cnt_e) {
  int start = 0;
  for (int i = 0; i < 32; ++i) {
    int c = p.cnt[i];
    int nb = (c + MOE_BLK - 1) / MOE_BLK;
    if (mb < start + nb) { e = i; lb = mb - start; cnt_e = c; return true; }
    start += nb;
  }
  return false;
}
__device__ __forceinline__ void moe1_epilogue(PRef p, int slot0, int nt, const float* sC, int tid) {
#pragma unroll
  for (int ps = 0; ps < 8; ++ps) {
    const int row = ps * 16 + (tid >> 4), c4 = (tid & 15) * 4;
    const float4 a = *(const float4*)(sC + row * LDC + c4);
    const float4 b = *(const float4*)(sC + row * LDC + 64 + c4);
    const uint2 o = make_uint2(pack2(siluf(a.x) * b.x, siluf(a.y) * b.y), pack2(siluf(a.z) * b.z, siluf(a.w) * b.w));
    *(uint2*)(p.act + (size_t)(slot0 + row) * 512 + nt * 64 + c4) = o;
  }
}
__device__ __forceinline__ void moe2_epilogue(PRef p, int slot0, int nt, const float* sC, int tid) {
#pragma unroll
  for (int ps = 0; ps < 8; ++ps) {
    const int row = ps * 16 + (tid >> 4), c8 = tid & 15;
    float v[8];
    lds_read8(sC + row * LDC + c8 * 8, v);
    *(uint4*)(p.ysl + (size_t)(slot0 + row) * D + nt * 128 + c8 * 8) = pack8(v);
  }
}
__device__ __forceinline__ void phase_moe1(PRef p, int layer, char* smem_all) {
  LAS3 unsigned char* lds = (LAS3 unsigned char*)smem_all;
  if (__builtin_amdgcn_workgroup_id_x() == 0 && __builtin_amdgcn_workitem_id_x() == 0) {
    int start = 0;
    for (int i = 0; i < 32; ++i) { p.estart[i] = start; start += (p.cnt[i] + MOE_BLK - 1) / MOE_BLK; }
  }
  for (int i = 0;; ++i) {
    const int L = pg8::unit_linear(i);
    int mb = L >> 2, pn = L & 3;
    if (mb >= MAX_MBLK) break;
    int e, lb, ce;
    if (!moe_block_lookup(p, mb, e, lb, ce)) break;
    unsigned voffA0[2], voffA1[2];
    {
      int tid = __builtin_amdgcn_workitem_id_x();
      asm volatile("" : "+v"(tid));
#pragma unroll
      for (int q = 0; q < 2; ++q) {
        int R, C;
        pg8::stage_rc(tid * 16 + q * 8192, R, C);
        const int s0 = lb * MOE_BLK + R, s1 = s0 + 128;
        const int t0 = s0 < ce ? p.list[e * MOE_CAP + s0] : 0;
        const int t1 = s1 < ce ? p.list[e * MOE_CAP + s1] : 0;
        voffA0[q] = (unsigned)(t0 * D + C) * 2u;
        voffA1[q] = (unsigned)(t1 * D + C) * 2u;
      }
    }
    pg8::f32x4 acc[2][2][4][2];
    pg8::gemm_unit(lds, (const char*)p.h2, (const char*)p.h2, voffA0, voffA1, (const char*)(p.wt_13 + ((size_t)e * 1024 + pn * 256) * D), D, acc);
    asm volatile("" : "+s"(mb), "+s"(pn));
    PRef pe = params_view();
    const int etid = tid_();
    const int half = half_();
    float* sCh = (float*)(smem_all + half * SMEM_BYTES);
    pg8::acc_to_lds<0, 0>(acc, false, (float*)smem_all);
    pg8::acc_to_lds<0, 1>(acc, false, (float*)(smem_all + SMEM_BYTES));
    __syncthreads();
    moe1_epilogue(pe, mb * MOE_BLK, 2 * pn + half, sCh, etid);
    __syncthreads();
    pg8::acc_to_lds<1, 0>(acc, false, (float*)smem_all);
    pg8::acc_to_lds<1, 1>(acc, false, (float*)(smem_all + SMEM_BYTES));
    __syncthreads();
    moe1_epilogue(pe, mb * MOE_BLK + 128, 2 * pn + half, sCh, etid);
    __syncthreads();
  }
}
__device__ __forceinline__ void phase_moe2(PRef p, int layer, char* smem_all) {
  LAS3 unsigned char* lds = (LAS3 unsigned char*)smem_all;
  const bf16_t* actp = p.act;
  const bf16_t* w2p = p.wt_2;
  bf16_t* yp = p.ysl;
  const int* cntp = p.cnt;
  auto lookup = [&](int mb, int& e) {
    int start = 0;
    for (int i = 0; i < 32; ++i) {
      const int nb = (cntp[i] + MOE_BLK - 1) / MOE_BLK;
      if (mb < start + nb) { e = i; return true; }
      start += nb;
    }
    return false;
  };
  pg8::gemm_stream<true>(lds, 512,
    [&](int ui, pg8::UnitAB& u) {
      const int L = pg8::unit_linear(ui);
      const int mb = L >> 2, pn = L & 3;
      int e;
      if (mb >= MAX_MBLK || !lookup(mb, e)) return false;
      u.a = (const char*)(actp + (size_t)mb * MOE_BLK * 512);
      u.b = (const char*)(w2p + ((size_t)e * 1024 + pn * 256) * 512);
      return true;
    },
    [&](int ui, const pg8::f32x4 (&acc)[2][2][4][2]) {
      const int L = pg8::unit_linear(ui);
      const int mb = L >> 2, pn = L & 3;
      bf16_t* ydst = yp + (size_t)mb * MOE_BLK * D + pn * 256;
      pg8::for_each_piece(acc, [&](int row, int col, float (&v)[8]) { st_nt16(ydst + (size_t)row * D + col, pack8(v)); });
    });
}

struct AttnState { f32x16 negm; f32x16 L; };
__device__ __forceinline__ void attn_qk(const char* sK, const bf16x8 (&bq)[4], const f32x16& negm, f32x16 (&S)[2], int r, int hh) {
  const int pr = 16 * (r >> 4) + 8 * ((r >> 2) & 1) + 4 * ((r >> 3) & 1) + (r & 3);
  const char* kp = sK + pr * 128;
#pragma unroll
  for (int s = 0; s < 4; ++s) {
    const int co = ((2 * s + hh) ^ ((pr >> 1) & 7)) << 4;
    bf16x8 a0 = *(const bf16x8*)(kp + co);
    bf16x8 a1 = *(const bf16x8*)(kp + 4096 + co);
    if (s == 0) { S[0] = mfma32(a0, bq[0], negm); S[1] = mfma32(a1, bq[0], negm); }
    else { S[0] = mfma32(a0, bq[s], S[0]); S[1] = mfma32(a1, bq[s], S[1]); }
  }
}
template <class MaskF>
__device__ __forceinline__ float attn_softmax_pv(f32x16 (&S)[2], const char* sV, f32x16 (&O)[2], AttnState& st, bf16x8 ones, int r, int hh,
                                                 MaskF maskf, const bool FIRST) {
  maskf(S);
  float mx = S[0][0];
#pragma unroll
  for (int g = 1; g < 16; ++g) mx = fmaxf(mx, S[0][g]);
#pragma unroll
  for (int g = 0; g < 16; ++g) mx = fmaxf(mx, S[1][g]);
  {
    auto sw = __builtin_amdgcn_permlane32_swap(__float_as_uint(mx), __float_as_uint(mx), false, false);
    mx = fmaxf(__uint_as_float(sw[0]), __uint_as_float(sw[1]));
  }
  float dshift = 0.f;
  if (FIRST || __any(mx > 8.f)) {
    const float d = FIRST ? mx : fmaxf(mx, 0.f);
    dshift = d;
    const float alpha = __builtin_amdgcn_exp2f(-d);
#pragma unroll
    for (int g = 0; g < 16; ++g) {
      st.negm[g] -= d;
      S[0][g] -= d; S[1][g] -= d;
      O[0][g] *= alpha; O[1][g] *= alpha;
    }
    st.L[0] *= alpha;
  }
#pragma unroll
  for (int kb = 0; kb < 2; ++kb)
#pragma unroll
    for (int g = 0; g < 16; ++g) S[kb][g] = __builtin_amdgcn_exp2f(S[kb][g]);
  const char* vp = sV + r * 128;
  const int vsw = (r >> 1) & 7;
#pragma unroll
  for (int sp = 0; sp < 4; ++sp) {
    const int sb_ = sp >> 1, so_ = 8 * (sp & 1);
    u32x4 bpu = {pack2(S[sb_][so_], S[sb_][so_ + 1]), pack2(S[sb_][so_ + 2], S[sb_][so_ + 3]), pack2(S[sb_][so_ + 4], S[sb_][so_ + 5]),
                 pack2(S[sb_][so_ + 6], S[sb_][so_ + 7])};
    bf16x8 bp = __builtin_bit_cast(bf16x8, bpu);
#pragma unroll
    for (int db = 0; db < 2; ++db) {
      bf16x8 av = *(const bf16x8*)(vp + db * 4096 + (((2 * sp + hh) ^ vsw) << 4));
      O[db] = mfma32(av, bp, O[db]);
    }
    st.L = mfma32(ones, bp, st.L);
  }
  return dshift;
}
template <class MaskF>
__device__ __forceinline__ void attn_tile(const char* sK, const char* sV, const bf16x8 (&bq)[4], f32x16 (&O)[2], AttnState& st, bf16x8 ones,
                                          int r, int hh, MaskF maskf, const bool FIRST) {
  f32x16 S[2];
  attn_qk(sK, bq, st.negm, S, r, hh);
  (void)attn_softmax_pv(S, sV, O, st, ones, r, hh, maskf, FIRST);
}
__device__ __forceinline__ void attn_state_init(AttnState& st, bf16x8& ones, int r) {
  st.negm = zero16();
  st.L = zero16();
  const short one = (r == 0) ? (short)0x3F80 : (short)0;
  ones = (bf16x8){one, one, one, one, one, one, one, one};
}

__device__ __forceinline__ void attn_stage(const bf16_t* kg, size_t kstride, const bf16_t* vg, size_t vstride, char* sKd, char* sVd, int tid) {
  const int row = tid >> 3, u = ((tid & 7) ^ ((tid >> 4) & 7)) * 8;
#pragma unroll
  for (int i = 0; i < 2; ++i) {
    __builtin_amdgcn_global_load_lds((const unsigned*)(kg + (size_t)(row + 32 * i) * kstride + u), (LAS3 unsigned*)(sKd + tid * 16 + i * 4096), 16, 0, 0);
    __builtin_amdgcn_global_load_lds((const unsigned*)(vg + (size_t)(row + 32 * i) * vstride + u), (LAS3 unsigned*)(sVd + tid * 16 + i * 4096), 16, 0, 0);
  }
}
struct NoMask { __device__ __forceinline__ void operator()(f32x16 (&)[2]) const {} };

__device__ __forceinline__ void attn_write_out(bf16_t* dst  , const f32x16 (&O)[2], float l, int hh) {
  float lt = l + __shfl_xor(l, 32);
  float inv = 1.f / lt;
#pragma unroll
  for (int db = 0; db < 2; ++db)
#pragma unroll
    for (int g4 = 0; g4 < 4; ++g4) {
      uint2 o = make_uint2(pack2(O[db][4 * g4] * inv, O[db][4 * g4 + 1] * inv), pack2(O[db][4 * g4 + 2] * inv, O[db][4 * g4 + 3] * inv));
      *(uint2*)(dst + 32 * db + 8 * g4 + 4 * hh) = o;
    }
}

__device__ __forceinline__ void phase_attnA(PRef p, int layer, char* smem_all) {
  int tid = __builtin_amdgcn_workitem_id_x();
  asm volatile("" : "+v"(tid));
  const int lane = tid & 63, w8 = tid >> 6, w = w8 & 3, qsub = w8 >> 2, r = lane & 31, hh = lane >> 5;
  char* sK = smem_all;
  char* sV = smem_all + 32768;
  const int nitems = layer == 0 ? 544 : 512;
  const int G = (int)gridDim.x;
  for (int item = (int)__builtin_amdgcn_workgroup_id_x(); item < nitems; item += G) {
    int b, kvh, qtok0, nkt;
    if (item < 512) { b = item >> 7; kvh = (item >> 6) & 1; qtok0 = b * 4096 + (item & 63) * 64 + qsub * 32; nkt = 68; }
    else { int it = item - 512; b = it >> 3; kvh = (it >> 2) & 1; qtok0 = TLAT + b * 256 + (it & 3) * 64 + qsub * 32; nkt = 4; }
    const int head = kvh * 4 + w;
    bf16x8 bq[4];
    {
      const bf16_t* qp = p.qA + (size_t)(qtok0 + r) * 512 + head * 64 + 8 * hh;
#pragma unroll
      for (int s = 0; s < 4; ++s) bq[s] = *(const bf16x8*)(qp + 16 * s);
    }
    const bf16_t* kbase = p.kA + (size_t)(b * 2 + kvh) * PALL * 64;
    const bf16_t* vbase = p.vAT + (size_t)(b * 2 + kvh) * 64 * PALL;
    const int srow = tid >> 3, su = ((tid & 7) ^ ((tid >> 4) & 7)) * 8;
    const bf16_t* kg = kbase + (size_t)srow * 64 + su;
    const bf16_t* vg = vbase + (size_t)srow * PALL + su;
    f32x16 O[2];
    O[0] = zero16();
    O[1] = zero16();
    AttnState st;
    bf16x8 ones;
    attn_state_init(st, ones, r);
    __syncthreads();
#define ATT_STAGE(KT)                                                                                                                     \
  {                                                                                                                                       \
    __builtin_amdgcn_global_load_lds((const unsigned*)(kg + (size_t)(KT) * 4096), (LAS3 unsigned*)(sK + ((KT) & 3) * 8192 + tid * 16), 16, 0, 0); \
    __builtin_amdgcn_global_load_lds((const unsigned*)(vg + (KT) * 64), (LAS3 unsigned*)(sV + ((KT) & 3) * 8192 + tid * 16), 16, 0, 0);           \
  }
    ATT_STAGE(0);
    ATT_STAGE(1);
    dma_sync();
    f32x16 Sa[2], Sb[2];
    attn_qk(sK, bq, st.negm, Sa, r, hh);
#define ATT_STEP(KT, CUR, NXT)                                                                                              \
  {                                                                                                                         \
    if ((KT) > 0) dma_sync();                \
    if ((KT) + 2 < nkt) ATT_STAGE((KT) + 2);                                                                                \
    if ((KT) + 1 < nkt) attn_qk(sK + (((KT) + 1) & 3) * 8192, bq, st.negm, NXT, r, hh);                                     \
    const float d_ = attn_softmax_pv(CUR, sV + ((KT) & 3) * 8192, O, st, ones, r, hh, NoMask(), (KT) == 0);                 \
    if ((KT) + 1 < nkt && __any(d_ != 0.f)) {      \
      _Pragma("unroll") for (int g = 0; g < 16; ++g) { NXT[0][g] -= d_; NXT[1][g] -= d_; }                                  \
    }                                                                                                                       \
  }
    for (int kt = 0; kt < nkt; kt += 2) {
      ATT_STEP(kt, Sa, Sb);
      ATT_STEP(kt + 1, Sb, Sa);
    }
#undef ATT_STEP
#undef ATT_STAGE
    attn_write_out(p.oA + (size_t)(qtok0 + r) * 512 + head * 64, O, st.L[0], hh);
  }
}

struct NaMask {
  const float* bp;
  int cofs;
  bool on;
  __device__ __forceinline__ void operator()(f32x16 (&S)[2]) const {
    if (!on) return;
    f32x16 bv[2];
#pragma unroll
    for (int kb = 0; kb < 2; ++kb)
#pragma unroll
      for (int g = 0; g < 16; ++g) bv[kb][g] = bp[32 * kb + 16 * (g >> 3) + 4 * ((g >> 2) & 1) + (g & 3)];
    asm volatile("" : "+v"(bv[0]), "+v"(bv[1]));
#pragma unroll
    for (int kb = 0; kb < 2; ++kb)
#pragma unroll
      for (int g = 0; g < 16; ++g) {
        const int cc = 32 * kb + 16 * (g >> 3) + 4 * ((g >> 2) & 1) + (g & 3);
        const bool valid = (unsigned)(cc + cofs) < 16u;
        S[kb][g] = valid ? S[kb][g] + bv[kb][g] : -1e30f;
      }
  }
};
__device__ __forceinline__ void phase_na(PRef p, int layer, char* smem) {
  const int tid = tid_(), lane = tid & 63, w = tid >> 6, r = lane & 31, hh = lane >> 5;
  char* sK = smem;
  char* sV = smem + 32768;
  float* sBias = (float*)(smem + 65536);
  const int nitems = layer == 0 ? 1088 : 1024;
  const int set = w >> 1, qhalf = w & 1;
  for (int item = bid_(); item < nitems; item += vgrid_()) {
    int b, hp, row = 0, rs = 0, qtok0, kt0, kt1;
    if (item < 1024) {
      b = item >> 8; row = (item >> 2) & 63; hp = item & 3;
      rs = row - 4; rs = rs < 0 ? 0 : (rs > 56 ? 56 : rs);
      qtok0 = b * 4096 + row * 64; kt0 = 0; kt1 = 12;
    } else {
      int it = item - 1024;
      b = it >> 4; hp = (it >> 2) & 3;
      qtok0 = TLAT + b * 256 + (it & 3) * 64; kt0 = 8; kt1 = 12;
    }
    const int head = 2 * hp + set;
    __syncthreads();
    for (int i = tid; i < 930; i += 256) {
      int s = i / 465, j = i % 465;
      sBias[i] = p.rpb[((size_t)layer * 8 + 2 * hp + s) * 465 + j] * LOG2E;
    }
    bf16x8 bq[4];
    {
      const bf16_t* qp = p.qC + (size_t)(qtok0 + 32 * qhalf + r) * 512 + head * 64 + 8 * hh;
#pragma unroll
      for (int s = 0; s < 4; ++s) bq[s] = *(const bf16x8*)(qp + 16 * s);
    }
    f32x16 O[2];
    O[0] = zero16();
    O[1] = zero16();
    AttnState st;
    bf16x8 ones;
    attn_state_init(st, ones, r);
#define NA_STAGE(KT, BUF)                                                                                          \
  {                                                                                                                \
    int tokK, pallb;                                                                                               \
    if ((KT) < 8) { tokK = b * 4096 + (rs + (KT)) * 64; pallb = 256 + (rs + (KT)) * 64; }                          \
    else { tokK = TLAT + b * 256 + ((KT) - 8) * 64; pallb = ((KT) - 8) * 64; }                                     \
    _Pragma("unroll") for (int s2 = 0; s2 < 2; ++s2)                                                               \
      attn_stage(p.kC + (size_t)tokK * 512 + (2 * hp + s2) * 64, 512, p.vCT + (size_t)(b * 8 + 2 * hp + s2) * 64 * PALL + pallb, PALL, \
                 sK + (BUF) * 16384 + s2 * 8192, sV + (BUF) * 16384 + s2 * 8192, tid);                             \
  }
    NA_STAGE(kt0, 0);
    for (int kt = kt0; kt < kt1; ++kt) {
      const int cur = (kt - kt0) & 1;
      dma_sync();
      if (kt + 1 < kt1) NA_STAGE(kt + 1, cur ^ 1);
      {
        NaMask mk;
        const int wq = 32 * qhalf + r;
        int cs = wq - 8;
        cs = cs < 0 ? 0 : (cs > 48 ? 48 : cs);
        mk.on = kt < 8;
        mk.bp = sBias + set * 465 + (mk.on ? (rs + kt - row + 7) * 31 : 0) - wq + 15 + 8 * hh;
        mk.cofs = 8 * hh - cs;
        attn_tile(sK + cur * 16384 + set * 8192, sV + cur * 16384 + set * 8192, bq, O, st, ones, r, hh, mk, kt == kt0);
      }
    }
#undef NA_STAGE
    attn_write_out(p.oC + (size_t)(qtok0 + 32 * qhalf + r) * 512 + head * 64, O, st.L[0], hh);
  }
}

__device__ __forceinline__ float log_sigmoidf_(float x) { return fminf(x, 0.f) - __logf(1.f + __expf(-fabsf(x))); }
struct GlaPre { f32x4v a0, a1, a2, a3, wg0, wg1; float bg; };
__device__ __forceinline__ void gla_prep_load(PRef p, int layer, int hd, int dir, int tok0, GlaPre& R) {
  const int tid = tid_(), lane = tid & 63, w = tid >> 6, r = lane & 31, hh = lane >> 5, pb = w >> 1, db = w & 1;
  const float* ap = p.aB + (size_t)(tok0 + 32 * pb + r) * 32 + dir * 16;
  R.a0 = *(const f32x4v*)(ap); R.a1 = *(const f32x4v*)(ap + 4); R.a2 = *(const f32x4v*)(ap + 8); R.a3 = *(const f32x4v*)(ap + 12);
  const float* wp = p.gla_wg + (((size_t)layer * 2 + dir) * 16 + hh) * 256 + hd * 64 + 32 * db + r;
  R.wg0 = (f32x4v){wp[0], wp[2 * 256], wp[4 * 256], wp[6 * 256]};
  R.wg1 = (f32x4v){wp[8 * 256], wp[10 * 256], wp[12 * 256], wp[14 * 256]};
  R.bg = p.gla_bg[((size_t)layer * 2 + dir) * 256 + hd * 64 + 32 * db + r];
}
#define GLA_DPP_ADD(v, ctrl, rmask) v += __builtin_bit_cast(float, __builtin_amdgcn_update_dpp(0, __builtin_bit_cast(int, v), ctrl, rmask, 0xf, false))
__device__ __forceinline__ void gla_prep_compute(const GlaPre& R, int dir, float* sBc) {
  const int tid = tid_(), lane = tid & 63, w = tid >> 6, r = lane & 31, hh = lane >> 5, pb = w >> 1, db = w & 1;
  {
    f32x16 x;
#pragma unroll
    for (int g = 0; g < 16; ++g) x[g] = R.bg;
    const float ae[8] = {R.a0[0], R.a0[2], R.a1[0], R.a1[2], R.a2[0], R.a2[2], R.a3[0], R.a3[2]};
    const float ao[8] = {R.a0[1], R.a0[3], R.a1[1], R.a1[3], R.a2[1], R.a2[3], R.a3[1], R.a3[3]};
    const float wv[8] = {R.wg0[0], R.wg0[1], R.wg0[2], R.wg0[3], R.wg1[0], R.wg1[1], R.wg1[2], R.wg1[3]};
#pragma unroll
    for (int s = 0; s < 8; ++s) x = __builtin_amdgcn_mfma_f32_32x32x2f32(hh ? ao[s] : ae[s], wv[s], x, 0, 0, 0);
#pragma unroll
    for (int g = 0; g < 16; ++g) {
      const int pos = 32 * pb + (g & 3) + 8 * (g >> 2) + 4 * hh;
      sBc[pos * 65 + 32 * db + r] = log_sigmoidf_(x[g]) * (1.f / 16.f);
    }
  }
  __syncthreads();
  {
    const int idx = dir ? 63 - lane : lane;
    float v[16];
#pragma unroll
    for (int dd = 0; dd < 16; ++dd) v[dd] = sBc[idx * 65 + w * 16 + dd];
#pragma unroll
    for (int dd = 0; dd < 16; ++dd) GLA_DPP_ADD(v[dd], 0x111, 0xf);
#pragma unroll
    for (int dd = 0; dd < 16; ++dd) GLA_DPP_ADD(v[dd], 0x112, 0xf);
#pragma unroll
    for (int dd = 0; dd < 16; ++dd) GLA_DPP_ADD(v[dd], 0x114, 0xf);
#pragma unroll
    for (int dd = 0; dd < 16; ++dd) GLA_DPP_ADD(v[dd], 0x118, 0xf);
#pragma unroll
    for (int dd = 0; dd < 16; ++dd) GLA_DPP_ADD(v[dd], 0x142, 0xa);
#pragma unroll
    for (int dd = 0; dd < 16; ++dd) GLA_DPP_ADD(v[dd], 0x143, 0xc);
#pragma unroll
    for (int dd = 0; dd < 16; ++dd) sBc[idx * 65 + w * 16 + dd] = v[dd];
  }
  __syncthreads();
}
__device__ __forceinline__ void chunk_pos(int b, int dir, int c, int& tok0, int& pall0) {
  if (c < 4) { int pc = dir ? 3 - c : c; tok0 = TLAT + b * 256 + pc * 64; pall0 = pc * 64; }
  else { int j = c - 4; int pc = dir ? 63 - j : j; tok0 = b * 4096 + pc * 64; pall0 = 256 + pc * 64; }
}
__device__ __forceinline__ void phase_gla1(PRef p, int layer, char* smem) {
  float* sWg = (float*)smem;
  float* sBc = (float*)(smem + 4096);
  bf16_t* sKt = (bf16_t*)(smem + 20736);
  bf16_t* sVt = (bf16_t*)(smem + 29952);
  const int tid = tid_(), lane = tid & 63, w = tid >> 6, r = lane & 31, hh = lane >> 5;
  for (int item = bid_(); item < 32 * NCHUNK; item += vgrid_()) {
    const int ch = item / NCHUNK, c = item % NCHUNK;
    const int dir = ch & 1, hd = (ch >> 1) & 3, b = ch >> 3;
    int tok0, pall0;
    chunk_pos(b, dir, c, tok0, pall0);
    GlaPre R;
    gla_prep_load(p, layer, hd, dir, tok0, R);
    u32x4 k0, k1, vv0, vv1, vv2, vv3;
    {
      const int pos = tid >> 2, dg = tid & 3;
      const bf16_t* kp = p.kB + (size_t)(tok0 + pos) * 256 + hd * 64 + dg * 16;
      k0 = *(const u32x4*)kp; k1 = *(const u32x4*)(kp + 8);
      const bf16_t* vb = p.vBT + (size_t)(b * 4 + hd) * 128 * PALL + pall0 + (tid & 7) * 8;
      vv0 = *(const u32x4*)(vb + (size_t)(tid >> 3) * PALL);
      vv1 = *(const u32x4*)(vb + (size_t)((tid >> 3) + 32) * PALL);
      vv2 = *(const u32x4*)(vb + (size_t)((tid >> 3) + 64) * PALL);
      vv3 = *(const u32x4*)(vb + (size_t)((tid >> 3) + 96) * PALL);
    }
    __syncthreads();
    gla_prep_compute(R, dir, sBc);
    {
      const int pos = tid >> 2, dg = tid & 3;
      float* bd = p.bcum + (size_t)item * 4096 + pos * 64 + dg * 16;
#pragma unroll
      for (int q4 = 0; q4 < 4; ++q4)
        *(float4*)(bd + 4 * q4) = make_float4(sBc[pos * 65 + dg * 16 + 4 * q4], sBc[pos * 65 + dg * 16 + 4 * q4 + 1], sBc[pos * 65 + dg * 16 + 4 * q4 + 2], sBc[pos * 65 + dg * 16 + 4 * q4 + 3]);
    }
    {
      int pos = tid >> 2, dg = tid & 3;
      unsigned ku[8] = {k0[0], k0[1], k0[2], k0[3], k1[0], k1[1], k1[2], k1[3]};
#pragma unroll
      for (int e = 0; e < 16; ++e) {
        int d = dg * 16 + e;
        float kv = bf2f((bf16_t)((e & 1) ? (ku[e >> 1] >> 16) : (ku[e >> 1] & 0xffff)));
        float bend = sBc[(dir ? 0 : 63) * 65 + d];
        sKt[d * 72 + pos] = f2bf(kv * __expf(bend - sBc[pos * 65 + d]));
      }
      {
        const int dv = tid >> 3, cc = tid & 7;
        *(u32x4*)(sVt + dv * 72 + cc * 8) = vv0;
        *(u32x4*)(sVt + (dv + 32) * 72 + cc * 8) = vv1;
        *(u32x4*)(sVt + (dv + 64) * 72 + cc * 8) = vv2;
        *(u32x4*)(sVt + (dv + 96) * 72 + cc * 8) = vv3;
      }
      if (tid < 64) p.decay[(size_t)item * 64 + tid] = __expf(sBc[(dir ? 0 : 63) * 65 + tid]);
    }
    __syncthreads();
    f32x16 acc[2];
    acc[0] = zero16();
    acc[1] = zero16();
#pragma unroll
    for (int s = 0; s < 4; ++s) {
      bf16x8 a = *(const bf16x8*)(sVt + (32 * w + r) * 72 + 16 * s + 8 * hh);
      bf16x8 b0 = *(const bf16x8*)(sKt + r * 72 + 16 * s + 8 * hh);
      bf16x8 b1 = *(const bf16x8*)(sKt + (32 + r) * 72 + 16 * s + 8 * hh);
      acc[0] = mfma32(b0, a, acc[0]);
      acc[1] = mfma32(b1, a, acc[1]);
    }
    float* dst = p.KVt + (size_t)item * 8192 + (32 * w + r) * 64 + 4 * hh;
#pragma unroll
    for (int jb = 0; jb < 2; ++jb)
#pragma unroll
      for (int g4 = 0; g4 < 4; ++g4)
        *(float4*)(dst + 32 * jb + 8 * g4) = make_float4(acc[jb][4 * g4], acc[jb][4 * g4 + 1], acc[jb][4 * g4 + 2], acc[jb][4 * g4 + 3]);
  }
}
__device__ __forceinline__ void phase_gla2(PRef p) {
  for (int idx = bid_() * 256 + tid_(); idx < 32 * 8192; idx += vgrid_() * 256) {
    const int ch = idx >> 13, e = idx & 8191;
    float S = 0.f;
    const float* kv = p.KVt + (size_t)ch * NCHUNK * 8192 + e;
    const float* dc = p.decay + (size_t)ch * NCHUNK * 64 + (e & 63);
    bf16_t* sp = p.SP + (size_t)ch * NCHUNK * 8192 + e;
#pragma unroll 1
    for (int c0 = 0; c0 < NCHUNK; c0 += 17) {
      float kvv[17], dcv[17];
#pragma unroll
      for (int j = 0; j < 17; ++j) { kvv[j] = kv[(size_t)(c0 + j) * 8192]; dcv[j] = dc[(c0 + j) * 64]; }
#pragma unroll
      for (int j = 0; j < 17; ++j) { sp[(size_t)(c0 + j) * 8192] = f2bf(S); S = dcv[j] * S + kvv[j]; }
    }
  }
}
__device__ __forceinline__ void phase_gla3(PRef p, int layer, char* smem) {
  float* sWg = (float*)smem;
  float* sBc = (float*)(smem + 4096);
  bf16_t* sQ = (bf16_t*)(smem + 20736);
  bf16_t* sK = (bf16_t*)(smem + 29952);
  bf16_t* sVt = (bf16_t*)(smem + 39168);
  float* sRed = (float*)(smem + 57600);
  const int tid = tid_(), lane = tid & 63, w = tid >> 6, r = lane & 31, hh = lane >> 5;
  const int npc = layer == 0 ? 68 : 64;
  const int pr = 16 * (r >> 4) + 8 * ((r >> 2) & 1) + 4 * ((r >> 3) & 1) + (r & 3);
  for (int item = bid_(); item < 16 * npc; item += vgrid_()) {
    const int bh = item / npc;
    const int pca = (layer == 0) ? (item % npc) : (4 + item % npc);
    const int b = bh >> 2, hd = bh & 3;
    int tok0, pall0;
    chunk_pos(b, 0, pca, tok0, pall0);
    f32x16 O[2];
    O[0] = zero16();
    O[1] = zero16();
    const int c0 = pca, c1 = (pca < 4) ? 3 - pca : 4 + (63 - (pca - 4));
    f32x4v bA[4], bB[4];
    u32x4 q0, q1, k0, k1, vv0, vv1, vv2, vv3;
    {
      const int pos = tid >> 2, dg = tid & 3;
      const float* b0p = p.bcum + ((size_t)((b * 4 + hd) * 2 + 0) * NCHUNK + c0) * 4096 + pos * 64 + dg * 16;
      const float* b1p = p.bcum + ((size_t)((b * 4 + hd) * 2 + 1) * NCHUNK + c1) * 4096 + pos * 64 + dg * 16;
#pragma unroll
      for (int q4 = 0; q4 < 4; ++q4) { bA[q4] = *(const f32x4v*)(b0p + 4 * q4); bB[q4] = *(const f32x4v*)(b1p + 4 * q4); }
      const bf16_t* qp = p.qB + (size_t)(tok0 + pos) * 256 + hd * 64 + dg * 16;
      const bf16_t* kp = p.kB + (size_t)(tok0 + pos) * 256 + hd * 64 + dg * 16;
      q0 = *(const u32x4*)qp; q1 = *(const u32x4*)(qp + 8);
      k0 = *(const u32x4*)kp; k1 = *(const u32x4*)(kp + 8);
      const bf16_t* vb = p.vBT + (size_t)(b * 4 + hd) * 128 * PALL + pall0 + (tid & 7) * 8;
      vv0 = *(const u32x4*)(vb + (size_t)(tid >> 3) * PALL);
      vv1 = *(const u32x4*)(vb + (size_t)((tid >> 3) + 32) * PALL);
      vv2 = *(const u32x4*)(vb + (size_t)((tid >> 3) + 64) * PALL);
      vv3 = *(const u32x4*)(vb + (size_t)((tid >> 3) + 96) * PALL);
    }
    __syncthreads();
    {
      const int dv = tid >> 3, cc = tid & 7;
      *(u32x4*)(sVt + dv * 72 + cc * 8) = vv0;
      *(u32x4*)(sVt + (dv + 32) * 72 + cc * 8) = vv1;
      *(u32x4*)(sVt + (dv + 64) * 72 + cc * 8) = vv2;
      *(u32x4*)(sVt + (dv + 96) * 72 + cc * 8) = vv3;
    }
#pragma unroll
    for (int dir = 0; dir < 2; ++dir) {
      if (dir == 1) __syncthreads();
      {
        int pos = tid >> 2, dg = tid & 3;
        unsigned qu[8] = {q0[0], q0[1], q0[2], q0[3], q1[0], q1[1], q1[2], q1[3]};
        unsigned ku[8] = {k0[0], k0[1], k0[2], k0[3], k1[0], k1[1], k1[2], k1[3]};
        unsigned qo[8], ko[8];
#pragma unroll
        for (int e2 = 0; e2 < 8; ++e2) {
          const float b0 = dir ? bB[e2 >> 1][(2 * e2) & 3] : bA[e2 >> 1][(2 * e2) & 3];
          const float b1 = dir ? bB[e2 >> 1][(2 * e2 + 1) & 3] : bA[e2 >> 1][(2 * e2 + 1) & 3];
          const float ea0 = __expf(b0), ea1 = __expf(b1), ia0 = __builtin_amdgcn_rcpf(ea0), ia1 = __builtin_amdgcn_rcpf(ea1);
          qo[e2] = pack2(bf2f((bf16_t)(qu[e2] & 0xffff)) * ea0, bf2f((bf16_t)(qu[e2] >> 16)) * ea1);
          ko[e2] = pack2(bf2f((bf16_t)(ku[e2] & 0xffff)) * ia0, bf2f((bf16_t)(ku[e2] >> 16)) * ia1);
        }
        *(uint4*)(sQ + pos * 72 + dg * 16) = make_uint4(qo[0], qo[1], qo[2], qo[3]);
        *(uint4*)(sQ + pos * 72 + dg * 16 + 8) = make_uint4(qo[4], qo[5], qo[6], qo[7]);
        *(uint4*)(sK + pos * 72 + dg * 16) = make_uint4(ko[0], ko[1], ko[2], ko[3]);
        *(uint4*)(sK + pos * 72 + dg * 16 + 8) = make_uint4(ko[4], ko[5], ko[6], ko[7]);
      }
      __syncthreads();
      const int c = dir ? c1 : c0;
      const int ch = (b * 4 + hd) * 2 + dir;
      const bf16_t* sp = p.SP + ((size_t)ch * NCHUNK + c) * 8192 + (size_t)(32 * w + r) * 64 + 8 * hh;
      bf16x8 bqf[2][4];
#pragma unroll
      for (int tb = 0; tb < 2; ++tb)
#pragma unroll
        for (int ks = 0; ks < 4; ++ks) bqf[tb][ks] = *(const bf16x8*)(sQ + (32 * tb + r) * 72 + 16 * ks + 8 * hh);
#pragma unroll
      for (int ks = 0; ks < 4; ++ks) {
        bf16x8 a = *(const bf16x8*)(sp + 16 * ks);
        O[0] = mfma32(a, bqf[0][ks], O[0]);
        O[1] = mfma32(a, bqf[1][ks], O[1]);
      }
#pragma unroll
      for (int sb = 0; sb < 2; ++sb)
#pragma unroll
        for (int tb = 0; tb < 2; ++tb) {
          const bool skip = dir == 0 ? (sb == 1 && tb == 0) : (sb == 0 && tb == 1);
          if (skip) continue;
          f32x16 Sc = zero16();
#pragma unroll
          for (int ks = 0; ks < 4; ++ks) {
            bf16x8 a = *(const bf16x8*)(sK + (32 * sb + pr) * 72 + 16 * ks + 8 * hh);
            Sc = mfma32(a, bqf[tb][ks], Sc);
          }
          const int t = 32 * tb + r;
#pragma unroll
          for (int g = 0; g < 16; ++g) {
            int s = 32 * sb + 16 * (g >> 3) + 4 * ((g >> 2) & 1) + (g & 3) + 8 * hh;
            bool keep = dir == 0 ? (t >= s) : (s >= t);
            Sc[g] = keep ? Sc[g] : 0.f;
          }
#pragma unroll
          for (int s2 = 0; s2 < 2; ++s2) {
            const int sp4 = 2 * sb + s2;
            u32x4 bpu = {pack2(Sc[8 * s2], Sc[8 * s2 + 1]), pack2(Sc[8 * s2 + 2], Sc[8 * s2 + 3]), pack2(Sc[8 * s2 + 4], Sc[8 * s2 + 5]),
                         pack2(Sc[8 * s2 + 6], Sc[8 * s2 + 7])};
            bf16x8 bp = __builtin_bit_cast(bf16x8, bpu);
            bf16x8 av = *(const bf16x8*)(sVt + (32 * w + r) * 72 + 16 * sp4 + 8 * hh);
            O[tb] = mfma32(av, bp, O[tb]);
          }
        }
    }
    float ss[2];
#pragma unroll
    for (int tb = 0; tb < 2; ++tb) {
      float s = 0.f;
#pragma unroll
      for (int g = 0; g < 16; ++g) s += O[tb][g] * O[tb][g];
      s += __shfl_xor(s, 32);
      ss[tb] = s;
    }
    if (hh == 0) { sRed[w * 64 + r] = ss[0]; sRed[w * 64 + 32 + r] = ss[1]; }
    __syncthreads();
    f32x4v gnv[4];
#pragma unroll
    for (int g4 = 0; g4 < 4; ++g4) gnv[g4] = *(const f32x4v*)(p.gla_norm + layer * 128 + 32 * w + 8 * g4 + 4 * hh);
#pragma unroll
    for (int tb = 0; tb < 2; ++tb) {
      int t = 32 * tb + r;
      float tot = sRed[t] + sRed[64 + t] + sRed[128 + t] + sRed[192 + t];
      float rstd = rsqrtf(tot * (1.f / 128.f) + 1e-6f);
      const int tok = tok0 + t;
#pragma unroll
      for (int g4 = 0; g4 < 4; ++g4) {
        int dv = 32 * w + 8 * g4 + 4 * hh;
        uint2 rr = *(const uint2*)(p.rB + (size_t)tok * 512 + hd * 128 + dv);
        float rg[4] = {bf2f((bf16_t)(rr.x & 0xffff)), bf2f((bf16_t)(rr.x >> 16)), bf2f((bf16_t)(rr.y & 0xffff)), bf2f((bf16_t)(rr.y >> 16))};
        float o[4];
#pragma unroll
        for (int e = 0; e < 4; ++e) o[e] = O[tb][4 * g4 + e] * rstd * gnv[g4][e] * siluf(rg[e]);
        *(uint2*)(p.oB + (size_t)tok * 512 + hd * 128 + dv) = make_uint2(pack2(o[0], o[1]), pack2(o[2], o[3]));
      }
    }
  }
}

#define PHASE_KERNEL(name, call)                                               \
  __global__ void __launch_bounds__(512, 2) name(Params p_, int layer) {       \
    __shared__ __attribute__((aligned(16))) char smem_all[2 * SMEM_BYTES];     \
    char* smem = smem_all + half_() * SMEM_BYTES;                              \
    PRef p = params_view();                                           \
    call;                                                                      \
  }
PHASE_KERNEL(k_setup, phase_setup(p, smem))
PHASE_KERNEL(k_modreduce, phase_modreduce(p))
PHASE_KERNEL(k_convert, phase_convert(p, layer, smem))
PHASE_KERNEL(k_rowpass0, phase_rowpass0(p))
PHASE_KERNEL(k_inproj, phase_inproj(p, layer, smem_all))
PHASE_KERNEL(k_attnA, phase_attnA(p, layer, smem_all))
PHASE_KERNEL(k_na, phase_na(p, layer, smem))
PHASE_KERNEL(k_gla1, phase_gla1(p, layer, smem))
PHASE_KERNEL(k_gla2, phase_gla2(p))
PHASE_KERNEL(k_gla3, phase_gla3(p, layer, smem))
PHASE_KERNEL(k_merge, phase_merge(p, layer, smem_all))
PHASE_KERNEL(k_outproj, phase_outproj(p, layer, smem_all))
PHASE_KERNEL(k_rowpass1, phase_rowpass1(p, layer, smem))
PHASE_KERNEL(k_moescan, phase_moescan(p, layer, smem))
PHASE_KERNEL(k_moe1, phase_moe1(p, layer, smem_all))
PHASE_KERNEL(k_moe2, phase_moe2(p, layer, smem_all))
PHASE_KERNEL(k_rowpass2, phase_rowpass2(p, layer))

#define XB_TMO      128
#define XB_XCNT(j)  (256  + 64 * (j))
#define XB_XSUB(j)  (1280 + 64 * (j))
#define XB_XGEN(j)  (2304 + 64 * (j))
#define XB_TOP      3328
#define XB_TOPGEN   3392
#define XCD_BAR_WORDS 3456
#define XB_SPIN_CAP (1u << 23)
#define LAS __attribute__((address_space(3)))
__device__ __forceinline__ unsigned xb_ld(unsigned* p) { return __hip_atomic_load(p, __ATOMIC_RELAXED, __HIP_MEMORY_SCOPE_AGENT); }
__device__ __forceinline__ unsigned xb_add(unsigned* p, unsigned v) { return __hip_atomic_fetch_add(p, v, __ATOMIC_RELAXED, __HIP_MEMORY_SCOPE_AGENT); }
__device__ __forceinline__ unsigned xb_xcc_id() { return (unsigned)__builtin_amdgcn_s_getreg((3 << 11) | 20) & 0xFu; }
#define XB_SPIN(cond, bar) do { unsigned _sp = 0; while (cond) { __builtin_amdgcn_s_sleep(1); \
    if ((++_sp & 255u) == 0u) { if (xb_ld(&(bar)[XB_TMO])) break; if (_sp > XB_SPIN_CAP) { atomicAdd(&(bar)[XB_TMO], 1u); break; } } } } while (0)
struct XcdBarrier { unsigned* bar; unsigned x; volatile LAS unsigned* st; };
__device__ __forceinline__ XcdBarrier xcd_barrier_post(unsigned* bar, volatile LAS unsigned* st) {
  XcdBarrier b; b.bar = bar; b.x = xb_xcc_id(); b.st = st;
  if (__builtin_amdgcn_workitem_id_x() == 0) (void)xb_add(&bar[XB_XCNT(b.x)], 1u);
  return b;
}
__device__ __forceinline__ void xcd_barrier_complete(unsigned* bar, unsigned x, unsigned& nloc, unsigned& nx) {
  const unsigned G = gridDim.x * gridDim.y * gridDim.z;
  unsigned sum, cnt, mine, sp = 0u;
  for (;;) {
    sum = 0u; cnt = 0u; mine = 0u;
#pragma unroll
    for (unsigned j = 0; j < 16; ++j) { const unsigned c = xb_ld(&bar[XB_XCNT(j)]); sum += c; cnt += (c > 0u) ? 1u : 0u; mine = (j == x) ? c : mine; }
    if (sum == G) break;
    __builtin_amdgcn_s_sleep(1);
    if ((++sp & 255u) == 0u) { if (xb_ld(&bar[XB_TMO])) break; if (sp > XB_SPIN_CAP) { atomicAdd(&bar[XB_TMO], 1u); break; } }
  }
  nloc = mine > 0u ? mine : 1u; nx = cnt > 0u ? cnt : 1u;
}
__device__ __forceinline__ void xcd_barrier(const XcdBarrier& b) {
  asm volatile("s_waitcnt vmcnt(0)" ::: "memory");
  __syncthreads();
  if (__builtin_amdgcn_workitem_id_x() == 0) {
    unsigned* bar = b.bar;
    __builtin_amdgcn_s_waitcnt(0);
    unsigned nloc = b.st[0], nx = b.st[1];
    if (nloc == 0u) { xcd_barrier_complete(bar, b.x, nloc, nx); b.st[0] = nloc; b.st[1] = nx; }
    const unsigned old = xb_add(&bar[XB_XSUB(b.x)], 1u);
    const unsigned gen = old / nloc;
    if (old + 1u == (gen + 1u) * nloc) {
      __builtin_amdgcn_fence(__ATOMIC_RELEASE, "agent");
      asm volatile("s_waitcnt vmcnt(0)" ::: "memory");
      const unsigned og = xb_add(&bar[XB_TOP], 1u);
      const unsigned tg = og / nx;
      if (og + 1u == (tg + 1u) * nx) xb_add(&bar[XB_TOPGEN], 1u);
      else XB_SPIN(xb_ld(&bar[XB_TOPGEN]) == tg, bar);
      __builtin_amdgcn_fence(__ATOMIC_ACQUIRE, "agent");
      xb_add(&bar[XB_XGEN(b.x)], 1u);
      asm volatile("s_waitcnt vmcnt(0)" ::: "memory");
    } else {
      XB_SPIN(xb_ld(&bar[XB_XGEN(b.x)]) == gen, bar);
      __builtin_amdgcn_fence(__ATOMIC_ACQUIRE, "agent");
      asm volatile("s_waitcnt vmcnt(0)" ::: "memory");
    }
  }
  __syncthreads();
}

__global__ void __launch_bounds__(512, 2) k_mega(Params p_) {
  __shared__ __attribute__((aligned(16))) char smem_all[2 * SMEM_BYTES + 16];
  volatile LAS unsigned* st = (volatile LAS unsigned*)(smem_all + 2 * SMEM_BYTES);
  if (__builtin_amdgcn_workitem_id_x() == 0) { st[0] = 0u; st[1] = 0u; }
  __syncthreads();
  const XcdBarrier xb = xcd_barrier_post(p_.bar, st);
#pragma unroll 1
  for (int ph = 0; ph < 25; ++ph) {
    int l = (ph >= 14) ? 1 : 0;
    int q = (ph < 3) ? ph : 3 + (ph - 3) % 11;
    l = __builtin_amdgcn_readfirstlane(l);
    q = __builtin_amdgcn_readfirstlane(q);
#ifdef PROBE_MASK
    const unsigned long long pt0 = __builtin_amdgcn_s_memrealtime();
#endif
    PRef p = params_view();
    char* smem = smem_all + half_() * SMEM_BYTES;
    switch (q) {
      case 0: phase_setup(p, smem); phase_convert(p, 0, smem); break;
      case 1: phase_modreduce(p); break;
      case 2: phase_rowpass0(p); break;
      case 3: phase_inproj(p, l, smem_all); break;
      case 4: phase_gla1(p, l, smem); phase_na(p, l, smem); break;
      case 5: phase_gla2(p); phase_attnA(p, l, smem_all); break;
      case 6: phase_gla3(p, l, smem); break;
      case 7: phase_merge(p, l, smem_all); break;
      case 8: phase_outproj(p, l, smem_all); break;
      case 9: phase_rowpass1(p, l, smem); break;
      case 10: phase_moescan(p, l, smem); phase_convert(p, l | 16, smem); break;
      case 11: phase_moe1(p, l, smem_all); break;
      case 12: phase_moe2(p, l, smem_all); break;
      default: phase_rowpass2(p, l); if (l == 0) phase_convert(p, 1, smem); break;
    }
    if (ph != 24) xcd_barrier(xb);
#ifdef PROBE_MASK
    if ((PROBE_MASK >> q) & 1) {
      const unsigned long long pt1 = __builtin_amdgcn_s_memrealtime();
      while (__builtin_amdgcn_s_memrealtime() - pt1 < (pt1 - pt0)) __builtin_amdgcn_s_sleep(8);
    }
#endif
  }
}

#ifdef DIAG_STAGE
__device__ __forceinline__ unsigned dhash(unsigned s) { s ^= s >> 16; s *= 0x7feb352dU; s ^= s >> 15; s *= 0x846ca68bU; s ^= s >> 16; return s; }
__device__ __forceinline__ void diag_accum(double num, double den, double* accum, double* sred) {
  const int tid = threadIdx.x;
  __syncthreads();
  sred[tid] = num; sred[256 + tid] = den;
  __syncthreads();
  for (int o = 128; o > 0; o >>= 1) { if (tid < o) { sred[tid] += sred[tid + o]; sred[256 + tid] += sred[256 + tid + o]; } __syncthreads(); }
  if (tid == 0) { atomicAdd(&accum[0], sred[0]); atomicAdd(&accum[1], sred[256]); }
}
__device__ __forceinline__ int diag_tok(int s, int ns) {
  if (s < 8) return TLAT + (dhash(s + 77) % TCTX);
  if (s == 8) return 0; if (s == 9) return TLAT - 1; if (s == 10) return 4095; if (s == 11) return 4096;
  return dhash(s * 31 + 5) % TLAT;
}
__global__ void k_diag_zero(double* accum) { if (threadIdx.x < 32) accum[threadIdx.x] = 0.0; }
__global__ void k_diag_report(const double* accum, float* out, int n) {
  int i = blockIdx.x * 256 + threadIdx.x;
  for (; i < n; i += gridDim.x * 256) out[i] = 0.f;
  if (blockIdx.x == 0 && threadIdx.x == 0) {
    double E = 0.0;
    for (int k = 0; k < 16; ++k) {
      if (accum[2 * k + 1] > 0.0) { double e = accum[2 * k] / accum[2 * k + 1]; if (!(e == e)) e = 100.0; if (e > E) E = e; }
    }
    out[0] = (float)(4.096e7 * sqrt(E));
  }
}
__global__ void __launch_bounds__(256) k_chk_h(Params p, double* accum) {
  __shared__ double sred[512];
  __shared__ float sx[1024];
  const int tid = threadIdx.x;
  int tok = diag_tok(blockIdx.x, gridDim.x);
  const float* src = tok < TLAT ? p.x + (size_t)tok * D : p.ctx + (size_t)(tok - TLAT) * D;
  const float* cv = tok < TLAT ? p.c + (tok >> 12) * 1024 : p.c_ctx;
  double s = 0, q = 0;
  for (int i = 0; i < 1024; ++i) s += src[i];
  double mean = s / 1024;
  for (int i = 0; i < 1024; ++i) { double d = src[i] - mean; q += d * d; }
  double rstd = 1.0 / sqrt(q / 1024 + 1e-6);
  double num = 0, den = 0;
  for (int n = tid; n < 1024; n += 256) {
    double sh = p.b_mod[n], sc = p.b_mod[1024 + n];
    for (int k = 0; k < 1024; ++k) {
      double cc = cv[k]; double sl = cc / (1.0 + exp(-cc));
      sh += sl * p.w_mod[(size_t)k * NMOD + n];
      sc += sl * p.w_mod[(size_t)k * NMOD + 1024 + n];
    }
    double ref = (src[n] - mean) * rstd * (1.0 + sc) + sh;
    double got = bf2f(p.h[(size_t)tok * D + n]);
    num += (got - ref) * (got - ref); den += ref * ref;
  }
  diag_accum(num, den, accum, sred);
}
__global__ void __launch_bounds__(256) k_chk_inproj(Params p, int layer, double* accum) {
  __shared__ double sred[512];
  __shared__ float sz[3872];
  __shared__ float sh[1024];
  const int tid = threadIdx.x;
  int tok = diag_tok(blockIdx.x, gridDim.x);
  for (int i = tid; i < 1024; i += 256) sh[i] = bf2f(p.h[(size_t)tok * D + i]);
  __syncthreads();
  const float* W = p.w_in + (size_t)layer * 1024 * NIN_SRC;
  for (int j = tid; j < 3872; j += 256) {
    double a = p.b_in[layer * NIN_SRC + j];
    for (int k = 0; k < 1024; ++k) a += (double)sh[k] * W[(size_t)k * NIN_SRC + j];
    sz[j] = (float)a;
  }
  __syncthreads();
  const bool lat = tok < TLAT;
  int b, t, pall;
  if (lat) { b = tok >> 12; t = tok & 4095; pall = 256 + t; } else { int ci = tok - TLAT; b = ci >> 8; t = ci & 255; pall = t; }
  double num = 0, den = 0;
  for (int j = tid; j < 3872; j += 256) {
    double ref, got;
    if (j < 640) {
      int hb = (j >> 6) << 6, d = j & 63;
      double ss = 0;
      for (int e = 0; e < 64; ++e) ss += (double)sz[hb + e] * sz[hb + e];
      double rstd = 1.0 / sqrt(ss / 64 + 1e-6);
      const float* gn = (j < 512 ? p.q_norm : p.k_norm) + layer * 64;
      double xn = sz[j] * rstd * gn[d];
      if (lat) {
        int qd = d >> 4, f = d & 15;
        int dp = d ^ 16;
        double pn = sz[hb + dp] * rstd * gn[dp];
        double pos = (qd < 2) ? (double)(t >> 6) : (double)(t & 63);
        float inv = powf(10000.f, -(float)f / 16.f);
        float ang = (float)pos * inv;
        double cs = cos((double)ang), sn = sin((double)ang);
        double rot = (qd & 1) ? pn : -pn;
        xn = xn * cs + rot * sn;
      }
      if (j < 512) { ref = xn * QSCALE; got = bf2f(p.qA[(size_t)tok * 512 + j]); }
      else { int kvh = (j - 512) >> 6; ref = xn; got = bf2f(p.kA[((size_t)(b * 2 + kvh) * PALL + pall) * 64 + d]); }
    } else if (j < 768) { int c = j - 640; ref = sz[j]; got = bf2f(p.vAT[((size_t)(b * 2 + (c >> 6)) * 64 + (c & 63)) * PALL + pall]); }
    else if (j < 1024) { ref = sz[j] * 0.125; got = bf2f(p.qB[(size_t)tok * 256 + (j - 768)]); }
    else if (j < 1280) { ref = sz[j]; got = bf2f(p.kB[(size_t)tok * 256 + (j - 1024)]); }
    else if (j < 1792) { int c = j - 1280; ref = sz[j]; got = bf2f(p.vBT[((size_t)(b * 4 + (c >> 7)) * 128 + (c & 127)) * PALL + pall]); }
    else if (j < 2304) { ref = sz[j]; got = bf2f(p.rB[(size_t)tok * 512 + (j - 1792)]); }
    else if (j < 2336) { ref = sz[j]; got = p.aB[(size_t)tok * 32 + (j - 2304)]; }
    else if (j < 2848) { ref = sz[j] * QSCALE; got = bf2f(p.qC[(size_t)tok * 512 + (j - 2336)]); }
    else if (j < 3360) { ref = sz[j]; got = bf2f(p.kC[(size_t)tok * 512 + (j - 2848)]); }
    else { int c = j - 3360; ref = sz[j]; got = bf2f(p.vCT[((size_t)(b * 8 + (c >> 6)) * 64 + (c & 63)) * PALL + pall]); }
    num += (got - ref) * (got - ref); den += ref * ref;
  }
  diag_accum(num, den, accum, sred);
}
__global__ void __launch_bounds__(256) k_chk_attnA(Params p, int layer, double* accum) {
  __shared__ double sred[512];
  __shared__ float sp[4352];
  __shared__ float sq[64];
  __shared__ float so[64];
  const int tid = threadIdx.x;
  int tok = diag_tok(blockIdx.x >> 1, gridDim.x);
  if (layer == 1 && tok >= TLAT) tok = dhash(blockIdx.x) % TLAT;
  int head = dhash(blockIdx.x * 7 + 1) & 7, kvh = head >> 2;
  const bool lat = tok < TLAT;
  int b = lat ? tok >> 12 : (tok - TLAT) >> 8;
  int nk = lat ? PALL : 256;
  if (tid < 64) sq[tid] = bf2f(p.qA[(size_t)tok * 512 + head * 64 + tid]);
  __syncthreads();
  const bf16_t* kb = p.kA + (size_t)(b * 2 + kvh) * PALL * 64;
#pragma unroll 1
  for (int j = tid; j < nk; j += 256) {
    float s = 0.f;
#pragma unroll 1
    for (int d = 0; d < 64; ++d) s += sq[d] * bf2f(kb[(size_t)j * 64 + d]);
    sp[j] = s;
  }
  __syncthreads();
  float mx = -1e30f;
#pragma unroll 1
  for (int j = 0; j < nk; ++j) mx = fmaxf(mx, sp[j]);
  __syncthreads();
  for (int j = tid; j < nk; j += 256) sp[j] = exp2f(sp[j] - mx);
  __syncthreads();
  double num = 0, den = 0;
  if (tid < 64) {
    double l = 0, o = 0;
    const bf16_t* vb = p.vAT + ((size_t)(b * 2 + kvh) * 64 + tid) * PALL;
#pragma unroll 1
    for (int j = 0; j < nk; ++j) { l += sp[j]; o += (double)sp[j] * bf2f(vb[j]); }
    double ref = o / l, got = bf2f(p.oA[(size_t)tok * 512 + head * 64 + tid]);
    num = (got - ref) * (got - ref); den = ref * ref;
  }
  diag_accum(num, den, accum, sred);
}
__global__ void __launch_bounds__(256) k_chk_na(Params p, int layer, double* accum) {
  __shared__ double sred[512];
  __shared__ float sp[384];
  __shared__ int spos[384];
  __shared__ float sq[64];
  const int tid = threadIdx.x;
  int tok = diag_tok(blockIdx.x >> 1, gridDim.x);
  if (layer == 1 && tok >= TLAT) tok = dhash(blockIdx.x) % TLAT;
  int head = dhash(blockIdx.x * 13 + 3) & 7;
  const bool lat = tok < TLAT;
  int b = lat ? tok >> 12 : (tok - TLAT) >> 8;
  if (tid < 64) sq[tid] = bf2f(p.qC[(size_t)tok * 512 + head * 64 + tid]);
  __syncthreads();
  int nk = lat ? 384 : 256;
  for (int j = tid; j < nk; j += 256) {
    int ktok, kpall; float bias = 0.f;
    if (lat && j < 128) {
      int t = tok & 4095, r = t >> 6, w = t & 63;
      int rs = r - 4; rs = rs < 0 ? 0 : (rs > 56 ? 56 : rs);
      int cs = w - 8; cs = cs < 0 ? 0 : (cs > 48 ? 48 : cs);
      int i = j >> 4, jj = j & 15;
      int kr = rs + i, kc = cs + jj;
      ktok = b * 4096 + kr * 64 + kc; kpall = 256 + kr * 64 + kc;
      bias = p.rpb[(((size_t)layer * 8 + head) * 15 + (kr - r + 7)) * 31 + (kc - w + 15)] * LOG2E;
    } else {
      int c = lat ? j - 128 : j;
      ktok = TLAT + b * 256 + c; kpall = c;
    }
    float s = 0.f;
    for (int d = 0; d < 64; ++d) s += sq[d] * bf2f(p.kC[(size_t)ktok * 512 + head * 64 + d]);
    sp[j] = s + bias; spos[j] = kpall;
  }
  __syncthreads();
  float mx = -1e30f;
  for (int j = 0; j < nk; ++j) mx = fmaxf(mx, sp[j]);
  __syncthreads();
  for (int j = tid; j < nk; j += 256) sp[j] = exp2f(sp[j] - mx);
  __syncthreads();
  double num = 0, den = 0;
  if (tid < 64) {
    double l = 0, o = 0;
    const bf16_t* vb = p.vCT + ((size_t)(b * 8 + head) * 64 + tid) * PALL;
    for (int j = 0; j < nk; ++j) { l += sp[j]; o += (double)sp[j] * bf2f(vb[spos[j]]); }
    double ref = o / l, got = bf2f(p.oC[(size_t)tok * 512 + head * 64 + tid]);
    num = (got - ref) * (got - ref); den = ref * ref;
  }
  diag_accum(num, den, accum, sred);
}
__device__ constexpr int gla_sp(int i) { return i == 0 ? 0 : i == 1 ? 255 : i == 2 ? 256 : i == 3 ? 319 : i == 4 ? 320 : i == 5 ? 1257 : i == 6 ? 2756 : 4351; }
__global__ void __launch_bounds__(256) k_chk_gla(Params p, int layer, double* accum) {
  __shared__ double sred[512];
  __shared__ float sal[64], sqv[64], skv[64];
  __shared__ float sred2[128];
  const int tid = threadIdx.x;
  const int b = blockIdx.x >> 2, hd = blockIdx.x & 3;
  constexpr int NSP = 8;
  float osum[NSP];
#pragma unroll
  for (int i = 0; i < NSP; ++i) osum[i] = 0.f;
  for (int dir = 0; dir < 2; ++dir) {
    float S[64];
#pragma unroll
    for (int d = 0; d < 64; ++d) S[d] = 0.f;
#pragma unroll 1
    for (int step = 0; step < PALL; ++step) {
      int pall;
      if (step < 256) pall = dir ? 255 - step : step; else { int j = step - 256; pall = 256 + (dir ? 4095 - j : j); }
      int tok = pall < 256 ? TLAT + b * 256 + pall : b * 4096 + (pall - 256);
      __syncthreads();
      if (tid < 64) {
        float xv = p.gla_bg[((size_t)layer * 2 + dir) * 256 + hd * 64 + tid];
        for (int r = 0; r < 16; ++r) xv += p.aB[(size_t)tok * 32 + dir * 16 + r] * p.gla_wg[(((size_t)layer * 2 + dir) * 16 + r) * 256 + hd * 64 + tid];
        float ls = fminf(xv, 0.f) - log1pf(expf(-fabsf(xv)));
        sal[tid] = expf(ls / 16.f);
        sqv[tid] = bf2f(p.qB[(size_t)tok * 256 + hd * 64 + tid]);
        skv[tid] = bf2f(p.kB[(size_t)tok * 256 + hd * 64 + tid]);
      }
      __syncthreads();
      if (tid < 128) {
        float v = bf2f(p.vBT[((size_t)(b * 4 + hd) * 128 + tid) * PALL + pall]);
        float o = 0.f;
#pragma unroll
        for (int d = 0; d < 64; ++d) { S[d] = sal[d] * S[d] + skv[d] * v; o += sqv[d] * S[d]; }
#pragma unroll
        for (int i = 0; i < NSP; ++i) if (gla_sp(i) == pall) osum[i] += o;
      }
    }
  }
  double num = 0, den = 0;
#pragma unroll
  for (int i = 0; i < NSP; ++i) {
    if (layer == 1 && gla_sp(i) < 256) continue;
    __syncthreads();
    if (tid < 128) sred2[tid] = osum[i] * osum[i];
    __syncthreads();
    float tot = 0.f;
    for (int j = 0; j < 128; ++j) tot += sred2[j];
    if (tid < 128) {
      int pall = gla_sp(i);
      int tok = pall < 256 ? TLAT + b * 256 + pall : b * 4096 + (pall - 256);
      float rstd = 1.f / sqrtf(tot / 128.f + 1e-6f);
      float rg = bf2f(p.rB[(size_t)tok * 512 + hd * 128 + tid]);
      double ref = osum[i] * rstd * p.gla_norm[layer * 128 + tid] * (rg / (1.f + expf(-rg)));
      double got = bf2f(p.oB[(size_t)tok * 512 + hd * 128 + tid]);
      num += (got - ref) * (got - ref); den += ref * ref;
    }
  }
  diag_accum(num, den, accum, sred);
}
__global__ void __launch_bounds__(256) k_chk_merge(Params p, int layer, double* accum) {
  __shared__ double sred[512];
  const int tid = threadIdx.x;
  int tok = diag_tok(blockIdx.x, gridDim.x);
  if (layer == 1 && tok >= TLAT) tok = dhash(blockIdx.x) % TLAT;
  const float* W = p.w_in + (size_t)layer * 1024 * NIN_SRC;
  double num = 0, den = 0;
  for (int n = tid; n < 1024; n += 256) {
    double tot = 0;
    for (int br = 0; br < 3; ++br) {
      double g = p.b_in[layer * NIN_SRC + 3872 + br * 1024 + n];
      for (int k = 0; k < 1024; ++k) g += (double)bf2f(p.h[(size_t)tok * D + k]) * W[(size_t)k * NIN_SRC + 3872 + br * 1024 + n];
      g = 1.0 / (1.0 + exp(-g));
      const bf16_t* ob = br == 0 ? p.oA : (br == 1 ? p.oB : p.oC);
      const float* wb = (br == 0 ? p.w_br_attn : (br == 1 ? p.w_br_gla : p.w_br_na)) + (size_t)layer * 512 * 1024;
      double a = 0;
      for (int j = 0; j < 512; ++j) a += (double)bf2f(ob[(size_t)tok * 512 + j]) * wb[(size_t)j * 1024 + n];
      tot += g * a;
    }
    double got = bf2f(p.m[(size_t)tok * D + n]);
    num += (got - tot) * (got - tot); den += tot * tot;
  }
  diag_accum(num, den, accum, sred);
}
__global__ void __launch_bounds__(256) k_chk_x1(Params p, double* accum) {
  __shared__ double sred[512];
  __shared__ double sv[1024];
  __shared__ double sx1[1024];
  __shared__ double sst[4];
  const int tid = threadIdx.x;
  int tok = diag_tok(blockIdx.x, gridDim.x);
  const float* cv = tok < TLAT ? p.c + (tok >> 12) * 1024 : p.c_ctx;
  const float* xin = tok < TLAT ? p.x + (size_t)tok * D : p.ctx + (size_t)(tok - TLAT) * D;
  for (int n = tid; n < 1024; n += 256) {
    double y = 0, g1 = p.b_mod[2048 + n];
    for (int k = 0; k < 1024; ++k) {
      y += (double)bf2f(p.m[(size_t)tok * D + k]) * p.w_out[(size_t)k * 1024 + n];
      double cc = cv[k]; g1 += cc / (1.0 + exp(-cc)) * p.w_mod[(size_t)k * NMOD + 2048 + n];
    }
    sv[n] = 1.4142135623730951 * xin[n] + g1 * y;
  }
  __syncthreads();
  if (tid == 0) { double s = 0, q = 0; for (int i = 0; i < 1024; ++i) s += sv[i]; s /= 1024; for (int i = 0; i < 1024; ++i) q += (sv[i] - s) * (sv[i] - s); sst[0] = s; sst[1] = 1.0 / sqrt(q / 1024 + 1e-6); }
  __syncthreads();
  double num = 0, den = 0;
  for (int n = tid; n < 1024; n += 256) {
    double x1 = (sv[n] - sst[0]) * sst[1] * p.ln1_g[n] + p.ln1_b[n];
    sx1[n] = x1;
    double got = p.xres[(size_t)tok * D + n];
    num += (got - x1) * (got - x1); den += x1 * x1;
  }
  __syncthreads();
  if (tid == 0) { double s = 0, q = 0; for (int i = 0; i < 1024; ++i) s += sx1[i]; s /= 1024; for (int i = 0; i < 1024; ++i) q += (sx1[i] - s) * (sx1[i] - s); sst[2] = s; sst[3] = 1.0 / sqrt(q / 1024 + 1e-6); }
  __syncthreads();
  for (int n = tid; n < 1024; n += 256) {
    double sh = p.b_mod[3072 + n], sc = p.b_mod[4096 + n];
    for (int k = 0; k < 1024; ++k) { double cc = cv[k]; double sl = cc / (1.0 + exp(-cc)); sh += sl * p.w_mod[(size_t)k * NMOD + 3072 + n]; sc += sl * p.w_mod[(size_t)k * NMOD + 4096 + n]; }
    double h2 = (sx1[n] - sst[2]) * sst[3] * (1.0 + sc) + sh;
    double got = bf2f(p.h2[(size_t)tok * D + n]);
    num += (got - h2) * (got - h2); den += h2 * h2;
  }
  diag_accum(num, den, accum, sred);
}
__global__ void __launch_bounds__(256) k_chk_moe(Params p, int layer, int mode, double* accum) {
  __shared__ double sred[512];
  __shared__ float sh[1024];
  __shared__ float slog[36];
  __shared__ float shid[1024];
  __shared__ int se[2];
  __shared__ float sw[2];
  const int tid = threadIdx.x;
  int tok = diag_tok(blockIdx.x, gridDim.x);
  if (layer == 1 && tok >= TLAT) tok = dhash(blockIdx.x) % TLAT;
  for (int i = tid; i < 1024; i += 256) sh[i] = bf2f(p.h2[(size_t)tok * D + i]);
  __syncthreads();
  if (tid < 36) {
    double a;
    if (tid < 32) { a = p.b_re[layer * 32 + tid]; for (int k = 0; k < 1024; ++k) a += (double)sh[k] * p.w_re[((size_t)layer * 1024 + k) * 32 + tid]; }
    else { a = p.b_rg[layer * 4 + tid - 32]; for (int k = 0; k < 1024; ++k) a += (double)sh[k] * p.w_rg[((size_t)layer * 1024 + k) * 4 + tid - 32]; }
    slog[tid] = (float)a;
  }
  __syncthreads();
  if (tid == 0) {
    int grp = 0; for (int i = 1; i < 4; ++i) if (slog[32 + i] > slog[32 + grp]) grp = i;
    double gs = 0; for (int i = 0; i < 4; ++i) gs += exp((double)slog[32 + i] - slog[32 + grp]);
    double pg = 1.0 / gs;
    int i0 = 0; for (int i = 1; i < 8; ++i) if (slog[grp * 8 + i] > slog[grp * 8 + i0]) i0 = i;
    int i1 = -1; for (int i = 0; i < 8; ++i) if (i != i0 && (i1 < 0 || slog[grp * 8 + i] > slog[grp * 8 + i1])) i1 = i;
    double e1 = exp((double)slog[grp * 8 + i1] - slog[grp * 8 + i0]);
    se[0] = grp * 8 + i0; se[1] = grp * 8 + i1; sw[0] = (float)(pg / (1 + e1)); sw[1] = (float)(pg * e1 / (1 + e1));
  }
  __syncthreads();
  if (mode == 1) {
    double num = 0, den = 0;
    if (tid == 0) { den = 1.0; bool same = (p.tok_e[tok * 2] == se[0] && p.tok_e[tok * 2 + 1] == se[1]); num = same ? 0.0 : 1.0; }
    diag_accum(num, den, accum, sred);
    return;
  }
  int e0 = p.tok_e[tok * 2], e1 = p.tok_e[tok * 2 + 1];
  float w0 = p.tok_gate[tok * 2], w1 = p.tok_gate[tok * 2 + 1];
  double num = 0, den = 0;
  if (tid == 0 && e0 == se[0] && e1 == se[1]) { num += (w0 - sw[0]) * (w0 - sw[0]) + (w1 - sw[1]) * (w1 - sw[1]); }
  for (int i = tid; i < 1024; i += 256) {
    int k = i >> 9, j = i & 511, e = k ? e1 : e0;
    const float* w1p = p.w1 + ((size_t)layer * 32 + e) * 1024 * 512;
    const float* w3p = p.w3 + ((size_t)layer * 32 + e) * 1024 * 512;
    double a = 0, c = 0;
    for (int kk = 0; kk < 1024; ++kk) { a += (double)sh[kk] * w1p[(size_t)kk * 512 + j]; c += (double)sh[kk] * w3p[(size_t)kk * 512 + j]; }
    shid[i] = (float)(a / (1.0 + exp(-a)) * c);
  }
  __syncthreads();
  int s0 = p.estart[e0] * MOE_BLK + p.tok_pos[tok * 2], s1 = p.estart[e1] * MOE_BLK + p.tok_pos[tok * 2 + 1];
  for (int n = tid; n < 1024; n += 256) {
    double y = 0;
    const float* w2a = p.w2 + ((size_t)layer * 32 + e0) * 512 * 1024;
    const float* w2b = p.w2 + ((size_t)layer * 32 + e1) * 512 * 1024;
    double ya = 0, yb = 0;
    for (int j = 0; j < 512; ++j) { ya += (double)shid[j] * w2a[(size_t)j * 1024 + n]; yb += (double)shid[512 + j] * w2b[(size_t)j * 1024 + n]; }
    y = w0 * ya + w1 * yb;
    double got = w0 * bf2f(p.ysl[(size_t)s0 * D + n]) + w1 * bf2f(p.ysl[(size_t)s1 * D + n]);
    num += (got - y) * (got - y); den += y * y;
  }
  diag_accum(num, den, accum, sred);
}
__global__ void k_saverows(Params p, float* xsave, int layer) {
  int tok = diag_tok(blockIdx.x, gridDim.x);
  if (layer == 1 && tok >= TLAT) tok = dhash(blockIdx.x) % TLAT;
  for (int i = threadIdx.x; i < 1024; i += 256) xsave[(size_t)blockIdx.x * 1024 + i] = p.xres[(size_t)tok * D + i];
}
__global__ void __launch_bounds__(256) k_chk_final(Params p, int layer, const float* xsave, double* accum) {
  __shared__ double sred[512];
  __shared__ double sv[1024];
  __shared__ double sst[4];
  const int tid = threadIdx.x;
  int tok = diag_tok(blockIdx.x, gridDim.x);
  if (layer == 1 && tok >= TLAT) tok = dhash(blockIdx.x) % TLAT;
  const float* cv = tok < TLAT ? p.c + (tok >> 12) * 1024 : p.c_ctx;
  int e0 = p.tok_e[tok * 2], e1 = p.tok_e[tok * 2 + 1];
  float w0 = p.tok_gate[tok * 2], w1 = p.tok_gate[tok * 2 + 1];
  int s0 = p.estart[e0] * MOE_BLK + p.tok_pos[tok * 2], s1 = p.estart[e1] * MOE_BLK + p.tok_pos[tok * 2 + 1];
  for (int n = tid; n < 1024; n += 256) {
    double g2 = p.b_mod[layer * NMOD + 5120 + n];
    for (int k = 0; k < 1024; ++k) { double cc = cv[k]; g2 += cc / (1.0 + exp(-cc)) * p.w_mod[((size_t)layer * 1024 + k) * NMOD + 5120 + n]; }
    double y = w0 * bf2f(p.ysl[(size_t)s0 * D + n]) + w1 * bf2f(p.ysl[(size_t)s1 * D + n]);
    sv[n] = 1.4142135623730951 * xsave[(size_t)blockIdx.x * 1024 + n] + g2 * y;
  }
  __syncthreads();
  if (tid == 0) { double s = 0, q = 0; for (int i = 0; i < 1024; ++i) s += sv[i]; s /= 1024; for (int i = 0; i < 1024; ++i) q += (sv[i] - s) * (sv[i] - s); sst[0] = s; sst[1] = 1.0 / sqrt(q / 1024 + 1e-6); }
  __syncthreads();
  double num = 0, den = 0;
  for (int n = tid; n < 1024; n += 256) {
    double x2 = (sv[n] - sst[0]) * sst[1] * p.ln2_g[layer * D + n] + p.ln2_b[layer * D + n];
    sv[n] = x2;
    double got = layer == 1 ? p.out[(size_t)tok * D + n] : p.xres[(size_t)tok * D + n];
    num += (got - x2) * (got - x2); den += x2 * x2;
  }
  __syncthreads();
  if (layer == 0) {
    if (tid == 0) { double s = 0, q = 0; for (int i = 0; i < 1024; ++i) s += sv[i]; s /= 1024; for (int i = 0; i < 1024; ++i) q += (sv[i] - s) * (sv[i] - s); sst[2] = s; sst[3] = 1.0 / sqrt(q / 1024 + 1e-6); }
    __syncthreads();
    for (int n = tid; n < 1024; n += 256) {
      double sh = p.b_mod[NMOD + n], sc = p.b_mod[NMOD + 1024 + n];
      for (int k = 0; k < 1024; ++k) { double cc = cv[k]; double sl = cc / (1.0 + exp(-cc)); sh += sl * p.w_mod[((size_t)1024 + k) * NMOD + n]; sc += sl * p.w_mod[((size_t)1024 + k) * NMOD + 1024 + n]; }
      double h = (sv[n] - sst[2]) * sst[3] * (1.0 + sc) + sh;
      double got = bf2f(p.h[(size_t)tok * D + n]);
      num += (got - h) * (got - h); den += h * h;
    }
  }
  diag_accum(num, den, accum, sred);
}
#endif

static inline size_t align_up(size_t v, size_t a) { return (v + a - 1) / a * a; }

extern "C" void kernel_launch(void* const* d_in, const int* in_sizes, int n_in, void* d_out, int out_size, void* d_ws, size_t ws_size,
                              hipStream_t stream) {
  Params p{};
  const float* const* in = (const float* const*)d_in;
  p.x = in[0]; p.c = in[1]; p.ctx = in[2]; p.c_ctx = in[3]; p.w_mod = in[4]; p.b_mod = in[5]; p.w_in = in[6]; p.b_in = in[7];
  p.q_norm = in[8]; p.k_norm = in[9]; p.gla_wg = in[10]; p.gla_bg = in[11]; p.gla_norm = in[12]; p.rpb = in[13];
  p.w_br_attn = in[14]; p.w_br_gla = in[15]; p.w_br_na = in[16]; p.w_out = in[17]; p.ln1_g = in[18]; p.ln1_b = in[19];
  p.w_rg = in[20]; p.b_rg = in[21]; p.w_re = in[22]; p.b_re = in[23]; p.w1 = in[24]; p.w3 = in[25]; p.w2 = in[26];
  p.ln2_g = in[27]; p.ln2_b = in[28];
  p.out = (float*)d_out;

  char* base = (char*)d_ws;
  size_t off = 0;
  auto take = [&](size_t bytes) { char* q = base + off; off = align_up(off + bytes, 256); return q; };
  p.mod_part = (float*)take((size_t)16 * 2 * 5 * NMOD * 4);
  p.mod = (float*)take((size_t)2 * 5 * NMOD * 4);
  p.rope = (float*)take(2048 * 4);
  p.wrp = (float*)take((size_t)2 * 49152 * 4);
  p.bar = (unsigned*)take(XCD_BAR_WORDS * 4);
  p.cnt = (int*)take(32 * 4);
  p.estart = (int*)take(32 * 4);
  p.cntg = (int*)take((size_t)1088 * 32 * 4);
  p.list = (int*)take((size_t)32 * MOE_CAP * 4);
  p.tok_e = (int*)take((size_t)TALL * 2 * 4);
  p.tok_pos = (int*)take((size_t)TALL * 2 * 4);
  p.tok_gate = (float*)take((size_t)TALL * 2 * 4);
  p.wt_in = (bf16_t*)take((size_t)3968 * 1024 * 2);
  p.wt_gate = (bf16_t*)take((size_t)3072 * 1024 * 2);
  p.wt_br = (bf16_t*)take((size_t)3 * 1024 * 512 * 2);
  p.wt_out = (bf16_t*)take((size_t)1024 * 1024 * 2);
  p.wt_13 = (bf16_t*)take((size_t)32 * 1024 * 1024 * 2);
  p.wt_2 = (bf16_t*)take((size_t)32 * 1024 * 512 * 2);
  p.G = p.wt_13;
  p.xres = (float*)take((size_t)TALL * D * 4);
  p.h = (bf16_t*)take((size_t)TALL * D * 2);
  size_t r1 = off;
  p.qA = (bf16_t*)take((size_t)TALL * 512 * 2);
  p.kA = (bf16_t*)take((size_t)4 * 2 * PALL * 64 * 2);
  p.vAT = (bf16_t*)take((size_t)4 * 2 * 64 * PALL * 2);
  p.qB = (bf16_t*)take((size_t)TALL * 256 * 2);
  p.kB = (bf16_t*)take((size_t)TALL * 256 * 2);
  p.vBT = (bf16_t*)take((size_t)4 * 4 * 128 * PALL * 2);
  p.rB = (bf16_t*)take((size_t)TALL * 512 * 2);
  p.aB = (float*)take((size_t)TALL * 32 * 4);
  p.qC = (bf16_t*)take((size_t)TALL * 512 * 2);
  p.kC = (bf16_t*)take((size_t)TALL * 512 * 2);
  p.vCT = (bf16_t*)take((size_t)4 * 8 * 64 * PALL * 2);
  p.oA = (bf16_t*)take((size_t)TALL * 512 * 2);
  p.oB = (bf16_t*)take((size_t)TALL * 512 * 2);
  p.oC = (bf16_t*)take((size_t)TALL * 512 * 2);
  size_t r1_end = off;
  {
    size_t o2 = r1;
    p.act = (bf16_t*)(base + o2); o2 = align_up(o2 + (size_t)MAX_MBLK * MOE_BLK * 512 * 2, 256);
    p.ysl = (bf16_t*)(base + o2); o2 = align_up(o2 + (size_t)MAX_MBLK * MOE_BLK * 1024 * 2, 256);
    if (o2 > r1_end) off = o2;
  }
  p.KVt = (float*)take((size_t)32 * NCHUNK * 8192 * 4);
  p.SP = (bf16_t*)take((size_t)32 * NCHUNK * 8192 * 2);
  p.decay = (float*)take((size_t)32 * NCHUNK * 64 * 4);
  p.bcum = (float*)take((size_t)32 * NCHUNK * 4096 * 4);
  p.m = (bf16_t*)p.KVt;
  p.h2 = p.SP;
  if (off > ws_size) {
    fprintf(stderr, "workspace too small: need %zu have %zu\n", off, ws_size);
    return;
  }
  const dim3 blk(256);
#ifdef DIAG_STAGE
  {
    double* accum = (double*)take(64);
    float* xsave = (float*)take((size_t)64 * 1024 * 4);
    if (off > ws_size) return;
    const int G = 1024;
    const int DL = DIAG_LAYER, DS = DIAG_STAGE;
    k_diag_zero<<<1, 64, 0, stream>>>(accum);
    k_setup<<<((769 + 96) + 1) / 2, dim3(512), 0, stream>>>(p, 0);
    k_convert<<<((2048) + 1) / 2, dim3(512), 0, stream>>>(p, 0);
    k_modreduce<<<((240) + 1) / 2, dim3(512), 0, stream>>>(p, 0);
    k_rowpass0<<<((G) + 1) / 2, dim3(512), 0, stream>>>(p, 0);
    if (DS == 1 || DS == 0) k_chk_h<<<32, blk, 0, stream>>>(p, accum + 2);
    for (int l = 0; l <= DL; ++l) {
      const bool chk = (l == DL);
      k_inproj<<<((G) + 1) / 2, dim3(512), 0, stream>>>(p, l);
      if (chk && (DS == 2 || DS == 0)) k_chk_inproj<<<64, blk, 0, stream>>>(p, l, accum + 4);
      k_gla1<<<((G) + 1) / 2, dim3(512), 0, stream>>>(p, l);
      k_na<<<((1088) + 1) / 2, dim3(512), 0, stream>>>(p, l);
      if (chk && (DS == 4 || DS == 0)) k_chk_na<<<128, blk, 0, stream>>>(p, l, accum + 8);
      k_gla2<<<((G) + 1) / 2, dim3(512), 0, stream>>>(p, l);
      k_attnA<<<((1088) + 1) / 2, dim3(512), 0, stream>>>(p, l);
      if (chk && (DS == 3 || DS == 0)) k_chk_attnA<<<128, blk, 0, stream>>>(p, l, accum + 6);
      k_gla3<<<((1088) + 1) / 2, dim3(512), 0, stream>>>(p, l);
      if (chk && (DS == 5 || DS == 0)) k_chk_gla<<<16, blk, 0, stream>>>(p, l, accum + 10);
      k_merge<<<((G) + 1) / 2, dim3(512), 0, stream>>>(p, l);
      if (chk && (DS == 6 || DS == 0)) k_chk_merge<<<32, blk, 0, stream>>>(p, l, accum + 12);
      k_outproj<<<((G) + 1) / 2, dim3(512), 0, stream>>>(p, l);
      k_rowpass1<<<((G) + 1) / 2, dim3(512), 0, stream>>>(p, l);
      if (chk && l == 0 && (DS == 7 || DS == 0)) k_chk_x1<<<32, blk, 0, stream>>>(p, accum + 14);
      k_moescan<<<((32) + 1) / 2, dim3(512), 0, stream>>>(p, l);
      k_convert<<<((2048) + 1) / 2, dim3(512), 0, stream>>>(p, l | 16);
    k_moe1<<<((G) + 1) / 2, dim3(512), 0, stream>>>(p, l);
      k_moe2<<<((G) + 1) / 2, dim3(512), 0, stream>>>(p, l);
      if (chk && (DS == 8 || DS == 0)) k_chk_moe<<<32, blk, 0, stream>>>(p, l, 0, accum + 16);
      if (chk && DS == 9) k_chk_moe<<<512, blk, 0, stream>>>(p, l, 1, accum + 18);
      if (chk && (DS == 10 || DS == 0)) k_saverows<<<32, blk, 0, stream>>>(p, xsave, l);
      k_rowpass2<<<((G) + 1) / 2, dim3(512), 0, stream>>>(p, l);
      if (chk && (DS == 10 || DS == 0)) k_chk_final<<<32, blk, 0, stream>>>(p, l, xsave, accum + 20);
      if (l == 0) k_convert<<<((2048) + 1) / 2, dim3(512), 0, stream>>>(p, 1);
    }
    k_diag_report<<<1024, blk, 0, stream>>>(accum, p.out, TLAT * D);
    return;
  }
#endif
#ifdef MK_MULTI
  const int G = 1024;
  k_setup<<<((769 + 96) + 1) / 2, dim3(512), 0, stream>>>(p, 0);
  k_convert<<<((2048) + 1) / 2, dim3(512), 0, stream>>>(p, 0);
  k_modreduce<<<((240) + 1) / 2, dim3(512), 0, stream>>>(p, 0);
  k_rowpass0<<<((G) + 1) / 2, dim3(512), 0, stream>>>(p, 0);
  for (int l = 0; l < 2; ++l) {
    k_inproj<<<((G) + 1) / 2, dim3(512), 0, stream>>>(p, l);
    k_gla1<<<((G) + 1) / 2, dim3(512), 0, stream>>>(p, l);
    k_na<<<((1088) + 1) / 2, dim3(512), 0, stream>>>(p, l);
    k_gla2<<<((G) + 1) / 2, dim3(512), 0, stream>>>(p, l);
    k_attnA<<<((1088) + 1) / 2, dim3(512), 0, stream>>>(p, l);
    k_gla3<<<((1088) + 1) / 2, dim3(512), 0, stream>>>(p, l);
    k_merge<<<((G) + 1) / 2, dim3(512), 0, stream>>>(p, l);
    k_outproj<<<((G) + 1) / 2, dim3(512), 0, stream>>>(p, l);
    k_rowpass1<<<((G) + 1) / 2, dim3(512), 0, stream>>>(p, l);
    k_moescan<<<((32) + 1) / 2, dim3(512), 0, stream>>>(p, l);
    k_convert<<<((2048) + 1) / 2, dim3(512), 0, stream>>>(p, l | 16);
    k_moe1<<<((G) + 1) / 2, dim3(512), 0, stream>>>(p, l);
    k_moe2<<<((G) + 1) / 2, dim3(512), 0, stream>>>(p, l);
    k_rowpass2<<<((G) + 1) / 2, dim3(512), 0, stream>>>(p, l);
    if (l == 0) k_convert<<<((2048) + 1) / 2, dim3(512), 0, stream>>>(p, 1);
  }
#else
  static int grid_blocks = 0;
  if (!grid_blocks) {
    int dev = 0, cus = 0, per_cu = 0;
    hipGetDevice(&dev);
    hipDeviceGetAttribute(&cus, hipDeviceAttributeMultiprocessorCount, dev);
    hipOccupancyMaxActiveBlocksPerMultiprocessor(&per_cu, k_mega, 512, 0);
    per_cu = 1;
    grid_blocks = cus * per_cu;
  }
  hipMemsetAsync(p.bar, 0, XCD_BAR_WORDS * 4, stream);
  k_mega<<<dim3(grid_blocks), dim3(512), 0, stream>>>(p);
#endif
}
```

```cpp
#include <hip/hip_runtime.h>
#include <hip/hip_cooperative_groups.h>
#include <stdint.h>
#include <stdio.h>
namespace cg = cooperative_groups;

typedef unsigned short bf16_t;
typedef __attribute__((ext_vector_type(8))) short bf16x8;
typedef __attribute__((ext_vector_type(4))) short bf16x4;
typedef __attribute__((ext_vector_type(16))) float f32x16;
typedef __attribute__((ext_vector_type(4))) unsigned u32x4;
typedef __attribute__((ext_vector_type(4))) float f32x4v;

#ifndef XCD_MAP_ENABLE
#define XCD_MAP_ENABLE 0
#endif
constexpr int D = 1024;
constexpr int TLAT = 16384, TCTX = 1024, TALL = 17408, PALL = 4352;
constexpr int NIN_SRC = 6944, NMOD = 6144;
constexpr int NT_IN = 31;
constexpr int SMEM_BYTES = 69632;
constexpr int LDC = 132;
constexpr float LOG2E = 1.4426950408889634f;
constexpr float QSCALE = 0.125f * LOG2E;
constexpr float ALPHA = 1.4142135623730951f;
constexpr int NCHUNK = 68;
constexpr int MOE_CAP = TALL;
constexpr int MOE_BLK = 256;
constexpr int MAX_MBLK = 168;

struct Params {
  const float *x, *c, *ctx, *c_ctx, *w_mod, *b_mod, *w_in, *b_in, *q_norm, *k_norm, *gla_wg, *gla_bg, *gla_norm, *rpb,
      *w_br_attn, *w_br_gla, *w_br_na, *w_out, *ln1_g, *ln1_b, *w_rg, *b_rg, *w_re, *b_re, *w1, *w3, *w2, *ln2_g, *ln2_b;
  float* out;
  float *mod_part, *mod, *rope, *wrp;
  bf16_t *wt_in, *wt_gate, *wt_br, *wt_out, *wt_13, *wt_2, *G;
  float* xres;
  bf16_t *h, *h2;
  bf16_t *qA, *kA, *vAT, *qB, *kB, *vBT, *rB;
  float* aB;
  bf16_t *qC, *kC, *vCT;
  bf16_t *oA, *oB, *oC;
  float* KVt;
  float* bcum;
  bf16_t* SP;
  float* decay;
  bf16_t* m;
  bf16_t *act, *ysl;
  int *cnt, *cntg, *list, *tok_e, *tok_pos, *estart;
  float* tok_gate;
  unsigned* bar;
};

typedef const __attribute__((address_space(4))) Params& PRef;
__device__ __forceinline__ PRef params_view() {
  const __attribute__((address_space(4))) Params* pp = (const __attribute__((address_space(4))) Params*)__builtin_amdgcn_kernarg_segment_ptr();
  asm volatile("" : "+s"(pp));
  return *pp;
}

__device__ __forceinline__ int tid_() { int t = __builtin_amdgcn_workitem_id_x() & 255; asm volatile("" : "+v"(t)); return t; }
__device__ __forceinline__ int half_() { int h = __builtin_amdgcn_readfirstlane(__builtin_amdgcn_workitem_id_x() >> 8); asm volatile("" : "+s"(h)); return h; }
__device__ __forceinline__ int bid_() { int t = 2 * __builtin_amdgcn_workgroup_id_x() + half_(); asm volatile("" : "+s"(t)); return t; }
__device__ __forceinline__ int vgrid_() { return 2 * (int)gridDim.x; }
typedef __attribute__((ext_vector_type(2))) __bf16 bf16x2n;
typedef __attribute__((ext_vector_type(2))) float f32x2n;
__device__ __forceinline__ bf16_t f2bf(float f) { return __builtin_bit_cast(bf16_t, (__bf16)f); }
__device__ __forceinline__ float bf2f(bf16_t b) { return __uint_as_float(((unsigned)b) << 16); }
__device__ __forceinline__ unsigned pack2(float a, float b) {
  f32x2n v = {a, b};
  return __builtin_bit_cast(unsigned, __builtin_convertvector(v, bf16x2n));
}
__device__ __forceinline__ float wave_sum(float v) {
  int x;
  x = __builtin_amdgcn_update_dpp(0, __float_as_int(v), 0xB1, 0xf, 0xf, true);  v += __int_as_float(x);
  x = __builtin_amdgcn_update_dpp(0, __float_as_int(v), 0x4E, 0xf, 0xf, true);  v += __int_as_float(x);
  x = __builtin_amdgcn_update_dpp(0, __float_as_int(v), 0x141, 0xf, 0xf, true); v += __int_as_float(x);
  x = __builtin_amdgcn_update_dpp(0, __float_as_int(v), 0x140, 0xf, 0xf, true); v += __int_as_float(x);
  x = __builtin_amdgcn_update_dpp(0, __float_as_int(v), 0x142, 0xa, 0xf, false); v += __int_as_float(x);
  x = __builtin_amdgcn_update_dpp(0, __float_as_int(v), 0x143, 0xc, 0xf, false); v += __int_as_float(x);
  return __int_as_float(__builtin_amdgcn_readlane(__float_as_int(v), 63));
}
__device__ __forceinline__ float siluf(float x) { return x * __builtin_amdgcn_rcpf(1.f + __expf(-x)); }
__device__ __forceinline__ float sigmoidf_(float x) { return __builtin_amdgcn_rcpf(1.f + __expf(-x)); }
__device__ __forceinline__ f32x16 zero16() {
  f32x16 z;
#pragma unroll
  for (int i = 0; i < 16; ++i) z[i] = 0.f;
  return z;
}
__device__ __forceinline__ f32x16 mfma32(bf16x8 a, bf16x8 b, f32x16 c) {
  return __builtin_amdgcn_mfma_f32_32x32x16_bf16(a, b, c, 0, 0, 0);
}
__device__ __forceinline__ int tok_modrow(int tok) { return tok < TLAT ? (tok >> 12) : 4; }

__device__ __forceinline__ void phase_setup(PRef p, char* smem) {
  float* sS = (float*)smem;
  const int tid = tid_();
  for (int item = bid_(); item < 769 + 96; item += vgrid_()) {
    if (item >= 769) {
      int it = item - 769;
      int l = it / 48, chunk = it % 48;
      for (int i = tid; i < 1024; i += 256) {
        int idx = chunk * 1024 + i;
        int e = idx & 3, ln = (idx >> 2) & 63, t = (idx >> 8) & 63, nt = idx >> 14;
        int k = 16 * t + 4 * (ln >> 4) + e, n = 16 * nt + (ln & 15);
        float v = 0.f;
        if (n < 32) v = p.w_re[((size_t)l * 1024 + k) * 32 + n];
        else if (n < 36) v = p.w_rg[((size_t)l * 1024 + k) * 4 + (n - 32)];
        p.wrp[(size_t)l * 49152 + idx] = v;
      }
      continue;
    }
    if (item == 768) {
      for (int i = tid; i < 1024; i += 256) {
        int pos = i >> 4, f = i & 15;
        float inv = powf(10000.f, -(float)f / 16.f);
        float ang = (float)pos * inv;
        p.rope[i] = cosf(ang);
        p.rope[1024 + i] = sinf(ang);
      }
      continue;
    }
    int nb = item % 24, ks = (item / 24) % 16, l = item / 384;
    __syncthreads();
    for (int i = tid; i < 320; i += 256) {
      int r = i >> 6, k = ks * 64 + (i & 63);
      float cv = (r < 4) ? p.c[r * 1024 + k] : p.c_ctx[k];
      sS[i] = siluf(cv);
    }
    __syncthreads();
    int n = nb * 256 + tid;
    const float* w = p.w_mod + ((size_t)l * 1024 + ks * 64) * NMOD + n;
    float acc[5] = {0.f, 0.f, 0.f, 0.f, 0.f};
#pragma unroll
    for (int k0 = 0; k0 < 64; k0 += 32) {
      float wv[32];
#pragma unroll
      for (int k = 0; k < 32; ++k) wv[k] = w[(size_t)(k0 + k) * NMOD];
#pragma unroll
      for (int k = 0; k < 32; ++k)
#pragma unroll
        for (int r = 0; r < 5; ++r) acc[r] += sS[r * 64 + k0 + k] * wv[k];
    }
#pragma unroll
    for (int r = 0; r < 5; ++r) p.mod_part[(((size_t)ks * 2 + l) * 5 + r) * NMOD + n] = acc[r];
  }
}
__device__ __forceinline__ void phase_modreduce(PRef p) {
  for (int i = bid_() * 256 + tid_(); i < 2 * 5 * NMOD; i += vgrid_() * 256) {
    int n = i % NMOD, l = i / (5 * NMOD);
    float s = p.b_mod[l * NMOD + n];
#pragma unroll
    for (int ks = 0; ks < 16; ++ks) s += p.mod_part[(size_t)ks * 2 * 5 * NMOD + i];
    p.mod[i] = s;
  }
}

constexpr int CV_IN = 16 * 62, CV_GATE = 16 * 48, CV_BR = 8 * 16, CV_OUT = 16 * 16, CV_13 = 16 * 16, CV_2 = 8 * 16;
constexpr int CV_O1 = CV_IN, CV_O2 = CV_O1 + CV_GATE, CV_O3 = CV_O2 + 3 * CV_BR, CV_O4 = CV_O3 + CV_OUT, CV_O5 = CV_O4 + 32 * CV_13,
              CV_TOTAL = CV_O5 + 32 * CV_2;
struct ConvDesc { const float* src; int ldsrc; int ncols; bf16_t* dst; int lddst; };
__device__ __forceinline__ ConvDesc conv_desc(PRef p, int layer, int item) {
  ConvDesc d;
  d.ncols = 64;
  if (item < CV_O1) {
    int kt = item & 15, ntile = item >> 4;
    int n0 = ntile * 64, srccol;
    if (n0 < 2304) srccol = n0;
    else if (n0 < 3840) srccol = n0 + 32;
    else if (n0 == 3840) { srccol = 2304; d.ncols = 32; }
    else { srccol = 0; d.ncols = 0; }
    d.src = p.w_in + (size_t)layer * 1024 * NIN_SRC + (size_t)(kt * 64) * NIN_SRC + srccol; d.ldsrc = NIN_SRC;
    d.dst = p.wt_in + (size_t)n0 * 1024 + kt * 64; d.lddst = 1024;
  } else if (item < CV_O2) {
    int it = item - CV_O1, kt = it & 15, ntile = it >> 4;
    d.src = p.w_in + (size_t)layer * 1024 * NIN_SRC + (size_t)(kt * 64) * NIN_SRC + 3872 + ntile * 64; d.ldsrc = NIN_SRC;
    d.dst = p.wt_gate + (size_t)(ntile * 64) * 1024 + kt * 64; d.lddst = 1024;
  } else if (item < CV_O3) {
    int it = item - CV_O2, br = it / CV_BR, t = it % CV_BR, kt = t & 7, ntile = t >> 3;
    const float* s0 = (br == 0 ? p.w_br_attn : (br == 1 ? p.w_br_gla : p.w_br_na)) + (size_t)layer * 512 * 1024;
    d.src = s0 + (size_t)(kt * 64) * 1024 + ntile * 64; d.ldsrc = 1024;
    d.dst = p.wt_br + (size_t)br * 1024 * 512 + (size_t)(ntile * 64) * 512 + kt * 64; d.lddst = 512;
  } else if (item < CV_O4) {
    int it = item - CV_O3, kt = it & 15, ntile = it >> 4;
    d.src = p.w_out + (size_t)layer * 1024 * 1024 + (size_t)(kt * 64) * 1024 + ntile * 64; d.ldsrc = 1024;
    d.dst = p.wt_out + (size_t)(ntile * 64) * 1024 + kt * 64; d.lddst = 1024;
  } else if (item < CV_O5) {
    int it = item - CV_O4, e = it >> 8, t = it & 255, kt = t & 15, ntile = t >> 4;
    int j = ntile >> 1, isw3 = ntile & 1;
    d.src = (isw3 ? p.w3 : p.w1) + ((size_t)layer * 32 + e) * 1024 * 512 + (size_t)(kt * 64) * 512 + j * 64; d.ldsrc = 512;
    d.dst = p.wt_13 + (size_t)e * 1024 * 1024 + (size_t)(ntile * 64) * 1024 + kt * 64; d.lddst = 1024;
  } else {
    int it = item - CV_O5, e = it >> 7, t = it & 127, kt = t & 7, ntile = t >> 3;
    d.src = p.w2 + ((size_t)layer * 32 + e) * 512 * 1024 + (size_t)(kt * 64) * 1024 + ntile * 64; d.ldsrc = 1024;
    d.dst = p.wt_2 + (size_t)e * 1024 * 512 + (size_t)(ntile * 64) * 512 + kt * 64; d.lddst = 512;
  }
  return d;
}
__device__ __forceinline__ void conv_load8(const ConvDesc& d, int nhalf, int lane, f32x4v (&v)[8]) {
  const int kb = lane >> 3, c0 = nhalf * 32 + (lane & 7) * 4;
  const float* sp = d.src + (size_t)(kb * 8) * d.ldsrc + c0;
  const bool ok = c0 < d.ncols;
#pragma unroll
  for (int j = 0; j < 8; ++j) {
    f32x4v z = {0.f, 0.f, 0.f, 0.f};
    v[j] = ok ? *(const f32x4v*)(sp + (size_t)j * d.ldsrc) : z;
  }
}
__device__ __forceinline__ void phase_convert(PRef p, int layer_part, char* smem) {
  const int tid = tid_(), lane = tid & 63, w = tid >> 6;
  const int layer = layer_part & 15, part = layer_part >> 4;
  const int begin = part ? CV_O4 : 0, ntiles = part ? (CV_TOTAL - CV_O4) : CV_O4;
  const int nw = vgrid_() * 4;
  int wt = bid_() * 4 + w;
  if (wt >= 2 * ntiles) return;
  ConvDesc d0 = conv_desc(p, layer, begin + (wt >> 1));
  f32x4v v0[8], v1[8];
  conv_load8(d0, wt & 1, lane, v0);
  for (;;) {
    const int nwt = wt + nw;
    const bool more = nwt < 2 * ntiles;
    ConvDesc d1 = d0;
    if (more) { d1 = conv_desc(p, layer, begin + (nwt >> 1)); conv_load8(d1, nwt & 1, lane, v1); }
    {
      const int kb = lane >> 3, c0 = (wt & 1) * 32 + (lane & 7) * 4;
      bf16_t* dp = d0.dst + (size_t)c0 * d0.lddst + kb * 8;
#pragma unroll
      for (int c = 0; c < 4; ++c) {
        const uint4 o = make_uint4(pack2(v0[0][c], v0[1][c]), pack2(v0[2][c], v0[3][c]), pack2(v0[4][c], v0[5][c]), pack2(v0[6][c], v0[7][c]));
        *(uint4*)(dp + (size_t)c * d0.lddst) = o;
      }
    }
    if (!more) break;
    wt = nwt;
    d0 = d1;
#pragma unroll
    for (int j = 0; j < 8; ++j) v0[j] = v1[j];
  }
}

__device__ __forceinline__ void row_stats(const float (&v)[16], float& mean, float& rstd) {
  float s = 0.f;
#pragma unroll
  for (int i = 0; i < 16; ++i) s += v[i];
  mean = wave_sum(s) * (1.f / 1024.f);
  float q = 0.f;
#pragma unroll
  for (int i = 0; i < 16; ++i) { float d = v[i] - mean; q += d * d; }
  float var = wave_sum(q) * (1.f / 1024.f);
  rstd = rsqrtf(var + 1e-6f);
}
__device__ __forceinline__ void load_row(const float* src, int lane, float (&v)[16]) {
#pragma unroll
  for (int i = 0; i < 4; ++i) {
    float4 t = *(const float4*)(src + lane * 4 + 256 * i);
    v[4 * i] = t.x; v[4 * i + 1] = t.y; v[4 * i + 2] = t.z; v[4 * i + 3] = t.w;
  }
}
__device__ __forceinline__ void store_row(float* dst, int lane, const float (&v)[16]) {
#pragma unroll
  for (int i = 0; i < 4; ++i) *(float4*)(dst + lane * 4 + 256 * i) = make_float4(v[4 * i], v[4 * i + 1], v[4 * i + 2], v[4 * i + 3]);
}
__device__ __forceinline__ void store_row_bf(bf16_t* dst, int lane, const float (&v)[16]) {
#pragma unroll
  for (int i = 0; i < 4; ++i) {
    uint2 o = make_uint2(pack2(v[4 * i], v[4 * i + 1]), pack2(v[4 * i + 2], v[4 * i + 3]));
    *(uint2*)(dst + lane * 4 + 256 * i) = o;
  }
}
__device__ __forceinline__ void modulate_row(const float (&x)[16], const float* shift, const float* scale, int lane, float (&h)[16]) {
  float mean, rstd;
  row_stats(x, mean, rstd);
  float sh[16], sc[16];
  load_row(shift, lane, sh);
  load_row(scale, lane, sc);
#pragma unroll
  for (int i = 0; i < 16; ++i) h[i] = (x[i] - mean) * rstd * (1.f + sc[i]) + sh[i];
}

__device__ __forceinline__ void phase_rowpass0(PRef p) {
  const int lane = tid_() & 63, w = tid_() >> 6;
  for (int tok = bid_() * 4 + w; tok < TALL; tok += vgrid_() * 4) {
    const float* src = tok < TLAT ? p.x + (size_t)tok * D : p.ctx + (size_t)(tok - TLAT) * D;
    const float* md = p.mod + (size_t)tok_modrow(tok) * NMOD;
    float x[16], h[16];
    load_row(src, lane, x);
    modulate_row(x, md, md + 1024, lane, h);
    store_row_bf(p.h + (size_t)tok * D, lane, h);
  }
}

typedef __attribute__((ext_vector_type(4))) float f32x4;
__device__ __forceinline__ void phase_rowpass1(PRef p, int layer, char* smem) {
  float* sH = (float*)smem;
  float* sPart = (float*)smem;
  int* sE = (int*)(smem + 16384);
  const int tid = tid_(), lane = tid & 63, w = tid >> 6;
  const int ntok = layer == 0 ? TALL : TLAT;
  const float* lg = p.ln1_g + layer * D;
  const float* lb = p.ln1_b + layer * D;
  const float* wrp = p.wrp + (size_t)layer * 49152;
  for (int g0 = bid_() * 16; g0 < ntok; g0 += vgrid_() * 16) {
    __syncthreads();
    {
      float v[4][16];
#pragma unroll
      for (int rr = 0; rr < 4; ++rr) load_row(p.xres + (size_t)(g0 + w * 4 + rr) * D, lane, v[rr]);
      float gg[16], bb[16], sh2[16], sc2[16];
      load_row(lg, lane, gg);
      load_row(lb, lane, bb);
      {
        const float* md = p.mod + ((size_t)layer * 5 + tok_modrow(g0)) * NMOD;
        load_row(md + 3072, lane, sh2);
        load_row(md + 4096, lane, sc2);
      }
#pragma unroll
      for (int rr = 0; rr < 4; ++rr) {
        const int tok = g0 + w * 4 + rr;
        float mean, rstd;
        row_stats(v[rr], mean, rstd);
        float x1[16], h2[16];
#pragma unroll
        for (int i = 0; i < 16; ++i) x1[i] = (v[rr][i] - mean) * rstd * gg[i] + bb[i];
        store_row(p.xres + (size_t)tok * D, lane, x1);
        {
          float m2, r2;
          row_stats(x1, m2, r2);
#pragma unroll
          for (int i = 0; i < 16; ++i) h2[i] = (x1[i] - m2) * r2 * (1.f + sc2[i]) + sh2[i];
        }
        store_row_bf(p.h2 + (size_t)tok * D, lane, h2);
        store_row(sH + (w * 4 + rr) * 1028, lane, h2);
      }
    }
    __syncthreads();
    f32x4 acc0 = {0.f, 0.f, 0.f, 0.f}, acc1 = acc0, acc2 = acc0;
    {
      const float* ap = sH + (lane & 15) * 1028 + 4 * (lane >> 4) + 256 * w;
      const float* bp = wrp + (size_t)(16 * w) * 256 + lane * 4;
#pragma unroll 8
      for (int t = 0; t < 16; ++t) {
        float4 a = *(const float4*)(ap + 16 * t);
        float4 b0 = *(const float4*)(bp + t * 256);
        float4 b1 = *(const float4*)(bp + t * 256 + 16384);
        float4 b2 = *(const float4*)(bp + t * 256 + 32768);
        acc0 = __builtin_amdgcn_mfma_f32_16x16x4f32(a.x, b0.x, acc0, 0, 0, 0);
        acc1 = __builtin_amdgcn_mfma_f32_16x16x4f32(a.x, b1.x, acc1, 0, 0, 0);
        acc2 = __builtin_amdgcn_mfma_f32_16x16x4f32(a.x, b2.x, acc2, 0, 0, 0);
        acc0 = __builtin_amdgcn_mfma_f32_16x16x4f32(a.y, b0.y, acc0, 0, 0, 0);
        acc1 = __builtin_amdgcn_mfma_f32_16x16x4f32(a.y, b1.y, acc1, 0, 0, 0);
        acc2 = __builtin_amdgcn_mfma_f32_16x16x4f32(a.y, b2.y, acc2, 0, 0, 0);
        acc0 = __builtin_amdgcn_mfma_f32_16x16x4f32(a.z, b0.z, acc0, 0, 0, 0);
        acc1 = __builtin_amdgcn_mfma_f32_16x16x4f32(a.z, b1.z, acc1, 0, 0, 0);
        acc2 = __builtin_amdgcn_mfma_f32_16x16x4f32(a.z, b2.z, acc2, 0, 0, 0);
        acc0 = __builtin_amdgcn_mfma_f32_16x16x4f32(a.w, b0.w, acc0, 0, 0, 0);
        acc1 = __builtin_amdgcn_mfma_f32_16x16x4f32(a.w, b1.w, acc1, 0, 0, 0);
        acc2 = __builtin_amdgcn_mfma_f32_16x16x4f32(a.w, b2.w, acc2, 0, 0, 0);
      }
    }
    __syncthreads();
#pragma unroll
    for (int g = 0; g < 4; ++g) {
      const int row = (lane >> 4) * 4 + g, col = lane & 15;
      sPart[(w * 16 + row) * 48 + col] = acc0[g];
      sPart[(w * 16 + row) * 48 + 16 + col] = acc1[g];
      sPart[(w * 16 + row) * 48 + 32 + col] = acc2[g];
    }
    __syncthreads();
    if (tid < 16) {
      int tok = g0 + tid;
      const float* l0 = sPart + tid * 48;
      float g[4];
#pragma unroll
      for (int i = 0; i < 4; ++i) g[i] = ((l0[32 + i] + l0[768 + 32 + i]) + (l0[1536 + 32 + i] + l0[2304 + 32 + i])) + p.b_rg[layer * 4 + i];
      int grp = 0;
      float gm = g[0];
#pragma unroll
      for (int i = 1; i < 4; ++i) if (g[i] > gm) { gm = g[i]; grp = i; }
      float gs = 0.f;
#pragma unroll
      for (int i = 0; i < 4; ++i) gs += __expf(g[i] - gm);
      float pg = 1.f / gs;
      float sv[8];
#pragma unroll
      for (int i = 0; i < 8; ++i) {
        const int c = grp * 8 + i;
        sv[i] = ((l0[c] + l0[768 + c]) + (l0[1536 + c] + l0[2304 + c])) + p.b_re[layer * 32 + c];
      }
      int i0 = 0;
      float v0 = sv[0];
#pragma unroll
      for (int i = 1; i < 8; ++i) if (sv[i] > v0) { v0 = sv[i]; i0 = i; }
      int i1 = -1;
      float v1 = -3.0e38f;
#pragma unroll
      for (int i = 0; i < 8; ++i) if (i != i0 && sv[i] > v1) { v1 = sv[i]; i1 = i; }
      float e1 = __expf(v1 - v0);
      float w0 = pg / (1.f + e1), w1 = pg * e1 / (1.f + e1);
      int ex0 = grp * 8 + i0, ex1 = grp * 8 + i1;
      sE[tid * 2] = ex0; sE[tid * 2 + 1] = ex1;
      p.tok_e[tok * 2] = ex0; p.tok_e[tok * 2 + 1] = ex1;
      p.tok_gate[tok * 2] = w0; p.tok_gate[tok * 2 + 1] = w1;
    }
    __syncthreads();
    if (tid < 32) {
      int c = 0;
#pragma unroll 8
      for (int i = 0; i < 32; ++i) c += (sE[i] == tid) ? 1 : 0;
      p.cntg[(size_t)(g0 >> 4) * 32 + tid] = c;
      const int mine = sE[tid];
      int rk = 0;
      for (int i = 0; i < (tid & ~1); ++i) rk += (sE[i] == mine) ? 1 : 0;
      p.tok_pos[(g0 + (tid >> 1)) * 2 + (tid & 1)] = rk;
    }
  }
}

__device__ __forceinline__ void phase_moescan(PRef p, int layer, char* smem) {
  int* sOff = (int*)smem;
  int* sScan = sOff + 1280;
  const int tid = tid_();
  const int e = bid_();
  if (e >= 32) return;
  const int ntok = layer == 0 ? TALL : TLAT;
  const int ng = ntok >> 4;
  __syncthreads();
  int loc[5], s = 0;
#pragma unroll
  for (int i = 0; i < 5; ++i) {
    const int g = tid * 5 + i;
    loc[i] = g < ng ? p.cntg[(size_t)g * 32 + e] : 0;
    s += loc[i];
  }
  sScan[tid] = s;
  __syncthreads();
  for (int o = 1; o < 256; o <<= 1) {
    int v = tid >= o ? sScan[tid - o] : 0;
    __syncthreads();
    sScan[tid] += v;
    __syncthreads();
  }
  int run = sScan[tid] - s;
#pragma unroll
  for (int i = 0; i < 5; ++i) { sOff[tid * 5 + i] = run; run += loc[i]; }
  if (tid == 255) p.cnt[e] = sScan[255];
  __syncthreads();
  typedef int i32x2v __attribute__((ext_vector_type(2)));
  for (int base = 0; base < ntok; base += 2048) {
    i32x2v te[8], tp[8];
#pragma unroll
    for (int u = 0; u < 8; ++u) {
      const int tok = base + u * 256 + tid;
      const int tc = tok < ntok ? tok : 0;
      te[u] = *(const i32x2v*)(p.tok_e + tc * 2);
      tp[u] = *(const i32x2v*)(p.tok_pos + tc * 2);
      if (tok >= ntok) te[u] = (i32x2v){-1, -1};
    }
#pragma unroll
    for (int u = 0; u < 8; ++u) {
      const int tok = base + u * 256 + tid;
      if (te[u][0] == e) { const int pos = sOff[tok >> 4] + tp[u][0]; p.list[e * MOE_CAP + pos] = tok; p.tok_pos[tok * 2] = pos; }
      if (te[u][1] == e) { const int pos = sOff[tok >> 4] + tp[u][1]; p.list[e * MOE_CAP + pos] = tok; p.tok_pos[tok * 2 + 1] = pos; }
    }
  }
}

__device__ __forceinline__ void phase_rowpass2(PRef p, int layer) {
  const int lane = tid_() & 63, w = tid_() >> 6;
  const bool last = layer == 1;
  const int ntok = last ? TLAT : TALL;
  const float* lg = p.ln2_g + layer * D;
  const float* lb = p.ln2_b + layer * D;
  const int stride = vgrid_() * 4;
  for (int tokA = bid_() * 4 + w; tokA < ntok; tokA += 2 * stride) {
    const bool hasB = tokA + stride < ntok;
    int tk[2];
    tk[0] = tokA; tk[1] = hasB ? tokA + stride : tokA;
    int s0[2], s1[2];
    float w0[2], w1[2];
#pragma unroll
    for (int u = 0; u < 2; ++u) {
      const int t = tk[u];
      const int e0 = p.tok_e[t * 2], e1 = p.tok_e[t * 2 + 1];
      s0[u] = p.estart[e0] * MOE_BLK + p.tok_pos[t * 2];
      s1[u] = p.estart[e1] * MOE_BLK + p.tok_pos[t * 2 + 1];
      w0[u] = p.tok_gate[t * 2]; w1[u] = p.tok_gate[t * 2 + 1];
    }
    float x1[2][16], g2[2][16];
    uint2 ya[2][4], yb[2][4];
#pragma unroll
    for (int u = 0; u < 2; ++u) {
      const int t = tk[u];
      load_row(p.xres + (size_t)t * D, lane, x1[u]);
      load_row(p.mod + ((size_t)layer * 5 + tok_modrow(t)) * NMOD + 5120, lane, g2[u]);
      const bf16_t* y0 = p.ysl + (size_t)s0[u] * D;
      const bf16_t* y1 = p.ysl + (size_t)s1[u] * D;
#pragma unroll
      for (int i = 0; i < 4; ++i) { ya[u][i] = *(const uint2*)(y0 + lane * 4 + 256 * i); yb[u][i] = *(const uint2*)(y1 + lane * 4 + 256 * i); }
    }
    float gg[16], bb[16];
    load_row(lg, lane, gg);
    load_row(lb, lane, bb);
#pragma unroll
    for (int u = 0; u < 2; ++u) {
      if (u == 1 && !hasB) break;
      const int tok = tk[u];
      float v[16], x2[16];
#pragma unroll
      for (int i = 0; i < 4; ++i) {
        const uint2 a = ya[u][i], b = yb[u][i];
        float fa[4] = {bf2f(a.x & 0xffff), bf2f(a.x >> 16), bf2f(a.y & 0xffff), bf2f(a.y >> 16)};
        float fb[4] = {bf2f(b.x & 0xffff), bf2f(b.x >> 16), bf2f(b.y & 0xffff), bf2f(b.y >> 16)};
#pragma unroll
        for (int e = 0; e < 4; ++e) v[4 * i + e] = ALPHA * x1[u][4 * i + e] + g2[u][4 * i + e] * (w0[u] * fa[e] + w1[u] * fb[e]);
      }
      float mean, rstd;
      row_stats(v, mean, rstd);
#pragma unroll
      for (int i = 0; i < 16; ++i) x2[i] = (v[i] - mean) * rstd * gg[i] + bb[i];
      if (last) {
        store_row(p.out + (size_t)tok * D, lane, x2);
      } else {
        store_row(p.xres + (size_t)tok * D, lane, x2);
        const float* mdn = p.mod + ((size_t)(layer + 1) * 5 + tok_modrow(tok)) * NMOD;
        float h[16];
        modulate_row(x2, mdn, mdn + 1024, lane, h);
        store_row_bf(p.h + (size_t)tok * D, lane, h);
      }
    }
  }
}

struct Ptr4 { const bf16_t* p[4]; };

template <int NJ>
__device__ __forceinline__ void gemm_compute_tile(const char* cA, const char* cB, int r, int hh, f32x16 (&acc)[2][NJ]) {
#pragma unroll
  for (int s = 0; s < 4; ++s) {
    const int co = ((2 * s + hh) ^ ((r >> 1) & 7)) << 4;
    bf16x8 a0 = *(const bf16x8*)(cA + co);
    bf16x8 a1 = *(const bf16x8*)(cA + 4096 + co);
    bf16x8 b[NJ];
#pragma unroll
    for (int j = 0; j < NJ; ++j) b[j] = *(const bf16x8*)(cB + j * 4096 + co);
#pragma unroll
    for (int j = 0; j < NJ; ++j) {
      acc[0][j] = mfma32(a0, b[j], acc[0][j]);
      acc[1][j] = mfma32(a1, b[j], acc[1][j]);
    }
  }
}
#define LAS3 __attribute__((address_space(3)))
__device__ __forceinline__ void dma_sync() { asm volatile("s_waitcnt vmcnt(0)" ::: "memory"); __syncthreads(); }
template <int NJ>
__device__ __forceinline__ void g_stage(const Ptr4& ap, const Ptr4& bp, int kt, char* dA, char* dB) {
#pragma unroll
  for (int i = 0; i < 4; ++i) __builtin_amdgcn_global_load_lds((const unsigned*)(ap.p[i] + kt * 64), (LAS3 unsigned*)(dA + i * 4096), 16, 0, 0);
#pragma unroll
  for (int i = 0; i < 2 * NJ; ++i) __builtin_amdgcn_global_load_lds((const unsigned*)(bp.p[i] + kt * 64), (LAS3 unsigned*)(dB + i * 4096), 16, 0, 0);
}
template <int NJ>
__device__ __forceinline__ void gemm_mainloop(const Ptr4& ap, const Ptr4& bp, int nk, f32x16 (&acc)[2][NJ], char* smem) {
  const int tid = tid_(), lane = tid & 63, w = tid >> 6, wr = w >> 1, wc = w & 1, r = lane & 31, hh = lane >> 5;
  char* sA = smem;
  char* sB = smem + 32768;
  const int dofs = tid * 16;
  g_stage<NJ>(ap, bp, 0, sA + dofs, sB + dofs);
  dma_sync();
  const char* cA = sA + (wr * 64 + r) * 128;
  const char* cB = sB + (wc * 32 * NJ + r) * 128;
  for (int kt = 0; kt < nk; ++kt) {
    const int cur = kt & 1;
    if (kt + 1 < nk) g_stage<NJ>(ap, bp, kt + 1, sA + (cur ^ 1) * 16384 + dofs, sB + (cur ^ 1) * 16384 + dofs);
    gemm_compute_tile<NJ>(cA + cur * 16384, cB + cur * 16384, r, hh, acc);
    dma_sync();
  }
}
__device__ __forceinline__ Ptr4 rows_contig(const bf16_t* base, int ld) {
  Ptr4 q;
  const int lrow = tid_() >> 3, lch = tid_() & 7;
#pragma unroll
  for (int i = 0; i < 4; ++i) q.p[i] = base + (size_t)(lrow + 32 * i) * ld + ((lch ^ ((lrow >> 1) & 7)) * 8);
  return q;
}
__device__ __forceinline__ void acc_to_lds(const f32x16 (&acc)[2][2], float* sC) {
  const int lane = tid_() & 63, w = tid_() >> 6, wr = w >> 1, wc = w & 1, r = lane & 31, hh = lane >> 5;
#pragma unroll
  for (int i = 0; i < 2; ++i)
#pragma unroll
    for (int j = 0; j < 2; ++j)
#pragma unroll
      for (int g = 0; g < 16; ++g) {
        int row = wr * 64 + i * 32 + (g & 3) + 8 * (g >> 2) + 4 * hh, col = wc * 64 + j * 32 + r;
        sC[row * LDC + col] = acc[i][j][g];
      }
}
__device__ __forceinline__ void acc_to_lds_T(const f32x16 (&acc)[2][2], float* sC) {
  const int lane = tid_() & 63, w = tid_() >> 6, wr = w >> 1, wc = w & 1, r = lane & 31, hh = lane >> 5;
#pragma unroll
  for (int i = 0; i < 2; ++i)
#pragma unroll
    for (int j = 0; j < 2; ++j)
#pragma unroll
      for (int g4 = 0; g4 < 4; ++g4) {
        int row = wr * 64 + i * 32 + 8 * g4 + 4 * hh, col = wc * 64 + j * 32 + r;
        *(float4*)(sC + col * LDC + row) = make_float4(acc[i][j][4 * g4], acc[i][j][4 * g4 + 1], acc[i][j][4 * g4 + 2], acc[i][j][4 * g4 + 3]);
      }
}
__device__ __forceinline__ void lds_read8(const float* s, float (&v)[8]) {
  float4 a = *(const float4*)s, b = *(const float4*)(s + 4);
  v[0] = a.x; v[1] = a.y; v[2] = a.z; v[3] = a.w; v[4] = b.x; v[5] = b.y; v[6] = b.z; v[7] = b.w;
}
__device__ __forceinline__ uint4 pack8(const float (&v)[8]) {
  return make_uint4(pack2(v[0], v[1]), pack2(v[2], v[3]), pack2(v[4], v[5]), pack2(v[6], v[7]));
}
__device__ __forceinline__ void st_nt16(void* q, const uint4 v) {
  typedef unsigned nt_u32x4 __attribute__((ext_vector_type(4)));
  const nt_u32x4 t = {v.x, v.y, v.z, v.w};
  __builtin_nontemporal_store(t, (nt_u32x4*)q);
}


__device__ __forceinline__ int xcd_rounds(const char*, int nMt, int nNt) { return (nMt * nNt + vgrid_() - 1) / vgrid_(); }
__device__ __forceinline__ bool xcd_tile(const char*, int round, int nMt, int nNt, int& mt, int& nt) {
  const int item = round * vgrid_() + bid_();
  mt = item / nNt; nt = item % nNt;
  return item < nMt * nNt;
}

namespace pg8 {
constexpr int BK = 64, HALF = 128, HTB = HALF * BK * 2, STAGE_BYTES = 8 * HTB;
__device__ __forceinline__ int lds_byte(int r, int c) { const int st = (r >> 4) * 2 + (c >> 5), rr = r & 15, cc = c & 31, ob = rr * 64 + cc * 2; return st * 1024 + (ob ^ (((ob >> 9) & 1) << 5)); }
__device__ __forceinline__ void stage_rc(int b, int& R, int& C) { const int st = b / 1024, sb = b % 1024, swz = sb ^ (((sb >> 9) & 1) << 5); R = (st >> 1) * 16 + swz / 64; C = (st & 1) * 32 + (swz % 64) / 2; }
typedef float f32x4 __attribute__((ext_vector_type(4)));
__device__ __forceinline__ int perm32(int rho) { const int n = rho >> 4, i = rho & 15; return 8 * (i >> 2) + 4 * n + (i & 3); }
template <bool PERM = false>
__device__ __forceinline__ void gemm_unit(LAS3 unsigned char* lds, const char* cA0, const char* cA1, const unsigned (&voffA0)[2], const unsigned (&voffA1)[2],
                                          const char* cB, int K, f32x4 (&acc)[2][2][4][2]) {
  int tid = __builtin_amdgcn_workitem_id_x();
  asm volatile("" : "+v"(tid));
  const int wid = __builtin_amdgcn_readfirstlane(tid >> 6), lane = tid & 63, wr = wid >> 2, wc = wid & 3, fr = lane & 15, fq = lane >> 4;
  const int nt = K / BK;
  unsigned voffB[2];
#pragma unroll
  for (int i = 0; i < 2; ++i) { int R, C; stage_rc(tid * 16 + i * 8192, R, C); const int Rb = PERM ? ((R & ~31) + perm32(R & 31)) : R; voffB[i] = (unsigned)(Rb * K + C) * 2u; }
  const size_t kstep = (size_t)(BK * 2);
  const size_t hstep = (size_t)HALF * K * 2;
  const unsigned ldsw = (unsigned)wid * 1024u;
  const int aoff = lds_byte(wr * 64 + fr, fq * 8), boff = lds_byte(wc * 32 + fr, fq * 8);
#define PG8_SA(b, h) (((b) * 2 + (h)) * HTB)
#define PG8_SB(b, h) ((4 + (b) * 2 + (h)) * HTB)
#define PG8_STAGE(bufoff, gbase, voff) do { _Pragma("unroll") for (int _i = 0; _i < 2; ++_i) \
        __builtin_amdgcn_global_load_lds((const unsigned*)((const char*)(gbase) + (voff)[_i]), (LAS3 unsigned*)(lds + (bufoff) + ldsw + _i * 8192), 16, 0, 0); } while (0)
#define PG8_LDA(dst, b, h) do { _Pragma("unroll") for (int m = 0; m < 4; ++m) _Pragma("unroll") for (int k = 0; k < 2; ++k) dst[m][k] = *(const LAS3 bf16x8*)(lds + PG8_SA(b, h) + aoff + m * 2048 + k * 1024); } while (0)
#define PG8_LDB(dst, b, h) do { _Pragma("unroll") for (int n = 0; n < 2; ++n) _Pragma("unroll") for (int k = 0; k < 2; ++k) dst[n][k] = *(const LAS3 bf16x8*)(lds + PG8_SB(b, h) + boff + n * 2048 + k * 1024); } while (0)
#define PG8_MMA(ai, bj, At, Bt) do { __builtin_amdgcn_s_setprio(1); _Pragma("unroll") for (int m = 0; m < 4; ++m) _Pragma("unroll") for (int n = 0; n < 2; ++n) _Pragma("unroll") for (int k = 0; k < 2; ++k) \
        acc[ai][bj][m][n] = __builtin_amdgcn_mfma_f32_16x16x32_bf16(Bt[n][k], At[m][k], acc[ai][bj][m][n], 0, 0, 0); __builtin_amdgcn_s_setprio(0); } while (0)
#define PG8_WAIT_V(n) asm volatile("s_waitcnt vmcnt(" #n ")" ::: "memory")
#define PG8_WAIT_L(n) asm volatile("s_waitcnt lgkmcnt(" #n ")" ::: "memory")
#define PG8_BAR __builtin_amdgcn_s_barrier()
#define PG8_SCHED __builtin_amdgcn_sched_barrier(0)
#pragma unroll
  for (int a = 0; a < 2; ++a)
#pragma unroll
    for (int b = 0; b < 2; ++b)
#pragma unroll
      for (int m = 0; m < 4; ++m)
#pragma unroll
        for (int n = 0; n < 2; ++n) acc[a][b][m][n] = (f32x4){0.f, 0.f, 0.f, 0.f};
  bf16x8 At[4][2], B0[2][2], B1[2][2];
  PG8_STAGE(PG8_SB(0, 0), cB, voffB); PG8_STAGE(PG8_SA(0, 0), cA0, voffA0); PG8_STAGE(PG8_SB(0, 1), cB + hstep, voffB); PG8_STAGE(PG8_SA(0, 1), cA1, voffA1);
  if (wr == 1) PG8_BAR;
  PG8_WAIT_V(4); PG8_BAR;
  PG8_STAGE(PG8_SB(1, 0), cB + kstep, voffB); PG8_STAGE(PG8_SA(1, 0), cA0 + kstep, voffA0); PG8_STAGE(PG8_SB(1, 1), cB + hstep + kstep, voffB);
  PG8_WAIT_V(6); PG8_BAR;
  for (int t = 0; t < nt; t += 2) {
    const bool last = (t == nt - 2);
    const size_t o1 = (size_t)(t + 1) * kstep;
    const size_t o2 = last ? 0 : (size_t)(t + 2) * kstep;
    const size_t o3 = o2 + kstep;
    PG8_LDB(B0, 0, 0); PG8_SCHED; PG8_LDA(At, 0, 0); PG8_STAGE(PG8_SA(1, 1), cA1 + o1, voffA1);
    PG8_WAIT_L(8); PG8_BAR; PG8_WAIT_L(0); PG8_MMA(0, 0, At, B0); PG8_BAR; PG8_SCHED;
    PG8_LDB(B1, 0, 1); PG8_STAGE(PG8_SB(0, 0), cB + o2, voffB);
    PG8_BAR; PG8_WAIT_L(0); PG8_MMA(0, 1, At, B1); PG8_BAR;
    PG8_LDA(At, 0, 1); PG8_STAGE(PG8_SA(0, 0), cA0 + o2, voffA0);
    PG8_BAR; PG8_WAIT_L(0); PG8_MMA(1, 0, At, B0); PG8_BAR; PG8_SCHED;
    PG8_STAGE(PG8_SB(0, 1), cB + hstep + o2, voffB);
    PG8_WAIT_V(6); PG8_BAR; PG8_MMA(1, 1, At, B1); PG8_BAR;
    PG8_LDB(B0, 1, 0); PG8_SCHED; PG8_LDA(At, 1, 0); PG8_STAGE(PG8_SA(0, 1), cA1 + o2, voffA1);
    PG8_WAIT_L(8); PG8_BAR; PG8_WAIT_L(0); PG8_MMA(0, 0, At, B0); PG8_BAR; PG8_SCHED;
    PG8_LDB(B1, 1, 1); PG8_STAGE(PG8_SB(1, 0), cB + o3, voffB);
    PG8_BAR; PG8_WAIT_L(0); PG8_MMA(0, 1, At, B1); PG8_BAR;
    PG8_LDA(At, 1, 1); PG8_STAGE(PG8_SA(1, 0), cA0 + o3, voffA0);
    PG8_BAR; PG8_WAIT_L(0); PG8_MMA(1, 0, At, B0); PG8_BAR; PG8_SCHED;
    PG8_STAGE(PG8_SB(1, 1), cB + hstep + o3, voffB);
    PG8_WAIT_V(6); PG8_BAR; PG8_MMA(1, 1, At, B1); PG8_BAR;
  }
  PG8_WAIT_V(0);
  if (wr == 0) PG8_BAR;
  PG8_BAR;
#undef PG8_SA
#undef PG8_SB
#undef PG8_STAGE
#undef PG8_LDA
#undef PG8_LDB
#undef PG8_MMA
#undef PG8_WAIT_V
#undef PG8_WAIT_L
#undef PG8_BAR
#undef PG8_SCHED
}
struct UnitAB { const char* a; const char* b; };
template <bool PERM, class Prov, class Epi>
__device__ __forceinline__ void gemm_stream(LAS3 unsigned char* lds, int K, Prov prov, Epi epi) {
  int tid = __builtin_amdgcn_workitem_id_x();
  asm volatile("" : "+v"(tid));
  const int wid = __builtin_amdgcn_readfirstlane(tid >> 6), lane = tid & 63, wr = wid >> 2, wc = wid & 3, fr = lane & 15, fq = lane >> 4;
  const int nt = K / BK;
  UnitAB cur, nxt;
  if (!prov(0, cur)) return;
  unsigned voffA[2], voffB[2];
#pragma unroll
  for (int i = 0; i < 2; ++i) { int R, C; stage_rc(tid * 16 + i * 8192, R, C); const int Rb = PERM ? ((R & ~31) + perm32(R & 31)) : R;
    voffA[i] = (unsigned)(R * K + C) * 2u; voffB[i] = (unsigned)(Rb * K + C) * 2u; }
  const size_t kstep = (size_t)(BK * 2);
  const size_t hstep = (size_t)HALF * K * 2;
  const unsigned ldsw = (unsigned)wid * 1024u;
  const int aoff = lds_byte(wr * 64 + fr, fq * 8), boff = lds_byte(wc * 32 + fr, fq * 8);
#define PG8_SA(b, h) (((b) * 2 + (h)) * HTB)
#define PG8_SB(b, h) ((4 + (b) * 2 + (h)) * HTB)
#define PG8_STAGE(bufoff, gbase, voff) do { _Pragma("unroll") for (int _i = 0; _i < 2; ++_i) \
        __builtin_amdgcn_global_load_lds((const unsigned*)((const char*)(gbase) + (voff)[_i]), (LAS3 unsigned*)(lds + (bufoff) + ldsw + _i * 8192), 16, 0, 0); } while (0)
#define PG8_LDA(dst, b, h) do { _Pragma("unroll") for (int m = 0; m < 4; ++m) _Pragma("unroll") for (int k = 0; k < 2; ++k) dst[m][k] = *(const LAS3 bf16x8*)(lds + PG8_SA(b, h) + aoff + m * 2048 + k * 1024); } while (0)
#define PG8_LDB(dst, b, h) do { _Pragma("unroll") for (int n = 0; n < 2; ++n) _Pragma("unroll") for (int k = 0; k < 2; ++k) dst[n][k] = *(const LAS3 bf16x8*)(lds + PG8_SB(b, h) + boff + n * 2048 + k * 1024); } while (0)
#define PG8_MMA(ai, bj, At, Bt) do { __builtin_amdgcn_s_setprio(1); _Pragma("unroll") for (int m = 0; m < 4; ++m) _Pragma("unroll") for (int n = 0; n < 2; ++n) _Pragma("unroll") for (int k = 0; k < 2; ++k) \
        acc[ai][bj][m][n] = __builtin_amdgcn_mfma_f32_16x16x32_bf16(Bt[n][k], At[m][k], acc[ai][bj][m][n], 0, 0, 0); __builtin_amdgcn_s_setprio(0); } while (0)
#define PG8_WAIT_V(n) asm volatile("s_waitcnt vmcnt(" #n ")" ::: "memory")
#define PG8_WAIT_L(n) asm volatile("s_waitcnt lgkmcnt(" #n ")" ::: "memory")
#define PG8_BAR __builtin_amdgcn_s_barrier()
#define PG8_SCHED __builtin_amdgcn_sched_barrier(0)
#define PG8_ZERO() do { _Pragma("unroll") for (int a = 0; a < 2; ++a) _Pragma("unroll") for (int b = 0; b < 2; ++b) _Pragma("unroll") for (int m = 0; m < 4; ++m) \
        _Pragma("unroll") for (int n = 0; n < 2; ++n) acc[a][b][m][n] = (f32x4){0.f, 0.f, 0.f, 0.f}; } while (0)
  f32x4 acc[2][2][4][2];
  PG8_ZERO();
  bf16x8 At[4][2], B0[2][2], B1[2][2];
  const char* cA = cur.a; const char* cB = cur.b;
  PG8_STAGE(PG8_SB(0, 0), cB, voffB); PG8_STAGE(PG8_SA(0, 0), cA, voffA); PG8_STAGE(PG8_SB(0, 1), cB + hstep, voffB); PG8_STAGE(PG8_SA(0, 1), cA + hstep, voffA);
  if (wr == 1) PG8_BAR;
  PG8_WAIT_V(4); PG8_BAR;
  PG8_STAGE(PG8_SB(1, 0), cB + kstep, voffB); PG8_STAGE(PG8_SA(1, 0), cA + kstep, voffA); PG8_STAGE(PG8_SB(1, 1), cB + hstep + kstep, voffB);
  PG8_WAIT_V(6); PG8_BAR;
  for (int ui = 0;; ++ui) {
    const bool has_next = prov(ui + 1, nxt);
    const char* nA = has_next ? nxt.a : cA; const char* nB = has_next ? nxt.b : cB;
    for (int t = 0; t < nt; t += 2) {
      const bool last = (t == nt - 2);
      const char* a1 = cA + (size_t)(t + 1) * kstep;
      const char* a2 = last ? nA : cA + (size_t)(t + 2) * kstep; const char* b2 = last ? nB : cB + (size_t)(t + 2) * kstep;
      const char* a3 = a2 + kstep; const char* b3 = b2 + kstep;
      PG8_LDB(B0, 0, 0); PG8_SCHED; PG8_LDA(At, 0, 0); PG8_STAGE(PG8_SA(1, 1), a1 + hstep, voffA);
      PG8_WAIT_L(8); PG8_BAR; PG8_WAIT_L(0); PG8_MMA(0, 0, At, B0); PG8_BAR; PG8_SCHED;
      PG8_LDB(B1, 0, 1); PG8_STAGE(PG8_SB(0, 0), b2, voffB);
      PG8_BAR; PG8_WAIT_L(0); PG8_MMA(0, 1, At, B1); PG8_BAR;
      PG8_LDA(At, 0, 1); PG8_STAGE(PG8_SA(0, 0), a2, voffA);
      PG8_BAR; PG8_WAIT_L(0); PG8_MMA(1, 0, At, B0); PG8_BAR; PG8_SCHED;
      PG8_STAGE(PG8_SB(0, 1), b2 + hstep, voffB);
      PG8_WAIT_V(6); PG8_BAR; PG8_MMA(1, 1, At, B1); PG8_BAR;
      PG8_LDB(B0, 1, 0); PG8_SCHED; PG8_LDA(At, 1, 0); PG8_STAGE(PG8_SA(0, 1), a2 + hstep, voffA);
      PG8_WAIT_L(8); PG8_BAR; PG8_WAIT_L(0); PG8_MMA(0, 0, At, B0); PG8_BAR; PG8_SCHED;
      PG8_LDB(B1, 1, 1); PG8_STAGE(PG8_SB(1, 0), b3, voffB);
      PG8_BAR; PG8_WAIT_L(0); PG8_MMA(0, 1, At, B1); PG8_BAR;
      PG8_LDA(At, 1, 1); PG8_STAGE(PG8_SA(1, 0), a3, voffA);
      PG8_BAR; PG8_WAIT_L(0); PG8_MMA(1, 0, At, B0); PG8_BAR; PG8_SCHED;
      PG8_STAGE(PG8_SB(1, 1), b3 + hstep, voffB);
      PG8_WAIT_V(6); PG8_BAR; PG8_MMA(1, 1, At, B1); PG8_BAR;
    }
    epi(ui, acc);
    if (!has_next) break;
    PG8_ZERO();
    cA = nA; cB = nB;
  }
  PG8_WAIT_V(0);
  if (wr == 0) PG8_BAR;
  PG8_BAR;
#undef PG8_SA
#undef PG8_SB
#undef PG8_STAGE
#undef PG8_LDA
#undef PG8_LDB
#undef PG8_MMA
#undef PG8_WAIT_V
#undef PG8_WAIT_L
#undef PG8_BAR
#undef PG8_SCHED
#undef PG8_ZERO
}
__device__ __forceinline__ void voff_contig(int K, unsigned (&voff)[2]) {
  int tid = __builtin_amdgcn_workitem_id_x();
  asm volatile("" : "+v"(tid));
#pragma unroll
  for (int i = 0; i < 2; ++i) { int R, C; stage_rc(tid * 16 + i * 8192, R, C); voff[i] = (unsigned)(R * K + C) * 2u; }
}
template <int ai, int bj>
__device__ __forceinline__ void acc_to_lds(const f32x4 (&acc)[2][2][4][2], bool transposed, float* sC) {
  int tid = __builtin_amdgcn_workitem_id_x();
  asm volatile("" : "+v"(tid));
  const int wid = tid >> 6, lane = tid & 63, wr = wid >> 2, wc = wid & 3, fr = lane & 15, fq = lane >> 4;
#pragma unroll
  for (int m = 0; m < 4; ++m)
#pragma unroll
    for (int n = 0; n < 2; ++n) {
      const int row = 64 * wr + 16 * m + fr, col = 32 * wc + 16 * n + 4 * fq;
      const f32x4 v = acc[ai][bj][m][n];
      if (!transposed) *(f32x4*)(sC + row * LDC + col) = v;
      else { sC[col * LDC + row] = v[0]; sC[(col + 1) * LDC + row] = v[1]; sC[(col + 2) * LDC + row] = v[2]; sC[(col + 3) * LDC + row] = v[3]; }
    }
}
template <class F>
__device__ __forceinline__ void for_each_piece(const f32x4 (&acc)[2][2][4][2], F f) {
  int tid = __builtin_amdgcn_workitem_id_x();
  asm volatile("" : "+v"(tid));
  const int wid = tid >> 6, lane = tid & 63, wr = wid >> 2, wc = wid & 3, fr = lane & 15, fq = lane >> 4;
#pragma unroll
  for (int ai = 0; ai < 2; ++ai)
#pragma unroll
    for (int m = 0; m < 4; ++m)
#pragma unroll
      for (int bj = 0; bj < 2; ++bj) {
        const f32x4 a = acc[ai][bj][m][0], b = acc[ai][bj][m][1];
        float v[8] = {a[0], a[1], a[2], a[3], b[0], b[1], b[2], b[3]};
        f(128 * ai + 64 * wr + 16 * m + fr, 128 * bj + 32 * wc + 8 * fq, v);
      }
}
__device__ __forceinline__ int unit_linear(int i) { return i * (int)gridDim.x + (int)__builtin_amdgcn_workgroup_id_x(); }
__device__ __forceinline__ bool unit_map(int L, int nM, int nN, int& pm, int& pn) {
  const int nwg = nM * nN;
  if (L >= nwg) return false;
  int wgid = L;
  { const int q = nwg / 8, r = nwg % 8, xcd = wgid % 8, off = wgid / 8; wgid = (xcd < r ? xcd * (q + 1) : r * (q + 1) + (xcd - r) * q) + off; }
  const int nig = 8 * nN, gid = wgid / nig, fm = gid * 8, gsz = (nM - fm) < 8 ? (nM - fm) : 8;
  pm = fm + ((wgid % nig) % gsz); pn = (wgid % nig) / gsz;
  return true;
}
}

__device__ __forceinline__ bool inproj_transposed(int nt) { return (nt == 5) || (nt >= 10 && nt <= 13) || (nt >= 26 && nt <= 29); }
__device__ __forceinline__ void inproj_epilogue(PRef p, int layer, int mt, int nt, const float* sC, int tid) {
  const float* bias = p.b_in + layer * NIN_SRC;
  const bool transposed = inproj_transposed(nt);
  const int tok0 = mt * 128;
  const bool lat = tok0 < TLAT;
  int b, pos0, pall0;
  if (lat) { b = tok0 >> 12; pos0 = tok0 & 4095; pall0 = 256 + pos0; }
  else { int ci = tok0 - TLAT; b = ci >> 8; pos0 = ci & 255; pall0 = pos0; }
  const int n0 = nt * 128;
  const int srcc0 = (nt < 18) ? n0 : n0 + 32;
  if (transposed) {
    const int tc = tid & 15, cb = tid >> 4;
    float bv[8];
#pragma unroll
    for (int ps = 0; ps < 8; ++ps) bv[ps] = bias[srcc0 + ps * 16 + cb];
#pragma unroll
    for (int ps = 0; ps < 8; ++ps) {
      const int col = ps * 16 + cb;
      float v[8];
      lds_read8(sC + col * LDC + tc * 8, v);
#pragma unroll
      for (int e = 0; e < 8; ++e) v[e] += bv[ps];
      bf16_t* dst;
      if (nt == 5) dst = p.vAT + ((size_t)(b * 2 + (col >> 6)) * 64 + (col & 63)) * PALL;
      else if (nt <= 13) dst = p.vBT + ((size_t)(b * 4 + (nt - 10)) * 128 + col) * PALL;
      else dst = p.vCT + ((size_t)(b * 8 + (nt - 26) * 2 + (col >> 6)) * 64 + (col & 63)) * PALL;
      *(uint4*)(dst + pall0 + tc * 8) = pack8(v);
    }
  } else if (nt <= 4) {
    const float* gn = (nt < 4 ? p.q_norm : p.k_norm) + layer * 64;
    const float osc = nt < 4 ? QSCALE : 1.f;
    const int c8 = tid & 15, rb = tid >> 4, d0 = (c8 & 7) * 8;
    float bs[8], bp[8], g0[8], g1[8];
    {
      const float4 t0 = *(const float4*)(bias + srcc0 + c8 * 8), t1 = *(const float4*)(bias + srcc0 + c8 * 8 + 4);
      const float4 u0 = *(const float4*)(bias + srcc0 + ((c8 * 8) ^ 16)), u1 = *(const float4*)(bias + srcc0 + ((c8 * 8) ^ 16) + 4);
      const float4 a0 = *(const float4*)(gn + d0), a1 = *(const float4*)(gn + d0 + 4);
      const float4 c0 = *(const float4*)(gn + (d0 ^ 16)), c1 = *(const float4*)(gn + (d0 ^ 16) + 4);
      bs[0] = t0.x; bs[1] = t0.y; bs[2] = t0.z; bs[3] = t0.w; bs[4] = t1.x; bs[5] = t1.y; bs[6] = t1.z; bs[7] = t1.w;
      bp[0] = u0.x; bp[1] = u0.y; bp[2] = u0.z; bp[3] = u0.w; bp[4] = u1.x; bp[5] = u1.y; bp[6] = u1.z; bp[7] = u1.w;
      g0[0] = a0.x; g0[1] = a0.y; g0[2] = a0.z; g0[3] = a0.w; g0[4] = a1.x; g0[5] = a1.y; g0[6] = a1.z; g0[7] = a1.w;
      g1[0] = c0.x; g1[1] = c0.y; g1[2] = c0.z; g1[3] = c0.w; g1[4] = c1.x; g1[5] = c1.y; g1[6] = c1.z; g1[7] = c1.w;
    }
    const int qd = d0 >> 4;
    const float sgn = (qd & 1) ? 1.f : -1.f;
#pragma unroll 2
    for (int ps = 0; ps < 8; ++ps) {
      const int row = ps * 16 + rb;
      float v[8], pv[8];
      lds_read8(sC + row * LDC + c8 * 8, v);
      lds_read8(sC + row * LDC + ((c8 * 8) ^ 16), pv);
      float cs[8], sn[8];
      if (lat) {
        const int t = pos0 + row;
        const int pp = (qd < 2) ? (t >> 6) : (t & 63);
        const float* rp = p.rope + pp * 16 + (d0 & 15);
        const float4 r0 = *(const float4*)rp, r1 = *(const float4*)(rp + 4), s0 = *(const float4*)(rp + 1024), s1 = *(const float4*)(rp + 1028);
        cs[0] = r0.x; cs[1] = r0.y; cs[2] = r0.z; cs[3] = r0.w; cs[4] = r1.x; cs[5] = r1.y; cs[6] = r1.z; cs[7] = r1.w;
        sn[0] = s0.x; sn[1] = s0.y; sn[2] = s0.z; sn[3] = s0.w; sn[4] = s1.x; sn[5] = s1.y; sn[6] = s1.z; sn[7] = s1.w;
      } else {
#pragma unroll
        for (int e = 0; e < 8; ++e) { cs[e] = 1.f; sn[e] = 0.f; }
      }
      float ss = 0.f;
#pragma unroll
      for (int e = 0; e < 8; ++e) { v[e] += bs[e]; pv[e] += bp[e]; ss += v[e] * v[e]; }
      ss += __shfl_xor(ss, 1);
      ss += __shfl_xor(ss, 2);
      ss += __shfl_xor(ss, 4);
      const float rstd = rsqrtf(ss * (1.f / 64.f) + 1e-6f);
      float o[8];
#pragma unroll
      for (int e = 0; e < 8; ++e) {
        const float xn = v[e] * rstd * g0[e], pn = pv[e] * rstd * g1[e];
        o[e] = (xn * cs[e] + sgn * pn * sn[e]) * osc;
      }
      bf16_t* dst;
      if (nt < 4) dst = p.qA + (size_t)(tok0 + row) * 512 + nt * 128 + c8 * 8;
      else dst = p.kA + ((size_t)(b * 2 + (c8 >> 3)) * PALL + pall0 + row) * 64 + d0;
      *(uint4*)dst = pack8(o);
    }
  } else {
    bf16_t* base;
    int ld, cofs;
    float osc = 1.f;
    if (nt <= 7) { base = p.qB; ld = 256; cofs = (nt - 6) * 128; osc = 0.125f; }
    else if (nt <= 9) { base = p.kB; ld = 256; cofs = (nt - 8) * 128; }
    else if (nt <= 17) { base = p.rB; ld = 512; cofs = (nt - 14) * 128; }
    else if (nt <= 21) { base = p.qC; ld = 512; cofs = (nt - 18) * 128; osc = QSCALE; }
    else { base = p.kC; ld = 512; cofs = (nt - 22) * 128; }
    const int c8 = tid & 15, rb = tid >> 4;
    float bs[8];
    {
      const float4 t0 = *(const float4*)(bias + srcc0 + c8 * 8), t1 = *(const float4*)(bias + srcc0 + c8 * 8 + 4);
      bs[0] = t0.x; bs[1] = t0.y; bs[2] = t0.z; bs[3] = t0.w; bs[4] = t1.x; bs[5] = t1.y; bs[6] = t1.z; bs[7] = t1.w;
    }
#pragma unroll
    for (int ps = 0; ps < 8; ++ps) {
      const int row = ps * 16 + rb;
      float v[8];
      lds_read8(sC + row * LDC + c8 * 8, v);
#pragma unroll
      for (int e = 0; e < 8; ++e) v[e] = (v[e] + bs[e]) * osc;
      *(uint4*)(base + (size_t)(tok0 + row) * ld + cofs + c8 * 8) = pack8(v);
    }
  }
}

__device__ __forceinline__ void gate_epilogue(PRef p, int layer, int mt, int nt, const float* sC, int tid) {
  const float* bias = p.b_in + layer * NIN_SRC + 3872 + nt * 128;
  const int c8 = tid & 15, rb = tid >> 4;
  float bs[8];
  {
    const float4 t0 = *(const float4*)(bias + c8 * 8), t1 = *(const float4*)(bias + c8 * 8 + 4);
    bs[0] = t0.x; bs[1] = t0.y; bs[2] = t0.z; bs[3] = t0.w; bs[4] = t1.x; bs[5] = t1.y; bs[6] = t1.z; bs[7] = t1.w;
  }
#pragma unroll
  for (int ps = 0; ps < 8; ++ps) {
    const int row = ps * 16 + rb;
    float v[8];
    lds_read8(sC + row * LDC + c8 * 8, v);
#pragma unroll
    for (int e = 0; e < 8; ++e) v[e] = sigmoidf_(v[e] + bs[e]);
    *(uint4*)(p.G + (size_t)(mt * 128 + row) * 3072 + nt * 128 + c8 * 8) = pack8(v);
  }
}
__device__ __forceinline__ void phase_inproj(PRef p, int layer, char* smem_all) {
  LAS3 unsigned char* lds = (LAS3 unsigned char*)smem_all;
  constexpr int NSTREAM_IN = 68 * 12, NSTREAM = NSTREAM_IN + 64 * 12, NOLD = 68 * 3;
  {
    unsigned voffA[2];
    pg8::voff_contig(D, voffA);
    const int G = (int)gridDim.x, c = (int)__builtin_amdgcn_workgroup_id_x();
    const int rem = NSTREAM % G;
    for (int j = (c - rem + G) % G; j < NOLD; j += G) {
      int pm, pn;
      pg8::unit_map(j, 68, 3, pm, pn);
      pg8::f32x4 acc[2][2][4][2];
      const char* a0 = (const char*)(p.h + (size_t)pm * 256 * D);
      pg8::gemm_unit(lds, a0, a0 + (size_t)128 * D * 2, voffA, voffA, (const char*)(p.wt_in + (size_t)pn * 256 * D), D, acc);
      asm volatile("" : "+s"(pm), "+s"(pn));
      PRef pe = params_view();
      const int etid = tid_();
      const int half = half_();
      float* sCh = (float*)(smem_all + half * SMEM_BYTES);
      pg8::acc_to_lds<0, 0>(acc, inproj_transposed(2 * pn), (float*)smem_all);
      pg8::acc_to_lds<0, 1>(acc, inproj_transposed(2 * pn + 1), (float*)(smem_all + SMEM_BYTES));
      __syncthreads();
      inproj_epilogue(pe, layer, 2 * pm, 2 * pn + half, sCh, etid);
      __syncthreads();
      pg8::acc_to_lds<1, 0>(acc, inproj_transposed(2 * pn), (float*)smem_all);
      pg8::acc_to_lds<1, 1>(acc, inproj_transposed(2 * pn + 1), (float*)(smem_all + SMEM_BYTES));
      __syncthreads();
      inproj_epilogue(pe, layer, 2 * pm + 1, 2 * pn + half, sCh, etid);
      __syncthreads();
    }
  }
  {
    PRef pg = params_view();
    const bf16_t* hbase = pg.h;
    const bf16_t* win = pg.wt_in;
    const bf16_t* wg = pg.wt_gate;
    const float* bias = pg.b_in + layer * NIN_SRC;
    bf16_t* gbase = pg.G;
    pg8::gemm_stream<true>(lds, D,
      [&](int ui, pg8::UnitAB& u) {
        const int s = pg8::unit_linear(ui);
        int pm, pn;
        if (s < NSTREAM_IN) {
          pg8::unit_map(s, 68, 12, pm, pn);
          pn += 3;
          const char* hr = (const char*)(hbase + (size_t)pm * 256 * D);
          const char* wr_ = (const char*)(win + (size_t)pn * 256 * D);
          const bool T = (pn == 5) || (pn == 6) || (pn >= 13);
          u.a = T ? wr_ : hr;
          u.b = T ? hr : wr_;
          return true;
        }
        if (!pg8::unit_map(s - NSTREAM_IN, 64, 12, pm, pn)) return false;
        u.a = (const char*)(hbase + (size_t)pm * 256 * D);
        u.b = (const char*)(wg + (size_t)pn * 256 * D);
        return true;
      },
      [&](int ui, const pg8::f32x4 (&acc)[2][2][4][2]) {
        const int s = pg8::unit_linear(ui);
        int lt = __builtin_amdgcn_workitem_id_x();
        asm volatile("" : "+v"(lt));
        const int wc = (lt >> 6) & 3, wr = lt >> 8, fr = lt & 15, fq = (lt & 63) >> 4;
        const int cbase = 32 * wc + 8 * fq;
        int pm, pn;
        if (s >= NSTREAM_IN) {
          pg8::unit_map(s - NSTREAM_IN, 64, 12, pm, pn);
          const float* gb = bias + 3872 + pn * 256;
          bf16_t* gdst = gbase + (size_t)pm * 256 * 3072 + pn * 256;
          const float4 ba0 = *(const float4*)(gb + cbase), ba1 = *(const float4*)(gb + cbase + 4);
          const float4 bb0 = *(const float4*)(gb + 128 + cbase), bb1 = *(const float4*)(gb + 128 + cbase + 4);
          pg8::for_each_piece(acc, [&](int row, int col, float (&v)[8]) {
            const float4 b0 = col < 128 ? ba0 : bb0, b1 = col < 128 ? ba1 : bb1;
            v[0] = sigmoidf_(v[0] + b0.x); v[1] = sigmoidf_(v[1] + b0.y); v[2] = sigmoidf_(v[2] + b0.z); v[3] = sigmoidf_(v[3] + b0.w);
            v[4] = sigmoidf_(v[4] + b1.x); v[5] = sigmoidf_(v[5] + b1.y); v[6] = sigmoidf_(v[6] + b1.z); v[7] = sigmoidf_(v[7] + b1.w);
            st_nt16(gdst + (size_t)row * 3072 + col, pack8(v));
          });
          return;
        }
        pg8::unit_map(s, 68, 12, pm, pn);
        pn += 3;
        const float* bsrc = bias + (pn < 9 ? pn * 256 : pn * 256 + 32);
        const bool T = (pn == 5) || (pn == 6) || (pn >= 13);
        if (!T) {
          bf16_t* base; int ld, cofs0; float osc = 1.f;
          if (pn == 3) { base = pg.qB; ld = 256; cofs0 = 0; osc = 0.125f; }
          else if (pn == 4) { base = pg.kB; ld = 256; cofs0 = 0; }
          else if (pn <= 8) { base = pg.rB; ld = 512; cofs0 = (pn - 7) * 256; }
          else if (pn <= 10) { base = pg.qC; ld = 512; cofs0 = (pn - 9) * 256; osc = QSCALE; }
          else { base = pg.kC; ld = 512; cofs0 = (pn - 11) * 256; }
          const float4 ba0 = *(const float4*)(bsrc + cbase), ba1 = *(const float4*)(bsrc + cbase + 4);
          const float4 bb0 = *(const float4*)(bsrc + 128 + cbase), bb1 = *(const float4*)(bsrc + 128 + cbase + 4);
          bf16_t* d0 = base + (size_t)pm * 256 * ld + cofs0;
          pg8::for_each_piece(acc, [&](int row, int col, float (&v)[8]) {
            const float4 b0 = col < 128 ? ba0 : bb0, b1 = col < 128 ? ba1 : bb1;
            v[0] = (v[0] + b0.x) * osc; v[1] = (v[1] + b0.y) * osc; v[2] = (v[2] + b0.z) * osc; v[3] = (v[3] + b0.w) * osc;
            v[4] = (v[4] + b1.x) * osc; v[5] = (v[5] + b1.y) * osc; v[6] = (v[6] + b1.z) * osc; v[7] = (v[7] + b1.w) * osc;
            st_nt16(d0 + (size_t)row * ld + col, pack8(v));
          });
        } else {
          bf16_t* tb; int f0;
          if (pn <= 6) { tb = pg.vBT; f0 = (pn - 5) * 256; } else { tb = pg.vCT; f0 = (pn - 13) * 256; }
          const int tok0 = pm * 256;
          int b, pall0;
          if (tok0 < TLAT) { b = tok0 >> 12; pall0 = 256 + (tok0 & 4095); } else { const int ci = tok0 - TLAT; b = ci >> 8; pall0 = ci & 255; }
          bf16_t* d0 = tb + (size_t)(b * 512 + f0) * PALL + pall0;
          const int rbase = 64 * wr + fr;
          float bv[2][4];
#pragma unroll
          for (int ai = 0; ai < 2; ++ai)
#pragma unroll
            for (int m = 0; m < 4; ++m) bv[ai][m] = bsrc[128 * ai + rbase + 16 * m];
#pragma unroll
          for (int ai = 0; ai < 2; ++ai)
#pragma unroll
            for (int m = 0; m < 4; ++m)
#pragma unroll
              for (int bj = 0; bj < 2; ++bj) {
                const pg8::f32x4 x0 = acc[ai][bj][m][0], x1 = acc[ai][bj][m][1];
                const float bb = bv[ai][m];
                float v[8] = {x0[0] + bb, x0[1] + bb, x0[2] + bb, x0[3] + bb, x1[0] + bb, x1[1] + bb, x1[2] + bb, x1[3] + bb};
                st_nt16(d0 + (size_t)(128 * ai + rbase + 16 * m) * PALL + 128 * bj + cbase, pack8(v));
              }
        }
      });
  }
  {
    const int vtid = tid_();
    char* smem = smem_all + half_() * SMEM_BYTES;
    float* sC = (float*)smem;
    const int lane = vtid & 63, w = vtid >> 6, wr = w >> 1, wc = w & 1, r = lane & 31, hh = lane >> 5;
    for (int mt = bid_(); mt < 136; mt += vgrid_()) {
      f32x16 acc[2][1];
      acc[0][0] = zero16();
      acc[1][0] = zero16();
      gemm_mainloop<1>(rows_contig(p.h + (size_t)mt * 128 * D, D), rows_contig(p.wt_in + (size_t)3840 * D, D), 16, acc, smem);
#pragma unroll
      for (int i2 = 0; i2 < 2; ++i2)
#pragma unroll
        for (int g = 0; g < 16; ++g) {
          int row = wr * 64 + i2 * 32 + (g & 3) + 8 * (g >> 2) + 4 * hh, col = wc * 32 + r;
          sC[row * LDC + col] = acc[i2][0][g];
        }
      __syncthreads();
      for (int i2 = vtid; i2 < 128 * 32; i2 += 256) {
        int row = i2 >> 5, col = i2 & 31;
        p.aB[(size_t)(mt * 128 + row) * 32 + col] = sC[row * LDC + col] + p.b_in[layer * NIN_SRC + 2304 + col];
      }
      __syncthreads();
    }
  }
}

__device__ __forceinline__ void merge_tiles(PRef p, int layer, char* smem, int mt0, int nmt) {
  float* sC = (float*)smem;
  const int tid = tid_(), lane = tid & 63, w = tid >> 6, wr = w >> 1, wc = w & 1, r = lane & 31, hh = lane >> 5;
  const float* bias = p.b_in + layer * NIN_SRC + 3872;
  const int nrounds = xcd_rounds(smem, nmt, 16);
  for (int rd = 0; rd < nrounds; ++rd) {
    int mt, nt;
    if (!xcd_tile(smem, rd, nmt, 16, mt, nt)) continue;
    mt += mt0;
    f32x16 tot[2][1];
    tot[0][0] = zero16();
    tot[1][0] = zero16();
#pragma unroll 1
    for (int br = 0; br < 3; ++br) {
      f32x16 acc[2][1];
      acc[0][0] = zero16();
      acc[1][0] = zero16();
      gemm_mainloop<1>(rows_contig(p.h + (size_t)mt * 128 * D, D), rows_contig(p.wt_gate + (size_t)(br * 1024 + nt * 64) * D, D), 16, acc, smem);
      unsigned sg[2][8];
      {
        float bv = bias[br * 1024 + nt * 64 + wc * 32 + r];
#pragma unroll
        for (int i = 0; i < 2; ++i)
#pragma unroll
          for (int g = 0; g < 8; ++g)
            sg[i][g] = pack2(sigmoidf_(acc[i][0][2 * g] + bv), sigmoidf_(acc[i][0][2 * g + 1] + bv));
      }
      acc[0][0] = zero16();
      acc[1][0] = zero16();
      const bf16_t* ob = (br == 0 ? p.oA : (br == 1 ? p.oB : p.oC));
      gemm_mainloop<1>(rows_contig(ob + (size_t)mt * 128 * 512, 512), rows_contig(p.wt_br + ((size_t)br * 1024 + nt * 64) * 512, 512), 8, acc, smem);
#pragma unroll
      for (int i = 0; i < 2; ++i)
#pragma unroll
        for (int g = 0; g < 8; ++g) {
          tot[i][0][2 * g] += bf2f((bf16_t)(sg[i][g] & 0xffff)) * acc[i][0][2 * g];
          tot[i][0][2 * g + 1] += bf2f((bf16_t)(sg[i][g] >> 16)) * acc[i][0][2 * g + 1];
        }
    }
#pragma unroll
    for (int i = 0; i < 2; ++i)
#pragma unroll
      for (int g = 0; g < 16; ++g) {
        int row = wr * 64 + i * 32 + (g & 3) + 8 * (g >> 2) + 4 * hh, col = wc * 32 + r;
        sC[row * LDC + col] = tot[i][0][g];
      }
    __syncthreads();
#pragma unroll 1
    for (int ps = 0; ps < 4; ++ps) {
      int row = ps * 32 + (tid >> 3), c8 = tid & 7;
      float v[8];
      lds_read8(sC + row * LDC + c8 * 8, v);
      *(uint4*)(p.m + (size_t)(mt * 128 + row) * D + nt * 64 + c8 * 8) = pack8(v);
    }
    __syncthreads();
  }
}

__device__ __forceinline__ void merge_epilogue(PRef p, int br, int mt, int nt, const float* sC, int tid) {
  const int c8 = tid & 15, rb = tid >> 4;
#pragma unroll 1
  for (int hb = 0; hb < 2; ++hb) {
    u32x4 gv[4], mv[4];
#pragma unroll
    for (int q = 0; q < 4; ++q) {
      const size_t tok = (size_t)(mt * 128 + (hb * 4 + q) * 16 + rb);
      gv[q] = *(const u32x4*)(p.G + tok * 3072 + br * 1024 + nt * 128 + c8 * 8);
      if (br > 0) mv[q] = *(const u32x4*)(p.m + tok * D + nt * 128 + c8 * 8);
    }
#pragma unroll
    for (int q = 0; q < 4; ++q) {
      const int row = (hb * 4 + q) * 16 + rb;
      float v[8];
      lds_read8(sC + row * LDC + c8 * 8, v);
#pragma unroll
      for (int e2 = 0; e2 < 4; ++e2) {
        v[2 * e2] *= bf2f((bf16_t)(gv[q][e2] & 0xffff));
        v[2 * e2 + 1] *= bf2f((bf16_t)(gv[q][e2] >> 16));
        if (br > 0) { v[2 * e2] += bf2f((bf16_t)(mv[q][e2] & 0xffff)); v[2 * e2 + 1] += bf2f((bf16_t)(mv[q][e2] >> 16)); }
      }
      *(uint4*)(p.m + (size_t)(mt * 128 + row) * D + nt * 128 + c8 * 8) = pack8(v);
    }
  }
}
__device__ __forceinline__ void phase_merge(PRef p, int layer, char* smem_all) {
  LAS3 unsigned char* lds = (LAS3 unsigned char*)smem_all;
  {
    PRef pe = params_view();
    const bf16_t* oA = pe.oA; const bf16_t* oB = pe.oB; const bf16_t* oC = pe.oC;
    const bf16_t* wbr = pe.wt_br;
    const bf16_t* Gp = pe.G;
    bf16_t* mp = pe.m;
    pg8::gemm_stream<true>(lds, 512,
      [&](int ui, pg8::UnitAB& u) {
        const int br = ui % 3;
        int pm, pn;
        if (!pg8::unit_map(pg8::unit_linear(ui / 3), 64, 4, pm, pn)) return false;
        const bf16_t* ob = (br == 0 ? oA : (br == 1 ? oB : oC));
        u.a = (const char*)(ob + (size_t)pm * 256 * 512);
        u.b = (const char*)(wbr + ((size_t)br * 1024 + pn * 256) * 512);
        return true;
      },
      [&](int ui, const pg8::f32x4 (&acc)[2][2][4][2]) {
        const int br = ui % 3;
        int pm, pn;
        pg8::unit_map(pg8::unit_linear(ui / 3), 64, 4, pm, pn);
        const bf16_t* gsrc = Gp + (size_t)pm * 256 * 3072 + br * 1024 + pn * 256;
        bf16_t* mdst = mp + (size_t)pm * 256 * D + pn * 256;
        const bool rmw = br > 0;
        int lt = __builtin_amdgcn_workitem_id_x();
        asm volatile("" : "+v"(lt));
        const int wid = lt >> 6, lane = lt & 63, wr = wid >> 2, wc = wid & 3, fr = lane & 15, fq = lane >> 4;
#pragma unroll
        for (int ai = 0; ai < 2; ++ai) {
          u32x4 gq[4][2], mq[4][2];
#pragma unroll
          for (int m = 0; m < 4; ++m)
#pragma unroll
            for (int bj = 0; bj < 2; ++bj) {
              const int row = 128 * ai + 64 * wr + 16 * m + fr, col = 128 * bj + 32 * wc + 8 * fq;
              gq[m][bj] = *(const u32x4*)(gsrc + (size_t)row * 3072 + col);
              if (rmw) mq[m][bj] = *(const u32x4*)(mdst + (size_t)row * D + col);
            }
#pragma unroll
          for (int m = 0; m < 4; ++m)
#pragma unroll
            for (int bj = 0; bj < 2; ++bj) {
              const int row = 128 * ai + 64 * wr + 16 * m + fr, col = 128 * bj + 32 * wc + 8 * fq;
              const pg8::f32x4 a = acc[ai][bj][m][0], b = acc[ai][bj][m][1];
              float v[8] = {a[0], a[1], a[2], a[3], b[0], b[1], b[2], b[3]};
              const u32x4 g = gq[m][bj];
#pragma unroll
              for (int e2 = 0; e2 < 4; ++e2) {
                v[2 * e2] *= bf2f((bf16_t)(g[e2] & 0xffff));
                v[2 * e2 + 1] *= bf2f((bf16_t)(g[e2] >> 16));
                if (rmw) { v[2 * e2] += bf2f((bf16_t)(mq[m][bj][e2] & 0xffff)); v[2 * e2 + 1] += bf2f((bf16_t)(mq[m][bj][e2] >> 16)); }
              }
              *(uint4*)(mdst + (size_t)row * D + col) = pack8(v);
            }
        }
      });
  }
  if (layer == 0) merge_tiles(p, layer, smem_all + half_() * SMEM_BYTES, 128, 8);
}

__device__ __forceinline__ void outproj_epilogue(PRef p, int layer, int mt, int nt, const float* sC, int tid) {
  const int tok0 = mt * 128;
  const float* g1 = p.mod + ((size_t)layer * 5 + tok_modrow(tok0)) * NMOD + 2048 + nt * 128;
  const int c8 = tid & 15, rb = tid >> 4;
  const float4 ga = *(const float4*)(g1 + c8 * 8), gb = *(const float4*)(g1 + c8 * 8 + 4);
#pragma unroll 1
  for (int hb = 0; hb < 2; ++hb) {
    float4 x0[4], x1[4];
#pragma unroll
    for (int q = 0; q < 4; ++q) {
      const int tok = tok0 + (hb * 4 + q) * 16 + rb;
      const float* xp;
      if (layer == 0) xp = tok < TLAT ? p.x + (size_t)tok * D : p.ctx + (size_t)(tok - TLAT) * D;
      else xp = p.xres + (size_t)tok * D;
      xp += nt * 128 + c8 * 8;
      x0[q] = *(const float4*)xp; x1[q] = *(const float4*)(xp + 4);
    }
#pragma unroll
    for (int q = 0; q < 4; ++q) {
      const int row = (hb * 4 + q) * 16 + rb;
      float v[8];
      lds_read8(sC + row * LDC + c8 * 8, v);
      float4 o0 = make_float4(ALPHA * x0[q].x + ga.x * v[0], ALPHA * x0[q].y + ga.y * v[1], ALPHA * x0[q].z + ga.z * v[2], ALPHA * x0[q].w + ga.w * v[3]);
      float4 o1 = make_float4(ALPHA * x1[q].x + gb.x * v[4], ALPHA * x1[q].y + gb.y * v[5], ALPHA * x1[q].z + gb.z * v[6], ALPHA * x1[q].w + gb.w * v[7]);
      float* op = p.xres + (size_t)(tok0 + row) * D + nt * 128 + c8 * 8;
      *(float4*)op = o0;
      *(float4*)(op + 4) = o1;
    }
  }
}
__device__ __forceinline__ void phase_outproj(PRef p, int layer, char* smem_all) {
  LAS3 unsigned char* lds = (LAS3 unsigned char*)smem_all;
  unsigned voffA[2];
  pg8::voff_contig(D, voffA);
  for (int i = 0;; ++i) {
    int pm, pn;
    if (!pg8::unit_map(pg8::unit_linear(i), 64, 4, pm, pn)) break;
    pg8::f32x4 acc[2][2][4][2];
    const char* a0 = (const char*)(p.m + (size_t)pm * 256 * D);
    pg8::gemm_unit(lds, a0, a0 + (size_t)128 * D * 2, voffA, voffA, (const char*)(p.wt_out + (size_t)pn * 256 * D), D, acc);
    asm volatile("" : "+s"(pm), "+s"(pn));
    PRef pe = params_view();
    const int etid = tid_();
    const int half = half_();
    float* sCh = (float*)(smem_all + half * SMEM_BYTES);
    pg8::acc_to_lds<0, 0>(acc, false, (float*)smem_all);
    pg8::acc_to_lds<0, 1>(acc, false, (float*)(smem_all + SMEM_BYTES));
    __syncthreads();
    outproj_epilogue(pe, layer, 2 * pm, 2 * pn + half, sCh, etid);
    __syncthreads();
    pg8::acc_to_lds<1, 0>(acc, false, (float*)smem_all);
    pg8::acc_to_lds<1, 1>(acc, false, (float*)(smem_all + SMEM_BYTES));
    __syncthreads();
    outproj_epilogue(pe, layer, 2 * pm + 1, 2 * pn + half, sCh, etid);
    __syncthreads();
  }
  if (layer == 0) {
    char* smem = smem_all + half_() * SMEM_BYTES;
    float* sC = (float*)smem;
    const int tid = tid_();
    for (int item = bid_(); item < 64; item += vgrid_()) {
      const int mt = 128 + (item >> 3), nt = item & 7;
      f32x16 acc[2][2];
#pragma unroll
      for (int i = 0; i < 2; ++i)
#pragma unroll
        for (int j = 0; j < 2; ++j) acc[i][j] = zero16();
      gemm_mainloop<2>(rows_contig(p.m + (size_t)mt * 128 * D, D), rows_contig(p.wt_out + (size_t)nt * 128 * D, D), 16, acc, smem);
      acc_to_lds(acc, sC);
      __syncthreads();
      outproj_epilogue(p, layer, mt, nt, sC, tid);
      __syncthreads();
    }
  }
}

__device__ __forceinline__ bool moe_block_lookup(PRef p, int mb, int& e, int& lb, int& cnt_e) {
  int start = 0;
  for (int i = 0; i < 32; ++i) {
    int c = p.cnt[i];
    int nb = (c + MOE_BLK - 1) / MOE_BLK;
    if (mb < start + nb) { e = i; lb = mb - start; cnt_e = c; return true; }
    start += nb;
  }
  return false;
}
struct MoeMap { int c, start, incl; };
__device__ __forceinline__ MoeMap moe_map_build(const int* cnt) {
  int lane = __builtin_amdgcn_workitem_id_x() & 63;
  asm volatile("" : "+v"(lane));
  MoeMap m;
  m.c = lane < 32 ? cnt[lane] : 0;
  const int nb = (m.c + MOE_BLK - 1) / MOE_BLK;
  int v = nb;
#define MOE_DPP_ADD(ctrl, rmask) v += __builtin_amdgcn_update_dpp(0, v, ctrl, rmask, 0xf, false)
  MOE_DPP_ADD(0x111, 0xf); MOE_DPP_ADD(0x112, 0xf); MOE_DPP_ADD(0x114, 0xf); MOE_DPP_ADD(0x118, 0xf);
  MOE_DPP_ADD(0x142, 0xa); MOE_DPP_ADD(0x143, 0xc);
#undef MOE_DPP_ADD
  m.incl = v;
  m.start = v - nb;
  return m;
}
__device__ __forceinline__ bool moe_map_lookup(const MoeMap& m, int mb, int& e, int& lb, int& cnt_e) {
  const unsigned long long hit = __ballot(mb >= m.start && mb < m.incl);
  if (hit == 0ull) return false;
  e = __builtin_amdgcn_readfirstlane(__ffsll((long long)hit) - 1);
  lb = mb - __builtin_amdgcn_readlane(m.start, e);
  cnt_e = __builtin_amdgcn_readlane(m.c, e);
  return true;
}
__device__ __forceinline__ void moe1_epilogue(PRef p, int slot0, int nt, const float* sC, int tid) {
#pragma unroll
  for (int ps = 0; ps < 8; ++ps) {
    const int row = ps * 16 + (tid >> 4), c4 = (tid & 15) * 4;
    const float4 a = *(const float4*)(sC + row * LDC + c4);
    const float4 b = *(const float4*)(sC + row * LDC + 64 + c4);
    const uint2 o = make_uint2(pack2(siluf(a.x) * b.x, siluf(a.y) * b.y), pack2(siluf(a.z) * b.z, siluf(a.w) * b.w));
    *(uint2*)(p.act + (size_t)(slot0 + row) * 512 + nt * 64 + c4) = o;
  }
}
__device__ __forceinline__ void moe2_epilogue(PRef p, int slot0, int nt, const float* sC, int tid) {
#pragma unroll
  for (int ps = 0; ps < 8; ++ps) {
    const int row = ps * 16 + (tid >> 4), c8 = tid & 15;
    float v[8];
    lds_read8(sC + row * LDC + c8 * 8, v);
    *(uint4*)(p.ysl + (size_t)(slot0 + row) * D + nt * 128 + c8 * 8) = pack8(v);
  }
}
__device__ __forceinline__ void phase_moe1(PRef p, int layer, char* smem_all) {
  LAS3 unsigned char* lds = (LAS3 unsigned char*)smem_all;
  const MoeMap mm = moe_map_build(p.cnt);
  if (__builtin_amdgcn_workgroup_id_x() == 0 && __builtin_amdgcn_workitem_id_x() < 32) p.estart[__builtin_amdgcn_workitem_id_x()] = mm.start;
  struct UnitG { int mb, pn, e; unsigned a0[2], a1[2]; bool ok; };
  auto fetch = [&](int i, int& mb, int& pn, int& e, unsigned (&a0)[2], unsigned (&a1)[2]) -> bool {
    const int L = pg8::unit_linear(i);
    mb = L >> 2; pn = L & 3;
    int lb, ce;
    if (mb >= MAX_MBLK || !moe_map_lookup(mm, mb, e, lb, ce)) return false;
    int tid = __builtin_amdgcn_workitem_id_x();
    asm volatile("" : "+v"(tid));
#pragma unroll
    for (int q = 0; q < 2; ++q) {
      int R, C;
      pg8::stage_rc(tid * 16 + q * 8192, R, C);
      const int s0 = lb * MOE_BLK + R, s1 = s0 + 128;
      const int t0 = s0 < ce ? p.list[e * MOE_CAP + s0] : 0;
      const int t1 = s1 < ce ? p.list[e * MOE_CAP + s1] : 0;
      a0[q] = (unsigned)(t0 * D + C) * 2u;
      a1[q] = (unsigned)(t1 * D + C) * 2u;
    }
    return true;
  };
  int mb, pn, e;
  unsigned voffA0[2], voffA1[2];
  bool ok = fetch(0, mb, pn, e, voffA0, voffA1);
  for (int i = 0; ok; ++i) {
    int mbn, pnn, en;
    unsigned n0[2], n1[2];
    const bool okn = fetch(i + 1, mbn, pnn, en, n0, n1);
    pg8::f32x4 acc[2][2][4][2];
    pg8::gemm_unit(lds, (const char*)p.h2, (const char*)p.h2, voffA0, voffA1, (const char*)(p.wt_13 + ((size_t)e * 1024 + pn * 256) * D), D, acc);
    asm volatile("" : "+s"(mb), "+s"(pn));
    PRef pe = params_view();
    const int etid = tid_();
    const int half = half_();
    float* sCh = (float*)(smem_all + half * SMEM_BYTES);
    pg8::acc_to_lds<0, 0>(acc, false, (float*)smem_all);
    pg8::acc_to_lds<0, 1>(acc, false, (float*)(smem_all + SMEM_BYTES));
    __syncthreads();
    moe1_epilogue(pe, mb * MOE_BLK, 2 * pn + half, sCh, etid);
    __syncthreads();
    pg8::acc_to_lds<1, 0>(acc, false, (float*)smem_all);
    pg8::acc_to_lds<1, 1>(acc, false, (float*)(smem_all + SMEM_BYTES));
    __syncthreads();
    moe1_epilogue(pe, mb * MOE_BLK + 128, 2 * pn + half, sCh, etid);
    __syncthreads();
    ok = okn; mb = mbn; pn = pnn; e = en;
    voffA0[0] = n0[0]; voffA0[1] = n0[1]; voffA1[0] = n1[0]; voffA1[1] = n1[1];
  }
}
__device__ __forceinline__ void phase_moe2(PRef p, int layer, char* smem_all) {
  LAS3 unsigned char* lds = (LAS3 unsigned char*)smem_all;
  const bf16_t* actp = p.act;
  const bf16_t* w2p = p.wt_2;
  bf16_t* yp = p.ysl;
  const MoeMap mm = moe_map_build(p.cnt);
  auto lookup = [&](int mb, int& e) { int lb, ce; return moe_map_lookup(mm, mb, e, lb, ce); };
  pg8::gemm_stream<true>(lds, 512,
    [&](int ui, pg8::UnitAB& u) {
      const int L = pg8::unit_linear(ui);
      const int mb = L >> 2, pn = L & 3;
      int e;
      if (mb >= MAX_MBLK || !lookup(mb, e)) return false;
      u.a = (const char*)(actp + (size_t)mb * MOE_BLK * 512);
      u.b = (const char*)(w2p + ((size_t)e * 1024 + pn * 256) * 512);
      return true;
    },
    [&](int ui, const pg8::f32x4 (&acc)[2][2][4][2]) {
      const int L = pg8::unit_linear(ui);
      const int mb = L >> 2, pn = L & 3;
      bf16_t* ydst = yp + (size_t)mb * MOE_BLK * D + pn * 256;
      pg8::for_each_piece(acc, [&](int row, int col, float (&v)[8]) { st_nt16(ydst + (size_t)row * D + col, pack8(v)); });
    });
}

struct AttnState { f32x16 negm; f32x16 L; };
__device__ __forceinline__ void attn_qk(const char* sK, const bf16x8 (&bq)[4], const f32x16& negm, f32x16 (&S)[2], int r, int hh) {
  const int pr = 16 * (r >> 4) + 8 * ((r >> 2) & 1) + 4 * ((r >> 3) & 1) + (r & 3);
  const char* kp = sK + pr * 128;
#pragma unroll
  for (int s = 0; s < 4; ++s) {
    const int co = ((2 * s + hh) ^ ((pr >> 1) & 7)) << 4;
    bf16x8 a0 = *(const bf16x8*)(kp + co);
    bf16x8 a1 = *(const bf16x8*)(kp + 4096 + co);
    if (s == 0) { S[0] = mfma32(a0, bq[0], negm); S[1] = mfma32(a1, bq[0], negm); }
    else { S[0] = mfma32(a0, bq[s], S[0]); S[1] = mfma32(a1, bq[s], S[1]); }
  }
}
template <class MaskF>
__device__ __forceinline__ float attn_softmax_pv(f32x16 (&S)[2], const char* sV, f32x16 (&O)[2], AttnState& st, bf16x8 ones, int r, int hh,
                                                 MaskF maskf, const bool FIRST) {
  maskf(S);
  float mx = S[0][0];
#pragma unroll
  for (int g = 1; g < 16; ++g) mx = fmaxf(mx, S[0][g]);
#pragma unroll
  for (int g = 0; g < 16; ++g) mx = fmaxf(mx, S[1][g]);
  {
    auto sw = __builtin_amdgcn_permlane32_swap(__float_as_uint(mx), __float_as_uint(mx), false, false);
    mx = fmaxf(__uint_as_float(sw[0]), __uint_as_float(sw[1]));
  }
  float dshift = 0.f;
  if (FIRST || __any(mx > 8.f)) {
    const float d = FIRST ? mx : fmaxf(mx, 0.f);
    dshift = d;
    const float alpha = __builtin_amdgcn_exp2f(-d);
#pragma unroll
    for (int g = 0; g < 16; ++g) {
      st.negm[g] -= d;
      S[0][g] -= d; S[1][g] -= d;
      O[0][g] *= alpha; O[1][g] *= alpha;
    }
    st.L[0] *= alpha;
  }
#pragma unroll
  for (int kb = 0; kb < 2; ++kb)
#pragma unroll
    for (int g = 0; g < 16; ++g) S[kb][g] = __builtin_amdgcn_exp2f(S[kb][g]);
  const char* vp = sV + r * 128;
  const int vsw = (r >> 1) & 7;
#pragma unroll
  for (int sp = 0; sp < 4; ++sp) {
    const int sb_ = sp >> 1, so_ = 8 * (sp & 1);
    u32x4 bpu = {pack2(S[sb_][so_], S[sb_][so_ + 1]), pack2(S[sb_][so_ + 2], S[sb_][so_ + 3]), pack2(S[sb_][so_ + 4], S[sb_][so_ + 5]),
                 pack2(S[sb_][so_ + 6], S[sb_][so_ + 7])};
    bf16x8 bp = __builtin_bit_cast(bf16x8, bpu);
#pragma unroll
    for (int db = 0; db < 2; ++db) {
      bf16x8 av = *(const bf16x8*)(vp + db * 4096 + (((2 * sp + hh) ^ vsw) << 4));
      O[db] = mfma32(av, bp, O[db]);
    }
    st.L = mfma32(ones, bp, st.L);
  }
  return dshift;
}
template <class MaskF>
__device__ __forceinline__ void attn_tile(const char* sK, const char* sV, const bf16x8 (&bq)[4], f32x16 (&O)[2], AttnState& st, bf16x8 ones,
                                          int r, int hh, MaskF maskf, const bool FIRST) {
  f32x16 S[2];
  attn_qk(sK, bq, st.negm, S, r, hh);
  (void)attn_softmax_pv(S, sV, O, st, ones, r, hh, maskf, FIRST);
}
__device__ __forceinline__ void attn_state_init(AttnState& st, bf16x8& ones, int r) {
  st.negm = zero16();
  st.L = zero16();
  const short one = (r == 0) ? (short)0x3F80 : (short)0;
  ones = (bf16x8){one, one, one, one, one, one, one, one};
}

__device__ __forceinline__ void attn_stage(const bf16_t* kg, size_t kstride, const bf16_t* vg, size_t vstride, char* sKd, char* sVd, int tid) {
  const int row = tid >> 3, u = ((tid & 7) ^ ((tid >> 4) & 7)) * 8;
#pragma unroll
  for (int i = 0; i < 2; ++i) {
    __builtin_amdgcn_global_load_lds((const unsigned*)(kg + (size_t)(row + 32 * i) * kstride + u), (LAS3 unsigned*)(sKd + tid * 16 + i * 4096), 16, 0, 0);
    __builtin_amdgcn_global_load_lds((const unsigned*)(vg + (size_t)(row + 32 * i) * vstride + u), (LAS3 unsigned*)(sVd + tid * 16 + i * 4096), 16, 0, 0);
  }
}
struct NoMask { __device__ __forceinline__ void operator()(f32x16 (&)[2]) const {} };

__device__ __forceinline__ void attn_write_out(bf16_t* dst  , const f32x16 (&O)[2], float l, int hh) {
  float lt = l + __shfl_xor(l, 32);
  float inv = 1.f / lt;
#pragma unroll
  for (int db = 0; db < 2; ++db)
#pragma unroll
    for (int g4 = 0; g4 < 4; ++g4) {
      uint2 o = make_uint2(pack2(O[db][4 * g4] * inv, O[db][4 * g4 + 1] * inv), pack2(O[db][4 * g4 + 2] * inv, O[db][4 * g4 + 3] * inv));
      *(uint2*)(dst + 32 * db + 8 * g4 + 4 * hh) = o;
    }
}

__device__ __forceinline__ void phase_attnA(PRef p, int layer, char* smem_all) {
  int tid = __builtin_amdgcn_workitem_id_x();
  asm volatile("" : "+v"(tid));
  const int lane = tid & 63, w8 = tid >> 6, w = w8 & 3, qsub = w8 >> 2, r = lane & 31, hh = lane >> 5;
  char* sK = smem_all;
  char* sV = smem_all + 32768;
  const int nitems = layer == 0 ? 544 : 512;
  const int G = (int)gridDim.x;
  for (int item = (int)__builtin_amdgcn_workgroup_id_x(); item < nitems; item += G) {
    int b, kvh, qtok0, nkt;
    if (item < 512) { b = item >> 7; kvh = (item >> 6) & 1; qtok0 = b * 4096 + (item & 63) * 64 + qsub * 32; nkt = 68; }
    else { int it = item - 512; b = it >> 3; kvh = (it >> 2) & 1; qtok0 = TLAT + b * 256 + (it & 3) * 64 + qsub * 32; nkt = 4; }
    const int head = kvh * 4 + w;
    bf16x8 bq[4];
    {
      const bf16_t* qp = p.qA + (size_t)(qtok0 + r) * 512 + head * 64 + 8 * hh;
#pragma unroll
      for (int s = 0; s < 4; ++s) bq[s] = *(const bf16x8*)(qp + 16 * s);
    }
    const bf16_t* kbase = p.kA + (size_t)(b * 2 + kvh) * PALL * 64;
    const bf16_t* vbase = p.vAT + (size_t)(b * 2 + kvh) * 64 * PALL;
    const int srow = tid >> 3, su = ((tid & 7) ^ ((tid >> 4) & 7)) * 8;
    const bf16_t* kg = kbase + (size_t)srow * 64 + su;
    const bf16_t* vg = vbase + (size_t)srow * PALL + su;
    f32x16 O[2];
    O[0] = zero16();
    O[1] = zero16();
    AttnState st;
    bf16x8 ones;
    attn_state_init(st, ones, r);
    __syncthreads();
#define ATT_STAGE(KT)                                                                                                                     \
  {                                                                                                                                       \
    __builtin_amdgcn_global_load_lds((const unsigned*)(kg + (size_t)(KT) * 4096), (LAS3 unsigned*)(sK + ((KT) & 3) * 8192 + tid * 16), 16, 0, 0); \
    __builtin_amdgcn_global_load_lds((const unsigned*)(vg + (KT) * 64), (LAS3 unsigned*)(sV + ((KT) & 3) * 8192 + tid * 16), 16, 0, 0);           \
  }
    ATT_STAGE(0);
    ATT_STAGE(1);
    dma_sync();
    f32x16 Sa[2], Sb[2];
    attn_qk(sK, bq, st.negm, Sa, r, hh);
#define ATT_STEP(KT, CUR, NXT)                                                                                              \
  {                                                                                                                         \
    if ((KT) > 0) dma_sync();                \
    if ((KT) + 2 < nkt) ATT_STAGE((KT) + 2);                                                                                \
    if ((KT) + 1 < nkt) attn_qk(sK + (((KT) + 1) & 3) * 8192, bq, st.negm, NXT, r, hh);                                     \
    const float d_ = attn_softmax_pv(CUR, sV + ((KT) & 3) * 8192, O, st, ones, r, hh, NoMask(), (KT) == 0);                 \
    if ((KT) + 1 < nkt && __any(d_ != 0.f)) {      \
      _Pragma("unroll") for (int g = 0; g < 16; ++g) { NXT[0][g] -= d_; NXT[1][g] -= d_; }                                  \
    }                                                                                                                       \
  }
    for (int kt = 0; kt < nkt; kt += 2) {
      ATT_STEP(kt, Sa, Sb);
      ATT_STEP(kt + 1, Sb, Sa);
    }
#undef ATT_STEP
#undef ATT_STAGE
    attn_write_out(p.oA + (size_t)(qtok0 + r) * 512 + head * 64, O, st.L[0], hh);
  }
}

struct NaMask {
  const float* bp;
  int cofs;
  bool on;
  __device__ __forceinline__ void operator()(f32x16 (&S)[2]) const {
    if (!on) return;
    f32x16 bv[2];
#pragma unroll
    for (int kb = 0; kb < 2; ++kb)
#pragma unroll
      for (int g = 0; g < 16; ++g) bv[kb][g] = bp[32 * kb + 16 * (g >> 3) + 4 * ((g >> 2) & 1) + (g & 3)];
    asm volatile("" : "+v"(bv[0]), "+v"(bv[1]));
#pragma unroll
    for (int kb = 0; kb < 2; ++kb)
#pragma unroll
      for (int g = 0; g < 16; ++g) {
        const int cc = 32 * kb + 16 * (g >> 3) + 4 * ((g >> 2) & 1) + (g & 3);
        const bool valid = (unsigned)(cc + cofs) < 16u;
        S[kb][g] = valid ? S[kb][g] + bv[kb][g] : -1e30f;
      }
  }
};
__device__ __forceinline__ void phase_na(PRef p, int layer, char* smem) {
  const int tid = tid_(), lane = tid & 63, w = tid >> 6, r = lane & 31, hh = lane >> 5;
  char* sK = smem;
  char* sV = smem + 32768;
  float* sBias = (float*)(smem + 65536);
  const int nitems = layer == 0 ? 1088 : 1024;
  const int set = w >> 1, qhalf = w & 1;
  for (int item = bid_(); item < nitems; item += vgrid_()) {
    int b, hp, row = 0, rs = 0, qtok0, kt0, kt1;
    if (item < 1024) {
      b = item >> 8; row = (item >> 2) & 63; hp = item & 3;
      rs = row - 4; rs = rs < 0 ? 0 : (rs > 56 ? 56 : rs);
      qtok0 = b * 4096 + row * 64; kt0 = 0; kt1 = 12;
    } else {
      int it = item - 1024;
      b = it >> 4; hp = (it >> 2) & 3;
      qtok0 = TLAT + b * 256 + (it & 3) * 64; kt0 = 8; kt1 = 12;
    }
    const int head = 2 * hp + set;
    __syncthreads();
    for (int i = tid; i < 930; i += 256) {
      int s = i / 465, j = i % 465;
      sBias[i] = p.rpb[((size_t)layer * 8 + 2 * hp + s) * 465 + j] * LOG2E;
    }
    bf16x8 bq[4];
    {
      const bf16_t* qp = p.qC + (size_t)(qtok0 + 32 * qhalf + r) * 512 + head * 64 + 8 * hh;
#pragma unroll
      for (int s = 0; s < 4; ++s) bq[s] = *(const bf16x8*)(qp + 16 * s);
    }
    f32x16 O[2];
    O[0] = zero16();
    O[1] = zero16();
    AttnState st;
    bf16x8 ones;
    attn_state_init(st, ones, r);
#define NA_STAGE(KT, BUF)                                                                                          \
  {                                                                                                                \
    int tokK, pallb;                                                                                               \
    if ((KT) < 8) { tokK = b * 4096 + (rs + (KT)) * 64; pallb = 256 + (rs + (KT)) * 64; }                          \
    else { tokK = TLAT + b * 256 + ((KT) - 8) * 64; pallb = ((KT) - 8) * 64; }                                     \
    _Pragma("unroll") for (int s2 = 0; s2 < 2; ++s2)                                                               \
      attn_stage(p.kC + (size_t)tokK * 512 + (2 * hp + s2) * 64, 512, p.vCT + (size_t)(b * 8 + 2 * hp + s2) * 64 * PALL + pallb, PALL, \
                 sK + (BUF) * 16384 + s2 * 8192, sV + (BUF) * 16384 + s2 * 8192, tid);                             \
  }
    NA_STAGE(kt0, 0);
    for (int kt = kt0; kt < kt1; ++kt) {
      const int cur = (kt - kt0) & 1;
      dma_sync();
      if (kt + 1 < kt1) NA_STAGE(kt + 1, cur ^ 1);
      {
        NaMask mk;
        const int wq = 32 * qhalf + r;
        int cs = wq - 8;
        cs = cs < 0 ? 0 : (cs > 48 ? 48 : cs);
        mk.on = kt < 8;
        mk.bp = sBias + set * 465 + (mk.on ? (rs + kt - row + 7) * 31 : 0) - wq + 15 + 8 * hh;
        mk.cofs = 8 * hh - cs;
        attn_tile(sK + cur * 16384 + set * 8192, sV + cur * 16384 + set * 8192, bq, O, st, ones, r, hh, mk, kt == kt0);
      }
    }
#undef NA_STAGE
    attn_write_out(p.oC + (size_t)(qtok0 + 32 * qhalf + r) * 512 + head * 64, O, st.L[0], hh);
  }
}

__device__ __forceinline__ float log_sigmoidf_(float x) { return fminf(x, 0.f) - __logf(1.f + __expf(-fabsf(x))); }
struct GlaPre { f32x4v a0, a1, a2, a3, wg0, wg1; float bg; };
__device__ __forceinline__ void gla_prep_load(PRef p, int layer, int hd, int dir, int tok0, GlaPre& R) {
  const int tid = tid_(), lane = tid & 63, w = tid >> 6, r = lane & 31, hh = lane >> 5, pb = w >> 1, db = w & 1;
  const float* ap = p.aB + (size_t)(tok0 + 32 * pb + r) * 32 + dir * 16;
  R.a0 = *(const f32x4v*)(ap); R.a1 = *(const f32x4v*)(ap + 4); R.a2 = *(const f32x4v*)(ap + 8); R.a3 = *(const f32x4v*)(ap + 12);
  const float* wp = p.gla_wg + (((size_t)layer * 2 + dir) * 16 + hh) * 256 + hd * 64 + 32 * db + r;
  R.wg0 = (f32x4v){wp[0], wp[2 * 256], wp[4 * 256], wp[6 * 256]};
  R.wg1 = (f32x4v){wp[8 * 256], wp[10 * 256], wp[12 * 256], wp[14 * 256]};
  R.bg = p.gla_bg[((size_t)layer * 2 + dir) * 256 + hd * 64 + 32 * db + r];
}
#define GLA_DPP_ADD(v, ctrl, rmask) v += __builtin_bit_cast(float, __builtin_amdgcn_update_dpp(0, __builtin_bit_cast(int, v), ctrl, rmask, 0xf, false))
__device__ __forceinline__ void gla_prep_compute(const GlaPre& R, int dir, float* sBc) {
  const int tid = tid_(), lane = tid & 63, w = tid >> 6, r = lane & 31, hh = lane >> 5, pb = w >> 1, db = w & 1;
  {
    f32x16 x;
#pragma unroll
    for (int g = 0; g < 16; ++g) x[g] = R.bg;
    const float ae[8] = {R.a0[0], R.a0[2], R.a1[0], R.a1[2], R.a2[0], R.a2[2], R.a3[0], R.a3[2]};
    const float ao[8] = {R.a0[1], R.a0[3], R.a1[1], R.a1[3], R.a2[1], R.a2[3], R.a3[1], R.a3[3]};
    const float wv[8] = {R.wg0[0], R.wg0[1], R.wg0[2], R.wg0[3], R.wg1[0], R.wg1[1], R.wg1[2], R.wg1[3]};
#pragma unroll
    for (int s = 0; s < 8; ++s) x = __builtin_amdgcn_mfma_f32_32x32x2f32(hh ? ao[s] : ae[s], wv[s], x, 0, 0, 0);
#pragma unroll
    for (int g = 0; g < 16; ++g) {
      const int pos = 32 * pb + (g & 3) + 8 * (g >> 2) + 4 * hh;
      sBc[pos * 65 + 32 * db + r] = log_sigmoidf_(x[g]) * (1.f / 16.f);
    }
  }
  __syncthreads();
  {
    const int idx = dir ? 63 - lane : lane;
    float v[16];
#pragma unroll
    for (int dd = 0; dd < 16; ++dd) v[dd] = sBc[idx * 65 + w * 16 + dd];
#pragma unroll
    for (int dd = 0; dd < 16; ++dd) GLA_DPP_ADD(v[dd], 0x111, 0xf);
#pragma unroll
    for (int dd = 0; dd < 16; ++dd) GLA_DPP_ADD(v[dd], 0x112, 0xf);
#pragma unroll
    for (int dd = 0; dd < 16; ++dd) GLA_DPP_ADD(v[dd], 0x114, 0xf);
#pragma unroll
    for (int dd = 0; dd < 16; ++dd) GLA_DPP_ADD(v[dd], 0x118, 0xf);
#pragma unroll
    for (int dd = 0; dd < 16; ++dd) GLA_DPP_ADD(v[dd], 0x142, 0xa);
#pragma unroll
    for (int dd = 0; dd < 16; ++dd) GLA_DPP_ADD(v[dd], 0x143, 0xc);
#pragma unroll
    for (int dd = 0; dd < 16; ++dd) sBc[idx * 65 + w * 16 + dd] = v[dd];
  }
  __syncthreads();
}
__device__ __forceinline__ void chunk_pos(int b, int dir, int c, int& tok0, int& pall0) {
  if (c < 4) { int pc = dir ? 3 - c : c; tok0 = TLAT + b * 256 + pc * 64; pall0 = pc * 64; }
  else { int j = c - 4; int pc = dir ? 63 - j : j; tok0 = b * 4096 + pc * 64; pall0 = 256 + pc * 64; }
}
__device__ __forceinline__ void phase_gla1(PRef p, int layer, char* smem) {
  float* sWg = (float*)smem;
  float* sBc = (float*)(smem + 4096);
  bf16_t* sKt = (bf16_t*)(smem + 20736);
  bf16_t* sVt = (bf16_t*)(smem + 29952);
  const int tid = tid_(), lane = tid & 63, w = tid >> 6, r = lane & 31, hh = lane >> 5;
  for (int item = bid_(); item < 32 * NCHUNK; item += vgrid_()) {
    const int ch = item / NCHUNK, c = item % NCHUNK;
    const int dir = ch & 1, hd = (ch >> 1) & 3, b = ch >> 3;
    int tok0, pall0;
    chunk_pos(b, dir, c, tok0, pall0);
    GlaPre R;
    gla_prep_load(p, layer, hd, dir, tok0, R);
    u32x4 k0, k1, vv0, vv1, vv2, vv3;
    {
      const int pos = tid >> 2, dg = tid & 3;
      const bf16_t* kp = p.kB + (size_t)(tok0 + pos) * 256 + hd * 64 + dg * 16;
      k0 = *(const u32x4*)kp; k1 = *(const u32x4*)(kp + 8);
      const bf16_t* vb = p.vBT + (size_t)(b * 4 + hd) * 128 * PALL + pall0 + (tid & 7) * 8;
      vv0 = *(const u32x4*)(vb + (size_t)(tid >> 3) * PALL);
      vv1 = *(const u32x4*)(vb + (size_t)((tid >> 3) + 32) * PALL);
      vv2 = *(const u32x4*)(vb + (size_t)((tid >> 3) + 64) * PALL);
      vv3 = *(const u32x4*)(vb + (size_t)((tid >> 3) + 96) * PALL);
    }
    __syncthreads();
    gla_prep_compute(R, dir, sBc);
    {
      const int pos = tid >> 2, dg = tid & 3;
      float* bd = p.bcum + (size_t)item * 4096 + pos * 64 + dg * 16;
#pragma unroll
      for (int q4 = 0; q4 < 4; ++q4)
        *(float4*)(bd + 4 * q4) = make_float4(sBc[pos * 65 + dg * 16 + 4 * q4], sBc[pos * 65 + dg * 16 + 4 * q4 + 1], sBc[pos * 65 + dg * 16 + 4 * q4 + 2], sBc[pos * 65 + dg * 16 + 4 * q4 + 3]);
    }
    {
      int pos = tid >> 2, dg = tid & 3;
      unsigned ku[8] = {k0[0], k0[1], k0[2], k0[3], k1[0], k1[1], k1[2], k1[3]};
#pragma unroll
      for (int e = 0; e < 16; ++e) {
        int d = dg * 16 + e;
        float kv = bf2f((bf16_t)((e & 1) ? (ku[e >> 1] >> 16) : (ku[e >> 1] & 0xffff)));
        float bend = sBc[(dir ? 0 : 63) * 65 + d];
        sKt[d * 72 + pos] = f2bf(kv * __expf(bend - sBc[pos * 65 + d]));
      }
      {
        const int dv = tid >> 3, cc = tid & 7;
        *(u32x4*)(sVt + dv * 72 + cc * 8) = vv0;
        *(u32x4*)(sVt + (dv + 32) * 72 + cc * 8) = vv1;
        *(u32x4*)(sVt + (dv + 64) * 72 + cc * 8) = vv2;
        *(u32x4*)(sVt + (dv + 96) * 72 + cc * 8) = vv3;
      }
      if (tid < 64) p.decay[(size_t)item * 64 + tid] = __expf(sBc[(dir ? 0 : 63) * 65 + tid]);
    }
    __syncthreads();
    f32x16 acc[2];
    acc[0] = zero16();
    acc[1] = zero16();
#pragma unroll
    for (int s = 0; s < 4; ++s) {
      bf16x8 a = *(const bf16x8*)(sVt + (32 * w + r) * 72 + 16 * s + 8 * hh);
      bf16x8 b0 = *(const bf16x8*)(sKt + r * 72 + 16 * s + 8 * hh);
      bf16x8 b1 = *(const bf16x8*)(sKt + (32 + r) * 72 + 16 * s + 8 * hh);
      acc[0] = mfma32(b0, a, acc[0]);
      acc[1] = mfma32(b1, a, acc[1]);
    }
    float* dst = p.KVt + (size_t)item * 8192 + (32 * w + r) * 64 + 4 * hh;
#pragma unroll
    for (int jb = 0; jb < 2; ++jb)
#pragma unroll
      for (int g4 = 0; g4 < 4; ++g4)
        *(float4*)(dst + 32 * jb + 8 * g4) = make_float4(acc[jb][4 * g4], acc[jb][4 * g4 + 1], acc[jb][4 * g4 + 2], acc[jb][4 * g4 + 3]);
  }
}
__device__ __forceinline__ void phase_gla2(PRef p) {
  for (int idx = bid_() * 256 + tid_(); idx < 32 * 8192; idx += vgrid_() * 256) {
    const int ch = idx >> 13, e = idx & 8191;
    float S = 0.f;
    const float* kv = p.KVt + (size_t)ch * NCHUNK * 8192 + e;
    const float* dc = p.decay + (size_t)ch * NCHUNK * 64 + (e & 63);
    bf16_t* sp = p.SP + (size_t)ch * NCHUNK * 8192 + e;
#pragma unroll 1
    for (int c0 = 0; c0 < NCHUNK; c0 += 17) {
      float kvv[17], dcv[17];
#pragma unroll
      for (int j = 0; j < 17; ++j) { kvv[j] = kv[(size_t)(c0 + j) * 8192]; dcv[j] = dc[(c0 + j) * 64]; }
#pragma unroll
      for (int j = 0; j < 17; ++j) { sp[(size_t)(c0 + j) * 8192] = f2bf(S); S = dcv[j] * S + kvv[j]; }
    }
  }
}
__device__ __forceinline__ void phase_gla3(PRef p, int layer, char* smem) {
  float* sWg = (float*)smem;
  float* sBc = (float*)(smem + 4096);
  bf16_t* sQ = (bf16_t*)(smem + 20736);
  bf16_t* sK = (bf16_t*)(smem + 29952);
  bf16_t* sVt = (bf16_t*)(smem + 39168);
  float* sRed = (float*)(smem + 57600);
  const int tid = tid_(), lane = tid & 63, w = tid >> 6, r = lane & 31, hh = lane >> 5;
  const int npc = layer == 0 ? 68 : 64;
  const int pr = 16 * (r >> 4) + 8 * ((r >> 2) & 1) + 4 * ((r >> 3) & 1) + (r & 3);
  for (int item = bid_(); item < 16 * npc; item += vgrid_()) {
    const int bh = item / npc;
    const int pca = (layer == 0) ? (item % npc) : (4 + item % npc);
    const int b = bh >> 2, hd = bh & 3;
    int tok0, pall0;
    chunk_pos(b, 0, pca, tok0, pall0);
    f32x16 O[2];
    O[0] = zero16();
    O[1] = zero16();
    const int c0 = pca, c1 = (pca < 4) ? 3 - pca : 4 + (63 - (pca - 4));
    f32x4v bA[4], bB[4];
    u32x4 q0, q1, k0, k1, vv0, vv1, vv2, vv3;
    {
      const int pos = tid >> 2, dg = tid & 3;
      const float* b0p = p.bcum + ((size_t)((b * 4 + hd) * 2 + 0) * NCHUNK + c0) * 4096 + pos * 64 + dg * 16;
      const float* b1p = p.bcum + ((size_t)((b * 4 + hd) * 2 + 1) * NCHUNK + c1) * 4096 + pos * 64 + dg * 16;
#pragma unroll
      for (int q4 = 0; q4 < 4; ++q4) { bA[q4] = *(const f32x4v*)(b0p + 4 * q4); bB[q4] = *(const f32x4v*)(b1p + 4 * q4); }
      const bf16_t* qp = p.qB + (size_t)(tok0 + pos) * 256 + hd * 64 + dg * 16;
      const bf16_t* kp = p.kB + (size_t)(tok0 + pos) * 256 + hd * 64 + dg * 16;
      q0 = *(const u32x4*)qp; q1 = *(const u32x4*)(qp + 8);
      k0 = *(const u32x4*)kp; k1 = *(const u32x4*)(kp + 8);
      const bf16_t* vb = p.vBT + (size_t)(b * 4 + hd) * 128 * PALL + pall0 + (tid & 7) * 8;
      vv0 = *(const u32x4*)(vb + (size_t)(tid >> 3) * PALL);
      vv1 = *(const u32x4*)(vb + (size_t)((tid >> 3) + 32) * PALL);
      vv2 = *(const u32x4*)(vb + (size_t)((tid >> 3) + 64) * PALL);
      vv3 = *(const u32x4*)(vb + (size_t)((tid >> 3) + 96) * PALL);
    }
    typedef unsigned u32x2v __attribute__((ext_vector_type(2)));
    u32x2v rrv[2][4];
#pragma unroll
    for (int tb = 0; tb < 2; ++tb)
#pragma unroll
      for (int g4 = 0; g4 < 4; ++g4)
        rrv[tb][g4] = *(const u32x2v*)(p.rB + (size_t)(tok0 + 32 * tb + r) * 512 + hd * 128 + 32 * w + 8 * g4 + 4 * hh);
    __syncthreads();
    {
      const int dv = tid >> 3, cc = tid & 7;
      *(u32x4*)(sVt + dv * 72 + cc * 8) = vv0;
      *(u32x4*)(sVt + (dv + 32) * 72 + cc * 8) = vv1;
      *(u32x4*)(sVt + (dv + 64) * 72 + cc * 8) = vv2;
      *(u32x4*)(sVt + (dv + 96) * 72 + cc * 8) = vv3;
    }
#pragma unroll
    for (int dir = 0; dir < 2; ++dir) {
      if (dir == 1) __syncthreads();
      {
        int pos = tid >> 2, dg = tid & 3;
        unsigned qu[8] = {q0[0], q0[1], q0[2], q0[3], q1[0], q1[1], q1[2], q1[3]};
        unsigned ku[8] = {k0[0], k0[1], k0[2], k0[3], k1[0], k1[1], k1[2], k1[3]};
        unsigned qo[8], ko[8];
#pragma unroll
        for (int e2 = 0; e2 < 8; ++e2) {
          const float b0 = dir ? bB[e2 >> 1][(2 * e2) & 3] : bA[e2 >> 1][(2 * e2) & 3];
          const float b1 = dir ? bB[e2 >> 1][(2 * e2 + 1) & 3] : bA[e2 >> 1][(2 * e2 + 1) & 3];
          const float ea0 = __expf(b0), ea1 = __expf(b1), ia0 = __builtin_amdgcn_rcpf(ea0), ia1 = __builtin_amdgcn_rcpf(ea1);
          qo[e2] = pack2(bf2f((bf16_t)(qu[e2] & 0xffff)) * ea0, bf2f((bf16_t)(qu[e2] >> 16)) * ea1);
          ko[e2] = pack2(bf2f((bf16_t)(ku[e2] & 0xffff)) * ia0, bf2f((bf16_t)(ku[e2] >> 16)) * ia1);
        }
        *(uint4*)(sQ + pos * 72 + dg * 16) = make_uint4(qo[0], qo[1], qo[2], qo[3]);
        *(uint4*)(sQ + pos * 72 + dg * 16 + 8) = make_uint4(qo[4], qo[5], qo[6], qo[7]);
        *(uint4*)(sK + pos * 72 + dg * 16) = make_uint4(ko[0], ko[1], ko[2], ko[3]);
        *(uint4*)(sK + pos * 72 + dg * 16 + 8) = make_uint4(ko[4], ko[5], ko[6], ko[7]);
      }
      __syncthreads();
      const int c = dir ? c1 : c0;
      const int ch = (b * 4 + hd) * 2 + dir;
      const bf16_t* sp = p.SP + ((size_t)ch * NCHUNK + c) * 8192 + (size_t)(32 * w + r) * 64 + 8 * hh;
      bf16x8 bqf[2][4];
#pragma unroll
      for (int tb = 0; tb < 2; ++tb)
#pragma unroll
        for (int ks = 0; ks < 4; ++ks) bqf[tb][ks] = *(const bf16x8*)(sQ + (32 * tb + r) * 72 + 16 * ks + 8 * hh);
#pragma unroll
      for (int ks = 0; ks < 4; ++ks) {
        bf16x8 a = *(const bf16x8*)(sp + 16 * ks);
        O[0] = mfma32(a, bqf[0][ks], O[0]);
        O[1] = mfma32(a, bqf[1][ks], O[1]);
      }
#pragma unroll
      for (int sb = 0; sb < 2; ++sb)
#pragma unroll
        for (int tb = 0; tb < 2; ++tb) {
          const bool skip = dir == 0 ? (sb == 1 && tb == 0) : (sb == 0 && tb == 1);
          if (skip) continue;
          f32x16 Sc = zero16();
#pragma unroll
          for (int ks = 0; ks < 4; ++ks) {
            bf16x8 a = *(const bf16x8*)(sK + (32 * sb + pr) * 72 + 16 * ks + 8 * hh);
            Sc = mfma32(a, bqf[tb][ks], Sc);
          }
          const int t = 32 * tb + r;
#pragma unroll
          for (int g = 0; g < 16; ++g) {
            int s = 32 * sb + 16 * (g >> 3) + 4 * ((g >> 2) & 1) + (g & 3) + 8 * hh;
            bool keep = dir == 0 ? (t >= s) : (s >= t);
            Sc[g] = keep ? Sc[g] : 0.f;
          }
#pragma unroll
          for (int s2 = 0; s2 < 2; ++s2) {
            const int sp4 = 2 * sb + s2;
            u32x4 bpu = {pack2(Sc[8 * s2], Sc[8 * s2 + 1]), pack2(Sc[8 * s2 + 2], Sc[8 * s2 + 3]), pack2(Sc[8 * s2 + 4], Sc[8 * s2 + 5]),
                         pack2(Sc[8 * s2 + 6], Sc[8 * s2 + 7])};
            bf16x8 bp = __builtin_bit_cast(bf16x8, bpu);
            bf16x8 av = *(const bf16x8*)(sVt + (32 * w + r) * 72 + 16 * sp4 + 8 * hh);
            O[tb] = mfma32(av, bp, O[tb]);
          }
        }
    }
    float ss[2];
#pragma unroll
    for (int tb = 0; tb < 2; ++tb) {
      float s = 0.f;
#pragma unroll
      for (int g = 0; g < 16; ++g) s += O[tb][g] * O[tb][g];
      s += __shfl_xor(s, 32);
      ss[tb] = s;
    }
    if (hh == 0) { sRed[w * 64 + r] = ss[0]; sRed[w * 64 + 32 + r] = ss[1]; }
    __syncthreads();
    f32x4v gnv[4];
#pragma unroll
    for (int g4 = 0; g4 < 4; ++g4) gnv[g4] = *(const f32x4v*)(p.gla_norm + layer * 128 + 32 * w + 8 * g4 + 4 * hh);
#pragma unroll
    for (int tb = 0; tb < 2; ++tb) {
      int t = 32 * tb + r;
      float tot = sRed[t] + sRed[64 + t] + sRed[128 + t] + sRed[192 + t];
      float rstd = rsqrtf(tot * (1.f / 128.f) + 1e-6f);
      const int tok = tok0 + t;
#pragma unroll
      for (int g4 = 0; g4 < 4; ++g4) {
        int dv = 32 * w + 8 * g4 + 4 * hh;
        const u32x2v rr = rrv[tb][g4];
        float rg[4] = {bf2f((bf16_t)(rr[0] & 0xffff)), bf2f((bf16_t)(rr[0] >> 16)), bf2f((bf16_t)(rr[1] & 0xffff)), bf2f((bf16_t)(rr[1] >> 16))};
        float o[4];
#pragma unroll
        for (int e = 0; e < 4; ++e) o[e] = O[tb][4 * g4 + e] * rstd * gnv[g4][e] * siluf(rg[e]);
        *(uint2*)(p.oB + (size_t)tok * 512 + hd * 128 + dv) = make_uint2(pack2(o[0], o[1]), pack2(o[2], o[3]));
      }
    }
  }
}

#define PHASE_KERNEL(name, call)                                               \
  __global__ void __launch_bounds__(512, 2) name(Params p_, int layer) {       \
    __shared__ __attribute__((aligned(16))) char smem_all[2 * SMEM_BYTES];     \
    char* smem = smem_all + half_() * SMEM_BYTES;                              \
    PRef p = params_view();                                           \
    call;                                                                      \
  }
PHASE_KERNEL(k_setup, phase_setup(p, smem))
PHASE_KERNEL(k_modreduce, phase_modreduce(p))
PHASE_KERNEL(k_convert, phase_convert(p, layer, smem))
PHASE_KERNEL(k_rowpass0, phase_rowpass0(p))
PHASE_KERNEL(k_inproj, phase_inproj(p, layer, smem_all))
PHASE_KERNEL(k_attnA, phase_attnA(p, layer, smem_all))
PHASE_KERNEL(k_na, phase_na(p, layer, smem))
PHASE_KERNEL(k_gla1, phase_gla1(p, layer, smem))
PHASE_KERNEL(k_gla2, phase_gla2(p))
PHASE_KERNEL(k_gla3, phase_gla3(p, layer, smem))
PHASE_KERNEL(k_merge, phase_merge(p, layer, smem_all))
PHASE_KERNEL(k_outproj, phase_outproj(p, layer, smem_all))
PHASE_KERNEL(k_rowpass1, phase_rowpass1(p, layer, smem))
PHASE_KERNEL(k_moescan, phase_moescan(p, layer, smem))
PHASE_KERNEL(k_moe1, phase_moe1(p, layer, smem_all))
PHASE_KERNEL(k_moe2, phase_moe2(p, layer, smem_all))
PHASE_KERNEL(k_rowpass2, phase_rowpass2(p, layer))

#define XB_TMO      128
#define XB_XCNT(j)  (256  + 64 * (j))
#define XB_XSUB(j)  (1280 + 64 * (j))
#define XB_XGEN(j)  (2304 + 64 * (j))
#define XB_TOP      3328
#define XB_TOPGEN   3392
#define XCD_BAR_WORDS 3456
#define XB_SPIN_CAP (1u << 23)
#define LAS __attribute__((address_space(3)))
__device__ __forceinline__ unsigned xb_ld(unsigned* p) { return __hip_atomic_load(p, __ATOMIC_RELAXED, __HIP_MEMORY_SCOPE_AGENT); }
__device__ __forceinline__ unsigned xb_add(unsigned* p, unsigned v) { return __hip_atomic_fetch_add(p, v, __ATOMIC_RELAXED, __HIP_MEMORY_SCOPE_AGENT); }
__device__ __forceinline__ unsigned xb_xcc_id() { return (unsigned)__builtin_amdgcn_s_getreg((3 << 11) | 20) & 0xFu; }
#define XB_SPIN(cond, bar) do { unsigned _sp = 0; while (cond) { __builtin_amdgcn_s_sleep(1); \
    if ((++_sp & 255u) == 0u) { if (xb_ld(&(bar)[XB_TMO])) break; if (_sp > XB_SPIN_CAP) { atomicAdd(&(bar)[XB_TMO], 1u); break; } } } } while (0)
struct XcdBarrier { unsigned* bar; unsigned x; volatile LAS unsigned* st; };
__device__ __forceinline__ XcdBarrier xcd_barrier_post(unsigned* bar, volatile LAS unsigned* st) {
  XcdBarrier b; b.bar = bar; b.x = xb_xcc_id(); b.st = st;
  if (__builtin_amdgcn_workitem_id_x() == 0) (void)xb_add(&bar[XB_XCNT(b.x)], 1u);
  return b;
}
__device__ __forceinline__ void xcd_barrier_complete(unsigned* bar, unsigned x, unsigned& nloc, unsigned& nx) {
  const unsigned G = gridDim.x * gridDim.y * gridDim.z;
  unsigned sum, cnt, mine, sp = 0u;
  for (;;) {
    sum = 0u; cnt = 0u; mine = 0u;
#pragma unroll
    for (unsigned j = 0; j < 16; ++j) { const unsigned c = xb_ld(&bar[XB_XCNT(j)]); sum += c; cnt += (c > 0u) ? 1u : 0u; mine = (j == x) ? c : mine; }
    if (sum == G) break;
    __builtin_amdgcn_s_sleep(1);
    if ((++sp & 255u) == 0u) { if (xb_ld(&bar[XB_TMO])) break; if (sp > XB_SPIN_CAP) { atomicAdd(&bar[XB_TMO], 1u); break; } }
  }
  nloc = mine > 0u ? mine : 1u; nx = cnt > 0u ? cnt : 1u;
}
__device__ __forceinline__ void xcd_barrier(const XcdBarrier& b) {
  asm volatile("s_waitcnt vmcnt(0)" ::: "memory");
  __syncthreads();
  if (__builtin_amdgcn_workitem_id_x() == 0) {
    unsigned* bar = b.bar;
    __builtin_amdgcn_s_waitcnt(0);
    unsigned nloc = b.st[0], nx = b.st[1];
    if (nloc == 0u) { xcd_barrier_complete(bar, b.x, nloc, nx); b.st[0] = nloc; b.st[1] = nx; }
    const unsigned old = xb_add(&bar[XB_XSUB(b.x)], 1u);
    const unsigned gen = old / nloc;
    if (old + 1u == (gen + 1u) * nloc) {
      __builtin_amdgcn_fence(__ATOMIC_RELEASE, "agent");
      asm volatile("s_waitcnt vmcnt(0)" ::: "memory");
      const unsigned og = xb_add(&bar[XB_TOP], 1u);
      const unsigned tg = og / nx;
      if (og + 1u == (tg + 1u) * nx) xb_add(&bar[XB_TOPGEN], 1u);
      else XB_SPIN(xb_ld(&bar[XB_TOPGEN]) == tg, bar);
      __builtin_amdgcn_fence(__ATOMIC_ACQUIRE, "agent");
      xb_add(&bar[XB_XGEN(b.x)], 1u);
      asm volatile("s_waitcnt vmcnt(0)" ::: "memory");
    } else {
      XB_SPIN(xb_ld(&bar[XB_XGEN(b.x)]) == gen, bar);
      __builtin_amdgcn_fence(__ATOMIC_ACQUIRE, "agent");
      asm volatile("s_waitcnt vmcnt(0)" ::: "memory");
    }
  }
  __syncthreads();
}

__global__ void __launch_bounds__(512, 2) k_mega(Params p_) {
  __shared__ __attribute__((aligned(16))) char smem_all[2 * SMEM_BYTES + 16];
  volatile LAS unsigned* st = (volatile LAS unsigned*)(smem_all + 2 * SMEM_BYTES);
  if (__builtin_amdgcn_workitem_id_x() == 0) { st[0] = 0u; st[1] = 0u; }
  __syncthreads();
  const XcdBarrier xb = xcd_barrier_post(p_.bar, st);
#pragma unroll 1
  for (int ph = 0; ph < 25; ++ph) {
    int l = (ph >= 14) ? 1 : 0;
    int q = (ph < 3) ? ph : 3 + (ph - 3) % 11;
    l = __builtin_amdgcn_readfirstlane(l);
    q = __builtin_amdgcn_readfirstlane(q);
#ifdef PROBE_MASK
    const unsigned long long pt0 = __builtin_amdgcn_s_memrealtime();
#endif
    PRef p = params_view();
    char* smem = smem_all + half_() * SMEM_BYTES;
    switch (q) {
      case 0: phase_setup(p, smem); phase_convert(p, 0, smem); break;
      case 1: phase_modreduce(p); break;
      case 2: phase_rowpass0(p); break;
      case 3: phase_inproj(p, l, smem_all); break;
      case 4: phase_gla1(p, l, smem); phase_na(p, l, smem); break;
      case 5: phase_gla2(p); phase_attnA(p, l, smem_all); break;
      case 6: phase_gla3(p, l, smem); break;
      case 7: phase_merge(p, l, smem_all); break;
      case 8: phase_outproj(p, l, smem_all); break;
      case 9: phase_rowpass1(p, l, smem); break;
      case 10: phase_moescan(p, l, smem); phase_convert(p, l | 16, smem); break;
      case 11: phase_moe1(p, l, smem_all); break;
      case 12: phase_moe2(p, l, smem_all); break;
      default: phase_rowpass2(p, l); if (l == 0) phase_convert(p, 1, smem); break;
    }
    if (ph != 24) xcd_barrier(xb);
#ifdef PROBE_MASK
    if ((PROBE_MASK >> q) & 1) {
      const unsigned long long pt1 = __builtin_amdgcn_s_memrealtime();
      while (__builtin_amdgcn_s_memrealtime() - pt1 < (pt1 - pt0)) __builtin_amdgcn_s_sleep(8);
    }
#endif
  }
}

#ifdef DIAG_STAGE
__device__ __forceinline__ unsigned dhash(unsigned s) { s ^= s >> 16; s *= 0x7feb352dU; s ^= s >> 15; s *= 0x846ca68bU; s ^= s >> 16; return s; }
__device__ __forceinline__ void diag_accum(double num, double den, double* accum, double* sred) {
  const int tid = threadIdx.x;
  __syncthreads();
  sred[tid] = num; sred[256 + tid] = den;
  __syncthreads();
  for (int o = 128; o > 0; o >>= 1) { if (tid < o) { sred[tid] += sred[tid + o]; sred[256 + tid] += sred[256 + tid + o]; } __syncthreads(); }
  if (tid == 0) { atomicAdd(&accum[0], sred[0]); atomicAdd(&accum[1], sred[256]); }
}
__device__ __forceinline__ int diag_tok(int s, int ns) {
  if (s < 8) return TLAT + (dhash(s + 77) % TCTX);
  if (s == 8) return 0; if (s == 9) return TLAT - 1; if (s == 10) return 4095; if (s == 11) return 4096;
  return dhash(s * 31 + 5) % TLAT;
}
__global__ void k_diag_zero(double* accum) { if (threadIdx.x < 32) accum[threadIdx.x] = 0.0; }
__global__ void k_diag_report(const double* accum, float* out, int n) {
  int i = blockIdx.x * 256 + threadIdx.x;
  for (; i < n; i += gridDim.x * 256) out[i] = 0.f;
  if (blockIdx.x == 0 && threadIdx.x == 0) {
    double E = 0.0;
    for (int k = 0; k < 16; ++k) {
      if (accum[2 * k + 1] > 0.0) { double e = accum[2 * k] / accum[2 * k + 1]; if (!(e == e)) e = 100.0; if (e > E) E = e; }
    }
    out[0] = (float)(4.096e7 * sqrt(E));
  }
}
__global__ void __launch_bounds__(256) k_chk_h(Params p, double* accum) {
  __shared__ double sred[512];
  __shared__ float sx[1024];
  const int tid = threadIdx.x;
  int tok = diag_tok(blockIdx.x, gridDim.x);
  const float* src = tok < TLAT ? p.x + (size_t)tok * D : p.ctx + (size_t)(tok - TLAT) * D;
  const float* cv = tok < TLAT ? p.c + (tok >> 12) * 1024 : p.c_ctx;
  double s = 0, q = 0;
  for (int i = 0; i < 1024; ++i) s += src[i];
  double mean = s / 1024;
  for (int i = 0; i < 1024; ++i) { double d = src[i] - mean; q += d * d; }
  double rstd = 1.0 / sqrt(q / 1024 + 1e-6);
  double num = 0, den = 0;
  for (int n = tid; n < 1024; n += 256) {
    double sh = p.b_mod[n], sc = p.b_mod[1024 + n];
    for (int k = 0; k < 1024; ++k) {
      double cc = cv[k]; double sl = cc / (1.0 + exp(-cc));
      sh += sl * p.w_mod[(size_t)k * NMOD + n];
      sc += sl * p.w_mod[(size_t)k * NMOD + 1024 + n];
    }
    double ref = (src[n] - mean) * rstd * (1.0 + sc) + sh;
    double got = bf2f(p.h[(size_t)tok * D + n]);
    num += (got - ref) * (got - ref); den += ref * ref;
  }
  diag_accum(num, den, accum, sred);
}
__global__ void __launch_bounds__(256) k_chk_inproj(Params p, int layer, double* accum) {
  __shared__ double sred[512];
  __shared__ float sz[3872];
  __shared__ float sh[1024];
  const int tid = threadIdx.x;
  int tok = diag_tok(blockIdx.x, gridDim.x);
  for (int i = tid; i < 1024; i += 256) sh[i] = bf2f(p.h[(size_t)tok * D + i]);
  __syncthreads();
  const float* W = p.w_in + (size_t)layer * 1024 * NIN_SRC;
  for (int j = tid; j < 3872; j += 256) {
    double a = p.b_in[layer * NIN_SRC + j];
    for (int k = 0; k < 1024; ++k) a += (double)sh[k] * W[(size_t)k * NIN_SRC + j];
    sz[j] = (float)a;
  }
  __syncthreads();
  const bool lat = tok < TLAT;
  int b, t, pall;
  if (lat) { b = tok >> 12; t = tok & 4095; pall = 256 + t; } else { int ci = tok - TLAT; b = ci >> 8; t = ci & 255; pall = t; }
  double num = 0, den = 0;
  for (int j = tid; j < 3872; j += 256) {
    double ref, got;
    if (j < 640) {
      int hb = (j >> 6) << 6, d = j & 63;
      double ss = 0;
      for (int e = 0; e < 64; ++e) ss += (double)sz[hb + e] * sz[hb + e];
      double rstd = 1.0 / sqrt(ss / 64 + 1e-6);
      const float* gn = (j < 512 ? p.q_norm : p.k_norm) + layer * 64;
      double xn = sz[j] * rstd * gn[d];
      if (lat) {
        int qd = d >> 4, f = d & 15;
        int dp = d ^ 16;
        double pn = sz[hb + dp] * rstd * gn[dp];
        double pos = (qd < 2) ? (double)(t >> 6) : (double)(t & 63);
        float inv = powf(10000.f, -(float)f / 16.f);
        float ang = (float)pos * inv;
        double cs = cos((double)ang), sn = sin((double)ang);
        double rot = (qd & 1) ? pn : -pn;
        xn = xn * cs + rot * sn;
      }
      if (j < 512) { ref = xn * QSCALE; got = bf2f(p.qA[(size_t)tok * 512 + j]); }
      else { int kvh = (j - 512) >> 6; ref = xn; got = bf2f(p.kA[((size_t)(b * 2 + kvh) * PALL + pall) * 64 + d]); }
    } else if (j < 768) { int c = j - 640; ref = sz[j]; got = bf2f(p.vAT[((size_t)(b * 2 + (c >> 6)) * 64 + (c & 63)) * PALL + pall]); }
    else if (j < 1024) { ref = sz[j] * 0.125; got = bf2f(p.qB[(size_t)tok * 256 + (j - 768)]); }
    else if (j < 1280) { ref = sz[j]; got = bf2f(p.kB[(size_t)tok * 256 + (j - 1024)]); }
    else if (j < 1792) { int c = j - 1280; ref = sz[j]; got = bf2f(p.vBT[((size_t)(b * 4 + (c >> 7)) * 128 + (c & 127)) * PALL + pall]); }
    else if (j < 2304) { ref = sz[j]; got = bf2f(p.rB[(size_t)tok * 512 + (j - 1792)]); }
    else if (j < 2336) { ref = sz[j]; got = p.aB[(size_t)tok * 32 + (j - 2304)]; }
    else if (j < 2848) { ref = sz[j] * QSCALE; got = bf2f(p.qC[(size_t)tok * 512 + (j - 2336)]); }
    else if (j < 3360) { ref = sz[j]; got = bf2f(p.kC[(size_t)tok * 512 + (j - 2848)]); }
    else { int c = j - 3360; ref = sz[j]; got = bf2f(p.vCT[((size_t)(b * 8 + (c >> 6)) * 64 + (c & 63)) * PALL + pall]); }
    num += (got - ref) * (got - ref); den += ref * ref;
  }
  diag_accum(num, den, accum, sred);
}
__global__ void __launch_bounds__(256) k_chk_attnA(Params p, int layer, double* accum) {
  __shared__ double sred[512];
  __shared__ float sp[4352];
  __shared__ float sq[64];
  __shared__ float so[64];
  const int tid = threadIdx.x;
  int tok = diag_tok(blockIdx.x >> 1, gridDim.x);
  if (layer == 1 && tok >= TLAT) tok = dhash(blockIdx.x) % TLAT;
  int head = dhash(blockIdx.x * 7 + 1) & 7, kvh = head >> 2;
  const bool lat = tok < TLAT;
  int b = lat ? tok >> 12 : (tok - TLAT) >> 8;
  int nk = lat ? PALL : 256;
  if (tid < 64) sq[tid] = bf2f(p.qA[(size_t)tok * 512 + head * 64 + tid]);
  __syncthreads();
  const bf16_t* kb = p.kA + (size_t)(b * 2 + kvh) * PALL * 64;
#pragma unroll 1
  for (int j = tid; j < nk; j += 256) {
    float s = 0.f;
#pragma unroll 1
    for (int d = 0; d < 64; ++d) s += sq[d] * bf2f(kb[(size_t)j * 64 + d]);
    sp[j] = s;
  }
  __syncthreads();
  float mx = -1e30f;
#pragma unroll 1
  for (int j = 0; j < nk; ++j) mx = fmaxf(mx, sp[j]);
  __syncthreads();
  for (int j = tid; j < nk; j += 256) sp[j] = exp2f(sp[j] - mx);
  __syncthreads();
  double num = 0, den = 0;
  if (tid < 64) {
    double l = 0, o = 0;
    const bf16_t* vb = p.vAT + ((size_t)(b * 2 + kvh) * 64 + tid) * PALL;
#pragma unroll 1
    for (int j = 0; j < nk; ++j) { l += sp[j]; o += (double)sp[j] * bf2f(vb[j]); }
    double ref = o / l, got = bf2f(p.oA[(size_t)tok * 512 + head * 64 + tid]);
    num = (got - ref) * (got - ref); den = ref * ref;
  }
  diag_accum(num, den, accum, sred);
}
__global__ void __launch_bounds__(256) k_chk_na(Params p, int layer, double* accum) {
  __shared__ double sred[512];
  __shared__ float sp[384];
  __shared__ int spos[384];
  __shared__ float sq[64];
  const int tid = threadIdx.x;
  int tok = diag_tok(blockIdx.x >> 1, gridDim.x);
  if (layer == 1 && tok >= TLAT) tok = dhash(blockIdx.x) % TLAT;
  int head = dhash(blockIdx.x * 13 + 3) & 7;
  const bool lat = tok < TLAT;
  int b = lat ? tok >> 12 : (tok - TLAT) >> 8;
  if (tid < 64) sq[tid] = bf2f(p.qC[(size_t)tok * 512 + head * 64 + tid]);
  __syncthreads();
  int nk = lat ? 384 : 256;
  for (int j = tid; j < nk; j += 256) {
    int ktok, kpall; float bias = 0.f;
    if (lat && j < 128) {
      int t = tok & 4095, r = t >> 6, w = t & 63;
      int rs = r - 4; rs = rs < 0 ? 0 : (rs > 56 ? 56 : rs);
      int cs = w - 8; cs = cs < 0 ? 0 : (cs > 48 ? 48 : cs);
      int i = j >> 4, jj = j & 15;
      int kr = rs + i, kc = cs + jj;
      ktok = b * 4096 + kr * 64 + kc; kpall = 256 + kr * 64 + kc;
      bias = p.rpb[(((size_t)layer * 8 + head) * 15 + (kr - r + 7)) * 31 + (kc - w + 15)] * LOG2E;
    } else {
      int c = lat ? j - 128 : j;
      ktok = TLAT + b * 256 + c; kpall = c;
    }
    float s = 0.f;
    for (int d = 0; d < 64; ++d) s += sq[d] * bf2f(p.kC[(size_t)ktok * 512 + head * 64 + d]);
    sp[j] = s + bias; spos[j] = kpall;
  }
  __syncthreads();
  float mx = -1e30f;
  for (int j = 0; j < nk; ++j) mx = fmaxf(mx, sp[j]);
  __syncthreads();
  for (int j = tid; j < nk; j += 256) sp[j] = exp2f(sp[j] - mx);
  __syncthreads();
  double num = 0, den = 0;
  if (tid < 64) {
    double l = 0, o = 0;
    const bf16_t* vb = p.vCT + ((size_t)(b * 8 + head) * 64 + tid) * PALL;
    for (int j = 0; j < nk; ++j) { l += sp[j]; o += (double)sp[j] * bf2f(vb[spos[j]]); }
    double ref = o / l, got = bf2f(p.oC[(size_t)tok * 512 + head * 64 + tid]);
    num = (got - ref) * (got - ref); den = ref * ref;
  }
  diag_accum(num, den, accum, sred);
}
__device__ constexpr int gla_sp(int i) { return i == 0 ? 0 : i == 1 ? 255 : i == 2 ? 256 : i == 3 ? 319 : i == 4 ? 320 : i == 5 ? 1257 : i == 6 ? 2756 : 4351; }
__global__ void __launch_bounds__(256) k_chk_gla(Params p, int layer, double* accum) {
  __shared__ double sred[512];
  __shared__ float sal[64], sqv[64], skv[64];
  __shared__ float sred2[128];
  const int tid = threadIdx.x;
  const int b = blockIdx.x >> 2, hd = blockIdx.x & 3;
  constexpr int NSP = 8;
  float osum[NSP];
#pragma unroll
  for (int i = 0; i < NSP; ++i) osum[i] = 0.f;
  for (int dir = 0; dir < 2; ++dir) {
    float S[64];
#pragma unroll
    for (int d = 0; d < 64; ++d) S[d] = 0.f;
#pragma unroll 1
    for (int step = 0; step < PALL; ++step) {
      int pall;
      if (step < 256) pall = dir ? 255 - step : step; else { int j = step - 256; pall = 256 + (dir ? 4095 - j : j); }
      int tok = pall < 256 ? TLAT + b * 256 + pall : b * 4096 + (pall - 256);
      __syncthreads();
      if (tid < 64) {
        float xv = p.gla_bg[((size_t)layer * 2 + dir) * 256 + hd * 64 + tid];
        for (int r = 0; r < 16; ++r) xv += p.aB[(size_t)tok * 32 + dir * 16 + r] * p.gla_wg[(((size_t)layer * 2 + dir) * 16 + r) * 256 + hd * 64 + tid];
        float ls = fminf(xv, 0.f) - log1pf(expf(-fabsf(xv)));
        sal[tid] = expf(ls / 16.f);
        sqv[tid] = bf2f(p.qB[(size_t)tok * 256 + hd * 64 + tid]);
        skv[tid] = bf2f(p.kB[(size_t)tok * 256 + hd * 64 + tid]);
      }
      __syncthreads();
      if (tid < 128) {
        float v = bf2f(p.vBT[((size_t)(b * 4 + hd) * 128 + tid) * PALL + pall]);
        float o = 0.f;
#pragma unroll
        for (int d = 0; d < 64; ++d) { S[d] = sal[d] * S[d] + skv[d] * v; o += sqv[d] * S[d]; }
#pragma unroll
        for (int i = 0; i < NSP; ++i) if (gla_sp(i) == pall) osum[i] += o;
      }
    }
  }
  double num = 0, den = 0;
#pragma unroll
  for (int i = 0; i < NSP; ++i) {
    if (layer == 1 && gla_sp(i) < 256) continue;
    __syncthreads();
    if (tid < 128) sred2[tid] = osum[i] * osum[i];
    __syncthreads();
    float tot = 0.f;
    for (int j = 0; j < 128; ++j) tot += sred2[j];
    if (tid < 128) {
      int pall = gla_sp(i);
      int tok = pall < 256 ? TLAT + b * 256 + pall : b * 4096 + (pall - 256);
      float rstd = 1.f / sqrtf(tot / 128.f + 1e-6f);
      float rg = bf2f(p.rB[(size_t)tok * 512 + hd * 128 + tid]);
      double ref = osum[i] * rstd * p.gla_norm[layer * 128 + tid] * (rg / (1.f + expf(-rg)));
      double got = bf2f(p.oB[(size_t)tok * 512 + hd * 128 + tid]);
      num += (got - ref) * (got - ref); den += ref * ref;
    }
  }
  diag_accum(num, den, accum, sred);
}
__global__ void __launch_bounds__(256) k_chk_merge(Params p, int layer, double* accum) {
  __shared__ double sred[512];
  const int tid = threadIdx.x;
  int tok = diag_tok(blockIdx.x, gridDim.x);
  if (layer == 1 && tok >= TLAT) tok = dhash(blockIdx.x) % TLAT;
  const float* W = p.w_in + (size_t)layer * 1024 * NIN_SRC;
  double num = 0, den = 0;
  for (int n = tid; n < 1024; n += 256) {
    double tot = 0;
    for (int br = 0; br < 3; ++br) {
      double g = p.b_in[layer * NIN_SRC + 3872 + br * 1024 + n];
      for (int k = 0; k < 1024; ++k) g += (double)bf2f(p.h[(size_t)tok * D + k]) * W[(size_t)k * NIN_SRC + 3872 + br * 1024 + n];
      g = 1.0 / (1.0 + exp(-g));
      const bf16_t* ob = br == 0 ? p.oA : (br == 1 ? p.oB : p.oC);
      const float* wb = (br == 0 ? p.w_br_attn : (br == 1 ? p.w_br_gla : p.w_br_na)) + (size_t)layer * 512 * 1024;
      double a = 0;
      for (int j = 0; j < 512; ++j) a += (double)bf2f(ob[(size_t)tok * 512 + j]) * wb[(size_t)j * 1024 + n];
      tot += g * a;
    }
    double got = bf2f(p.m[(size_t)tok * D + n]);
    num += (got - tot) * (got - tot); den += tot * tot;
  }
  diag_accum(num, den, accum, sred);
}
__global__ void __launch_bounds__(256) k_chk_x1(Params p, double* accum) {
  __shared__ double sred[512];
  __shared__ double sv[1024];
  __shared__ double sx1[1024];
  __shared__ double sst[4];
  const int tid = threadIdx.x;
  int tok = diag_tok(blockIdx.x, gridDim.x);
  const float* cv = tok < TLAT ? p.c + (tok >> 12) * 1024 : p.c_ctx;
  const float* xin = tok < TLAT ? p.x + (size_t)tok * D : p.ctx + (size_t)(tok - TLAT) * D;
  for (int n = tid; n < 1024; n += 256) {
    double y = 0, g1 = p.b_mod[2048 + n];
    for (int k = 0; k < 1024; ++k) {
      y += (double)bf2f(p.m[(size_t)tok * D + k]) * p.w_out[(size_t)k * 1024 + n];
      double cc = cv[k]; g1 += cc / (1.0 + exp(-cc)) * p.w_mod[(size_t)k * NMOD + 2048 + n];
    }
    sv[n] = 1.4142135623730951 * xin[n] + g1 * y;
  }
  __syncthreads();
  if (tid == 0) { double s = 0, q = 0; for (int i = 0; i < 1024; ++i) s += sv[i]; s /= 1024; for (int i = 0; i < 1024; ++i) q += (sv[i] - s) * (sv[i] - s); sst[0] = s; sst[1] = 1.0 / sqrt(q / 1024 + 1e-6); }
  __syncthreads();
  double num = 0, den = 0;
  for (int n = tid; n < 1024; n += 256) {
    double x1 = (sv[n] - sst[0]) * sst[1] * p.ln1_g[n] + p.ln1_b[n];
    sx1[n] = x1;
    double got = p.xres[(size_t)tok * D + n];
    num += (got - x1) * (got - x1); den += x1 * x1;
  }
  __syncthreads();
  if (tid == 0) { double s = 0, q = 0; for (int i = 0; i < 1024; ++i) s += sx1[i]; s /= 1024; for (int i = 0; i < 1024; ++i) q += (sx1[i] - s) * (sx1[i] - s); sst[2] = s; sst[3] = 1.0 / sqrt(q / 1024 + 1e-6); }
  __syncthreads();
  for (int n = tid; n < 1024; n += 256) {
    double sh = p.b_mod[3072 + n], sc = p.b_mod[4096 + n];
    for (int k = 0; k < 1024; ++k) { double cc = cv[k]; double sl = cc / (1.0 + exp(-cc)); sh += sl * p.w_mod[(size_t)k * NMOD + 3072 + n]; sc += sl * p.w_mod[(size_t)k * NMOD + 4096 + n]; }
    double h2 = (sx1[n] - sst[2]) * sst[3] * (1.0 + sc) + sh;
    double got = bf2f(p.h2[(size_t)tok * D + n]);
    num += (got - h2) * (got - h2); den += h2 * h2;
  }
  diag_accum(num, den, accum, sred);
}
__global__ void __launch_bounds__(256) k_chk_moe(Params p, int layer, int mode, double* accum) {
  __shared__ double sred[512];
  __shared__ float sh[1024];
  __shared__ float slog[36];
  __shared__ float shid[1024];
  __shared__ int se[2];
  __shared__ float sw[2];
  const int tid = threadIdx.x;
  int tok = diag_tok(blockIdx.x, gridDim.x);
  if (layer == 1 && tok >= TLAT) tok = dhash(blockIdx.x) % TLAT;
  for (int i = tid; i < 1024; i += 256) sh[i] = bf2f(p.h2[(size_t)tok * D + i]);
  __syncthreads();
  if (tid < 36) {
    double a;
    if (tid < 32) { a = p.b_re[layer * 32 + tid]; for (int k = 0; k < 1024; ++k) a += (double)sh[k] * p.w_re[((size_t)layer * 1024 + k) * 32 + tid]; }
    else { a = p.b_rg[layer * 4 + tid - 32]; for (int k = 0; k < 1024; ++k) a += (double)sh[k] * p.w_rg[((size_t)layer * 1024 + k) * 4 + tid - 32]; }
    slog[tid] = (float)a;
  }
  __syncthreads();
  if (tid == 0) {
    int grp = 0; for (int i = 1; i < 4; ++i) if (slog[32 + i] > slog[32 + grp]) grp = i;
    double gs = 0; for (int i = 0; i < 4; ++i) gs += exp((double)slog[32 + i] - slog[32 + grp]);
    double pg = 1.0 / gs;
    int i0 = 0; for (int i = 1; i < 8; ++i) if (slog[grp * 8 + i] > slog[grp * 8 + i0]) i0 = i;
    int i1 = -1; for (int i = 0; i < 8; ++i) if (i != i0 && (i1 < 0 || slog[grp * 8 + i] > slog[grp * 8 + i1])) i1 = i;
    double e1 = exp((double)slog[grp * 8 + i1] - slog[grp * 8 + i0]);
    se[0] = grp * 8 + i0; se[1] = grp * 8 + i1; sw[0] = (float)(pg / (1 + e1)); sw[1] = (float)(pg * e1 / (1 + e1));
  }
  __syncthreads();
  if (mode == 1) {
    double num = 0, den = 0;
    if (tid == 0) { den = 1.0; bool same = (p.tok_e[tok * 2] == se[0] && p.tok_e[tok * 2 + 1] == se[1]); num = same ? 0.0 : 1.0; }
    diag_accum(num, den, accum, sred);
    return;
  }
  int e0 = p.tok_e[tok * 2], e1 = p.tok_e[tok * 2 + 1];
  float w0 = p.tok_gate[tok * 2], w1 = p.tok_gate[tok * 2 + 1];
  double num = 0, den = 0;
  if (tid == 0 && e0 == se[0] && e1 == se[1]) { num += (w0 - sw[0]) * (w0 - sw[0]) + (w1 - sw[1]) * (w1 - sw[1]); }
  for (int i = tid; i < 1024; i += 256) {
    int k = i >> 9, j = i & 511, e = k ? e1 : e0;
    const float* w1p = p.w1 + ((size_t)layer * 32 + e) * 1024 * 512;
    const float* w3p = p.w3 + ((size_t)layer * 32 + e) * 1024 * 512;
    double a = 0, c = 0;
    for (int kk = 0; kk < 1024; ++kk) { a += (double)sh[kk] * w1p[(size_t)kk * 512 + j]; c += (double)sh[kk] * w3p[(size_t)kk * 512 + j]; }
    shid[i] = (float)(a / (1.0 + exp(-a)) * c);
  }
  __syncthreads();
  int s0 = p.estart[e0] * MOE_BLK + p.tok_pos[tok * 2], s1 = p.estart[e1] * MOE_BLK + p.tok_pos[tok * 2 + 1];
  for (int n = tid; n < 1024; n += 256) {
    double y = 0;
    const float* w2a = p.w2 + ((size_t)layer * 32 + e0) * 512 * 1024;
    const float* w2b = p.w2 + ((size_t)layer * 32 + e1) * 512 * 1024;
    double ya = 0, yb = 0;
    for (int j = 0; j < 512; ++j) { ya += (double)shid[j] * w2a[(size_t)j * 1024 + n]; yb += (double)shid[512 + j] * w2b[(size_t)j * 1024 + n]; }
    y = w0 * ya + w1 * yb;
    double got = w0 * bf2f(p.ysl[(size_t)s0 * D + n]) + w1 * bf2f(p.ysl[(size_t)s1 * D + n]);
    num += (got - y) * (got - y); den += y * y;
  }
  diag_accum(num, den, accum, sred);
}
__global__ void k_saverows(Params p, float* xsave, int layer) {
  int tok = diag_tok(blockIdx.x, gridDim.x);
  if (layer == 1 && tok >= TLAT) tok = dhash(blockIdx.x) % TLAT;
  for (int i = threadIdx.x; i < 1024; i += 256) xsave[(size_t)blockIdx.x * 1024 + i] = p.xres[(size_t)tok * D + i];
}
__global__ void __launch_bounds__(256) k_chk_final(Params p, int layer, const float* xsave, double* accum) {
  __shared__ double sred[512];
  __shared__ double sv[1024];
  __shared__ double sst[4];
  const int tid = threadIdx.x;
  int tok = diag_tok(blockIdx.x, gridDim.x);
  if (layer == 1 && tok >= TLAT) tok = dhash(blockIdx.x) % TLAT;
  const float* cv = tok < TLAT ? p.c + (tok >> 12) * 1024 : p.c_ctx;
  int e0 = p.tok_e[tok * 2], e1 = p.tok_e[tok * 2 + 1];
  float w0 = p.tok_gate[tok * 2], w1 = p.tok_gate[tok * 2 + 1];
  int s0 = p.estart[e0] * MOE_BLK + p.tok_pos[tok * 2], s1 = p.estart[e1] * MOE_BLK + p.tok_pos[tok * 2 + 1];
  for (int n = tid; n < 1024; n += 256) {
    double g2 = p.b_mod[layer * NMOD + 5120 + n];
    for (int k = 0; k < 1024; ++k) { double cc = cv[k]; g2 += cc / (1.0 + exp(-cc)) * p.w_mod[((size_t)layer * 1024 + k) * NMOD + 5120 + n]; }
    double y = w0 * bf2f(p.ysl[(size_t)s0 * D + n]) + w1 * bf2f(p.ysl[(size_t)s1 * D + n]);
    sv[n] = 1.4142135623730951 * xsave[(size_t)blockIdx.x * 1024 + n] + g2 * y;
  }
  __syncthreads();
  if (tid == 0) { double s = 0, q = 0; for (int i = 0; i < 1024; ++i) s += sv[i]; s /= 1024; for (int i = 0; i < 1024; ++i) q += (sv[i] - s) * (sv[i] - s); sst[0] = s; sst[1] = 1.0 / sqrt(q / 1024 + 1e-6); }
  __syncthreads();
  double num = 0, den = 0;
  for (int n = tid; n < 1024; n += 256) {
    double x2 = (sv[n] - sst[0]) * sst[1] * p.ln2_g[layer * D + n] + p.ln2_b[layer * D + n];
    sv[n] = x2;
    double got = layer == 1 ? p.out[(size_t)tok * D + n] : p.xres[(size_t)tok * D + n];
    num += (got - x2) * (got - x2); den += x2 * x2;
  }
  __syncthreads();
  if (layer == 0) {
    if (tid == 0) { double s = 0, q = 0; for (int i = 0; i < 1024; ++i) s += sv[i]; s /= 1024; for (int i = 0; i < 1024; ++i) q += (sv[i] - s) * (sv[i] - s); sst[2] = s; sst[3] = 1.0 / sqrt(q / 1024 + 1e-6); }
    __syncthreads();
    for (int n = tid; n < 1024; n += 256) {
      double sh = p.b_mod[NMOD + n], sc = p.b_mod[NMOD + 1024 + n];
      for (int k = 0; k < 1024; ++k) { double cc = cv[k]; double sl = cc / (1.0 + exp(-cc)); sh += sl * p.w_mod[((size_t)1024 + k) * NMOD + n]; sc += sl * p.w_mod[((size_t)1024 + k) * NMOD + 1024 + n]; }
      double h = (sv[n] - sst[2]) * sst[3] * (1.0 + sc) + sh;
      double got = bf2f(p.h[(size_t)tok * D + n]);
      num += (got - h) * (got - h); den += h * h;
    }
  }
  diag_accum(num, den, accum, sred);
}
#endif

static inline size_t align_up(size_t v, size_t a) { return (v + a - 1) / a * a; }

extern "C" void kernel_launch(void* const* d_in, const int* in_sizes, int n_in, void* d_out, int out_size, void* d_ws, size_t ws_size,
                              hipStream_t stream) {
  Params p{};
  const float* const* in = (const float* const*)d_in;
  p.x = in[0]; p.c = in[1]; p.ctx = in[2]; p.c_ctx = in[3]; p.w_mod = in[4]; p.b_mod = in[5]; p.w_in = in[6]; p.b_in = in[7];
  p.q_norm = in[8]; p.k_norm = in[9]; p.gla_wg = in[10]; p.gla_bg = in[11]; p.gla_norm = in[12]; p.rpb = in[13];
  p.w_br_attn = in[14]; p.w_br_gla = in[15]; p.w_br_na = in[16]; p.w_out = in[17]; p.ln1_g = in[18]; p.ln1_b = in[19];
  p.w_rg = in[20]; p.b_rg = in[21]; p.w_re = in[22]; p.b_re = in[23]; p.w1 = in[24]; p.w3 = in[25]; p.w2 = in[26];
  p.ln2_g = in[27]; p.ln2_b = in[28];
  p.out = (float*)d_out;

  char* base = (char*)d_ws;
  size_t off = 0;
  auto take = [&](size_t bytes) { char* q = base + off; off = align_up(off + bytes, 256); return q; };
  p.mod_part = (float*)take((size_t)16 * 2 * 5 * NMOD * 4);
  p.mod = (float*)take((size_t)2 * 5 * NMOD * 4);
  p.rope = (float*)take(2048 * 4);
  p.wrp = (float*)take((size_t)2 * 49152 * 4);
  p.bar = (unsigned*)take(XCD_BAR_WORDS * 4);
  p.cnt = (int*)take(32 * 4);
  p.estart = (int*)take(32 * 4);
  p.cntg = (int*)take((size_t)1088 * 32 * 4);
  p.list = (int*)take((size_t)32 * MOE_CAP * 4);
  p.tok_e = (int*)take((size_t)TALL * 2 * 4);
  p.tok_pos = (int*)take((size_t)TALL * 2 * 4);
  p.tok_gate = (float*)take((size_t)TALL * 2 * 4);
  p.wt_in = (bf16_t*)take((size_t)3968 * 1024 * 2);
  p.wt_gate = (bf16_t*)take((size_t)3072 * 1024 * 2);
  p.wt_br = (bf16_t*)take((size_t)3 * 1024 * 512 * 2);
  p.wt_out = (bf16_t*)take((size_t)1024 * 1024 * 2);
  p.wt_13 = (bf16_t*)take((size_t)32 * 1024 * 1024 * 2);
  p.wt_2 = (bf16_t*)take((size_t)32 * 1024 * 512 * 2);
  p.G = p.wt_13;
  p.xres = (float*)take((size_t)TALL * D * 4);
  p.h = (bf16_t*)take((size_t)TALL * D * 2);
  size_t r1 = off;
  p.qA = (bf16_t*)take((size_t)TALL * 512 * 2);
  p.kA = (bf16_t*)take((size_t)4 * 2 * PALL * 64 * 2);
  p.vAT = (bf16_t*)take((size_t)4 * 2 * 64 * PALL * 2);
  p.qB = (bf16_t*)take((size_t)TALL * 256 * 2);
  p.kB = (bf16_t*)take((size_t)TALL * 256 * 2);
  p.vBT = (bf16_t*)take((size_t)4 * 4 * 128 * PALL * 2);
  p.rB = (bf16_t*)take((size_t)TALL * 512 * 2);
  p.aB = (float*)take((size_t)TALL * 32 * 4);
  p.qC = (bf16_t*)take((size_t)TALL * 512 * 2);
  p.kC = (bf16_t*)take((size_t)TALL * 512 * 2);
  p.vCT = (bf16_t*)take((size_t)4 * 8 * 64 * PALL * 2);
  p.oA = (bf16_t*)take((size_t)TALL * 512 * 2);
  p.oB = (bf16_t*)take((size_t)TALL * 512 * 2);
  p.oC = (bf16_t*)take((size_t)TALL * 512 * 2);
  size_t r1_end = off;
  {
    size_t o2 = r1;
    p.act = (bf16_t*)(base + o2); o2 = align_up(o2 + (size_t)MAX_MBLK * MOE_BLK * 512 * 2, 256);
    p.ysl = (bf16_t*)(base + o2); o2 = align_up(o2 + (size_t)MAX_MBLK * MOE_BLK * 1024 * 2, 256);
    if (o2 > r1_end) off = o2;
  }
  p.KVt = (float*)take((size_t)32 * NCHUNK * 8192 * 4);
  p.SP = (bf16_t*)take((size_t)32 * NCHUNK * 8192 * 2);
  p.decay = (float*)take((size_t)32 * NCHUNK * 64 * 4);
  p.bcum = (float*)take((size_t)32 * NCHUNK * 4096 * 4);
  p.m = (bf16_t*)p.KVt;
  p.h2 = p.SP;
  if (off > ws_size) {
    fprintf(stderr, "workspace too small: need %zu have %zu\n", off, ws_size);
    return;
  }
  const dim3 blk(256);
#ifdef DIAG_STAGE
  {
    double* accum = (double*)take(64);
    float* xsave = (float*)take((size_t)64 * 1024 * 4);
    if (off > ws_size) return;
    const int G = 1024;
    const int DL = DIAG_LAYER, DS = DIAG_STAGE;
    k_diag_zero<<<1, 64, 0, stream>>>(accum);
    k_setup<<<((769 + 96) + 1) / 2, dim3(512), 0, stream>>>(p, 0);
    k_convert<<<((2048) + 1) / 2, dim3(512), 0, stream>>>(p, 0);
    k_modreduce<<<((240) + 1) / 2, dim3(512), 0, stream>>>(p, 0);
    k_rowpass0<<<((G) + 1) / 2, dim3(512), 0, stream>>>(p, 0);
    if (DS == 1 || DS == 0) k_chk_h<<<32, blk, 0, stream>>>(p, accum + 2);
    for (int l = 0; l <= DL; ++l) {
      const bool chk = (l == DL);
      k_inproj<<<((G) + 1) / 2, dim3(512), 0, stream>>>(p, l);
      if (chk && (DS == 2 || DS == 0)) k_chk_inproj<<<64, blk, 0, stream>>>(p, l, accum + 4);
      k_gla1<<<((G) + 1) / 2, dim3(512), 0, stream>>>(p, l);
      k_na<<<((1088) + 1) / 2, dim3(512), 0, stream>>>(p, l);
      if (chk && (DS == 4 || DS == 0)) k_chk_na<<<128, blk, 0, stream>>>(p, l, accum + 8);
      k_gla2<<<((G) + 1) / 2, dim3(512), 0, stream>>>(p, l);
      k_attnA<<<((1088) + 1) / 2, dim3(512), 0, stream>>>(p, l);
      if (chk && (DS == 3 || DS == 0)) k_chk_attnA<<<128, blk, 0, stream>>>(p, l, accum + 6);
      k_gla3<<<((1088) + 1) / 2, dim3(512), 0, stream>>>(p, l);
      if (chk && (DS == 5 || DS == 0)) k_chk_gla<<<16, blk, 0, stream>>>(p, l, accum + 10);
      k_merge<<<((G) + 1) / 2, dim3(512), 0, stream>>>(p, l);
      if (chk && (DS == 6 || DS == 0)) k_chk_merge<<<32, blk, 0, stream>>>(p, l, accum + 12);
      k_outproj<<<((G) + 1) / 2, dim3(512), 0, stream>>>(p, l);
      k_rowpass1<<<((G) + 1) / 2, dim3(512), 0, stream>>>(p, l);
      if (chk && l == 0 && (DS == 7 || DS == 0)) k_chk_x1<<<32, blk, 0, stream>>>(p, accum + 14);
      k_moescan<<<((32) + 1) / 2, dim3(512), 0, stream>>>(p, l);
      k_convert<<<((2048) + 1) / 2, dim3(512), 0, stream>>>(p, l | 16);
    k_moe1<<<((G) + 1) / 2, dim3(512), 0, stream>>>(p, l);
      k_moe2<<<((G) + 1) / 2, dim3(512), 0, stream>>>(p, l);
      if (chk && (DS == 8 || DS == 0)) k_chk_moe<<<32, blk, 0, stream>>>(p, l, 0, accum + 16);
      if (chk && DS == 9) k_chk_moe<<<512, blk, 0, stream>>>(p, l, 1, accum + 18);
      if (chk && (DS == 10 || DS == 0)) k_saverows<<<32, blk, 0, stream>>>(p, xsave, l);
      k_rowpass2<<<((G) + 1) / 2, dim3(512), 0, stream>>>(p, l);
      if (chk && (DS == 10 || DS == 0)) k_chk_final<<<32, blk, 0, stream>>>(p, l, xsave, accum + 20);
      if (l == 0) k_convert<<<((2048) + 1) / 2, dim3(512), 0, stream>>>(p, 1);
    }
    k_diag_report<<<1024, blk, 0, stream>>>(accum, p.out, TLAT * D);
    return;
  }
#endif
#ifdef MK_MULTI
  const int G = 1024;
  k_setup<<<((769 + 96) + 1) / 2, dim3(512), 0, stream>>>(p, 0);
  k_convert<<<((2048) + 1) / 2, dim3(512), 0, stream>>>(p, 0);
  k_modreduce<<<((240) + 1) / 2, dim3(512), 0, stream>>>(p, 0);
  k_rowpass0<<<((G) + 1) / 2, dim3(512), 0, stream>>>(p, 0);
  for (int l = 0; l < 2; ++l) {
    k_inproj<<<((G) + 1) / 2, dim3(512), 0, stream>>>(p, l);
    k_gla1<<<((G) + 1) / 2, dim3(512), 0, stream>>>(p, l);
    k_na<<<((1088) + 1) / 2, dim3(512), 0, stream>>>(p, l);
    k_gla2<<<((G) + 1) / 2, dim3(512), 0, stream>>>(p, l);
    k_attnA<<<((1088) + 1) / 2, dim3(512), 0, stream>>>(p, l);
    k_gla3<<<((1088) + 1) / 2, dim3(512), 0, stream>>>(p, l);
    k_merge<<<((G) + 1) / 2, dim3(512), 0, stream>>>(p, l);
    k_outproj<<<((G) + 1) / 2, dim3(512), 0, stream>>>(p, l);
    k_rowpass1<<<((G) + 1) / 2, dim3(512), 0, stream>>>(p, l);
    k_moescan<<<((32) + 1) / 2, dim3(512), 0, stream>>>(p, l);
    k_convert<<<((2048) + 1) / 2, dim3(512), 0, stream>>>(p, l | 16);
    k_moe1<<<((G) + 1) / 2, dim3(512), 0, stream>>>(p, l);
    k_moe2<<<((G) + 1) / 2, dim3(512), 0, stream>>>(p, l);
    k_rowpass2<<<((G) + 1) / 2, dim3(512), 0, stream>>>(p, l);
    if (l == 0) k_convert<<<((2048) + 1) / 2, dim3(512), 0, stream>>>(p, 1);
  }
#else
  static int grid_blocks = 0;
  if (!grid_blocks) {
    int dev = 0, cus = 0, per_cu = 0;
    hipGetDevice(&dev);
    hipDeviceGetAttribute(&cus, hipDeviceAttributeMultiprocessorCount, dev);
    hipOccupancyMaxActiveBlocksPerMultiprocessor(&per_cu, k_mega, 512, 0);
    per_cu = 1;
    grid_blocks = cus * per_cu;
  }
  hipMemsetAsync(p.bar, 0, XCD_BAR_WORDS * 4, stream);
  k_mega<<<dim3(grid_blocks), dim3(512), 0, stream>>>(p);
#endif
}
```

```cpp
#include <hip/hip_runtime.h>
#include <hip/hip_cooperative_groups.h>
#include <stdint.h>
#include <stdio.h>
namespace cg = cooperative_groups;

typedef unsigned short bf16_t;
typedef __attribute__((ext_vector_type(8))) short bf16x8;
typedef __attribute__((ext_vector_type(4))) short bf16x4;
typedef __attribute__((ext_vector_type(16))) float f32x16;
typedef __attribute__((ext_vector_type(4))) unsigned u32x4;
typedef __attribute__((ext_vector_type(4))) float f32x4v;

#ifndef XCD_MAP_ENABLE
#define XCD_MAP_ENABLE 0
#endif
constexpr int D = 1024;
constexpr int TLAT = 16384, TCTX = 1024, TALL = 17408, PALL = 4352;
constexpr int NIN_SRC = 6944, NMOD = 6144;
constexpr int NT_IN = 31;
constexpr int SMEM_BYTES = 69632;
constexpr int LDC = 132;
constexpr float LOG2E = 1.4426950408889634f;
constexpr float QSCALE = 0.125f * LOG2E;
constexpr float ALPHA = 1.4142135623730951f;
constexpr int NCHUNK = 68;
constexpr int MOE_CAP = TALL;
constexpr int MOE_BLK = 256;
constexpr int MAX_MBLK = 168;

struct Params {
  const float *x, *c, *ctx, *c_ctx, *w_mod, *b_mod, *w_in, *b_in, *q_norm, *k_norm, *gla_wg, *gla_bg, *gla_norm, *rpb,
      *w_br_attn, *w_br_gla, *w_br_na, *w_out, *ln1_g, *ln1_b, *w_rg, *b_rg, *w_re, *b_re, *w1, *w3, *w2, *ln2_g, *ln2_b;
  float* out;
  float *mod_part, *mod, *rope, *wrp;
  bf16_t *wt_in, *wt_gate, *wt_br, *wt_out, *wt_13, *wt_2, *G;
  float* xres;
  bf16_t *h, *h2;
  bf16_t *qA, *kA, *vAT, *qB, *kB, *vBT, *rB;
  float* aB;
  bf16_t *qC, *kC, *vCT;
  bf16_t *oA, *oB, *oC;
  float* KVt;
  float* bcum;
  bf16_t* SP;
  float* decay;
  bf16_t* m;
  bf16_t *act, *ysl;
  int *cnt, *cntg, *list, *tok_e, *tok_pos, *estart;
  float* tok_gate;
  unsigned* bar;
};

typedef const __attribute__((address_space(4))) Params& PRef;
__device__ __forceinline__ PRef params_view() {
  const __attribute__((address_space(4))) Params* pp = (const __attribute__((address_space(4))) Params*)__builtin_amdgcn_kernarg_segment_ptr();
  asm volatile("" : "+s"(pp));
  return *pp;
}

__device__ __forceinline__ int tid_() { int t = __builtin_amdgcn_workitem_id_x() & 255; asm volatile("" : "+v"(t)); return t; }
__device__ __forceinline__ int half_() { int h = __builtin_amdgcn_readfirstlane(__builtin_amdgcn_workitem_id_x() >> 8); asm volatile("" : "+s"(h)); return h; }
__device__ __forceinline__ int bid_() { int t = 2 * __builtin_amdgcn_workgroup_id_x() + half_(); asm volatile("" : "+s"(t)); return t; }
__device__ __forceinline__ int vgrid_() { return 2 * (int)gridDim.x; }
typedef __attribute__((ext_vector_type(2))) __bf16 bf16x2n;
typedef __attribute__((ext_vector_type(2))) float f32x2n;
__device__ __forceinline__ bf16_t f2bf(float f) { return __builtin_bit_cast(bf16_t, (__bf16)f); }
__device__ __forceinline__ float bf2f(bf16_t b) { return __uint_as_float(((unsigned)b) << 16); }
__device__ __forceinline__ unsigned pack2(float a, float b) {
  f32x2n v = {a, b};
  return __builtin_bit_cast(unsigned, __builtin_convertvector(v, bf16x2n));
}
__device__ __forceinline__ float wave_sum(float v) {
  int x;
  x = __builtin_amdgcn_update_dpp(0, __float_as_int(v), 0xB1, 0xf, 0xf, true);  v += __int_as_float(x);
  x = __builtin_amdgcn_update_dpp(0, __float_as_int(v), 0x4E, 0xf, 0xf, true);  v += __int_as_float(x);
  x = __builtin_amdgcn_update_dpp(0, __float_as_int(v), 0x141, 0xf, 0xf, true); v += __int_as_float(x);
  x = __builtin_amdgcn_update_dpp(0, __float_as_int(v), 0x140, 0xf, 0xf, true); v += __int_as_float(x);
  x = __builtin_amdgcn_update_dpp(0, __float_as_int(v), 0x142, 0xa, 0xf, false); v += __int_as_float(x);
  x = __builtin_amdgcn_update_dpp(0, __float_as_int(v), 0x143, 0xc, 0xf, false); v += __int_as_float(x);
  return __int_as_float(__builtin_amdgcn_readlane(__float_as_int(v), 63));
}
__device__ __forceinline__ float siluf(float x) { return x * __builtin_amdgcn_rcpf(1.f + __expf(-x)); }
__device__ __forceinline__ float sigmoidf_(float x) { return __builtin_amdgcn_rcpf(1.f + __expf(-x)); }
__device__ __forceinline__ f32x16 zero16() {
  f32x16 z;
#pragma unroll
  for (int i = 0; i < 16; ++i) z[i] = 0.f;
  return z;
}
__device__ __forceinline__ f32x16 mfma32(bf16x8 a, bf16x8 b, f32x16 c) {
  return __builtin_amdgcn_mfma_f32_32x32x16_bf16(a, b, c, 0, 0, 0);
}
__device__ __forceinline__ int tok_modrow(int tok) { return tok < TLAT ? (tok >> 12) : 4; }

__device__ __forceinline__ void phase_setup(PRef p, char* smem) {
  float* sS = (float*)smem;
  const int tid = tid_();
  for (int item = bid_(); item < 769 + 96; item += vgrid_()) {
    if (item >= 769) {
      int it = item - 769;
      int l = it / 48, chunk = it % 48;
      for (int i = tid; i < 1024; i += 256) {
        int idx = chunk * 1024 + i;
        int e = idx & 3, ln = (idx >> 2) & 63, t = (idx >> 8) & 63, nt = idx >> 14;
        int k = 16 * t + 4 * (ln >> 4) + e, n = 16 * nt + (ln & 15);
        float v = 0.f;
        if (n < 32) v = p.w_re[((size_t)l * 1024 + k) * 32 + n];
        else if (n < 36) v = p.w_rg[((size_t)l * 1024 + k) * 4 + (n - 32)];
        p.wrp[(size_t)l * 49152 + idx] = v;
      }
      continue;
    }
    if (item == 768) {
      for (int i = tid; i < 1024; i += 256) {
        int pos = i >> 4, f = i & 15;
        float inv = powf(10000.f, -(float)f / 16.f);
        float ang = (float)pos * inv;
        p.rope[i] = cosf(ang);
        p.rope[1024 + i] = sinf(ang);
      }
      continue;
    }
    int nb = item % 24, ks = (item / 24) % 16, l = item / 384;
    __syncthreads();
    for (int i = tid; i < 320; i += 256) {
      int r = i >> 6, k = ks * 64 + (i & 63);
      float cv = (r < 4) ? p.c[r * 1024 + k] : p.c_ctx[k];
      sS[i] = siluf(cv);
    }
    __syncthreads();
    int n = nb * 256 + tid;
    const float* w = p.w_mod + ((size_t)l * 1024 + ks * 64) * NMOD + n;
    float acc[5] = {0.f, 0.f, 0.f, 0.f, 0.f};
#pragma unroll
    for (int k0 = 0; k0 < 64; k0 += 32) {
      float wv[32];
#pragma unroll
      for (int k = 0; k < 32; ++k) wv[k] = w[(size_t)(k0 + k) * NMOD];
#pragma unroll
      for (int k = 0; k < 32; ++k)
#pragma unroll
        for (int r = 0; r < 5; ++r) acc[r] += sS[r * 64 + k0 + k] * wv[k];
    }
#pragma unroll
    for (int r = 0; r < 5; ++r) p.mod_part[(((size_t)ks * 2 + l) * 5 + r) * NMOD + n] = acc[r];
  }
}
__device__ __forceinline__ void phase_modreduce(PRef p) {
  for (int i = bid_() * 256 + tid_(); i < 2 * 5 * NMOD; i += vgrid_() * 256) {
    int n = i % NMOD, l = i / (5 * NMOD);
    float s = p.b_mod[l * NMOD + n];
#pragma unroll
    for (int ks = 0; ks < 16; ++ks) s += p.mod_part[(size_t)ks * 2 * 5 * NMOD + i];
    p.mod[i] = s;
  }
}

constexpr int CV_IN = 16 * 62, CV_GATE = 16 * 48, CV_BR = 8 * 16, CV_OUT = 16 * 16, CV_13 = 16 * 16, CV_2 = 8 * 16;
constexpr int CV_O1 = CV_IN, CV_O2 = CV_O1 + CV_GATE, CV_O3 = CV_O2 + 3 * CV_BR, CV_O4 = CV_O3 + CV_OUT, CV_O5 = CV_O4 + 32 * CV_13,
              CV_TOTAL = CV_O5 + 32 * CV_2;
struct ConvDesc { const float* src; int ldsrc; int ncols; bf16_t* dst; int lddst; };
__device__ __forceinline__ ConvDesc conv_desc(PRef p, int layer, int item) {
  ConvDesc d;
  d.ncols = 64;
  if (item < CV_O1) {
    int kt = item & 15, ntile = item >> 4;
    int n0 = ntile * 64, srccol;
    if (n0 < 2304) srccol = n0;
    else if (n0 < 3840) srccol = n0 + 32;
    else if (n0 == 3840) { srccol = 2304; d.ncols = 32; }
    else { srccol = 0; d.ncols = 0; }
    d.src = p.w_in + (size_t)layer * 1024 * NIN_SRC + (size_t)(kt * 64) * NIN_SRC + srccol; d.ldsrc = NIN_SRC;
    d.dst = p.wt_in + (size_t)n0 * 1024 + kt * 64; d.lddst = 1024;
  } else if (item < CV_O2) {
    int it = item - CV_O1, kt = it & 15, ntile = it >> 4;
    d.src = p.w_in + (size_t)layer * 1024 * NIN_SRC + (size_t)(kt * 64) * NIN_SRC + 3872 + ntile * 64; d.ldsrc = NIN_SRC;
    d.dst = p.wt_gate + (size_t)(ntile * 64) * 1024 + kt * 64; d.lddst = 1024;
  } else if (item < CV_O3) {
    int it = item - CV_O2, br = it / CV_BR, t = it % CV_BR, kt = t & 7, ntile = t >> 3;
    const float* s0 = (br == 0 ? p.w_br_attn : (br == 1 ? p.w_br_gla : p.w_br_na)) + (size_t)layer * 512 * 1024;
    d.src = s0 + (size_t)(kt * 64) * 1024 + ntile * 64; d.ldsrc = 1024;
    d.dst = p.wt_br + (size_t)br * 1024 * 512 + (size_t)(ntile * 64) * 512 + kt * 64; d.lddst = 512;
  } else if (item < CV_O4) {
    int it = item - CV_O3, kt = it & 15, ntile = it >> 4;
    d.src = p.w_out + (size_t)layer * 1024 * 1024 + (size_t)(kt * 64) * 1024 + ntile * 64; d.ldsrc = 1024;
    d.dst = p.wt_out + (size_t)(ntile * 64) * 1024 + kt * 64; d.lddst = 1024;
  } else if (item < CV_O5) {
    int it = item - CV_O4, e = it >> 8, t = it & 255, kt = t & 15, ntile = t >> 4;
    int j = ntile >> 1, isw3 = ntile & 1;
    d.src = (isw3 ? p.w3 : p.w1) + ((size_t)layer * 32 + e) * 1024 * 512 + (size_t)(kt * 64) * 512 + j * 64; d.ldsrc = 512;
    d.dst = p.wt_13 + (size_t)e * 1024 * 1024 + (size_t)(ntile * 64) * 1024 + kt * 64; d.lddst = 1024;
  } else {
    int it = item - CV_O5, e = it >> 7, t = it & 127, kt = t & 7, ntile = t >> 3;
    d.src = p.w2 + ((size_t)layer * 32 + e) * 512 * 1024 + (size_t)(kt * 64) * 1024 + ntile * 64; d.ldsrc = 1024;
    d.dst = p.wt_2 + (size_t)e * 1024 * 512 + (size_t)(ntile * 64) * 512 + kt * 64; d.lddst = 512;
  }
  return d;
}
__device__ __forceinline__ void conv_load8(const ConvDesc& d, int nhalf, int lane, f32x4v (&v)[8]) {
  const int kb = lane >> 3, c0 = nhalf * 32 + (lane & 7) * 4;
  const float* sp = d.src + (size_t)(kb * 8) * d.ldsrc + c0;
  const bool ok = c0 < d.ncols;
#pragma unroll
  for (int j = 0; j < 8; ++j) {
    f32x4v z = {0.f, 0.f, 0.f, 0.f};
    v[j] = ok ? *(const f32x4v*)(sp + (size_t)j * d.ldsrc) : z;
  }
}
__device__ __forceinline__ void phase_convert(PRef p, int layer_part, char* smem) {
  const int tid = tid_(), lane = tid & 63, w = tid >> 6;
  const int layer = layer_part & 15, part = layer_part >> 4;
  const int begin = part ? CV_O4 : 0, ntiles = part ? (CV_TOTAL - CV_O4) : CV_O4;
  const int nw = vgrid_() * 4;
  int wt = bid_() * 4 + w;
  if (wt >= 2 * ntiles) return;
  ConvDesc d0 = conv_desc(p, layer, begin + (wt >> 1));
  f32x4v v0[8], v1[8];
  conv_load8(d0, wt & 1, lane, v0);
  for (;;) {
    const int nwt = wt + nw;
    const bool more = nwt < 2 * ntiles;
    ConvDesc d1 = d0;
    if (more) { d1 = conv_desc(p, layer, begin + (nwt >> 1)); conv_load8(d1, nwt & 1, lane, v1); }
    {
      const int kb = lane >> 3, c0 = (wt & 1) * 32 + (lane & 7) * 4;
      bf16_t* dp = d0.dst + (size_t)c0 * d0.lddst + kb * 8;
#pragma unroll
      for (int c = 0; c < 4; ++c) {
        const uint4 o = make_uint4(pack2(v0[0][c], v0[1][c]), pack2(v0[2][c], v0[3][c]), pack2(v0[4][c], v0[5][c]), pack2(v0[6][c], v0[7][c]));
        *(uint4*)(dp + (size_t)c * d0.lddst) = o;
      }
    }
    if (!more) break;
    wt = nwt;
    d0 = d1;
#pragma unroll
    for (int j = 0; j < 8; ++j) v0[j] = v1[j];
  }
}

__device__ __forceinline__ void row_stats(const float (&v)[16], float& mean, float& rstd) {
  float s = 0.f;
#pragma unroll
  for (int i = 0; i < 16; ++i) s += v[i];
  mean = wave_sum(s) * (1.f / 1024.f);
  float q = 0.f;
#pragma unroll
  for (int i = 0; i < 16; ++i) { float d = v[i] - mean; q += d * d; }
  float var = wave_sum(q) * (1.f / 1024.f);
  rstd = rsqrtf(var + 1e-6f);
}
__device__ __forceinline__ void load_row(const float* src, int lane, float (&v)[16]) {
#pragma unroll
  for (int i = 0; i < 4; ++i) {
    float4 t = *(const float4*)(src + lane * 4 + 256 * i);
    v[4 * i] = t.x; v[4 * i + 1] = t.y; v[4 * i + 2] = t.z; v[4 * i + 3] = t.w;
  }
}
__device__ __forceinline__ void store_row(float* dst, int lane, const float (&v)[16]) {
#pragma unroll
  for (int i = 0; i < 4; ++i) *(float4*)(dst + lane * 4 + 256 * i) = make_float4(v[4 * i], v[4 * i + 1], v[4 * i + 2], v[4 * i + 3]);
}
__device__ __forceinline__ void store_row_bf(bf16_t* dst, int lane, const float (&v)[16]) {
#pragma unroll
  for (int i = 0; i < 4; ++i) {
    uint2 o = make_uint2(pack2(v[4 * i], v[4 * i + 1]), pack2(v[4 * i + 2], v[4 * i + 3]));
    *(uint2*)(dst + lane * 4 + 256 * i) = o;
  }
}
__device__ __forceinline__ void modulate_row(const float (&x)[16], const float* shift, const float* scale, int lane, float (&h)[16]) {
  float mean, rstd;
  row_stats(x, mean, rstd);
  float sh[16], sc[16];
  load_row(shift, lane, sh);
  load_row(scale, lane, sc);
#pragma unroll
  for (int i = 0; i < 16; ++i) h[i] = (x[i] - mean) * rstd * (1.f + sc[i]) + sh[i];
}

__device__ __forceinline__ void phase_rowpass0(PRef p) {
  const int lane = tid_() & 63, w = tid_() >> 6;
  for (int tok = bid_() * 4 + w; tok < TALL; tok += vgrid_() * 4) {
    const float* src = tok < TLAT ? p.x + (size_t)tok * D : p.ctx + (size_t)(tok - TLAT) * D;
    const float* md = p.mod + (size_t)tok_modrow(tok) * NMOD;
    float x[16], h[16];
    load_row(src, lane, x);
    modulate_row(x, md, md + 1024, lane, h);
    store_row_bf(p.h + (size_t)tok * D, lane, h);
  }
}

typedef __attribute__((ext_vector_type(4))) float f32x4;
__device__ __forceinline__ void phase_rowpass1(PRef p, int layer, char* smem) {
  float* sH = (float*)smem;
  float* sPart = (float*)smem;
  int* sE = (int*)(smem + 16384);
  const int tid = tid_(), lane = tid & 63, w = tid >> 6;
  const int ntok = layer == 0 ? TALL : TLAT;
  const float* lg = p.ln1_g + layer * D;
  const float* lb = p.ln1_b + layer * D;
  const float* wrp = p.wrp + (size_t)layer * 49152;
  for (int g0 = bid_() * 16; g0 < ntok; g0 += vgrid_() * 16) {
    __syncthreads();
    {
      float v[4][16];
#pragma unroll
      for (int rr = 0; rr < 4; ++rr) load_row(p.xres + (size_t)(g0 + w * 4 + rr) * D, lane, v[rr]);
      float gg[16], bb[16], sh2[16], sc2[16];
      load_row(lg, lane, gg);
      load_row(lb, lane, bb);
      {
        const float* md = p.mod + ((size_t)layer * 5 + tok_modrow(g0)) * NMOD;
        load_row(md + 3072, lane, sh2);
        load_row(md + 4096, lane, sc2);
      }
#pragma unroll
      for (int rr = 0; rr < 4; ++rr) {
        const int tok = g0 + w * 4 + rr;
        float mean, rstd;
        row_stats(v[rr], mean, rstd);
        float x1[16], h2[16];
#pragma unroll
        for (int i = 0; i < 16; ++i) x1[i] = (v[rr][i] - mean) * rstd * gg[i] + bb[i];
        store_row(p.xres + (size_t)tok * D, lane, x1);
        {
          float m2, r2;
          row_stats(x1, m2, r2);
#pragma unroll
          for (int i = 0; i < 16; ++i) h2[i] = (x1[i] - m2) * r2 * (1.f + sc2[i]) + sh2[i];
        }
        store_row_bf(p.h2 + (size_t)tok * D, lane, h2);
        store_row(sH + (w * 4 + rr) * 1028, lane, h2);
      }
    }
    __syncthreads();
    f32x4 acc0 = {0.f, 0.f, 0.f, 0.f}, acc1 = acc0, acc2 = acc0;
    {
      const float* ap = sH + (lane & 15) * 1028 + 4 * (lane >> 4) + 256 * w;
      const float* bp = wrp + (size_t)(16 * w) * 256 + lane * 4;
#pragma unroll 8
      for (int t = 0; t < 16; ++t) {
        float4 a = *(const float4*)(ap + 16 * t);
        float4 b0 = *(const float4*)(bp + t * 256);
        float4 b1 = *(const float4*)(bp + t * 256 + 16384);
        float4 b2 = *(const float4*)(bp + t * 256 + 32768);
        acc0 = __builtin_amdgcn_mfma_f32_16x16x4f32(a.x, b0.x, acc0, 0, 0, 0);
        acc1 = __builtin_amdgcn_mfma_f32_16x16x4f32(a.x, b1.x, acc1, 0, 0, 0);
        acc2 = __builtin_amdgcn_mfma_f32_16x16x4f32(a.x, b2.x, acc2, 0, 0, 0);
        acc0 = __builtin_amdgcn_mfma_f32_16x16x4f32(a.y, b0.y, acc0, 0, 0, 0);
        acc1 = __builtin_amdgcn_mfma_f32_16x16x4f32(a.y, b1.y, acc1, 0, 0, 0);
        acc2 = __builtin_amdgcn_mfma_f32_16x16x4f32(a.y, b2.y, acc2, 0, 0, 0);
        acc0 = __builtin_amdgcn_mfma_f32_16x16x4f32(a.z, b0.z, acc0, 0, 0, 0);
        acc1 = __builtin_amdgcn_mfma_f32_16x16x4f32(a.z, b1.z, acc1, 0, 0, 0);
        acc2 = __builtin_amdgcn_mfma_f32_16x16x4f32(a.z, b2.z, acc2, 0, 0, 0);
        acc0 = __builtin_amdgcn_mfma_f32_16x16x4f32(a.w, b0.w, acc0, 0, 0, 0);
        acc1 = __builtin_amdgcn_mfma_f32_16x16x4f32(a.w, b1.w, acc1, 0, 0, 0);
        acc2 = __builtin_amdgcn_mfma_f32_16x16x4f32(a.w, b2.w, acc2, 0, 0, 0);
      }
    }
    __syncthreads();
#pragma unroll
    for (int g = 0; g < 4; ++g) {
      const int row = (lane >> 4) * 4 + g, col = lane & 15;
      sPart[(w * 16 + row) * 48 + col] = acc0[g];
      sPart[(w * 16 + row) * 48 + 16 + col] = acc1[g];
      sPart[(w * 16 + row) * 48 + 32 + col] = acc2[g];
    }
    __syncthreads();
    if (tid < 16) {
      int tok = g0 + tid;
      const float* l0 = sPart + tid * 48;
      float g[4];
#pragma unroll
      for (int i = 0; i < 4; ++i) g[i] = ((l0[32 + i] + l0[768 + 32 + i]) + (l0[1536 + 32 + i] + l0[2304 + 32 + i])) + p.b_rg[layer * 4 + i];
      int grp = 0;
      float gm = g[0];
#pragma unroll
      for (int i = 1; i < 4; ++i) if (g[i] > gm) { gm = g[i]; grp = i; }
      float gs = 0.f;
#pragma unroll
      for (int i = 0; i < 4; ++i) gs += __expf(g[i] - gm);
      float pg = 1.f / gs;
      float sv[8];
#pragma unroll
      for (int i = 0; i < 8; ++i) {
        const int c = grp * 8 + i;
        sv[i] = ((l0[c] + l0[768 + c]) + (l0[1536 + c] + l0[2304 + c])) + p.b_re[layer * 32 + c];
      }
      int i0 = 0;
      float v0 = sv[0];
#pragma unroll
      for (int i = 1; i < 8; ++i) if (sv[i] > v0) { v0 = sv[i]; i0 = i; }
      int i1 = -1;
      float v1 = -3.0e38f;
#pragma unroll
      for (int i = 0; i < 8; ++i) if (i != i0 && sv[i] > v1) { v1 = sv[i]; i1 = i; }
      float e1 = __expf(v1 - v0);
      float w0 = pg / (1.f + e1), w1 = pg * e1 / (1.f + e1);
      int ex0 = grp * 8 + i0, ex1 = grp * 8 + i1;
      sE[tid * 2] = ex0; sE[tid * 2 + 1] = ex1;
      p.tok_e[tok * 2] = ex0; p.tok_e[tok * 2 + 1] = ex1;
      p.tok_gate[tok * 2] = w0; p.tok_gate[tok * 2 + 1] = w1;
    }
    __syncthreads();
    if (tid < 32) {
      int c = 0;
#pragma unroll 8
      for (int i = 0; i < 32; ++i) c += (sE[i] == tid) ? 1 : 0;
      p.cntg[(size_t)(g0 >> 4) * 32 + tid] = c;
      const int mine = sE[tid];
      int rk = 0;
      for (int i = 0; i < (tid & ~1); ++i) rk += (sE[i] == mine) ? 1 : 0;
      p.tok_pos[(g0 + (tid >> 1)) * 2 + (tid & 1)] = rk;
    }
  }
}

__device__ __forceinline__ void phase_moescan(PRef p, int layer, char* smem) {
  int* sOff = (int*)smem;
  int* sScan = sOff + 1280;
  const int tid = tid_();
  const int e = bid_();
  if (e >= 32) return;
  const int ntok = layer == 0 ? TALL : TLAT;
  const int ng = ntok >> 4;
  __syncthreads();
  int loc[5], s = 0;
#pragma unroll
  for (int i = 0; i < 5; ++i) {
    const int g = tid * 5 + i;
    loc[i] = g < ng ? p.cntg[(size_t)g * 32 + e] : 0;
    s += loc[i];
  }
  sScan[tid] = s;
  __syncthreads();
  for (int o = 1; o < 256; o <<= 1) {
    int v = tid >= o ? sScan[tid - o] : 0;
    __syncthreads();
    sScan[tid] += v;
    __syncthreads();
  }
  int run = sScan[tid] - s;
#pragma unroll
  for (int i = 0; i < 5; ++i) { sOff[tid * 5 + i] = run; run += loc[i]; }
  if (tid == 255) p.cnt[e] = sScan[255];
  __syncthreads();
  typedef int i32x2v __attribute__((ext_vector_type(2)));
  for (int base = 0; base < ntok; base += 2048) {
    i32x2v te[8], tp[8];
#pragma unroll
    for (int u = 0; u < 8; ++u) {
      const int tok = base + u * 256 + tid;
      const int tc = tok < ntok ? tok : 0;
      te[u] = *(const i32x2v*)(p.tok_e + tc * 2);
      tp[u] = *(const i32x2v*)(p.tok_pos + tc * 2);
      if (tok >= ntok) te[u] = (i32x2v){-1, -1};
    }
#pragma unroll
    for (int u = 0; u < 8; ++u) {
      const int tok = base + u * 256 + tid;
      if (te[u][0] == e) { const int pos = sOff[tok >> 4] + tp[u][0]; p.list[e * MOE_CAP + pos] = tok; p.tok_pos[tok * 2] = pos; }
      if (te[u][1] == e) { const int pos = sOff[tok >> 4] + tp[u][1]; p.list[e * MOE_CAP + pos] = tok; p.tok_pos[tok * 2 + 1] = pos; }
    }
  }
}

__device__ __forceinline__ void phase_rowpass2(PRef p, int layer) {
  const int lane = tid_() & 63, w = tid_() >> 6;
  const bool last = layer == 1;
  const int ntok = last ? TLAT : TALL;
  const float* lg = p.ln2_g + layer * D;
  const float* lb = p.ln2_b + layer * D;
  const int stride = vgrid_() * 4;
  for (int tokA = bid_() * 4 + w; tokA < ntok; tokA += 2 * stride) {
    const bool hasB = tokA + stride < ntok;
    int tk[2];
    tk[0] = tokA; tk[1] = hasB ? tokA + stride : tokA;
    int s0[2], s1[2];
    float w0[2], w1[2];
#pragma unroll
    for (int u = 0; u < 2; ++u) {
      const int t = tk[u];
      const int e0 = p.tok_e[t * 2], e1 = p.tok_e[t * 2 + 1];
      s0[u] = p.estart[e0] * MOE_BLK + p.tok_pos[t * 2];
      s1[u] = p.estart[e1] * MOE_BLK + p.tok_pos[t * 2 + 1];
      w0[u] = p.tok_gate[t * 2]; w1[u] = p.tok_gate[t * 2 + 1];
    }
    float x1[2][16], g2[2][16];
    uint2 ya[2][4], yb[2][4];
#pragma unroll
    for (int u = 0; u < 2; ++u) {
      const int t = tk[u];
      load_row(p.xres + (size_t)t * D, lane, x1[u]);
      load_row(p.mod + ((size_t)layer * 5 + tok_modrow(t)) * NMOD + 5120, lane, g2[u]);
      const bf16_t* y0 = p.ysl + (size_t)s0[u] * D;
      const bf16_t* y1 = p.ysl + (size_t)s1[u] * D;
#pragma unroll
      for (int i = 0; i < 4; ++i) { ya[u][i] = *(const uint2*)(y0 + lane * 4 + 256 * i); yb[u][i] = *(const uint2*)(y1 + lane * 4 + 256 * i); }
    }
    float gg[16], bb[16];
    load_row(lg, lane, gg);
    load_row(lb, lane, bb);
#pragma unroll
    for (int u = 0; u < 2; ++u) {
      if (u == 1 && !hasB) break;
      const int tok = tk[u];
      float v[16], x2[16];
#pragma unroll
      for (int i = 0; i < 4; ++i) {
        const uint2 a = ya[u][i], b = yb[u][i];
        float fa[4] = {bf2f(a.x & 0xffff), bf2f(a.x >> 16), bf2f(a.y & 0xffff), bf2f(a.y >> 16)};
        float fb[4] = {bf2f(b.x & 0xffff), bf2f(b.x >> 16), bf2f(b.y & 0xffff), bf2f(b.y >> 16)};
#pragma unroll
        for (int e = 0; e < 4; ++e) v[4 * i + e] = ALPHA * x1[u][4 * i + e] + g2[u][4 * i + e] * (w0[u] * fa[e] + w1[u] * fb[e]);
      }
      float mean, rstd;
      row_stats(v, mean, rstd);
#pragma unroll
      for (int i = 0; i < 16; ++i) x2[i] = (v[i] - mean) * rstd * gg[i] + bb[i];
      if (last) {
        store_row(p.out + (size_t)tok * D, lane, x2);
      } else {
        store_row(p.xres + (size_t)tok * D, lane, x2);
        const float* mdn = p.mod + ((size_t)(layer + 1) * 5 + tok_modrow(tok)) * NMOD;
        float h[16];
        modulate_row(x2, mdn, mdn + 1024, lane, h);
        store_row_bf(p.h + (size_t)tok * D, lane, h);
      }
    }
  }
}

struct Ptr4 { const bf16_t* p[4]; };

template <int NJ>
__device__ __forceinline__ void gemm_compute_tile(const char* cA, const char* cB, int r, int hh, f32x16 (&acc)[2][NJ]) {
#pragma unroll
  for (int s = 0; s < 4; ++s) {
    const int co = ((2 * s + hh) ^ ((r >> 1) & 7)) << 4;
    bf16x8 a0 = *(const bf16x8*)(cA + co);
    bf16x8 a1 = *(const bf16x8*)(cA + 4096 + co);
    bf16x8 b[NJ];
#pragma unroll
    for (int j = 0; j < NJ; ++j) b[j] = *(const bf16x8*)(cB + j * 4096 + co);
#pragma unroll
    for (int j = 0; j < NJ; ++j) {
      acc[0][j] = mfma32(a0, b[j], acc[0][j]);
      acc[1][j] = mfma32(a1, b[j], acc[1][j]);
    }
  }
}
#define LAS3 __attribute__((address_space(3)))
__device__ __forceinline__ void dma_sync() { asm volatile("s_waitcnt vmcnt(0)" ::: "memory"); __syncthreads(); }
template <int NJ>
__device__ __forceinline__ void g_stage(const Ptr4& ap, const Ptr4& bp, int kt, char* dA, char* dB) {
#pragma unroll
  for (int i = 0; i < 4; ++i) __builtin_amdgcn_global_load_lds((const unsigned*)(ap.p[i] + kt * 64), (LAS3 unsigned*)(dA + i * 4096), 16, 0, 0);
#pragma unroll
  for (int i = 0; i < 2 * NJ; ++i) __builtin_amdgcn_global_load_lds((const unsigned*)(bp.p[i] + kt * 64), (LAS3 unsigned*)(dB + i * 4096), 16, 0, 0);
}
template <int NJ>
__device__ __forceinline__ void gemm_mainloop(const Ptr4& ap, const Ptr4& bp, int nk, f32x16 (&acc)[2][NJ], char* smem) {
  const int tid = tid_(), lane = tid & 63, w = tid >> 6, wr = w >> 1, wc = w & 1, r = lane & 31, hh = lane >> 5;
  char* sA = smem;
  char* sB = smem + 32768;
  const int dofs = tid * 16;
  g_stage<NJ>(ap, bp, 0, sA + dofs, sB + dofs);
  dma_sync();
  const char* cA = sA + (wr * 64 + r) * 128;
  const char* cB = sB + (wc * 32 * NJ + r) * 128;
  for (int kt = 0; kt < nk; ++kt) {
    const int cur = kt & 1;
    if (kt + 1 < nk) g_stage<NJ>(ap, bp, kt + 1, sA + (cur ^ 1) * 16384 + dofs, sB + (cur ^ 1) * 16384 + dofs);
    gemm_compute_tile<NJ>(cA + cur * 16384, cB + cur * 16384, r, hh, acc);
    dma_sync();
  }
}
__device__ __forceinline__ Ptr4 rows_contig(const bf16_t* base, int ld) {
  Ptr4 q;
  const int lrow = tid_() >> 3, lch = tid_() & 7;
#pragma unroll
  for (int i = 0; i < 4; ++i) q.p[i] = base + (size_t)(lrow + 32 * i) * ld + ((lch ^ ((lrow >> 1) & 7)) * 8);
  return q;
}
__device__ __forceinline__ void acc_to_lds(const f32x16 (&acc)[2][2], float* sC) {
  const int lane = tid_() & 63, w = tid_() >> 6, wr = w >> 1, wc = w & 1, r = lane & 31, hh = lane >> 5;
#pragma unroll
  for (int i = 0; i < 2; ++i)
#pragma unroll
    for (int j = 0; j < 2; ++j)
#pragma unroll
      for (int g = 0; g < 16; ++g) {
        int row = wr * 64 + i * 32 + (g & 3) + 8 * (g >> 2) + 4 * hh, col = wc * 64 + j * 32 + r;
        sC[row * LDC + col] = acc[i][j][g];
      }
}
__device__ __forceinline__ void acc_to_lds_T(const f32x16 (&acc)[2][2], float* sC) {
  const int lane = tid_() & 63, w = tid_() >> 6, wr = w >> 1, wc = w & 1, r = lane & 31, hh = lane >> 5;
#pragma unroll
  for (int i = 0; i < 2; ++i)
#pragma unroll
    for (int j = 0; j < 2; ++j)
#pragma unroll
      for (int g4 = 0; g4 < 4; ++g4) {
        int row = wr * 64 + i * 32 + 8 * g4 + 4 * hh, col = wc * 64 + j * 32 + r;
        *(float4*)(sC + col * LDC + row) = make_float4(acc[i][j][4 * g4], acc[i][j][4 * g4 + 1], acc[i][j][4 * g4 + 2], acc[i][j][4 * g4 + 3]);
      }
}
__device__ __forceinline__ void lds_read8(const float* s, float (&v)[8]) {
  float4 a = *(const float4*)s, b = *(const float4*)(s + 4);
  v[0] = a.x; v[1] = a.y; v[2] = a.z; v[3] = a.w; v[4] = b.x; v[5] = b.y; v[6] = b.z; v[7] = b.w;
}
__device__ __forceinline__ uint4 pack8(const float (&v)[8]) {
  return make_uint4(pack2(v[0], v[1]), pack2(v[2], v[3]), pack2(v[4], v[5]), pack2(v[6], v[7]));
}
__device__ __forceinline__ void st_nt16(void* q, const uint4 v) {
  typedef unsigned nt_u32x4 __attribute__((ext_vector_type(4)));
  const nt_u32x4 t = {v.x, v.y, v.z, v.w};
  __builtin_nontemporal_store(t, (nt_u32x4*)q);
}


__device__ __forceinline__ int xcd_rounds(const char*, int nMt, int nNt) { return (nMt * nNt + vgrid_() - 1) / vgrid_(); }
__device__ __forceinline__ bool xcd_tile(const char*, int round, int nMt, int nNt, int& mt, int& nt) {
  const int item = round * vgrid_() + bid_();
  mt = item / nNt; nt = item % nNt;
  return item < nMt * nNt;
}

namespace pg8 {
constexpr int BK = 64, HALF = 128, HTB = HALF * BK * 2, STAGE_BYTES = 8 * HTB;
__device__ __forceinline__ int lds_byte(int r, int c) { const int st = (r >> 4) * 2 + (c >> 5), rr = r & 15, cc = c & 31, ob = rr * 64 + cc * 2; return st * 1024 + (ob ^ (((ob >> 9) & 1) << 5)); }
__device__ __forceinline__ void stage_rc(int b, int& R, int& C) { const int st = b / 1024, sb = b % 1024, swz = sb ^ (((sb >> 9) & 1) << 5); R = (st >> 1) * 16 + swz / 64; C = (st & 1) * 32 + (swz % 64) / 2; }
typedef float f32x4 __attribute__((ext_vector_type(4)));
__device__ __forceinline__ int perm32(int rho) { const int n = rho >> 4, i = rho & 15; return 8 * (i >> 2) + 4 * n + (i & 3); }
template <bool PERM = false>
__device__ __forceinline__ void gemm_unit(LAS3 unsigned char* lds, const char* cA0, const char* cA1, const unsigned (&voffA0)[2], const unsigned (&voffA1)[2],
                                          const char* cB, int K, f32x4 (&acc)[2][2][4][2]) {
  int tid = __builtin_amdgcn_workitem_id_x();
  asm volatile("" : "+v"(tid));
  const int wid = __builtin_amdgcn_readfirstlane(tid >> 6), lane = tid & 63, wr = wid >> 2, wc = wid & 3, fr = lane & 15, fq = lane >> 4;
  const int nt = K / BK;
  unsigned voffB[2];
#pragma unroll
  for (int i = 0; i < 2; ++i) { int R, C; stage_rc(tid * 16 + i * 8192, R, C); const int Rb = PERM ? ((R & ~31) + perm32(R & 31)) : R; voffB[i] = (unsigned)(Rb * K + C) * 2u; }
  const size_t kstep = (size_t)(BK * 2);
  const size_t hstep = (size_t)HALF * K * 2;
  const unsigned ldsw = (unsigned)wid * 1024u;
  const int aoff = lds_byte(wr * 64 + fr, fq * 8), boff = lds_byte(wc * 32 + fr, fq * 8);
#define PG8_SA(b, h) (((b) * 2 + (h)) * HTB)
#define PG8_SB(b, h) ((4 + (b) * 2 + (h)) * HTB)
#define PG8_STAGE(bufoff, gbase, voff) do { _Pragma("unroll") for (int _i = 0; _i < 2; ++_i) \
        __builtin_amdgcn_global_load_lds((const unsigned*)((const char*)(gbase) + (voff)[_i]), (LAS3 unsigned*)(lds + (bufoff) + ldsw + _i * 8192), 16, 0, 0); } while (0)
#define PG8_LDA(dst, b, h) do { _Pragma("unroll") for (int m = 0; m < 4; ++m) _Pragma("unroll") for (int k = 0; k < 2; ++k) dst[m][k] = *(const LAS3 bf16x8*)(lds + PG8_SA(b, h) + aoff + m * 2048 + k * 1024); } while (0)
#define PG8_LDB(dst, b, h) do { _Pragma("unroll") for (int n = 0; n < 2; ++n) _Pragma("unroll") for (int k = 0; k < 2; ++k) dst[n][k] = *(const LAS3 bf16x8*)(lds + PG8_SB(b, h) + boff + n * 2048 + k * 1024); } while (0)
#define PG8_MMA(ai, bj, At, Bt) do { __builtin_amdgcn_s_setprio(1); _Pragma("unroll") for (int m = 0; m < 4; ++m) _Pragma("unroll") for (int n = 0; n < 2; ++n) _Pragma("unroll") for (int k = 0; k < 2; ++k) \
        acc[ai][bj][m][n] = __builtin_amdgcn_mfma_f32_16x16x32_bf16(Bt[n][k], At[m][k], acc[ai][bj][m][n], 0, 0, 0); __builtin_amdgcn_s_setprio(0); } while (0)
#define PG8_WAIT_V(n) asm volatile("s_waitcnt vmcnt(" #n ")" ::: "memory")
#define PG8_WAIT_L(n) asm volatile("s_waitcnt lgkmcnt(" #n ")" ::: "memory")
#define PG8_BAR __builtin_amdgcn_s_barrier()
#define PG8_SCHED __builtin_amdgcn_sched_barrier(0)
#pragma unroll
  for (int a = 0; a < 2; ++a)
#pragma unroll
    for (int b = 0; b < 2; ++b)
#pragma unroll
      for (int m = 0; m < 4; ++m)
#pragma unroll
        for (int n = 0; n < 2; ++n) acc[a][b][m][n] = (f32x4){0.f, 0.f, 0.f, 0.f};
  bf16x8 At[4][2], B0[2][2], B1[2][2];
  PG8_STAGE(PG8_SB(0, 0), cB, voffB); PG8_STAGE(PG8_SA(0, 0), cA0, voffA0); PG8_STAGE(PG8_SB(0, 1), cB + hstep, voffB); PG8_STAGE(PG8_SA(0, 1), cA1, voffA1);
  if (wr == 1) PG8_BAR;
  PG8_WAIT_V(4); PG8_BAR;
  PG8_STAGE(PG8_SB(1, 0), cB + kstep, voffB); PG8_STAGE(PG8_SA(1, 0), cA0 + kstep, voffA0); PG8_STAGE(PG8_SB(1, 1), cB + hstep + kstep, voffB);
  PG8_WAIT_V(6); PG8_BAR;
  for (int t = 0; t < nt; t += 2) {
    const bool last = (t == nt - 2);
    const size_t o1 = (size_t)(t + 1) * kstep;
    const size_t o2 = last ? 0 : (size_t)(t + 2) * kstep;
    const size_t o3 = o2 + kstep;
    PG8_LDB(B0, 0, 0); PG8_SCHED; PG8_LDA(At, 0, 0); PG8_STAGE(PG8_SA(1, 1), cA1 + o1, voffA1);
    PG8_WAIT_L(8); PG8_BAR; PG8_WAIT_L(0); PG8_MMA(0, 0, At, B0); PG8_BAR; PG8_SCHED;
    PG8_LDB(B1, 0, 1); PG8_STAGE(PG8_SB(0, 0), cB + o2, voffB);
    PG8_BAR; PG8_WAIT_L(0); PG8_MMA(0, 1, At, B1); PG8_BAR;
    PG8_LDA(At, 0, 1); PG8_STAGE(PG8_SA(0, 0), cA0 + o2, voffA0);
    PG8_BAR; PG8_WAIT_L(0); PG8_MMA(1, 0, At, B0); PG8_BAR; PG8_SCHED;
    PG8_STAGE(PG8_SB(0, 1), cB + hstep + o2, voffB);
    PG8_WAIT_V(6); PG8_BAR; PG8_MMA(1, 1, At, B1); PG8_BAR;
    PG8_LDB(B0, 1, 0); PG8_SCHED; PG8_LDA(At, 1, 0); PG8_STAGE(PG8_SA(0, 1), cA1 + o2, voffA1);
    PG8_WAIT_L(8); PG8_BAR; PG8_WAIT_L(0); PG8_MMA(0, 0, At, B0); PG8_BAR; PG8_SCHED;
    PG8_LDB(B1, 1, 1); PG8_STAGE(PG8_SB(1, 0), cB + o3, voffB);
    PG8_BAR; PG8_WAIT_L(0); PG8_MMA(0, 1, At, B1); PG8_BAR;
    PG8_LDA(At, 1, 1); PG8_STAGE(PG8_SA(1, 0), cA0 + o3, voffA0);
    PG8_BAR; PG8_WAIT_L(0); PG8_MMA(1, 0, At, B0); PG8_BAR; PG8_SCHED;
    PG8_STAGE(PG8_SB(1, 1), cB + hstep + o3, voffB);
    PG8_WAIT_V(6); PG8_BAR; PG8_MMA(1, 1, At, B1); PG8_BAR;
  }
  PG8_WAIT_V(0);
  if (wr == 0) PG8_BAR;
  PG8_BAR;
#undef PG8_SA
#undef PG8_SB
#undef PG8_STAGE
#undef PG8_LDA
#undef PG8_LDB
#undef PG8_MMA
#undef PG8_WAIT_V
#undef PG8_WAIT_L
#undef PG8_BAR
#undef PG8_SCHED
}
struct UnitAB { const char* a; const char* b; };
template <bool PERM, class Prov, class Epi>
__device__ __forceinline__ void gemm_stream(LAS3 unsigned char* lds, int K, Prov prov, Epi epi) {
  int tid = __builtin_amdgcn_workitem_id_x();
  asm volatile("" : "+v"(tid));
  const int wid = __builtin_amdgcn_readfirstlane(tid >> 6), lane = tid & 63, wr = wid >> 2, wc = wid & 3, fr = lane & 15, fq = lane >> 4;
  const int nt = K / BK;
  UnitAB cur, nxt;
  if (!prov(0, cur)) return;
  unsigned voffA[2], voffB[2];
#pragma unroll
  for (int i = 0; i < 2; ++i) { int R, C; stage_rc(tid * 16 + i * 8192, R, C); const int Rb = PERM ? ((R & ~31) + perm32(R & 31)) : R;
    voffA[i] = (unsigned)(R * K + C) * 2u; voffB[i] = (unsigned)(Rb * K + C) * 2u; }
  const size_t kstep = (size_t)(BK * 2);
  const size_t hstep = (size_t)HALF * K * 2;
  const unsigned ldsw = (unsigned)wid * 1024u;
  const int aoff = lds_byte(wr * 64 + fr, fq * 8), boff = lds_byte(wc * 32 + fr, fq * 8);
#define PG8_SA(b, h) (((b) * 2 + (h)) * HTB)
#define PG8_SB(b, h) ((4 + (b) * 2 + (h)) * HTB)
#define PG8_STAGE(bufoff, gbase, voff) do { _Pragma("unroll") for (int _i = 0; _i < 2; ++_i) \
        __builtin_amdgcn_global_load_lds((const unsigned*)((const char*)(gbase) + (voff)[_i]), (LAS3 unsigned*)(lds + (bufoff) + ldsw + _i * 8192), 16, 0, 0); } while (0)
#define PG8_LDA(dst, b, h) do { _Pragma("unroll") for (int m = 0; m < 4; ++m) _Pragma("unroll") for (int k = 0; k < 2; ++k) dst[m][k] = *(const LAS3 bf16x8*)(lds + PG8_SA(b, h) + aoff + m * 2048 + k * 1024); } while (0)
#define PG8_LDB(dst, b, h) do { _Pragma("unroll") for (int n = 0; n < 2; ++n) _Pragma("unroll") for (int k = 0; k < 2; ++k) dst[n][k] = *(const LAS3 bf16x8*)(lds + PG8_SB(b, h) + boff + n * 2048 + k * 1024); } while (0)
#define PG8_MMA(ai, bj, At, Bt) do { __builtin_amdgcn_s_setprio(1); _Pragma("unroll") for (int m = 0; m < 4; ++m) _Pragma("unroll") for (int n = 0; n < 2; ++n) _Pragma("unroll") for (int k = 0; k < 2; ++k) \
        acc[ai][bj][m][n] = __builtin_amdgcn_mfma_f32_16x16x32_bf16(Bt[n][k], At[m][k], acc[ai][bj][m][n], 0, 0, 0); __builtin_amdgcn_s_setprio(0); } while (0)
#define PG8_WAIT_V(n) asm volatile("s_waitcnt vmcnt(" #n ")" ::: "memory")
#define PG8_WAIT_L(n) asm volatile("s_waitcnt lgkmcnt(" #n ")" ::: "memory")
#define PG8_BAR __builtin_amdgcn_s_barrier()
#define PG8_SCHED __builtin_amdgcn_sched_barrier(0)
#define PG8_ZERO() do { _Pragma("unroll") for (int a = 0; a < 2; ++a) _Pragma("unroll") for (int b = 0; b < 2; ++b) _Pragma("unroll") for (int m = 0; m < 4; ++m) \
        _Pragma("unroll") for (int n = 0; n < 2; ++n) acc[a][b][m][n] = (f32x4){0.f, 0.f, 0.f, 0.f}; } while (0)
  f32x4 acc[2][2][4][2];
  PG8_ZERO();
  bf16x8 At[4][2], B0[2][2], B1[2][2];
  const char* cA = cur.a; const char* cB = cur.b;
  PG8_STAGE(PG8_SB(0, 0), cB, voffB); PG8_STAGE(PG8_SA(0, 0), cA, voffA); PG8_STAGE(PG8_SB(0, 1), cB + hstep, voffB); PG8_STAGE(PG8_SA(0, 1), cA + hstep, voffA);
  if (wr == 1) PG8_BAR;
  PG8_WAIT_V(4); PG8_BAR;
  PG8_STAGE(PG8_SB(1, 0), cB + kstep, voffB); PG8_STAGE(PG8_SA(1, 0), cA + kstep, voffA); PG8_STAGE(PG8_SB(1, 1), cB + hstep + kstep, voffB);
  PG8_WAIT_V(6); PG8_BAR;
  for (int ui = 0;; ++ui) {
    const bool has_next = prov(ui + 1, nxt);
    const char* nA = has_next ? nxt.a : cA; const char* nB = has_next ? nxt.b : cB;
    for (int t = 0; t < nt; t += 2) {
      const bool last = (t == nt - 2);
      const char* a1 = cA + (size_t)(t + 1) * kstep;
      const char* a2 = last ? nA : cA + (size_t)(t + 2) * kstep; const char* b2 = last ? nB : cB + (size_t)(t + 2) * kstep;
      const char* a3 = a2 + kstep; const char* b3 = b2 + kstep;
      PG8_LDB(B0, 0, 0); PG8_SCHED; PG8_LDA(At, 0, 0); PG8_STAGE(PG8_SA(1, 1), a1 + hstep, voffA);
      PG8_WAIT_L(8); PG8_BAR; PG8_WAIT_L(0); PG8_MMA(0, 0, At, B0); PG8_BAR; PG8_SCHED;
      PG8_LDB(B1, 0, 1); PG8_STAGE(PG8_SB(0, 0), b2, voffB);
      PG8_BAR; PG8_WAIT_L(0); PG8_MMA(0, 1, At, B1); PG8_BAR;
      PG8_LDA(At, 0, 1); PG8_STAGE(PG8_SA(0, 0), a2, voffA);
      PG8_BAR; PG8_WAIT_L(0); PG8_MMA(1, 0, At, B0); PG8_BAR; PG8_SCHED;
      PG8_STAGE(PG8_SB(0, 1), b2 + hstep, voffB);
      PG8_WAIT_V(6); PG8_BAR; PG8_MMA(1, 1, At, B1); PG8_BAR;
      PG8_LDB(B0, 1, 0); PG8_SCHED; PG8_LDA(At, 1, 0); PG8_STAGE(PG8_SA(0, 1), a2 + hstep, voffA);
      PG8_WAIT_L(8); PG8_BAR; PG8_WAIT_L(0); PG8_MMA(0, 0, At, B0); PG8_BAR; PG8_SCHED;
      PG8_LDB(B1, 1, 1); PG8_STAGE(PG8_SB(1, 0), b3, voffB);
      PG8_BAR; PG8_WAIT_L(0); PG8_MMA(0, 1, At, B1); PG8_BAR;
      PG8_LDA(At, 1, 1); PG8_STAGE(PG8_SA(1, 0), a3, voffA);
      PG8_BAR; PG8_WAIT_L(0); PG8_MMA(1, 0, At, B0); PG8_BAR; PG8_SCHED;
      PG8_STAGE(PG8_SB(1, 1), b3 + hstep, voffB);
      PG8_WAIT_V(6); PG8_BAR; PG8_MMA(1, 1, At, B1); PG8_BAR;
    }
    epi(ui, acc);
    if (!has_next) break;
    PG8_ZERO();
    cA = nA; cB = nB;
  }
  PG8_WAIT_V(0);
  if (wr == 0) PG8_BAR;
  PG8_BAR;
#undef PG8_SA
#undef PG8_SB
#undef PG8_STAGE
#undef PG8_LDA
#undef PG8_LDB
#undef PG8_MMA
#undef PG8_WAIT_V
#undef PG8_WAIT_L
#undef PG8_BAR
#undef PG8_SCHED
#undef PG8_ZERO
}
__device__ __forceinline__ void voff_contig(int K, unsigned (&voff)[2]) {
  int tid = __builtin_amdgcn_workitem_id_x();
  asm volatile("" : "+v"(tid));
#pragma unroll
  for (int i = 0; i < 2; ++i) { int R, C; stage_rc(tid * 16 + i * 8192, R, C); voff[i] = (unsigned)(R * K + C) * 2u; }
}
template <int ai, int bj>
__device__ __forceinline__ void acc_to_lds(const f32x4 (&acc)[2][2][4][2], bool transposed, float* sC) {
  int tid = __builtin_amdgcn_workitem_id_x();
  asm volatile("" : "+v"(tid));
  const int wid = tid >> 6, lane = tid & 63, wr = wid >> 2, wc = wid & 3, fr = lane & 15, fq = lane >> 4;
#pragma unroll
  for (int m = 0; m < 4; ++m)
#pragma unroll
    for (int n = 0; n < 2; ++n) {
      const int row = 64 * wr + 16 * m + fr, col = 32 * wc + 16 * n + 4 * fq;
      const f32x4 v = acc[ai][bj][m][n];
      if (!transposed) *(f32x4*)(sC + row * LDC + col) = v;
      else { sC[col * LDC + row] = v[0]; sC[(col + 1) * LDC + row] = v[1]; sC[(col + 2) * LDC + row] = v[2]; sC[(col + 3) * LDC + row] = v[3]; }
    }
}
template <class F>
__device__ __forceinline__ void for_each_piece(const f32x4 (&acc)[2][2][4][2], F f) {
  int tid = __builtin_amdgcn_workitem_id_x();
  asm volatile("" : "+v"(tid));
  const int wid = tid >> 6, lane = tid & 63, wr = wid >> 2, wc = wid & 3, fr = lane & 15, fq = lane >> 4;
#pragma unroll
  for (int ai = 0; ai < 2; ++ai)
#pragma unroll
    for (int m = 0; m < 4; ++m)
#pragma unroll
      for (int bj = 0; bj < 2; ++bj) {
        const f32x4 a = acc[ai][bj][m][0], b = acc[ai][bj][m][1];
        float v[8] = {a[0], a[1], a[2], a[3], b[0], b[1], b[2], b[3]};
        f(128 * ai + 64 * wr + 16 * m + fr, 128 * bj + 32 * wc + 8 * fq, v);
      }
}
__device__ __forceinline__ int unit_linear(int i) { return i * (int)gridDim.x + (int)__builtin_amdgcn_workgroup_id_x(); }
__device__ __forceinline__ bool unit_map(int L, int nM, int nN, int& pm, int& pn) {
  const int nwg = nM * nN;
  if (L >= nwg) return false;
  int wgid = L;
  { const int q = nwg / 8, r = nwg % 8, xcd = wgid % 8, off = wgid / 8; wgid = (xcd < r ? xcd * (q + 1) : r * (q + 1) + (xcd - r) * q) + off; }
  const int nig = 8 * nN, gid = wgid / nig, fm = gid * 8, gsz = (nM - fm) < 8 ? (nM - fm) : 8;
  pm = fm + ((wgid % nig) % gsz); pn = (wgid % nig) / gsz;
  return true;
}
}

__device__ __forceinline__ bool inproj_transposed(int nt) { return (nt == 5) || (nt >= 10 && nt <= 13) || (nt >= 26 && nt <= 29); }
__device__ __forceinline__ void inproj_epilogue(PRef p, int layer, int mt, int nt, const float* sC, int tid) {
  const float* bias = p.b_in + layer * NIN_SRC;
  const bool transposed = inproj_transposed(nt);
  const int tok0 = mt * 128;
  const bool lat = tok0 < TLAT;
  int b, pos0, pall0;
  if (lat) { b = tok0 >> 12; pos0 = tok0 & 4095; pall0 = 256 + pos0; }
  else { int ci = tok0 - TLAT; b = ci >> 8; pos0 = ci & 255; pall0 = pos0; }
  const int n0 = nt * 128;
  const int srcc0 = (nt < 18) ? n0 : n0 + 32;
  if (transposed) {
    const int tc = tid & 15, cb = tid >> 4;
    float bv[8];
#pragma unroll
    for (int ps = 0; ps < 8; ++ps) bv[ps] = bias[srcc0 + ps * 16 + cb];
#pragma unroll
    for (int ps = 0; ps < 8; ++ps) {
      const int col = ps * 16 + cb;
      float v[8];
      lds_read8(sC + col * LDC + tc * 8, v);
#pragma unroll
      for (int e = 0; e < 8; ++e) v[e] += bv[ps];
      bf16_t* dst;
      if (nt == 5) dst = p.vAT + ((size_t)(b * 2 + (col >> 6)) * 64 + (col & 63)) * PALL;
      else if (nt <= 13) dst = p.vBT + ((size_t)(b * 4 + (nt - 10)) * 128 + col) * PALL;
      else dst = p.vCT + ((size_t)(b * 8 + (nt - 26) * 2 + (col >> 6)) * 64 + (col & 63)) * PALL;
      *(uint4*)(dst + pall0 + tc * 8) = pack8(v);
    }
  } else if (nt <= 4) {
    const float* gn = (nt < 4 ? p.q_norm : p.k_norm) + layer * 64;
    const float osc = nt < 4 ? QSCALE : 1.f;
    const int c8 = tid & 15, rb = tid >> 4, d0 = (c8 & 7) * 8;
    float bs[8], bp[8], g0[8], g1[8];
    {
      const float4 t0 = *(const float4*)(bias + srcc0 + c8 * 8), t1 = *(const float4*)(bias + srcc0 + c8 * 8 + 4);
      const float4 u0 = *(const float4*)(bias + srcc0 + ((c8 * 8) ^ 16)), u1 = *(const float4*)(bias + srcc0 + ((c8 * 8) ^ 16) + 4);
      const float4 a0 = *(const float4*)(gn + d0), a1 = *(const float4*)(gn + d0 + 4);
      const float4 c0 = *(const float4*)(gn + (d0 ^ 16)), c1 = *(const float4*)(gn + (d0 ^ 16) + 4);
      bs[0] = t0.x; bs[1] = t0.y; bs[2] = t0.z; bs[3] = t0.w; bs[4] = t1.x; bs[5] = t1.y; bs[6] = t1.z; bs[7] = t1.w;
      bp[0] = u0.x; bp[1] = u0.y; bp[2] = u0.z; bp[3] = u0.w; bp[4] = u1.x; bp[5] = u1.y; bp[6] = u1.z; bp[7] = u1.w;
      g0[0] = a0.x; g0[1] = a0.y; g0[2] = a0.z; g0[3] = a0.w; g0[4] = a1.x; g0[5] = a1.y; g0[6] = a1.z; g0[7] = a1.w;
      g1[0] = c0.x; g1[1] = c0.y; g1[2] = c0.z; g1[3] = c0.w; g1[4] = c1.x; g1[5] = c1.y; g1[6] = c1.z; g1[7] = c1.w;
    }
    const int qd = d0 >> 4;
    const float sgn = (qd & 1) ? 1.f : -1.f;
#pragma unroll 1
    for (int hb = 0; hb < 2; ++hb) {
      f32x4v rc0[4], rc1[4], rs0[4], rs1[4];
#pragma unroll
      for (int q = 0; q < 4; ++q) {
        const int t = pos0 + (hb * 4 + q) * 16 + rb;
        const int pp = (qd < 2) ? (t >> 6) : (t & 63);
        const float* rp = p.rope + pp * 16 + (d0 & 15);
        if (lat) { rc0[q] = *(const f32x4v*)rp; rc1[q] = *(const f32x4v*)(rp + 4); rs0[q] = *(const f32x4v*)(rp + 1024); rs1[q] = *(const f32x4v*)(rp + 1028); }
        else { rc0[q] = rc1[q] = (f32x4v){1.f, 1.f, 1.f, 1.f}; rs0[q] = rs1[q] = (f32x4v){0.f, 0.f, 0.f, 0.f}; }
      }
#pragma unroll
      for (int q = 0; q < 4; ++q) {
        const int row = (hb * 4 + q) * 16 + rb;
        float v[8], pv[8];
        lds_read8(sC + row * LDC + c8 * 8, v);
        lds_read8(sC + row * LDC + ((c8 * 8) ^ 16), pv);
        const float cs[8] = {rc0[q][0], rc0[q][1], rc0[q][2], rc0[q][3], rc1[q][0], rc1[q][1], rc1[q][2], rc1[q][3]};
        const float sn[8] = {rs0[q][0], rs0[q][1], rs0[q][2], rs0[q][3], rs1[q][0], rs1[q][1], rs1[q][2], rs1[q][3]};
        float ss = 0.f;
#pragma unroll
        for (int e = 0; e < 8; ++e) { v[e] += bs[e]; pv[e] += bp[e]; ss += v[e] * v[e]; }
        ss += __shfl_xor(ss, 1);
        ss += __shfl_xor(ss, 2);
        ss += __shfl_xor(ss, 4);
        const float rstd = rsqrtf(ss * (1.f / 64.f) + 1e-6f);
        float o[8];
#pragma unroll
        for (int e = 0; e < 8; ++e) {
          const float xn = v[e] * rstd * g0[e], pn = pv[e] * rstd * g1[e];
          o[e] = (xn * cs[e] + sgn * pn * sn[e]) * osc;
        }
        bf16_t* dst;
        if (nt < 4) dst = p.qA + (size_t)(tok0 + row) * 512 + nt * 128 + c8 * 8;
        else dst = p.kA + ((size_t)(b * 2 + (c8 >> 3)) * PALL + pall0 + row) * 64 + d0;
        *(uint4*)dst = pack8(o);
      }
    }
  } else {
    bf16_t* base;
    int ld, cofs;
    float osc = 1.f;
    if (nt <= 7) { base = p.qB; ld = 256; cofs = (nt - 6) * 128; osc = 0.125f; }
    else if (nt <= 9) { base = p.kB; ld = 256; cofs = (nt - 8) * 128; }
    else if (nt <= 17) { base = p.rB; ld = 512; cofs = (nt - 14) * 128; }
    else if (nt <= 21) { base = p.qC; ld = 512; cofs = (nt - 18) * 128; osc = QSCALE; }
    else { base = p.kC; ld = 512; cofs = (nt - 22) * 128; }
    const int c8 = tid & 15, rb = tid >> 4;
    float bs[8];
    {
      const float4 t0 = *(const float4*)(bias + srcc0 + c8 * 8), t1 = *(const float4*)(bias + srcc0 + c8 * 8 + 4);
      bs[0] = t0.x; bs[1] = t0.y; bs[2] = t0.z; bs[3] = t0.w; bs[4] = t1.x; bs[5] = t1.y; bs[6] = t1.z; bs[7] = t1.w;
    }
#pragma unroll
    for (int ps = 0; ps < 8; ++ps) {
      const int row = ps * 16 + rb;
      float v[8];
      lds_read8(sC + row * LDC + c8 * 8, v);
#pragma unroll
      for (int e = 0; e < 8; ++e) v[e] = (v[e] + bs[e]) * osc;
      *(uint4*)(base + (size_t)(tok0 + row) * ld + cofs + c8 * 8) = pack8(v);
    }
  }
}

__device__ __forceinline__ void gate_epilogue(PRef p, int layer, int mt, int nt, const float* sC, int tid) {
  const float* bias = p.b_in + layer * NIN_SRC + 3872 + nt * 128;
  const int c8 = tid & 15, rb = tid >> 4;
  float bs[8];
  {
    const float4 t0 = *(const float4*)(bias + c8 * 8), t1 = *(const float4*)(bias + c8 * 8 + 4);
    bs[0] = t0.x; bs[1] = t0.y; bs[2] = t0.z; bs[3] = t0.w; bs[4] = t1.x; bs[5] = t1.y; bs[6] = t1.z; bs[7] = t1.w;
  }
#pragma unroll
  for (int ps = 0; ps < 8; ++ps) {
    const int row = ps * 16 + rb;
    float v[8];
    lds_read8(sC + row * LDC + c8 * 8, v);
#pragma unroll
    for (int e = 0; e < 8; ++e) v[e] = sigmoidf_(v[e] + bs[e]);
    *(uint4*)(p.G + (size_t)(mt * 128 + row) * 3072 + nt * 128 + c8 * 8) = pack8(v);
  }
}
__device__ __forceinline__ void phase_inproj(PRef p, int layer, char* smem_all) {
  LAS3 unsigned char* lds = (LAS3 unsigned char*)smem_all;
  constexpr int NSTREAM_IN = 68 * 12, NSTREAM = NSTREAM_IN + 64 * 12, NOLD = 68 * 3;
  {
    unsigned voffA[2];
    pg8::voff_contig(D, voffA);
    const int G = (int)gridDim.x, c = (int)__builtin_amdgcn_workgroup_id_x();
    const int rem = NSTREAM % G;
    for (int j = (c - rem + G) % G; j < NOLD; j += G) {
      int pm, pn;
      pg8::unit_map(j, 68, 3, pm, pn);
      pg8::f32x4 acc[2][2][4][2];
      const char* a0 = (const char*)(p.h + (size_t)pm * 256 * D);
      pg8::gemm_unit(lds, a0, a0 + (size_t)128 * D * 2, voffA, voffA, (const char*)(p.wt_in + (size_t)pn * 256 * D), D, acc);
      asm volatile("" : "+s"(pm), "+s"(pn));
      PRef pe = params_view();
      const int etid = tid_();
      const int half = half_();
      float* sCh = (float*)(smem_all + half * SMEM_BYTES);
      pg8::acc_to_lds<0, 0>(acc, inproj_transposed(2 * pn), (float*)smem_all);
      pg8::acc_to_lds<0, 1>(acc, inproj_transposed(2 * pn + 1), (float*)(smem_all + SMEM_BYTES));
      __syncthreads();
      inproj_epilogue(pe, layer, 2 * pm, 2 * pn + half, sCh, etid);
      __syncthreads();
      pg8::acc_to_lds<1, 0>(acc, inproj_transposed(2 * pn), (float*)smem_all);
      pg8::acc_to_lds<1, 1>(acc, inproj_transposed(2 * pn + 1), (float*)(smem_all + SMEM_BYTES));
      __syncthreads();
      inproj_epilogue(pe, layer, 2 * pm + 1, 2 * pn + half, sCh, etid);
      __syncthreads();
    }
  }
  {
    PRef pg = params_view();
    const bf16_t* hbase = pg.h;
    const bf16_t* win = pg.wt_in;
    const bf16_t* wg = pg.wt_gate;
    const float* bias = pg.b_in + layer * NIN_SRC;
    bf16_t* gbase = pg.G;
    pg8::gemm_stream<true>(lds, D,
      [&](int ui, pg8::UnitAB& u) {
        const int s = pg8::unit_linear(ui);
        int pm, pn;
        if (s < NSTREAM_IN) {
          pg8::unit_map(s, 68, 12, pm, pn);
          pn += 3;
          const char* hr = (const char*)(hbase + (size_t)pm * 256 * D);
          const char* wr_ = (const char*)(win + (size_t)pn * 256 * D);
          const bool T = (pn == 5) || (pn == 6) || (pn >= 13);
          u.a = T ? wr_ : hr;
          u.b = T ? hr : wr_;
          return true;
        }
        if (!pg8::unit_map(s - NSTREAM_IN, 64, 12, pm, pn)) return false;
        u.a = (const char*)(hbase + (size_t)pm * 256 * D);
        u.b = (const char*)(wg + (size_t)pn * 256 * D);
        return true;
      },
      [&](int ui, const pg8::f32x4 (&acc)[2][2][4][2]) {
        const int s = pg8::unit_linear(ui);
        int lt = __builtin_amdgcn_workitem_id_x();
        asm volatile("" : "+v"(lt));
        const int wc = (lt >> 6) & 3, wr = lt >> 8, fr = lt & 15, fq = (lt & 63) >> 4;
        const int cbase = 32 * wc + 8 * fq;
        int pm, pn;
        if (s >= NSTREAM_IN) {
          pg8::unit_map(s - NSTREAM_IN, 64, 12, pm, pn);
          const float* gb = bias + 3872 + pn * 256;
          bf16_t* gdst = gbase + (size_t)pm * 256 * 3072 + pn * 256;
          const float4 ba0 = *(const float4*)(gb + cbase), ba1 = *(const float4*)(gb + cbase + 4);
          const float4 bb0 = *(const float4*)(gb + 128 + cbase), bb1 = *(const float4*)(gb + 128 + cbase + 4);
          pg8::for_each_piece(acc, [&](int row, int col, float (&v)[8]) {
            const float4 b0 = col < 128 ? ba0 : bb0, b1 = col < 128 ? ba1 : bb1;
            v[0] = sigmoidf_(v[0] + b0.x); v[1] = sigmoidf_(v[1] + b0.y); v[2] = sigmoidf_(v[2] + b0.z); v[3] = sigmoidf_(v[3] + b0.w);
            v[4] = sigmoidf_(v[4] + b1.x); v[5] = sigmoidf_(v[5] + b1.y); v[6] = sigmoidf_(v[6] + b1.z); v[7] = sigmoidf_(v[7] + b1.w);
            st_nt16(gdst + (size_t)row * 3072 + col, pack8(v));
          });
          return;
        }
        pg8::unit_map(s, 68, 12, pm, pn);
        pn += 3;
        const float* bsrc = bias + (pn < 9 ? pn * 256 : pn * 256 + 32);
        const bool T = (pn == 5) || (pn == 6) || (pn >= 13);
        if (!T) {
          bf16_t* base; int ld, cofs0; float osc = 1.f;
          if (pn == 3) { base = pg.qB; ld = 256; cofs0 = 0; osc = 0.125f; }
          else if (pn == 4) { base = pg.kB; ld = 256; cofs0 = 0; }
          else if (pn <= 8) { base = pg.rB; ld = 512; cofs0 = (pn - 7) * 256; }
          else if (pn <= 10) { base = pg.qC; ld = 512; cofs0 = (pn - 9) * 256; osc = QSCALE; }
          else { base = pg.kC; ld = 512; cofs0 = (pn - 11) * 256; }
          const float4 ba0 = *(const float4*)(bsrc + cbase), ba1 = *(const float4*)(bsrc + cbase + 4);
          const float4 bb0 = *(const float4*)(bsrc + 128 + cbase), bb1 = *(const float4*)(bsrc + 128 + cbase + 4);
          bf16_t* d0 = base + (size_t)pm * 256 * ld + cofs0;
          pg8::for_each_piece(acc, [&](int row, int col, float (&v)[8]) {
            const float4 b0 = col < 128 ? ba0 : bb0, b1 = col < 128 ? ba1 : bb1;
            v[0] = (v[0] + b0.x) * osc; v[1] = (v[1] + b0.y) * osc; v[2] = (v[2] + b0.z) * osc; v[3] = (v[3] + b0.w) * osc;
            v[4] = (v[4] + b1.x) * osc; v[5] = (v[5] + b1.y) * osc; v[6] = (v[6] + b1.z) * osc; v[7] = (v[7] + b1.w) * osc;
            st_nt16(d0 + (size_t)row * ld + col, pack8(v));
          });
        } else {
          bf16_t* tb; int f0;
          if (pn <= 6) { tb = pg.vBT; f0 = (pn - 5) * 256; } else { tb = pg.vCT; f0 = (pn - 13) * 256; }
          const int tok0 = pm * 256;
          int b, pall0;
          if (tok0 < TLAT) { b = tok0 >> 12; pall0 = 256 + (tok0 & 4095); } else { const int ci = tok0 - TLAT; b = ci >> 8; pall0 = ci & 255; }
          bf16_t* d0 = tb + (size_t)(b * 512 + f0) * PALL + pall0;
          const int rbase = 64 * wr + fr;
          float bv[2][4];
#pragma unroll
          for (int ai = 0; ai < 2; ++ai)
#pragma unroll
            for (int m = 0; m < 4; ++m) bv[ai][m] = bsrc[128 * ai + rbase + 16 * m];
#pragma unroll
          for (int ai = 0; ai < 2; ++ai)
#pragma unroll
            for (int m = 0; m < 4; ++m)
#pragma unroll
              for (int bj = 0; bj < 2; ++bj) {
                const pg8::f32x4 x0 = acc[ai][bj][m][0], x1 = acc[ai][bj][m][1];
                const float bb = bv[ai][m];
                float v[8] = {x0[0] + bb, x0[1] + bb, x0[2] + bb, x0[3] + bb, x1[0] + bb, x1[1] + bb, x1[2] + bb, x1[3] + bb};
                st_nt16(d0 + (size_t)(128 * ai + rbase + 16 * m) * PALL + 128 * bj + cbase, pack8(v));
              }
        }
      });
  }
  {
    const int vtid = tid_();
    char* smem = smem_all + half_() * SMEM_BYTES;
    float* sC = (float*)smem;
    const int lane = vtid & 63, w = vtid >> 6, wr = w >> 1, wc = w & 1, r = lane & 31, hh = lane >> 5;
    for (int mt = bid_(); mt < 136; mt += vgrid_()) {
      f32x16 acc[2][1];
      acc[0][0] = zero16();
      acc[1][0] = zero16();
      gemm_mainloop<1>(rows_contig(p.h + (size_t)mt * 128 * D, D), rows_contig(p.wt_in + (size_t)3840 * D, D), 16, acc, smem);
#pragma unroll
      for (int i2 = 0; i2 < 2; ++i2)
#pragma unroll
        for (int g = 0; g < 16; ++g) {
          int row = wr * 64 + i2 * 32 + (g & 3) + 8 * (g >> 2) + 4 * hh, col = wc * 32 + r;
          sC[row * LDC + col] = acc[i2][0][g];
        }
      __syncthreads();
      const float ba = p.b_in[layer * NIN_SRC + 2304 + (vtid & 31)];
      for (int i2 = vtid; i2 < 128 * 32; i2 += 256) {
        int row = i2 >> 5, col = i2 & 31;
        p.aB[(size_t)(mt * 128 + row) * 32 + col] = sC[row * LDC + col] + ba;
      }
      __syncthreads();
    }
  }
}

__device__ __forceinline__ void merge_tiles(PRef p, int layer, char* smem, int mt0, int nmt) {
  float* sC = (float*)smem;
  const int tid = tid_(), lane = tid & 63, w = tid >> 6, wr = w >> 1, wc = w & 1, r = lane & 31, hh = lane >> 5;
  const float* bias = p.b_in + layer * NIN_SRC + 3872;
  const int nrounds = xcd_rounds(smem, nmt, 16);
  for (int rd = 0; rd < nrounds; ++rd) {
    int mt, nt;
    if (!xcd_tile(smem, rd, nmt, 16, mt, nt)) continue;
    mt += mt0;
    f32x16 tot[2][1];
    tot[0][0] = zero16();
    tot[1][0] = zero16();
#pragma unroll 1
    for (int br = 0; br < 3; ++br) {
      f32x16 acc[2][1];
      acc[0][0] = zero16();
      acc[1][0] = zero16();
      gemm_mainloop<1>(rows_contig(p.h + (size_t)mt * 128 * D, D), rows_contig(p.wt_gate + (size_t)(br * 1024 + nt * 64) * D, D), 16, acc, smem);
      unsigned sg[2][8];
      {
        float bv = bias[br * 1024 + nt * 64 + wc * 32 + r];
#pragma unroll
        for (int i = 0; i < 2; ++i)
#pragma unroll
          for (int g = 0; g < 8; ++g)
            sg[i][g] = pack2(sigmoidf_(acc[i][0][2 * g] + bv), sigmoidf_(acc[i][0][2 * g + 1] + bv));
      }
      acc[0][0] = zero16();
      acc[1][0] = zero16();
      const bf16_t* ob = (br == 0 ? p.oA : (br == 1 ? p.oB : p.oC));
      gemm_mainloop<1>(rows_contig(ob + (size_t)mt * 128 * 512, 512), rows_contig(p.wt_br + ((size_t)br * 1024 + nt * 64) * 512, 512), 8, acc, smem);
#pragma unroll
      for (int i = 0; i < 2; ++i)
#pragma unroll
        for (int g = 0; g < 8; ++g) {
          tot[i][0][2 * g] += bf2f((bf16_t)(sg[i][g] & 0xffff)) * acc[i][0][2 * g];
          tot[i][0][2 * g + 1] += bf2f((bf16_t)(sg[i][g] >> 16)) * acc[i][0][2 * g + 1];
        }
    }
#pragma unroll
    for (int i = 0; i < 2; ++i)
#pragma unroll
      for (int g = 0; g < 16; ++g) {
        int row = wr * 64 + i * 32 + (g & 3) + 8 * (g >> 2) + 4 * hh, col = wc * 32 + r;
        sC[row * LDC + col] = tot[i][0][g];
      }
    __syncthreads();
#pragma unroll 1
    for (int ps = 0; ps < 4; ++ps) {
      int row = ps * 32 + (tid >> 3), c8 = tid & 7;
      float v[8];
      lds_read8(sC + row * LDC + c8 * 8, v);
      *(uint4*)(p.m + (size_t)(mt * 128 + row) * D + nt * 64 + c8 * 8) = pack8(v);
    }
    __syncthreads();
  }
}

__device__ __forceinline__ void merge_epilogue(PRef p, int br, int mt, int nt, const float* sC, int tid) {
  const int c8 = tid & 15, rb = tid >> 4;
#pragma unroll 1
  for (int hb = 0; hb < 2; ++hb) {
    u32x4 gv[4], mv[4];
#pragma unroll
    for (int q = 0; q < 4; ++q) {
      const size_t tok = (size_t)(mt * 128 + (hb * 4 + q) * 16 + rb);
      gv[q] = *(const u32x4*)(p.G + tok * 3072 + br * 1024 + nt * 128 + c8 * 8);
      if (br > 0) mv[q] = *(const u32x4*)(p.m + tok * D + nt * 128 + c8 * 8);
    }
#pragma unroll
    for (int q = 0; q < 4; ++q) {
      const int row = (hb * 4 + q) * 16 + rb;
      float v[8];
      lds_read8(sC + row * LDC + c8 * 8, v);
#pragma unroll
      for (int e2 = 0; e2 < 4; ++e2) {
        v[2 * e2] *= bf2f((bf16_t)(gv[q][e2] & 0xffff));
        v[2 * e2 + 1] *= bf2f((bf16_t)(gv[q][e2] >> 16));
        if (br > 0) { v[2 * e2] += bf2f((bf16_t)(mv[q][e2] & 0xffff)); v[2 * e2 + 1] += bf2f((bf16_t)(mv[q][e2] >> 16)); }
      }
      *(uint4*)(p.m + (size_t)(mt * 128 + row) * D + nt * 128 + c8 * 8) = pack8(v);
    }
  }
}
__device__ __forceinline__ void phase_merge(PRef p, int layer, char* smem_all) {
  LAS3 unsigned char* lds = (LAS3 unsigned char*)smem_all;
  {
    PRef pe = params_view();
    const bf16_t* oA = pe.oA; const bf16_t* oB = pe.oB; const bf16_t* oC = pe.oC;
    const bf16_t* wbr = pe.wt_br;
    const bf16_t* Gp = pe.G;
    bf16_t* mp = pe.m;
    pg8::gemm_stream<true>(lds, 512,
      [&](int ui, pg8::UnitAB& u) {
        const int br = ui % 3;
        int pm, pn;
        if (!pg8::unit_map(pg8::unit_linear(ui / 3), 64, 4, pm, pn)) return false;
        const bf16_t* ob = (br == 0 ? oA : (br == 1 ? oB : oC));
        u.a = (const char*)(ob + (size_t)pm * 256 * 512);
        u.b = (const char*)(wbr + ((size_t)br * 1024 + pn * 256) * 512);
        return true;
      },
      [&](int ui, const pg8::f32x4 (&acc)[2][2][4][2]) {
        const int br = ui % 3;
        int pm, pn;
        pg8::unit_map(pg8::unit_linear(ui / 3), 64, 4, pm, pn);
        const bf16_t* gsrc = Gp + (size_t)pm * 256 * 3072 + br * 1024 + pn * 256;
        bf16_t* mdst = mp + (size_t)pm * 256 * D + pn * 256;
        const bool rmw = br > 0;
        int lt = __builtin_amdgcn_workitem_id_x();
        asm volatile("" : "+v"(lt));
        const int wid = lt >> 6, lane = lt & 63, wr = wid >> 2, wc = wid & 3, fr = lane & 15, fq = lane >> 4;
#pragma unroll
        for (int ai = 0; ai < 2; ++ai) {
          u32x4 gq[4][2], mq[4][2];
#pragma unroll
          for (int m = 0; m < 4; ++m)
#pragma unroll
            for (int bj = 0; bj < 2; ++bj) {
              const int row = 128 * ai + 64 * wr + 16 * m + fr, col = 128 * bj + 32 * wc + 8 * fq;
              gq[m][bj] = *(const u32x4*)(gsrc + (size_t)row * 3072 + col);
              if (rmw) mq[m][bj] = *(const u32x4*)(mdst + (size_t)row * D + col);
            }
#pragma unroll
          for (int m = 0; m < 4; ++m)
#pragma unroll
            for (int bj = 0; bj < 2; ++bj) {
              const int row = 128 * ai + 64 * wr + 16 * m + fr, col = 128 * bj + 32 * wc + 8 * fq;
              const pg8::f32x4 a = acc[ai][bj][m][0], b = acc[ai][bj][m][1];
              float v[8] = {a[0], a[1], a[2], a[3], b[0], b[1], b[2], b[3]};
              const u32x4 g = gq[m][bj];
#pragma unroll
              for (int e2 = 0; e2 < 4; ++e2) {
                v[2 * e2] *= bf2f((bf16_t)(g[e2] & 0xffff));
                v[2 * e2 + 1] *= bf2f((bf16_t)(g[e2] >> 16));
                if (rmw) { v[2 * e2] += bf2f((bf16_t)(mq[m][bj][e2] & 0xffff)); v[2 * e2 + 1] += bf2f((bf16_t)(mq[m][bj][e2] >> 16)); }
              }
              *(uint4*)(mdst + (size_t)row * D + col) = pack8(v);
            }
        }
      });
  }
  if (layer == 0) merge_tiles(p, layer, smem_all + half_() * SMEM_BYTES, 128, 8);
}

__device__ __forceinline__ void outproj_epilogue(PRef p, int layer, int mt, int nt, const float* sC, int tid) {
  const int tok0 = mt * 128;
  const float* g1 = p.mod + ((size_t)layer * 5 + tok_modrow(tok0)) * NMOD + 2048 + nt * 128;
  const int c8 = tid & 15, rb = tid >> 4;
  const float4 ga = *(const float4*)(g1 + c8 * 8), gb = *(const float4*)(g1 + c8 * 8 + 4);
#pragma unroll 1
  for (int hb = 0; hb < 2; ++hb) {
    float4 x0[4], x1[4];
#pragma unroll
    for (int q = 0; q < 4; ++q) {
      const int tok = tok0 + (hb * 4 + q) * 16 + rb;
      const float* xp;
      if (layer == 0) xp = tok < TLAT ? p.x + (size_t)tok * D : p.ctx + (size_t)(tok - TLAT) * D;
      else xp = p.xres + (size_t)tok * D;
      xp += nt * 128 + c8 * 8;
      x0[q] = *(const float4*)xp; x1[q] = *(const float4*)(xp + 4);
    }
#pragma unroll
    for (int q = 0; q < 4; ++q) {
      const int row = (hb * 4 + q) * 16 + rb;
      float v[8];
      lds_read8(sC + row * LDC + c8 * 8, v);
      float4 o0 = make_float4(ALPHA * x0[q].x + ga.x * v[0], ALPHA * x0[q].y + ga.y * v[1], ALPHA * x0[q].z + ga.z * v[2], ALPHA * x0[q].w + ga.w * v[3]);
      float4 o1 = make_float4(ALPHA * x1[q].x + gb.x * v[4], ALPHA * x1[q].y + gb.y * v[5], ALPHA * x1[q].z + gb.z * v[6], ALPHA * x1[q].w + gb.w * v[7]);
      float* op = p.xres + (size_t)(tok0 + row) * D + nt * 128 + c8 * 8;
      *(float4*)op = o0;
      *(float4*)(op + 4) = o1;
    }
  }
}
__device__ __forceinline__ void phase_outproj(PRef p, int layer, char* smem_all) {
  LAS3 unsigned char* lds = (LAS3 unsigned char*)smem_all;
  unsigned voffA[2];
  pg8::voff_contig(D, voffA);
  for (int i = 0;; ++i) {
    int pm, pn;
    if (!pg8::unit_map(pg8::unit_linear(i), 64, 4, pm, pn)) break;
    pg8::f32x4 acc[2][2][4][2];
    const char* a0 = (const char*)(p.m + (size_t)pm * 256 * D);
    pg8::gemm_unit(lds, a0, a0 + (size_t)128 * D * 2, voffA, voffA, (const char*)(p.wt_out + (size_t)pn * 256 * D), D, acc);
    asm volatile("" : "+s"(pm), "+s"(pn));
    PRef pe = params_view();
    const int etid = tid_();
    const int half = half_();
    float* sCh = (float*)(smem_all + half * SMEM_BYTES);
    pg8::acc_to_lds<0, 0>(acc, false, (float*)smem_all);
    pg8::acc_to_lds<0, 1>(acc, false, (float*)(smem_all + SMEM_BYTES));
    __syncthreads();
    outproj_epilogue(pe, layer, 2 * pm, 2 * pn + half, sCh, etid);
    __syncthreads();
    pg8::acc_to_lds<1, 0>(acc, false, (float*)smem_all);
    pg8::acc_to_lds<1, 1>(acc, false, (float*)(smem_all + SMEM_BYTES));
    __syncthreads();
    outproj_epilogue(pe, layer, 2 * pm + 1, 2 * pn + half, sCh, etid);
    __syncthreads();
  }
  if (layer == 0) {
    char* smem = smem_all + half_() * SMEM_BYTES;
    float* sC = (float*)smem;
    const int tid = tid_();
    for (int item = bid_(); item < 64; item += vgrid_()) {
      const int mt = 128 + (item >> 3), nt = item & 7;
      f32x16 acc[2][2];
#pragma unroll
      for (int i = 0; i < 2; ++i)
#pragma unroll
        for (int j = 0; j < 2; ++j) acc[i][j] = zero16();
      gemm_mainloop<2>(rows_contig(p.m + (size_t)mt * 128 * D, D), rows_contig(p.wt_out + (size_t)nt * 128 * D, D), 16, acc, smem);
      acc_to_lds(acc, sC);
      __syncthreads();
      outproj_epilogue(p, layer, mt, nt, sC, tid);
      __syncthreads();
    }
  }
}

__device__ __forceinline__ bool moe_block_lookup(PRef p, int mb, int& e, int& lb, int& cnt_e) {
  int start = 0;
  for (int i = 0; i < 32; ++i) {
    int c = p.cnt[i];
    int nb = (c + MOE_BLK - 1) / MOE_BLK;
    if (mb < start + nb) { e = i; lb = mb - start; cnt_e = c; return true; }
    start += nb;
  }
  return false;
}
struct MoeMap { int c, start, incl; };
__device__ __forceinline__ MoeMap moe_map_build(const int* cnt) {
  int lane = __builtin_amdgcn_workitem_id_x() & 63;
  asm volatile("" : "+v"(lane));
  MoeMap m;
  m.c = lane < 32 ? cnt[lane] : 0;
  const int nb = (m.c + MOE_BLK - 1) / MOE_BLK;
  int v = nb;
#define MOE_DPP_ADD(ctrl, rmask) v += __builtin_amdgcn_update_dpp(0, v, ctrl, rmask, 0xf, false)
  MOE_DPP_ADD(0x111, 0xf); MOE_DPP_ADD(0x112, 0xf); MOE_DPP_ADD(0x114, 0xf); MOE_DPP_ADD(0x118, 0xf);
  MOE_DPP_ADD(0x142, 0xa); MOE_DPP_ADD(0x143, 0xc);
#undef MOE_DPP_ADD
  m.incl = v;
  m.start = v - nb;
  return m;
}
__device__ __forceinline__ bool moe_map_lookup(const MoeMap& m, int mb, int& e, int& lb, int& cnt_e) {
  const unsigned long long hit = __ballot(mb >= m.start && mb < m.incl);
  if (hit == 0ull) return false;
  e = __builtin_amdgcn_readfirstlane(__ffsll((long long)hit) - 1);
  lb = mb - __builtin_amdgcn_readlane(m.start, e);
  cnt_e = __builtin_amdgcn_readlane(m.c, e);
  return true;
}
__device__ __forceinline__ void moe1_epilogue(PRef p, int slot0, int nt, const float* sC, int tid) {
#pragma unroll
  for (int ps = 0; ps < 8; ++ps) {
    const int row = ps * 16 + (tid >> 4), c4 = (tid & 15) * 4;
    const float4 a = *(const float4*)(sC + row * LDC + c4);
    const float4 b = *(const float4*)(sC + row * LDC + 64 + c4);
    const uint2 o = make_uint2(pack2(siluf(a.x) * b.x, siluf(a.y) * b.y), pack2(siluf(a.z) * b.z, siluf(a.w) * b.w));
    *(uint2*)(p.act + (size_t)(slot0 + row) * 512 + nt * 64 + c4) = o;
  }
}
__device__ __forceinline__ void moe2_epilogue(PRef p, int slot0, int nt, const float* sC, int tid) {
#pragma unroll
  for (int ps = 0; ps < 8; ++ps) {
    const int row = ps * 16 + (tid >> 4), c8 = tid & 15;
    float v[8];
    lds_read8(sC + row * LDC + c8 * 8, v);
    *(uint4*)(p.ysl + (size_t)(slot0 + row) * D + nt * 128 + c8 * 8) = pack8(v);
  }
}
__device__ __forceinline__ void phase_moe1(PRef p, int layer, char* smem_all) {
  LAS3 unsigned char* lds = (LAS3 unsigned char*)smem_all;
  const MoeMap mm = moe_map_build(p.cnt);
  if (__builtin_amdgcn_workgroup_id_x() == 0 && __builtin_amdgcn_workitem_id_x() < 32) p.estart[__builtin_amdgcn_workitem_id_x()] = mm.start;
  struct UnitG { int mb, pn, e; unsigned a0[2], a1[2]; bool ok; };
  auto fetch = [&](int i, int& mb, int& pn, int& e, unsigned (&a0)[2], unsigned (&a1)[2]) -> bool {
    const int L = pg8::unit_linear(i);
    mb = L >> 2; pn = L & 3;
    int lb, ce;
    if (mb >= MAX_MBLK || !moe_map_lookup(mm, mb, e, lb, ce)) return false;
    int tid = __builtin_amdgcn_workitem_id_x();
    asm volatile("" : "+v"(tid));
#pragma unroll
    for (int q = 0; q < 2; ++q) {
      int R, C;
      pg8::stage_rc(tid * 16 + q * 8192, R, C);
      const int s0 = lb * MOE_BLK + R, s1 = s0 + 128;
      const int t0 = s0 < ce ? p.list[e * MOE_CAP + s0] : 0;
      const int t1 = s1 < ce ? p.list[e * MOE_CAP + s1] : 0;
      a0[q] = (unsigned)(t0 * D + C) * 2u;
      a1[q] = (unsigned)(t1 * D + C) * 2u;
    }
    return true;
  };
  int mb, pn, e;
  unsigned voffA0[2], voffA1[2];
  bool ok = fetch(0, mb, pn, e, voffA0, voffA1);
  for (int i = 0; ok; ++i) {
    int mbn, pnn, en;
    unsigned n0[2], n1[2];
    const bool okn = fetch(i + 1, mbn, pnn, en, n0, n1);
    pg8::f32x4 acc[2][2][4][2];
    pg8::gemm_unit(lds, (const char*)p.h2, (const char*)p.h2, voffA0, voffA1, (const char*)(p.wt_13 + ((size_t)e * 1024 + pn * 256) * D), D, acc);
    asm volatile("" : "+s"(mb), "+s"(pn));
    PRef pe = params_view();
    const int etid = tid_();
    const int half = half_();
    float* sCh = (float*)(smem_all + half * SMEM_BYTES);
    pg8::acc_to_lds<0, 0>(acc, false, (float*)smem_all);
    pg8::acc_to_lds<0, 1>(acc, false, (float*)(smem_all + SMEM_BYTES));
    __syncthreads();
    moe1_epilogue(pe, mb * MOE_BLK, 2 * pn + half, sCh, etid);
    __syncthreads();
    pg8::acc_to_lds<1, 0>(acc, false, (float*)smem_all);
    pg8::acc_to_lds<1, 1>(acc, false, (float*)(smem_all + SMEM_BYTES));
    __syncthreads();
    moe1_epilogue(pe, mb * MOE_BLK + 128, 2 * pn + half, sCh, etid);
    __syncthreads();
    ok = okn; mb = mbn; pn = pnn; e = en;
    voffA0[0] = n0[0]; voffA0[1] = n0[1]; voffA1[0] = n1[0]; voffA1[1] = n1[1];
  }
}
__device__ __forceinline__ void phase_moe2(PRef p, int layer, char* smem_all) {
  LAS3 unsigned char* lds = (LAS3 unsigned char*)smem_all;
  const bf16_t* actp = p.act;
  const bf16_t* w2p = p.wt_2;
  bf16_t* yp = p.ysl;
  const MoeMap mm = moe_map_build(p.cnt);
  auto lookup = [&](int mb, int& e) { int lb, ce; return moe_map_lookup(mm, mb, e, lb, ce); };
  pg8::gemm_stream<true>(lds, 512,
    [&](int ui, pg8::UnitAB& u) {
      const int L = pg8::unit_linear(ui);
      const int mb = L >> 2, pn = L & 3;
      int e;
      if (mb >= MAX_MBLK || !lookup(mb, e)) return false;
      u.a = (const char*)(actp + (size_t)mb * MOE_BLK * 512);
      u.b = (const char*)(w2p + ((size_t)e * 1024 + pn * 256) * 512);
      return true;
    },
    [&](int ui, const pg8::f32x4 (&acc)[2][2][4][2]) {
      const int L = pg8::unit_linear(ui);
      const int mb = L >> 2, pn = L & 3;
      bf16_t* ydst = yp + (size_t)mb * MOE_BLK * D + pn * 256;
      pg8::for_each_piece(acc, [&](int row, int col, float (&v)[8]) { st_nt16(ydst + (size_t)row * D + col, pack8(v)); });
    });
}

struct AttnState { f32x16 negm; f32x16 L; };
__device__ __forceinline__ void attn_qk(const char* sK, const bf16x8 (&bq)[4], const f32x16& negm, f32x16 (&S)[2], int r, int hh) {
  const int pr = 16 * (r >> 4) + 8 * ((r >> 2) & 1) + 4 * ((r >> 3) & 1) + (r & 3);
  const char* kp = sK + pr * 128;
#pragma unroll
  for (int s = 0; s < 4; ++s) {
    const int co = ((2 * s + hh) ^ ((pr >> 1) & 7)) << 4;
    bf16x8 a0 = *(const bf16x8*)(kp + co);
    bf16x8 a1 = *(const bf16x8*)(kp + 4096 + co);
    if (s == 0) { S[0] = mfma32(a0, bq[0], negm); S[1] = mfma32(a1, bq[0], negm); }
    else { S[0] = mfma32(a0, bq[s], S[0]); S[1] = mfma32(a1, bq[s], S[1]); }
  }
}
template <class MaskF>
__device__ __forceinline__ float attn_softmax_pv(f32x16 (&S)[2], const char* sV, f32x16 (&O)[2], AttnState& st, bf16x8 ones, int r, int hh,
                                                 MaskF maskf, const bool FIRST) {
  maskf(S);
  float mx = S[0][0];
#pragma unroll
  for (int g = 1; g < 16; ++g) mx = fmaxf(mx, S[0][g]);
#pragma unroll
  for (int g = 0; g < 16; ++g) mx = fmaxf(mx, S[1][g]);
  {
    auto sw = __builtin_amdgcn_permlane32_swap(__float_as_uint(mx), __float_as_uint(mx), false, false);
    mx = fmaxf(__uint_as_float(sw[0]), __uint_as_float(sw[1]));
  }
  float dshift = 0.f;
  if (FIRST || __any(mx > 8.f)) {
    const float d = FIRST ? mx : fmaxf(mx, 0.f);
    dshift = d;
    const float alpha = __builtin_amdgcn_exp2f(-d);
#pragma unroll
    for (int g = 0; g < 16; ++g) {
      st.negm[g] -= d;
      S[0][g] -= d; S[1][g] -= d;
      O[0][g] *= alpha; O[1][g] *= alpha;
    }
    st.L[0] *= alpha;
  }
#pragma unroll
  for (int kb = 0; kb < 2; ++kb)
#pragma unroll
    for (int g = 0; g < 16; ++g) S[kb][g] = __builtin_amdgcn_exp2f(S[kb][g]);
  const char* vp = sV + r * 128;
  const int vsw = (r >> 1) & 7;
#pragma unroll
  for (int sp = 0; sp < 4; ++sp) {
    const int sb_ = sp >> 1, so_ = 8 * (sp & 1);
    u32x4 bpu = {pack2(S[sb_][so_], S[sb_][so_ + 1]), pack2(S[sb_][so_ + 2], S[sb_][so_ + 3]), pack2(S[sb_][so_ + 4], S[sb_][so_ + 5]),
                 pack2(S[sb_][so_ + 6], S[sb_][so_ + 7])};
    bf16x8 bp = __builtin_bit_cast(bf16x8, bpu);
#pragma unroll
    for (int db = 0; db < 2; ++db) {
      bf16x8 av = *(const bf16x8*)(vp + db * 4096 + (((2 * sp + hh) ^ vsw) << 4));
      O[db] = mfma32(av, bp, O[db]);
    }
    st.L = mfma32(ones, bp, st.L);
  }
  return dshift;
}
template <class MaskF>
__device__ __forceinline__ void attn_tile(const char* sK, const char* sV, const bf16x8 (&bq)[4], f32x16 (&O)[2], AttnState& st, bf16x8 ones,
                                          int r, int hh, MaskF maskf, const bool FIRST) {
  f32x16 S[2];
  attn_qk(sK, bq, st.negm, S, r, hh);
  (void)attn_softmax_pv(S, sV, O, st, ones, r, hh, maskf, FIRST);
}
__device__ __forceinline__ void attn_state_init(AttnState& st, bf16x8& ones, int r) {
  st.negm = zero16();
  st.L = zero16();
  const short one = (r == 0) ? (short)0x3F80 : (short)0;
  ones = (bf16x8){one, one, one, one, one, one, one, one};
}

__device__ __forceinline__ void attn_stage(const bf16_t* kg, size_t kstride, const bf16_t* vg, size_t vstride, char* sKd, char* sVd, int tid) {
  const int row = tid >> 3, u = ((tid & 7) ^ ((tid >> 4) & 7)) * 8;
#pragma unroll
  for (int i = 0; i < 2; ++i) {
    __builtin_amdgcn_global_load_lds((const unsigned*)(kg + (size_t)(row + 32 * i) * kstride + u), (LAS3 unsigned*)(sKd + tid * 16 + i * 4096), 16, 0, 0);
    __builtin_amdgcn_global_load_lds((const unsigned*)(vg + (size_t)(row + 32 * i) * vstride + u), (LAS3 unsigned*)(sVd + tid * 16 + i * 4096), 16, 0, 0);
  }
}
struct NoMask { __device__ __forceinline__ void operator()(f32x16 (&)[2]) const {} };

__device__ __forceinline__ void attn_write_out(bf16_t* dst  , const f32x16 (&O)[2], float l, int hh) {
  float lt = l + __shfl_xor(l, 32);
  float inv = 1.f / lt;
#pragma unroll
  for (int db = 0; db < 2; ++db)
#pragma unroll
    for (int g4 = 0; g4 < 4; ++g4) {
      uint2 o = make_uint2(pack2(O[db][4 * g4] * inv, O[db][4 * g4 + 1] * inv), pack2(O[db][4 * g4 + 2] * inv, O[db][4 * g4 + 3] * inv));
      *(uint2*)(dst + 32 * db + 8 * g4 + 4 * hh) = o;
    }
}

__device__ __forceinline__ void phase_attnA(PRef p, int layer, char* smem_all) {
  int tid = __builtin_amdgcn_workitem_id_x();
  asm volatile("" : "+v"(tid));
  const int lane = tid & 63, w8 = tid >> 6, w = w8 & 3, qsub = w8 >> 2, r = lane & 31, hh = lane >> 5;
  char* sK = smem_all;
  char* sV = smem_all + 32768;
  const int nitems = layer == 0 ? 544 : 512;
  const int G = (int)gridDim.x;
  for (int item = (int)__builtin_amdgcn_workgroup_id_x(); item < nitems; item += G) {
    int b, kvh, qtok0, nkt;
    if (item < 512) { b = item >> 7; kvh = (item >> 6) & 1; qtok0 = b * 4096 + (item & 63) * 64 + qsub * 32; nkt = 68; }
    else { int it = item - 512; b = it >> 3; kvh = (it >> 2) & 1; qtok0 = TLAT + b * 256 + (it & 3) * 64 + qsub * 32; nkt = 4; }
    const int head = kvh * 4 + w;
    bf16x8 bq[4];
    {
      const bf16_t* qp = p.qA + (size_t)(qtok0 + r) * 512 + head * 64 + 8 * hh;
#pragma unroll
      for (int s = 0; s < 4; ++s) bq[s] = *(const bf16x8*)(qp + 16 * s);
    }
    const bf16_t* kbase = p.kA + (size_t)(b * 2 + kvh) * PALL * 64;
    const bf16_t* vbase = p.vAT + (size_t)(b * 2 + kvh) * 64 * PALL;
    const int srow = tid >> 3, su = ((tid & 7) ^ ((tid >> 4) & 7)) * 8;
    const bf16_t* kg = kbase + (size_t)srow * 64 + su;
    const bf16_t* vg = vbase + (size_t)srow * PALL + su;
    f32x16 O[2];
    O[0] = zero16();
    O[1] = zero16();
    AttnState st;
    bf16x8 ones;
    attn_state_init(st, ones, r);
    __syncthreads();
#define ATT_STAGE(KT)                                                                                                                     \
  {                                                                                                                                       \
    __builtin_amdgcn_global_load_lds((const unsigned*)(kg + (size_t)(KT) * 4096), (LAS3 unsigned*)(sK + ((KT) & 3) * 8192 + tid * 16), 16, 0, 0); \
    __builtin_amdgcn_global_load_lds((const unsigned*)(vg + (KT) * 64), (LAS3 unsigned*)(sV + ((KT) & 3) * 8192 + tid * 16), 16, 0, 0);           \
  }
    ATT_STAGE(0);
    ATT_STAGE(1);
    dma_sync();
    f32x16 Sa[2], Sb[2];
    attn_qk(sK, bq, st.negm, Sa, r, hh);
#define ATT_STEP(KT, CUR, NXT)                                                                                              \
  {                                                                                                                         \
    if ((KT) > 0) dma_sync();                \
    if ((KT) + 2 < nkt) ATT_STAGE((KT) + 2);                                                                                \
    if ((KT) + 1 < nkt) attn_qk(sK + (((KT) + 1) & 3) * 8192, bq, st.negm, NXT, r, hh);                                     \
    const float d_ = attn_softmax_pv(CUR, sV + ((KT) & 3) * 8192, O, st, ones, r, hh, NoMask(), (KT) == 0);                 \
    if ((KT) + 1 < nkt && __any(d_ != 0.f)) {      \
      _Pragma("unroll") for (int g = 0; g < 16; ++g) { NXT[0][g] -= d_; NXT[1][g] -= d_; }                                  \
    }                                                                                                                       \
  }
    for (int kt = 0; kt < nkt; kt += 2) {
      ATT_STEP(kt, Sa, Sb);
      ATT_STEP(kt + 1, Sb, Sa);
    }
#undef ATT_STEP
#undef ATT_STAGE
    attn_write_out(p.oA + (size_t)(qtok0 + r) * 512 + head * 64, O, st.L[0], hh);
  }
}

struct NaMask {
  const float* bp;
  int cofs;
  bool on;
  __device__ __forceinline__ void operator()(f32x16 (&S)[2]) const {
    if (!on) return;
    f32x16 bv[2];
#pragma unroll
    for (int kb = 0; kb < 2; ++kb)
#pragma unroll
      for (int g = 0; g < 16; ++g) bv[kb][g] = bp[32 * kb + 16 * (g >> 3) + 4 * ((g >> 2) & 1) + (g & 3)];
    asm volatile("" : "+v"(bv[0]), "+v"(bv[1]));
#pragma unroll
    for (int kb = 0; kb < 2; ++kb)
#pragma unroll
      for (int g = 0; g < 16; ++g) {
        const int cc = 32 * kb + 16 * (g >> 3) + 4 * ((g >> 2) & 1) + (g & 3);
        const bool valid = (unsigned)(cc + cofs) < 16u;
        S[kb][g] = valid ? S[kb][g] + bv[kb][g] : -1e30f;
      }
  }
};
__device__ __forceinline__ void phase_na(PRef p, int layer, char* smem) {
  const int tid = tid_(), lane = tid & 63, w = tid >> 6, r = lane & 31, hh = lane >> 5;
  char* sK = smem;
  char* sV = smem + 32768;
  float* sBias = (float*)(smem + 65536);
  const int nitems = layer == 0 ? 1088 : 1024;
  const int set = w >> 1, qhalf = w & 1;
  for (int item = bid_(); item < nitems; item += vgrid_()) {
    int b, hp, row = 0, rs = 0, qtok0, kt0, kt1;
    if (item < 1024) {
      b = item >> 8; row = (item >> 2) & 63; hp = item & 3;
      rs = row - 4; rs = rs < 0 ? 0 : (rs > 56 ? 56 : rs);
      qtok0 = b * 4096 + row * 64; kt0 = 0; kt1 = 12;
    } else {
      int it = item - 1024;
      b = it >> 4; hp = (it >> 2) & 3;
      qtok0 = TLAT + b * 256 + (it & 3) * 64; kt0 = 8; kt1 = 12;
    }
    const int head = 2 * hp + set;
    __syncthreads();
#define NA_STAGE(KT, BUF)                                                                                          \
  {                                                                                                                \
    int tokK, pallb;                                                                                               \
    if ((KT) < 8) { tokK = b * 4096 + (rs + (KT)) * 64; pallb = 256 + (rs + (KT)) * 64; }                          \
    else { tokK = TLAT + b * 256 + ((KT) - 8) * 64; pallb = ((KT) - 8) * 64; }                                     \
    _Pragma("unroll") for (int s2 = 0; s2 < 2; ++s2)                                                               \
      attn_stage(p.kC + (size_t)tokK * 512 + (2 * hp + s2) * 64, 512, p.vCT + (size_t)(b * 8 + 2 * hp + s2) * 64 * PALL + pallb, PALL, \
                 sK + (BUF) * 16384 + s2 * 8192, sV + (BUF) * 16384 + s2 * 8192, tid);                             \
  }
    NA_STAGE(kt0, 0);
    for (int i = tid; i < 930; i += 256) {
      int s = i / 465, j = i % 465;
      sBias[i] = p.rpb[((size_t)layer * 8 + 2 * hp + s) * 465 + j] * LOG2E;
    }
    bf16x8 bq[4];
    {
      const bf16_t* qp = p.qC + (size_t)(qtok0 + 32 * qhalf + r) * 512 + head * 64 + 8 * hh;
#pragma unroll
      for (int s = 0; s < 4; ++s) bq[s] = *(const bf16x8*)(qp + 16 * s);
    }
    f32x16 O[2];
    O[0] = zero16();
    O[1] = zero16();
    AttnState st;
    bf16x8 ones;
    attn_state_init(st, ones, r);
    for (int kt = kt0; kt < kt1; ++kt) {
      const int cur = (kt - kt0) & 1;
      dma_sync();
      if (kt + 1 < kt1) NA_STAGE(kt + 1, cur ^ 1);
      {
        NaMask mk;
        const int wq = 32 * qhalf + r;
        int cs = wq - 8;
        cs = cs < 0 ? 0 : (cs > 48 ? 48 : cs);
        mk.on = kt < 8;
        mk.bp = sBias + set * 465 + (mk.on ? (rs + kt - row + 7) * 31 : 0) - wq + 15 + 8 * hh;
        mk.cofs = 8 * hh - cs;
        attn_tile(sK + cur * 16384 + set * 8192, sV + cur * 16384 + set * 8192, bq, O, st, ones, r, hh, mk, kt == kt0);
      }
    }
#undef NA_STAGE
    attn_write_out(p.oC + (size_t)(qtok0 + 32 * qhalf + r) * 512 + head * 64, O, st.L[0], hh);
  }
}

__device__ __forceinline__ float log_sigmoidf_(float x) { return fminf(x, 0.f) - __logf(1.f + __expf(-fabsf(x))); }
struct GlaPre { f32x4v a0, a1, a2, a3, wg0, wg1; float bg; };
__device__ __forceinline__ void gla_prep_load(PRef p, int layer, int hd, int dir, int tok0, GlaPre& R) {
  const int tid = tid_(), lane = tid & 63, w = tid >> 6, r = lane & 31, hh = lane >> 5, pb = w >> 1, db = w & 1;
  const float* ap = p.aB + (size_t)(tok0 + 32 * pb + r) * 32 + dir * 16;
  R.a0 = *(const f32x4v*)(ap); R.a1 = *(const f32x4v*)(ap + 4); R.a2 = *(const f32x4v*)(ap + 8); R.a3 = *(const f32x4v*)(ap + 12);
  const float* wp = p.gla_wg + (((size_t)layer * 2 + dir) * 16 + hh) * 256 + hd * 64 + 32 * db + r;
  R.wg0 = (f32x4v){wp[0], wp[2 * 256], wp[4 * 256], wp[6 * 256]};
  R.wg1 = (f32x4v){wp[8 * 256], wp[10 * 256], wp[12 * 256], wp[14 * 256]};
  R.bg = p.gla_bg[((size_t)layer * 2 + dir) * 256 + hd * 64 + 32 * db + r];
}
#define GLA_DPP_ADD(v, ctrl, rmask) v += __builtin_bit_cast(float, __builtin_amdgcn_update_dpp(0, __builtin_bit_cast(int, v), ctrl, rmask, 0xf, false))
__device__ __forceinline__ void gla_prep_compute(const GlaPre& R, int dir, float* sBc) {
  const int tid = tid_(), lane = tid & 63, w = tid >> 6, r = lane & 31, hh = lane >> 5, pb = w >> 1, db = w & 1;
  {
    f32x16 x;
#pragma unroll
    for (int g = 0; g < 16; ++g) x[g] = R.bg;
    const float ae[8] = {R.a0[0], R.a0[2], R.a1[0], R.a1[2], R.a2[0], R.a2[2], R.a3[0], R.a3[2]};
    const float ao[8] = {R.a0[1], R.a0[3], R.a1[1], R.a1[3], R.a2[1], R.a2[3], R.a3[1], R.a3[3]};
    const float wv[8] = {R.wg0[0], R.wg0[1], R.wg0[2], R.wg0[3], R.wg1[0], R.wg1[1], R.wg1[2], R.wg1[3]};
#pragma unroll
    for (int s = 0; s < 8; ++s) x = __builtin_amdgcn_mfma_f32_32x32x2f32(hh ? ao[s] : ae[s], wv[s], x, 0, 0, 0);
#pragma unroll
    for (int g = 0; g < 16; ++g) {
      const int pos = 32 * pb + (g & 3) + 8 * (g >> 2) + 4 * hh;
      sBc[pos * 65 + 32 * db + r] = log_sigmoidf_(x[g]) * (1.f / 16.f);
    }
  }
  __syncthreads();
  {
    const int idx = dir ? 63 - lane : lane;
    float v[16];
#pragma unroll
    for (int dd = 0; dd < 16; ++dd) v[dd] = sBc[idx * 65 + w * 16 + dd];
#pragma unroll
    for (int dd = 0; dd < 16; ++dd) GLA_DPP_ADD(v[dd], 0x111, 0xf);
#pragma unroll
    for (int dd = 0; dd < 16; ++dd) GLA_DPP_ADD(v[dd], 0x112, 0xf);
#pragma unroll
    for (int dd = 0; dd < 16; ++dd) GLA_DPP_ADD(v[dd], 0x114, 0xf);
#pragma unroll
    for (int dd = 0; dd < 16; ++dd) GLA_DPP_ADD(v[dd], 0x118, 0xf);
#pragma unroll
    for (int dd = 0; dd < 16; ++dd) GLA_DPP_ADD(v[dd], 0x142, 0xa);
#pragma unroll
    for (int dd = 0; dd < 16; ++dd) GLA_DPP_ADD(v[dd], 0x143, 0xc);
#pragma unroll
    for (int dd = 0; dd < 16; ++dd) sBc[idx * 65 + w * 16 + dd] = v[dd];
  }
  __syncthreads();
}
__device__ __forceinline__ void chunk_pos(int b, int dir, int c, int& tok0, int& pall0) {
  if (c < 4) { int pc = dir ? 3 - c : c; tok0 = TLAT + b * 256 + pc * 64; pall0 = pc * 64; }
  else { int j = c - 4; int pc = dir ? 63 - j : j; tok0 = b * 4096 + pc * 64; pall0 = 256 + pc * 64; }
}
__device__ __forceinline__ void phase_gla1(PRef p, int layer, char* smem) {
  float* sWg = (float*)smem;
  float* sBc = (float*)(smem + 4096);
  bf16_t* sKt = (bf16_t*)(smem + 20736);
  bf16_t* sVt = (bf16_t*)(smem + 29952);
  const int tid = tid_(), lane = tid & 63, w = tid >> 6, r = lane & 31, hh = lane >> 5;
  for (int item = bid_(); item < 32 * NCHUNK; item += vgrid_()) {
    const int ch = item / NCHUNK, c = item % NCHUNK;
    const int dir = ch & 1, hd = (ch >> 1) & 3, b = ch >> 3;
    int tok0, pall0;
    chunk_pos(b, dir, c, tok0, pall0);
    GlaPre R;
    gla_prep_load(p, layer, hd, dir, tok0, R);
    u32x4 k0, k1, vv0, vv1, vv2, vv3;
    {
      const int pos = tid >> 2, dg = tid & 3;
      const bf16_t* kp = p.kB + (size_t)(tok0 + pos) * 256 + hd * 64 + dg * 16;
      k0 = *(const u32x4*)kp; k1 = *(const u32x4*)(kp + 8);
      const bf16_t* vb = p.vBT + (size_t)(b * 4 + hd) * 128 * PALL + pall0 + (tid & 7) * 8;
      vv0 = *(const u32x4*)(vb + (size_t)(tid >> 3) * PALL);
      vv1 = *(const u32x4*)(vb + (size_t)((tid >> 3) + 32) * PALL);
      vv2 = *(const u32x4*)(vb + (size_t)((tid >> 3) + 64) * PALL);
      vv3 = *(const u32x4*)(vb + (size_t)((tid >> 3) + 96) * PALL);
    }
    __syncthreads();
    gla_prep_compute(R, dir, sBc);
    {
      const int pos = tid >> 2, dg = tid & 3;
      float* bd = p.bcum + (size_t)item * 4096 + pos * 64 + dg * 16;
#pragma unroll
      for (int q4 = 0; q4 < 4; ++q4)
        *(float4*)(bd + 4 * q4) = make_float4(sBc[pos * 65 + dg * 16 + 4 * q4], sBc[pos * 65 + dg * 16 + 4 * q4 + 1], sBc[pos * 65 + dg * 16 + 4 * q4 + 2], sBc[pos * 65 + dg * 16 + 4 * q4 + 3]);
    }
    {
      int pos = tid >> 2, dg = tid & 3;
      unsigned ku[8] = {k0[0], k0[1], k0[2], k0[3], k1[0], k1[1], k1[2], k1[3]};
#pragma unroll
      for (int e = 0; e < 16; ++e) {
        int d = dg * 16 + e;
        float kv = bf2f((bf16_t)((e & 1) ? (ku[e >> 1] >> 16) : (ku[e >> 1] & 0xffff)));
        float bend = sBc[(dir ? 0 : 63) * 65 + d];
        sKt[d * 72 + pos] = f2bf(kv * __expf(bend - sBc[pos * 65 + d]));
      }
      {
        const int dv = tid >> 3, cc = tid & 7;
        *(u32x4*)(sVt + dv * 72 + cc * 8) = vv0;
        *(u32x4*)(sVt + (dv + 32) * 72 + cc * 8) = vv1;
        *(u32x4*)(sVt + (dv + 64) * 72 + cc * 8) = vv2;
        *(u32x4*)(sVt + (dv + 96) * 72 + cc * 8) = vv3;
      }
      if (tid < 64) p.decay[(size_t)item * 64 + tid] = __expf(sBc[(dir ? 0 : 63) * 65 + tid]);
    }
    __syncthreads();
    f32x16 acc[2];
    acc[0] = zero16();
    acc[1] = zero16();
#pragma unroll
    for (int s = 0; s < 4; ++s) {
      bf16x8 a = *(const bf16x8*)(sVt + (32 * w + r) * 72 + 16 * s + 8 * hh);
      bf16x8 b0 = *(const bf16x8*)(sKt + r * 72 + 16 * s + 8 * hh);
      bf16x8 b1 = *(const bf16x8*)(sKt + (32 + r) * 72 + 16 * s + 8 * hh);
      acc[0] = mfma32(b0, a, acc[0]);
      acc[1] = mfma32(b1, a, acc[1]);
    }
    float* dst = p.KVt + (size_t)item * 8192 + (32 * w + r) * 64 + 4 * hh;
#pragma unroll
    for (int jb = 0; jb < 2; ++jb)
#pragma unroll
      for (int g4 = 0; g4 < 4; ++g4)
        *(float4*)(dst + 32 * jb + 8 * g4) = make_float4(acc[jb][4 * g4], acc[jb][4 * g4 + 1], acc[jb][4 * g4 + 2], acc[jb][4 * g4 + 3]);
  }
}
__device__ __forceinline__ void phase_gla2(PRef p) {
  for (int idx = bid_() * 256 + tid_(); idx < 32 * 8192; idx += vgrid_() * 256) {
    const int ch = idx >> 13, e = idx & 8191;
    float S = 0.f;
    const float* kv = p.KVt + (size_t)ch * NCHUNK * 8192 + e;
    const float* dc = p.decay + (size_t)ch * NCHUNK * 64 + (e & 63);
    bf16_t* sp = p.SP + (size_t)ch * NCHUNK * 8192 + e;
#pragma unroll 1
    for (int c0 = 0; c0 < NCHUNK; c0 += 17) {
      float kvv[17], dcv[17];
#pragma unroll
      for (int j = 0; j < 17; ++j) { kvv[j] = kv[(size_t)(c0 + j) * 8192]; dcv[j] = dc[(c0 + j) * 64]; }
#pragma unroll
      for (int j = 0; j < 17; ++j) { sp[(size_t)(c0 + j) * 8192] = f2bf(S); S = dcv[j] * S + kvv[j]; }
    }
  }
}
__device__ __forceinline__ void phase_gla3(PRef p, int layer, char* smem) {
  float* sWg = (float*)smem;
  float* sBc = (float*)(smem + 4096);
  bf16_t* sQ = (bf16_t*)(smem + 20736);
  bf16_t* sK = (bf16_t*)(smem + 29952);
  bf16_t* sVt = (bf16_t*)(smem + 39168);
  float* sRed = (float*)(smem + 57600);
  const int tid = tid_(), lane = tid & 63, w = tid >> 6, r = lane & 31, hh = lane >> 5;
  const int npc = layer == 0 ? 68 : 64;
  const int pr = 16 * (r >> 4) + 8 * ((r >> 2) & 1) + 4 * ((r >> 3) & 1) + (r & 3);
  for (int item = bid_(); item < 16 * npc; item += vgrid_()) {
    const int bh = item / npc;
    const int pca = (layer == 0) ? (item % npc) : (4 + item % npc);
    const int b = bh >> 2, hd = bh & 3;
    int tok0, pall0;
    chunk_pos(b, 0, pca, tok0, pall0);
    f32x16 O[2];
    O[0] = zero16();
    O[1] = zero16();
    const int c0 = pca, c1 = (pca < 4) ? 3 - pca : 4 + (63 - (pca - 4));
    f32x4v bA[4], bB[4];
    u32x4 q0, q1, k0, k1, vv0, vv1, vv2, vv3;
    {
      const int pos = tid >> 2, dg = tid & 3;
      const float* b0p = p.bcum + ((size_t)((b * 4 + hd) * 2 + 0) * NCHUNK + c0) * 4096 + pos * 64 + dg * 16;
      const float* b1p = p.bcum + ((size_t)((b * 4 + hd) * 2 + 1) * NCHUNK + c1) * 4096 + pos * 64 + dg * 16;
#pragma unroll
      for (int q4 = 0; q4 < 4; ++q4) { bA[q4] = *(const f32x4v*)(b0p + 4 * q4); bB[q4] = *(const f32x4v*)(b1p + 4 * q4); }
      const bf16_t* qp = p.qB + (size_t)(tok0 + pos) * 256 + hd * 64 + dg * 16;
      const bf16_t* kp = p.kB + (size_t)(tok0 + pos) * 256 + hd * 64 + dg * 16;
      q0 = *(const u32x4*)qp; q1 = *(const u32x4*)(qp + 8);
      k0 = *(const u32x4*)kp; k1 = *(const u32x4*)(kp + 8);
      const bf16_t* vb = p.vBT + (size_t)(b * 4 + hd) * 128 * PALL + pall0 + (tid & 7) * 8;
      vv0 = *(const u32x4*)(vb + (size_t)(tid >> 3) * PALL);
      vv1 = *(const u32x4*)(vb + (size_t)((tid >> 3) + 32) * PALL);
      vv2 = *(const u32x4*)(vb + (size_t)((tid >> 3) + 64) * PALL);
      vv3 = *(const u32x4*)(vb + (size_t)((tid >> 3) + 96) * PALL);
    }
    typedef unsigned u32x2v __attribute__((ext_vector_type(2)));
    u32x2v rrv[2][4];
#pragma unroll
    for (int tb = 0; tb < 2; ++tb)
#pragma unroll
      for (int g4 = 0; g4 < 4; ++g4)
        rrv[tb][g4] = *(const u32x2v*)(p.rB + (size_t)(tok0 + 32 * tb + r) * 512 + hd * 128 + 32 * w + 8 * g4 + 4 * hh);
    __syncthreads();
    {
      const int dv = tid >> 3, cc = tid & 7;
      *(u32x4*)(sVt + dv * 72 + cc * 8) = vv0;
      *(u32x4*)(sVt + (dv + 32) * 72 + cc * 8) = vv1;
      *(u32x4*)(sVt + (dv + 64) * 72 + cc * 8) = vv2;
      *(u32x4*)(sVt + (dv + 96) * 72 + cc * 8) = vv3;
    }
#pragma unroll
    for (int dir = 0; dir < 2; ++dir) {
      if (dir == 1) __syncthreads();
      {
        int pos = tid >> 2, dg = tid & 3;
        unsigned qu[8] = {q0[0], q0[1], q0[2], q0[3], q1[0], q1[1], q1[2], q1[3]};
        unsigned ku[8] = {k0[0], k0[1], k0[2], k0[3], k1[0], k1[1], k1[2], k1[3]};
        unsigned qo[8], ko[8];
#pragma unroll
        for (int e2 = 0; e2 < 8; ++e2) {
          const float b0 = dir ? bB[e2 >> 1][(2 * e2) & 3] : bA[e2 >> 1][(2 * e2) & 3];
          const float b1 = dir ? bB[e2 >> 1][(2 * e2 + 1) & 3] : bA[e2 >> 1][(2 * e2 + 1) & 3];
          const float ea0 = __expf(b0), ea1 = __expf(b1), ia0 = __builtin_amdgcn_rcpf(ea0), ia1 = __builtin_amdgcn_rcpf(ea1);
          qo[e2] = pack2(bf2f((bf16_t)(qu[e2] & 0xffff)) * ea0, bf2f((bf16_t)(qu[e2] >> 16)) * ea1);
          ko[e2] = pack2(bf2f((bf16_t)(ku[e2] & 0xffff)) * ia0, bf2f((bf16_t)(ku[e2] >> 16)) * ia1);
        }
        *(uint4*)(sQ + pos * 72 + dg * 16) = make_uint4(qo[0], qo[1], qo[2], qo[3]);
        *(uint4*)(sQ + pos * 72 + dg * 16 + 8) = make_uint4(qo[4], qo[5], qo[6], qo[7]);
        *(uint4*)(sK + pos * 72 + dg * 16) = make_uint4(ko[0], ko[1], ko[2], ko[3]);
        *(uint4*)(sK + pos * 72 + dg * 16 + 8) = make_uint4(ko[4], ko[5], ko[6], ko[7]);
      }
      __syncthreads();
      const int c = dir ? c1 : c0;
      const int ch = (b * 4 + hd) * 2 + dir;
      const bf16_t* sp = p.SP + ((size_t)ch * NCHUNK + c) * 8192 + (size_t)(32 * w + r) * 64 + 8 * hh;
      bf16x8 bqf[2][4];
#pragma unroll
      for (int tb = 0; tb < 2; ++tb)
#pragma unroll
        for (int ks = 0; ks < 4; ++ks) bqf[tb][ks] = *(const bf16x8*)(sQ + (32 * tb + r) * 72 + 16 * ks + 8 * hh);
#pragma unroll
      for (int ks = 0; ks < 4; ++ks) {
        bf16x8 a = *(const bf16x8*)(sp + 16 * ks);
        O[0] = mfma32(a, bqf[0][ks], O[0]);
        O[1] = mfma32(a, bqf[1][ks], O[1]);
      }
#pragma unroll
      for (int sb = 0; sb < 2; ++sb)
#pragma unroll
        for (int tb = 0; tb < 2; ++tb) {
          const bool skip = dir == 0 ? (sb == 1 && tb == 0) : (sb == 0 && tb == 1);
          if (skip) continue;
          f32x16 Sc = zero16();
#pragma unroll
          for (int ks = 0; ks < 4; ++ks) {
            bf16x8 a = *(const bf16x8*)(sK + (32 * sb + pr) * 72 + 16 * ks + 8 * hh);
            Sc = mfma32(a, bqf[tb][ks], Sc);
          }
          const int t = 32 * tb + r;
#pragma unroll
          for (int g = 0; g < 16; ++g) {
            int s = 32 * sb + 16 * (g >> 3) + 4 * ((g >> 2) & 1) + (g & 3) + 8 * hh;
            bool keep = dir == 0 ? (t >= s) : (s >= t);
            Sc[g] = keep ? Sc[g] : 0.f;
          }
#pragma unroll
          for (int s2 = 0; s2 < 2; ++s2) {
            const int sp4 = 2 * sb + s2;
            u32x4 bpu = {pack2(Sc[8 * s2], Sc[8 * s2 + 1]), pack2(Sc[8 * s2 + 2], Sc[8 * s2 + 3]), pack2(Sc[8 * s2 + 4], Sc[8 * s2 + 5]),
                         pack2(Sc[8 * s2 + 6], Sc[8 * s2 + 7])};
            bf16x8 bp = __builtin_bit_cast(bf16x8, bpu);
            bf16x8 av = *(const bf16x8*)(sVt + (32 * w + r) * 72 + 16 * sp4 + 8 * hh);
            O[tb] = mfma32(av, bp, O[tb]);
          }
        }
    }
    float ss[2];
#pragma unroll
    for (int tb = 0; tb < 2; ++tb) {
      float s = 0.f;
#pragma unroll
      for (int g = 0; g < 16; ++g) s += O[tb][g] * O[tb][g];
      s += __shfl_xor(s, 32);
      ss[tb] = s;
    }
    if (hh == 0) { sRed[w * 64 + r] = ss[0]; sRed[w * 64 + 32 + r] = ss[1]; }
    __syncthreads();
    f32x4v gnv[4];
#pragma unroll
    for (int g4 = 0; g4 < 4; ++g4) gnv[g4] = *(const f32x4v*)(p.gla_norm + layer * 128 + 32 * w + 8 * g4 + 4 * hh);
#pragma unroll
    for (int tb = 0; tb < 2; ++tb) {
      int t = 32 * tb + r;
      float tot = sRed[t] + sRed[64 + t] + sRed[128 + t] + sRed[192 + t];
      float rstd = rsqrtf(tot * (1.f / 128.f) + 1e-6f);
      const int tok = tok0 + t;
#pragma unroll
      for (int g4 = 0; g4 < 4; ++g4) {
        int dv = 32 * w + 8 * g4 + 4 * hh;
        const u32x2v rr = rrv[tb][g4];
        float rg[4] = {bf2f((bf16_t)(rr[0] & 0xffff)), bf2f((bf16_t)(rr[0] >> 16)), bf2f((bf16_t)(rr[1] & 0xffff)), bf2f((bf16_t)(rr[1] >> 16))};
        float o[4];
#pragma unroll
        for (int e = 0; e < 4; ++e) o[e] = O[tb][4 * g4 + e] * rstd * gnv[g4][e] * siluf(rg[e]);
        *(uint2*)(p.oB + (size_t)tok * 512 + hd * 128 + dv) = make_uint2(pack2(o[0], o[1]), pack2(o[2], o[3]));
      }
    }
  }
}

#define PHASE_KERNEL(name, call)                                               \
  __global__ void __launch_bounds__(512, 2) name(Params p_, int layer) {       \
    __shared__ __attribute__((aligned(16))) char smem_all[2 * SMEM_BYTES];     \
    char* smem = smem_all + half_() * SMEM_BYTES;                              \
    PRef p = params_view();                                           \
    call;                                                                      \
  }
PHASE_KERNEL(k_setup, phase_setup(p, smem))
PHASE_KERNEL(k_modreduce, phase_modreduce(p))
PHASE_KERNEL(k_convert, phase_convert(p, layer, smem))
PHASE_KERNEL(k_rowpass0, phase_rowpass0(p))
PHASE_KERNEL(k_inproj, phase_inproj(p, layer, smem_all))
PHASE_KERNEL(k_attnA, phase_attnA(p, layer, smem_all))
PHASE_KERNEL(k_na, phase_na(p, layer, smem))
PHASE_KERNEL(k_gla1, phase_gla1(p, layer, smem))
PHASE_KERNEL(k_gla2, phase_gla2(p))
PHASE_KERNEL(k_gla3, phase_gla3(p, layer, smem))
PHASE_KERNEL(k_merge, phase_merge(p, layer, smem_all))
PHASE_KERNEL(k_outproj, phase_outproj(p, layer, smem_all))
PHASE_KERNEL(k_rowpass1, phase_rowpass1(p, layer, smem))
PHASE_KERNEL(k_moescan, phase_moescan(p, layer, smem))
PHASE_KERNEL(k_moe1, phase_moe1(p, layer, smem_all))
PHASE_KERNEL(k_moe2, phase_moe2(p, layer, smem_all))
PHASE_KERNEL(k_rowpass2, phase_rowpass2(p, layer))

#define XB_TMO      128
#define XB_XCNT(j)  (256  + 64 * (j))
#define XB_XSUB(j)  (1280 + 64 * (j))
#define XB_XGEN(j)  (2304 + 64 * (j))
#define XB_TOP      3328
#define XB_TOPGEN   3392
#define XCD_BAR_WORDS 3456
#define XB_SPIN_CAP (1u << 23)
#define LAS __attribute__((address_space(3)))
__device__ __forceinline__ unsigned xb_ld(unsigned* p) { return __hip_atomic_load(p, __ATOMIC_RELAXED, __HIP_MEMORY_SCOPE_AGENT); }
__device__ __forceinline__ unsigned xb_add(unsigned* p, unsigned v) { return __hip_atomic_fetch_add(p, v, __ATOMIC_RELAXED, __HIP_MEMORY_SCOPE_AGENT); }
__device__ __forceinline__ unsigned xb_xcc_id() { return (unsigned)__builtin_amdgcn_s_getreg((3 << 11) | 20) & 0xFu; }
#define XB_SPIN(cond, bar) do { unsigned _sp = 0; while (cond) { __builtin_amdgcn_s_sleep(1); \
    if ((++_sp & 255u) == 0u) { if (xb_ld(&(bar)[XB_TMO])) break; if (_sp > XB_SPIN_CAP) { atomicAdd(&(bar)[XB_TMO], 1u); break; } } } } while (0)
struct XcdBarrier { unsigned* bar; unsigned x; volatile LAS unsigned* st; };
__device__ __forceinline__ XcdBarrier xcd_barrier_post(unsigned* bar, volatile LAS unsigned* st) {
  XcdBarrier b; b.bar = bar; b.x = xb_xcc_id(); b.st = st;
  if (__builtin_amdgcn_workitem_id_x() == 0) (void)xb_add(&bar[XB_XCNT(b.x)], 1u);
  return b;
}
__device__ __forceinline__ void xcd_barrier_complete(unsigned* bar, unsigned x, unsigned& nloc, unsigned& nx) {
  const unsigned G = gridDim.x * gridDim.y * gridDim.z;
  unsigned sum, cnt, mine, sp = 0u;
  for (;;) {
    sum = 0u; cnt = 0u; mine = 0u;
#pragma unroll
    for (unsigned j = 0; j < 16; ++j) { const unsigned c = xb_ld(&bar[XB_XCNT(j)]); sum += c; cnt += (c > 0u) ? 1u : 0u; mine = (j == x) ? c : mine; }
    if (sum == G) break;
    __builtin_amdgcn_s_sleep(1);
    if ((++sp & 255u) == 0u) { if (xb_ld(&bar[XB_TMO])) break; if (sp > XB_SPIN_CAP) { atomicAdd(&bar[XB_TMO], 1u); break; } }
  }
  nloc = mine > 0u ? mine : 1u; nx = cnt > 0u ? cnt : 1u;
}
__device__ __forceinline__ void xcd_barrier(const XcdBarrier& b) {
  asm volatile("s_waitcnt vmcnt(0)" ::: "memory");
  __syncthreads();
  if (__builtin_amdgcn_workitem_id_x() == 0) {
    unsigned* bar = b.bar;
    __builtin_amdgcn_s_waitcnt(0);
    unsigned nloc = b.st[0], nx = b.st[1];
    if (nloc == 0u) { xcd_barrier_complete(bar, b.x, nloc, nx); b.st[0] = nloc; b.st[1] = nx; }
    const unsigned old = xb_add(&bar[XB_XSUB(b.x)], 1u);
    const unsigned gen = old / nloc;
    if (old + 1u == (gen + 1u) * nloc) {
      __builtin_amdgcn_fence(__ATOMIC_RELEASE, "agent");
      asm volatile("s_waitcnt vmcnt(0)" ::: "memory");
      const unsigned og = xb_add(&bar[XB_TOP], 1u);
      const unsigned tg = og / nx;
      if (og + 1u == (tg + 1u) * nx) xb_add(&bar[XB_TOPGEN], 1u);
      else XB_SPIN(xb_ld(&bar[XB_TOPGEN]) == tg, bar);
      __builtin_amdgcn_fence(__ATOMIC_ACQUIRE, "agent");
      xb_add(&bar[XB_XGEN(b.x)], 1u);
      asm volatile("s_waitcnt vmcnt(0)" ::: "memory");
    } else {
      XB_SPIN(xb_ld(&bar[XB_XGEN(b.x)]) == gen, bar);
      __builtin_amdgcn_fence(__ATOMIC_ACQUIRE, "agent");
      asm volatile("s_waitcnt vmcnt(0)" ::: "memory");
    }
  }
  __syncthreads();
}

__global__ void __launch_bounds__(512, 2) k_mega(Params p_) {
  __shared__ __attribute__((aligned(16))) char smem_all[2 * SMEM_BYTES + 16];
  volatile LAS unsigned* st = (volatile LAS unsigned*)(smem_all + 2 * SMEM_BYTES);
  if (__builtin_amdgcn_workitem_id_x() == 0) { st[0] = 0u; st[1] = 0u; }
  __syncthreads();
  const XcdBarrier xb = xcd_barrier_post(p_.bar, st);
#pragma unroll 1
  for (int ph = 0; ph < 25; ++ph) {
    int l = (ph >= 14) ? 1 : 0;
    int q = (ph < 3) ? ph : 3 + (ph - 3) % 11;
    l = __builtin_amdgcn_readfirstlane(l);
    q = __builtin_amdgcn_readfirstlane(q);
#ifdef PROBE_MASK
    const unsigned long long pt0 = __builtin_amdgcn_s_memrealtime();
#endif
    PRef p = params_view();
    char* smem = smem_all + half_() * SMEM_BYTES;
    switch (q) {
      case 0: phase_setup(p, smem); phase_convert(p, 0, smem); break;
      case 1: phase_modreduce(p); break;
      case 2: phase_rowpass0(p); break;
      case 3: phase_inproj(p, l, smem_all); break;
      case 4: phase_gla1(p, l, smem); phase_na(p, l, smem); break;
      case 5: phase_gla2(p); phase_attnA(p, l, smem_all); break;
      case 6: phase_gla3(p, l, smem); break;
      case 7: phase_merge(p, l, smem_all); break;
      case 8: phase_outproj(p, l, smem_all); break;
      case 9: phase_rowpass1(p, l, smem); break;
      case 10: phase_moescan(p, l, smem); phase_convert(p, l | 16, smem); break;
      case 11: phase_moe1(p, l, smem_all); break;
      case 12: phase_moe2(p, l, smem_all); break;
      default: phase_rowpass2(p, l); if (l == 0) phase_convert(p, 1, smem); break;
    }
    if (ph != 24) xcd_barrier(xb);
#ifdef PROBE_MASK
    if ((PROBE_MASK >> q) & 1) {
      const unsigned long long pt1 = __builtin_amdgcn_s_memrealtime();
      while (__builtin_amdgcn_s_memrealtime() - pt1 < (pt1 - pt0)) __builtin_amdgcn_s_sleep(8);
    }
#endif
  }
}

#ifdef DIAG_STAGE
__device__ __forceinline__ unsigned dhash(unsigned s) { s ^= s >> 16; s *= 0x7feb352dU; s ^= s >> 15; s *= 0x846ca68bU; s ^= s >> 16; return s; }
__device__ __forceinline__ void diag_accum(double num, double den, double* accum, double* sred) {
  const int tid = threadIdx.x;
  __syncthreads();
  sred[tid] = num; sred[256 + tid] = den;
  __syncthreads();
  for (int o = 128; o > 0; o >>= 1) { if (tid < o) { sred[tid] += sred[tid + o]; sred[256 + tid] += sred[256 + tid + o]; } __syncthreads(); }
  if (tid == 0) { atomicAdd(&accum[0], sred[0]); atomicAdd(&accum[1], sred[256]); }
}
__device__ __forceinline__ int diag_tok(int s, int ns) {
  if (s < 8) return TLAT + (dhash(s + 77) % TCTX);
  if (s == 8) return 0; if (s == 9) return TLAT - 1; if (s == 10) return 4095; if (s == 11) return 4096;
  return dhash(s * 31 + 5) % TLAT;
}
__global__ void k_diag_zero(double* accum) { if (threadIdx.x < 32) accum[threadIdx.x] = 0.0; }
__global__ void k_diag_report(const double* accum, float* out, int n) {
  int i = blockIdx.x * 256 + threadIdx.x;
  for (; i < n; i += gridDim.x * 256) out[i] = 0.f;
  if (blockIdx.x == 0 && threadIdx.x == 0) {
    double E = 0.0;
    for (int k = 0; k < 16; ++k) {
      if (accum[2 * k + 1] > 0.0) { double e = accum[2 * k] / accum[2 * k + 1]; if (!(e == e)) e = 100.0; if (e > E) E = e; }
    }
    out[0] = (float)(4.096e7 * sqrt(E));
  }
}
__global__ void __launch_bounds__(256) k_chk_h(Params p, double* accum) {
  __shared__ double sred[512];
  __shared__ float sx[1024];
  const int tid = threadIdx.x;
  int tok = diag_tok(blockIdx.x, gridDim.x);
  const float* src = tok < TLAT ? p.x + (size_t)tok * D : p.ctx + (size_t)(tok - TLAT) * D;
  const float* cv = tok < TLAT ? p.c + (tok >> 12) * 1024 : p.c_ctx;
  double s = 0, q = 0;
  for (int i = 0; i < 1024; ++i) s += src[i];
  double mean = s / 1024;
  for (int i = 0; i < 1024; ++i) { double d = src[i] - mean; q += d * d; }
  double rstd = 1.0 / sqrt(q / 1024 + 1e-6);
  double num = 0, den = 0;
  for (int n = tid; n < 1024; n += 256) {
    double sh = p.b_mod[n], sc = p.b_mod[1024 + n];
    for (int k = 0; k < 1024; ++k) {
      double cc = cv[k]; double sl = cc / (1.0 + exp(-cc));
      sh += sl * p.w_mod[(size_t)k * NMOD + n];
      sc += sl * p.w_mod[(size_t)k * NMOD + 1024 + n];
    }
    double ref = (src[n] - mean) * rstd * (1.0 + sc) + sh;
    double got = bf2f(p.h[(size_t)tok * D + n]);
    num += (got - ref) * (got - ref); den += ref * ref;
  }
  diag_accum(num, den, accum, sred);
}
__global__ void __launch_bounds__(256) k_chk_inproj(Params p, int layer, double* accum) {
  __shared__ double sred[512];
  __shared__ float sz[3872];
  __shared__ float sh[1024];
  const int tid = threadIdx.x;
  int tok = diag_tok(blockIdx.x, gridDim.x);
  for (int i = tid; i < 1024; i += 256) sh[i] = bf2f(p.h[(size_t)tok * D + i]);
  __syncthreads();
  const float* W = p.w_in + (size_t)layer * 1024 * NIN_SRC;
  for (int j = tid; j < 3872; j += 256) {
    double a = p.b_in[layer * NIN_SRC + j];
    for (int k = 0; k < 1024; ++k) a += (double)sh[k] * W[(size_t)k * NIN_SRC + j];
    sz[j] = (float)a;
  }
  __syncthreads();
  const bool lat = tok < TLAT;
  int b, t, pall;
  if (lat) { b = tok >> 12; t = tok & 4095; pall = 256 + t; } else { int ci = tok - TLAT; b = ci >> 8; t = ci & 255; pall = t; }
  double num = 0, den = 0;
  for (int j = tid; j < 3872; j += 256) {
    double ref, got;
    if (j < 640) {
      int hb = (j >> 6) << 6, d = j & 63;
      double ss = 0;
      for (int e = 0; e < 64; ++e) ss += (double)sz[hb + e] * sz[hb + e];
      double rstd = 1.0 / sqrt(ss / 64 + 1e-6);
      const float* gn = (j < 512 ? p.q_norm : p.k_norm) + layer * 64;
      double xn = sz[j] * rstd * gn[d];
      if (lat) {
        int qd = d >> 4, f = d & 15;
        int dp = d ^ 16;
        double pn = sz[hb + dp] * rstd * gn[dp];
        double pos = (qd < 2) ? (double)(t >> 6) : (double)(t & 63);
        float inv = powf(10000.f, -(float)f / 16.f);
        float ang = (float)pos * inv;
        double cs = cos((double)ang), sn = sin((double)ang);
        double rot = (qd & 1) ? pn : -pn;
        xn = xn * cs + rot * sn;
      }
      if (j < 512) { ref = xn * QSCALE; got = bf2f(p.qA[(size_t)tok * 512 + j]); }
      else { int kvh = (j - 512) >> 6; ref = xn; got = bf2f(p.kA[((size_t)(b * 2 + kvh) * PALL + pall) * 64 + d]); }
    } else if (j < 768) { int c = j - 640; ref = sz[j]; got = bf2f(p.vAT[((size_t)(b * 2 + (c >> 6)) * 64 + (c & 63)) * PALL + pall]); }
    else if (j < 1024) { ref = sz[j] * 0.125; got = bf2f(p.qB[(size_t)tok * 256 + (j - 768)]); }
    else if (j < 1280) { ref = sz[j]; got = bf2f(p.kB[(size_t)tok * 256 + (j - 1024)]); }
    else if (j < 1792) { int c = j - 1280; ref = sz[j]; got = bf2f(p.vBT[((size_t)(b * 4 + (c >> 7)) * 128 + (c & 127)) * PALL + pall]); }
    else if (j < 2304) { ref = sz[j]; got = bf2f(p.rB[(size_t)tok * 512 + (j - 1792)]); }
    else if (j < 2336) { ref = sz[j]; got = p.aB[(size_t)tok * 32 + (j - 2304)]; }
    else if (j < 2848) { ref = sz[j] * QSCALE; got = bf2f(p.qC[(size_t)tok * 512 + (j - 2336)]); }
    else if (j < 3360) { ref = sz[j]; got = bf2f(p.kC[(size_t)tok * 512 + (j - 2848)]); }
    else { int c = j - 3360; ref = sz[j]; got = bf2f(p.vCT[((size_t)(b * 8 + (c >> 6)) * 64 + (c & 63)) * PALL + pall]); }
    num += (got - ref) * (got - ref); den += ref * ref;
  }
  diag_accum(num, den, accum, sred);
}
__global__ void __launch_bounds__(256) k_chk_attnA(Params p, int layer, double* accum) {
  __shared__ double sred[512];
  __shared__ float sp[4352];
  __shared__ float sq[64];
  __shared__ float so[64];
  const int tid = threadIdx.x;
  int tok = diag_tok(blockIdx.x >> 1, gridDim.x);
  if (layer == 1 && tok >= TLAT) tok = dhash(blockIdx.x) % TLAT;
  int head = dhash(blockIdx.x * 7 + 1) & 7, kvh = head >> 2;
  const bool lat = tok < TLAT;
  int b = lat ? tok >> 12 : (tok - TLAT) >> 8;
  int nk = lat ? PALL : 256;
  if (tid < 64) sq[tid] = bf2f(p.qA[(size_t)tok * 512 + head * 64 + tid]);
  __syncthreads();
  const bf16_t* kb = p.kA + (size_t)(b * 2 + kvh) * PALL * 64;
#pragma unroll 1
  for (int j = tid; j < nk; j += 256) {
    float s = 0.f;
#pragma unroll 1
    for (int d = 0; d < 64; ++d) s += sq[d] * bf2f(kb[(size_t)j * 64 + d]);
    sp[j] = s;
  }
  __syncthreads();
  float mx = -1e30f;
#pragma unroll 1
  for (int j = 0; j < nk; ++j) mx = fmaxf(mx, sp[j]);
  __syncthreads();
  for (int j = tid; j < nk; j += 256) sp[j] = exp2f(sp[j] - mx);
  __syncthreads();
  double num = 0, den = 0;
  if (tid < 64) {
    double l = 0, o = 0;
    const bf16_t* vb = p.vAT + ((size_t)(b * 2 + kvh) * 64 + tid) * PALL;
#pragma unroll 1
    for (int j = 0; j < nk; ++j) { l += sp[j]; o += (double)sp[j] * bf2f(vb[j]); }
    double ref = o / l, got = bf2f(p.oA[(size_t)tok * 512 + head * 64 + tid]);
    num = (got - ref) * (got - ref); den = ref * ref;
  }
  diag_accum(num, den, accum, sred);
}
__global__ void __launch_bounds__(256) k_chk_na(Params p, int layer, double* accum) {
  __shared__ double sred[512];
  __shared__ float sp[384];
  __shared__ int spos[384];
  __shared__ float sq[64];
  const int tid = threadIdx.x;
  int tok = diag_tok(blockIdx.x >> 1, gridDim.x);
  if (layer == 1 && tok >= TLAT) tok = dhash(blockIdx.x) % TLAT;
  int head = dhash(blockIdx.x * 13 + 3) & 7;
  const bool lat = tok < TLAT;
  int b = lat ? tok >> 12 : (tok - TLAT) >> 8;
  if (tid < 64) sq[tid] = bf2f(p.qC[(size_t)tok * 512 + head * 64 + tid]);
  __syncthreads();
  int nk = lat ? 384 : 256;
  for (int j = tid; j < nk; j += 256) {
    int ktok, kpall; float bias = 0.f;
    if (lat && j < 128) {
      int t = tok & 4095, r = t >> 6, w = t & 63;
      int rs = r - 4; rs = rs < 0 ? 0 : (rs > 56 ? 56 : rs);
      int cs = w - 8; cs = cs < 0 ? 0 : (cs > 48 ? 48 : cs);
      int i = j >> 4, jj = j & 15;
      int kr = rs + i, kc = cs + jj;
      ktok = b * 4096 + kr * 64 + kc; kpall = 256 + kr * 64 + kc;
      bias = p.rpb[(((size_t)layer * 8 + head) * 15 + (kr - r + 7)) * 31 + (kc - w + 15)] * LOG2E;
    } else {
      int c = lat ? j - 128 : j;
      ktok = TLAT + b * 256 + c; kpall = c;
    }
    float s = 0.f;
    for (int d = 0; d < 64; ++d) s += sq[d] * bf2f(p.kC[(size_t)ktok * 512 + head * 64 + d]);
    sp[j] = s + bias; spos[j] = kpall;
  }
  __syncthreads();
  float mx = -1e30f;
  for (int j = 0; j < nk; ++j) mx = fmaxf(mx, sp[j]);
  __syncthreads();
  for (int j = tid; j < nk; j += 256) sp[j] = exp2f(sp[j] - mx);
  __syncthreads();
  double num = 0, den = 0;
  if (tid < 64) {
    double l = 0, o = 0;
    const bf16_t* vb = p.vCT + ((size_t)(b * 8 + head) * 64 + tid) * PALL;
    for (int j = 0; j < nk; ++j) { l += sp[j]; o += (double)sp[j] * bf2f(vb[spos[j]]); }
    double ref = o / l, got = bf2f(p.oC[(size_t)tok * 512 + head * 64 + tid]);
    num = (got - ref) * (got - ref); den = ref * ref;
  }
  diag_accum(num, den, accum, sred);
}
__device__ constexpr int gla_sp(int i) { return i == 0 ? 0 : i == 1 ? 255 : i == 2 ? 256 : i == 3 ? 319 : i == 4 ? 320 : i == 5 ? 1257 : i == 6 ? 2756 : 4351; }
__global__ void __launch_bounds__(256) k_chk_gla(Params p, int layer, double* accum) {
  __shared__ double sred[512];
  __shared__ float sal[64], sqv[64], skv[64];
  __shared__ float sred2[128];
  const int tid = threadIdx.x;
  const int b = blockIdx.x >> 2, hd = blockIdx.x & 3;
  constexpr int NSP = 8;
  float osum[NSP];
#pragma unroll
  for (int i = 0; i < NSP; ++i) osum[i] = 0.f;
  for (int dir = 0; dir < 2; ++dir) {
    float S[64];
#pragma unroll
    for (int d = 0; d < 64; ++d) S[d] = 0.f;
#pragma unroll 1
    for (int step = 0; step < PALL; ++step) {
      int pall;
      if (step < 256) pall = dir ? 255 - step : step; else { int j = step - 256; pall = 256 + (dir ? 4095 - j : j); }
      int tok = pall < 256 ? TLAT + b * 256 + pall : b * 4096 + (pall - 256);
      __syncthreads();
      if (tid < 64) {
        float xv = p.gla_bg[((size_t)layer * 2 + dir) * 256 + hd * 64 + tid];
        for (int r = 0; r < 16; ++r) xv += p.aB[(size_t)tok * 32 + dir * 16 + r] * p.gla_wg[(((size_t)layer * 2 + dir) * 16 + r) * 256 + hd * 64 + tid];
        float ls = fminf(xv, 0.f) - log1pf(expf(-fabsf(xv)));
        sal[tid] = expf(ls / 16.f);
        sqv[tid] = bf2f(p.qB[(size_t)tok * 256 + hd * 64 + tid]);
        skv[tid] = bf2f(p.kB[(size_t)tok * 256 + hd * 64 + tid]);
      }
      __syncthreads();
      if (tid < 128) {
        float v = bf2f(p.vBT[((size_t)(b * 4 + hd) * 128 + tid) * PALL + pall]);
        float o = 0.f;
#pragma unroll
        for (int d = 0; d < 64; ++d) { S[d] = sal[d] * S[d] + skv[d] * v; o += sqv[d] * S[d]; }
#pragma unroll
        for (int i = 0; i < NSP; ++i) if (gla_sp(i) == pall) osum[i] += o;
      }
    }
  }
  double num = 0, den = 0;
#pragma unroll
  for (int i = 0; i < NSP; ++i) {
    if (layer == 1 && gla_sp(i) < 256) continue;
    __syncthreads();
    if (tid < 128) sred2[tid] = osum[i] * osum[i];
    __syncthreads();
    float tot = 0.f;
    for (int j = 0; j < 128; ++j) tot += sred2[j];
    if (tid < 128) {
      int pall = gla_sp(i);
      int tok = pall < 256 ? TLAT + b * 256 + pall : b * 4096 + (pall - 256);
      float rstd = 1.f / sqrtf(tot / 128.f + 1e-6f);
      float rg = bf2f(p.rB[(size_t)tok * 512 + hd * 128 + tid]);
      double ref = osum[i] * rstd * p.gla_norm[layer * 128 + tid] * (rg / (1.f + expf(-rg)));
      double got = bf2f(p.oB[(size_t)tok * 512 + hd * 128 + tid]);
      num += (got - ref) * (got - ref); den += ref * ref;
    }
  }
  diag_accum(num, den, accum, sred);
}
__global__ void __launch_bounds__(256) k_chk_merge(Params p, int layer, double* accum) {
  __shared__ double sred[512];
  const int tid = threadIdx.x;
  int tok = diag_tok(blockIdx.x, gridDim.x);
  if (layer == 1 && tok >= TLAT) tok = dhash(blockIdx.x) % TLAT;
  const float* W = p.w_in + (size_t)layer * 1024 * NIN_SRC;
  double num = 0, den = 0;
  for (int n = tid; n < 1024; n += 256) {
    double tot = 0;
    for (int br = 0; br < 3; ++br) {
      double g = p.b_in[layer * NIN_SRC + 3872 + br * 1024 + n];
      for (int k = 0; k < 1024; ++k) g += (double)bf2f(p.h[(size_t)tok * D + k]) * W[(size_t)k * NIN_SRC + 3872 + br * 1024 + n];
      g = 1.0 / (1.0 + exp(-g));
      const bf16_t* ob = br == 0 ? p.oA : (br == 1 ? p.oB : p.oC);
      const float* wb = (br == 0 ? p.w_br_attn : (br == 1 ? p.w_br_gla : p.w_br_na)) + (size_t)layer * 512 * 1024;
      double a = 0;
      for (int j = 0; j < 512; ++j) a += (double)bf2f(ob[(size_t)tok * 512 + j]) * wb[(size_t)j * 1024 + n];
      tot += g * a;
    }
    double got = bf2f(p.m[(size_t)tok * D + n]);
    num += (got - tot) * (got - tot); den += tot * tot;
  }
  diag_accum(num, den, accum, sred);
}
__global__ void __launch_bounds__(256) k_chk_x1(Params p, double* accum) {
  __shared__ double sred[512];
  __shared__ double sv[1024];
  __shared__ double sx1[1024];
  __shared__ double sst[4];
  const int tid = threadIdx.x;
  int tok = diag_tok(blockIdx.x, gridDim.x);
  const float* cv = tok < TLAT ? p.c + (tok >> 12) * 1024 : p.c_ctx;
  const float* xin = tok < TLAT ? p.x + (size_t)tok * D : p.ctx + (size_t)(tok - TLAT) * D;
  for (int n = tid; n < 1024; n += 256) {
    double y = 0, g1 = p.b_mod[2048 + n];
    for (int k = 0; k < 1024; ++k) {
      y += (double)bf2f(p.m[(size_t)tok * D + k]) * p.w_out[(size_t)k * 1024 + n];
      double cc = cv[k]; g1 += cc / (1.0 + exp(-cc)) * p.w_mod[(size_t)k * NMOD + 2048 + n];
    }
    sv[n] = 1.4142135623730951 * xin[n] + g1 * y;
  }
  __syncthreads();
  if (tid == 0) { double s = 0, q = 0; for (int i = 0; i < 1024; ++i) s += sv[i]; s /= 1024; for (int i = 0; i < 1024; ++i) q += (sv[i] - s) * (sv[i] - s); sst[0] = s; sst[1] = 1.0 / sqrt(q / 1024 + 1e-6); }
  __syncthreads();
  double num = 0, den = 0;
  for (int n = tid; n < 1024; n += 256) {
    double x1 = (sv[n] - sst[0]) * sst[1] * p.ln1_g[n] + p.ln1_b[n];
    sx1[n] = x1;
    double got = p.xres[(size_t)tok * D + n];
    num += (got - x1) * (got - x1); den += x1 * x1;
  }
  __syncthreads();
  if (tid == 0) { double s = 0, q = 0; for (int i = 0; i < 1024; ++i) s += sx1[i]; s /= 1024; for (int i = 0; i < 1024; ++i) q += (sx1[i] - s) * (sx1[i] - s); sst[2] = s; sst[3] = 1.0 / sqrt(q / 1024 + 1e-6); }
  __syncthreads();
  for (int n = tid; n < 1024; n += 256) {
    double sh = p.b_mod[3072 + n], sc = p.b_mod[4096 + n];
    for (int k = 0; k < 1024; ++k) { double cc = cv[k]; double sl = cc / (1.0 + exp(-cc)); sh += sl * p.w_mod[(size_t)k * NMOD + 3072 + n]; sc += sl * p.w_mod[(size_t)k * NMOD + 4096 + n]; }
    double h2 = (sx1[n] - sst[2]) * sst[3] * (1.0 + sc) + sh;
    double got = bf2f(p.h2[(size_t)tok * D + n]);
    num += (got - h2) * (got - h2); den += h2 * h2;
  }
  diag_accum(num, den, accum, sred);
}
__global__ void __launch_bounds__(256) k_chk_moe(Params p, int layer, int mode, double* accum) {
  __shared__ double sred[512];
  __shared__ float sh[1024];
  __shared__ float slog[36];
  __shared__ float shid[1024];
  __shared__ int se[2];
  __shared__ float sw[2];
  const int tid = threadIdx.x;
  int tok = diag_tok(blockIdx.x, gridDim.x);
  if (layer == 1 && tok >= TLAT) tok = dhash(blockIdx.x) % TLAT;
  for (int i = tid; i < 1024; i += 256) sh[i] = bf2f(p.h2[(size_t)tok * D + i]);
  __syncthreads();
  if (tid < 36) {
    double a;
    if (tid < 32) { a = p.b_re[layer * 32 + tid]; for (int k = 0; k < 1024; ++k) a += (double)sh[k] * p.w_re[((size_t)layer * 1024 + k) * 32 + tid]; }
    else { a = p.b_rg[layer * 4 + tid - 32]; for (int k = 0; k < 1024; ++k) a += (double)sh[k] * p.w_rg[((size_t)layer * 1024 + k) * 4 + tid - 32]; }
    slog[tid] = (float)a;
  }
  __syncthreads();
  if (tid == 0) {
    int grp = 0; for (int i = 1; i < 4; ++i) if (slog[32 + i] > slog[32 + grp]) grp = i;
    double gs = 0; for (int i = 0; i < 4; ++i) gs += exp((double)slog[32 + i] - slog[32 + grp]);
    double pg = 1.0 / gs;
    int i0 = 0; for (int i = 1; i < 8; ++i) if (slog[grp * 8 + i] > slog[grp * 8 + i0]) i0 = i;
    int i1 = -1; for (int i = 0; i < 8; ++i) if (i != i0 && (i1 < 0 || slog[grp * 8 + i] > slog[grp * 8 + i1])) i1 = i;
    double e1 = exp((double)slog[grp * 8 + i1] - slog[grp * 8 + i0]);
    se[0] = grp * 8 + i0; se[1] = grp * 8 + i1; sw[0] = (float)(pg / (1 + e1)); sw[1] = (float)(pg * e1 / (1 + e1));
  }
  __syncthreads();
  if (mode == 1) {
    double num = 0, den = 0;
    if (tid == 0) { den = 1.0; bool same = (p.tok_e[tok * 2] == se[0] && p.tok_e[tok * 2 + 1] == se[1]); num = same ? 0.0 : 1.0; }
    diag_accum(num, den, accum, sred);
    return;
  }
  int e0 = p.tok_e[tok * 2], e1 = p.tok_e[tok * 2 + 1];
  float w0 = p.tok_gate[tok * 2], w1 = p.tok_gate[tok * 2 + 1];
  double num = 0, den = 0;
  if (tid == 0 && e0 == se[0] && e1 == se[1]) { num += (w0 - sw[0]) * (w0 - sw[0]) + (w1 - sw[1]) * (w1 - sw[1]); }
  for (int i = tid; i < 1024; i += 256) {
    int k = i >> 9, j = i & 511, e = k ? e1 : e0;
    const float* w1p = p.w1 + ((size_t)layer * 32 + e) * 1024 * 512;
    const float* w3p = p.w3 + ((size_t)layer * 32 + e) * 1024 * 512;
    double a = 0, c = 0;
    for (int kk = 0; kk < 1024; ++kk) { a += (double)sh[kk] * w1p[(size_t)kk * 512 + j]; c += (double)sh[kk] * w3p[(size_t)kk * 512 + j]; }
    shid[i] = (float)(a / (1.0 + exp(-a)) * c);
  }
  __syncthreads();
  int s0 = p.estart[e0] * MOE_BLK + p.tok_pos[tok * 2], s1 = p.estart[e1] * MOE_BLK + p.tok_pos[tok * 2 + 1];
  for (int n = tid; n < 1024; n += 256) {
    double y = 0;
    const float* w2a = p.w2 + ((size_t)layer * 32 + e0) * 512 * 1024;
    const float* w2b = p.w2 + ((size_t)layer * 32 + e1) * 512 * 1024;
    double ya = 0, yb = 0;
    for (int j = 0; j < 512; ++j) { ya += (double)shid[j] * w2a[(size_t)j * 1024 + n]; yb += (double)shid[512 + j] * w2b[(size_t)j * 1024 + n]; }
    y = w0 * ya + w1 * yb;
    double got = w0 * bf2f(p.ysl[(size_t)s0 * D + n]) + w1 * bf2f(p.ysl[(size_t)s1 * D + n]);
    num += (got - y) * (got - y); den += y * y;
  }
  diag_accum(num, den, accum, sred);
}
__global__ void k_saverows(Params p, float* xsave, int layer) {
  int tok = diag_tok(blockIdx.x, gridDim.x);
  if (layer == 1 && tok >= TLAT) tok = dhash(blockIdx.x) % TLAT;
  for (int i = threadIdx.x; i < 1024; i += 256) xsave[(size_t)blockIdx.x * 1024 + i] = p.xres[(size_t)tok * D + i];
}
__global__ void __launch_bounds__(256) k_chk_final(Params p, int layer, const float* xsave, double* accum) {
  __shared__ double sred[512];
  __shared__ double sv[1024];
  __shared__ double sst[4];
  const int tid = threadIdx.x;
  int tok = diag_tok(blockIdx.x, gridDim.x);
  if (layer == 1 && tok >= TLAT) tok = dhash(blockIdx.x) % TLAT;
  const float* cv = tok < TLAT ? p.c + (tok >> 12) * 1024 : p.c_ctx;
  int e0 = p.tok_e[tok * 2], e1 = p.tok_e[tok * 2 + 1];
  float w0 = p.tok_gate[tok * 2], w1 = p.tok_gate[tok * 2 + 1];
  int s0 = p.estart[e0] * MOE_BLK + p.tok_pos[tok * 2], s1 = p.estart[e1] * MOE_BLK + p.tok_pos[tok * 2 + 1];
  for (int n = tid; n < 1024; n += 256) {
    double g2 = p.b_mod[layer * NMOD + 5120 + n];
    for (int k = 0; k < 1024; ++k) { double cc = cv[k]; g2 += cc / (1.0 + exp(-cc)) * p.w_mod[((size_t)layer * 1024 + k) * NMOD + 5120 + n]; }
    double y = w0 * bf2f(p.ysl[(size_t)s0 * D + n]) + w1 * bf2f(p.ysl[(size_t)s1 * D + n]);
    sv[n] = 1.4142135623730951 * xsave[(size_t)blockIdx.x * 1024 + n] + g2 * y;
  }
  __syncthreads();
  if (tid == 0) { double s = 0, q = 0; for (int i = 0; i < 1024; ++i) s += sv[i]; s /= 1024; for (int i = 0; i < 1024; ++i) q += (sv[i] - s) * (sv[i] - s); sst[0] = s; sst[1] = 1.0 / sqrt(q / 1024 + 1e-6); }
  __syncthreads();
  double num = 0, den = 0;
  for (int n = tid; n < 1024; n += 256) {
    double x2 = (sv[n] - sst[0]) * sst[1] * p.ln2_g[layer * D + n] + p.ln2_b[layer * D + n];
    sv[n] = x2;
    double got = layer == 1 ? p.out[(size_t)tok * D + n] : p.xres[(size_t)tok * D + n];
    num += (got - x2) * (got - x2); den += x2 * x2;
  }
  __syncthreads();
  if (layer == 0) {
    if (tid == 0) { double s = 0, q = 0; for (int i = 0; i < 1024; ++i) s += sv[i]; s /= 1024; for (int i = 0; i < 1024; ++i) q += (sv[i] - s) * (sv[i] - s); sst[2] = s; sst[3] = 1.0 / sqrt(q / 1024 + 1e-6); }
    __syncthreads();
    for (int n = tid; n < 1024; n += 256) {
      double sh = p.b_mod[NMOD + n], sc = p.b_mod[NMOD + 1024 + n];
      for (int k = 0; k < 1024; ++k) { double cc = cv[k]; double sl = cc / (1.0 + exp(-cc)); sh += sl * p.w_mod[((size_t)1024 + k) * NMOD + n]; sc += sl * p.w_mod[((size_t)1024 + k) * NMOD + 1024 + n]; }
      double h = (sv[n] - sst[2]) * sst[3] * (1.0 + sc) + sh;
      double got = bf2f(p.h[(size_t)tok * D + n]);
      num += (got - h) * (got - h); den += h * h;
    }
  }
  diag_accum(num, den, accum, sred);
}
#endif

static inline size_t align_up(size_t v, size_t a) { return (v + a - 1) / a * a; }

extern "C" void kernel_launch(void* const* d_in, const int* in_sizes, int n_in, void* d_out, int out_size, void* d_ws, size_t ws_size,
                              hipStream_t stream) {
  Params p{};
  const float* const* in = (const float* const*)d_in;
  p.x = in[0]; p.c = in[1]; p.ctx = in[2]; p.c_ctx = in[3]; p.w_mod = in[4]; p.b_mod = in[5]; p.w_in = in[6]; p.b_in = in[7];
  p.q_norm = in[8]; p.k_norm = in[9]; p.gla_wg = in[10]; p.gla_bg = in[11]; p.gla_norm = in[12]; p.rpb = in[13];
  p.w_br_attn = in[14]; p.w_br_gla = in[15]; p.w_br_na = in[16]; p.w_out = in[17]; p.ln1_g = in[18]; p.ln1_b = in[19];
  p.w_rg = in[20]; p.b_rg = in[21]; p.w_re = in[22]; p.b_re = in[23]; p.w1 = in[24]; p.w3 = in[25]; p.w2 = in[26];
  p.ln2_g = in[27]; p.ln2_b = in[28];
  p.out = (float*)d_out;

  char* base = (char*)d_ws;
  size_t off = 0;
  auto take = [&](size_t bytes) { char* q = base + off; off = align_up(off + bytes, 256); return q; };
  p.mod_part = (float*)take((size_t)16 * 2 * 5 * NMOD * 4);
  p.mod = (float*)take((size_t)2 * 5 * NMOD * 4);
  p.rope = (float*)take(2048 * 4);
  p.wrp = (float*)take((size_t)2 * 49152 * 4);
  p.bar = (unsigned*)take(XCD_BAR_WORDS * 4);
  p.cnt = (int*)take(32 * 4);
  p.estart = (int*)take(32 * 4);
  p.cntg = (int*)take((size_t)1088 * 32 * 4);
  p.list = (int*)take((size_t)32 * MOE_CAP * 4);
  p.tok_e = (int*)take((size_t)TALL * 2 * 4);
  p.tok_pos = (int*)take((size_t)TALL * 2 * 4);
  p.tok_gate = (float*)take((size_t)TALL * 2 * 4);
  p.wt_in = (bf16_t*)take((size_t)3968 * 1024 * 2);
  p.wt_gate = (bf16_t*)take((size_t)3072 * 1024 * 2);
  p.wt_br = (bf16_t*)take((size_t)3 * 1024 * 512 * 2);
  p.wt_out = (bf16_t*)take((size_t)1024 * 1024 * 2);
  p.wt_13 = (bf16_t*)take((size_t)32 * 1024 * 1024 * 2);
  p.wt_2 = (bf16_t*)take((size_t)32 * 1024 * 512 * 2);
  p.G = p.wt_13;
  p.xres = (float*)take((size_t)TALL * D * 4);
  p.h = (bf16_t*)take((size_t)TALL * D * 2);
  size_t r1 = off;
  p.qA = (bf16_t*)take((size_t)TALL * 512 * 2);
  p.kA = (bf16_t*)take((size_t)4 * 2 * PALL * 64 * 2);
  p.vAT = (bf16_t*)take((size_t)4 * 2 * 64 * PALL * 2);
  p.qB = (bf16_t*)take((size_t)TALL * 256 * 2);
  p.kB = (bf16_t*)take((size_t)TALL * 256 * 2);
  p.vBT = (bf16_t*)take((size_t)4 * 4 * 128 * PALL * 2);
  p.rB = (bf16_t*)take((size_t)TALL * 512 * 2);
  p.aB = (float*)take((size_t)TALL * 32 * 4);
  p.qC = (bf16_t*)take((size_t)TALL * 512 * 2);
  p.kC = (bf16_t*)take((size_t)TALL * 512 * 2);
  p.vCT = (bf16_t*)take((size_t)4 * 8 * 64 * PALL * 2);
  p.oA = (bf16_t*)take((size_t)TALL * 512 * 2);
  p.oB = (bf16_t*)take((size_t)TALL * 512 * 2);
  p.oC = (bf16_t*)take((size_t)TALL * 512 * 2);
  size_t r1_end = off;
  {
    size_t o2 = r1;
    p.act = (bf16_t*)(base + o2); o2 = align_up(o2 + (size_t)MAX_MBLK * MOE_BLK * 512 * 2, 256);
    p.ysl = (bf16_t*)(base + o2); o2 = align_up(o2 + (size_t)MAX_MBLK * MOE_BLK * 1024 * 2, 256);
    if (o2 > r1_end) off = o2;
  }
  p.KVt = (float*)take((size_t)32 * NCHUNK * 8192 * 4);
  p.SP = (bf16_t*)take((size_t)32 * NCHUNK * 8192 * 2);
  p.decay = (float*)take((size_t)32 * NCHUNK * 64 * 4);
  p.bcum = (float*)take((size_t)32 * NCHUNK * 4096 * 4);
  p.m = (bf16_t*)p.KVt;
  p.h2 = p.SP;
  if (off > ws_size) {
    fprintf(stderr, "workspace too small: need %zu have %zu\n", off, ws_size);
    return;
  }
  const dim3 blk(256);
#ifdef DIAG_STAGE
  {
    double* accum = (double*)take(64);
    float* xsave = (float*)take((size_t)64 * 1024 * 4);
    if (off > ws_size) return;
    const int G = 1024;
    const int DL = DIAG_LAYER, DS = DIAG_STAGE;
    k_diag_zero<<<1, 64, 0, stream>>>(accum);
    k_setup<<<((769 + 96) + 1) / 2, dim3(512), 0, stream>>>(p, 0);
    k_convert<<<((2048) + 1) / 2, dim3(512), 0, stream>>>(p, 0);
    k_modreduce<<<((240) + 1) / 2, dim3(512), 0, stream>>>(p, 0);
    k_rowpass0<<<((G) + 1) / 2, dim3(512), 0, stream>>>(p, 0);
    if (DS == 1 || DS == 0) k_chk_h<<<32, blk, 0, stream>>>(p, accum + 2);
    for (int l = 0; l <= DL; ++l) {
      const bool chk = (l == DL);
      k_inproj<<<((G) + 1) / 2, dim3(512), 0, stream>>>(p, l);
      if (chk && (DS == 2 || DS == 0)) k_chk_inproj<<<64, blk, 0, stream>>>(p, l, accum + 4);
      k_gla1<<<((G) + 1) / 2, dim3(512), 0, stream>>>(p, l);
      k_na<<<((1088) + 1) / 2, dim3(512), 0, stream>>>(p, l);
      if (chk && (DS == 4 || DS == 0)) k_chk_na<<<128, blk, 0, stream>>>(p, l, accum + 8);
      k_gla2<<<((G) + 1) / 2, dim3(512), 0, stream>>>(p, l);
      k_attnA<<<((1088) + 1) / 2, dim3(512), 0, stream>>>(p, l);
      if (chk && (DS == 3 || DS == 0)) k_chk_attnA<<<128, blk, 0, stream>>>(p, l, accum + 6);
      k_gla3<<<((1088) + 1) / 2, dim3(512), 0, stream>>>(p, l);
      if (chk && (DS == 5 || DS == 0)) k_chk_gla<<<16, blk, 0, stream>>>(p, l, accum + 10);
      k_merge<<<((G) + 1) / 2, dim3(512), 0, stream>>>(p, l);
      if (chk && (DS == 6 || DS == 0)) k_chk_merge<<<32, blk, 0, stream>>>(p, l, accum + 12);
      k_outproj<<<((G) + 1) / 2, dim3(512), 0, stream>>>(p, l);
      k_rowpass1<<<((G) + 1) / 2, dim3(512), 0, stream>>>(p, l);
      if (chk && l == 0 && (DS == 7 || DS == 0)) k_chk_x1<<<32, blk, 0, stream>>>(p, accum + 14);
      k_moescan<<<((32) + 1) / 2, dim3(512), 0, stream>>>(p, l);
      k_convert<<<((2048) + 1) / 2, dim3(512), 0, stream>>>(p, l | 16);
    k_moe1<<<((G) + 1) / 2, dim3(512), 0, stream>>>(p, l);
      k_moe2<<<((G) + 1) / 2, dim3(512), 0, stream>>>(p, l);
      if (chk && (DS == 8 || DS == 0)) k_chk_moe<<<32, blk, 0, stream>>>(p, l, 0, accum + 16);
      if (chk && DS == 9) k_chk_moe<<<512, blk, 0, stream>>>(p, l, 1, accum + 18);
      if (chk && (DS == 10 || DS == 0)) k_saverows<<<32, blk, 0, stream>>>(p, xsave, l);
      k_rowpass2<<<((G) + 1) / 2, dim3(512), 0, stream>>>(p, l);
      if (chk && (DS == 10 || DS == 0)) k_chk_final<<<32, blk, 0, stream>>>(p, l, xsave, accum + 20);
      if (l == 0) k_convert<<<((2048) + 1) / 2, dim3(512), 0, stream>>>(p, 1);
    }
    k_diag_report<<<1024, blk, 0, stream>>>(accum, p.out, TLAT * D);
    return;
  }
#endif
#ifdef MK_MULTI
  const int G = 1024;
  k_setup<<<((769 + 96) + 1) / 2, dim3(512), 0, stream>>>(p, 0);
  k_convert<<<((2048) + 1) / 2, dim3(512), 0, stream>>>(p, 0);
  k_modreduce<<<((240) + 1) / 2, dim3(512), 0, stream>>>(p, 0);
  k_rowpass0<<<((G) + 1) / 2, dim3(512), 0, stream>>>(p, 0);
  for (int l = 0; l < 2; ++l) {
    k_inproj<<<((G) + 1) / 2, dim3(512), 0, stream>>>(p, l);
    k_gla1<<<((G) + 1) / 2, dim3(512), 0, stream>>>(p, l);
    k_na<<<((1088) + 1) / 2, dim3(512), 0, stream>>>(p, l);
    k_gla2<<<((G) + 1) / 2, dim3(512), 0, stream>>>(p, l);
    k_attnA<<<((1088) + 1) / 2, dim3(512), 0, stream>>>(p, l);
    k_gla3<<<((1088) + 1) / 2, dim3(512), 0, stream>>>(p, l);
    k_merge<<<((G) + 1) / 2, dim3(512), 0, stream>>>(p, l);
    k_outproj<<<((G) + 1) / 2, dim3(512), 0, stream>>>(p, l);
    k_rowpass1<<<((G) + 1) / 2, dim3(512), 0, stream>>>(p, l);
    k_moescan<<<((32) + 1) / 2, dim3(512), 0, stream>>>(p, l);
    k_convert<<<((2048) + 1) / 2, dim3(512), 0, stream>>>(p, l | 16);
    k_moe1<<<((G) + 1) / 2, dim3(512), 0, stream>>>(p, l);
    k_moe2<<<((G) + 1) / 2, dim3(512), 0, stream>>>(p, l);
    k_rowpass2<<<((G) + 1) / 2, dim3(512), 0, stream>>>(p, l);
    if (l == 0) k_convert<<<((2048) + 1) / 2, dim3(512), 0, stream>>>(p, 1);
  }
#else
  static int grid_blocks = 0;
  if (!grid_blocks) {
    int dev = 0, cus = 0, per_cu = 0;
    hipGetDevice(&dev);
    hipDeviceGetAttribute(&cus, hipDeviceAttributeMultiprocessorCount, dev);
    hipOccupancyMaxActiveBlocksPerMultiprocessor(&per_cu, k_mega, 512, 0);
    per_cu = 1;
    grid_blocks = cus * per_cu;
  }
  hipMemsetAsync(p.bar, 0, XCD_BAR_WORDS * 4, stream);
  k_mega<<<dim3(grid_blocks), dim3(512), 0, stream>>>(p);
#endif
}
```

```cpp
#include <hip/hip_runtime.h>
#include <hip/hip_cooperative_groups.h>
#include <stdint.h>
#include <stdio.h>
namespace cg = cooperative_groups;

typedef unsigned short bf16_t;
typedef __attribute__((ext_vector_type(8))) short bf16x8;
typedef __attribute__((ext_vector_type(4))) short bf16x4;
typedef __attribute__((ext_vector_type(16))) float f32x16;
typedef __attribute__((ext_vector_type(4))) unsigned u32x4;
typedef __attribute__((ext_vector_type(4))) float f32x4v;

#ifndef XCD_MAP_ENABLE
#define XCD_MAP_ENABLE 0
#endif
constexpr int D = 1024;
constexpr int TLAT = 16384, TCTX = 1024, TALL = 17408, PALL = 4352;
constexpr int NIN_SRC = 6944, NMOD = 6144;
constexpr int NT_IN = 31;
constexpr int SMEM_BYTES = 69632;
constexpr int LDC = 132;
constexpr float LOG2E = 1.4426950408889634f;
constexpr float QSCALE = 0.125f * LOG2E;
constexpr float ALPHA = 1.4142135623730951f;
constexpr int NCHUNK = 68;
constexpr int MOE_CAP = TALL;
constexpr int MOE_BLK = 256;
constexpr int MAX_MBLK = 168;

struct Params {
  const float *x, *c, *ctx, *c_ctx, *w_mod, *b_mod, *w_in, *b_in, *q_norm, *k_norm, *gla_wg, *gla_bg, *gla_norm, *rpb,
      *w_br_attn, *w_br_gla, *w_br_na, *w_out, *ln1_g, *ln1_b, *w_rg, *b_rg, *w_re, *b_re, *w1, *w3, *w2, *ln2_g, *ln2_b;
  float* out;
  float *mod_part, *mod, *rope, *wrp;
  bf16_t *wt_in, *wt_gate, *wt_br, *wt_out, *wt_13, *wt_2, *G;
  float* xres;
  bf16_t *h, *h2;
  bf16_t *qA, *kA, *vAT, *qB, *kB, *vBT, *rB;
  float* aB;
  bf16_t *qC, *kC, *vCT;
  bf16_t *oA, *oB, *oC;
  float* KVt;
  float* bcum;
  bf16_t* SP;
  float* decay;
  bf16_t* m;
  bf16_t *act, *ysl;
  int *cnt, *cntg, *list, *tok_e, *tok_pos, *estart;
  float* tok_gate;
  unsigned* bar;
};

typedef const __attribute__((address_space(4))) Params& PRef;
__device__ __forceinline__ PRef params_view() {
  const __attribute__((address_space(4))) Params* pp = (const __attribute__((address_space(4))) Params*)__builtin_amdgcn_kernarg_segment_ptr();
  asm volatile("" : "+s"(pp));
  return *pp;
}

__device__ __forceinline__ int tid_() { int t = __builtin_amdgcn_workitem_id_x() & 255; asm volatile("" : "+v"(t)); return t; }
__device__ __forceinline__ int half_() { int h = __builtin_amdgcn_readfirstlane(__builtin_amdgcn_workitem_id_x() >> 8); asm volatile("" : "+s"(h)); return h; }
__device__ __forceinline__ int bid_() { int t = 2 * __builtin_amdgcn_workgroup_id_x() + half_(); asm volatile("" : "+s"(t)); return t; }
__device__ __forceinline__ int vgrid_() { return 2 * (int)gridDim.x; }
typedef __attribute__((ext_vector_type(2))) __bf16 bf16x2n;
typedef __attribute__((ext_vector_type(2))) float f32x2n;
__device__ __forceinline__ bf16_t f2bf(float f) { return __builtin_bit_cast(bf16_t, (__bf16)f); }
__device__ __forceinline__ float bf2f(bf16_t b) { return __uint_as_float(((unsigned)b) << 16); }
__device__ __forceinline__ unsigned pack2(float a, float b) {
  f32x2n v = {a, b};
  return __builtin_bit_cast(unsigned, __builtin_convertvector(v, bf16x2n));
}
__device__ __forceinline__ float wave_sum(float v) {
  int x;
  x = __builtin_amdgcn_update_dpp(0, __float_as_int(v), 0xB1, 0xf, 0xf, true);  v += __int_as_float(x);
  x = __builtin_amdgcn_update_dpp(0, __float_as_int(v), 0x4E, 0xf, 0xf, true);  v += __int_as_float(x);
  x = __builtin_amdgcn_update_dpp(0, __float_as_int(v), 0x141, 0xf, 0xf, true); v += __int_as_float(x);
  x = __builtin_amdgcn_update_dpp(0, __float_as_int(v), 0x140, 0xf, 0xf, true); v += __int_as_float(x);
  x = __builtin_amdgcn_update_dpp(0, __float_as_int(v), 0x142, 0xa, 0xf, false); v += __int_as_float(x);
  x = __builtin_amdgcn_update_dpp(0, __float_as_int(v), 0x143, 0xc, 0xf, false); v += __int_as_float(x);
  return __int_as_float(__builtin_amdgcn_readlane(__float_as_int(v), 63));
}
__device__ __forceinline__ float siluf(float x) { return x * __builtin_amdgcn_rcpf(1.f + __expf(-x)); }
__device__ __forceinline__ float sigmoidf_(float x) { return __builtin_amdgcn_rcpf(1.f + __expf(-x)); }
__device__ __forceinline__ f32x16 zero16() {
  f32x16 z;
#pragma unroll
  for (int i = 0; i < 16; ++i) z[i] = 0.f;
  return z;
}
__device__ __forceinline__ f32x16 mfma32(bf16x8 a, bf16x8 b, f32x16 c) {
  return __builtin_amdgcn_mfma_f32_32x32x16_bf16(a, b, c, 0, 0, 0);
}
__device__ __forceinline__ int tok_modrow(int tok) { return tok < TLAT ? (tok >> 12) : 4; }

__device__ __forceinline__ void phase_setup(PRef p, char* smem) {
  float* sS = (float*)smem;
  const int tid = tid_();
  for (int item = bid_(); item < 769 + 96; item += vgrid_()) {
    if (item >= 769) {
      int it = item - 769;
      int l = it / 48, chunk = it % 48;
      for (int i = tid; i < 1024; i += 256) {
        int idx = chunk * 1024 + i;
        int e = idx & 3, ln = (idx >> 2) & 63, t = (idx >> 8) & 63, nt = idx >> 14;
        int k = 16 * t + 4 * (ln >> 4) + e, n = 16 * nt + (ln & 15);
        float v = 0.f;
        if (n < 32) v = p.w_re[((size_t)l * 1024 + k) * 32 + n];
        else if (n < 36) v = p.w_rg[((size_t)l * 1024 + k) * 4 + (n - 32)];
        p.wrp[(size_t)l * 49152 + idx] = v;
      }
      continue;
    }
    if (item == 768) {
      for (int i = tid; i < 1024; i += 256) {
        int pos = i >> 4, f = i & 15;
        float inv = powf(10000.f, -(float)f / 16.f);
        float ang = (float)pos * inv;
        p.rope[i] = cosf(ang);
        p.rope[1024 + i] = sinf(ang);
      }
      continue;
    }
    int nb = item % 24, ks = (item / 24) % 16, l = item / 384;
    __syncthreads();
    for (int i = tid; i < 320; i += 256) {
      int r = i >> 6, k = ks * 64 + (i & 63);
      float cv = (r < 4) ? p.c[r * 1024 + k] : p.c_ctx[k];
      sS[i] = siluf(cv);
    }
    __syncthreads();
    int n = nb * 256 + tid;
    const float* w = p.w_mod + ((size_t)l * 1024 + ks * 64) * NMOD + n;
    float acc[5] = {0.f, 0.f, 0.f, 0.f, 0.f};
#pragma unroll
    for (int k0 = 0; k0 < 64; k0 += 32) {
      float wv[32];
#pragma unroll
      for (int k = 0; k < 32; ++k) wv[k] = w[(size_t)(k0 + k) * NMOD];
#pragma unroll
      for (int k = 0; k < 32; ++k)
#pragma unroll
        for (int r = 0; r < 5; ++r) acc[r] += sS[r * 64 + k0 + k] * wv[k];
    }
#pragma unroll
    for (int r = 0; r < 5; ++r) p.mod_part[(((size_t)ks * 2 + l) * 5 + r) * NMOD + n] = acc[r];
  }
}
__device__ __forceinline__ void phase_modreduce(PRef p) {
  for (int i = bid_() * 256 + tid_(); i < 2 * 5 * NMOD; i += vgrid_() * 256) {
    int n = i % NMOD, l = i / (5 * NMOD);
    float s = p.b_mod[l * NMOD + n];
#pragma unroll
    for (int ks = 0; ks < 16; ++ks) s += p.mod_part[(size_t)ks * 2 * 5 * NMOD + i];
    p.mod[i] = s;
  }
}

constexpr int CV_IN = 16 * 62, CV_GATE = 16 * 48, CV_BR = 8 * 16, CV_OUT = 16 * 16, CV_13 = 16 * 16, CV_2 = 8 * 16;
constexpr int CV_O1 = CV_IN, CV_O2 = CV_O1 + CV_GATE, CV_O3 = CV_O2 + 3 * CV_BR, CV_O4 = CV_O3 + CV_OUT, CV_O5 = CV_O4 + 32 * CV_13,
              CV_TOTAL = CV_O5 + 32 * CV_2;
struct ConvDesc { const float* src; int ldsrc; int ncols; bf16_t* dst; int lddst; };
__device__ __forceinline__ ConvDesc conv_desc(PRef p, int layer, int item) {
  ConvDesc d;
  d.ncols = 64;
  if (item < CV_O1) {
    int kt = item & 15, ntile = item >> 4;
    int n0 = ntile * 64, srccol;
    if (n0 < 2304) srccol = n0;
    else if (n0 < 3840) srccol = n0 + 32;
    else if (n0 == 3840) { srccol = 2304; d.ncols = 32; }
    else { srccol = 0; d.ncols = 0; }
    d.src = p.w_in + (size_t)layer * 1024 * NIN_SRC + (size_t)(kt * 64) * NIN_SRC + srccol; d.ldsrc = NIN_SRC;
    d.dst = p.wt_in + (size_t)n0 * 1024 + kt * 64; d.lddst = 1024;
  } else if (item < CV_O2) {
    int it = item - CV_O1, kt = it & 15, ntile = it >> 4;
    d.src = p.w_in + (size_t)layer * 1024 * NIN_SRC + (size_t)(kt * 64) * NIN_SRC + 3872 + ntile * 64; d.ldsrc = NIN_SRC;
    d.dst = p.wt_gate + (size_t)(ntile * 64) * 1024 + kt * 64; d.lddst = 1024;
  } else if (item < CV_O3) {
    int it = item - CV_O2, br = it / CV_BR, t = it % CV_BR, kt = t & 7, ntile = t >> 3;
    const float* s0 = (br == 0 ? p.w_br_attn : (br == 1 ? p.w_br_gla : p.w_br_na)) + (size_t)layer * 512 * 1024;
    d.src = s0 + (size_t)(kt * 64) * 1024 + ntile * 64; d.ldsrc = 1024;
    d.dst = p.wt_br + (size_t)br * 1024 * 512 + (size_t)(ntile * 64) * 512 + kt * 64; d.lddst = 512;
  } else if (item < CV_O4) {
    int it = item - CV_O3, kt = it & 15, ntile = it >> 4;
    d.src = p.w_out + (size_t)layer * 1024 * 1024 + (size_t)(kt * 64) * 1024 + ntile * 64; d.ldsrc = 1024;
    d.dst = p.wt_out + (size_t)(ntile * 64) * 1024 + kt * 64; d.lddst = 1024;
  } else if (item < CV_O5) {
    int it = item - CV_O4, e = it >> 8, t = it & 255, kt = t & 15, ntile = t >> 4;
    int j = ntile >> 1, isw3 = ntile & 1;
    d.src = (isw3 ? p.w3 : p.w1) + ((size_t)layer * 32 + e) * 1024 * 512 + (size_t)(kt * 64) * 512 + j * 64; d.ldsrc = 512;
    d.dst = p.wt_13 + (size_t)e * 1024 * 1024 + (size_t)(ntile * 64) * 1024 + kt * 64; d.lddst = 1024;
  } else {
    int it = item - CV_O5, e = it >> 7, t = it & 127, kt = t & 7, ntile = t >> 3;
    d.src = p.w2 + ((size_t)layer * 32 + e) * 512 * 1024 + (size_t)(kt * 64) * 1024 + ntile * 64; d.ldsrc = 1024;
    d.dst = p.wt_2 + (size_t)e * 1024 * 512 + (size_t)(ntile * 64) * 512 + kt * 64; d.lddst = 512;
  }
  return d;
}
__device__ __forceinline__ void conv_load8(const ConvDesc& d, int nhalf, int lane, f32x4v (&v)[8]) {
  const int kb = lane >> 3, c0 = nhalf * 32 + (lane & 7) * 4;
  const float* sp = d.src + (size_t)(kb * 8) * d.ldsrc + c0;
  const bool ok = c0 < d.ncols;
#pragma unroll
  for (int j = 0; j < 8; ++j) {
    f32x4v z = {0.f, 0.f, 0.f, 0.f};
    v[j] = ok ? *(const f32x4v*)(sp + (size_t)j * d.ldsrc) : z;
  }
}
__device__ __forceinline__ void phase_convert(PRef p, int layer_part, char* smem) {
  const int tid = tid_(), lane = tid & 63, w = tid >> 6;
  const int layer = layer_part & 15, part = layer_part >> 4;
  const int begin = part ? CV_O4 : 0, ntiles = part ? (CV_TOTAL - CV_O4) : CV_O4;
  const int nw = vgrid_() * 4;
  int wt = bid_() * 4 + w;
  if (wt >= 2 * ntiles) return;
  ConvDesc d0 = conv_desc(p, layer, begin + (wt >> 1));
  f32x4v v0[8], v1[8];
  conv_load8(d0, wt & 1, lane, v0);
  for (;;) {
    const int nwt = wt + nw;
    const bool more = nwt < 2 * ntiles;
    ConvDesc d1 = d0;
    if (more) { d1 = conv_desc(p, layer, begin + (nwt >> 1)); conv_load8(d1, nwt & 1, lane, v1); }
    {
      const int kb = lane >> 3, c0 = (wt & 1) * 32 + (lane & 7) * 4;
      bf16_t* dp = d0.dst + (size_t)c0 * d0.lddst + kb * 8;
#pragma unroll
      for (int c = 0; c < 4; ++c) {
        const uint4 o = make_uint4(pack2(v0[0][c], v0[1][c]), pack2(v0[2][c], v0[3][c]), pack2(v0[4][c], v0[5][c]), pack2(v0[6][c], v0[7][c]));
        *(uint4*)(dp + (size_t)c * d0.lddst) = o;
      }
    }
    if (!more) break;
    wt = nwt;
    d0 = d1;
#pragma unroll
    for (int j = 0; j < 8; ++j) v0[j] = v1[j];
  }
}

__device__ __forceinline__ void row_stats(const float (&v)[16], float& mean, float& rstd) {
  float s = 0.f;
#pragma unroll
  for (int i = 0; i < 16; ++i) s += v[i];
  mean = wave_sum(s) * (1.f / 1024.f);
  float q = 0.f;
#pragma unroll
  for (int i = 0; i < 16; ++i) { float d = v[i] - mean; q += d * d; }
  float var = wave_sum(q) * (1.f / 1024.f);
  rstd = rsqrtf(var + 1e-6f);
}
__device__ __forceinline__ void load_row(const float* src, int lane, float (&v)[16]) {
#pragma unroll
  for (int i = 0; i < 4; ++i) {
    float4 t = *(const float4*)(src + lane * 4 + 256 * i);
    v[4 * i] = t.x; v[4 * i + 1] = t.y; v[4 * i + 2] = t.z; v[4 * i + 3] = t.w;
  }
}
__device__ __forceinline__ void store_row(float* dst, int lane, const float (&v)[16]) {
#pragma unroll
  for (int i = 0; i < 4; ++i) *(float4*)(dst + lane * 4 + 256 * i) = make_float4(v[4 * i], v[4 * i + 1], v[4 * i + 2], v[4 * i + 3]);
}
__device__ __forceinline__ void store_row_bf(bf16_t* dst, int lane, const float (&v)[16]) {
#pragma unroll
  for (int i = 0; i < 4; ++i) {
    uint2 o = make_uint2(pack2(v[4 * i], v[4 * i + 1]), pack2(v[4 * i + 2], v[4 * i + 3]));
    *(uint2*)(dst + lane * 4 + 256 * i) = o;
  }
}
__device__ __forceinline__ void modulate_row(const float (&x)[16], const float* shift, const float* scale, int lane, float (&h)[16]) {
  float mean, rstd;
  row_stats(x, mean, rstd);
  float sh[16], sc[16];
  load_row(shift, lane, sh);
  load_row(scale, lane, sc);
#pragma unroll
  for (int i = 0; i < 16; ++i) h[i] = (x[i] - mean) * rstd * (1.f + sc[i]) + sh[i];
}

__device__ __forceinline__ void phase_rowpass0(PRef p) {
  const int lane = tid_() & 63, w = tid_() >> 6;
  for (int tok = bid_() * 4 + w; tok < TALL; tok += vgrid_() * 4) {
    const float* src = tok < TLAT ? p.x + (size_t)tok * D : p.ctx + (size_t)(tok - TLAT) * D;
    const float* md = p.mod + (size_t)tok_modrow(tok) * NMOD;
    float x[16], h[16];
    load_row(src, lane, x);
    modulate_row(x, md, md + 1024, lane, h);
    store_row_bf(p.h + (size_t)tok * D, lane, h);
  }
}

typedef __attribute__((ext_vector_type(4))) float f32x4;
__device__ __forceinline__ void phase_rowpass1(PRef p, int layer, char* smem) {
  float* sH = (float*)smem;
  float* sPart = (float*)smem;
  int* sE = (int*)(smem + 16384);
  const int tid = tid_(), lane = tid & 63, w = tid >> 6;
  const int ntok = layer == 0 ? TALL : TLAT;
  const float* lg = p.ln1_g + layer * D;
  const float* lb = p.ln1_b + layer * D;
  const float* wrp = p.wrp + (size_t)layer * 49152;
  float* sRB = (float*)(smem + 66048);
  if (tid < 36) sRB[tid] = tid < 4 ? p.b_rg[layer * 4 + tid] : p.b_re[layer * 32 + tid - 4];
  for (int g0 = bid_() * 16; g0 < ntok; g0 += vgrid_() * 16) {
    __syncthreads();
    {
      float v[4][16];
#pragma unroll
      for (int rr = 0; rr < 4; ++rr) load_row(p.xres + (size_t)(g0 + w * 4 + rr) * D, lane, v[rr]);
      float gg[16], bb[16], sh2[16], sc2[16];
      load_row(lg, lane, gg);
      load_row(lb, lane, bb);
      {
        const float* md = p.mod + ((size_t)layer * 5 + tok_modrow(g0)) * NMOD;
        load_row(md + 3072, lane, sh2);
        load_row(md + 4096, lane, sc2);
      }
#pragma unroll
      for (int rr = 0; rr < 4; ++rr) {
        const int tok = g0 + w * 4 + rr;
        float mean, rstd;
        row_stats(v[rr], mean, rstd);
        float x1[16], h2[16];
#pragma unroll
        for (int i = 0; i < 16; ++i) x1[i] = (v[rr][i] - mean) * rstd * gg[i] + bb[i];
        store_row(p.xres + (size_t)tok * D, lane, x1);
        {
          float m2, r2;
          row_stats(x1, m2, r2);
#pragma unroll
          for (int i = 0; i < 16; ++i) h2[i] = (x1[i] - m2) * r2 * (1.f + sc2[i]) + sh2[i];
        }
        store_row_bf(p.h2 + (size_t)tok * D, lane, h2);
        store_row(sH + (w * 4 + rr) * 1028, lane, h2);
      }
    }
    __syncthreads();
    f32x4 acc0 = {0.f, 0.f, 0.f, 0.f}, acc1 = acc0, acc2 = acc0;
    {
      const float* ap = sH + (lane & 15) * 1028 + 4 * (lane >> 4) + 256 * w;
      const float* bp = wrp + (size_t)(16 * w) * 256 + lane * 4;
#pragma unroll 8
      for (int t = 0; t < 16; ++t) {
        float4 a = *(const float4*)(ap + 16 * t);
        float4 b0 = *(const float4*)(bp + t * 256);
        float4 b1 = *(const float4*)(bp + t * 256 + 16384);
        float4 b2 = *(const float4*)(bp + t * 256 + 32768);
        acc0 = __builtin_amdgcn_mfma_f32_16x16x4f32(a.x, b0.x, acc0, 0, 0, 0);
        acc1 = __builtin_amdgcn_mfma_f32_16x16x4f32(a.x, b1.x, acc1, 0, 0, 0);
        acc2 = __builtin_amdgcn_mfma_f32_16x16x4f32(a.x, b2.x, acc2, 0, 0, 0);
        acc0 = __builtin_amdgcn_mfma_f32_16x16x4f32(a.y, b0.y, acc0, 0, 0, 0);
        acc1 = __builtin_amdgcn_mfma_f32_16x16x4f32(a.y, b1.y, acc1, 0, 0, 0);
        acc2 = __builtin_amdgcn_mfma_f32_16x16x4f32(a.y, b2.y, acc2, 0, 0, 0);
        acc0 = __builtin_amdgcn_mfma_f32_16x16x4f32(a.z, b0.z, acc0, 0, 0, 0);
        acc1 = __builtin_amdgcn_mfma_f32_16x16x4f32(a.z, b1.z, acc1, 0, 0, 0);
        acc2 = __builtin_amdgcn_mfma_f32_16x16x4f32(a.z, b2.z, acc2, 0, 0, 0);
        acc0 = __builtin_amdgcn_mfma_f32_16x16x4f32(a.w, b0.w, acc0, 0, 0, 0);
        acc1 = __builtin_amdgcn_mfma_f32_16x16x4f32(a.w, b1.w, acc1, 0, 0, 0);
        acc2 = __builtin_amdgcn_mfma_f32_16x16x4f32(a.w, b2.w, acc2, 0, 0, 0);
      }
    }
    __syncthreads();
#pragma unroll
    for (int g = 0; g < 4; ++g) {
      const int row = (lane >> 4) * 4 + g, col = lane & 15;
      sPart[(w * 16 + row) * 48 + col] = acc0[g];
      sPart[(w * 16 + row) * 48 + 16 + col] = acc1[g];
      sPart[(w * 16 + row) * 48 + 32 + col] = acc2[g];
    }
    __syncthreads();
    if (tid < 16) {
      int tok = g0 + tid;
      const float* l0 = sPart + tid * 48;
      float g[4];
#pragma unroll
      for (int i = 0; i < 4; ++i) g[i] = ((l0[32 + i] + l0[768 + 32 + i]) + (l0[1536 + 32 + i] + l0[2304 + 32 + i])) + sRB[i];
      int grp = 0;
      float gm = g[0];
#pragma unroll
      for (int i = 1; i < 4; ++i) if (g[i] > gm) { gm = g[i]; grp = i; }
      float gs = 0.f;
#pragma unroll
      for (int i = 0; i < 4; ++i) gs += __expf(g[i] - gm);
      float pg = 1.f / gs;
      float sv[8];
#pragma unroll
      for (int i = 0; i < 8; ++i) {
        const int c = grp * 8 + i;
        sv[i] = ((l0[c] + l0[768 + c]) + (l0[1536 + c] + l0[2304 + c])) + sRB[4 + c];
      }
      int i0 = 0;
      float v0 = sv[0];
#pragma unroll
      for (int i = 1; i < 8; ++i) if (sv[i] > v0) { v0 = sv[i]; i0 = i; }
      int i1 = -1;
      float v1 = -3.0e38f;
#pragma unroll
      for (int i = 0; i < 8; ++i) if (i != i0 && sv[i] > v1) { v1 = sv[i]; i1 = i; }
      float e1 = __expf(v1 - v0);
      float w0 = pg / (1.f + e1), w1 = pg * e1 / (1.f + e1);
      int ex0 = grp * 8 + i0, ex1 = grp * 8 + i1;
      sE[tid * 2] = ex0; sE[tid * 2 + 1] = ex1;
      p.tok_e[tok * 2] = ex0; p.tok_e[tok * 2 + 1] = ex1;
      p.tok_gate[tok * 2] = w0; p.tok_gate[tok * 2 + 1] = w1;
    }
    __syncthreads();
    if (tid < 32) {
      int c = 0;
#pragma unroll 8
      for (int i = 0; i < 32; ++i) c += (sE[i] == tid) ? 1 : 0;
      p.cntg[(size_t)(g0 >> 4) * 32 + tid] = c;
      const int mine = sE[tid];
      int rk = 0;
      for (int i = 0; i < (tid & ~1); ++i) rk += (sE[i] == mine) ? 1 : 0;
      p.tok_pos[(g0 + (tid >> 1)) * 2 + (tid & 1)] = rk;
    }
  }
}

__device__ __forceinline__ void phase_moescan(PRef p, int layer, char* smem) {
  int* sOff = (int*)smem;
  int* sScan = sOff + 1280;
  const int tid = tid_();
  const int e = bid_();
  if (e >= 32) return;
  const int ntok = layer == 0 ? TALL : TLAT;
  const int ng = ntok >> 4;
  __syncthreads();
  int loc[5], s = 0;
#pragma unroll
  for (int i = 0; i < 5; ++i) {
    const int g = tid * 5 + i;
    loc[i] = g < ng ? p.cntg[(size_t)g * 32 + e] : 0;
    s += loc[i];
  }
  sScan[tid] = s;
  __syncthreads();
  for (int o = 1; o < 256; o <<= 1) {
    int v = tid >= o ? sScan[tid - o] : 0;
    __syncthreads();
    sScan[tid] += v;
    __syncthreads();
  }
  int run = sScan[tid] - s;
#pragma unroll
  for (int i = 0; i < 5; ++i) { sOff[tid * 5 + i] = run; run += loc[i]; }
  if (tid == 255) p.cnt[e] = sScan[255];
  __syncthreads();
  typedef int i32x2v __attribute__((ext_vector_type(2)));
  for (int base = 0; base < ntok; base += 2048) {
    i32x2v te[8], tp[8];
#pragma unroll
    for (int u = 0; u < 8; ++u) {
      const int tok = base + u * 256 + tid;
      const int tc = tok < ntok ? tok : 0;
      te[u] = *(const i32x2v*)(p.tok_e + tc * 2);
      tp[u] = *(const i32x2v*)(p.tok_pos + tc * 2);
      if (tok >= ntok) te[u] = (i32x2v){-1, -1};
    }
#pragma unroll
    for (int u = 0; u < 8; ++u) {
      const int tok = base + u * 256 + tid;
      if (te[u][0] == e) { const int pos = sOff[tok >> 4] + tp[u][0]; p.list[e * MOE_CAP + pos] = tok; p.tok_pos[tok * 2] = pos; }
      if (te[u][1] == e) { const int pos = sOff[tok >> 4] + tp[u][1]; p.list[e * MOE_CAP + pos] = tok; p.tok_pos[tok * 2 + 1] = pos; }
    }
  }
}

__device__ __forceinline__ void phase_rowpass2(PRef p, int layer) {
  const int lane = tid_() & 63, w = tid_() >> 6;
  const bool last = layer == 1;
  const int ntok = last ? TLAT : TALL;
  const float* lg = p.ln2_g + layer * D;
  const float* lb = p.ln2_b + layer * D;
  const int stride = vgrid_() * 4;
  const int est = p.estart[lane & 31];
  for (int tokA = bid_() * 4 + w; tokA < ntok; tokA += 2 * stride) {
    const bool hasB = tokA + stride < ntok;
    int tk[2];
    tk[0] = tokA; tk[1] = hasB ? tokA + stride : tokA;
    int s0[2], s1[2];
    float w0[2], w1[2];
#pragma unroll
    for (int u = 0; u < 2; ++u) {
      const int t = tk[u];
      const int e0 = __builtin_amdgcn_readfirstlane(p.tok_e[t * 2]), e1 = __builtin_amdgcn_readfirstlane(p.tok_e[t * 2 + 1]);
      s0[u] = __builtin_amdgcn_readlane(est, e0) * MOE_BLK + p.tok_pos[t * 2];
      s1[u] = __builtin_amdgcn_readlane(est, e1) * MOE_BLK + p.tok_pos[t * 2 + 1];
      w0[u] = p.tok_gate[t * 2]; w1[u] = p.tok_gate[t * 2 + 1];
    }
    float x1[2][16], g2[2][16];
    uint2 ya[2][4], yb[2][4];
#pragma unroll
    for (int u = 0; u < 2; ++u) {
      const int t = tk[u];
      load_row(p.xres + (size_t)t * D, lane, x1[u]);
      load_row(p.mod + ((size_t)layer * 5 + tok_modrow(t)) * NMOD + 5120, lane, g2[u]);
      const bf16_t* y0 = p.ysl + (size_t)s0[u] * D;
      const bf16_t* y1 = p.ysl + (size_t)s1[u] * D;
#pragma unroll
      for (int i = 0; i < 4; ++i) { ya[u][i] = *(const uint2*)(y0 + lane * 4 + 256 * i); yb[u][i] = *(const uint2*)(y1 + lane * 4 + 256 * i); }
    }
    float gg[16], bb[16];
    load_row(lg, lane, gg);
    load_row(lb, lane, bb);
#pragma unroll
    for (int u = 0; u < 2; ++u) {
      if (u == 1 && !hasB) break;
      const int tok = tk[u];
      float v[16], x2[16];
#pragma unroll
      for (int i = 0; i < 4; ++i) {
        const uint2 a = ya[u][i], b = yb[u][i];
        float fa[4] = {bf2f(a.x & 0xffff), bf2f(a.x >> 16), bf2f(a.y & 0xffff), bf2f(a.y >> 16)};
        float fb[4] = {bf2f(b.x & 0xffff), bf2f(b.x >> 16), bf2f(b.y & 0xffff), bf2f(b.y >> 16)};
#pragma unroll
        for (int e = 0; e < 4; ++e) v[4 * i + e] = ALPHA * x1[u][4 * i + e] + g2[u][4 * i + e] * (w0[u] * fa[e] + w1[u] * fb[e]);
      }
      float mean, rstd;
      row_stats(v, mean, rstd);
#pragma unroll
      for (int i = 0; i < 16; ++i) x2[i] = (v[i] - mean) * rstd * gg[i] + bb[i];
      if (last) {
        store_row(p.out + (size_t)tok * D, lane, x2);
      } else {
        store_row(p.xres + (size_t)tok * D, lane, x2);
        const float* mdn = p.mod + ((size_t)(layer + 1) * 5 + tok_modrow(tok)) * NMOD;
        float h[16];
        modulate_row(x2, mdn, mdn + 1024, lane, h);
        store_row_bf(p.h + (size_t)tok * D, lane, h);
      }
    }
  }
}

struct Ptr4 { const bf16_t* p[4]; };

template <int NJ>
__device__ __forceinline__ void gemm_compute_tile(const char* cA, const char* cB, int r, int hh, f32x16 (&acc)[2][NJ]) {
#pragma unroll
  for (int s = 0; s < 4; ++s) {
    const int co = ((2 * s + hh) ^ ((r >> 1) & 7)) << 4;
    bf16x8 a0 = *(const bf16x8*)(cA + co);
    bf16x8 a1 = *(const bf16x8*)(cA + 4096 + co);
    bf16x8 b[NJ];
#pragma unroll
    for (int j = 0; j < NJ; ++j) b[j] = *(const bf16x8*)(cB + j * 4096 + co);
#pragma unroll
    for (int j = 0; j < NJ; ++j) {
      acc[0][j] = mfma32(a0, b[j], acc[0][j]);
      acc[1][j] = mfma32(a1, b[j], acc[1][j]);
    }
  }
}
#define LAS3 __attribute__((address_space(3)))
__device__ __forceinline__ void dma_sync() { asm volatile("s_waitcnt vmcnt(0)" ::: "memory"); __syncthreads(); }
template <int NJ>
__device__ __forceinline__ void g_stage(const Ptr4& ap, const Ptr4& bp, int kt, char* dA, char* dB) {
#pragma unroll
  for (int i = 0; i < 4; ++i) __builtin_amdgcn_global_load_lds((const unsigned*)(ap.p[i] + kt * 64), (LAS3 unsigned*)(dA + i * 4096), 16, 0, 0);
#pragma unroll
  for (int i = 0; i < 2 * NJ; ++i) __builtin_amdgcn_global_load_lds((const unsigned*)(bp.p[i] + kt * 64), (LAS3 unsigned*)(dB + i * 4096), 16, 0, 0);
}
template <int NJ>
__device__ __forceinline__ void gemm_mainloop(const Ptr4& ap, const Ptr4& bp, int nk, f32x16 (&acc)[2][NJ], char* smem) {
  const int tid = tid_(), lane = tid & 63, w = tid >> 6, wr = w >> 1, wc = w & 1, r = lane & 31, hh = lane >> 5;
  char* sA = smem;
  char* sB = smem + 32768;
  const int dofs = tid * 16;
  g_stage<NJ>(ap, bp, 0, sA + dofs, sB + dofs);
  dma_sync();
  const char* cA = sA + (wr * 64 + r) * 128;
  const char* cB = sB + (wc * 32 * NJ + r) * 128;
  for (int kt = 0; kt < nk; ++kt) {
    const int cur = kt & 1;
    if (kt + 1 < nk) g_stage<NJ>(ap, bp, kt + 1, sA + (cur ^ 1) * 16384 + dofs, sB + (cur ^ 1) * 16384 + dofs);
    gemm_compute_tile<NJ>(cA + cur * 16384, cB + cur * 16384, r, hh, acc);
    dma_sync();
  }
}
__device__ __forceinline__ Ptr4 rows_contig(const bf16_t* base, int ld) {
  Ptr4 q;
  const int lrow = tid_() >> 3, lch = tid_() & 7;
#pragma unroll
  for (int i = 0; i < 4; ++i) q.p[i] = base + (size_t)(lrow + 32 * i) * ld + ((lch ^ ((lrow >> 1) & 7)) * 8);
  return q;
}
__device__ __forceinline__ void acc_to_lds(const f32x16 (&acc)[2][2], float* sC) {
  const int lane = tid_() & 63, w = tid_() >> 6, wr = w >> 1, wc = w & 1, r = lane & 31, hh = lane >> 5;
#pragma unroll
  for (int i = 0; i < 2; ++i)
#pragma unroll
    for (int j = 0; j < 2; ++j)
#pragma unroll
      for (int g = 0; g < 16; ++g) {
        int row = wr * 64 + i * 32 + (g & 3) + 8 * (g >> 2) + 4 * hh, col = wc * 64 + j * 32 + r;
        sC[row * LDC + col] = acc[i][j][g];
      }
}
__device__ __forceinline__ void acc_to_lds_T(const f32x16 (&acc)[2][2], float* sC) {
  const int lane = tid_() & 63, w = tid_() >> 6, wr = w >> 1, wc = w & 1, r = lane & 31, hh = lane >> 5;
#pragma unroll
  for (int i = 0; i < 2; ++i)
#pragma unroll
    for (int j = 0; j < 2; ++j)
#pragma unroll
      for (int g4 = 0; g4 < 4; ++g4) {
        int row = wr * 64 + i * 32 + 8 * g4 + 4 * hh, col = wc * 64 + j * 32 + r;
        *(float4*)(sC + col * LDC + row) = make_float4(acc[i][j][4 * g4], acc[i][j][4 * g4 + 1], acc[i][j][4 * g4 + 2], acc[i][j][4 * g4 + 3]);
      }
}
__device__ __forceinline__ void lds_read8(const float* s, float (&v)[8]) {
  float4 a = *(const float4*)s, b = *(const float4*)(s + 4);
  v[0] = a.x; v[1] = a.y; v[2] = a.z; v[3] = a.w; v[4] = b.x; v[5] = b.y; v[6] = b.z; v[7] = b.w;
}
__device__ __forceinline__ uint4 pack8(const float (&v)[8]) {
  return make_uint4(pack2(v[0], v[1]), pack2(v[2], v[3]), pack2(v[4], v[5]), pack2(v[6], v[7]));
}
__device__ __forceinline__ void st_nt16(void* q, const uint4 v) {
  typedef unsigned nt_u32x4 __attribute__((ext_vector_type(4)));
  const nt_u32x4 t = {v.x, v.y, v.z, v.w};
  __builtin_nontemporal_store(t, (nt_u32x4*)q);
}


__device__ __forceinline__ int xcd_rounds(const char*, int nMt, int nNt) { return (nMt * nNt + vgrid_() - 1) / vgrid_(); }
__device__ __forceinline__ bool xcd_tile(const char*, int round, int nMt, int nNt, int& mt, int& nt) {
  const int item = round * vgrid_() + bid_();
  mt = item / nNt; nt = item % nNt;
  return item < nMt * nNt;
}

namespace pg8 {
constexpr int BK = 64, HALF = 128, HTB = HALF * BK * 2, STAGE_BYTES = 8 * HTB;
__device__ __forceinline__ int lds_byte(int r, int c) { const int st = (r >> 4) * 2 + (c >> 5), rr = r & 15, cc = c & 31, ob = rr * 64 + cc * 2; return st * 1024 + (ob ^ (((ob >> 9) & 1) << 5)); }
__device__ __forceinline__ void stage_rc(int b, int& R, int& C) { const int st = b / 1024, sb = b % 1024, swz = sb ^ (((sb >> 9) & 1) << 5); R = (st >> 1) * 16 + swz / 64; C = (st & 1) * 32 + (swz % 64) / 2; }
typedef float f32x4 __attribute__((ext_vector_type(4)));
__device__ __forceinline__ int perm32(int rho) { const int n = rho >> 4, i = rho & 15; return 8 * (i >> 2) + 4 * n + (i & 3); }
template <bool PERM = false>
__device__ __forceinline__ void gemm_unit(LAS3 unsigned char* lds, const char* cA0, const char* cA1, const unsigned (&voffA0)[2], const unsigned (&voffA1)[2],
                                          const char* cB, int K, f32x4 (&acc)[2][2][4][2]) {
  int tid = __builtin_amdgcn_workitem_id_x();
  asm volatile("" : "+v"(tid));
  const int wid = __builtin_amdgcn_readfirstlane(tid >> 6), lane = tid & 63, wr = wid >> 2, wc = wid & 3, fr = lane & 15, fq = lane >> 4;
  const int nt = K / BK;
  unsigned voffB[2];
#pragma unroll
  for (int i = 0; i < 2; ++i) { int R, C; stage_rc(tid * 16 + i * 8192, R, C); const int Rb = PERM ? ((R & ~31) + perm32(R & 31)) : R; voffB[i] = (unsigned)(Rb * K + C) * 2u; }
  const size_t kstep = (size_t)(BK * 2);
  const size_t hstep = (size_t)HALF * K * 2;
  const unsigned ldsw = (unsigned)wid * 1024u;
  const int aoff = lds_byte(wr * 64 + fr, fq * 8), boff = lds_byte(wc * 32 + fr, fq * 8);
#define PG8_SA(b, h) (((b) * 2 + (h)) * HTB)
#define PG8_SB(b, h) ((4 + (b) * 2 + (h)) * HTB)
#define PG8_STAGE(bufoff, gbase, voff) do { _Pragma("unroll") for (int _i = 0; _i < 2; ++_i) \
        __builtin_amdgcn_global_load_lds((const unsigned*)((const char*)(gbase) + (voff)[_i]), (LAS3 unsigned*)(lds + (bufoff) + ldsw + _i * 8192), 16, 0, 0); } while (0)
#define PG8_LDA(dst, b, h) do { _Pragma("unroll") for (int m = 0; m < 4; ++m) _Pragma("unroll") for (int k = 0; k < 2; ++k) dst[m][k] = *(const LAS3 bf16x8*)(lds + PG8_SA(b, h) + aoff + m * 2048 + k * 1024); } while (0)
#define PG8_LDB(dst, b, h) do { _Pragma("unroll") for (int n = 0; n < 2; ++n) _Pragma("unroll") for (int k = 0; k < 2; ++k) dst[n][k] = *(const LAS3 bf16x8*)(lds + PG8_SB(b, h) + boff + n * 2048 + k * 1024); } while (0)
#define PG8_MMA(ai, bj, At, Bt) do { __builtin_amdgcn_s_setprio(1); _Pragma("unroll") for (int m = 0; m < 4; ++m) _Pragma("unroll") for (int n = 0; n < 2; ++n) _Pragma("unroll") for (int k = 0; k < 2; ++k) \
        acc[ai][bj][m][n] = __builtin_amdgcn_mfma_f32_16x16x32_bf16(Bt[n][k], At[m][k], acc[ai][bj][m][n], 0, 0, 0); __builtin_amdgcn_s_setprio(0); } while (0)
#define PG8_WAIT_V(n) asm volatile("s_waitcnt vmcnt(" #n ")" ::: "memory")
#define PG8_WAIT_L(n) asm volatile("s_waitcnt lgkmcnt(" #n ")" ::: "memory")
#define PG8_BAR __builtin_amdgcn_s_barrier()
#define PG8_SCHED __builtin_amdgcn_sched_barrier(0)
#pragma unroll
  for (int a = 0; a < 2; ++a)
#pragma unroll
    for (int b = 0; b < 2; ++b)
#pragma unroll
      for (int m = 0; m < 4; ++m)
#pragma unroll
        for (int n = 0; n < 2; ++n) acc[a][b][m][n] = (f32x4){0.f, 0.f, 0.f, 0.f};
  bf16x8 At[4][2], B0[2][2], B1[2][2];
  PG8_STAGE(PG8_SB(0, 0), cB, voffB); PG8_STAGE(PG8_SA(0, 0), cA0, voffA0); PG8_STAGE(PG8_SB(0, 1), cB + hstep, voffB); PG8_STAGE(PG8_SA(0, 1), cA1, voffA1);
  if (wr == 1) PG8_BAR;
  PG8_WAIT_V(4); PG8_BAR;
  PG8_STAGE(PG8_SB(1, 0), cB + kstep, voffB); PG8_STAGE(PG8_SA(1, 0), cA0 + kstep, voffA0); PG8_STAGE(PG8_SB(1, 1), cB + hstep + kstep, voffB);
  PG8_WAIT_V(6); PG8_BAR;
  for (int t = 0; t < nt; t += 2) {
    const bool last = (t == nt - 2);
    const size_t o1 = (size_t)(t + 1) * kstep;
    const size_t o2 = last ? 0 : (size_t)(t + 2) * kstep;
    const size_t o3 = o2 + kstep;
    PG8_LDB(B0, 0, 0); PG8_SCHED; PG8_LDA(At, 0, 0); PG8_STAGE(PG8_SA(1, 1), cA1 + o1, voffA1);
    PG8_WAIT_L(8); PG8_BAR; PG8_WAIT_L(0); PG8_MMA(0, 0, At, B0); PG8_BAR; PG8_SCHED;
    PG8_LDB(B1, 0, 1); PG8_STAGE(PG8_SB(0, 0), cB + o2, voffB);
    PG8_BAR; PG8_WAIT_L(0); PG8_MMA(0, 1, At, B1); PG8_BAR;
    PG8_LDA(At, 0, 1); PG8_STAGE(PG8_SA(0, 0), cA0 + o2, voffA0);
    PG8_BAR; PG8_WAIT_L(0); PG8_MMA(1, 0, At, B0); PG8_BAR; PG8_SCHED;
    PG8_STAGE(PG8_SB(0, 1), cB + hstep + o2, voffB);
    PG8_WAIT_V(6); PG8_BAR; PG8_MMA(1, 1, At, B1); PG8_BAR;
    PG8_LDB(B0, 1, 0); PG8_SCHED; PG8_LDA(At, 1, 0); PG8_STAGE(PG8_SA(0, 1), cA1 + o2, voffA1);
    PG8_WAIT_L(8); PG8_BAR; PG8_WAIT_L(0); PG8_MMA(0, 0, At, B0); PG8_BAR; PG8_SCHED;
    PG8_LDB(B1, 1, 1); PG8_STAGE(PG8_SB(1, 0), cB + o3, voffB);
    PG8_BAR; PG8_WAIT_L(0); PG8_MMA(0, 1, At, B1); PG8_BAR;
    PG8_LDA(At, 1, 1); PG8_STAGE(PG8_SA(1, 0), cA0 + o3, voffA0);
    PG8_BAR; PG8_WAIT_L(0); PG8_MMA(1, 0, At, B0); PG8_BAR; PG8_SCHED;
    PG8_STAGE(PG8_SB(1, 1), cB + hstep + o3, voffB);
    PG8_WAIT_V(6); PG8_BAR; PG8_MMA(1, 1, At, B1); PG8_BAR;
  }
  PG8_WAIT_V(0);
  if (wr == 0) PG8_BAR;
  PG8_BAR;
#undef PG8_SA
#undef PG8_SB
#undef PG8_STAGE
#undef PG8_LDA
#undef PG8_LDB
#undef PG8_MMA
#undef PG8_WAIT_V
#undef PG8_WAIT_L
#undef PG8_BAR
#undef PG8_SCHED
}
struct UnitAB { const char* a; const char* b; };
template <bool PERM, class Prov, class Epi>
__device__ __forceinline__ void gemm_stream(LAS3 unsigned char* lds, int K, Prov prov, Epi epi) {
  int tid = __builtin_amdgcn_workitem_id_x();
  asm volatile("" : "+v"(tid));
  const int wid = __builtin_amdgcn_readfirstlane(tid >> 6), lane = tid & 63, wr = wid >> 2, wc = wid & 3, fr = lane & 15, fq = lane >> 4;
  const int nt = K / BK;
  UnitAB cur, nxt;
  if (!prov(0, cur)) return;
  unsigned voffA[2], voffB[2];
#pragma unroll
  for (int i = 0; i < 2; ++i) { int R, C; stage_rc(tid * 16 + i * 8192, R, C); const int Rb = PERM ? ((R & ~31) + perm32(R & 31)) : R;
    voffA[i] = (unsigned)(R * K + C) * 2u; voffB[i] = (unsigned)(Rb * K + C) * 2u; }
  const size_t kstep = (size_t)(BK * 2);
  const size_t hstep = (size_t)HALF * K * 2;
  const unsigned ldsw = (unsigned)wid * 1024u;
  const int aoff = lds_byte(wr * 64 + fr, fq * 8), boff = lds_byte(wc * 32 + fr, fq * 8);
#define PG8_SA(b, h) (((b) * 2 + (h)) * HTB)
#define PG8_SB(b, h) ((4 + (b) * 2 + (h)) * HTB)
#define PG8_STAGE(bufoff, gbase, voff) do { _Pragma("unroll") for (int _i = 0; _i < 2; ++_i) \
        __builtin_amdgcn_global_load_lds((const unsigned*)((const char*)(gbase) + (voff)[_i]), (LAS3 unsigned*)(lds + (bufoff) + ldsw + _i * 8192), 16, 0, 0); } while (0)
#define PG8_LDA(dst, b, h) do { _Pragma("unroll") for (int m = 0; m < 4; ++m) _Pragma("unroll") for (int k = 0; k < 2; ++k) dst[m][k] = *(const LAS3 bf16x8*)(lds + PG8_SA(b, h) + aoff + m * 2048 + k * 1024); } while (0)
#define PG8_LDB(dst, b, h) do { _Pragma("unroll") for (int n = 0; n < 2; ++n) _Pragma("unroll") for (int k = 0; k < 2; ++k) dst[n][k] = *(const LAS3 bf16x8*)(lds + PG8_SB(b, h) + boff + n * 2048 + k * 1024); } while (0)
#define PG8_MMA(ai, bj, At, Bt) do { __builtin_amdgcn_s_setprio(1); _Pragma("unroll") for (int m = 0; m < 4; ++m) _Pragma("unroll") for (int n = 0; n < 2; ++n) _Pragma("unroll") for (int k = 0; k < 2; ++k) \
        acc[ai][bj][m][n] = __builtin_amdgcn_mfma_f32_16x16x32_bf16(Bt[n][k], At[m][k], acc[ai][bj][m][n], 0, 0, 0); __builtin_amdgcn_s_setprio(0); } while (0)
#define PG8_WAIT_V(n) asm volatile("s_waitcnt vmcnt(" #n ")" ::: "memory")
#define PG8_WAIT_L(n) asm volatile("s_waitcnt lgkmcnt(" #n ")" ::: "memory")
#define PG8_BAR __builtin_amdgcn_s_barrier()
#define PG8_SCHED __builtin_amdgcn_sched_barrier(0)
#define PG8_ZERO() do { _Pragma("unroll") for (int a = 0; a < 2; ++a) _Pragma("unroll") for (int b = 0; b < 2; ++b) _Pragma("unroll") for (int m = 0; m < 4; ++m) \
        _Pragma("unroll") for (int n = 0; n < 2; ++n) acc[a][b][m][n] = (f32x4){0.f, 0.f, 0.f, 0.f}; } while (0)
  f32x4 acc[2][2][4][2];
  PG8_ZERO();
  bf16x8 At[4][2], B0[2][2], B1[2][2];
  const char* cA = cur.a; const char* cB = cur.b;
  PG8_STAGE(PG8_SB(0, 0), cB, voffB); PG8_STAGE(PG8_SA(0, 0), cA, voffA); PG8_STAGE(PG8_SB(0, 1), cB + hstep, voffB); PG8_STAGE(PG8_SA(0, 1), cA + hstep, voffA);
  if (wr == 1) PG8_BAR;
  PG8_WAIT_V(4); PG8_BAR;
  PG8_STAGE(PG8_SB(1, 0), cB + kstep, voffB); PG8_STAGE(PG8_SA(1, 0), cA + kstep, voffA); PG8_STAGE(PG8_SB(1, 1), cB + hstep + kstep, voffB);
  PG8_WAIT_V(6); PG8_BAR;
  for (int ui = 0;; ++ui) {
    const bool has_next = prov(ui + 1, nxt);
    const char* nA = has_next ? nxt.a : cA; const char* nB = has_next ? nxt.b : cB;
    for (int t = 0; t < nt; t += 2) {
      const bool last = (t == nt - 2);
      const char* a1 = cA + (size_t)(t + 1) * kstep;
      const char* a2 = last ? nA : cA + (size_t)(t + 2) * kstep; const char* b2 = last ? nB : cB + (size_t)(t + 2) * kstep;
      const char* a3 = a2 + kstep; const char* b3 = b2 + kstep;
      PG8_LDB(B0, 0, 0); PG8_SCHED; PG8_LDA(At, 0, 0); PG8_STAGE(PG8_SA(1, 1), a1 + hstep, voffA);
      PG8_WAIT_L(8); PG8_BAR; PG8_WAIT_L(0); PG8_MMA(0, 0, At, B0); PG8_BAR; PG8_SCHED;
      PG8_LDB(B1, 0, 1); PG8_STAGE(PG8_SB(0, 0), b2, voffB);
      PG8_BAR; PG8_WAIT_L(0); PG8_MMA(0, 1, At, B1); PG8_BAR;
      PG8_LDA(At, 0, 1); PG8_STAGE(PG8_SA(0, 0), a2, voffA);
      PG8_BAR; PG8_WAIT_L(0); PG8_MMA(1, 0, At, B0); PG8_BAR; PG8_SCHED;
      PG8_STAGE(PG8_SB(0, 1), b2 + hstep, voffB);
      PG8_WAIT_V(6); PG8_BAR; PG8_MMA(1, 1, At, B1); PG8_BAR;
      PG8_LDB(B0, 1, 0); PG8_SCHED; PG8_LDA(At, 1, 0); PG8_STAGE(PG8_SA(0, 1), a2 + hstep, voffA);
      PG8_WAIT_L(8); PG8_BAR; PG8_WAIT_L(0); PG8_MMA(0, 0, At, B0); PG8_BAR; PG8_SCHED;
      PG8_LDB(B1, 1, 1); PG8_STAGE(PG8_SB(1, 0), b3, voffB);
      PG8_BAR; PG8_WAIT_L(0); PG8_MMA(0, 1, At, B1); PG8_BAR;
      PG8_LDA(At, 1, 1); PG8_STAGE(PG8_SA(1, 0), a3, voffA);
      PG8_BAR; PG8_WAIT_L(0); PG8_MMA(1, 0, At, B0); PG8_BAR; PG8_SCHED;
      PG8_STAGE(PG8_SB(1, 1), b3 + hstep, voffB);
      PG8_WAIT_V(6); PG8_BAR; PG8_MMA(1, 1, At, B1); PG8_BAR;
    }
    epi(ui, acc);
    if (!has_next) break;
    PG8_ZERO();
    cA = nA; cB = nB;
  }
  PG8_WAIT_V(0);
  if (wr == 0) PG8_BAR;
  PG8_BAR;
#undef PG8_SA
#undef PG8_SB
#undef PG8_STAGE
#undef PG8_LDA
#undef PG8_LDB
#undef PG8_MMA
#undef PG8_WAIT_V
#undef PG8_WAIT_L
#undef PG8_BAR
#undef PG8_SCHED
#undef PG8_ZERO
}
__device__ __forceinline__ void voff_contig(int K, unsigned (&voff)[2]) {
  int tid = __builtin_amdgcn_workitem_id_x();
  asm volatile("" : "+v"(tid));
#pragma unroll
  for (int i = 0; i < 2; ++i) { int R, C; stage_rc(tid * 16 + i * 8192, R, C); voff[i] = (unsigned)(R * K + C) * 2u; }
}
template <int ai, int bj>
__device__ __forceinline__ void acc_to_lds(const f32x4 (&acc)[2][2][4][2], bool transposed, float* sC) {
  int tid = __builtin_amdgcn_workitem_id_x();
  asm volatile("" : "+v"(tid));
  const int wid = tid >> 6, lane = tid & 63, wr = wid >> 2, wc = wid & 3, fr = lane & 15, fq = lane >> 4;
#pragma unroll
  for (int m = 0; m < 4; ++m)
#pragma unroll
    for (int n = 0; n < 2; ++n) {
      const int row = 64 * wr + 16 * m + fr, col = 32 * wc + 16 * n + 4 * fq;
      const f32x4 v = acc[ai][bj][m][n];
      if (!transposed) *(f32x4*)(sC + row * LDC + col) = v;
      else { sC[col * LDC + row] = v[0]; sC[(col + 1) * LDC + row] = v[1]; sC[(col + 2) * LDC + row] = v[2]; sC[(col + 3) * LDC + row] = v[3]; }
    }
}
template <class F>
__device__ __forceinline__ void for_each_piece(const f32x4 (&acc)[2][2][4][2], F f) {
  int tid = __builtin_amdgcn_workitem_id_x();
  asm volatile("" : "+v"(tid));
  const int wid = tid >> 6, lane = tid & 63, wr = wid >> 2, wc = wid & 3, fr = lane & 15, fq = lane >> 4;
#pragma unroll
  for (int ai = 0; ai < 2; ++ai)
#pragma unroll
    for (int m = 0; m < 4; ++m)
#pragma unroll
      for (int bj = 0; bj < 2; ++bj) {
        const f32x4 a = acc[ai][bj][m][0], b = acc[ai][bj][m][1];
        float v[8] = {a[0], a[1], a[2], a[3], b[0], b[1], b[2], b[3]};
        f(128 * ai + 64 * wr + 16 * m + fr, 128 * bj + 32 * wc + 8 * fq, v);
      }
}
__device__ __forceinline__ int unit_linear(int i) { return i * (int)gridDim.x + (int)__builtin_amdgcn_workgroup_id_x(); }
__device__ __forceinline__ bool unit_map(int L, int nM, int nN, int& pm, int& pn) {
  const int nwg = nM * nN;
  if (L >= nwg) return false;
  int wgid = L;
  { const int q = nwg / 8, r = nwg % 8, xcd = wgid % 8, off = wgid / 8; wgid = (xcd < r ? xcd * (q + 1) : r * (q + 1) + (xcd - r) * q) + off; }
  const int nig = 8 * nN, gid = wgid / nig, fm = gid * 8, gsz = (nM - fm) < 8 ? (nM - fm) : 8;
  pm = fm + ((wgid % nig) % gsz); pn = (wgid % nig) / gsz;
  return true;
}
}

__device__ __forceinline__ bool inproj_transposed(int nt) { return (nt == 5) || (nt >= 10 && nt <= 13) || (nt >= 26 && nt <= 29); }
__device__ __forceinline__ void inproj_epilogue(PRef p, int layer, int mt, int nt, const float* sC, int tid) {
  const float* bias = p.b_in + layer * NIN_SRC;
  const bool transposed = inproj_transposed(nt);
  const int tok0 = mt * 128;
  const bool lat = tok0 < TLAT;
  int b, pos0, pall0;
  if (lat) { b = tok0 >> 12; pos0 = tok0 & 4095; pall0 = 256 + pos0; }
  else { int ci = tok0 - TLAT; b = ci >> 8; pos0 = ci & 255; pall0 = pos0; }
  const int n0 = nt * 128;
  const int srcc0 = (nt < 18) ? n0 : n0 + 32;
  if (transposed) {
    const int tc = tid & 15, cb = tid >> 4;
    float bv[8];
#pragma unroll
    for (int ps = 0; ps < 8; ++ps) bv[ps] = bias[srcc0 + ps * 16 + cb];
#pragma unroll
    for (int ps = 0; ps < 8; ++ps) {
      const int col = ps * 16 + cb;
      float v[8];
      lds_read8(sC + col * LDC + tc * 8, v);
#pragma unroll
      for (int e = 0; e < 8; ++e) v[e] += bv[ps];
      bf16_t* dst;
      if (nt == 5) dst = p.vAT + ((size_t)(b * 2 + (col >> 6)) * 64 + (col & 63)) * PALL;
      else if (nt <= 13) dst = p.vBT + ((size_t)(b * 4 + (nt - 10)) * 128 + col) * PALL;
      else dst = p.vCT + ((size_t)(b * 8 + (nt - 26) * 2 + (col >> 6)) * 64 + (col & 63)) * PALL;
      *(uint4*)(dst + pall0 + tc * 8) = pack8(v);
    }
  } else if (nt <= 4) {
    const float* gn = (nt < 4 ? p.q_norm : p.k_norm) + layer * 64;
    const float osc = nt < 4 ? QSCALE : 1.f;
    const int c8 = tid & 15, rb = tid >> 4, d0 = (c8 & 7) * 8;
    float bs[8], bp[8], g0[8], g1[8];
    {
      const float4 t0 = *(const float4*)(bias + srcc0 + c8 * 8), t1 = *(const float4*)(bias + srcc0 + c8 * 8 + 4);
      const float4 u0 = *(const float4*)(bias + srcc0 + ((c8 * 8) ^ 16)), u1 = *(const float4*)(bias + srcc0 + ((c8 * 8) ^ 16) + 4);
      const float4 a0 = *(const float4*)(gn + d0), a1 = *(const float4*)(gn + d0 + 4);
      const float4 c0 = *(const float4*)(gn + (d0 ^ 16)), c1 = *(const float4*)(gn + (d0 ^ 16) + 4);
      bs[0] = t0.x; bs[1] = t0.y; bs[2] = t0.z; bs[3] = t0.w; bs[4] = t1.x; bs[5] = t1.y; bs[6] = t1.z; bs[7] = t1.w;
      bp[0] = u0.x; bp[1] = u0.y; bp[2] = u0.z; bp[3] = u0.w; bp[4] = u1.x; bp[5] = u1.y; bp[6] = u1.z; bp[7] = u1.w;
      g0[0] = a0.x; g0[1] = a0.y; g0[2] = a0.z; g0[3] = a0.w; g0[4] = a1.x; g0[5] = a1.y; g0[6] = a1.z; g0[7] = a1.w;
      g1[0] = c0.x; g1[1] = c0.y; g1[2] = c0.z; g1[3] = c0.w; g1[4] = c1.x; g1[5] = c1.y; g1[6] = c1.z; g1[7] = c1.w;
    }
    const int qd = d0 >> 4;
    const float sgn = (qd & 1) ? 1.f : -1.f;
#pragma unroll 1
    for (int hb = 0; hb < 2; ++hb) {
      f32x4v rc0[4], rc1[4], rs0[4], rs1[4];
#pragma unroll
      for (int q = 0; q < 4; ++q) {
        const int t = pos0 + (hb * 4 + q) * 16 + rb;
        const int pp = (qd < 2) ? (t >> 6) : (t & 63);
        const float* rp = p.rope + pp * 16 + (d0 & 15);
        if (lat) { rc0[q] = *(const f32x4v*)rp; rc1[q] = *(const f32x4v*)(rp + 4); rs0[q] = *(const f32x4v*)(rp + 1024); rs1[q] = *(const f32x4v*)(rp + 1028); }
        else { rc0[q] = rc1[q] = (f32x4v){1.f, 1.f, 1.f, 1.f}; rs0[q] = rs1[q] = (f32x4v){0.f, 0.f, 0.f, 0.f}; }
      }
#pragma unroll
      for (int q = 0; q < 4; ++q) {
        const int row = (hb * 4 + q) * 16 + rb;
        float v[8], pv[8];
        lds_read8(sC + row * LDC + c8 * 8, v);
        lds_read8(sC + row * LDC + ((c8 * 8) ^ 16), pv);
        const float cs[8] = {rc0[q][0], rc0[q][1], rc0[q][2], rc0[q][3], rc1[q][0], rc1[q][1], rc1[q][2], rc1[q][3]};
        const float sn[8] = {rs0[q][0], rs0[q][1], rs0[q][2], rs0[q][3], rs1[q][0], rs1[q][1], rs1[q][2], rs1[q][3]};
        float ss = 0.f;
#pragma unroll
        for (int e = 0; e < 8; ++e) { v[e] += bs[e]; pv[e] += bp[e]; ss += v[e] * v[e]; }
        ss += __shfl_xor(ss, 1);
        ss += __shfl_xor(ss, 2);
        ss += __shfl_xor(ss, 4);
        const float rstd = rsqrtf(ss * (1.f / 64.f) + 1e-6f);
        float o[8];
#pragma unroll
        for (int e = 0; e < 8; ++e) {
          const float xn = v[e] * rstd * g0[e], pn = pv[e] * rstd * g1[e];
          o[e] = (xn * cs[e] + sgn * pn * sn[e]) * osc;
        }
        bf16_t* dst;
        if (nt < 4) dst = p.qA + (size_t)(tok0 + row) * 512 + nt * 128 + c8 * 8;
        else dst = p.kA + ((size_t)(b * 2 + (c8 >> 3)) * PALL + pall0 + row) * 64 + d0;
        *(uint4*)dst = pack8(o);
      }
    }
  } else {
    bf16_t* base;
    int ld, cofs;
    float osc = 1.f;
    if (nt <= 7) { base = p.qB; ld = 256; cofs = (nt - 6) * 128; osc = 0.125f; }
    else if (nt <= 9) { base = p.kB; ld = 256; cofs = (nt - 8) * 128; }
    else if (nt <= 17) { base = p.rB; ld = 512; cofs = (nt - 14) * 128; }
    else if (nt <= 21) { base = p.qC; ld = 512; cofs = (nt - 18) * 128; osc = QSCALE; }
    else { base = p.kC; ld = 512; cofs = (nt - 22) * 128; }
    const int c8 = tid & 15, rb = tid >> 4;
    float bs[8];
    {
      const float4 t0 = *(const float4*)(bias + srcc0 + c8 * 8), t1 = *(const float4*)(bias + srcc0 + c8 * 8 + 4);
      bs[0] = t0.x; bs[1] = t0.y; bs[2] = t0.z; bs[3] = t0.w; bs[4] = t1.x; bs[5] = t1.y; bs[6] = t1.z; bs[7] = t1.w;
    }
#pragma unroll
    for (int ps = 0; ps < 8; ++ps) {
      const int row = ps * 16 + rb;
      float v[8];
      lds_read8(sC + row * LDC + c8 * 8, v);
#pragma unroll
      for (int e = 0; e < 8; ++e) v[e] = (v[e] + bs[e]) * osc;
      *(uint4*)(base + (size_t)(tok0 + row) * ld + cofs + c8 * 8) = pack8(v);
    }
  }
}

__device__ __forceinline__ void gate_epilogue(PRef p, int layer, int mt, int nt, const float* sC, int tid) {
  const float* bias = p.b_in + layer * NIN_SRC + 3872 + nt * 128;
  const int c8 = tid & 15, rb = tid >> 4;
  float bs[8];
  {
    const float4 t0 = *(const float4*)(bias + c8 * 8), t1 = *(const float4*)(bias + c8 * 8 + 4);
    bs[0] = t0.x; bs[1] = t0.y; bs[2] = t0.z; bs[3] = t0.w; bs[4] = t1.x; bs[5] = t1.y; bs[6] = t1.z; bs[7] = t1.w;
  }
#pragma unroll
  for (int ps = 0; ps < 8; ++ps) {
    const int row = ps * 16 + rb;
    float v[8];
    lds_read8(sC + row * LDC + c8 * 8, v);
#pragma unroll
    for (int e = 0; e < 8; ++e) v[e] = sigmoidf_(v[e] + bs[e]);
    *(uint4*)(p.G + (size_t)(mt * 128 + row) * 3072 + nt * 128 + c8 * 8) = pack8(v);
  }
}
__device__ __forceinline__ void phase_inproj(PRef p, int layer, char* smem_all) {
  LAS3 unsigned char* lds = (LAS3 unsigned char*)smem_all;
  constexpr int NSTREAM_IN = 68 * 12, NSTREAM = NSTREAM_IN + 64 * 12, NOLD = 68 * 3;
  {
    unsigned voffA[2];
    pg8::voff_contig(D, voffA);
    const int G = (int)gridDim.x, c = (int)__builtin_amdgcn_workgroup_id_x();
    const int rem = NSTREAM % G;
    for (int j = (c - rem + G) % G; j < NOLD; j += G) {
      int pm, pn;
      pg8::unit_map(j, 68, 3, pm, pn);
      pg8::f32x4 acc[2][2][4][2];
      const char* a0 = (const char*)(p.h + (size_t)pm * 256 * D);
      pg8::gemm_unit(lds, a0, a0 + (size_t)128 * D * 2, voffA, voffA, (const char*)(p.wt_in + (size_t)pn * 256 * D), D, acc);
      asm volatile("" : "+s"(pm), "+s"(pn));
      PRef pe = params_view();
      const int etid = tid_();
      const int half = half_();
      float* sCh = (float*)(smem_all + half * SMEM_BYTES);
      pg8::acc_to_lds<0, 0>(acc, inproj_transposed(2 * pn), (float*)smem_all);
      pg8::acc_to_lds<0, 1>(acc, inproj_transposed(2 * pn + 1), (float*)(smem_all + SMEM_BYTES));
      __syncthreads();
      inproj_epilogue(pe, layer, 2 * pm, 2 * pn + half, sCh, etid);
      __syncthreads();
      pg8::acc_to_lds<1, 0>(acc, inproj_transposed(2 * pn), (float*)smem_all);
      pg8::acc_to_lds<1, 1>(acc, inproj_transposed(2 * pn + 1), (float*)(smem_all + SMEM_BYTES));
      __syncthreads();
      inproj_epilogue(pe, layer, 2 * pm + 1, 2 * pn + half, sCh, etid);
      __syncthreads();
    }
  }
  {
    PRef pg = params_view();
    const bf16_t* hbase = pg.h;
    const bf16_t* win = pg.wt_in;
    const bf16_t* wg = pg.wt_gate;
    const float* bias = pg.b_in + layer * NIN_SRC;
    bf16_t* gbase = pg.G;
    pg8::gemm_stream<true>(lds, D,
      [&](int ui, pg8::UnitAB& u) {
        const int s = pg8::unit_linear(ui);
        int pm, pn;
        if (s < NSTREAM_IN) {
          pg8::unit_map(s, 68, 12, pm, pn);
          pn += 3;
          const char* hr = (const char*)(hbase + (size_t)pm * 256 * D);
          const char* wr_ = (const char*)(win + (size_t)pn * 256 * D);
          const bool T = (pn == 5) || (pn == 6) || (pn >= 13);
          u.a = T ? wr_ : hr;
          u.b = T ? hr : wr_;
          return true;
        }
        if (!pg8::unit_map(s - NSTREAM_IN, 64, 12, pm, pn)) return false;
        u.a = (const char*)(hbase + (size_t)pm * 256 * D);
        u.b = (const char*)(wg + (size_t)pn * 256 * D);
        return true;
      },
      [&](int ui, const pg8::f32x4 (&acc)[2][2][4][2]) {
        const int s = pg8::unit_linear(ui);
        int lt = __builtin_amdgcn_workitem_id_x();
        asm volatile("" : "+v"(lt));
        const int wc = (lt >> 6) & 3, wr = lt >> 8, fr = lt & 15, fq = (lt & 63) >> 4;
        const int cbase = 32 * wc + 8 * fq;
        int pm, pn;
        if (s >= NSTREAM_IN) {
          pg8::unit_map(s - NSTREAM_IN, 64, 12, pm, pn);
          const float* gb = bias + 3872 + pn * 256;
          bf16_t* gdst = gbase + (size_t)pm * 256 * 3072 + pn * 256;
          const float4 ba0 = *(const float4*)(gb + cbase), ba1 = *(const float4*)(gb + cbase + 4);
          const float4 bb0 = *(const float4*)(gb + 128 + cbase), bb1 = *(const float4*)(gb + 128 + cbase + 4);
          pg8::for_each_piece(acc, [&](int row, int col, float (&v)[8]) {
            const float4 b0 = col < 128 ? ba0 : bb0, b1 = col < 128 ? ba1 : bb1;
            v[0] = sigmoidf_(v[0] + b0.x); v[1] = sigmoidf_(v[1] + b0.y); v[2] = sigmoidf_(v[2] + b0.z); v[3] = sigmoidf_(v[3] + b0.w);
            v[4] = sigmoidf_(v[4] + b1.x); v[5] = sigmoidf_(v[5] + b1.y); v[6] = sigmoidf_(v[6] + b1.z); v[7] = sigmoidf_(v[7] + b1.w);
            st_nt16(gdst + (size_t)row * 3072 + col, pack8(v));
          });
          return;
        }
        pg8::unit_map(s, 68, 12, pm, pn);
        pn += 3;
        const float* bsrc = bias + (pn < 9 ? pn * 256 : pn * 256 + 32);
        const bool T = (pn == 5) || (pn == 6) || (pn >= 13);
        if (!T) {
          bf16_t* base; int ld, cofs0; float osc = 1.f;
          if (pn == 3) { base = pg.qB; ld = 256; cofs0 = 0; osc = 0.125f; }
          else if (pn == 4) { base = pg.kB; ld = 256; cofs0 = 0; }
          else if (pn <= 8) { base = pg.rB; ld = 512; cofs0 = (pn - 7) * 256; }
          else if (pn <= 10) { base = pg.qC; ld = 512; cofs0 = (pn - 9) * 256; osc = QSCALE; }
          else { base = pg.kC; ld = 512; cofs0 = (pn - 11) * 256; }
          const float4 ba0 = *(const float4*)(bsrc + cbase), ba1 = *(const float4*)(bsrc + cbase + 4);
          const float4 bb0 = *(const float4*)(bsrc + 128 + cbase), bb1 = *(const float4*)(bsrc + 128 + cbase + 4);
          bf16_t* d0 = base + (size_t)pm * 256 * ld + cofs0;
          pg8::for_each_piece(acc, [&](int row, int col, float (&v)[8]) {
            const float4 b0 = col < 128 ? ba0 : bb0, b1 = col < 128 ? ba1 : bb1;
            v[0] = (v[0] + b0.x) * osc; v[1] = (v[1] + b0.y) * osc; v[2] = (v[2] + b0.z) * osc; v[3] = (v[3] + b0.w) * osc;
            v[4] = (v[4] + b1.x) * osc; v[5] = (v[5] + b1.y) * osc; v[6] = (v[6] + b1.z) * osc; v[7] = (v[7] + b1.w) * osc;
            st_nt16(d0 + (size_t)row * ld + col, pack8(v));
          });
        } else {
          bf16_t* tb; int f0;
          if (pn <= 6) { tb = pg.vBT; f0 = (pn - 5) * 256; } else { tb = pg.vCT; f0 = (pn - 13) * 256; }
          const int tok0 = pm * 256;
          int b, pall0;
          if (tok0 < TLAT) { b = tok0 >> 12; pall0 = 256 + (tok0 & 4095); } else { const int ci = tok0 - TLAT; b = ci >> 8; pall0 = ci & 255; }
          bf16_t* d0 = tb + (size_t)(b * 512 + f0) * PALL + pall0;
          const int rbase = 64 * wr + fr;
          float bv[2][4];
#pragma unroll
          for (int ai = 0; ai < 2; ++ai)
#pragma unroll
            for (int m = 0; m < 4; ++m) bv[ai][m] = bsrc[128 * ai + rbase + 16 * m];
#pragma unroll
          for (int ai = 0; ai < 2; ++ai)
#pragma unroll
            for (int m = 0; m < 4; ++m)
#pragma unroll
              for (int bj = 0; bj < 2; ++bj) {
                const pg8::f32x4 x0 = acc[ai][bj][m][0], x1 = acc[ai][bj][m][1];
                const float bb = bv[ai][m];
                float v[8] = {x0[0] + bb, x0[1] + bb, x0[2] + bb, x0[3] + bb, x1[0] + bb, x1[1] + bb, x1[2] + bb, x1[3] + bb};
                st_nt16(d0 + (size_t)(128 * ai + rbase + 16 * m) * PALL + 128 * bj + cbase, pack8(v));
              }
        }
      });
  }
  {
    const int vtid = tid_();
    char* smem = smem_all + half_() * SMEM_BYTES;
    float* sC = (float*)smem;
    const int lane = vtid & 63, w = vtid >> 6, wr = w >> 1, wc = w & 1, r = lane & 31, hh = lane >> 5;
    for (int mt = bid_(); mt < 136; mt += vgrid_()) {
      f32x16 acc[2][1];
      acc[0][0] = zero16();
      acc[1][0] = zero16();
      gemm_mainloop<1>(rows_contig(p.h + (size_t)mt * 128 * D, D), rows_contig(p.wt_in + (size_t)3840 * D, D), 16, acc, smem);
#pragma unroll
      for (int i2 = 0; i2 < 2; ++i2)
#pragma unroll
        for (int g = 0; g < 16; ++g) {
          int row = wr * 64 + i2 * 32 + (g & 3) + 8 * (g >> 2) + 4 * hh, col = wc * 32 + r;
          sC[row * LDC + col] = acc[i2][0][g];
        }
      __syncthreads();
      const float ba = p.b_in[layer * NIN_SRC + 2304 + (vtid & 31)];
      for (int i2 = vtid; i2 < 128 * 32; i2 += 256) {
        int row = i2 >> 5, col = i2 & 31;
        p.aB[(size_t)(mt * 128 + row) * 32 + col] = sC[row * LDC + col] + ba;
      }
      __syncthreads();
    }
  }
}

__device__ __forceinline__ void merge_tiles(PRef p, int layer, char* smem, int mt0, int nmt) {
  float* sC = (float*)smem;
  const int tid = tid_(), lane = tid & 63, w = tid >> 6, wr = w >> 1, wc = w & 1, r = lane & 31, hh = lane >> 5;
  const float* bias = p.b_in + layer * NIN_SRC + 3872;
  const int nrounds = xcd_rounds(smem, nmt, 16);
  for (int rd = 0; rd < nrounds; ++rd) {
    int mt, nt;
    if (!xcd_tile(smem, rd, nmt, 16, mt, nt)) continue;
    mt += mt0;
    f32x16 tot[2][1];
    tot[0][0] = zero16();
    tot[1][0] = zero16();
#pragma unroll 1
    for (int br = 0; br < 3; ++br) {
      f32x16 acc[2][1];
      acc[0][0] = zero16();
      acc[1][0] = zero16();
      gemm_mainloop<1>(rows_contig(p.h + (size_t)mt * 128 * D, D), rows_contig(p.wt_gate + (size_t)(br * 1024 + nt * 64) * D, D), 16, acc, smem);
      unsigned sg[2][8];
      {
        float bv = bias[br * 1024 + nt * 64 + wc * 32 + r];
#pragma unroll
        for (int i = 0; i < 2; ++i)
#pragma unroll
          for (int g = 0; g < 8; ++g)
            sg[i][g] = pack2(sigmoidf_(acc[i][0][2 * g] + bv), sigmoidf_(acc[i][0][2 * g + 1] + bv));
      }
      acc[0][0] = zero16();
      acc[1][0] = zero16();
      const bf16_t* ob = (br == 0 ? p.oA : (br == 1 ? p.oB : p.oC));
      gemm_mainloop<1>(rows_contig(ob + (size_t)mt * 128 * 512, 512), rows_contig(p.wt_br + ((size_t)br * 1024 + nt * 64) * 512, 512), 8, acc, smem);
#pragma unroll
      for (int i = 0; i < 2; ++i)
#pragma unroll
        for (int g = 0; g < 8; ++g) {
          tot[i][0][2 * g] += bf2f((bf16_t)(sg[i][g] & 0xffff)) * acc[i][0][2 * g];
          tot[i][0][2 * g + 1] += bf2f((bf16_t)(sg[i][g] >> 16)) * acc[i][0][2 * g + 1];
        }
    }
#pragma unroll
    for (int i = 0; i < 2; ++i)
#pragma unroll
      for (int g = 0; g < 16; ++g) {
        int row = wr * 64 + i * 32 + (g & 3) + 8 * (g >> 2) + 4 * hh, col = wc * 32 + r;
        sC[row * LDC + col] = tot[i][0][g];
      }
    __syncthreads();
#pragma unroll 1
    for (int ps = 0; ps < 4; ++ps) {
      int row = ps * 32 + (tid >> 3), c8 = tid & 7;
      float v[8];
      lds_read8(sC + row * LDC + c8 * 8, v);
      *(uint4*)(p.m + (size_t)(mt * 128 + row) * D + nt * 64 + c8 * 8) = pack8(v);
    }
    __syncthreads();
  }
}

__device__ __forceinline__ void merge_epilogue(PRef p, int br, int mt, int nt, const float* sC, int tid) {
  const int c8 = tid & 15, rb = tid >> 4;
#pragma unroll 1
  for (int hb = 0; hb < 2; ++hb) {
    u32x4 gv[4], mv[4];
#pragma unroll
    for (int q = 0; q < 4; ++q) {
      const size_t tok = (size_t)(mt * 128 + (hb * 4 + q) * 16 + rb);
      gv[q] = *(const u32x4*)(p.G + tok * 3072 + br * 1024 + nt * 128 + c8 * 8);
      if (br > 0) mv[q] = *(const u32x4*)(p.m + tok * D + nt * 128 + c8 * 8);
    }
#pragma unroll
    for (int q = 0; q < 4; ++q) {
      const int row = (hb * 4 + q) * 16 + rb;
      float v[8];
      lds_read8(sC + row * LDC + c8 * 8, v);
#pragma unroll
      for (int e2 = 0; e2 < 4; ++e2) {
        v[2 * e2] *= bf2f((bf16_t)(gv[q][e2] & 0xffff));
        v[2 * e2 + 1] *= bf2f((bf16_t)(gv[q][e2] >> 16));
        if (br > 0) { v[2 * e2] += bf2f((bf16_t)(mv[q][e2] & 0xffff)); v[2 * e2 + 1] += bf2f((bf16_t)(mv[q][e2] >> 16)); }
      }
      *(uint4*)(p.m + (size_t)(mt * 128 + row) * D + nt * 128 + c8 * 8) = pack8(v);
    }
  }
}
__device__ __forceinline__ void phase_merge(PRef p, int layer, char* smem_all) {
  LAS3 unsigned char* lds = (LAS3 unsigned char*)smem_all;
  {
    PRef pe = params_view();
    const bf16_t* oA = pe.oA; const bf16_t* oB = pe.oB; const bf16_t* oC = pe.oC;
    const bf16_t* wbr = pe.wt_br;
    const bf16_t* Gp = pe.G;
    bf16_t* mp = pe.m;
    pg8::gemm_stream<true>(lds, 512,
      [&](int ui, pg8::UnitAB& u) {
        const int br = ui % 3;
        int pm, pn;
        if (!pg8::unit_map(pg8::unit_linear(ui / 3), 64, 4, pm, pn)) return false;
        const bf16_t* ob = (br == 0 ? oA : (br == 1 ? oB : oC));
        u.a = (const char*)(ob + (size_t)pm * 256 * 512);
        u.b = (const char*)(wbr + ((size_t)br * 1024 + pn * 256) * 512);
        return true;
      },
      [&](int ui, const pg8::f32x4 (&acc)[2][2][4][2]) {
        const int br = ui % 3;
        int pm, pn;
        pg8::unit_map(pg8::unit_linear(ui / 3), 64, 4, pm, pn);
        const bf16_t* gsrc = Gp + (size_t)pm * 256 * 3072 + br * 1024 + pn * 256;
        bf16_t* mdst = mp + (size_t)pm * 256 * D + pn * 256;
        const bool rmw = br > 0;
        int lt = __builtin_amdgcn_workitem_id_x();
        asm volatile("" : "+v"(lt));
        const int wid = lt >> 6, lane = lt & 63, wr = wid >> 2, wc = wid & 3, fr = lane & 15, fq = lane >> 4;
#pragma unroll
        for (int ai = 0; ai < 2; ++ai) {
          u32x4 gq[4][2], mq[4][2];
#pragma unroll
          for (int m = 0; m < 4; ++m)
#pragma unroll
            for (int bj = 0; bj < 2; ++bj) {
              const int row = 128 * ai + 64 * wr + 16 * m + fr, col = 128 * bj + 32 * wc + 8 * fq;
              gq[m][bj] = *(const u32x4*)(gsrc + (size_t)row * 3072 + col);
              if (rmw) mq[m][bj] = *(const u32x4*)(mdst + (size_t)row * D + col);
            }
#pragma unroll
          for (int m = 0; m < 4; ++m)
#pragma unroll
            for (int bj = 0; bj < 2; ++bj) {
              const int row = 128 * ai + 64 * wr + 16 * m + fr, col = 128 * bj + 32 * wc + 8 * fq;
              const pg8::f32x4 a = acc[ai][bj][m][0], b = acc[ai][bj][m][1];
              float v[8] = {a[0], a[1], a[2], a[3], b[0], b[1], b[2], b[3]};
              const u32x4 g = gq[m][bj];
#pragma unroll
              for (int e2 = 0; e2 < 4; ++e2) {
                v[2 * e2] *= bf2f((bf16_t)(g[e2] & 0xffff));
                v[2 * e2 + 1] *= bf2f((bf16_t)(g[e2] >> 16));
                if (rmw) { v[2 * e2] += bf2f((bf16_t)(mq[m][bj][e2] & 0xffff)); v[2 * e2 + 1] += bf2f((bf16_t)(mq[m][bj][e2] >> 16)); }
              }
              *(uint4*)(mdst + (size_t)row * D + col) = pack8(v);
            }
        }
      });
  }
  if (layer == 0) merge_tiles(p, layer, smem_all + half_() * SMEM_BYTES, 128, 8);
}

__device__ __forceinline__ void outproj_epilogue(PRef p, int layer, int mt, int nt, const float* sC, int tid) {
  const int tok0 = mt * 128;
  const float* g1 = p.mod + ((size_t)layer * 5 + tok_modrow(tok0)) * NMOD + 2048 + nt * 128;
  const int c8 = tid & 15, rb = tid >> 4;
  const float4 ga = *(const float4*)(g1 + c8 * 8), gb = *(const float4*)(g1 + c8 * 8 + 4);
  f32x4v x0[8], x1[8];
#pragma unroll
  for (int q = 0; q < 8; ++q) {
    const int tok = tok0 + q * 16 + rb;
    const float* xp;
    if (layer == 0) xp = tok < TLAT ? p.x + (size_t)tok * D : p.ctx + (size_t)(tok - TLAT) * D;
    else xp = p.xres + (size_t)tok * D;
    xp += nt * 128 + c8 * 8;
    x0[q] = *(const f32x4v*)xp; x1[q] = *(const f32x4v*)(xp + 4);
  }
#pragma unroll
  for (int q = 0; q < 8; ++q) {
    const int row = q * 16 + rb;
    float v[8];
    lds_read8(sC + row * LDC + c8 * 8, v);
    float4 o0 = make_float4(ALPHA * x0[q][0] + ga.x * v[0], ALPHA * x0[q][1] + ga.y * v[1], ALPHA * x0[q][2] + ga.z * v[2], ALPHA * x0[q][3] + ga.w * v[3]);
    float4 o1 = make_float4(ALPHA * x1[q][0] + gb.x * v[4], ALPHA * x1[q][1] + gb.y * v[5], ALPHA * x1[q][2] + gb.z * v[6], ALPHA * x1[q][3] + gb.w * v[7]);
    float* op = p.xres + (size_t)(tok0 + row) * D + nt * 128 + c8 * 8;
    *(float4*)op = o0;
    *(float4*)(op + 4) = o1;
  }
}
__device__ __forceinline__ void phase_outproj(PRef p, int layer, char* smem_all) {
  LAS3 unsigned char* lds = (LAS3 unsigned char*)smem_all;
  unsigned voffA[2];
  pg8::voff_contig(D, voffA);
  for (int i = 0;; ++i) {
    int pm, pn;
    if (!pg8::unit_map(pg8::unit_linear(i), 64, 4, pm, pn)) break;
    pg8::f32x4 acc[2][2][4][2];
    const char* a0 = (const char*)(p.m + (size_t)pm * 256 * D);
    pg8::gemm_unit(lds, a0, a0 + (size_t)128 * D * 2, voffA, voffA, (const char*)(p.wt_out + (size_t)pn * 256 * D), D, acc);
    asm volatile("" : "+s"(pm), "+s"(pn));
    PRef pe = params_view();
    const int etid = tid_();
    const int half = half_();
    float* sCh = (float*)(smem_all + half * SMEM_BYTES);
    pg8::acc_to_lds<0, 0>(acc, false, (float*)smem_all);
    pg8::acc_to_lds<0, 1>(acc, false, (float*)(smem_all + SMEM_BYTES));
    __syncthreads();
    outproj_epilogue(pe, layer, 2 * pm, 2 * pn + half, sCh, etid);
    __syncthreads();
    pg8::acc_to_lds<1, 0>(acc, false, (float*)smem_all);
    pg8::acc_to_lds<1, 1>(acc, false, (float*)(smem_all + SMEM_BYTES));
    __syncthreads();
    outproj_epilogue(pe, layer, 2 * pm + 1, 2 * pn + half, sCh, etid);
    __syncthreads();
  }
  if (layer == 0) {
    char* smem = smem_all + half_() * SMEM_BYTES;
    float* sC = (float*)smem;
    const int tid = tid_();
    for (int item = bid_(); item < 64; item += vgrid_()) {
      const int mt = 128 + (item >> 3), nt = item & 7;
      f32x16 acc[2][2];
#pragma unroll
      for (int i = 0; i < 2; ++i)
#pragma unroll
        for (int j = 0; j < 2; ++j) acc[i][j] = zero16();
      gemm_mainloop<2>(rows_contig(p.m + (size_t)mt * 128 * D, D), rows_contig(p.wt_out + (size_t)nt * 128 * D, D), 16, acc, smem);
      acc_to_lds(acc, sC);
      __syncthreads();
      outproj_epilogue(p, layer, mt, nt, sC, tid);
      __syncthreads();
    }
  }
}

__device__ __forceinline__ bool moe_block_lookup(PRef p, int mb, int& e, int& lb, int& cnt_e) {
  int start = 0;
  for (int i = 0; i < 32; ++i) {
    int c = p.cnt[i];
    int nb = (c + MOE_BLK - 1) / MOE_BLK;
    if (mb < start + nb) { e = i; lb = mb - start; cnt_e = c; return true; }
    start += nb;
  }
  return false;
}
struct MoeMap { int c, start, incl; };
__device__ __forceinline__ MoeMap moe_map_build(const int* cnt) {
  int lane = __builtin_amdgcn_workitem_id_x() & 63;
  asm volatile("" : "+v"(lane));
  MoeMap m;
  m.c = lane < 32 ? cnt[lane] : 0;
  const int nb = (m.c + MOE_BLK - 1) / MOE_BLK;
  int v = nb;
#define MOE_DPP_ADD(ctrl, rmask) v += __builtin_amdgcn_update_dpp(0, v, ctrl, rmask, 0xf, false)
  MOE_DPP_ADD(0x111, 0xf); MOE_DPP_ADD(0x112, 0xf); MOE_DPP_ADD(0x114, 0xf); MOE_DPP_ADD(0x118, 0xf);
  MOE_DPP_ADD(0x142, 0xa); MOE_DPP_ADD(0x143, 0xc);
#undef MOE_DPP_ADD
  m.incl = v;
  m.start = v - nb;
  return m;
}
__device__ __forceinline__ bool moe_map_lookup(const MoeMap& m, int mb, int& e, int& lb, int& cnt_e) {
  const unsigned long long hit = __ballot(mb >= m.start && mb < m.incl);
  if (hit == 0ull) return false;
  e = __builtin_amdgcn_readfirstlane(__ffsll((long long)hit) - 1);
  lb = mb - __builtin_amdgcn_readlane(m.start, e);
  cnt_e = __builtin_amdgcn_readlane(m.c, e);
  return true;
}
__device__ __forceinline__ void moe1_epilogue(PRef p, int slot0, int nt, const float* sC, int tid) {
#pragma unroll
  for (int ps = 0; ps < 8; ++ps) {
    const int row = ps * 16 + (tid >> 4), c4 = (tid & 15) * 4;
    const float4 a = *(const float4*)(sC + row * LDC + c4);
    const float4 b = *(const float4*)(sC + row * LDC + 64 + c4);
    const uint2 o = make_uint2(pack2(siluf(a.x) * b.x, siluf(a.y) * b.y), pack2(siluf(a.z) * b.z, siluf(a.w) * b.w));
    *(uint2*)(p.act + (size_t)(slot0 + row) * 512 + nt * 64 + c4) = o;
  }
}
__device__ __forceinline__ void moe2_epilogue(PRef p, int slot0, int nt, const float* sC, int tid) {
#pragma unroll
  for (int ps = 0; ps < 8; ++ps) {
    const int row = ps * 16 + (tid >> 4), c8 = tid & 15;
    float v[8];
    lds_read8(sC + row * LDC + c8 * 8, v);
    *(uint4*)(p.ysl + (size_t)(slot0 + row) * D + nt * 128 + c8 * 8) = pack8(v);
  }
}
__device__ __forceinline__ void phase_moe1(PRef p, int layer, char* smem_all) {
  LAS3 unsigned char* lds = (LAS3 unsigned char*)smem_all;
  const MoeMap mm = moe_map_build(p.cnt);
  if (__builtin_amdgcn_workgroup_id_x() == 0 && __builtin_amdgcn_workitem_id_x() < 32) p.estart[__builtin_amdgcn_workitem_id_x()] = mm.start;
  struct UnitG { int mb, pn, e; unsigned a0[2], a1[2]; bool ok; };
  auto fetch = [&](int i, int& mb, int& pn, int& e, unsigned (&a0)[2], unsigned (&a1)[2]) -> bool {
    const int L = pg8::unit_linear(i);
    mb = L >> 2; pn = L & 3;
    int lb, ce;
    if (mb >= MAX_MBLK || !moe_map_lookup(mm, mb, e, lb, ce)) return false;
    int tid = __builtin_amdgcn_workitem_id_x();
    asm volatile("" : "+v"(tid));
#pragma unroll
    for (int q = 0; q < 2; ++q) {
      int R, C;
      pg8::stage_rc(tid * 16 + q * 8192, R, C);
      const int s0 = lb * MOE_BLK + R, s1 = s0 + 128;
      const int t0 = s0 < ce ? p.list[e * MOE_CAP + s0] : 0;
      const int t1 = s1 < ce ? p.list[e * MOE_CAP + s1] : 0;
      a0[q] = (unsigned)(t0 * D + C) * 2u;
      a1[q] = (unsigned)(t1 * D + C) * 2u;
    }
    return true;
  };
  int mb, pn, e;
  unsigned voffA0[2], voffA1[2];
  bool ok = fetch(0, mb, pn, e, voffA0, voffA1);
  for (int i = 0; ok; ++i) {
    int mbn, pnn, en;
    unsigned n0[2], n1[2];
    const bool okn = fetch(i + 1, mbn, pnn, en, n0, n1);
    pg8::f32x4 acc[2][2][4][2];
    pg8::gemm_unit(lds, (const char*)p.h2, (const char*)p.h2, voffA0, voffA1, (const char*)(p.wt_13 + ((size_t)e * 1024 + pn * 256) * D), D, acc);
    asm volatile("" : "+s"(mb), "+s"(pn));
    PRef pe = params_view();
    const int etid = tid_();
    const int half = half_();
    float* sCh = (float*)(smem_all + half * SMEM_BYTES);
    pg8::acc_to_lds<0, 0>(acc, false, (float*)smem_all);
    pg8::acc_to_lds<0, 1>(acc, false, (float*)(smem_all + SMEM_BYTES));
    __syncthreads();
    moe1_epilogue(pe, mb * MOE_BLK, 2 * pn + half, sCh, etid);
    __syncthreads();
    pg8::acc_to_lds<1, 0>(acc, false, (float*)smem_all);
    pg8::acc_to_lds<1, 1>(acc, false, (float*)(smem_all + SMEM_BYTES));
    __syncthreads();
    moe1_epilogue(pe, mb * MOE_BLK + 128, 2 * pn + half, sCh, etid);
    __syncthreads();
    ok = okn; mb = mbn; pn = pnn; e = en;
    voffA0[0] = n0[0]; voffA0[1] = n0[1]; voffA1[0] = n1[0]; voffA1[1] = n1[1];
  }
}
__device__ __forceinline__ void phase_moe2(PRef p, int layer, char* smem_all) {
  LAS3 unsigned char* lds = (LAS3 unsigned char*)smem_all;
  const bf16_t* actp = p.act;
  const bf16_t* w2p = p.wt_2;
  bf16_t* yp = p.ysl;
  const MoeMap mm = moe_map_build(p.cnt);
  auto lookup = [&](int mb, int& e) { int lb, ce; return moe_map_lookup(mm, mb, e, lb, ce); };
  pg8::gemm_stream<true>(lds, 512,
    [&](int ui, pg8::UnitAB& u) {
      const int L = pg8::unit_linear(ui);
      const int mb = L >> 2, pn = L & 3;
      int e;
      if (mb >= MAX_MBLK || !lookup(mb, e)) return false;
      u.a = (const char*)(actp + (size_t)mb * MOE_BLK * 512);
      u.b = (const char*)(w2p + ((size_t)e * 1024 + pn * 256) * 512);
      return true;
    },
    [&](int ui, const pg8::f32x4 (&acc)[2][2][4][2]) {
      const int L = pg8::unit_linear(ui);
      const int mb = L >> 2, pn = L & 3;
      bf16_t* ydst = yp + (size_t)mb * MOE_BLK * D + pn * 256;
      pg8::for_each_piece(acc, [&](int row, int col, float (&v)[8]) { st_nt16(ydst + (size_t)row * D + col, pack8(v)); });
    });
}

struct AttnState { f32x16 negm; f32x16 L; };
__device__ __forceinline__ void attn_qk(const char* sK, const bf16x8 (&bq)[4], const f32x16& negm, f32x16 (&S)[2], int r, int hh) {
  const int pr = 16 * (r >> 4) + 8 * ((r >> 2) & 1) + 4 * ((r >> 3) & 1) + (r & 3);
  const char* kp = sK + pr * 128;
#pragma unroll
  for (int s = 0; s < 4; ++s) {
    const int co = ((2 * s + hh) ^ ((pr >> 1) & 7)) << 4;
    bf16x8 a0 = *(const bf16x8*)(kp + co);
    bf16x8 a1 = *(const bf16x8*)(kp + 4096 + co);
    if (s == 0) { S[0] = mfma32(a0, bq[0], negm); S[1] = mfma32(a1, bq[0], negm); }
    else { S[0] = mfma32(a0, bq[s], S[0]); S[1] = mfma32(a1, bq[s], S[1]); }
  }
}
template <class MaskF>
__device__ __forceinline__ float attn_softmax_pv(f32x16 (&S)[2], const char* sV, f32x16 (&O)[2], AttnState& st, bf16x8 ones, int r, int hh,
                                                 MaskF maskf, const bool FIRST) {
  maskf(S);
  float mx = S[0][0];
#pragma unroll
  for (int g = 1; g < 16; ++g) mx = fmaxf(mx, S[0][g]);
#pragma unroll
  for (int g = 0; g < 16; ++g) mx = fmaxf(mx, S[1][g]);
  {
    auto sw = __builtin_amdgcn_permlane32_swap(__float_as_uint(mx), __float_as_uint(mx), false, false);
    mx = fmaxf(__uint_as_float(sw[0]), __uint_as_float(sw[1]));
  }
  float dshift = 0.f;
  if (FIRST || __any(mx > 8.f)) {
    const float d = FIRST ? mx : fmaxf(mx, 0.f);
    dshift = d;
    const float alpha = __builtin_amdgcn_exp2f(-d);
#pragma unroll
    for (int g = 0; g < 16; ++g) {
      st.negm[g] -= d;
      S[0][g] -= d; S[1][g] -= d;
      O[0][g] *= alpha; O[1][g] *= alpha;
    }
    st.L[0] *= alpha;
  }
#pragma unroll
  for (int kb = 0; kb < 2; ++kb)
#pragma unroll
    for (int g = 0; g < 16; ++g) S[kb][g] = __builtin_amdgcn_exp2f(S[kb][g]);
  const char* vp = sV + r * 128;
  const int vsw = (r >> 1) & 7;
#pragma unroll
  for (int sp = 0; sp < 4; ++sp) {
    const int sb_ = sp >> 1, so_ = 8 * (sp & 1);
    u32x4 bpu = {pack2(S[sb_][so_], S[sb_][so_ + 1]), pack2(S[sb_][so_ + 2], S[sb_][so_ + 3]), pack2(S[sb_][so_ + 4], S[sb_][so_ + 5]),
                 pack2(S[sb_][so_ + 6], S[sb_][so_ + 7])};
    bf16x8 bp = __builtin_bit_cast(bf16x8, bpu);
#pragma unroll
    for (int db = 0; db < 2; ++db) {
      bf16x8 av = *(const bf16x8*)(vp + db * 4096 + (((2 * sp + hh) ^ vsw) << 4));
      O[db] = mfma32(av, bp, O[db]);
    }
    st.L = mfma32(ones, bp, st.L);
  }
  return dshift;
}
template <class MaskF>
__device__ __forceinline__ void attn_tile(const char* sK, const char* sV, const bf16x8 (&bq)[4], f32x16 (&O)[2], AttnState& st, bf16x8 ones,
                                          int r, int hh, MaskF maskf, const bool FIRST) {
  f32x16 S[2];
  attn_qk(sK, bq, st.negm, S, r, hh);
  (void)attn_softmax_pv(S, sV, O, st, ones, r, hh, maskf, FIRST);
}
__device__ __forceinline__ void attn_state_init(AttnState& st, bf16x8& ones, int r) {
  st.negm = zero16();
  st.L = zero16();
  const short one = (r == 0) ? (short)0x3F80 : (short)0;
  ones = (bf16x8){one, one, one, one, one, one, one, one};
}

__device__ __forceinline__ void attn_stage(const bf16_t* kg, size_t kstride, const bf16_t* vg, size_t vstride, char* sKd, char* sVd, int tid) {
  const int row = tid >> 3, u = ((tid & 7) ^ ((tid >> 4) & 7)) * 8;
#pragma unroll
  for (int i = 0; i < 2; ++i) {
    __builtin_amdgcn_global_load_lds((const unsigned*)(kg + (size_t)(row + 32 * i) * kstride + u), (LAS3 unsigned*)(sKd + tid * 16 + i * 4096), 16, 0, 0);
    __builtin_amdgcn_global_load_lds((const unsigned*)(vg + (size_t)(row + 32 * i) * vstride + u), (LAS3 unsigned*)(sVd + tid * 16 + i * 4096), 16, 0, 0);
  }
}
struct NoMask { __device__ __forceinline__ void operator()(f32x16 (&)[2]) const {} };

__device__ __forceinline__ void attn_write_out(bf16_t* dst  , const f32x16 (&O)[2], float l, int hh) {
  float lt = l + __shfl_xor(l, 32);
  float inv = 1.f / lt;
#pragma unroll
  for (int db = 0; db < 2; ++db)
#pragma unroll
    for (int g4 = 0; g4 < 4; ++g4) {
      uint2 o = make_uint2(pack2(O[db][4 * g4] * inv, O[db][4 * g4 + 1] * inv), pack2(O[db][4 * g4 + 2] * inv, O[db][4 * g4 + 3] * inv));
      *(uint2*)(dst + 32 * db + 8 * g4 + 4 * hh) = o;
    }
}

__device__ __forceinline__ void phase_attnA(PRef p, int layer, char* smem_all) {
  int tid = __builtin_amdgcn_workitem_id_x();
  asm volatile("" : "+v"(tid));
  const int lane = tid & 63, w8 = tid >> 6, w = w8 & 3, qsub = w8 >> 2, r = lane & 31, hh = lane >> 5;
  char* sK = smem_all;
  char* sV = smem_all + 32768;
  const int nitems = layer == 0 ? 544 : 512;
  const int G = (int)gridDim.x;
  for (int item = (int)__builtin_amdgcn_workgroup_id_x(); item < nitems; item += G) {
    int b, kvh, qtok0, nkt;
    if (item < 512) { b = item >> 7; kvh = (item >> 6) & 1; qtok0 = b * 4096 + (item & 63) * 64 + qsub * 32; nkt = 68; }
    else { int it = item - 512; b = it >> 3; kvh = (it >> 2) & 1; qtok0 = TLAT + b * 256 + (it & 3) * 64 + qsub * 32; nkt = 4; }
    const int head = kvh * 4 + w;
    bf16x8 bq[4];
    {
      const bf16_t* qp = p.qA + (size_t)(qtok0 + r) * 512 + head * 64 + 8 * hh;
#pragma unroll
      for (int s = 0; s < 4; ++s) bq[s] = *(const bf16x8*)(qp + 16 * s);
    }
    const bf16_t* kbase = p.kA + (size_t)(b * 2 + kvh) * PALL * 64;
    const bf16_t* vbase = p.vAT + (size_t)(b * 2 + kvh) * 64 * PALL;
    const int srow = tid >> 3, su = ((tid & 7) ^ ((tid >> 4) & 7)) * 8;
    const bf16_t* kg = kbase + (size_t)srow * 64 + su;
    const bf16_t* vg = vbase + (size_t)srow * PALL + su;
    f32x16 O[2];
    O[0] = zero16();
    O[1] = zero16();
    AttnState st;
    bf16x8 ones;
    attn_state_init(st, ones, r);
    __syncthreads();
#define ATT_STAGE(KT)                                                                                                                     \
  {                                                                                                                                       \
    __builtin_amdgcn_global_load_lds((const unsigned*)(kg + (size_t)(KT) * 4096), (LAS3 unsigned*)(sK + ((KT) & 3) * 8192 + tid * 16), 16, 0, 0); \
    __builtin_amdgcn_global_load_lds((const unsigned*)(vg + (KT) * 64), (LAS3 unsigned*)(sV + ((KT) & 3) * 8192 + tid * 16), 16, 0, 0);           \
  }
    ATT_STAGE(0);
    ATT_STAGE(1);
    dma_sync();
    f32x16 Sa[2], Sb[2];
    attn_qk(sK, bq, st.negm, Sa, r, hh);
#define ATT_STEP(KT, CUR, NXT)                                                                                              \
  {                                                                                                                         \
    if ((KT) > 0) dma_sync();                \
    if ((KT) + 2 < nkt) ATT_STAGE((KT) + 2);                                                                                \
    if ((KT) + 1 < nkt) attn_qk(sK + (((KT) + 1) & 3) * 8192, bq, st.negm, NXT, r, hh);                                     \
    const float d_ = attn_softmax_pv(CUR, sV + ((KT) & 3) * 8192, O, st, ones, r, hh, NoMask(), (KT) == 0);                 \
    if ((KT) + 1 < nkt && __any(d_ != 0.f)) {      \
      _Pragma("unroll") for (int g = 0; g < 16; ++g) { NXT[0][g] -= d_; NXT[1][g] -= d_; }                                  \
    }                                                                                                                       \
  }
    for (int kt = 0; kt < nkt; kt += 2) {
      ATT_STEP(kt, Sa, Sb);
      ATT_STEP(kt + 1, Sb, Sa);
    }
#undef ATT_STEP
#undef ATT_STAGE
    attn_write_out(p.oA + (size_t)(qtok0 + r) * 512 + head * 64, O, st.L[0], hh);
  }
}

struct NaMask {
  const float* bp;
  int cofs;
  bool on;
  __device__ __forceinline__ void operator()(f32x16 (&S)[2]) const {
    if (!on) return;
    f32x16 bv[2];
#pragma unroll
    for (int kb = 0; kb < 2; ++kb)
#pragma unroll
      for (int g = 0; g < 16; ++g) bv[kb][g] = bp[32 * kb + 16 * (g >> 3) + 4 * ((g >> 2) & 1) + (g & 3)];
    asm volatile("" : "+v"(bv[0]), "+v"(bv[1]));
#pragma unroll
    for (int kb = 0; kb < 2; ++kb)
#pragma unroll
      for (int g = 0; g < 16; ++g) {
        const int cc = 32 * kb + 16 * (g >> 3) + 4 * ((g >> 2) & 1) + (g & 3);
        const bool valid = (unsigned)(cc + cofs) < 16u;
        S[kb][g] = valid ? S[kb][g] + bv[kb][g] : -1e30f;
      }
  }
};
__device__ __forceinline__ void phase_na(PRef p, int layer, char* smem) {
  const int tid = tid_(), lane = tid & 63, w = tid >> 6, r = lane & 31, hh = lane >> 5;
  char* sK = smem;
  char* sV = smem + 32768;
  float* sBias = (float*)(smem + 65536);
  const int nitems = layer == 0 ? 1088 : 1024;
  const int set = w >> 1, qhalf = w & 1;
  for (int item = bid_(); item < nitems; item += vgrid_()) {
    int b, hp, row = 0, rs = 0, qtok0, kt0, kt1;
    if (item < 1024) {
      b = item >> 8; row = (item >> 2) & 63; hp = item & 3;
      rs = row - 4; rs = rs < 0 ? 0 : (rs > 56 ? 56 : rs);
      qtok0 = b * 4096 + row * 64; kt0 = 0; kt1 = 12;
    } else {
      int it = item - 1024;
      b = it >> 4; hp = (it >> 2) & 3;
      qtok0 = TLAT + b * 256 + (it & 3) * 64; kt0 = 8; kt1 = 12;
    }
    const int head = 2 * hp + set;
    __syncthreads();
#define NA_STAGE(KT, BUF)                                                                                          \
  {                                                                                                                \
    int tokK, pallb;                                                                                               \
    if ((KT) < 8) { tokK = b * 4096 + (rs + (KT)) * 64; pallb = 256 + (rs + (KT)) * 64; }                          \
    else { tokK = TLAT + b * 256 + ((KT) - 8) * 64; pallb = ((KT) - 8) * 64; }                                     \
    _Pragma("unroll") for (int s2 = 0; s2 < 2; ++s2)                                                               \
      attn_stage(p.kC + (size_t)tokK * 512 + (2 * hp + s2) * 64, 512, p.vCT + (size_t)(b * 8 + 2 * hp + s2) * 64 * PALL + pallb, PALL, \
                 sK + (BUF) * 16384 + s2 * 8192, sV + (BUF) * 16384 + s2 * 8192, tid);                             \
  }
    NA_STAGE(kt0, 0);
    for (int i = tid; i < 930; i += 256) {
      int s = i / 465, j = i % 465;
      sBias[i] = p.rpb[((size_t)layer * 8 + 2 * hp + s) * 465 + j] * LOG2E;
    }
    bf16x8 bq[4];
    {
      const bf16_t* qp = p.qC + (size_t)(qtok0 + 32 * qhalf + r) * 512 + head * 64 + 8 * hh;
#pragma unroll
      for (int s = 0; s < 4; ++s) bq[s] = *(const bf16x8*)(qp + 16 * s);
    }
    f32x16 O[2];
    O[0] = zero16();
    O[1] = zero16();
    AttnState st;
    bf16x8 ones;
    attn_state_init(st, ones, r);
    for (int kt = kt0; kt < kt1; ++kt) {
      const int cur = (kt - kt0) & 1;
      dma_sync();
      if (kt + 1 < kt1) NA_STAGE(kt + 1, cur ^ 1);
      {
        NaMask mk;
        const int wq = 32 * qhalf + r;
        int cs = wq - 8;
        cs = cs < 0 ? 0 : (cs > 48 ? 48 : cs);
        mk.on = kt < 8;
        mk.bp = sBias + set * 465 + (mk.on ? (rs + kt - row + 7) * 31 : 0) - wq + 15 + 8 * hh;
        mk.cofs = 8 * hh - cs;
        attn_tile(sK + cur * 16384 + set * 8192, sV + cur * 16384 + set * 8192, bq, O, st, ones, r, hh, mk, kt == kt0);
      }
    }
#undef NA_STAGE
    attn_write_out(p.oC + (size_t)(qtok0 + 32 * qhalf + r) * 512 + head * 64, O, st.L[0], hh);
  }
}

__device__ __forceinline__ float log_sigmoidf_(float x) { return fminf(x, 0.f) - __logf(1.f + __expf(-fabsf(x))); }
struct GlaPre { f32x4v a0, a1, a2, a3, wg0, wg1; float bg; };
__device__ __forceinline__ void gla_prep_load(PRef p, int layer, int hd, int dir, int tok0, GlaPre& R) {
  const int tid = tid_(), lane = tid & 63, w = tid >> 6, r = lane & 31, hh = lane >> 5, pb = w >> 1, db = w & 1;
  const float* ap = p.aB + (size_t)(tok0 + 32 * pb + r) * 32 + dir * 16;
  R.a0 = *(const f32x4v*)(ap); R.a1 = *(const f32x4v*)(ap + 4); R.a2 = *(const f32x4v*)(ap + 8); R.a3 = *(const f32x4v*)(ap + 12);
  const float* wp = p.gla_wg + (((size_t)layer * 2 + dir) * 16 + hh) * 256 + hd * 64 + 32 * db + r;
  R.wg0 = (f32x4v){wp[0], wp[2 * 256], wp[4 * 256], wp[6 * 256]};
  R.wg1 = (f32x4v){wp[8 * 256], wp[10 * 256], wp[12 * 256], wp[14 * 256]};
  R.bg = p.gla_bg[((size_t)layer * 2 + dir) * 256 + hd * 64 + 32 * db + r];
}
#define GLA_DPP_ADD(v, ctrl, rmask) v += __builtin_bit_cast(float, __builtin_amdgcn_update_dpp(0, __builtin_bit_cast(int, v), ctrl, rmask, 0xf, false))
__device__ __forceinline__ void gla_prep_compute(const GlaPre& R, int dir, float* sBc) {
  const int tid = tid_(), lane = tid & 63, w = tid >> 6, r = lane & 31, hh = lane >> 5, pb = w >> 1, db = w & 1;
  {
    f32x16 x;
#pragma unroll
    for (int g = 0; g < 16; ++g) x[g] = R.bg;
    const float ae[8] = {R.a0[0], R.a0[2], R.a1[0], R.a1[2], R.a2[0], R.a2[2], R.a3[0], R.a3[2]};
    const float ao[8] = {R.a0[1], R.a0[3], R.a1[1], R.a1[3], R.a2[1], R.a2[3], R.a3[1], R.a3[3]};
    const float wv[8] = {R.wg0[0], R.wg0[1], R.wg0[2], R.wg0[3], R.wg1[0], R.wg1[1], R.wg1[2], R.wg1[3]};
#pragma unroll
    for (int s = 0; s < 8; ++s) x = __builtin_amdgcn_mfma_f32_32x32x2f32(hh ? ao[s] : ae[s], wv[s], x, 0, 0, 0);
#pragma unroll
    for (int g = 0; g < 16; ++g) {
      const int pos = 32 * pb + (g & 3) + 8 * (g >> 2) + 4 * hh;
      sBc[pos * 65 + 32 * db + r] = log_sigmoidf_(x[g]) * (1.f / 16.f);
    }
  }
  __syncthreads();
  {
    const int idx = dir ? 63 - lane : lane;
    float v[16];
#pragma unroll
    for (int dd = 0; dd < 16; ++dd) v[dd] = sBc[idx * 65 + w * 16 + dd];
#pragma unroll
    for (int dd = 0; dd < 16; ++dd) GLA_DPP_ADD(v[dd], 0x111, 0xf);
#pragma unroll
    for (int dd = 0; dd < 16; ++dd) GLA_DPP_ADD(v[dd], 0x112, 0xf);
#pragma unroll
    for (int dd = 0; dd < 16; ++dd) GLA_DPP_ADD(v[dd], 0x114, 0xf);
#pragma unroll
    for (int dd = 0; dd < 16; ++dd) GLA_DPP_ADD(v[dd], 0x118, 0xf);
#pragma unroll
    for (int dd = 0; dd < 16; ++dd) GLA_DPP_ADD(v[dd], 0x142, 0xa);
#pragma unroll
    for (int dd = 0; dd < 16; ++dd) GLA_DPP_ADD(v[dd], 0x143, 0xc);
#pragma unroll
    for (int dd = 0; dd < 16; ++dd) sBc[idx * 65 + w * 16 + dd] = v[dd];
  }
  __syncthreads();
}
__device__ __forceinline__ void chunk_pos(int b, int dir, int c, int& tok0, int& pall0) {
  if (c < 4) { int pc = dir ? 3 - c : c; tok0 = TLAT + b * 256 + pc * 64; pall0 = pc * 64; }
  else { int j = c - 4; int pc = dir ? 63 - j : j; tok0 = b * 4096 + pc * 64; pall0 = 256 + pc * 64; }
}
__device__ __forceinline__ void phase_gla1(PRef p, int layer, char* smem) {
  float* sWg = (float*)smem;
  float* sBc = (float*)(smem + 4096);
  bf16_t* sKt = (bf16_t*)(smem + 20736);
  bf16_t* sVt = (bf16_t*)(smem + 29952);
  const int tid = tid_(), lane = tid & 63, w = tid >> 6, r = lane & 31, hh = lane >> 5;
  struct GlaIn { GlaPre R; u32x4 k0, k1, vv0, vv1, vv2, vv3; };
  auto load_item = [&](int item, GlaIn& I) {
    const int ch = item / NCHUNK, c = item % NCHUNK;
    const int dir = ch & 1, hd = (ch >> 1) & 3, b = ch >> 3;
    int tok0, pall0;
    chunk_pos(b, dir, c, tok0, pall0);
    gla_prep_load(p, layer, hd, dir, tok0, I.R);
    const int pos = tid >> 2, dg = tid & 3;
    const bf16_t* kp = p.kB + (size_t)(tok0 + pos) * 256 + hd * 64 + dg * 16;
    I.k0 = *(const u32x4*)kp; I.k1 = *(const u32x4*)(kp + 8);
    const bf16_t* vb = p.vBT + (size_t)(b * 4 + hd) * 128 * PALL + pall0 + (tid & 7) * 8;
    I.vv0 = *(const u32x4*)(vb + (size_t)(tid >> 3) * PALL);
    I.vv1 = *(const u32x4*)(vb + (size_t)((tid >> 3) + 32) * PALL);
    I.vv2 = *(const u32x4*)(vb + (size_t)((tid >> 3) + 64) * PALL);
    I.vv3 = *(const u32x4*)(vb + (size_t)((tid >> 3) + 96) * PALL);
  };
  GlaIn cur;
  if (bid_() < 32 * NCHUNK) load_item(bid_(), cur);
  for (int item = bid_(); item < 32 * NCHUNK; item += vgrid_()) {
    const int ch = item / NCHUNK;
    const int dir = ch & 1;
    GlaIn nxt = cur;
    if (item + vgrid_() < 32 * NCHUNK) load_item(item + vgrid_(), nxt);
    const GlaPre R = cur.R;
    const u32x4 k0 = cur.k0, k1 = cur.k1, vv0 = cur.vv0, vv1 = cur.vv1, vv2 = cur.vv2, vv3 = cur.vv3;
    cur = nxt;
    __syncthreads();
    gla_prep_compute(R, dir, sBc);
    {
      const int pos = tid >> 2, dg = tid & 3;
      float* bd = p.bcum + (size_t)item * 4096 + pos * 64 + dg * 16;
#pragma unroll
      for (int q4 = 0; q4 < 4; ++q4)
        *(float4*)(bd + 4 * q4) = make_float4(sBc[pos * 65 + dg * 16 + 4 * q4], sBc[pos * 65 + dg * 16 + 4 * q4 + 1], sBc[pos * 65 + dg * 16 + 4 * q4 + 2], sBc[pos * 65 + dg * 16 + 4 * q4 + 3]);
    }
    {
      int pos = tid >> 2, dg = tid & 3;
      unsigned ku[8] = {k0[0], k0[1], k0[2], k0[3], k1[0], k1[1], k1[2], k1[3]};
#pragma unroll
      for (int e = 0; e < 16; ++e) {
        int d = dg * 16 + e;
        float kv = bf2f((bf16_t)((e & 1) ? (ku[e >> 1] >> 16) : (ku[e >> 1] & 0xffff)));
        float bend = sBc[(dir ? 0 : 63) * 65 + d];
        sKt[d * 72 + pos] = f2bf(kv * __expf(bend - sBc[pos * 65 + d]));
      }
      {
        const int dv = tid >> 3, cc = tid & 7;
        *(u32x4*)(sVt + dv * 72 + cc * 8) = vv0;
        *(u32x4*)(sVt + (dv + 32) * 72 + cc * 8) = vv1;
        *(u32x4*)(sVt + (dv + 64) * 72 + cc * 8) = vv2;
        *(u32x4*)(sVt + (dv + 96) * 72 + cc * 8) = vv3;
      }
      if (tid < 64) p.decay[(size_t)item * 64 + tid] = __expf(sBc[(dir ? 0 : 63) * 65 + tid]);
    }
    __syncthreads();
    f32x16 acc[2];
    acc[0] = zero16();
    acc[1] = zero16();
#pragma unroll
    for (int s = 0; s < 4; ++s) {
      bf16x8 a = *(const bf16x8*)(sVt + (32 * w + r) * 72 + 16 * s + 8 * hh);
      bf16x8 b0 = *(const bf16x8*)(sKt + r * 72 + 16 * s + 8 * hh);
      bf16x8 b1 = *(const bf16x8*)(sKt + (32 + r) * 72 + 16 * s + 8 * hh);
      acc[0] = mfma32(b0, a, acc[0]);
      acc[1] = mfma32(b1, a, acc[1]);
    }
    float* dst = p.KVt + (size_t)item * 8192 + (32 * w + r) * 64 + 4 * hh;
#pragma unroll
    for (int jb = 0; jb < 2; ++jb)
#pragma unroll
      for (int g4 = 0; g4 < 4; ++g4)
        *(float4*)(dst + 32 * jb + 8 * g4) = make_float4(acc[jb][4 * g4], acc[jb][4 * g4 + 1], acc[jb][4 * g4 + 2], acc[jb][4 * g4 + 3]);
  }
}
__device__ __forceinline__ void phase_gla2(PRef p) {
  for (int idx = bid_() * 256 + tid_(); idx < 32 * 8192; idx += vgrid_() * 256) {
    const int ch = idx >> 13, e = idx & 8191;
    float S = 0.f;
    const float* kv = p.KVt + (size_t)ch * NCHUNK * 8192 + e;
    const float* dc = p.decay + (size_t)ch * NCHUNK * 64 + (e & 63);
    bf16_t* sp = p.SP + (size_t)ch * NCHUNK * 8192 + e;
#pragma unroll 1
    for (int c0 = 0; c0 < NCHUNK; c0 += 17) {
      float kvv[17], dcv[17];
#pragma unroll
      for (int j = 0; j < 17; ++j) { kvv[j] = kv[(size_t)(c0 + j) * 8192]; dcv[j] = dc[(c0 + j) * 64]; }
#pragma unroll
      for (int j = 0; j < 17; ++j) { sp[(size_t)(c0 + j) * 8192] = f2bf(S); S = dcv[j] * S + kvv[j]; }
    }
  }
}
__device__ __forceinline__ void phase_gla3(PRef p, int layer, char* smem) {
  float* sWg = (float*)smem;
  float* sBc = (float*)(smem + 4096);
  bf16_t* sQ = (bf16_t*)(smem + 20736);
  bf16_t* sK = (bf16_t*)(smem + 29952);
  bf16_t* sVt = (bf16_t*)(smem + 39168);
  float* sRed = (float*)(smem + 57600);
  const int tid = tid_(), lane = tid & 63, w = tid >> 6, r = lane & 31, hh = lane >> 5;
  const int npc = layer == 0 ? 68 : 64;
  const int pr = 16 * (r >> 4) + 8 * ((r >> 2) & 1) + 4 * ((r >> 3) & 1) + (r & 3);
  for (int item = bid_(); item < 16 * npc; item += vgrid_()) {
    const int bh = item / npc;
    const int pca = (layer == 0) ? (item % npc) : (4 + item % npc);
    const int b = bh >> 2, hd = bh & 3;
    int tok0, pall0;
    chunk_pos(b, 0, pca, tok0, pall0);
    f32x16 O[2];
    O[0] = zero16();
    O[1] = zero16();
    const int c0 = pca, c1 = (pca < 4) ? 3 - pca : 4 + (63 - (pca - 4));
    f32x4v bA[4], bB[4];
    u32x4 q0, q1, k0, k1, vv0, vv1, vv2, vv3;
    {
      const int pos = tid >> 2, dg = tid & 3;
      const float* b0p = p.bcum + ((size_t)((b * 4 + hd) * 2 + 0) * NCHUNK + c0) * 4096 + pos * 64 + dg * 16;
      const float* b1p = p.bcum + ((size_t)((b * 4 + hd) * 2 + 1) * NCHUNK + c1) * 4096 + pos * 64 + dg * 16;
#pragma unroll
      for (int q4 = 0; q4 < 4; ++q4) { bA[q4] = *(const f32x4v*)(b0p + 4 * q4); bB[q4] = *(const f32x4v*)(b1p + 4 * q4); }
      const bf16_t* qp = p.qB + (size_t)(tok0 + pos) * 256 + hd * 64 + dg * 16;
      const bf16_t* kp = p.kB + (size_t)(tok0 + pos) * 256 + hd * 64 + dg * 16;
      q0 = *(const u32x4*)qp; q1 = *(const u32x4*)(qp + 8);
      k0 = *(const u32x4*)kp; k1 = *(const u32x4*)(kp + 8);
      const bf16_t* vb = p.vBT + (size_t)(b * 4 + hd) * 128 * PALL + pall0 + (tid & 7) * 8;
      vv0 = *(const u32x4*)(vb + (size_t)(tid >> 3) * PALL);
      vv1 = *(const u32x4*)(vb + (size_t)((tid >> 3) + 32) * PALL);
      vv2 = *(const u32x4*)(vb + (size_t)((tid >> 3) + 64) * PALL);
      vv3 = *(const u32x4*)(vb + (size_t)((tid >> 3) + 96) * PALL);
    }
    typedef unsigned u32x2v __attribute__((ext_vector_type(2)));
    u32x2v rrv[2][4];
#pragma unroll
    for (int tb = 0; tb < 2; ++tb)
#pragma unroll
      for (int g4 = 0; g4 < 4; ++g4)
        rrv[tb][g4] = *(const u32x2v*)(p.rB + (size_t)(tok0 + 32 * tb + r) * 512 + hd * 128 + 32 * w + 8 * g4 + 4 * hh);
    __syncthreads();
    {
      const int dv = tid >> 3, cc = tid & 7;
      *(u32x4*)(sVt + dv * 72 + cc * 8) = vv0;
      *(u32x4*)(sVt + (dv + 32) * 72 + cc * 8) = vv1;
      *(u32x4*)(sVt + (dv + 64) * 72 + cc * 8) = vv2;
      *(u32x4*)(sVt + (dv + 96) * 72 + cc * 8) = vv3;
    }
#pragma unroll
    for (int dir = 0; dir < 2; ++dir) {
      if (dir == 1) __syncthreads();
      {
        int pos = tid >> 2, dg = tid & 3;
        unsigned qu[8] = {q0[0], q0[1], q0[2], q0[3], q1[0], q1[1], q1[2], q1[3]};
        unsigned ku[8] = {k0[0], k0[1], k0[2], k0[3], k1[0], k1[1], k1[2], k1[3]};
        unsigned qo[8], ko[8];
#pragma unroll
        for (int e2 = 0; e2 < 8; ++e2) {
          const float b0 = dir ? bB[e2 >> 1][(2 * e2) & 3] : bA[e2 >> 1][(2 * e2) & 3];
          const float b1 = dir ? bB[e2 >> 1][(2 * e2 + 1) & 3] : bA[e2 >> 1][(2 * e2 + 1) & 3];
          const float ea0 = __expf(b0), ea1 = __expf(b1), ia0 = __builtin_amdgcn_rcpf(ea0), ia1 = __builtin_amdgcn_rcpf(ea1);
          qo[e2] = pack2(bf2f((bf16_t)(qu[e2] & 0xffff)) * ea0, bf2f((bf16_t)(qu[e2] >> 16)) * ea1);
          ko[e2] = pack2(bf2f((bf16_t)(ku[e2] & 0xffff)) * ia0, bf2f((bf16_t)(ku[e2] >> 16)) * ia1);
        }
        *(uint4*)(sQ + pos * 72 + dg * 16) = make_uint4(qo[0], qo[1], qo[2], qo[3]);
        *(uint4*)(sQ + pos * 72 + dg * 16 + 8) = make_uint4(qo[4], qo[5], qo[6], qo[7]);
        *(uint4*)(sK + pos * 72 + dg * 16) = make_uint4(ko[0], ko[1], ko[2], ko[3]);
        *(uint4*)(sK + pos * 72 + dg * 16 + 8) = make_uint4(ko[4], ko[5], ko[6], ko[7]);
      }
      __syncthreads();
      const int c = dir ? c1 : c0;
      const int ch = (b * 4 + hd) * 2 + dir;
      const bf16_t* sp = p.SP + ((size_t)ch * NCHUNK + c) * 8192 + (size_t)(32 * w + r) * 64 + 8 * hh;
      bf16x8 bqf[2][4];
#pragma unroll
      for (int tb = 0; tb < 2; ++tb)
#pragma unroll
        for (int ks = 0; ks < 4; ++ks) bqf[tb][ks] = *(const bf16x8*)(sQ + (32 * tb + r) * 72 + 16 * ks + 8 * hh);
#pragma unroll
      for (int ks = 0; ks < 4; ++ks) {
        bf16x8 a = *(const bf16x8*)(sp + 16 * ks);
        O[0] = mfma32(a, bqf[0][ks], O[0]);
        O[1] = mfma32(a, bqf[1][ks], O[1]);
      }
#pragma unroll
      for (int sb = 0; sb < 2; ++sb)
#pragma unroll
        for (int tb = 0; tb < 2; ++tb) {
          const bool skip = dir == 0 ? (sb == 1 && tb == 0) : (sb == 0 && tb == 1);
          if (skip) continue;
          f32x16 Sc = zero16();
#pragma unroll
          for (int ks = 0; ks < 4; ++ks) {
            bf16x8 a = *(const bf16x8*)(sK + (32 * sb + pr) * 72 + 16 * ks + 8 * hh);
            Sc = mfma32(a, bqf[tb][ks], Sc);
          }
          const int t = 32 * tb + r;
#pragma unroll
          for (int g = 0; g < 16; ++g) {
            int s = 32 * sb + 16 * (g >> 3) + 4 * ((g >> 2) & 1) + (g & 3) + 8 * hh;
            bool keep = dir == 0 ? (t >= s) : (s >= t);
            Sc[g] = keep ? Sc[g] : 0.f;
          }
#pragma unroll
          for (int s2 = 0; s2 < 2; ++s2) {
            const int sp4 = 2 * sb + s2;
            u32x4 bpu = {pack2(Sc[8 * s2], Sc[8 * s2 + 1]), pack2(Sc[8 * s2 + 2], Sc[8 * s2 + 3]), pack2(Sc[8 * s2 + 4], Sc[8 * s2 + 5]),
                         pack2(Sc[8 * s2 + 6], Sc[8 * s2 + 7])};
            bf16x8 bp = __builtin_bit_cast(bf16x8, bpu);
            bf16x8 av = *(const bf16x8*)(sVt + (32 * w + r) * 72 + 16 * sp4 + 8 * hh);
            O[tb] = mfma32(av, bp, O[tb]);
          }
        }
    }
    float ss[2];
#pragma unroll
    for (int tb = 0; tb < 2; ++tb) {
      float s = 0.f;
#pragma unroll
      for (int g = 0; g < 16; ++g) s += O[tb][g] * O[tb][g];
      s += __shfl_xor(s, 32);
      ss[tb] = s;
    }
    if (hh == 0) { sRed[w * 64 + r] = ss[0]; sRed[w * 64 + 32 + r] = ss[1]; }
    __syncthreads();
    f32x4v gnv[4];
#pragma unroll
    for (int g4 = 0; g4 < 4; ++g4) gnv[g4] = *(const f32x4v*)(p.gla_norm + layer * 128 + 32 * w + 8 * g4 + 4 * hh);
#pragma unroll
    for (int tb = 0; tb < 2; ++tb) {
      int t = 32 * tb + r;
      float tot = sRed[t] + sRed[64 + t] + sRed[128 + t] + sRed[192 + t];
      float rstd = rsqrtf(tot * (1.f / 128.f) + 1e-6f);
      const int tok = tok0 + t;
#pragma unroll
      for (int g4 = 0; g4 < 4; ++g4) {
        int dv = 32 * w + 8 * g4 + 4 * hh;
        const u32x2v rr = rrv[tb][g4];
        float rg[4] = {bf2f((bf16_t)(rr[0] & 0xffff)), bf2f((bf16_t)(rr[0] >> 16)), bf2f((bf16_t)(rr[1] & 0xffff)), bf2f((bf16_t)(rr[1] >> 16))};
        float o[4];
#pragma unroll
        for (int e = 0; e < 4; ++e) o[e] = O[tb][4 * g4 + e] * rstd * gnv[g4][e] * siluf(rg[e]);
        *(uint2*)(p.oB + (size_t)tok * 512 + hd * 128 + dv) = make_uint2(pack2(o[0], o[1]), pack2(o[2], o[3]));
      }
    }
  }
}

#define PHASE_KERNEL(name, call)                                               \
  __global__ void __launch_bounds__(512, 2) name(Params p_, int layer) {       \
    __shared__ __attribute__((aligned(16))) char smem_all[2 * SMEM_BYTES];     \
    char* smem = smem_all + half_() * SMEM_BYTES;                              \
    PRef p = params_view();                                           \
    call;                                                                      \
  }
PHASE_KERNEL(k_setup, phase_setup(p, smem))
PHASE_KERNEL(k_modreduce, phase_modreduce(p))
PHASE_KERNEL(k_convert, phase_convert(p, layer, smem))
PHASE_KERNEL(k_rowpass0, phase_rowpass0(p))
PHASE_KERNEL(k_inproj, phase_inproj(p, layer, smem_all))
PHASE_KERNEL(k_attnA, phase_attnA(p, layer, smem_all))
PHASE_KERNEL(k_na, phase_na(p, layer, smem))
PHASE_KERNEL(k_gla1, phase_gla1(p, layer, smem))
PHASE_KERNEL(k_gla2, phase_gla2(p))
PHASE_KERNEL(k_gla3, phase_gla3(p, layer, smem))
PHASE_KERNEL(k_merge, phase_merge(p, layer, smem_all))
PHASE_KERNEL(k_outproj, phase_outproj(p, layer, smem_all))
PHASE_KERNEL(k_rowpass1, phase_rowpass1(p, layer, smem))
PHASE_KERNEL(k_moescan, phase_moescan(p, layer, smem))
PHASE_KERNEL(k_moe1, phase_moe1(p, layer, smem_all))
PHASE_KERNEL(k_moe2, phase_moe2(p, layer, smem_all))
PHASE_KERNEL(k_rowpass2, phase_rowpass2(p, layer))

#define XB_TMO      128
#define XB_XCNT(j)  (256  + 64 * (j))
#define XB_XSUB(j)  (1280 + 64 * (j))
#define XB_XGEN(j)  (2304 + 64 * (j))
#define XB_TOP      3328
#define XB_TOPGEN   3392
#define XCD_BAR_WORDS 3456
#define XB_SPIN_CAP (1u << 23)
#define LAS __attribute__((address_space(3)))
__device__ __forceinline__ unsigned xb_ld(unsigned* p) { return __hip_atomic_load(p, __ATOMIC_RELAXED, __HIP_MEMORY_SCOPE_AGENT); }
__device__ __forceinline__ unsigned xb_add(unsigned* p, unsigned v) { return __hip_atomic_fetch_add(p, v, __ATOMIC_RELAXED, __HIP_MEMORY_SCOPE_AGENT); }
__device__ __forceinline__ unsigned xb_xcc_id() { return (unsigned)__builtin_amdgcn_s_getreg((3 << 11) | 20) & 0xFu; }
#define XB_SPIN(cond, bar) do { unsigned _sp = 0; while (cond) { __builtin_amdgcn_s_sleep(1); \
    if ((++_sp & 255u) == 0u) { if (xb_ld(&(bar)[XB_TMO])) break; if (_sp > XB_SPIN_CAP) { atomicAdd(&(bar)[XB_TMO], 1u); break; } } } } while (0)
struct XcdBarrier { unsigned* bar; unsigned x; volatile LAS unsigned* st; };
__device__ __forceinline__ XcdBarrier xcd_barrier_post(unsigned* bar, volatile LAS unsigned* st) {
  XcdBarrier b; b.bar = bar; b.x = xb_xcc_id(); b.st = st;
  if (__builtin_amdgcn_workitem_id_x() == 0) (void)xb_add(&bar[XB_XCNT(b.x)], 1u);
  return b;
}
__device__ __forceinline__ void xcd_barrier_complete(unsigned* bar, unsigned x, unsigned& nloc, unsigned& nx) {
  const unsigned G = gridDim.x * gridDim.y * gridDim.z;
  unsigned sum, cnt, mine, sp = 0u;
  for (;;) {
    sum = 0u; cnt = 0u; mine = 0u;
#pragma unroll
    for (unsigned j = 0; j < 16; ++j) { const unsigned c = xb_ld(&bar[XB_XCNT(j)]); sum += c; cnt += (c > 0u) ? 1u : 0u; mine = (j == x) ? c : mine; }
    if (sum == G) break;
    __builtin_amdgcn_s_sleep(1);
    if ((++sp & 255u) == 0u) { if (xb_ld(&bar[XB_TMO])) break; if (sp > XB_SPIN_CAP) { atomicAdd(&bar[XB_TMO], 1u); break; } }
  }
  nloc = mine > 0u ? mine : 1u; nx = cnt > 0u ? cnt : 1u;
}
__device__ __forceinline__ void xcd_barrier(const XcdBarrier& b) {
  asm volatile("s_waitcnt vmcnt(0)" ::: "memory");
  __syncthreads();
  if (__builtin_amdgcn_workitem_id_x() == 0) {
    unsigned* bar = b.bar;
    __builtin_amdgcn_s_waitcnt(0);
    unsigned nloc = b.st[0], nx = b.st[1];
    if (nloc == 0u) { xcd_barrier_complete(bar, b.x, nloc, nx); b.st[0] = nloc; b.st[1] = nx; }
    const unsigned old = xb_add(&bar[XB_XSUB(b.x)], 1u);
    const unsigned gen = old / nloc;
    if (old + 1u == (gen + 1u) * nloc) {
      __builtin_amdgcn_fence(__ATOMIC_RELEASE, "agent");
      asm volatile("s_waitcnt vmcnt(0)" ::: "memory");
      const unsigned og = xb_add(&bar[XB_TOP], 1u);
      const unsigned tg = og / nx;
      if (og + 1u == (tg + 1u) * nx) xb_add(&bar[XB_TOPGEN], 1u);
      else XB_SPIN(xb_ld(&bar[XB_TOPGEN]) == tg, bar);
      __builtin_amdgcn_fence(__ATOMIC_ACQUIRE, "agent");
      xb_add(&bar[XB_XGEN(b.x)], 1u);
      asm volatile("s_waitcnt vmcnt(0)" ::: "memory");
    } else {
      XB_SPIN(xb_ld(&bar[XB_XGEN(b.x)]) == gen, bar);
      __builtin_amdgcn_fence(__ATOMIC_ACQUIRE, "agent");
      asm volatile("s_waitcnt vmcnt(0)" ::: "memory");
    }
  }
  __syncthreads();
}

__global__ void __launch_bounds__(512, 2) k_mega(Params p_) {
  __shared__ __attribute__((aligned(16))) char smem_all[2 * SMEM_BYTES + 16];
  volatile LAS unsigned* st = (volatile LAS unsigned*)(smem_all + 2 * SMEM_BYTES);
  if (__builtin_amdgcn_workitem_id_x() == 0) { st[0] = 0u; st[1] = 0u; }
  __syncthreads();
  const XcdBarrier xb = xcd_barrier_post(p_.bar, st);
#pragma unroll 1
  for (int ph = 0; ph < 25; ++ph) {
    int l = (ph >= 14) ? 1 : 0;
    int q = (ph < 3) ? ph : 3 + (ph - 3) % 11;
    l = __builtin_amdgcn_readfirstlane(l);
    q = __builtin_amdgcn_readfirstlane(q);
#ifdef PROBE_MASK
    const unsigned long long pt0 = __builtin_amdgcn_s_memrealtime();
#endif
    PRef p = params_view();
    char* smem = smem_all + half_() * SMEM_BYTES;
    switch (q) {
      case 0: phase_setup(p, smem); phase_convert(p, 0, smem); break;
      case 1: phase_modreduce(p); break;
      case 2: phase_rowpass0(p); break;
      case 3: phase_inproj(p, l, smem_all); break;
      case 4: phase_gla1(p, l, smem); phase_na(p, l, smem); break;
      case 5: phase_gla2(p); phase_attnA(p, l, smem_all); break;
      case 6: phase_gla3(p, l, smem); break;
      case 7: phase_merge(p, l, smem_all); break;
      case 8: phase_outproj(p, l, smem_all); break;
      case 9: phase_rowpass1(p, l, smem); break;
      case 10: phase_moescan(p, l, smem); phase_convert(p, l | 16, smem); break;
      case 11: phase_moe1(p, l, smem_all); break;
      case 12: phase_moe2(p, l, smem_all); break;
      default: phase_rowpass2(p, l); if (l == 0) phase_convert(p, 1, smem); break;
    }
    if (ph != 24) xcd_barrier(xb);
#ifdef PROBE_MASK
    if ((PROBE_MASK >> q) & 1) {
      const unsigned long long pt1 = __builtin_amdgcn_s_memrealtime();
      while (__builtin_amdgcn_s_memrealtime() - pt1 < (pt1 - pt0)) __builtin_amdgcn_s_sleep(8);
    }
#endif
  }
}

#ifdef DIAG_STAGE
__device__ __forceinline__ unsigned dhash(unsigned s) { s ^= s >> 16; s *= 0x7feb352dU; s ^= s >> 15; s *= 0x846ca68bU; s ^= s >> 16; return s; }
__device__ __forceinline__ void diag_accum(double num, double den, double* accum, double* sred) {
  const int tid = threadIdx.x;
  __syncthreads();
  sred[tid] = num; sred[256 + tid] = den;
  __syncthreads();
  for (int o = 128; o > 0; o >>= 1) { if (tid < o) { sred[tid] += sred[tid + o]; sred[256 + tid] += sred[256 + tid + o]; } __syncthreads(); }
  if (tid == 0) { atomicAdd(&accum[0], sred[0]); atomicAdd(&accum[1], sred[256]); }
}
__device__ __forceinline__ int diag_tok(int s, int ns) {
  if (s < 8) return TLAT + (dhash(s + 77) % TCTX);
  if (s == 8) return 0; if (s == 9) return TLAT - 1; if (s == 10) return 4095; if (s == 11) return 4096;
  return dhash(s * 31 + 5) % TLAT;
}
__global__ void k_diag_zero(double* accum) { if (threadIdx.x < 32) accum[threadIdx.x] = 0.0; }
__global__ void k_diag_report(const double* accum, float* out, int n) {
  int i = blockIdx.x * 256 + threadIdx.x;
  for (; i < n; i += gridDim.x * 256) out[i] = 0.f;
  if (blockIdx.x == 0 && threadIdx.x == 0) {
    double E = 0.0;
    for (int k = 0; k < 16; ++k) {
      if (accum[2 * k + 1] > 0.0) { double e = accum[2 * k] / accum[2 * k + 1]; if (!(e == e)) e = 100.0; if (e > E) E = e; }
    }
    out[0] = (float)(4.096e7 * sqrt(E));
  }
}
__global__ void __launch_bounds__(256) k_chk_h(Params p, double* accum) {
  __shared__ double sred[512];
  __shared__ float sx[1024];
  const int tid = threadIdx.x;
  int tok = diag_tok(blockIdx.x, gridDim.x);
  const float* src = tok < TLAT ? p.x + (size_t)tok * D : p.ctx + (size_t)(tok - TLAT) * D;
  const float* cv = tok < TLAT ? p.c + (tok >> 12) * 1024 : p.c_ctx;
  double s = 0, q = 0;
  for (int i = 0; i < 1024; ++i) s += src[i];
  double mean = s / 1024;
  for (int i = 0; i < 1024; ++i) { double d = src[i] - mean; q += d * d; }
  double rstd = 1.0 / sqrt(q / 1024 + 1e-6);
  double num = 0, den = 0;
  for (int n = tid; n < 1024; n += 256) {
    double sh = p.b_mod[n], sc = p.b_mod[1024 + n];
    for (int k = 0; k < 1024; ++k) {
      double cc = cv[k]; double sl = cc / (1.0 + exp(-cc));
      sh += sl * p.w_mod[(size_t)k * NMOD + n];
      sc += sl * p.w_mod[(size_t)k * NMOD + 1024 + n];
    }
    double ref = (src[n] - mean) * rstd * (1.0 + sc) + sh;
    double got = bf2f(p.h[(size_t)tok * D + n]);
    num += (got - ref) * (got - ref); den += ref * ref;
  }
  diag_accum(num, den, accum, sred);
}
__global__ void __launch_bounds__(256) k_chk_inproj(Params p, int layer, double* accum) {
  __shared__ double sred[512];
  __shared__ float sz[3872];
  __shared__ float sh[1024];
  const int tid = threadIdx.x;
  int tok = diag_tok(blockIdx.x, gridDim.x);
  for (int i = tid; i < 1024; i += 256) sh[i] = bf2f(p.h[(size_t)tok * D + i]);
  __syncthreads();
  const float* W = p.w_in + (size_t)layer * 1024 * NIN_SRC;
  for (int j = tid; j < 3872; j += 256) {
    double a = p.b_in[layer * NIN_SRC + j];
    for (int k = 0; k < 1024; ++k) a += (double)sh[k] * W[(size_t)k * NIN_SRC + j];
    sz[j] = (float)a;
  }
  __syncthreads();
  const bool lat = tok < TLAT;
  int b, t, pall;
  if (lat) { b = tok >> 12; t = tok & 4095; pall = 256 + t; } else { int ci = tok - TLAT; b = ci >> 8; t = ci & 255; pall = t; }
  double num = 0, den = 0;
  for (int j = tid; j < 3872; j += 256) {
    double ref, got;
    if (j < 640) {
      int hb = (j >> 6) << 6, d = j & 63;
      double ss = 0;
      for (int e = 0; e < 64; ++e) ss += (double)sz[hb + e] * sz[hb + e];
      double rstd = 1.0 / sqrt(ss / 64 + 1e-6);
      const float* gn = (j < 512 ? p.q_norm : p.k_norm) + layer * 64;
      double xn = sz[j] * rstd * gn[d];
      if (lat) {
        int qd = d >> 4, f = d & 15;
        int dp = d ^ 16;
        double pn = sz[hb + dp] * rstd * gn[dp];
        double pos = (qd < 2) ? (double)(t >> 6) : (double)(t & 63);
        float inv = powf(10000.f, -(float)f / 16.f);
        float ang = (float)pos * inv;
        double cs = cos((double)ang), sn = sin((double)ang);
        double rot = (qd & 1) ? pn : -pn;
        xn = xn * cs + rot * sn;
      }
      if (j < 512) { ref = xn * QSCALE; got = bf2f(p.qA[(size_t)tok * 512 + j]); }
      else { int kvh = (j - 512) >> 6; ref = xn; got = bf2f(p.kA[((size_t)(b * 2 + kvh) * PALL + pall) * 64 + d]); }
    } else if (j < 768) { int c = j - 640; ref = sz[j]; got = bf2f(p.vAT[((size_t)(b * 2 + (c >> 6)) * 64 + (c & 63)) * PALL + pall]); }
    else if (j < 1024) { ref = sz[j] * 0.125; got = bf2f(p.qB[(size_t)tok * 256 + (j - 768)]); }
    else if (j < 1280) { ref = sz[j]; got = bf2f(p.kB[(size_t)tok * 256 + (j - 1024)]); }
    else if (j < 1792) { int c = j - 1280; ref = sz[j]; got = bf2f(p.vBT[((size_t)(b * 4 + (c >> 7)) * 128 + (c & 127)) * PALL + pall]); }
    else if (j < 2304) { ref = sz[j]; got = bf2f(p.rB[(size_t)tok * 512 + (j - 1792)]); }
    else if (j < 2336) { ref = sz[j]; got = p.aB[(size_t)tok * 32 + (j - 2304)]; }
    else if (j < 2848) { ref = sz[j] * QSCALE; got = bf2f(p.qC[(size_t)tok * 512 + (j - 2336)]); }
    else if (j < 3360) { ref = sz[j]; got = bf2f(p.kC[(size_t)tok * 512 + (j - 2848)]); }
    else { int c = j - 3360; ref = sz[j]; got = bf2f(p.vCT[((size_t)(b * 8 + (c >> 6)) * 64 + (c & 63)) * PALL + pall]); }
    num += (got - ref) * (got - ref); den += ref * ref;
  }
  diag_accum(num, den, accum, sred);
}
__global__ void __launch_bounds__(256) k_chk_attnA(Params p, int layer, double* accum) {
  __shared__ double sred[512];
  __shared__ float sp[4352];
  __shared__ float sq[64];
  __shared__ float so[64];
  const int tid = threadIdx.x;
  int tok = diag_tok(blockIdx.x >> 1, gridDim.x);
  if (layer == 1 && tok >= TLAT) tok = dhash(blockIdx.x) % TLAT;
  int head = dhash(blockIdx.x * 7 + 1) & 7, kvh = head >> 2;
  const bool lat = tok < TLAT;
  int b = lat ? tok >> 12 : (tok - TLAT) >> 8;
  int nk = lat ? PALL : 256;
  if (tid < 64) sq[tid] = bf2f(p.qA[(size_t)tok * 512 + head * 64 + tid]);
  __syncthreads();
  const bf16_t* kb = p.kA + (size_t)(b * 2 + kvh) * PALL * 64;
#pragma unroll 1
  for (int j = tid; j < nk; j += 256) {
    float s = 0.f;
#pragma unroll 1
    for (int d = 0; d < 64; ++d) s += sq[d] * bf2f(kb[(size_t)j * 64 + d]);
    sp[j] = s;
  }
  __syncthreads();
  float mx = -1e30f;
#pragma unroll 1
  for (int j = 0; j < nk; ++j) mx = fmaxf(mx, sp[j]);
  __syncthreads();
  for (int j = tid; j < nk; j += 256) sp[j] = exp2f(sp[j] - mx);
  __syncthreads();
  double num = 0, den = 0;
  if (tid < 64) {
    double l = 0, o = 0;
    const bf16_t* vb = p.vAT + ((size_t)(b * 2 + kvh) * 64 + tid) * PALL;
#pragma unroll 1
    for (int j = 0; j < nk; ++j) { l += sp[j]; o += (double)sp[j] * bf2f(vb[j]); }
    double ref = o / l, got = bf2f(p.oA[(size_t)tok * 512 + head * 64 + tid]);
    num = (got - ref) * (got - ref); den = ref * ref;
  }
  diag_accum(num, den, accum, sred);
}
__global__ void __launch_bounds__(256) k_chk_na(Params p, int layer, double* accum) {
  __shared__ double sred[512];
  __shared__ float sp[384];
  __shared__ int spos[384];
  __shared__ float sq[64];
  const int tid = threadIdx.x;
  int tok = diag_tok(blockIdx.x >> 1, gridDim.x);
  if (layer == 1 && tok >= TLAT) tok = dhash(blockIdx.x) % TLAT;
  int head = dhash(blockIdx.x * 13 + 3) & 7;
  const bool lat = tok < TLAT;
  int b = lat ? tok >> 12 : (tok - TLAT) >> 8;
  if (tid < 64) sq[tid] = bf2f(p.qC[(size_t)tok * 512 + head * 64 + tid]);
  __syncthreads();
  int nk = lat ? 384 : 256;
  for (int j = tid; j < nk; j += 256) {
    int ktok, kpall; float bias = 0.f;
    if (lat && j < 128) {
      int t = tok & 4095, r = t >> 6, w = t & 63;
      int rs = r - 4; rs = rs < 0 ? 0 : (rs > 56 ? 56 : rs);
      int cs = w - 8; cs = cs < 0 ? 0 : (cs > 48 ? 48 : cs);
      int i = j >> 4, jj = j & 15;
      int kr = rs + i, kc = cs + jj;
      ktok = b * 4096 + kr * 64 + kc; kpall = 256 + kr * 64 + kc;
      bias = p.rpb[(((size_t)layer * 8 + head) * 15 + (kr - r + 7)) * 31 + (kc - w + 15)] * LOG2E;
    } else {
      int c = lat ? j - 128 : j;
      ktok = TLAT + b * 256 + c; kpall = c;
    }
    float s = 0.f;
    for (int d = 0; d < 64; ++d) s += sq[d] * bf2f(p.kC[(size_t)ktok * 512 + head * 64 + d]);
    sp[j] = s + bias; spos[j] = kpall;
  }
  __syncthreads();
  float mx = -1e30f;
  for (int j = 0; j < nk; ++j) mx = fmaxf(mx, sp[j]);
  __syncthreads();
  for (int j = tid; j < nk; j += 256) sp[j] = exp2f(sp[j] - mx);
  __syncthreads();
  double num = 0, den = 0;
  if (tid < 64) {
    double l = 0, o = 0;
    const bf16_t* vb = p.vCT + ((size_t)(b * 8 + head) * 64 + tid) * PALL;
    for (int j = 0; j < nk; ++j) { l += sp[j]; o += (double)sp[j] * bf2f(vb[spos[j]]); }
    double ref = o / l, got = bf2f(p.oC[(size_t)tok * 512 + head * 64 + tid]);
    num = (got - ref) * (got - ref); den = ref * ref;
  }
  diag_accum(num, den, accum, sred);
}
__device__ constexpr int gla_sp(int i) { return i == 0 ? 0 : i == 1 ? 255 : i == 2 ? 256 : i == 3 ? 319 : i == 4 ? 320 : i == 5 ? 1257 : i == 6 ? 2756 : 4351; }
__global__ void __launch_bounds__(256) k_chk_gla(Params p, int layer, double* accum) {
  __shared__ double sred[512];
  __shared__ float sal[64], sqv[64], skv[64];
  __shared__ float sred2[128];
  const int tid = threadIdx.x;
  const int b = blockIdx.x >> 2, hd = blockIdx.x & 3;
  constexpr int NSP = 8;
  float osum[NSP];
#pragma unroll
  for (int i = 0; i < NSP; ++i) osum[i] = 0.f;
  for (int dir = 0; dir < 2; ++dir) {
    float S[64];
#pragma unroll
    for (int d = 0; d < 64; ++d) S[d] = 0.f;
#pragma unroll 1
    for (int step = 0; step < PALL; ++step) {
      int pall;
      if (step < 256) pall = dir ? 255 - step : step; else { int j = step - 256; pall = 256 + (dir ? 4095 - j : j); }
      int tok = pall < 256 ? TLAT + b * 256 + pall : b * 4096 + (pall - 256);
      __syncthreads();
      if (tid < 64) {
        float xv = p.gla_bg[((size_t)layer * 2 + dir) * 256 + hd * 64 + tid];
        for (int r = 0; r < 16; ++r) xv += p.aB[(size_t)tok * 32 + dir * 16 + r] * p.gla_wg[(((size_t)layer * 2 + dir) * 16 + r) * 256 + hd * 64 + tid];
        float ls = fminf(xv, 0.f) - log1pf(expf(-fabsf(xv)));
        sal[tid] = expf(ls / 16.f);
        sqv[tid] = bf2f(p.qB[(size_t)tok * 256 + hd * 64 + tid]);
        skv[tid] = bf2f(p.kB[(size_t)tok * 256 + hd * 64 + tid]);
      }
      __syncthreads();
      if (tid < 128) {
        float v = bf2f(p.vBT[((size_t)(b * 4 + hd) * 128 + tid) * PALL + pall]);
        float o = 0.f;
#pragma unroll
        for (int d = 0; d < 64; ++d) { S[d] = sal[d] * S[d] + skv[d] * v; o += sqv[d] * S[d]; }
#pragma unroll
        for (int i = 0; i < NSP; ++i) if (gla_sp(i) == pall) osum[i] += o;
      }
    }
  }
  double num = 0, den = 0;
#pragma unroll
  for (int i = 0; i < NSP; ++i) {
    if (layer == 1 && gla_sp(i) < 256) continue;
    __syncthreads();
    if (tid < 128) sred2[tid] = osum[i] * osum[i];
    __syncthreads();
    float tot = 0.f;
    for (int j = 0; j < 128; ++j) tot += sred2[j];
    if (tid < 128) {
      int pall = gla_sp(i);
      int tok = pall < 256 ? TLAT + b * 256 + pall : b * 4096 + (pall - 256);
      float rstd = 1.f / sqrtf(tot / 128.f + 1e-6f);
      float rg = bf2f(p.rB[(size_t)tok * 512 + hd * 128 + tid]);
      double ref = osum[i] * rstd * p.gla_norm[layer * 128 + tid] * (rg / (1.f + expf(-rg)));
      double got = bf2f(p.oB[(size_t)tok * 512 + hd * 128 + tid]);
      num += (got - ref) * (got - ref); den += ref * ref;
    }
  }
  diag_accum(num, den, accum, sred);
}
__global__ void __launch_bounds__(256) k_chk_merge(Params p, int layer, double* accum) {
  __shared__ double sred[512];
  const int tid = threadIdx.x;
  int tok = diag_tok(blockIdx.x, gridDim.x);
  if (layer == 1 && tok >= TLAT) tok = dhash(blockIdx.x) % TLAT;
  const float* W = p.w_in + (size_t)layer * 1024 * NIN_SRC;
  double num = 0, den = 0;
  for (int n = tid; n < 1024; n += 256) {
    double tot = 0;
    for (int br = 0; br < 3; ++br) {
      double g = p.b_in[layer * NIN_SRC + 3872 + br * 1024 + n];
      for (int k = 0; k < 1024; ++k) g += (double)bf2f(p.h[(size_t)tok * D + k]) * W[(size_t)k * NIN_SRC + 3872 + br * 1024 + n];
      g = 1.0 / (1.0 + exp(-g));
      const bf16_t* ob = br == 0 ? p.oA : (br == 1 ? p.oB : p.oC);
      const float* wb = (br == 0 ? p.w_br_attn : (br == 1 ? p.w_br_gla : p.w_br_na)) + (size_t)layer * 512 * 1024;
      double a = 0;
      for (int j = 0; j < 512; ++j) a += (double)bf2f(ob[(size_t)tok * 512 + j]) * wb[(size_t)j * 1024 + n];
      tot += g * a;
    }
    double got = bf2f(p.m[(size_t)tok * D + n]);
    num += (got - tot) * (got - tot); den += tot * tot;
  }
  diag_accum(num, den, accum, sred);
}
__global__ void __launch_bounds__(256) k_chk_x1(Params p, double* accum) {
  __shared__ double sred[512];
  __shared__ double sv[1024];
  __shared__ double sx1[1024];
  __shared__ double sst[4];
  const int tid = threadIdx.x;
  int tok = diag_tok(blockIdx.x, gridDim.x);
  const float* cv = tok < TLAT ? p.c + (tok >> 12) * 1024 : p.c_ctx;
  const float* xin = tok < TLAT ? p.x + (size_t)tok * D : p.ctx + (size_t)(tok - TLAT) * D;
  for (int n = tid; n < 1024; n += 256) {
    double y = 0, g1 = p.b_mod[2048 + n];
    for (int k = 0; k < 1024; ++k) {
      y += (double)bf2f(p.m[(size_t)tok * D + k]) * p.w_out[(size_t)k * 1024 + n];
      double cc = cv[k]; g1 += cc / (1.0 + exp(-cc)) * p.w_mod[(size_t)k * NMOD + 2048 + n];
    }
    sv[n] = 1.4142135623730951 * xin[n] + g1 * y;
  }
  __syncthreads();
  if (tid == 0) { double s = 0, q = 0; for (int i = 0; i < 1024; ++i) s += sv[i]; s /= 1024; for (int i = 0; i < 1024; ++i) q += (sv[i] - s) * (sv[i] - s); sst[0] = s; sst[1] = 1.0 / sqrt(q / 1024 + 1e-6); }
  __syncthreads();
  double num = 0, den = 0;
  for (int n = tid; n < 1024; n += 256) {
    double x1 = (sv[n] - sst[0]) * sst[1] * p.ln1_g[n] + p.ln1_b[n];
    sx1[n] = x1;
    double got = p.xres[(size_t)tok * D + n];
    num += (got - x1) * (got - x1); den += x1 * x1;
  }
  __syncthreads();
  if (tid == 0) { double s = 0, q = 0; for (int i = 0; i < 1024; ++i) s += sx1[i]; s /= 1024; for (int i = 0; i < 1024; ++i) q += (sx1[i] - s) * (sx1[i] - s); sst[2] = s; sst[3] = 1.0 / sqrt(q / 1024 + 1e-6); }
  __syncthreads();
  for (int n = tid; n < 1024; n += 256) {
    double sh = p.b_mod[3072 + n], sc = p.b_mod[4096 + n];
    for (int k = 0; k < 1024; ++k) { double cc = cv[k]; double sl = cc / (1.0 + exp(-cc)); sh += sl * p.w_mod[(size_t)k * NMOD + 3072 + n]; sc += sl * p.w_mod[(size_t)k * NMOD + 4096 + n]; }
    double h2 = (sx1[n] - sst[2]) * sst[3] * (1.0 + sc) + sh;
    double got = bf2f(p.h2[(size_t)tok * D + n]);
    num += (got - h2) * (got - h2); den += h2 * h2;
  }
  diag_accum(num, den, accum, sred);
}
__global__ void __launch_bounds__(256) k_chk_moe(Params p, int layer, int mode, double* accum) {
  __shared__ double sred[512];
  __shared__ float sh[1024];
  __shared__ float slog[36];
  __shared__ float shid[1024];
  __shared__ int se[2];
  __shared__ float sw[2];
  const int tid = threadIdx.x;
  int tok = diag_tok(blockIdx.x, gridDim.x);
  if (layer == 1 && tok >= TLAT) tok = dhash(blockIdx.x) % TLAT;
  for (int i = tid; i < 1024; i += 256) sh[i] = bf2f(p.h2[(size_t)tok * D + i]);
  __syncthreads();
  if (tid < 36) {
    double a;
    if (tid < 32) { a = p.b_re[layer * 32 + tid]; for (int k = 0; k < 1024; ++k) a += (double)sh[k] * p.w_re[((size_t)layer * 1024 + k) * 32 + tid]; }
    else { a = p.b_rg[layer * 4 + tid - 32]; for (int k = 0; k < 1024; ++k) a += (double)sh[k] * p.w_rg[((size_t)layer * 1024 + k) * 4 + tid - 32]; }
    slog[tid] = (float)a;
  }
  __syncthreads();
  if (tid == 0) {
    int grp = 0; for (int i = 1; i < 4; ++i) if (slog[32 + i] > slog[32 + grp]) grp = i;
    double gs = 0; for (int i = 0; i < 4; ++i) gs += exp((double)slog[32 + i] - slog[32 + grp]);
    double pg = 1.0 / gs;
    int i0 = 0; for (int i = 1; i < 8; ++i) if (slog[grp * 8 + i] > slog[grp * 8 + i0]) i0 = i;
    int i1 = -1; for (int i = 0; i < 8; ++i) if (i != i0 && (i1 < 0 || slog[grp * 8 + i] > slog[grp * 8 + i1])) i1 = i;
    double e1 = exp((double)slog[grp * 8 + i1] - slog[grp * 8 + i0]);
    se[0] = grp * 8 + i0; se[1] = grp * 8 + i1; sw[0] = (float)(pg / (1 + e1)); sw[1] = (float)(pg * e1 / (1 + e1));
  }
  __syncthreads();
  if (mode == 1) {
    double num = 0, den = 0;
    if (tid == 0) { den = 1.0; bool same = (p.tok_e[tok * 2] == se[0] && p.tok_e[tok * 2 + 1] == se[1]); num = same ? 0.0 : 1.0; }
    diag_accum(num, den, accum, sred);
    return;
  }
  int e0 = p.tok_e[tok * 2], e1 = p.tok_e[tok * 2 + 1];
  float w0 = p.tok_gate[tok * 2], w1 = p.tok_gate[tok * 2 + 1];
  double num = 0, den = 0;
  if (tid == 0 && e0 == se[0] && e1 == se[1]) { num += (w0 - sw[0]) * (w0 - sw[0]) + (w1 - sw[1]) * (w1 - sw[1]); }
  for (int i = tid; i < 1024; i += 256) {
    int k = i >> 9, j = i & 511, e = k ? e1 : e0;
    const float* w1p = p.w1 + ((size_t)layer * 32 + e) * 1024 * 512;
    const float* w3p = p.w3 + ((size_t)layer * 32 + e) * 1024 * 512;
    double a = 0, c = 0;
    for (int kk = 0; kk < 1024; ++kk) { a += (double)sh[kk] * w1p[(size_t)kk * 512 + j]; c += (double)sh[kk] * w3p[(size_t)kk * 512 + j]; }
    shid[i] = (float)(a / (1.0 + exp(-a)) * c);
  }
  __syncthreads();
  int s0 = p.estart[e0] * MOE_BLK + p.tok_pos[tok * 2], s1 = p.estart[e1] * MOE_BLK + p.tok_pos[tok * 2 + 1];
  for (int n = tid; n < 1024; n += 256) {
    double y = 0;
    const float* w2a = p.w2 + ((size_t)layer * 32 + e0) * 512 * 1024;
    const float* w2b = p.w2 + ((size_t)layer * 32 + e1) * 512 * 1024;
    double ya = 0, yb = 0;
    for (int j = 0; j < 512; ++j) { ya += (double)shid[j] * w2a[(size_t)j * 1024 + n]; yb += (double)shid[512 + j] * w2b[(size_t)j * 1024 + n]; }
    y = w0 * ya + w1 * yb;
    double got = w0 * bf2f(p.ysl[(size_t)s0 * D + n]) + w1 * bf2f(p.ysl[(size_t)s1 * D + n]);
    num += (got - y) * (got - y); den += y * y;
  }
  diag_accum(num, den, accum, sred);
}
__global__ void k_saverows(Params p, float* xsave, int layer) {
  int tok = diag_tok(blockIdx.x, gridDim.x);
  if (layer == 1 && tok >= TLAT) tok = dhash(blockIdx.x) % TLAT;
  for (int i = threadIdx.x; i < 1024; i += 256) xsave[(size_t)blockIdx.x * 1024 + i] = p.xres[(size_t)tok * D + i];
}
__global__ void __launch_bounds__(256) k_chk_final(Params p, int layer, const float* xsave, double* accum) {
  __shared__ double sred[512];
  __shared__ double sv[1024];
  __shared__ double sst[4];
  const int tid = threadIdx.x;
  int tok = diag_tok(blockIdx.x, gridDim.x);
  if (layer == 1 && tok >= TLAT) tok = dhash(blockIdx.x) % TLAT;
  const float* cv = tok < TLAT ? p.c + (tok >> 12) * 1024 : p.c_ctx;
  int e0 = p.tok_e[tok * 2], e1 = p.tok_e[tok * 2 + 1];
  float w0 = p.tok_gate[tok * 2], w1 = p.tok_gate[tok * 2 + 1];
  int s0 = p.estart[e0] * MOE_BLK + p.tok_pos[tok * 2], s1 = p.estart[e1] * MOE_BLK + p.tok_pos[tok * 2 + 1];
  for (int n = tid; n < 1024; n += 256) {
    double g2 = p.b_mod[layer * NMOD + 5120 + n];
    for (int k = 0; k < 1024; ++k) { double cc = cv[k]; g2 += cc / (1.0 + exp(-cc)) * p.w_mod[((size_t)layer * 1024 + k) * NMOD + 5120 + n]; }
    double y = w0 * bf2f(p.ysl[(size_t)s0 * D + n]) + w1 * bf2f(p.ysl[(size_t)s1 * D + n]);
    sv[n] = 1.4142135623730951 * xsave[(size_t)blockIdx.x * 1024 + n] + g2 * y;
  }
  __syncthreads();
  if (tid == 0) { double s = 0, q = 0; for (int i = 0; i < 1024; ++i) s += sv[i]; s /= 1024; for (int i = 0; i < 1024; ++i) q += (sv[i] - s) * (sv[i] - s); sst[0] = s; sst[1] = 1.0 / sqrt(q / 1024 + 1e-6); }
  __syncthreads();
  double num = 0, den = 0;
  for (int n = tid; n < 1024; n += 256) {
    double x2 = (sv[n] - sst[0]) * sst[1] * p.ln2_g[layer * D + n] + p.ln2_b[layer * D + n];
    sv[n] = x2;
    double got = layer == 1 ? p.out[(size_t)tok * D + n] : p.xres[(size_t)tok * D + n];
    num += (got - x2) * (got - x2); den += x2 * x2;
  }
  __syncthreads();
  if (layer == 0) {
    if (tid == 0) { double s = 0, q = 0; for (int i = 0; i < 1024; ++i) s += sv[i]; s /= 1024; for (int i = 0; i < 1024; ++i) q += (sv[i] - s) * (sv[i] - s); sst[2] = s; sst[3] = 1.0 / sqrt(q / 1024 + 1e-6); }
    __syncthreads();
    for (int n = tid; n < 1024; n += 256) {
      double sh = p.b_mod[NMOD + n], sc = p.b_mod[NMOD + 1024 + n];
      for (int k = 0; k < 1024; ++k) { double cc = cv[k]; double sl = cc / (1.0 + exp(-cc)); sh += sl * p.w_mod[((size_t)1024 + k) * NMOD + n]; sc += sl * p.w_mod[((size_t)1024 + k) * NMOD + 1024 + n]; }
      double h = (sv[n] - sst[2]) * sst[3] * (1.0 + sc) + sh;
      double got = bf2f(p.h[(size_t)tok * D + n]);
      num += (got - h) * (got - h); den += h * h;
    }
  }
  diag_accum(num, den, accum, sred);
}
#endif

static inline size_t align_up(size_t v, size_t a) { return (v + a - 1) / a * a; }

extern "C" void kernel_launch(void* const* d_in, const int* in_sizes, int n_in, void* d_out, int out_size, void* d_ws, size_t ws_size,
                              hipStream_t stream) {
  Params p{};
  const float* const* in = (const float* const*)d_in;
  p.x = in[0]; p.c = in[1]; p.ctx = in[2]; p.c_ctx = in[3]; p.w_mod = in[4]; p.b_mod = in[5]; p.w_in = in[6]; p.b_in = in[7];
  p.q_norm = in[8]; p.k_norm = in[9]; p.gla_wg = in[10]; p.gla_bg = in[11]; p.gla_norm = in[12]; p.rpb = in[13];
  p.w_br_attn = in[14]; p.w_br_gla = in[15]; p.w_br_na = in[16]; p.w_out = in[17]; p.ln1_g = in[18]; p.ln1_b = in[19];
  p.w_rg = in[20]; p.b_rg = in[21]; p.w_re = in[22]; p.b_re = in[23]; p.w1 = in[24]; p.w3 = in[25]; p.w2 = in[26];
  p.ln2_g = in[27]; p.ln2_b = in[28];
  p.out = (float*)d_out;

  char* base = (char*)d_ws;
  size_t off = 0;
  auto take = [&](size_t bytes) { char* q = base + off; off = align_up(off + bytes, 256); return q; };
  p.mod_part = (float*)take((size_t)16 * 2 * 5 * NMOD * 4);
  p.mod = (float*)take((size_t)2 * 5 * NMOD * 4);
  p.rope = (float*)take(2048 * 4);
  p.wrp = (float*)take((size_t)2 * 49152 * 4);
  p.bar = (unsigned*)take(XCD_BAR_WORDS * 4);
  p.cnt = (int*)take(32 * 4);
  p.estart = (int*)take(32 * 4);
  p.cntg = (int*)take((size_t)1088 * 32 * 4);
  p.list = (int*)take((size_t)32 * MOE_CAP * 4);
  p.tok_e = (int*)take((size_t)TALL * 2 * 4);
  p.tok_pos = (int*)take((size_t)TALL * 2 * 4);
  p.tok_gate = (float*)take((size_t)TALL * 2 * 4);
  p.wt_in = (bf16_t*)take((size_t)3968 * 1024 * 2);
  p.wt_gate = (bf16_t*)take((size_t)3072 * 1024 * 2);
  p.wt_br = (bf16_t*)take((size_t)3 * 1024 * 512 * 2);
  p.wt_out = (bf16_t*)take((size_t)1024 * 1024 * 2);
  p.wt_13 = (bf16_t*)take((size_t)32 * 1024 * 1024 * 2);
  p.wt_2 = (bf16_t*)take((size_t)32 * 1024 * 512 * 2);
  p.G = p.wt_13;
  p.xres = (float*)take((size_t)TALL * D * 4);
  p.h = (bf16_t*)take((size_t)TALL * D * 2);
  size_t r1 = off;
  p.qA = (bf16_t*)take((size_t)TALL * 512 * 2);
  p.kA = (bf16_t*)take((size_t)4 * 2 * PALL * 64 * 2);
  p.vAT = (bf16_t*)take((size_t)4 * 2 * 64 * PALL * 2);
  p.qB = (bf16_t*)take((size_t)TALL * 256 * 2);
  p.kB = (bf16_t*)take((size_t)TALL * 256 * 2);
  p.vBT = (bf16_t*)take((size_t)4 * 4 * 128 * PALL * 2);
  p.rB = (bf16_t*)take((size_t)TALL * 512 * 2);
  p.aB = (float*)take((size_t)TALL * 32 * 4);
  p.qC = (bf16_t*)take((size_t)TALL * 512 * 2);
  p.kC = (bf16_t*)take((size_t)TALL * 512 * 2);
  p.vCT = (bf16_t*)take((size_t)4 * 8 * 64 * PALL * 2);
  p.oA = (bf16_t*)take((size_t)TALL * 512 * 2);
  p.oB = (bf16_t*)take((size_t)TALL * 512 * 2);
  p.oC = (bf16_t*)take((size_t)TALL * 512 * 2);
  size_t r1_end = off;
  {
    size_t o2 = r1;
    p.act = (bf16_t*)(base + o2); o2 = align_up(o2 + (size_t)MAX_MBLK * MOE_BLK * 512 * 2, 256);
    p.ysl = (bf16_t*)(base + o2); o2 = align_up(o2 + (size_t)MAX_MBLK * MOE_BLK * 1024 * 2, 256);
    if (o2 > r1_end) off = o2;
  }
  p.KVt = (float*)take((size_t)32 * NCHUNK * 8192 * 4);
  p.SP = (bf16_t*)take((size_t)32 * NCHUNK * 8192 * 2);
  p.decay = (float*)take((size_t)32 * NCHUNK * 64 * 4);
  p.bcum = (float*)take((size_t)32 * NCHUNK * 4096 * 4);
  p.m = (bf16_t*)p.KVt;
  p.h2 = p.SP;
  if (off > ws_size) {
    fprintf(stderr, "workspace too small: need %zu have %zu\n", off, ws_size);
    return;
  }
  const dim3 blk(256);
#ifdef DIAG_STAGE
  {
    double* accum = (double*)take(64);
    float* xsave = (float*)take((size_t)64 * 1024 * 4);
    if (off > ws_size) return;
    const int G = 1024;
    const int DL = DIAG_LAYER, DS = DIAG_STAGE;
    k_diag_zero<<<1, 64, 0, stream>>>(accum);
    k_setup<<<((769 + 96) + 1) / 2, dim3(512), 0, stream>>>(p, 0);
    k_convert<<<((2048) + 1) / 2, dim3(512), 0, stream>>>(p, 0);
    k_modreduce<<<((240) + 1) / 2, dim3(512), 0, stream>>>(p, 0);
    k_rowpass0<<<((G) + 1) / 2, dim3(512), 0, stream>>>(p, 0);
    if (DS == 1 || DS == 0) k_chk_h<<<32, blk, 0, stream>>>(p, accum + 2);
    for (int l = 0; l <= DL; ++l) {
      const bool chk = (l == DL);
      k_inproj<<<((G) + 1) / 2, dim3(512), 0, stream>>>(p, l);
      if (chk && (DS == 2 || DS == 0)) k_chk_inproj<<<64, blk, 0, stream>>>(p, l, accum + 4);
      k_gla1<<<((G) + 1) / 2, dim3(512), 0, stream>>>(p, l);
      k_na<<<((1088) + 1) / 2, dim3(512), 0, stream>>>(p, l);
      if (chk && (DS == 4 || DS == 0)) k_chk_na<<<128, blk, 0, stream>>>(p, l, accum + 8);
      k_gla2<<<((G) + 1) / 2, dim3(512), 0, stream>>>(p, l);
      k_attnA<<<((1088) + 1) / 2, dim3(512), 0, stream>>>(p, l);
      if (chk && (DS == 3 || DS == 0)) k_chk_attnA<<<128, blk, 0, stream>>>(p, l, accum + 6);
      k_gla3<<<((1088) + 1) / 2, dim3(512), 0, stream>>>(p, l);
      if (chk && (DS == 5 || DS == 0)) k_chk_gla<<<16, blk, 0, stream>>>(p, l, accum + 10);
      k_merge<<<((G) + 1) / 2, dim3(512), 0, stream>>>(p, l);
      if (chk && (DS == 6 || DS == 0)) k_chk_merge<<<32, blk, 0, stream>>>(p, l, accum + 12);
      k_outproj<<<((G) + 1) / 2, dim3(512), 0, stream>>>(p, l);
      k_rowpass1<<<((G) + 1) / 2, dim3(512), 0, stream>>>(p, l);
      if (chk && l == 0 && (DS == 7 || DS == 0)) k_chk_x1<<<32, blk, 0, stream>>>(p, accum + 14);
      k_moescan<<<((32) + 1) / 2, dim3(512), 0, stream>>>(p, l);
      k_convert<<<((2048) + 1) / 2, dim3(512), 0, stream>>>(p, l | 16);
    k_moe1<<<((G) + 1) / 2, dim3(512), 0, stream>>>(p, l);
      k_moe2<<<((G) + 1) / 2, dim3(512), 0, stream>>>(p, l);
      if (chk && (DS == 8 || DS == 0)) k_chk_moe<<<32, blk, 0, stream>>>(p, l, 0, accum + 16);
      if (chk && DS == 9) k_chk_moe<<<512, blk, 0, stream>>>(p, l, 1, accum + 18);
      if (chk && (DS == 10 || DS == 0)) k_saverows<<<32, blk, 0, stream>>>(p, xsave, l);
      k_rowpass2<<<((G) + 1) / 2, dim3(512), 0, stream>>>(p, l);
      if (chk && (DS == 10 || DS == 0)) k_chk_final<<<32, blk, 0, stream>>>(p, l, xsave, accum + 20);
      if (l == 0) k_convert<<<((2048) + 1) / 2, dim3(512), 0, stream>>>(p, 1);
    }
    k_diag_report<<<1024, blk, 0, stream>>>(accum, p.out, TLAT * D);
    return;
  }
#endif
#ifdef MK_MULTI
  const int G = 1024;
  k_setup<<<((769 + 96) + 1) / 2, dim3(512), 0, stream>>>(p, 0);
  k_convert<<<((2048) + 1) / 2, dim3(512), 0, stream>>>(p, 0);
  k_modreduce<<<((240) + 1) / 2, dim3(512), 0, stream>>>(p, 0);
  k_rowpass0<<<((G) + 1) / 2, dim3(512), 0, stream>>>(p, 0);
  for (int l = 0; l < 2; ++l) {
    k_inproj<<<((G) + 1) / 2, dim3(512), 0, stream>>>(p, l);
    k_gla1<<<((G) + 1) / 2, dim3(512), 0, stream>>>(p, l);
    k_na<<<((1088) + 1) / 2, dim3(512), 0, stream>>>(p, l);
    k_gla2<<<((G) + 1) / 2, dim3(512), 0, stream>>>(p, l);
    k_attnA<<<((1088) + 1) / 2, dim3(512), 0, stream>>>(p, l);
    k_gla3<<<((1088) + 1) / 2, dim3(512), 0, stream>>>(p, l);
    k_merge<<<((G) + 1) / 2, dim3(512), 0, stream>>>(p, l);
    k_outproj<<<((G) + 1) / 2, dim3(512), 0, stream>>>(p, l);
    k_rowpass1<<<((G) + 1) / 2, dim3(512), 0, stream>>>(p, l);
    k_moescan<<<((32) + 1) / 2, dim3(512), 0, stream>>>(p, l);
    k_convert<<<((2048) + 1) / 2, dim3(512), 0, stream>>>(p, l | 16);
    k_moe1<<<((G) + 1) / 2, dim3(512), 0, stream>>>(p, l);
    k_moe2<<<((G) + 1) / 2, dim3(512), 0, stream>>>(p, l);
    k_rowpass2<<<((G) + 1) / 2, dim3(512), 0, stream>>>(p, l);
    if (l == 0) k_convert<<<((2048) + 1) / 2, dim3(512), 0, stream>>>(p, 1);
  }
#else
  static int grid_blocks = 0;
  if (!grid_blocks) {
    int dev = 0, cus = 0, per_cu = 0;
    hipGetDevice(&dev);
    hipDeviceGetAttribute(&cus, hipDeviceAttributeMultiprocessorCount, dev);
    hipOccupancyMaxActiveBlocksPerMultiprocessor(&per_cu, k_mega, 512, 0);
    per_cu = 1;
    grid_blocks = cus * per_cu;
  }
  hipMemsetAsync(p.bar, 0, XCD_BAR_WORDS * 4, stream);
  k_mega<<<dim3(grid_blocks), dim3(512), 0, stream>>>(p);
#endif
}
```
